# Optimizing an MI355X kernel written in HIP

```python
import numpy as np
import jax
import jax.numpy as jnp
from jax import lax

D_MODEL = 1024
BATCH = 8
SEQ = 2048
DEPTH = 2

GRID_W = 64
CTX_LEN = 256
Q_BLOCK = 128
ROPE_BASE = 10000.0
EPS = 1e-6

MLA_HEADS = 8
MLA_NOPE = 64
MLA_ROPE = 32
MLA_V = 64
MLA_Q_LORA = 256
MLA_KV_LORA = 128
RET_HEADS = 4
RET_DK = 64
RET_DV = 128
RET_CHUNK = 128
LRU_WIDTH = 512
LRU_BLOCKS = 8
LRU_BLOCK_W = LRU_WIDTH // LRU_BLOCKS
LRU_C = 8.0
CONV_W = 4
CONV_PAD_LEFT = 2
GQA_HEADS = 8
GQA_KV_HEADS = 2
GQA_HEAD_DIM = 64
N_BRANCH = 4
BRANCH_W = 512
N_EXPERTS = 64
N_GROUPS = 8
EXPERTS_PER_GROUP = N_EXPERTS // N_GROUPS
TOP_K = 2
EXPERT_FF = 256
MOE_BLOCK = 128

IN_SPLITS = (MLA_Q_LORA, MLA_KV_LORA, MLA_ROPE,
             RET_HEADS * RET_DK, RET_HEADS * RET_DK, RET_HEADS * RET_DV, RET_HEADS * RET_DV,
             LRU_WIDTH, LRU_WIDTH,
             GQA_HEADS * GQA_HEAD_DIM, GQA_KV_HEADS * GQA_HEAD_DIM, GQA_KV_HEADS * GQA_HEAD_DIM)
D_IN = sum(IN_SPLITS)
IN_OFFSETS = tuple(int(o) for o in np.cumsum(IN_SPLITS)[:-1])

kernel_name = "hybrid_mla_retnet_rglru_gqa_grouped_moe_dit"


def rms_norm(x, g):
    xf = x.astype(jnp.float32)
    y = xf * lax.rsqrt(jnp.mean(xf * xf, axis=-1, keepdims=True) + EPS)
    return (y * g.astype(jnp.float32)).astype(x.dtype)


def modulate(h, shift, scale):
    return h * (1 + scale) + shift


def group_layer_norm(o, g):
    of = o.astype(jnp.float32)
    mu = jnp.mean(of, axis=-1, keepdims=True)
    var = jnp.mean(jnp.square(of - mu), axis=-1, keepdims=True)
    y = ((of - mu) * lax.rsqrt(var + EPS)).reshape(o.shape[0], o.shape[1], -1)
    return (y * g.astype(jnp.float32)).astype(o.dtype)


def axial_angles(rows, cols, rot_dim):
    half = rot_dim // 2
    inv = ROPE_BASE ** (-jnp.arange(0, half, 2, dtype=jnp.float32) / half)
    return rows.astype(jnp.float32)[:, None] * inv, cols.astype(jnp.float32)[:, None] * inv


def rope_1d(x, ang):
    x1, x2 = jnp.split(x, 2, axis=-1)
    cos = jnp.cos(ang)[:, None, :].astype(x.dtype)
    sin = jnp.sin(ang)[:, None, :].astype(x.dtype)
    return jnp.concatenate([x1 * cos - x2 * sin, x2 * cos + x1 * sin], axis=-1)


def rope_2d(x, ang_row, ang_col):
    half = x.shape[-1] // 2
    return jnp.concatenate([rope_1d(x[..., :half], ang_row), rope_1d(x[..., half:], ang_col)], axis=-1)


def merge_heads(o):
    B, H, L, d = o.shape
    return o.transpose(0, 2, 1, 3).reshape(B, L, H * d)


def attend_blocked(q, k, v, scale):
    B, HQ, L, DK = q.shape
    HK = k.shape[1]
    G = HQ // HK
    nb = L // Q_BLOCK
    qb = q.reshape(B, HK, G, nb, Q_BLOCK, DK).transpose(3, 0, 1, 2, 4, 5)

    def block(qi):
        s = jnp.einsum('bhgqd,bhkd->bhgqk', qi, k, preferred_element_type=jnp.float32) * scale
        p = jax.nn.softmax(s, axis=-1).astype(v.dtype)
        return jnp.einsum('bhgqk,bhkd->bhgqd', p, v)

    o = lax.map(block, qb)
    return o.transpose(1, 2, 3, 0, 4, 5).reshape(B, HQ, L, v.shape[-1])


def mla_qkv(cq, ckv, k_rope, q_norm, kv_norm, w_uq, w_ukv, ang):
    B, L, _ = cq.shape
    q = (rms_norm(cq, q_norm) @ w_uq).reshape(B, L, MLA_HEADS, MLA_NOPE + MLA_ROPE)
    kv = (rms_norm(ckv, kv_norm) @ w_ukv).reshape(B, L, MLA_HEADS, MLA_NOPE + MLA_V)
    q_nope, q_rot = q[..., :MLA_NOPE], q[..., MLA_NOPE:]
    k_nope, v = kv[..., :MLA_NOPE], kv[..., MLA_NOPE:]
    k_rot = k_rope[:, :, None, :]
    if ang is not None:
        q_rot = rope_2d(q_rot, *ang)
        k_rot = rope_2d(k_rot, *ang)
    k_rot = jnp.broadcast_to(k_rot, (B, L, MLA_HEADS, MLA_ROPE))
    q = jnp.concatenate([q_nope, q_rot], axis=-1)
    k = jnp.concatenate([k_nope, k_rot], axis=-1)
    return q.transpose(0, 2, 1, 3), k.transpose(0, 2, 1, 3), v.transpose(0, 2, 1, 3)


def mla_branch(zl, zc, ang, with_ctx_out, q_norm, kv_norm, w_uq, w_ukv):
    ql, kl, vl = mla_qkv(zl[0], zl[1], zl[2], q_norm, kv_norm, w_uq, w_ukv, ang)
    qc, kc, vc = mla_qkv(zc[0], zc[1], zc[2], q_norm, kv_norm, w_uq, w_ukv, None)
    scale = (MLA_NOPE + MLA_ROPE) ** -0.5
    y_lat = merge_heads(attend_blocked(ql, jnp.concatenate([kl, kc], axis=2),
                                       jnp.concatenate([vl, vc], axis=2), scale))
    y_ctx = merge_heads(attend_blocked(qc, kc, vc, scale)) if with_ctx_out else None
    return y_lat, y_ctx


def retention_chunked(q, k, v, log_gamma, s0, inclusive):
    B, H, L, DK = q.shape
    DV = v.shape[-1]
    nc = L // RET_CHUNK
    pos = jnp.arange(RET_CHUNK, dtype=jnp.float32)
    diff = pos[:, None] - pos[None, :]
    mask = diff >= 0 if inclusive else diff > 0
    lg = log_gamma.astype(jnp.float32)
    intra = jnp.where(mask, jnp.exp(lg[:, None, None] * jnp.where(mask, diff, 0.0)), 0.0)
    q_dec = jnp.exp(lg[:, None] * (pos + 1.0))[None, :, :, None]
    k_dec = jnp.exp(lg[:, None] * (RET_CHUNK - 1.0 - pos))[None, :, :, None]
    c_dec = jnp.exp(lg * RET_CHUNK)[None, :, None, None]

    def to_chunks(t):
        return t.astype(jnp.float32).reshape(B, H, nc, RET_CHUNK, t.shape[-1]).transpose(2, 0, 1, 3, 4)

    def step(s, qkv):
        qi, ki, vi = qkv
        scores = jnp.einsum('bhid,bhjd->bhij', qi, ki) * intra
        o = jnp.einsum('bhij,bhje->bhie', scores, vi) + jnp.einsum('bhid,bhde->bhie', qi * q_dec, s)
        s = s * c_dec + jnp.einsum('bhjd,bhje->bhde', ki * k_dec, vi)
        return s, o

    s_fin, o = lax.scan(step, s0, (to_chunks(q), to_chunks(k), to_chunks(v)))
    o = o.transpose(1, 2, 0, 3, 4).reshape(B, H, L, DV)
    return s_fin, o.astype(v.dtype)


def retention_heads(q, k, v, ang):
    B, L, _ = q.shape
    q = q.reshape(B, L, RET_HEADS, RET_DK)
    k = k.reshape(B, L, RET_HEADS, RET_DK) * (RET_DK ** -0.5)
    v = v.reshape(B, L, RET_HEADS, RET_DV)
    if ang is not None:
        q = rope_2d(q, *ang)
        k = rope_2d(k, *ang)
    return q.transpose(0, 2, 1, 3), k.transpose(0, 2, 1, 3), v.transpose(0, 2, 1, 3)


def retention_branch(zl, zc, ang, with_ctx_out, ret_decay, ret_norm):
    ql, kl, vl = retention_heads(zl[3], zl[4], zl[5], ang)
    qc, kc, vc = retention_heads(zc[3], zc[4], zc[5], None)
    log_g = -jax.nn.softplus(-ret_decay.astype(jnp.float32))
    s0 = jnp.zeros((ql.shape[0], RET_HEADS, RET_DK, RET_DV), jnp.float32)

    def flip(t):
        return t[:, :, ::-1]

    s_cf, o_cf = retention_chunked(qc, kc, vc, log_g[0], s0, True)
    s_cb, o_cb = retention_chunked(flip(qc), flip(kc), flip(vc), log_g[1], s0, False)
    _, o_lf = retention_chunked(ql, kl, vl, log_g[0], s_cf, True)
    _, o_lb = retention_chunked(flip(ql), flip(kl), flip(vl), log_g[1], s_cb, False)

    def finish(o, gate):
        return jax.nn.silu(gate) * group_layer_norm(o.transpose(0, 2, 1, 3), ret_norm).astype(gate.dtype)

    y_lat = finish(o_lf + flip(o_lb), zl[6])
    y_ctx = finish(o_cf + flip(o_cb), zc[6]) if with_ctx_out else None
    return y_lat, y_ctx


def short_conv(u, w, b):
    L = u.shape[1]
    up = jnp.pad(u, ((0, 0), (CONV_PAD_LEFT, CONV_W - 1 - CONV_PAD_LEFT), (0, 0)))
    out = b
    for j in range(CONV_W):
        out = out + up[:, j:j + L] * w[j]
    return out


def rglru_coeffs(u, w_a, b_a, w_x, b_x, lam):
    B, L, W = u.shape
    ub = u.reshape(B, L, LRU_BLOCKS, LRU_BLOCK_W)
    r = jax.nn.sigmoid(jnp.einsum('blnc,ncd->blnd', ub, w_a).reshape(B, L, W) + b_a)
    i = jax.nn.sigmoid(jnp.einsum('blnc,ncd->blnd', ub, w_x).reshape(B, L, W) + b_x)
    log_a = (-LRU_C * r.astype(jnp.float32)) * jax.nn.softplus(-lam.astype(jnp.float32))
    a = jnp.exp(log_a)
    b = jnp.sqrt(-jnp.expm1(2.0 * log_a)) * (i * u).astype(jnp.float32)
    return a, b


def linear_recurrence(a, b, h0):
    b = b.at[:, 0].add(a[:, 0] * h0)

    def combine(left, right):
        a_l, b_l = left
        a_r, b_r = right
        return a_l * a_r, a_r * b_l + b_r

    _, h = lax.associative_scan(combine, (a, b), axis=1)
    return h


def rglru_branch(zl, zc, with_ctx_out, conv_w, conv_b, w_a, b_a, w_x, b_x, lam):
    u_lat = short_conv(zl[7], conv_w, conv_b)
    u_ctx = short_conv(zc[7], conv_w, conv_b)
    h_lat_dirs, h_ctx_dirs = [], []
    for d in range(2):
        def f(t, d=d):
            return t[:, ::-1] if d == 1 else t
        a_c, b_c = rglru_coeffs(f(u_ctx), w_a[d], b_a[d], w_x[d], b_x[d], lam[d])
        h_c = linear_recurrence(a_c, b_c, jnp.zeros_like(b_c[:, 0]))
        a_l, b_l = rglru_coeffs(f(u_lat), w_a[d], b_a[d], w_x[d], b_x[d], lam[d])
        h_l = linear_recurrence(a_l, b_l, h_c[:, -1])
        h_lat_dirs.append(f(h_l))
        h_ctx_dirs.append(f(h_c))
    y_lat = (h_lat_dirs[0] + h_lat_dirs[1]).astype(zl[8].dtype) * jax.nn.gelu(zl[8])
    y_ctx = ((h_ctx_dirs[0] + h_ctx_dirs[1]).astype(zc[8].dtype) * jax.nn.gelu(zc[8])) if with_ctx_out else None
    return y_lat, y_ctx


def gqa_qkv(q, k, v, q_norm, k_norm, ang):
    B, L, _ = q.shape
    q = rms_norm(q.reshape(B, L, GQA_HEADS, GQA_HEAD_DIM), q_norm)
    k = rms_norm(k.reshape(B, L, GQA_KV_HEADS, GQA_HEAD_DIM), k_norm)
    v = v.reshape(B, L, GQA_KV_HEADS, GQA_HEAD_DIM)
    if ang is not None:
        q = rope_2d(q, *ang)
        k = rope_2d(k, *ang)
    return q.transpose(0, 2, 1, 3), k.transpose(0, 2, 1, 3), v.transpose(0, 2, 1, 3)


def gqa_branch(zl, zc, ang, with_ctx_out, q_norm, k_norm):
    ql, kl, vl = gqa_qkv(zl[9], zl[10], zl[11], q_norm, k_norm, ang)
    qc, kc, vc = gqa_qkv(zc[9], zc[10], zc[11], q_norm, k_norm, None)
    scale = GQA_HEAD_DIM ** -0.5
    y_lat = merge_heads(attend_blocked(ql, jnp.concatenate([kl, kc], axis=2),
                                       jnp.concatenate([vl, vc], axis=2), scale))
    y_ctx = merge_heads(attend_blocked(qc, kc, vc, scale)) if with_ctx_out else None
    return y_lat, y_ctx


def merge_branches(h, branches, w_branch, w_merge, b_merge, w_out):
    stack = jnp.stack(branches, axis=2)
    proj = jnp.einsum('blnm,nmd->blnd', stack, w_branch)
    gates = jax.nn.sigmoid(h @ w_merge + b_merge).reshape(h.shape[0], h.shape[1], N_BRANCH, D_MODEL)
    return jnp.sum(gates * proj, axis=2) @ w_out


def token_mixers(h_lat, h_ctx, ang_mla, ang_head, with_ctx_out, w_in,
                 mla_q_norm, mla_kv_norm, mla_w_uq, mla_w_ukv, ret_decay, ret_norm,
                 lru_conv_w, lru_conv_b, lru_w_a, lru_b_a, lru_w_x, lru_b_x, lru_lambda,
                 gqa_q_norm, gqa_k_norm, w_branch, w_merge, b_merge, w_out):
    zl = jnp.split(h_lat @ w_in, list(IN_OFFSETS), axis=-1)
    zc = jnp.split(h_ctx @ w_in, list(IN_OFFSETS), axis=-1)
    ya = mla_branch(zl, zc, ang_mla, with_ctx_out, mla_q_norm, mla_kv_norm, mla_w_uq, mla_w_ukv)
    yb = retention_branch(zl, zc, ang_head, with_ctx_out, ret_decay, ret_norm)
    yc = rglru_branch(zl, zc, with_ctx_out, lru_conv_w, lru_conv_b, lru_w_a, lru_b_a, lru_w_x, lru_b_x, lru_lambda)
    yd = gqa_branch(zl, zc, ang_head, with_ctx_out, gqa_q_norm, gqa_k_norm)
    out_lat = merge_branches(h_lat, [ya[0], yb[0], yc[0], yd[0]], w_branch, w_merge, b_merge, w_out)
    if not with_ctx_out:
        return out_lat, None
    out_ctx = merge_branches(h_ctx, [ya[1], yb[1], yc[1], yd[1]], w_branch, w_merge, b_merge, w_out)
    return out_lat, out_ctx


def moe_ffn(h, router_w, router_bias, w1, w3, w2):
    T, D = h.shape
    scores = jax.nn.sigmoid(jnp.dot(h, router_w, preferred_element_type=jnp.float32))
    biased = (scores + router_bias.astype(jnp.float32)).reshape(T, N_GROUPS, EXPERTS_PER_GROUP)
    group_score = jnp.sum(lax.top_k(biased, 2)[0], axis=-1)
    grp = jnp.argmax(group_score, axis=-1)
    in_grp = jnp.take_along_axis(biased, grp[:, None, None], axis=1)[:, 0]
    _, local = lax.top_k(in_grp, TOP_K)
    expert = grp[:, None] * EXPERTS_PER_GROUP + local
    w = jnp.take_along_axis(scores, expert, axis=1)
    w = w / jnp.sum(w, axis=-1, keepdims=True)

    TK = T * TOP_K
    flat_e = expert.reshape(-1)
    flat_tok = jnp.arange(TK, dtype=jnp.int32) // TOP_K
    order = jnp.argsort(flat_e)
    e_sorted = flat_e[order]
    tok_sorted = flat_tok[order]
    w_sorted = w.reshape(-1)[order]
    counts = jnp.bincount(flat_e, length=N_EXPERTS)
    padded = (counts + MOE_BLOCK - 1) // MOE_BLOCK * MOE_BLOCK
    pad_end = jnp.cumsum(padded)
    pad_start = pad_end - padded
    start = jnp.cumsum(counts) - counts
    slot = pad_start[e_sorted] + (jnp.arange(TK, dtype=jnp.int32) - start[e_sorted])
    n_blocks = -(-TK // MOE_BLOCK) + N_EXPERTS
    slot_tok = jnp.full((n_blocks * MOE_BLOCK,), T, jnp.int32).at[slot].set(tok_sorted)
    block_expert = jnp.minimum(
        jnp.searchsorted(pad_end, jnp.arange(n_blocks, dtype=jnp.int32) * MOE_BLOCK, side='right'),
        N_EXPERTS - 1)
    h_pad = jnp.concatenate([h, jnp.zeros((1, D), h.dtype)], axis=0)
    xb = h_pad[slot_tok].reshape(n_blocks, MOE_BLOCK, D)

    def expert_block(args):
        xi, e = args
        return (jax.nn.silu(xi @ w1[e]) * (xi @ w3[e])) @ w2[e]

    yb = lax.map(expert_block, (xb, block_expert)).reshape(-1, D)
    y_assign = yb[slot] * w_sorted[:, None].astype(yb.dtype)
    return jax.ops.segment_sum(y_assign, tok_sorted, num_segments=T)


def setup_inputs(seed: int = 0) -> dict:
    key = jax.random.key(seed)
    ks = iter(jax.random.split(key, 48))
    f32 = jnp.float32

    def nrm(shape, fan_in, gain=1.0):
        return gain * fan_in ** -0.5 * jax.random.normal(next(ks), shape, f32)

    def gain_vec(shape):
        return 1.0 + 0.05 * jax.random.normal(next(ks), shape, f32)

    def bias(shape):
        return 0.01 * jax.random.normal(next(ks), shape, f32)

    ret_base = jnp.log(2.0 ** (5.0 + jnp.arange(RET_HEADS, dtype=f32)) - 1.0)
    lru_u = jax.random.uniform(next(ks), (DEPTH, 2, LRU_WIDTH), f32, 0.9, 0.999)
    lru_a0 = lru_u ** (1.0 / LRU_C)
    return {
        "x": jax.random.normal(next(ks), (BATCH, SEQ, D_MODEL), f32),
        "c": jax.random.normal(next(ks), (BATCH, D_MODEL), f32),
        "ctx": jax.random.normal(next(ks), (BATCH, CTX_LEN, D_MODEL), f32),
        "c_ctx": jax.random.normal(next(ks), (D_MODEL,), f32),
        "ada_w": nrm((DEPTH, D_MODEL, 6 * D_MODEL), D_MODEL, 0.5),
        "ada_b": bias((DEPTH, 6 * D_MODEL)),
        "norm1_g": gain_vec((DEPTH, D_MODEL)),
        "norm2_g": gain_vec((DEPTH, D_MODEL)),
        "w_in": nrm((DEPTH, D_MODEL, D_IN), D_MODEL),
        "mla_q_norm": gain_vec((DEPTH, MLA_Q_LORA)),
        "mla_kv_norm": gain_vec((DEPTH, MLA_KV_LORA)),
        "mla_w_uq": nrm((DEPTH, MLA_Q_LORA, MLA_HEADS * (MLA_NOPE + MLA_ROPE)), MLA_Q_LORA),
        "mla_w_ukv": nrm((DEPTH, MLA_KV_LORA, MLA_HEADS * (MLA_NOPE + MLA_V)), MLA_KV_LORA),
        "ret_decay": ret_base + 0.1 * jax.random.normal(next(ks), (DEPTH, 2, RET_HEADS), f32),
        "ret_norm": gain_vec((DEPTH, RET_HEADS * RET_DV)),
        "lru_conv_w": nrm((DEPTH, CONV_W, LRU_WIDTH), CONV_W),
        "lru_conv_b": bias((DEPTH, LRU_WIDTH)),
        "lru_w_a": nrm((DEPTH, 2, LRU_BLOCKS, LRU_BLOCK_W, LRU_BLOCK_W), LRU_BLOCK_W),
        "lru_b_a": bias((DEPTH, 2, LRU_WIDTH)),
        "lru_w_x": nrm((DEPTH, 2, LRU_BLOCKS, LRU_BLOCK_W, LRU_BLOCK_W), LRU_BLOCK_W),
        "lru_b_x": bias((DEPTH, 2, LRU_WIDTH)),
        "lru_lambda": jnp.log(lru_a0) - jnp.log1p(-lru_a0),
        "gqa_q_norm": gain_vec((DEPTH, GQA_HEAD_DIM)),
        "gqa_k_norm": gain_vec((DEPTH, GQA_HEAD_DIM)),
        "w_branch": nrm((DEPTH, N_BRANCH, BRANCH_W, D_MODEL), BRANCH_W),
        "w_merge": nrm((DEPTH, D_MODEL, N_BRANCH * D_MODEL), D_MODEL),
        "b_merge": bias((DEPTH, N_BRANCH * D_MODEL)),
        "w_out": nrm((DEPTH, D_MODEL, D_MODEL), D_MODEL),
        "router_w": nrm((D_MODEL, N_EXPERTS), D_MODEL),
        "router_bias": bias((N_EXPERTS,)),
        "moe_w1": nrm((DEPTH, N_EXPERTS, D_MODEL, EXPERT_FF), D_MODEL),
        "moe_w3": nrm((DEPTH, N_EXPERTS, D_MODEL, EXPERT_FF), D_MODEL),
        "moe_w2": nrm((DEPTH, N_EXPERTS, EXPERT_FF, D_MODEL), EXPERT_FF),
        "final_norm": gain_vec((D_MODEL,)),
    }


def reference(x, c, ctx, c_ctx, ada_w, ada_b, norm1_g, norm2_g, w_in,
              mla_q_norm, mla_kv_norm, mla_w_uq, mla_w_ukv, ret_decay, ret_norm,
              lru_conv_w, lru_conv_b, lru_w_a, lru_b_a, lru_w_x, lru_b_x, lru_lambda,
              gqa_q_norm, gqa_k_norm, w_branch, w_merge, b_merge, w_out,
              router_w, router_bias, moe_w1, moe_w3, moe_w2, final_norm):
    B, L, D = x.shape
    n_rows = L // GRID_W
    rows = jnp.repeat(jnp.arange(n_rows, dtype=jnp.int32), GRID_W)
    cols = jnp.tile(jnp.arange(GRID_W, dtype=jnp.int32), n_rows)
    ang_mla = axial_angles(rows, cols, MLA_ROPE)
    ang_head = axial_angles(rows, cols, GQA_HEAD_DIM)

    x_lat, x_ctx = x, ctx
    for l in range(DEPTH):
        last = l == DEPTH - 1
        m_lat = jnp.split((jax.nn.silu(c) @ ada_w[l] + ada_b[l])[:, None, :], 6, axis=-1)
        m_ctx = jnp.split((jax.nn.silu(c_ctx) @ ada_w[l] + ada_b[l])[None, None, :], 6, axis=-1)
        h_lat = modulate(rms_norm(x_lat, norm1_g[l]), m_lat[0], m_lat[1])
        h_ctx = modulate(rms_norm(x_ctx, norm1_g[l]), m_ctx[0], m_ctx[1])
        y_lat, y_ctx = token_mixers(h_lat, h_ctx, ang_mla, ang_head, not last, w_in[l],
                                    mla_q_norm[l], mla_kv_norm[l], mla_w_uq[l], mla_w_ukv[l],
                                    ret_decay[l], ret_norm[l],
                                    lru_conv_w[l], lru_conv_b[l], lru_w_a[l], lru_b_a[l],
                                    lru_w_x[l], lru_b_x[l], lru_lambda[l],
                                    gqa_q_norm[l], gqa_k_norm[l],
                                    w_branch[l], w_merge[l], b_merge[l], w_out[l])
        x_lat = x_lat + m_lat[2] * y_lat
        h2_lat = modulate(rms_norm(x_lat, norm2_g[l]), m_lat[3], m_lat[4])
        if last:
            f_lat = moe_ffn(h2_lat.reshape(-1, D), router_w, router_bias,
                            moe_w1[l], moe_w3[l], moe_w2[l]).reshape(B, L, D)
        else:
            x_ctx = x_ctx + m_ctx[2] * y_ctx
            h2_ctx = modulate(rms_norm(x_ctx, norm2_g[l]), m_ctx[3], m_ctx[4])
            f_all = moe_ffn(jnp.concatenate([h2_lat.reshape(-1, D), h2_ctx.reshape(-1, D)], axis=0),
                            router_w, router_bias, moe_w1[l], moe_w3[l], moe_w2[l])
            f_lat = f_all[:B * L].reshape(B, L, D)
            x_ctx = x_ctx + m_ctx[5] * f_all[B * L:].reshape(x_ctx.shape)
        x_lat = x_lat + m_lat[5] * f_lat
    return rms_norm(x_lat, final_norm)
```

```cpp
#include <hip/hip_runtime.h>
#include <hip/hip_cooperative_groups.h>
#include <stdint.h>
#include <stdio.h>
namespace cg = cooperative_groups;

#define DEVI __device__ __forceinline__
typedef unsigned short bf16_t;
typedef __attribute__((ext_vector_type(8))) short bf16x8;
typedef __attribute__((ext_vector_type(4))) float f32x4;

#ifndef NAIVE_GEMM
#define NAIVE_GEMM 0
#endif
#ifndef ONE_LAUNCH
#define ONE_LAUNCH 1
#endif

constexpr int DM = 1024, NBT = 8, SEQL = 2048, CTXL = 256, TPB = 2304, TT = 18432;
constexpr int DINP = 3840;
constexpr float LOG2E = 1.4426950408889634f;
constexpr float EPSV = 1e-6f;
constexpr int NSLOT = 2 * TT + 64 * 128;

enum { I_X = 0, I_C, I_CTX, I_CCTX, I_ADAW, I_ADAB, I_N1G, I_N2G, I_WIN, I_MQN, I_MKVN, I_WUQ, I_WUKV, I_RDEC, I_RNORM,
       I_LCW, I_LCB, I_LWA, I_LBA, I_LWX, I_LBX, I_LLAM, I_GQN, I_GKN, I_WBR, I_WMG, I_BMG, I_WOUT, I_RW, I_RB,
       I_W1, I_W3, I_W2, I_FN, N_IN };

constexpr size_t AL(size_t x) { return (x + 255) & ~(size_t)255; }
constexpr size_t OFF_BAR = 0;
constexpr size_t OFF_CNT = 16384;
constexpr size_t OFF_MOD = OFF_CNT + 4096;
constexpr size_t OFF_R64 = AL(OFF_MOD + (size_t)2 * 9 * 6144 * 4);
constexpr size_t OFF_R32 = OFF_R64 + (size_t)2048 * 64 * 4;
constexpr size_t OFF_REC = OFF_R32 + (size_t)2048 * 32 * 4;
constexpr size_t OFF_LIST = OFF_REC + (size_t)TT * 32;
constexpr size_t OFF_W = AL(OFF_LIST + (size_t)64 * TT * 4);
constexpr size_t W_IN = 0;
constexpr size_t W_UQ = W_IN + (size_t)2 * 3840 * 1024;
constexpr size_t W_UKV = W_UQ + (size_t)2 * 768 * 256;
constexpr size_t W_BR = W_UKV + (size_t)2 * 1024 * 128;
constexpr size_t W_MG = W_BR + (size_t)2 * 4 * 1024 * 512;
constexpr size_t W_OUT = W_MG + (size_t)2 * 4096 * 1024;
constexpr size_t W_LRU = W_OUT + (size_t)2 * 1024 * 1024;
constexpr size_t W_END = W_LRU + (size_t)2 * 2 * 8 * 2 * 64 * 64;
constexpr size_t OFF_XCUR = AL(OFF_W + W_END * 2);
constexpr size_t OFF_H = OFF_XCUR + (size_t)TT * 1024 * 4;
constexpr size_t OFF_C = OFF_H + (size_t)TT * 1024 * 2;
constexpr size_t C_CQ = 0;
constexpr size_t C_CKV = C_CQ + (size_t)TT * 256;
constexpr size_t C_KR = C_CKV + (size_t)TT * 128;
constexpr size_t C_MQ = C_KR + (size_t)TT * 32;
constexpr size_t C_KN = C_MQ + (size_t)TT * 768;
constexpr size_t C_VMT = C_KN + (size_t)TT * 512;
constexpr size_t C_RQ = C_VMT + (size_t)TT * 512;
constexpr size_t C_RK = C_RQ + (size_t)TT * 256;
constexpr size_t C_RKT = C_RK + (size_t)TT * 256;
constexpr size_t C_RVT = C_RKT + (size_t)TT * 256;
constexpr size_t C_RG = C_RVT + (size_t)TT * 512;
constexpr size_t C_LX = C_RG + (size_t)TT * 512;
constexpr size_t C_LG = C_LX + (size_t)TT * 512;
constexpr size_t C_GQ = C_LG + (size_t)TT * 512;
constexpr size_t C_GK = C_GQ + (size_t)TT * 512;
constexpr size_t C_GVT = C_GK + (size_t)TT * 128;
constexpr size_t C_END = C_GVT + (size_t)TT * 128;
constexpr size_t C_M = 0;
constexpr size_t C_W13 = (size_t)24 * 1024 * 1024;
constexpr size_t C_W2 = C_W13 + (size_t)64 * 512 * 1024;
static_assert(C_W2 + (size_t)64 * 1024 * 256 <= C_END, "moe alias");
static_assert((size_t)TT * 1024 <= C_W13, "m alias");
constexpr size_t OFF_D = OFF_C + C_END * 2;
constexpr size_t D_YA = 0;
constexpr size_t D_YD = (size_t)TT * 512;
constexpr size_t D_OF = (size_t)2 * TT * 512;
constexpr size_t D_OB = (size_t)3 * TT * 512;
constexpr size_t D_LH0 = (size_t)4 * TT * 512;
constexpr size_t D_LH1 = (size_t)5 * TT * 512;
constexpr size_t D_ACT = 0;
constexpr size_t D_YS = (size_t)12 * 1024 * 1024;
constexpr size_t D_END = D_YS + (size_t)NSLOT * 1024;
static_assert((size_t)NSLOT * 256 <= D_YS, "act alias");
static_assert((size_t)6 * TT * 512 <= D_END, "d size");
constexpr size_t WS_NEED = OFF_D + D_END * 2;

struct Params {
    const float* in[N_IN];
    float* out;
    unsigned char* ws;
};

#define WSF(off) ((float*)(p.ws + (off)))
#define WSI(off) ((int*)(p.ws + (off)))
#define WB(el) ((bf16_t*)(p.ws + OFF_W) + (el))
#define CB(el) ((bf16_t*)(p.ws + OFF_C) + (el))
#define DB(el) ((bf16_t*)(p.ws + OFF_D) + (el))
#define HB ((bf16_t*)(p.ws + OFF_H))
#define XCUR ((float*)(p.ws + OFF_XCUR))

constexpr int SMEM_BYTES = 49152;
constexpr int CT_LD = 136;
constexpr int AUX_OFF = 36864;

DEVI int launder_tid() { int t = __builtin_amdgcn_workitem_id_x(); asm volatile("" : "+v"(t)); return t; }
DEVI int launder_bid() { int t = __builtin_amdgcn_workgroup_id_x(); asm volatile("" : "+s"(t)); return t; }
#define TIDX launder_tid()
#define BIDX launder_bid()
DEVI float bf2f(bf16_t v) { return __uint_as_float(((unsigned)v) << 16); }
DEVI bf16_t f2bf(float f) {
    unsigned u = __float_as_uint(f);
    u += 0x7fffu + ((u >> 16) & 1u);
    return (bf16_t)(u >> 16);
}
DEVI float sigmoidf_(float x) { return 1.f / (1.f + __expf(-x)); }
DEVI float siluf_(float x) { return x / (1.f + __expf(-x)); }
DEVI float gelu_tanh(float x) {
    float u = 0.7978845608028654f * (x + 0.044715f * x * x * x);
    return 0.5f * x * (1.f + tanhf(u));
}
DEVI float wave_sum(float v) {
#pragma unroll
    for (int o = 32; o > 0; o >>= 1) v += __shfl_xor(v, o);
    return v;
}
DEVI int mt_of(int q, bool latonly) { return latonly ? (q >> 4) * 18 + 2 + (q & 15) : q; }

struct CvtJob { const float* src; bf16_t* dst; const float* ks; int K, N, ldd, batch; size_t sbs, dbs; int mode; };
DEVI int cvt_rowmap(int mode, int n) {
    if (mode == 1) return n < 384 ? n : (n < 416 ? n - 384 + 3712 : n - 32);
    if (mode == 2) { int h = n / 96, j = n % 96; return j < 64 ? h * 64 + j : 512 + h * 32 + (j - 64); }
    if (mode == 3) return (n >> 6) * 128 + (n & 63);
    return n;
}
DEVI void cvt_tile(const CvtJob& j, int tile, float* lds) {
    const int tn = j.N / 32, tk = j.K / 64, per = tn * tk;
    const int bb = tile / per, r = tile % per, kt = r / tn, nt = r % tn;
    const float* s = j.src + (size_t)bb * j.sbs + (size_t)(kt * 64) * j.N + nt * 32;
    const int tx = TIDX & 31, ty = TIDX >> 5;
#pragma unroll
    for (int i = 0; i < 8; ++i) {
        int k = ty + 8 * i;
        float v = s[(size_t)k * j.N + tx];
        if (j.ks) v *= j.ks[kt * 64 + k];
        lds[k * 33 + tx] = v;
    }
    __syncthreads();
    bf16_t* d = j.dst + (size_t)bb * j.dbs;
#pragma unroll
    for (int i = 0; i < 4; ++i) {
        int n = ty + 8 * i, kk = tx * 2;
        unsigned lo = f2bf(lds[kk * 33 + n]), hi = f2bf(lds[(kk + 1) * 33 + n]);
        int row = cvt_rowmap(j.mode, nt * 32 + n);
        *(unsigned*)(d + (size_t)row * j.ldd + kt * 64 + kk) = lo | (hi << 16);
    }
    __syncthreads();
}
__constant__ const int CVT_TILES[8] = {1872, 96, 64, 1024, 2048, 512, 32, 32};
constexpr int CVT_PER_LAYER = 1872 + 96 + 64 + 1024 + 2048 + 512 + 32 + 32;
DEVI CvtJob get_job(const Params& p, int l, int k) {
    CvtJob j; j.ks = nullptr; j.batch = 1; j.sbs = 0; j.dbs = 0; j.mode = 0;
    switch (k) {
    case 0: j.src = p.in[I_WIN] + (size_t)l * 1024 * 3744; j.dst = WB(W_IN + (size_t)l * 3840 * 1024); j.K = 1024; j.N = 3744; j.ldd = 1024; j.mode = 1; break;
    case 1: j.src = p.in[I_WUQ] + (size_t)l * 256 * 768; j.dst = WB(W_UQ + (size_t)l * 768 * 256); j.K = 256; j.N = 768; j.ldd = 256; j.ks = p.in[I_MQN] + l * 256; j.mode = 2; break;
    case 2: j.src = p.in[I_WUKV] + (size_t)l * 128 * 1024; j.dst = WB(W_UKV + (size_t)l * 1024 * 128); j.K = 128; j.N = 1024; j.ldd = 128; j.ks = p.in[I_MKVN] + l * 128; break;
    case 3: j.src = p.in[I_WBR] + (size_t)l * 4 * 512 * 1024; j.dst = WB(W_BR + (size_t)l * 4 * 1024 * 512); j.K = 512; j.N = 1024; j.ldd = 512; j.batch = 4; j.sbs = 512 * 1024; j.dbs = 1024 * 512; break;
    case 4: j.src = p.in[I_WMG] + (size_t)l * 1024 * 4096; j.dst = WB(W_MG + (size_t)l * 4096 * 1024); j.K = 1024; j.N = 4096; j.ldd = 1024; break;
    case 5: j.src = p.in[I_WOUT] + (size_t)l * 1024 * 1024; j.dst = WB(W_OUT + (size_t)l * 1024 * 1024); j.K = 1024; j.N = 1024; j.ldd = 1024; break;
    case 6: j.src = p.in[I_LWA] + (size_t)l * 16 * 4096; j.dst = WB(W_LRU + (size_t)l * 16 * 8192); j.K = 64; j.N = 64; j.ldd = 64; j.batch = 16; j.sbs = 4096; j.dbs = 8192; break;
    default: j.src = p.in[I_LWX] + (size_t)l * 16 * 4096; j.dst = WB(W_LRU + (size_t)l * 16 * 8192 + 4096); j.K = 64; j.N = 64; j.ldd = 64; j.batch = 16; j.sbs = 4096; j.dbs = 8192; break;
    }
    return j;
}
DEVI CvtJob get_moe_job(const Params& p, int l, int k) {
    CvtJob j; j.ks = nullptr; j.batch = 64; j.sbs = 262144;
    if (k == 0) { j.src = p.in[I_W1] + (size_t)l * 64 * 262144; j.dst = CB(C_W13); j.K = 1024; j.N = 256; j.ldd = 1024; j.dbs = 512 * 1024; j.mode = 3; }
    else if (k == 1) { j.src = p.in[I_W3] + (size_t)l * 64 * 262144; j.dst = CB(C_W13 + 64 * 1024); j.K = 1024; j.N = 256; j.ldd = 1024; j.dbs = 512 * 1024; j.mode = 3; }
    else { j.src = p.in[I_W2] + (size_t)l * 64 * 262144; j.dst = CB(C_W2); j.K = 256; j.N = 1024; j.ldd = 256; j.dbs = 262144; j.mode = 0; }
    return j;
}

struct AOp { const bf16_t* base; int ld; int row0; const int* ridx; };
DEVI const bf16_t* arow(const AOp& a, int i) {
    int r = a.ridx ? a.ridx[i] : a.row0 + i;
    return a.base + (size_t)r * a.ld;
}

#if NAIVE_GEMM
template <int BN>
DEVI void gemm_core(f32x4 (&acc)[4][BN / 32], const AOp& A, const bf16_t* B, int ldb, int K, unsigned char* smem) {
    constexpr int NI = BN / 32;
    const int tid = TIDX, lane = tid & 63, wid = tid >> 6, wr = wid >> 1, wc = wid & 1;
    for (int k0 = 0; k0 < K; k0 += 8) {
        bf16x8 bv[NI];
#pragma unroll
        for (int ni = 0; ni < NI; ++ni) bv[ni] = *(const bf16x8*)(B + (size_t)(wc * (BN / 2) + ni * 16 + (lane & 15)) * ldb + k0);
#pragma unroll
        for (int mi = 0; mi < 4; ++mi)
#pragma unroll
            for (int j = 0; j < 4; ++j) {
                bf16x8 av = *(const bf16x8*)(arow(A, wr * 64 + mi * 16 + (lane >> 4) * 4 + j) + k0);
#pragma unroll
                for (int ni = 0; ni < NI; ++ni) {
                    float s = 0.f;
#pragma unroll
                    for (int e = 0; e < 8; ++e) s += bf2f((bf16_t)av[e]) * bf2f((bf16_t)bv[ni][e]);
                    acc[mi][ni][j] += s;
                }
            }
    }
}
#else
template <int BN>
DEVI void gemm_core(f32x4 (&acc)[4][BN / 32], const AOp& A, const bf16_t* B, int ldb, int K, unsigned char* smem) {
    constexpr int NI = BN / 32;
    constexpr int NBL = BN / 32;
    const int tid = TIDX, lane = tid & 63, wid = tid >> 6, wr = wid >> 1, wc = wid & 1;
    unsigned char* sA = smem;
    unsigned char* sB = smem + 16384;
    const int lr = tid >> 3, lc = tid & 7;
    const bf16_t* ap[4];
    const bf16_t* bp[NBL];
#pragma unroll
    for (int i = 0; i < 4; ++i) ap[i] = arow(A, lr + 32 * i) + lc * 8;
#pragma unroll
    for (int i = 0; i < NBL; ++i) bp[i] = B + (size_t)(lr + 32 * i) * ldb + lc * 8;
    const int wofs = lr * 128 + ((lc ^ (lr & 7)) << 4);
    bf16x8 ra[4], rb[NBL];
#pragma unroll
    for (int i = 0; i < 4; ++i) ra[i] = *(const bf16x8*)(ap[i]);
#pragma unroll
    for (int i = 0; i < NBL; ++i) rb[i] = *(const bf16x8*)(bp[i]);
    const int nk = K >> 6;
    const int arow_off = (wr * 64 + (lane & 15)) * 128;
    const int brow_off = (wc * (BN / 2) + (lane & 15)) * 128;
    for (int kt = 0; kt < nk; ++kt) {
        __syncthreads();
#pragma unroll
        for (int i = 0; i < 4; ++i) *(bf16x8*)(sA + wofs + i * 4096) = ra[i];
#pragma unroll
        for (int i = 0; i < NBL; ++i) *(bf16x8*)(sB + wofs + i * 4096) = rb[i];
        __syncthreads();
        if (kt + 1 < nk) {
            const int ko = (kt + 1) * 64;
#pragma unroll
            for (int i = 0; i < 4; ++i) ra[i] = *(const bf16x8*)(ap[i] + ko);
#pragma unroll
            for (int i = 0; i < NBL; ++i) rb[i] = *(const bf16x8*)(bp[i] + ko);
        }
#pragma unroll
        for (int ks = 0; ks < 2; ++ks) {
            const int pch = ((ks * 4 + (lane >> 4)) ^ (lane & 7)) << 4;
            bf16x8 af[4], bfr[NI];
#pragma unroll
            for (int mi = 0; mi < 4; ++mi) af[mi] = *(const bf16x8*)(sA + arow_off + mi * 2048 + pch);
#pragma unroll
            for (int ni = 0; ni < NI; ++ni) bfr[ni] = *(const bf16x8*)(sB + brow_off + ni * 2048 + pch);
#pragma unroll
            for (int mi = 0; mi < 4; ++mi)
#pragma unroll
                for (int ni = 0; ni < NI; ++ni)
                    acc[mi][ni] = __builtin_amdgcn_mfma_f32_16x16x32_bf16(af[mi], bfr[ni], acc[mi][ni], 0, 0, 0);
        }
    }
}
#endif

template <int BN>
DEVI void acc_zero(f32x4 (&acc)[4][BN / 32]) {
#pragma unroll
    for (int mi = 0; mi < 4; ++mi)
#pragma unroll
        for (int ni = 0; ni < BN / 32; ++ni) acc[mi][ni] = f32x4{0.f, 0.f, 0.f, 0.f};
}
template <int BN>
DEVI void acc_to_ct(const f32x4 (&acc)[4][BN / 32], bf16_t* ct) {
    const int tid = TIDX, lane = tid & 63, wid = tid >> 6, wr = wid >> 1, wc = wid & 1;
#pragma unroll
    for (int mi = 0; mi < 4; ++mi)
#pragma unroll
        for (int ni = 0; ni < BN / 32; ++ni)
#pragma unroll
            for (int j = 0; j < 4; ++j)
                ct[(wr * 64 + mi * 16 + (lane >> 4) * 4 + j) * CT_LD + wc * (BN / 2) + ni * 16 + (lane & 15)] = f2bf(acc[mi][ni][j]);
}

template <int NC>
DEVI void ep_store_rows(const bf16_t* ct, int c0, bf16_t* dst, int ldd, int row0) {
    constexpr int CPR = NC / 8;
    for (int c = TIDX; c < 128 * CPR; c += 256) {
        int i = c / CPR, jc = c % CPR;
        *(bf16x8*)(dst + (size_t)(row0 + i) * ldd + jc * 8) = *(const bf16x8*)(ct + i * CT_LD + c0 + jc * 8);
    }
}
DEVI void ep_store_T(const bf16_t* ct, int c0, int nc, bf16_t* dstT, int ldT, int t0) {
    for (int c = TIDX; c < nc * 16; c += 256) {
        int j = c >> 4, ic = c & 15;
        bf16x8 v;
#pragma unroll
        for (int e = 0; e < 8; ++e) v[e] = (short)ct[(ic * 8 + e) * CT_LD + c0 + j];
        *(bf16x8*)(dstT + (size_t)j * ldT + t0 + ic * 8) = v;
    }
}
DEVI void ep_rope64(bf16_t* ct, const float* gain, float scale, bool lat, int pos0, const float* cs64) {
    const int row = TIDX >> 1, half = TIDX & 1;
    bf16_t* pr = ct + row * CT_LD + half * 64;
    float v[64];
#pragma unroll
    for (int c = 0; c < 8; ++c) {
        bf16x8 t = *(const bf16x8*)(pr + c * 8);
#pragma unroll
        for (int e = 0; e < 8; ++e) v[c * 8 + e] = bf2f((bf16_t)t[e]);
    }
    if (gain) {
        float ss = 0.f;
#pragma unroll
        for (int d = 0; d < 64; ++d) ss += v[d] * v[d];
        float rstd = rsqrtf(ss * (1.f / 64.f) + EPSV);
#pragma unroll
        for (int d = 0; d < 64; ++d) v[d] = v[d] * rstd * gain[d];
    }
    if (lat) {
        const float* cs = cs64 + (size_t)(pos0 + row) * 64;
#pragma unroll
        for (int i = 0; i < 16; ++i) {
            float a = v[i], b = v[i + 16], c = cs[i], s = cs[32 + i];
            v[i] = a * c - b * s; v[i + 16] = b * c + a * s;
            a = v[32 + i]; b = v[48 + i]; c = cs[16 + i]; s = cs[48 + i];
            v[32 + i] = a * c - b * s; v[48 + i] = b * c + a * s;
        }
    }
#pragma unroll
    for (int c = 0; c < 8; ++c) {
        bf16x8 t;
#pragma unroll
        for (int e = 0; e < 8; ++e) t[e] = (short)f2bf(v[c * 8 + e] * scale);
        *(bf16x8*)(pr + c * 8) = t;
    }
}
DEVI void ep_rope32(bf16_t* ct, int ngroups, const float* rstd, float scale, bool lat, int pos0, const float* cs32) {
    const int row = TIDX >> 1, half = TIDX & 1;
    const float rs = (rstd ? rstd[row] : 1.f) * scale;
#pragma unroll
    for (int gg = 0; gg < 2; ++gg) {
        const int g = half * 2 + gg;
        if (g < ngroups) {
            bf16_t* pr = ct + row * CT_LD + g * 32;
            float v[32];
#pragma unroll
            for (int c = 0; c < 4; ++c) {
                bf16x8 t = *(const bf16x8*)(pr + c * 8);
#pragma unroll
                for (int e = 0; e < 8; ++e) v[c * 8 + e] = bf2f((bf16_t)t[e]);
            }
            if (lat) {
                const float* cs = cs32 + (size_t)(pos0 + row) * 32;
#pragma unroll
                for (int i = 0; i < 8; ++i) {
                    float a = v[i], b = v[i + 8], c = cs[i], s = cs[16 + i];
                    v[i] = a * c - b * s; v[i + 8] = b * c + a * s;
                    a = v[16 + i]; b = v[24 + i]; c = cs[8 + i]; s = cs[24 + i];
                    v[16 + i] = a * c - b * s; v[24 + i] = b * c + a * s;
                }
            }
#pragma unroll
            for (int c = 0; c < 4; ++c) {
                bf16x8 t;
#pragma unroll
                for (int e = 0; e < 8; ++e) t[e] = (short)f2bf(v[c * 8 + e] * rs);
                *(bf16x8*)(pr + c * 8) = t;
            }
        }
    }
}
DEVI void ep_scale_rows(bf16_t* ct, int c0, int nc, const float* rstd, float scale) {
    const int cpr = nc / 8;
    for (int c = TIDX; c < 128 * cpr; c += 256) {
        int i = c / cpr, jc = c % cpr;
        bf16_t* pr = ct + i * CT_LD + c0 + jc * 8;
        bf16x8 t = *(const bf16x8*)pr;
        float rs = rstd[i] * scale;
#pragma unroll
        for (int e = 0; e < 8; ++e) t[e] = (short)f2bf(bf2f((bf16_t)t[e]) * rs);
        *(bf16x8*)pr = t;
    }
}
DEVI void ep_rstd(const bf16_t* A, int ld, int row0, int K, float* rstd) {
    const int row = TIDX >> 1, half = TIDX & 1;
    const bf16_t* pr = A + (size_t)(row0 + row) * ld + half * (K / 2);
    float ss = 0.f;
    for (int c = 0; c < K / 16; ++c) {
        bf16x8 t = *(const bf16x8*)(pr + c * 8);
#pragma unroll
        for (int e = 0; e < 8; ++e) { float f = bf2f((bf16_t)t[e]); ss += f * f; }
    }
    ss += __shfl_xor(ss, 1);
    if (half == 0) rstd[row] = rsqrtf(ss / (float)K + EPSV);
}

DEVI void phase0(const Params& p, unsigned char* smem) {
    const int tid = TIDX, lane = tid & 63, w = tid >> 6;
    const int NG = 192, NCV = 2 * CVT_PER_LAYER, NR = 8;
    const int ntask = NG + NCV + NR + 1;
    for (int task = BIDX; task < ntask; task += gridDim.x) {
        if (task < NG) {
            const int l = task / 96, n0 = (task % 96) * 64;
            float* sv = (float*)smem;
            float* red = (float*)(smem + 36864);
            for (int idx = lane; idx < 9 * 256; idx += 64) {
                int bi = idx >> 8, kk = idx & 255, k = 256 * w + kk;
                float c = bi < 8 ? p.in[I_C][bi * 1024 + k] : p.in[I_CCTX][k];
                sv[(w * 9 + bi) * 256 + kk] = siluf_(c);
            }
            __syncthreads();
            float acc[9];
#pragma unroll
            for (int bi = 0; bi < 9; ++bi) acc[bi] = 0.f;
            const float* wp = p.in[I_ADAW] + (size_t)l * 1024 * 6144 + (size_t)(256 * w) * 6144 + n0 + lane;
#pragma unroll 8
            for (int kk = 0; kk < 256; ++kk) {
                float wv = wp[(size_t)kk * 6144];
#pragma unroll
                for (int bi = 0; bi < 9; ++bi) acc[bi] += sv[(w * 9 + bi) * 256 + kk] * wv;
            }
#pragma unroll
            for (int bi = 0; bi < 9; ++bi) red[(w * 9 + bi) * 64 + lane] = acc[bi];
            __syncthreads();
            for (int idx = tid; idx < 9 * 64; idx += 256) {
                int bi = idx >> 6, c = idx & 63;
                float s = p.in[I_ADAB][l * 6144 + n0 + c];
#pragma unroll
                for (int ww = 0; ww < 4; ++ww) s += red[(ww * 9 + bi) * 64 + c];
                WSF(OFF_MOD)[(size_t)(l * 9 + bi) * 6144 + n0 + c] = s;
            }
            __syncthreads();
        } else if (task < NG + NCV) {
            int t = task - NG;
            int l = t / CVT_PER_LAYER; t %= CVT_PER_LAYER;
            int k = 0;
            while (t >= CVT_TILES[k]) { t -= CVT_TILES[k]; ++k; }
            CvtJob j = get_job(p, l, k);
            cvt_tile(j, t, (float*)smem);
        } else if (task < NG + NCV + NR) {
            int pos = (task - NG - NCV) * 256 + tid;
            float rp = (float)(pos >> 6), cp = (float)(pos & 63);
            float* t64 = WSF(OFF_R64) + (size_t)pos * 64;
            float* t32 = WSF(OFF_R32) + (size_t)pos * 32;
            for (int i = 0; i < 16; ++i) {
                float inv = powf(10000.f, -(float)(2 * i) / 32.f);
                float ar = rp * inv, ac = cp * inv;
                t64[i] = cosf(ar); t64[16 + i] = cosf(ac); t64[32 + i] = sinf(ar); t64[48 + i] = sinf(ac);
            }
            for (int i = 0; i < 8; ++i) {
                float inv = powf(10000.f, -(float)(2 * i) / 16.f);
                float ar = rp * inv, ac = cp * inv;
                t32[i] = cosf(ar); t32[8 + i] = cosf(ac); t32[16 + i] = sinf(ar); t32[24 + i] = sinf(ac);
            }
        } else {
            if (tid < 128) WSI(OFF_CNT)[tid] = 0;
            for (int l = 0; l < 2; ++l) {
                unsigned* z = (unsigned*)WB(W_IN + (size_t)l * 3840 * 1024 + (size_t)3744 * 1024);
                for (int i = tid; i < 96 * 1024 / 2; i += 256) z[i] = 0u;
            }
        }
    }
}

struct MoeTab { int* cnt; int* tp; int* seg; };
DEVI MoeTab moe_tables(const Params& p, int l, unsigned char* smem) {
    int* aux = (int*)(smem + AUX_OFF);
    MoeTab t; t.cnt = aux + 256; t.tp = aux + 320; t.seg = aux + 400;
    __syncthreads();
    if (TIDX < 64) t.cnt[TIDX] = WSI(OFF_CNT)[l * 64 + TIDX];
    __syncthreads();
    if (TIDX == 0) {
        int a = 0, s = 0;
        for (int e = 0; e < 64; ++e) {
            t.tp[e] = a; t.seg[e] = s;
            int nt = (t.cnt[e] + 127) >> 7;
            a += nt; s += nt * 128;
        }
        t.tp[64] = a; t.seg[64] = s;
    }
    __syncthreads();
    return t;
}
struct Rec { int e0, p0, e1, p1; float w0, w1; int pad0, pad1; };

DEVI void phase_norm1(const Params& p, int l, int mode, unsigned char* smem) {
    const int lane = TIDX & 63, w = TIDX >> 6;
    MoeTab mt;
    const bool comb = (l > 0) || mode == 1;
    const int lp = mode == 1 ? 1 : l - 1;
    if (comb) mt = moe_tables(p, lp, smem);
    const float* g1 = mode == 1 ? p.in[I_FN] : p.in[I_N1G] + l * 1024;
    for (int row = BIDX * 4 + w; row < TT; row += gridDim.x * 4) {
        const int b = row / TPB, t = row % TPB;
        const bool isctx = t < CTXL;
        if (mode == 1 && isctx) continue;
        const int bi = isctx ? 8 : b;
        float v[16];
        if (!comb) {
            const float* src = isctx ? p.in[I_CTX] + ((size_t)b * CTXL + t) * DM : p.in[I_X] + ((size_t)b * SEQL + (t - CTXL)) * DM;
#pragma unroll
            for (int i = 0; i < 4; ++i) {
                float4 x4 = *(const float4*)(src + i * 256 + lane * 4);
                v[i * 4] = x4.x; v[i * 4 + 1] = x4.y; v[i * 4 + 2] = x4.z; v[i * 4 + 3] = x4.w;
            }
        } else {
            float* xr = XCUR + (size_t)row * DM;
            const Rec rc = ((const Rec*)(p.ws + OFF_REC))[row];
            const bf16_t* y0 = DB(D_YS) + (size_t)(mt.seg[rc.e0] + rc.p0) * 1024;
            const bf16_t* y1 = DB(D_YS) + (size_t)(mt.seg[rc.e1] + rc.p1) * 1024;
            const float* gate = WSF(OFF_MOD) + (size_t)(lp * 9 + bi) * 6144 + 5 * 1024;
#pragma unroll
            for (int i = 0; i < 4; ++i) {
                const int c = i * 256 + lane * 4;
                float4 x4 = *(const float4*)(xr + c);
                float4 g4 = *(const float4*)(gate + c);
                uint2 a = *(const uint2*)(y0 + c), bb = *(const uint2*)(y1 + c);
                float f0 = rc.w0 * __uint_as_float(a.x << 16) + rc.w1 * __uint_as_float(bb.x << 16);
                float f1 = rc.w0 * __uint_as_float(a.x & 0xffff0000u) + rc.w1 * __uint_as_float(bb.x & 0xffff0000u);
                float f2 = rc.w0 * __uint_as_float(a.y << 16) + rc.w1 * __uint_as_float(bb.y << 16);
                float f3 = rc.w0 * __uint_as_float(a.y & 0xffff0000u) + rc.w1 * __uint_as_float(bb.y & 0xffff0000u);
                x4.x += g4.x * f0; x4.y += g4.y * f1; x4.z += g4.z * f2; x4.w += g4.w * f3;
                if (mode == 0) *(float4*)(xr + c) = x4;
                v[i * 4] = x4.x; v[i * 4 + 1] = x4.y; v[i * 4 + 2] = x4.z; v[i * 4 + 3] = x4.w;
            }
        }
        float ss = 0.f;
#pragma unroll
        for (int i = 0; i < 16; ++i) ss += v[i] * v[i];
        ss = wave_sum(ss);
        const float rstd = rsqrtf(ss * (1.f / 1024.f) + EPSV);
        if (mode == 1) {
            float* o = p.out + ((size_t)b * SEQL + (t - CTXL)) * DM;
#pragma unroll
            for (int i = 0; i < 4; ++i) {
                const int c = i * 256 + lane * 4;
                float4 g4 = *(const float4*)(g1 + c);
                float4 r4;
                r4.x = v[i * 4] * rstd * g4.x; r4.y = v[i * 4 + 1] * rstd * g4.y; r4.z = v[i * 4 + 2] * rstd * g4.z; r4.w = v[i * 4 + 3] * rstd * g4.w;
                *(float4*)(o + c) = r4;
            }
        } else {
            const float* md = WSF(OFF_MOD) + (size_t)(l * 9 + bi) * 6144;
            bf16_t* ho = HB + (size_t)row * DM;
#pragma unroll
            for (int i = 0; i < 4; ++i) {
                const int c = i * 256 + lane * 4;
                float4 g4 = *(const float4*)(g1 + c);
                float4 sh = *(const float4*)(md + c);
                float4 sc = *(const float4*)(md + 1024 + c);
                float h0 = v[i * 4] * rstd * g4.x * (1.f + sc.x) + sh.x;
                float h1 = v[i * 4 + 1] * rstd * g4.y * (1.f + sc.y) + sh.y;
                float h2 = v[i * 4 + 2] * rstd * g4.z * (1.f + sc.z) + sh.z;
                float h3 = v[i * 4 + 3] * rstd * g4.w * (1.f + sc.w) + sh.w;
                uint2 o2;
                o2.x = (unsigned)f2bf(h0) | ((unsigned)f2bf(h1) << 16);
                o2.y = (unsigned)f2bf(h2) | ((unsigned)f2bf(h3) << 16);
                *(uint2*)(ho + c) = o2;
            }
        }
    }
}

DEVI void phase_win(const Params& p, int l, unsigned char* smem) {
    bf16_t* ct = (bf16_t*)smem;
    const float* cs64 = WSF(OFF_R64);
    const float* cs32 = WSF(OFF_R32);
    const int ntile = 144 * 30;
    for (int tile = BIDX; tile < ntile; tile += gridDim.x) {
        const int mt = tile / 30, nt = tile % 30;
        const int row0 = mt * 128, b = mt / 18, t0 = (mt % 18) * 128;
        const bool lat = (mt % 18) >= 2;
        const int pos0 = t0 - CTXL;
        f32x4 acc[4][4];
        acc_zero<128>(acc);
        AOp A{HB, 1024, row0, nullptr};
        gemm_core<128>(acc, A, WB(W_IN + (size_t)l * 3840 * 1024 + (size_t)nt * 128 * 1024), 1024, 1024, smem);
        __syncthreads();
        acc_to_ct<128>(acc, ct);
        __syncthreads();
        if (nt < 2) ep_store_rows<128>(ct, 0, CB(C_CQ) + nt * 128, 256, row0);
        else if (nt == 2) ep_store_rows<128>(ct, 0, CB(C_CKV), 128, row0);
        else if (nt < 5) { ep_rope64(ct, nullptr, 1.f, lat, pos0, cs64); __syncthreads(); ep_store_rows<128>(ct, 0, CB(C_RQ) + (nt - 3) * 128, 256, row0); }
        else if (nt < 7) {
            ep_rope64(ct, nullptr, 0.125f, lat, pos0, cs64); __syncthreads();
            ep_store_rows<128>(ct, 0, CB(C_RK) + (nt - 5) * 128, 256, row0);
            ep_store_T(ct, 0, 128, CB(C_RKT) + ((size_t)b * 256 + (nt - 5) * 128) * TPB, TPB, t0);
        }
        else if (nt < 11) ep_store_T(ct, 0, 128, CB(C_RVT) + ((size_t)b * 4 + (nt - 7)) * 128 * TPB, TPB, t0);
        else if (nt < 15) ep_store_rows<128>(ct, 0, CB(C_RG) + (nt - 11) * 128, 512, row0);
        else if (nt < 19) ep_store_rows<128>(ct, 0, CB(C_LX) + (nt - 15) * 128, 512, row0);
        else if (nt < 23) ep_store_rows<128>(ct, 0, CB(C_LG) + (nt - 19) * 128, 512, row0);
        else if (nt < 27) { ep_rope64(ct, p.in[I_GQN] + l * 64, 0.125f * LOG2E, lat, pos0, cs64); __syncthreads(); ep_store_rows<128>(ct, 0, CB(C_GQ) + (nt - 23) * 128, 512, row0); }
        else if (nt == 27) { ep_rope64(ct, p.in[I_GKN] + l * 64, 1.f, lat, pos0, cs64); __syncthreads(); ep_store_rows<128>(ct, 0, CB(C_GK), 128, row0); }
        else if (nt == 28) ep_store_T(ct, 0, 128, CB(C_GVT) + (size_t)b * 128 * TPB, TPB, t0);
        else { ep_rope32(ct, 1, nullptr, 1.f, lat, pos0, cs32); __syncthreads(); ep_store_rows<32>(ct, 0, CB(C_KR), 32, row0); }
        __syncthreads();
    }
}

DEVI void phase_mla_up(const Params& p, int l, unsigned char* smem) {
    bf16_t* ct = (bf16_t*)smem;
    float* rstd = (float*)(smem + AUX_OFF);
    const float* cs32 = WSF(OFF_R32);
    const float qscale = 0.10206207261596575f * LOG2E;
    const int nq = (l == 0 ? 144 : 128) * 6;
    const int nkv = 144 * 8;
    for (int tile = BIDX; tile < nq + nkv; tile += gridDim.x) {
        if (tile < nq) {
            const int mt = mt_of(tile / 6, l != 0), nt = tile % 6;
            const int row0 = mt * 128, t0 = (mt % 18) * 128;
            const bool lat = (mt % 18) >= 2;
            f32x4 acc[4][4];
            acc_zero<128>(acc);
            AOp A{CB(C_CQ), 256, row0, nullptr};
            gemm_core<128>(acc, A, WB(W_UQ + (size_t)l * 768 * 256 + (size_t)nt * 128 * 256), 256, 256, smem);
            __syncthreads();
            acc_to_ct<128>(acc, ct);
            ep_rstd(CB(C_CQ), 256, row0, 256, rstd);
            __syncthreads();
            if (nt < 4) {
                ep_scale_rows(ct, 0, 128, rstd, qscale); __syncthreads();
                ep_store_rows<64>(ct, 0, CB(C_MQ) + (nt * 2) * 96, 768, row0);
                ep_store_rows<64>(ct, 64, CB(C_MQ) + (nt * 2 + 1) * 96, 768, row0);
            } else {
                ep_rope32(ct, 4, rstd, qscale, lat, t0 - CTXL, cs32); __syncthreads();
#pragma unroll
                for (int g = 0; g < 4; ++g) ep_store_rows<32>(ct, g * 32, CB(C_MQ) + ((nt - 4) * 4 + g) * 96 + 64, 768, row0);
            }
            __syncthreads();
        } else {
            const int tk = tile - nq;
            const int mt = tk / 8, nt = tk % 8;
            const int row0 = mt * 128, b = mt / 18, t0 = (mt % 18) * 128;
            f32x4 acc[4][4];
            acc_zero<128>(acc);
            AOp A{CB(C_CKV), 128, row0, nullptr};
            gemm_core<128>(acc, A, WB(W_UKV + (size_t)l * 1024 * 128 + (size_t)nt * 128 * 128), 128, 128, smem);
            __syncthreads();
            acc_to_ct<128>(acc, ct);
            ep_rstd(CB(C_CKV), 128, row0, 128, rstd);
            __syncthreads();
            ep_scale_rows(ct, 0, 128, rstd, 1.f); __syncthreads();
            ep_store_rows<64>(ct, 0, CB(C_KN) + nt * 64, 512, row0);
            ep_store_T(ct, 64, 64, CB(C_VMT) + ((size_t)b * 8 + nt) * 64 * TPB, TPB, t0);
            __syncthreads();
        }
    }
}

template <int DK, bool MLA>
DEVI void attn_naive_wave(const Params& p, int b, int t0, int hq) {
    const int lane = TIDX & 63;
    const int t = t0 + lane, row = b * TPB + t;
    const int nkeys = (t0 < CTXL) ? CTXL : TPB;
    float q[DK];
    const bf16_t* qp = MLA ? CB(C_MQ) + (size_t)row * 768 + hq * 96 : CB(C_GQ) + (size_t)row * 512 + hq * 64;
#pragma unroll
    for (int c = 0; c < DK / 8; ++c) {
        bf16x8 tq = *(const bf16x8*)(qp + c * 8);
#pragma unroll
        for (int e = 0; e < 8; ++e) q[c * 8 + e] = bf2f((bf16_t)tq[e]);
    }
    float acc[64];
#pragma unroll
    for (int d = 0; d < 64; ++d) acc[d] = 0.f;
    float m = -1e30f, lsum = 0.f;
    const int hk = MLA ? hq : (hq >> 2);
    const bf16_t* vT = MLA ? CB(C_VMT) + ((size_t)b * 8 + hk) * 64 * TPB : CB(C_GVT) + ((size_t)b * 2 + hk) * 64 * TPB;
    for (int kt = 0; kt < nkeys; ++kt) {
        const size_t krow = (size_t)b * TPB + kt;
        float s = 0.f;
        const bf16_t* kp = MLA ? CB(C_KN) + krow * 512 + hk * 64 : CB(C_GK) + krow * 128 + hk * 64;
#pragma unroll
        for (int c = 0; c < 8; ++c) {
            bf16x8 tk = *(const bf16x8*)(kp + c * 8);
#pragma unroll
            for (int e = 0; e < 8; ++e) s += q[c * 8 + e] * bf2f((bf16_t)tk[e]);
        }
        if (MLA) {
            const bf16_t* rp = CB(C_KR) + krow * 32;
#pragma unroll
            for (int c = 0; c < 4; ++c) {
                bf16x8 tk = *(const bf16x8*)(rp + c * 8);
#pragma unroll
                for (int e = 0; e < 8; ++e) s += q[(DK - 32) + c * 8 + e] * bf2f((bf16_t)tk[e]);
            }
        }
        const float mn = fmaxf(m, s);
        const float alpha = exp2f(m - mn), pp = exp2f(s - mn);
        lsum = lsum * alpha + pp;
#pragma unroll
        for (int d = 0; d < 64; ++d) acc[d] = acc[d] * alpha + pp * bf2f(vT[(size_t)d * TPB + kt]);
        m = mn;
    }
    const float inv = 1.f / lsum;
    bf16_t* op = (MLA ? DB(D_YA) : DB(D_YD)) + (size_t)row * 512 + hq * 64;
#pragma unroll
    for (int c = 0; c < 8; ++c) {
        bf16x8 o;
#pragma unroll
        for (int e = 0; e < 8; ++e) o[e] = (short)f2bf(acc[c * 8 + e] * inv);
        *(bf16x8*)(op + c * 8) = o;
    }
}

DEVI int proc_tok(int dir, int pidx) { return dir == 0 ? pidx : (pidx < CTXL ? CTXL - 1 - pidx : (CTXL + TPB - 1) - pidx); }

DEVI void retention_naive(const Params& p, int l, int task) {
    const int b = task >> 2, h = task & 3;
    const int dir = TIDX >> 7, dv = TIDX & 127;
    const float dec = p.in[I_RDEC][l * 8 + dir * 4 + h];
    const float lg = -log1pf(expf(-dec));
    const float g = expf(lg);
    float S[64];
#pragma unroll
    for (int d = 0; d < 64; ++d) S[d] = 0.f;
    const bf16_t* vT = CB(C_RVT) + (((size_t)b * 4 + h) * 128 + dv) * TPB;
    bf16_t* outp = (dir == 0 ? DB(D_OF) : DB(D_OB));
    for (int pi = 0; pi < TPB; ++pi) {
        const int u = proc_tok(dir, pi);
        const size_t row = (size_t)b * TPB + u;
        const bf16_t* qp = CB(C_RQ) + row * 256 + h * 64;
        const bf16_t* kp = CB(C_RK) + row * 256 + h * 64;
        const float v = bf2f(vT[u]);
        float o = 0.f;
#pragma unroll
        for (int c = 0; c < 8; ++c) {
            bf16x8 tq = *(const bf16x8*)(qp + c * 8);
            bf16x8 tk = *(const bf16x8*)(kp + c * 8);
#pragma unroll
            for (int e = 0; e < 8; ++e) {
                const int d = c * 8 + e;
                const float qd = bf2f((bf16_t)tq[e]), kd = bf2f((bf16_t)tk[e]);
                if (dir == 0) { S[d] = g * S[d] + kd * v; o += qd * S[d]; }
                else { S[d] = g * S[d]; o += qd * S[d]; S[d] += kd * v; }
            }
        }
        outp[row * 512 + h * 128 + dv] = f2bf(o);
    }
}

DEVI void lru_naive_wave(const Params& p, int l, int task) {
    const int lane = TIDX & 63;
    const int b = task >> 4, d = (task >> 3) & 1, blk = task & 7;
    const int ch = blk * 64 + lane;
    float cw[4];
#pragma unroll
    for (int j = 0; j < 4; ++j) cw[j] = p.in[I_LCW][(l * 4 + j) * 512 + ch];
    const float cb = p.in[I_LCB][l * 512 + ch];
    const float ba = p.in[I_LBA][(l * 2 + d) * 512 + ch], bx = p.in[I_LBX][(l * 2 + d) * 512 + ch];
    const float lam = p.in[I_LLAM][(l * 2 + d) * 512 + ch];
    const float sp = log1pf(expf(-lam));
    const float* Wa = p.in[I_LWA] + ((size_t)(l * 2 + d) * 8 + blk) * 4096;
    const float* Wx = p.in[I_LWX] + ((size_t)(l * 2 + d) * 8 + blk) * 4096;
    float h = 0.f;
    bf16_t* outp = (d == 0 ? DB(D_LH0) : DB(D_LH1));
    for (int pi = 0; pi < TPB; ++pi) {
        const int u = proc_tok(d, pi);
        const int lo = u < CTXL ? 0 : CTXL, hi = u < CTXL ? CTXL : TPB;
        const size_t row = (size_t)b * TPB + u;
        float uval = cb;
#pragma unroll
        for (int j = 0; j < 4; ++j) {
            const int tt = u - 2 + j;
            if (tt >= lo && tt < hi) uval += cw[j] * bf2f(CB(C_LX)[((size_t)b * TPB + tt) * 512 + ch]);
        }
        float rp = 0.f, ip = 0.f;
        for (int c = 0; c < 64; ++c) {
            const float uc = __shfl(uval, c);
            rp += uc * Wa[c * 64 + lane];
            ip += uc * Wx[c * 64 + lane];
        }
        const float r = sigmoidf_(rp + ba), ig = sigmoidf_(ip + bx);
        const float la = -8.f * r * sp;
        const float a = expf(la);
        const float bb = sqrtf(-expm1f(2.f * la)) * (ig * uval);
        h = a * h + bb;
        outp[row * 512 + ch] = f2bf(h);
    }
}

DEVI void phase_mix(const Params& p, int l, unsigned char* smem) {
    const int w = TIDX >> 6;
    const int NRET = 32, NLRU = 32;
    const int ngrp = (l == 0 ? 36 : 32) * 8;
    const int NATT = ngrp * 2   * 2  ;
    const int ntask = NRET + NLRU + NATT;
    for (int task = BIDX; task < ntask; task += gridDim.x) {
        if (task < NRET) retention_naive(p, l, task);
        else if (task < NRET + NLRU) lru_naive_wave(p, l, (task - NRET) * 4 + w);
        else {
            int a = task - NRET - NLRU;
            const int kind = a & 1; a >>= 1;
            const int hh = a & 1; a >>= 1;
            const int gpb = (l == 0 ? 36 : 32);
            const int b = a / gpb, gi = a % gpb;
            const int t0 = (l == 0 ? gi : gi + 4) * 64;
            if (kind == 0) attn_naive_wave<96, true>(p, b, t0, hh * 4 + w);
            else attn_naive_wave<64, false>(p, b, t0, hh * 4 + w);
        }
    }
}

DEVI void phase_fin(const Params& p, int l) {
    const int lane = TIDX & 63, w = TIDX >> 6;
    for (int row = BIDX * 4 + w; row < TT; row += gridDim.x * 4) {
        if (l == 1 && (row % TPB) < CTXL) continue;
        const size_t o = (size_t)row * 512 + lane * 8;
        bf16x8 f = *(const bf16x8*)(DB(D_OF) + o), bk = *(const bf16x8*)(DB(D_OB) + o), gt = *(const bf16x8*)(CB(C_RG) + o);
        float v[8], s = 0.f;
#pragma unroll
        for (int e = 0; e < 8; ++e) { v[e] = bf2f((bf16_t)f[e]) + bf2f((bf16_t)bk[e]); s += v[e]; }
#pragma unroll
        for (int off = 1; off < 16; off <<= 1) s += __shfl_xor(s, off);
        const float mu = s * (1.f / 128.f);
        float q = 0.f;
#pragma unroll
        for (int e = 0; e < 8; ++e) { v[e] -= mu; q += v[e] * v[e]; }
#pragma unroll
        for (int off = 1; off < 16; off <<= 1) q += __shfl_xor(q, off);
        const float rs = rsqrtf(q * (1.f / 128.f) + EPSV);
        const float* gn = p.in[I_RNORM] + l * 512 + lane * 8;
        bf16x8 ob;
#pragma unroll
        for (int e = 0; e < 8; ++e) ob[e] = (short)f2bf(siluf_(bf2f((bf16_t)gt[e])) * (v[e] * rs * gn[e]));
        *(bf16x8*)(DB(D_OF) + o) = ob;
        bf16x8 h0 = *(const bf16x8*)(DB(D_LH0) + o), h1 = *(const bf16x8*)(DB(D_LH1) + o), lg = *(const bf16x8*)(CB(C_LG) + o);
        bf16x8 oc;
#pragma unroll
        for (int e = 0; e < 8; ++e) oc[e] = (short)f2bf((bf2f((bf16_t)h0[e]) + bf2f((bf16_t)h1[e])) * gelu_tanh(bf2f((bf16_t)lg[e])));
        *(bf16x8*)(DB(D_LH0) + o) = oc;
    }
}

DEVI void phase_merge(const Params& p, int l, unsigned char* smem) {
    bf16_t* ct = (bf16_t*)smem;
    const int lane = TIDX & 63, wc = (TIDX >> 6) & 1;
    const int nmt = (l == 0 ? 144 : 128);
    for (int tile = BIDX; tile < nmt * 16; tile += gridDim.x) {
        const int mt = mt_of(tile >> 4, l != 0), nt = tile & 15;
        const int row0 = mt * 128;
        f32x4 m[4][2];
        acc_zero<64>(m);
        for (int n = 0; n < 4; ++n) {
            f32x4 ag[4][2], ap[4][2];
            acc_zero<64>(ag); acc_zero<64>(ap);
            AOp A1{HB, 1024, row0, nullptr};
            gemm_core<64>(ag, A1, WB(W_MG + (size_t)l * 4096 * 1024 + (size_t)(n * 1024 + nt * 64) * 1024), 1024, 1024, smem);
            const bf16_t* yb = n == 0 ? DB(D_YA) : (n == 1 ? DB(D_OF) : (n == 2 ? DB(D_LH0) : DB(D_YD)));
            AOp A2{yb, 512, row0, nullptr};
            gemm_core<64>(ap, A2, WB(W_BR + ((size_t)l * 4 + n) * 1024 * 512 + (size_t)(nt * 64) * 512), 512, 512, smem);
            const float* bm = p.in[I_BMG] + l * 4096 + n * 1024 + nt * 64 + wc * 32 + (lane & 15);
#pragma unroll
            for (int ni = 0; ni < 2; ++ni) {
                const float bias = bm[ni * 16];
#pragma unroll
                for (int mi = 0; mi < 4; ++mi)
#pragma unroll
                    for (int j = 0; j < 4; ++j) m[mi][ni][j] += sigmoidf_(ag[mi][ni][j] + bias) * ap[mi][ni][j];
            }
        }
        __syncthreads();
        acc_to_ct<64>(m, ct);
        __syncthreads();
        ep_store_rows<64>(ct, 0, CB(C_M) + nt * 64, 1024, row0);
        __syncthreads();
    }
}

DEVI void phase_wout(const Params& p, int l, unsigned char* smem) {
    bf16_t* ct = (bf16_t*)smem;
    const int nmt = (l == 0 ? 144 : 128);
    const int ngemm = nmt * 8, ncvt = 24576;
    for (int task = BIDX; task < ngemm + ncvt; task += gridDim.x) {
        if (task < ngemm) {
            const int mt = mt_of(task >> 3, l != 0), nt = task & 7;
            const int row0 = mt * 128, b = mt / 18, t0 = (mt % 18) * 128;
            const bool isctx = (mt % 18) < 2;
            const int bi = isctx ? 8 : b;
            f32x4 acc[4][4];
            acc_zero<128>(acc);
            AOp A{CB(C_M), 1024, row0, nullptr};
            gemm_core<128>(acc, A, WB(W_OUT + (size_t)l * 1024 * 1024 + (size_t)nt * 128 * 1024), 1024, 1024, smem);
            __syncthreads();
            acc_to_ct<128>(acc, ct);
            __syncthreads();
            const float* gate = WSF(OFF_MOD) + (size_t)(l * 9 + bi) * 6144 + 2 * 1024 + nt * 128;
            for (int c = TIDX; c < 128 * 32; c += 256) {
                const int i = c >> 5, jc = c & 31;
                const int t = t0 + i;
                const float* xs;
                if (l == 0) xs = isctx ? p.in[I_CTX] + ((size_t)b * CTXL + t) * DM : p.in[I_X] + ((size_t)b * SEQL + (t - CTXL)) * DM;
                else xs = XCUR + (size_t)(row0 + i) * DM;
                float4 x4 = *(const float4*)(xs + nt * 128 + jc * 4);
                float4 g4 = *(const float4*)(gate + jc * 4);
                uint2 y = *(const uint2*)(ct + i * CT_LD + jc * 4);
                x4.x += g4.x * __uint_as_float(y.x << 16);
                x4.y += g4.y * __uint_as_float(y.x & 0xffff0000u);
                x4.z += g4.z * __uint_as_float(y.y << 16);
                x4.w += g4.w * __uint_as_float(y.y & 0xffff0000u);
                *(float4*)(XCUR + (size_t)(row0 + i) * DM + nt * 128 + jc * 4) = x4;
            }
            __syncthreads();
        } else {
            int t = task - ngemm;
            const int k = t >> 13; t &= 8191;
            CvtJob j = get_moe_job(p, l, k);
            cvt_tile(j, t, (float*)smem);
        }
    }
}

DEVI void phase_route(const Params& p, int l, unsigned char* smem) {
    const int lane = TIDX & 63, w = TIDX >> 6;
    float* hb = (float*)smem + w * 1024;
    const float* g2 = p.in[I_N2G] + l * 1024;
    const float* rw = p.in[I_RW];
    const float rbias = p.in[I_RB][lane];
    int* cnt = WSI(OFF_CNT) + l * 64;
    int* list = WSI(OFF_LIST);
    for (int row = BIDX * 4 + w; row < TT; row += gridDim.x * 4) {
        const int b = row / TPB, t = row % TPB;
        const bool isctx = t < CTXL;
        if (l == 1 && isctx) continue;
        const int bi = isctx ? 8 : b;
        const float* xr = XCUR + (size_t)row * DM;
        float v[16];
        float ss = 0.f;
#pragma unroll
        for (int i = 0; i < 4; ++i) {
            float4 x4 = *(const float4*)(xr + i * 256 + lane * 4);
            v[i * 4] = x4.x; v[i * 4 + 1] = x4.y; v[i * 4 + 2] = x4.z; v[i * 4 + 3] = x4.w;
            ss += x4.x * x4.x + x4.y * x4.y + x4.z * x4.z + x4.w * x4.w;
        }
        ss = wave_sum(ss);
        const float rstd = rsqrtf(ss * (1.f / 1024.f) + EPSV);
        const float* md = WSF(OFF_MOD) + (size_t)(l * 9 + bi) * 6144 + 3 * 1024;
        bf16_t* ho = HB + (size_t)row * DM;
#pragma unroll
        for (int i = 0; i < 4; ++i) {
            const int c = i * 256 + lane * 4;
            float4 g4 = *(const float4*)(g2 + c);
            float4 sh = *(const float4*)(md + c);
            float4 sc = *(const float4*)(md + 1024 + c);
            float4 h4;
            h4.x = v[i * 4] * rstd * g4.x * (1.f + sc.x) + sh.x;
            h4.y = v[i * 4 + 1] * rstd * g4.y * (1.f + sc.y) + sh.y;
            h4.z = v[i * 4 + 2] * rstd * g4.z * (1.f + sc.z) + sh.z;
            h4.w = v[i * 4 + 3] * rstd * g4.w * (1.f + sc.w) + sh.w;
            uint2 o2;
            o2.x = (unsigned)f2bf(h4.x) | ((unsigned)f2bf(h4.y) << 16);
            o2.y = (unsigned)f2bf(h4.z) | ((unsigned)f2bf(h4.w) << 16);
            *(uint2*)(ho + c) = o2;
            *(float4*)(hb + c) = h4;
        }
        __builtin_amdgcn_wave_barrier();
        float lg = 0.f;
#pragma unroll 8
        for (int k = 0; k < 1024; ++k) lg += hb[k] * rw[k * 64 + lane];
        __builtin_amdgcn_wave_barrier();
        const float score = sigmoidf_(lg);
        const float biased = score + rbias;
        float v1 = biased; int i1 = lane;
#pragma unroll
        for (int off = 1; off < 8; off <<= 1) {
            float ov = __shfl_xor(v1, off); int oi = __shfl_xor(i1, off);
            if (ov > v1 || (ov == v1 && oi < i1)) { v1 = ov; i1 = oi; }
        }
        float v2 = (lane == i1) ? -3.0e38f : biased; int i2 = lane;
#pragma unroll
        for (int off = 1; off < 8; off <<= 1) {
            float ov = __shfl_xor(v2, off); int oi = __shfl_xor(i2, off);
            if (ov > v2 || (ov == v2 && oi < i2)) { v2 = ov; i2 = oi; }
        }
        float gv = v1 + v2; int gi = lane >> 3;
#pragma unroll
        for (int off = 8; off < 64; off <<= 1) {
            float ov = __shfl_xor(gv, off); int oi = __shfl_xor(gi, off);
            if (ov > gv || (ov == gv && oi < gi)) { gv = ov; gi = oi; }
        }
        const int e0 = __shfl(i1, gi * 8), e1 = __shfl(i2, gi * 8);
        const float s0 = __shfl(score, e0), s1 = __shfl(score, e1);
        if (lane == 0) {
            Rec rc;
            rc.e0 = e0; rc.e1 = e1;
            rc.p0 = atomicAdd(&cnt[e0], 1);
            rc.p1 = atomicAdd(&cnt[e1], 1);
            const float inv = 1.f / (s0 + s1);
            rc.w0 = s0 * inv; rc.w1 = s1 * inv; rc.pad0 = 0; rc.pad1 = 0;
            list[(size_t)e0 * TT + rc.p0] = row;
            list[(size_t)e1 * TT + rc.p1] = row;
            ((Rec*)(p.ws + OFF_REC))[row] = rc;
        }
    }
}

DEVI void phase_moe1(const Params& p, int l, unsigned char* smem) {
    bf16_t* ct = (bf16_t*)smem;
    int* ridx = (int*)(smem + AUX_OFF);
    MoeTab mt = moe_tables(p, l, smem);
    const int* list = WSI(OFF_LIST);
    const int ntile = mt.tp[64] * 4;
    for (int tile = BIDX; tile < ntile; tile += gridDim.x) {
        const int rt = tile >> 2, nt = tile & 3;
        int e = 0;
        while (mt.tp[e + 1] <= rt) ++e;
        const int jt = rt - mt.tp[e];
        if (TIDX < 128) {
            const int idx = jt * 128 + TIDX;
            ridx[TIDX] = list[(size_t)e * TT + (idx < mt.cnt[e] ? idx : 0)];
        }
        __syncthreads();
        f32x4 acc[4][4];
        acc_zero<128>(acc);
        AOp A{HB, 1024, 0, ridx};
        gemm_core<128>(acc, A, CB(C_W13) + ((size_t)e * 512 + nt * 128) * 1024, 1024, 1024, smem);
        __syncthreads();
        acc_to_ct<128>(acc, ct);
        __syncthreads();
        const int slot0 = mt.seg[e] + jt * 128;
        for (int c = TIDX; c < 128 * 8; c += 256) {
            const int i = c >> 3, jc = c & 7;
            bf16x8 a = *(const bf16x8*)(ct + i * CT_LD + jc * 8), g = *(const bf16x8*)(ct + i * CT_LD + 64 + jc * 8), o;
#pragma unroll
            for (int q = 0; q < 8; ++q) o[q] = (short)f2bf(siluf_(bf2f((bf16_t)a[q])) * bf2f((bf16_t)g[q]));
            *(bf16x8*)(DB(D_ACT) + (size_t)(slot0 + i) * 256 + nt * 64 + jc * 8) = o;
        }
        __syncthreads();
    }
}
DEVI void phase_moe2(const Params& p, int l, unsigned char* smem) {
    bf16_t* ct = (bf16_t*)smem;
    MoeTab mt = moe_tables(p, l, smem);
    const int ntile = mt.tp[64] * 8;
    for (int tile = BIDX; tile < ntile; tile += gridDim.x) {
        const int rt = tile >> 3, nt = tile & 7;
        int e = 0;
        while (mt.tp[e + 1] <= rt) ++e;
        const int jt = rt - mt.tp[e];
        const int slot0 = mt.seg[e] + jt * 128;
        f32x4 acc[4][4];
        acc_zero<128>(acc);
        AOp A{DB(D_ACT), 256, slot0, nullptr};
        gemm_core<128>(acc, A, CB(C_W2) + ((size_t)e * 1024 + nt * 128) * 256, 256, 256, smem);
        __syncthreads();
        acc_to_ct<128>(acc, ct);
        __syncthreads();
        ep_store_rows<128>(ct, 0, DB(D_YS) + nt * 128, 1024, slot0);
        __syncthreads();
    }
}

constexpr int NPHASE = 22;
DEVI void run_phase(const Params& p, int ph, unsigned char* smem) {
#ifndef ONLYK
    if (ph == 0) { phase0(p, smem); return; }
    if (ph == 21) { phase_norm1(p, 1, 1, smem); return; }
#endif
    const int l = (ph - 1) / 10, k = (ph - 1) % 10;
#ifdef ONLYK
    if (k != ONLYK) return;
#endif
    switch (k) {
    case 0: phase_norm1(p, l, 0, smem); break;
    case 1: phase_win(p, l, smem); break;
    case 2: phase_mla_up(p, l, smem); break;
    case 3: phase_mix(p, l, smem); break;
    case 4: phase_fin(p, l); break;
    case 5: phase_merge(p, l, smem); break;
    case 6: phase_wout(p, l, smem); break;
    case 7: phase_route(p, l, smem); break;
    case 8: phase_moe1(p, l, smem); break;
    default: phase_moe2(p, l, smem); break;
    }
}

__global__ void __launch_bounds__(256, 2) k_main(Params p, int ph_lo, int ph_hi) {
    __shared__ __attribute__((aligned(16))) unsigned char smem[SMEM_BYTES];
    for (int ph = ph_lo; ph < ph_hi; ++ph) {
        run_phase(p, ph, smem);
        if (ph + 1 < ph_hi) { cg::this_grid().sync(); }
    }
}

extern "C" void kernel_launch(void* const* d_in, const int* in_sizes, int n_in, void* d_out, int out_size, void* d_ws, size_t ws_size,
                              hipStream_t stream) {
    if (ws_size < WS_NEED || n_in < N_IN) { fprintf(stderr, "workspace too small: %zu < %zu\n", ws_size, (size_t)WS_NEED); return; }
    Params p{};
    for (int i = 0; i < N_IN; ++i) p.in[i] = (const float*)d_in[i];
    p.out = (float*)d_out;
    p.ws = (unsigned char*)d_ws;
    static int grid_blocks = 0;
    if (!grid_blocks) {
        int dev = 0, cus = 0, per_cu = 0;
        hipGetDevice(&dev);
        hipDeviceGetAttribute(&cus, hipDeviceAttributeMultiprocessorCount, dev);
        hipOccupancyMaxActiveBlocksPerMultiprocessor(&per_cu, k_main, 256, 0);
        if (per_cu > 2) per_cu = 2;
        if (per_cu < 1) per_cu = 1;
        grid_blocks = cus * per_cu;
    }
#if ONE_LAUNCH
    int lo = 0, hi = NPHASE;
    void* args[] = {&p, &lo, &hi};
    hipError_t e = hipLaunchCooperativeKernel((void*)k_main, dim3(grid_blocks), dim3(256), args, 0, stream);
    if (e != hipSuccess) fprintf(stderr, "cooperative launch failed: %s (grid %d)\n", hipGetErrorString(e), grid_blocks);
#else
    for (int ph = 0; ph < NPHASE; ++ph) hipLaunchKernelGGL(k_main, dim3(grid_blocks), dim3(256), 0, stream, p, ph, ph + 1);
#endif
}
```

```cpp
#include <hip/hip_runtime.h>
#include <hip/hip_cooperative_groups.h>
#include <stdint.h>
#include <stdio.h>
namespace cg = cooperative_groups;

#define DEVI __device__ __forceinline__
typedef unsigned short bf16_t;
typedef __attribute__((ext_vector_type(8))) short bf16x8;
typedef __attribute__((ext_vector_type(4))) float f32x4;
typedef __attribute__((ext_vector_type(16))) float f32x16;
typedef __attribute__((ext_vector_type(4))) short bf16x4;

#ifndef NAIVE_GEMM
#define NAIVE_GEMM 0
#endif
#ifndef ONE_LAUNCH
#define ONE_LAUNCH 1
#endif

constexpr int DM = 1024, NBT = 8, SEQL = 2048, CTXL = 256, TPB = 2304, TT = 18432;
constexpr int DINP = 3840;
constexpr float LOG2E = 1.4426950408889634f;
constexpr float EPSV = 1e-6f;
constexpr int NSLOT = 2 * TT + 64 * 128;

enum { I_X = 0, I_C, I_CTX, I_CCTX, I_ADAW, I_ADAB, I_N1G, I_N2G, I_WIN, I_MQN, I_MKVN, I_WUQ, I_WUKV, I_RDEC, I_RNORM,
       I_LCW, I_LCB, I_LWA, I_LBA, I_LWX, I_LBX, I_LLAM, I_GQN, I_GKN, I_WBR, I_WMG, I_BMG, I_WOUT, I_RW, I_RB,
       I_W1, I_W3, I_W2, I_FN, N_IN };

constexpr size_t AL(size_t x) { return (x + 255) & ~(size_t)255; }
constexpr size_t OFF_BAR = 0;
constexpr size_t OFF_CNT = 16384;
constexpr size_t OFF_MOD = OFF_CNT + 4096;
constexpr size_t OFF_R64 = AL(OFF_MOD + (size_t)2 * 9 * 6144 * 4);
constexpr size_t OFF_R32 = OFF_R64 + (size_t)2048 * 64 * 4;
constexpr size_t OFF_REC = OFF_R32 + (size_t)2048 * 32 * 4;
constexpr size_t OFF_LIST = OFF_REC + (size_t)TT * 32;
constexpr size_t OFF_W = AL(OFF_LIST + (size_t)64 * TT * 4);
constexpr size_t W_IN = 0;
constexpr size_t W_UQ = W_IN + (size_t)2 * 3840 * 1024;
constexpr size_t W_UKV = W_UQ + (size_t)2 * 768 * 256;
constexpr size_t W_BR = W_UKV + (size_t)2 * 1024 * 128;
constexpr size_t W_MG = W_BR + (size_t)2 * 4 * 1024 * 512;
constexpr size_t W_OUT = W_MG + (size_t)2 * 4096 * 1024;
constexpr size_t W_LRU = W_OUT + (size_t)2 * 1024 * 1024;
constexpr size_t W_END = W_LRU + (size_t)2 * 2 * 8 * 2 * 64 * 64;
constexpr size_t OFF_XCUR = AL(OFF_W + W_END * 2);
constexpr size_t OFF_H = OFF_XCUR + (size_t)TT * 1024 * 4;
constexpr size_t OFF_C = OFF_H + (size_t)TT * 1024 * 2;
constexpr size_t C_CQ = 0;
constexpr size_t C_CKV = C_CQ + (size_t)TT * 256;
constexpr size_t C_KR = C_CKV + (size_t)TT * 128;
constexpr size_t C_MQ = C_KR + (size_t)TT * 32;
constexpr size_t C_KN = C_MQ + (size_t)TT * 768;
constexpr size_t C_VMT = C_KN + (size_t)TT * 512;
constexpr size_t C_RQ = C_VMT + (size_t)TT * 512;
constexpr size_t C_RK = C_RQ + (size_t)TT * 256;
constexpr size_t C_RKT = C_RK + (size_t)TT * 256;
constexpr size_t C_RVT = C_RKT + (size_t)TT * 256;
constexpr size_t C_RG = C_RVT + (size_t)TT * 512;
constexpr size_t C_LX = C_RG + (size_t)TT * 512;
constexpr size_t C_LG = C_LX + (size_t)TT * 512;
constexpr size_t C_GQ = C_LG + (size_t)TT * 512;
constexpr size_t C_GK = C_GQ + (size_t)TT * 512;
constexpr size_t C_GVT = C_GK + (size_t)TT * 128;
constexpr size_t C_END = C_GVT + (size_t)TT * 128;
constexpr size_t C_M = 0;
constexpr size_t C_W13 = (size_t)24 * 1024 * 1024;
constexpr size_t C_W2 = C_W13 + (size_t)64 * 512 * 1024;
static_assert(C_W2 + (size_t)64 * 1024 * 256 <= C_END, "moe alias");
static_assert((size_t)TT * 1024 <= C_W13, "m alias");
constexpr size_t OFF_D = OFF_C + C_END * 2;
constexpr size_t D_YA = 0;
constexpr size_t D_YD = (size_t)TT * 512;
constexpr size_t D_OF = (size_t)2 * TT * 512;
constexpr size_t D_OB = (size_t)3 * TT * 512;
constexpr size_t D_LH0 = (size_t)4 * TT * 512;
constexpr size_t D_LH1 = (size_t)5 * TT * 512;
constexpr size_t D_ACT = 0;
constexpr size_t D_YS = (size_t)12 * 1024 * 1024;
constexpr size_t D_END = D_YS + (size_t)NSLOT * 1024;
static_assert((size_t)NSLOT * 256 <= D_YS, "act alias");
static_assert((size_t)6 * TT * 512 <= D_END, "d size");
constexpr size_t WS_NEED = OFF_D + D_END * 2;

struct Params {
    const float* in[N_IN];
    float* out;
    unsigned char* ws;
};

#define WSF(off) ((float*)(p.ws + (off)))
#define WSI(off) ((int*)(p.ws + (off)))
#define WB(el) ((bf16_t*)(p.ws + OFF_W) + (el))
#define CB(el) ((bf16_t*)(p.ws + OFF_C) + (el))
#define DB(el) ((bf16_t*)(p.ws + OFF_D) + (el))
#define HB ((bf16_t*)(p.ws + OFF_H))
#define XCUR ((float*)(p.ws + OFF_XCUR))

constexpr int SMEM_BYTES = 49152;
constexpr int CT_LD = 136;
constexpr int AUX_OFF = 36864;

DEVI int launder_tid() { int t = __builtin_amdgcn_workitem_id_x(); asm volatile("" : "+v"(t)); return t; }
DEVI int launder_bid() { int t = __builtin_amdgcn_workgroup_id_x(); asm volatile("" : "+s"(t)); return t; }
#define TIDX launder_tid()
#define BIDX launder_bid()
DEVI float bf2f(bf16_t v) { return __uint_as_float(((unsigned)v) << 16); }
DEVI bf16_t f2bf(float f) {
    __bf16 h = (__bf16)f;
    return __builtin_bit_cast(unsigned short, h);
}
DEVI float sigmoidf_(float x) { return 1.f / (1.f + __expf(-x)); }
DEVI float siluf_(float x) { return x / (1.f + __expf(-x)); }
DEVI float gelu_tanh(float x) {
    float u = 0.7978845608028654f * (x + 0.044715f * x * x * x);
    return 0.5f * x * (1.f + tanhf(u));
}
DEVI float wave_sum(float v) {
#pragma unroll
    for (int o = 32; o > 0; o >>= 1) v += __shfl_xor(v, o);
    return v;
}
DEVI int mt_of(int q, bool latonly) { return latonly ? (q >> 4) * 18 + 2 + (q & 15) : q; }

struct CvtJob { const float* src; bf16_t* dst; const float* ks; int K, N, ldd, batch; size_t sbs, dbs; int mode; };
DEVI int cvt_rowmap(int mode, int n) {
    if (mode == 1) return n < 384 ? n : (n < 416 ? n - 384 + 3712 : n - 32);
    if (mode == 2) { int h = n / 96, j = n % 96; return j < 64 ? h * 64 + j : 512 + h * 32 + (j - 64); }
    if (mode == 3) return (n >> 6) * 128 + (n & 63);
    return n;
}
DEVI void cvt_tile(const CvtJob& j, int tile, float* lds) {
    const int tn = j.N / 32, tk = j.K / 64, per = tn * tk;
    const int bb = tile / per, r = tile % per, kt = r / tn, nt = r % tn;
    const float* s = j.src + (size_t)bb * j.sbs + (size_t)(kt * 64) * j.N + nt * 32;
    const int tx = TIDX & 31, ty = TIDX >> 5;
#pragma unroll
    for (int i = 0; i < 8; ++i) {
        int k = ty + 8 * i;
        float v = s[(size_t)k * j.N + tx];
        if (j.ks) v *= j.ks[kt * 64 + k];
        lds[k * 33 + tx] = v;
    }
    __syncthreads();
    bf16_t* d = j.dst + (size_t)bb * j.dbs;
#pragma unroll
    for (int i = 0; i < 4; ++i) {
        int n = ty + 8 * i, kk = tx * 2;
        unsigned lo = f2bf(lds[kk * 33 + n]), hi = f2bf(lds[(kk + 1) * 33 + n]);
        int row = cvt_rowmap(j.mode, nt * 32 + n);
        *(unsigned*)(d + (size_t)row * j.ldd + kt * 64 + kk) = lo | (hi << 16);
    }
    __syncthreads();
}
__constant__ const int CVT_TILES[8] = {1872, 96, 64, 1024, 2048, 512, 32, 32};
constexpr int CVT_PER_LAYER = 1872 + 96 + 64 + 1024 + 2048 + 512 + 32 + 32;
DEVI CvtJob get_job(const Params& p, int l, int k) {
    CvtJob j; j.ks = nullptr; j.batch = 1; j.sbs = 0; j.dbs = 0; j.mode = 0;
    switch (k) {
    case 0: j.src = p.in[I_WIN] + (size_t)l * 1024 * 3744; j.dst = WB(W_IN + (size_t)l * 3840 * 1024); j.K = 1024; j.N = 3744; j.ldd = 1024; j.mode = 1; break;
    case 1: j.src = p.in[I_WUQ] + (size_t)l * 256 * 768; j.dst = WB(W_UQ + (size_t)l * 768 * 256); j.K = 256; j.N = 768; j.ldd = 256; j.ks = p.in[I_MQN] + l * 256; j.mode = 2; break;
    case 2: j.src = p.in[I_WUKV] + (size_t)l * 128 * 1024; j.dst = WB(W_UKV + (size_t)l * 1024 * 128); j.K = 128; j.N = 1024; j.ldd = 128; j.ks = p.in[I_MKVN] + l * 128; break;
    case 3: j.src = p.in[I_WBR] + (size_t)l * 4 * 512 * 1024; j.dst = WB(W_BR + (size_t)l * 4 * 1024 * 512); j.K = 512; j.N = 1024; j.ldd = 512; j.batch = 4; j.sbs = 512 * 1024; j.dbs = 1024 * 512; break;
    case 4: j.src = p.in[I_WMG] + (size_t)l * 1024 * 4096; j.dst = WB(W_MG + (size_t)l * 4096 * 1024); j.K = 1024; j.N = 4096; j.ldd = 1024; break;
    case 5: j.src = p.in[I_WOUT] + (size_t)l * 1024 * 1024; j.dst = WB(W_OUT + (size_t)l * 1024 * 1024); j.K = 1024; j.N = 1024; j.ldd = 1024; break;
    case 6: j.src = p.in[I_LWA] + (size_t)l * 16 * 4096; j.dst = WB(W_LRU + (size_t)l * 16 * 8192); j.K = 64; j.N = 64; j.ldd = 64; j.batch = 16; j.sbs = 4096; j.dbs = 8192; break;
    default: j.src = p.in[I_LWX] + (size_t)l * 16 * 4096; j.dst = WB(W_LRU + (size_t)l * 16 * 8192 + 4096); j.K = 64; j.N = 64; j.ldd = 64; j.batch = 16; j.sbs = 4096; j.dbs = 8192; break;
    }
    return j;
}
DEVI CvtJob get_moe_job(const Params& p, int l, int k) {
    CvtJob j; j.ks = nullptr; j.batch = 64; j.sbs = 262144;
    if (k == 0) { j.src = p.in[I_W1] + (size_t)l * 64 * 262144; j.dst = CB(C_W13); j.K = 1024; j.N = 256; j.ldd = 1024; j.dbs = 512 * 1024; j.mode = 3; }
    else if (k == 1) { j.src = p.in[I_W3] + (size_t)l * 64 * 262144; j.dst = CB(C_W13 + 64 * 1024); j.K = 1024; j.N = 256; j.ldd = 1024; j.dbs = 512 * 1024; j.mode = 3; }
    else { j.src = p.in[I_W2] + (size_t)l * 64 * 262144; j.dst = CB(C_W2); j.K = 256; j.N = 1024; j.ldd = 256; j.dbs = 262144; j.mode = 0; }
    return j;
}

struct AOp { const bf16_t* base; int ld; int row0; const int* ridx; };
DEVI const bf16_t* arow(const AOp& a, int i) {
    int r = a.ridx ? a.ridx[i] : a.row0 + i;
    return a.base + (size_t)r * a.ld;
}

#if NAIVE_GEMM
template <int BN>
DEVI void gemm_core(f32x4 (&acc)[4][BN / 32], const AOp& A, const bf16_t* B, int ldb, int K, unsigned char* smem) {
    constexpr int NI = BN / 32;
    const int tid = TIDX, lane = tid & 63, wid = tid >> 6, wr = wid >> 1, wc = wid & 1;
    for (int k0 = 0; k0 < K; k0 += 8) {
        bf16x8 bv[NI];
#pragma unroll
        for (int ni = 0; ni < NI; ++ni) bv[ni] = *(const bf16x8*)(B + (size_t)(wc * (BN / 2) + ni * 16 + (lane & 15)) * ldb + k0);
#pragma unroll
        for (int mi = 0; mi < 4; ++mi)
#pragma unroll
            for (int j = 0; j < 4; ++j) {
                bf16x8 av = *(const bf16x8*)(arow(A, wr * 64 + mi * 16 + (lane >> 4) * 4 + j) + k0);
#pragma unroll
                for (int ni = 0; ni < NI; ++ni) {
                    float s = 0.f;
#pragma unroll
                    for (int e = 0; e < 8; ++e) s += bf2f((bf16_t)av[e]) * bf2f((bf16_t)bv[ni][e]);
                    acc[mi][ni][j] += s;
                }
            }
    }
}
#else
template <int BN>
DEVI void gemm_core(f32x4 (&acc)[4][BN / 32], const AOp& A, const bf16_t* B, int ldb, int K, unsigned char* smem) {
    constexpr int NI = BN / 32;
    constexpr int NBL = BN / 32;
    const int tid = TIDX, lane = tid & 63, wid = tid >> 6, wr = wid >> 1, wc = wid & 1;
    unsigned char* sA = smem;
    unsigned char* sB = smem + 16384;
    const int lr = tid >> 3, lc = tid & 7;
    const bf16_t* ap[4];
    const bf16_t* bp[NBL];
#pragma unroll
    for (int i = 0; i < 4; ++i) ap[i] = arow(A, lr + 32 * i) + lc * 8;
#pragma unroll
    for (int i = 0; i < NBL; ++i) bp[i] = B + (size_t)(lr + 32 * i) * ldb + lc * 8;
    const int wofs = lr * 128 + ((lc ^ (lr & 7)) << 4);
    bf16x8 ra[4], rb[NBL];
#pragma unroll
    for (int i = 0; i < 4; ++i) ra[i] = *(const bf16x8*)(ap[i]);
#pragma unroll
    for (int i = 0; i < NBL; ++i) rb[i] = *(const bf16x8*)(bp[i]);
    const int nk = K >> 6;
    const int arow_off = (wr * 64 + (lane & 15)) * 128;
    const int brow_off = (wc * (BN / 2) + (lane & 15)) * 128;
    for (int kt = 0; kt < nk; ++kt) {
        __syncthreads();
#pragma unroll
        for (int i = 0; i < 4; ++i) *(bf16x8*)(sA + wofs + i * 4096) = ra[i];
#pragma unroll
        for (int i = 0; i < NBL; ++i) *(bf16x8*)(sB + wofs + i * 4096) = rb[i];
        __syncthreads();
        if (kt + 1 < nk) {
            const int ko = (kt + 1) * 64;
#pragma unroll
            for (int i = 0; i < 4; ++i) ra[i] = *(const bf16x8*)(ap[i] + ko);
#pragma unroll
            for (int i = 0; i < NBL; ++i) rb[i] = *(const bf16x8*)(bp[i] + ko);
        }
#pragma unroll
        for (int ks = 0; ks < 2; ++ks) {
            const int pch = ((ks * 4 + (lane >> 4)) ^ (lane & 7)) << 4;
            bf16x8 af[4], bfr[NI];
#pragma unroll
            for (int mi = 0; mi < 4; ++mi) af[mi] = *(const bf16x8*)(sA + arow_off + mi * 2048 + pch);
#pragma unroll
            for (int ni = 0; ni < NI; ++ni) bfr[ni] = *(const bf16x8*)(sB + brow_off + ni * 2048 + pch);
#pragma unroll
            for (int mi = 0; mi < 4; ++mi)
#pragma unroll
                for (int ni = 0; ni < NI; ++ni)
                    acc[mi][ni] = __builtin_amdgcn_mfma_f32_16x16x32_bf16(af[mi], bfr[ni], acc[mi][ni], 0, 0, 0);
        }
    }
}
#endif

template <int BN>
DEVI void acc_zero(f32x4 (&acc)[4][BN / 32]) {
#pragma unroll
    for (int mi = 0; mi < 4; ++mi)
#pragma unroll
        for (int ni = 0; ni < BN / 32; ++ni) acc[mi][ni] = f32x4{0.f, 0.f, 0.f, 0.f};
}
template <int BN>
DEVI void acc_to_ct(const f32x4 (&acc)[4][BN / 32], bf16_t* ct) {
    const int tid = TIDX, lane = tid & 63, wid = tid >> 6, wr = wid >> 1, wc = wid & 1;
#pragma unroll
    for (int mi = 0; mi < 4; ++mi)
#pragma unroll
        for (int ni = 0; ni < BN / 32; ++ni)
#pragma unroll
            for (int j = 0; j < 4; ++j)
                ct[(wr * 64 + mi * 16 + (lane >> 4) * 4 + j) * CT_LD + wc * (BN / 2) + ni * 16 + (lane & 15)] = f2bf(acc[mi][ni][j]);
}

template <int NC>
DEVI void ep_store_rows(const bf16_t* ct, int c0, bf16_t* dst, int ldd, int row0) {
    constexpr int CPR = NC / 8;
    for (int c = TIDX; c < 128 * CPR; c += 256) {
        int i = c / CPR, jc = c % CPR;
        *(bf16x8*)(dst + (size_t)(row0 + i) * ldd + jc * 8) = *(const bf16x8*)(ct + i * CT_LD + c0 + jc * 8);
    }
}
DEVI void ep_store_T(const bf16_t* ct, int c0, int nc, bf16_t* dstT, int ldT, int t0) {
    for (int c = TIDX; c < nc * 16; c += 256) {
        int j = c >> 4, ic = c & 15;
        bf16x8 v;
#pragma unroll
        for (int e = 0; e < 8; ++e) v[e] = (short)ct[(ic * 8 + e) * CT_LD + c0 + j];
        *(bf16x8*)(dstT + (size_t)j * ldT + t0 + ic * 8) = v;
    }
}
DEVI void ep_rope64(bf16_t* ct, const float* gain, float scale, bool lat, int pos0, const float* cs64) {
    const int row = TIDX >> 1, half = TIDX & 1;
    bf16_t* pr = ct + row * CT_LD + half * 64;
    float v[64];
#pragma unroll
    for (int c = 0; c < 8; ++c) {
        bf16x8 t = *(const bf16x8*)(pr + c * 8);
#pragma unroll
        for (int e = 0; e < 8; ++e) v[c * 8 + e] = bf2f((bf16_t)t[e]);
    }
    if (gain) {
        float ss = 0.f;
#pragma unroll
        for (int d = 0; d < 64; ++d) ss += v[d] * v[d];
        float rstd = rsqrtf(ss * (1.f / 64.f) + EPSV);
#pragma unroll
        for (int d = 0; d < 64; ++d) v[d] = v[d] * rstd * gain[d];
    }
    if (lat) {
        const float* cs = cs64 + (size_t)(pos0 + row) * 64;
#pragma unroll
        for (int i = 0; i < 16; ++i) {
            float a = v[i], b = v[i + 16], c = cs[i], s = cs[32 + i];
            v[i] = a * c - b * s; v[i + 16] = b * c + a * s;
            a = v[32 + i]; b = v[48 + i]; c = cs[16 + i]; s = cs[48 + i];
            v[32 + i] = a * c - b * s; v[48 + i] = b * c + a * s;
        }
    }
#pragma unroll
    for (int c = 0; c < 8; ++c) {
        bf16x8 t;
#pragma unroll
        for (int e = 0; e < 8; ++e) t[e] = (short)f2bf(v[c * 8 + e] * scale);
        *(bf16x8*)(pr + c * 8) = t;
    }
}
DEVI void ep_rope32(bf16_t* ct, int ngroups, const float* rstd, float scale, bool lat, int pos0, const float* cs32) {
    const int row = TIDX >> 1, half = TIDX & 1;
    const float rs = (rstd ? rstd[row] : 1.f) * scale;
#pragma unroll
    for (int gg = 0; gg < 2; ++gg) {
        const int g = half * 2 + gg;
        if (g < ngroups) {
            bf16_t* pr = ct + row * CT_LD + g * 32;
            float v[32];
#pragma unroll
            for (int c = 0; c < 4; ++c) {
                bf16x8 t = *(const bf16x8*)(pr + c * 8);
#pragma unroll
                for (int e = 0; e < 8; ++e) v[c * 8 + e] = bf2f((bf16_t)t[e]);
            }
            if (lat) {
                const float* cs = cs32 + (size_t)(pos0 + row) * 32;
#pragma unroll
                for (int i = 0; i < 8; ++i) {
                    float a = v[i], b = v[i + 8], c = cs[i], s = cs[16 + i];
                    v[i] = a * c - b * s; v[i + 8] = b * c + a * s;
                    a = v[16 + i]; b = v[24 + i]; c = cs[8 + i]; s = cs[24 + i];
                    v[16 + i] = a * c - b * s; v[24 + i] = b * c + a * s;
                }
            }
#pragma unroll
            for (int c = 0; c < 4; ++c) {
                bf16x8 t;
#pragma unroll
                for (int e = 0; e < 8; ++e) t[e] = (short)f2bf(v[c * 8 + e] * rs);
                *(bf16x8*)(pr + c * 8) = t;
            }
        }
    }
}
DEVI void ep_scale_rows(bf16_t* ct, int c0, int nc, const float* rstd, float scale) {
    const int cpr = nc / 8;
    for (int c = TIDX; c < 128 * cpr; c += 256) {
        int i = c / cpr, jc = c % cpr;
        bf16_t* pr = ct + i * CT_LD + c0 + jc * 8;
        bf16x8 t = *(const bf16x8*)pr;
        float rs = rstd[i] * scale;
#pragma unroll
        for (int e = 0; e < 8; ++e) t[e] = (short)f2bf(bf2f((bf16_t)t[e]) * rs);
        *(bf16x8*)pr = t;
    }
}
DEVI void ep_rstd(const bf16_t* A, int ld, int row0, int K, float* rstd) {
    const int row = TIDX >> 1, half = TIDX & 1;
    const bf16_t* pr = A + (size_t)(row0 + row) * ld + half * (K / 2);
    float ss = 0.f;
    for (int c = 0; c < K / 16; ++c) {
        bf16x8 t = *(const bf16x8*)(pr + c * 8);
#pragma unroll
        for (int e = 0; e < 8; ++e) { float f = bf2f((bf16_t)t[e]); ss += f * f; }
    }
    ss += __shfl_xor(ss, 1);
    if (half == 0) rstd[row] = rsqrtf(ss / (float)K + EPSV);
}

DEVI void phase0(const Params& p, unsigned char* smem) {
    const int tid = TIDX, lane = tid & 63, w = tid >> 6;
    const int NG = 192, NCV = 2 * CVT_PER_LAYER, NR = 8;
    const int ntask = NG + NCV + NR + 1;
    for (int task = BIDX; task < ntask; task += gridDim.x) {
        if (task < NG) {
            const int l = task / 96, n0 = (task % 96) * 64;
            float* sv = (float*)smem;
            float* red = (float*)(smem + 36864);
            for (int idx = lane; idx < 9 * 256; idx += 64) {
                int bi = idx >> 8, kk = idx & 255, k = 256 * w + kk;
                float c = bi < 8 ? p.in[I_C][bi * 1024 + k] : p.in[I_CCTX][k];
                sv[(w * 9 + bi) * 256 + kk] = siluf_(c);
            }
            __syncthreads();
            float acc[9];
#pragma unroll
            for (int bi = 0; bi < 9; ++bi) acc[bi] = 0.f;
            const float* wp = p.in[I_ADAW] + (size_t)l * 1024 * 6144 + (size_t)(256 * w) * 6144 + n0 + lane;
#pragma unroll 8
            for (int kk = 0; kk < 256; ++kk) {
                float wv = wp[(size_t)kk * 6144];
#pragma unroll
                for (int bi = 0; bi < 9; ++bi) acc[bi] += sv[(w * 9 + bi) * 256 + kk] * wv;
            }
#pragma unroll
            for (int bi = 0; bi < 9; ++bi) red[(w * 9 + bi) * 64 + lane] = acc[bi];
            __syncthreads();
            for (int idx = tid; idx < 9 * 64; idx += 256) {
                int bi = idx >> 6, c = idx & 63;
                float s = p.in[I_ADAB][l * 6144 + n0 + c];
#pragma unroll
                for (int ww = 0; ww < 4; ++ww) s += red[(ww * 9 + bi) * 64 + c];
                WSF(OFF_MOD)[(size_t)(l * 9 + bi) * 6144 + n0 + c] = s;
            }
            __syncthreads();
        } else if (task < NG + NCV) {
            int t = task - NG;
            int l = t / CVT_PER_LAYER; t %= CVT_PER_LAYER;
            int k = 0;
            while (t >= CVT_TILES[k]) { t -= CVT_TILES[k]; ++k; }
            CvtJob j = get_job(p, l, k);
            cvt_tile(j, t, (float*)smem);
        } else if (task < NG + NCV + NR) {
            int pos = (task - NG - NCV) * 256 + tid;
            float rp = (float)(pos >> 6), cp = (float)(pos & 63);
            float* t64 = WSF(OFF_R64) + (size_t)pos * 64;
            float* t32 = WSF(OFF_R32) + (size_t)pos * 32;
            for (int i = 0; i < 16; ++i) {
                float inv = powf(10000.f, -(float)(2 * i) / 32.f);
                float ar = rp * inv, ac = cp * inv;
                t64[i] = cosf(ar); t64[16 + i] = cosf(ac); t64[32 + i] = sinf(ar); t64[48 + i] = sinf(ac);
            }
            for (int i = 0; i < 8; ++i) {
                float inv = powf(10000.f, -(float)(2 * i) / 16.f);
                float ar = rp * inv, ac = cp * inv;
                t32[i] = cosf(ar); t32[8 + i] = cosf(ac); t32[16 + i] = sinf(ar); t32[24 + i] = sinf(ac);
            }
        } else {
            if (tid < 128) WSI(OFF_CNT)[tid] = 0;
            for (int l = 0; l < 2; ++l) {
                unsigned* z = (unsigned*)WB(W_IN + (size_t)l * 3840 * 1024 + (size_t)3744 * 1024);
                for (int i = tid; i < 96 * 1024 / 2; i += 256) z[i] = 0u;
            }
        }
    }
}

struct MoeTab { int* cnt; int* tp; int* seg; };
DEVI MoeTab moe_tables(const Params& p, int l, unsigned char* smem) {
    int* aux = (int*)(smem + AUX_OFF);
    MoeTab t; t.cnt = aux + 256; t.tp = aux + 320; t.seg = aux + 400;
    __syncthreads();
    if (TIDX < 64) t.cnt[TIDX] = WSI(OFF_CNT)[l * 64 + TIDX];
    __syncthreads();
    if (TIDX == 0) {
        int a = 0, s = 0;
        for (int e = 0; e < 64; ++e) {
            t.tp[e] = a; t.seg[e] = s;
            int nt = (t.cnt[e] + 127) >> 7;
            a += nt; s += nt * 128;
        }
        t.tp[64] = a; t.seg[64] = s;
    }
    __syncthreads();
    return t;
}
struct Rec { int e0, p0, e1, p1; float w0, w1; int pad0, pad1; };

DEVI void phase_norm1(const Params& p, int l, int mode, unsigned char* smem) {
    const int lane = TIDX & 63, w = TIDX >> 6;
    MoeTab mt;
    const bool comb = (l > 0) || mode == 1;
    const int lp = mode == 1 ? 1 : l - 1;
    if (comb) mt = moe_tables(p, lp, smem);
    const float* g1 = mode == 1 ? p.in[I_FN] : p.in[I_N1G] + l * 1024;
    for (int row = BIDX * 4 + w; row < TT; row += gridDim.x * 4) {
        const int b = row / TPB, t = row % TPB;
        const bool isctx = t < CTXL;
        if (mode == 1 && isctx) continue;
        const int bi = isctx ? 8 : b;
        float v[16];
        if (!comb) {
            const float* src = isctx ? p.in[I_CTX] + ((size_t)b * CTXL + t) * DM : p.in[I_X] + ((size_t)b * SEQL + (t - CTXL)) * DM;
#pragma unroll
            for (int i = 0; i < 4; ++i) {
                float4 x4 = *(const float4*)(src + i * 256 + lane * 4);
                v[i * 4] = x4.x; v[i * 4 + 1] = x4.y; v[i * 4 + 2] = x4.z; v[i * 4 + 3] = x4.w;
            }
        } else {
            float* xr = XCUR + (size_t)row * DM;
            const Rec rc = ((const Rec*)(p.ws + OFF_REC))[row];
            const bf16_t* y0 = DB(D_YS) + (size_t)(mt.seg[rc.e0] + rc.p0) * 1024;
            const bf16_t* y1 = DB(D_YS) + (size_t)(mt.seg[rc.e1] + rc.p1) * 1024;
            const float* gate = WSF(OFF_MOD) + (size_t)(lp * 9 + bi) * 6144 + 5 * 1024;
#pragma unroll
            for (int i = 0; i < 4; ++i) {
                const int c = i * 256 + lane * 4;
                float4 x4 = *(const float4*)(xr + c);
                float4 g4 = *(const float4*)(gate + c);
                uint2 a = *(const uint2*)(y0 + c), bb = *(const uint2*)(y1 + c);
                float f0 = rc.w0 * __uint_as_float(a.x << 16) + rc.w1 * __uint_as_float(bb.x << 16);
                float f1 = rc.w0 * __uint_as_float(a.x & 0xffff0000u) + rc.w1 * __uint_as_float(bb.x & 0xffff0000u);
                float f2 = rc.w0 * __uint_as_float(a.y << 16) + rc.w1 * __uint_as_float(bb.y << 16);
                float f3 = rc.w0 * __uint_as_float(a.y & 0xffff0000u) + rc.w1 * __uint_as_float(bb.y & 0xffff0000u);
                x4.x += g4.x * f0; x4.y += g4.y * f1; x4.z += g4.z * f2; x4.w += g4.w * f3;
                if (mode == 0) *(float4*)(xr + c) = x4;
                v[i * 4] = x4.x; v[i * 4 + 1] = x4.y; v[i * 4 + 2] = x4.z; v[i * 4 + 3] = x4.w;
            }
        }
        float ss = 0.f;
#pragma unroll
        for (int i = 0; i < 16; ++i) ss += v[i] * v[i];
        ss = wave_sum(ss);
        const float rstd = rsqrtf(ss * (1.f / 1024.f) + EPSV);
        if (mode == 1) {
            float* o = p.out + ((size_t)b * SEQL + (t - CTXL)) * DM;
#pragma unroll
            for (int i = 0; i < 4; ++i) {
                const int c = i * 256 + lane * 4;
                float4 g4 = *(const float4*)(g1 + c);
                float4 r4;
                r4.x = v[i * 4] * rstd * g4.x; r4.y = v[i * 4 + 1] * rstd * g4.y; r4.z = v[i * 4 + 2] * rstd * g4.z; r4.w = v[i * 4 + 3] * rstd * g4.w;
                *(float4*)(o + c) = r4;
            }
        } else {
            const float* md = WSF(OFF_MOD) + (size_t)(l * 9 + bi) * 6144;
            bf16_t* ho = HB + (size_t)row * DM;
#pragma unroll
            for (int i = 0; i < 4; ++i) {
                const int c = i * 256 + lane * 4;
                float4 g4 = *(const float4*)(g1 + c);
                float4 sh = *(const float4*)(md + c);
                float4 sc = *(const float4*)(md + 1024 + c);
                float h0 = v[i * 4] * rstd * g4.x * (1.f + sc.x) + sh.x;
                float h1 = v[i * 4 + 1] * rstd * g4.y * (1.f + sc.y) + sh.y;
                float h2 = v[i * 4 + 2] * rstd * g4.z * (1.f + sc.z) + sh.z;
                float h3 = v[i * 4 + 3] * rstd * g4.w * (1.f + sc.w) + sh.w;
                uint2 o2;
                o2.x = (unsigned)f2bf(h0) | ((unsigned)f2bf(h1) << 16);
                o2.y = (unsigned)f2bf(h2) | ((unsigned)f2bf(h3) << 16);
                *(uint2*)(ho + c) = o2;
            }
        }
    }
}

DEVI void phase_win(const Params& p, int l, unsigned char* smem) {
    bf16_t* ct = (bf16_t*)smem;
    const float* cs64 = WSF(OFF_R64);
    const float* cs32 = WSF(OFF_R32);
    const int ntile = 144 * 30;
    for (int tile = BIDX; tile < ntile; tile += gridDim.x) {
        const int mt = tile / 30, nt = tile % 30;
        const int row0 = mt * 128, b = mt / 18, t0 = (mt % 18) * 128;
        const bool lat = (mt % 18) >= 2;
        const int pos0 = t0 - CTXL;
        f32x4 acc[4][4];
        acc_zero<128>(acc);
        AOp A{HB, 1024, row0, nullptr};
        gemm_core<128>(acc, A, WB(W_IN + (size_t)l * 3840 * 1024 + (size_t)nt * 128 * 1024), 1024, 1024, smem);
        __syncthreads();
        acc_to_ct<128>(acc, ct);
        __syncthreads();
        if (nt < 2) ep_store_rows<128>(ct, 0, CB(C_CQ) + nt * 128, 256, row0);
        else if (nt == 2) ep_store_rows<128>(ct, 0, CB(C_CKV), 128, row0);
        else if (nt < 5) { ep_rope64(ct, nullptr, 1.f, lat, pos0, cs64); __syncthreads(); ep_store_rows<128>(ct, 0, CB(C_RQ) + (nt - 3) * 128, 256, row0); }
        else if (nt < 7) {
            ep_rope64(ct, nullptr, 0.125f, lat, pos0, cs64); __syncthreads();
            ep_store_rows<128>(ct, 0, CB(C_RK) + (nt - 5) * 128, 256, row0);
            ep_store_T(ct, 0, 128, CB(C_RKT) + ((size_t)b * 256 + (nt - 5) * 128) * TPB, TPB, t0);
        }
        else if (nt < 11) ep_store_T(ct, 0, 128, CB(C_RVT) + ((size_t)b * 4 + (nt - 7)) * 128 * TPB, TPB, t0);
        else if (nt < 15) ep_store_rows<128>(ct, 0, CB(C_RG) + (nt - 11) * 128, 512, row0);
        else if (nt < 19) ep_store_rows<128>(ct, 0, CB(C_LX) + (nt - 15) * 128, 512, row0);
        else if (nt < 23) ep_store_rows<128>(ct, 0, CB(C_LG) + (nt - 19) * 128, 512, row0);
        else if (nt < 27) { ep_rope64(ct, p.in[I_GQN] + l * 64, 0.125f * LOG2E, lat, pos0, cs64); __syncthreads(); ep_store_rows<128>(ct, 0, CB(C_GQ) + (nt - 23) * 128, 512, row0); }
        else if (nt == 27) { ep_rope64(ct, p.in[I_GKN] + l * 64, 1.f, lat, pos0, cs64); __syncthreads(); ep_store_rows<128>(ct, 0, CB(C_GK), 128, row0); }
        else if (nt == 28) ep_store_T(ct, 0, 128, CB(C_GVT) + (size_t)b * 128 * TPB, TPB, t0);
        else { ep_rope32(ct, 1, nullptr, 1.f, lat, pos0, cs32); __syncthreads(); ep_store_rows<32>(ct, 0, CB(C_KR), 32, row0); }
        __syncthreads();
    }
}

DEVI void phase_mla_up(const Params& p, int l, unsigned char* smem) {
    bf16_t* ct = (bf16_t*)smem;
    float* rstd = (float*)(smem + AUX_OFF);
    const float* cs32 = WSF(OFF_R32);
    const float qscale = 0.10206207261596575f * LOG2E;
    const int nq = (l == 0 ? 144 : 128) * 6;
    const int nkv = 144 * 8;
    for (int tile = BIDX; tile < nq + nkv; tile += gridDim.x) {
        if (tile < nq) {
            const int mt = mt_of(tile / 6, l != 0), nt = tile % 6;
            const int row0 = mt * 128, t0 = (mt % 18) * 128;
            const bool lat = (mt % 18) >= 2;
            f32x4 acc[4][4];
            acc_zero<128>(acc);
            AOp A{CB(C_CQ), 256, row0, nullptr};
            gemm_core<128>(acc, A, WB(W_UQ + (size_t)l * 768 * 256 + (size_t)nt * 128 * 256), 256, 256, smem);
            __syncthreads();
            acc_to_ct<128>(acc, ct);
            ep_rstd(CB(C_CQ), 256, row0, 256, rstd);
            __syncthreads();
            if (nt < 4) {
                ep_scale_rows(ct, 0, 128, rstd, qscale); __syncthreads();
                ep_store_rows<64>(ct, 0, CB(C_MQ) + (nt * 2) * 96, 768, row0);
                ep_store_rows<64>(ct, 64, CB(C_MQ) + (nt * 2 + 1) * 96, 768, row0);
            } else {
                ep_rope32(ct, 4, rstd, qscale, lat, t0 - CTXL, cs32); __syncthreads();
#pragma unroll
                for (int g = 0; g < 4; ++g) ep_store_rows<32>(ct, g * 32, CB(C_MQ) + ((nt - 4) * 4 + g) * 96 + 64, 768, row0);
            }
            __syncthreads();
        } else {
            const int tk = tile - nq;
            const int mt = tk / 8, nt = tk % 8;
            const int row0 = mt * 128, b = mt / 18, t0 = (mt % 18) * 128;
            f32x4 acc[4][4];
            acc_zero<128>(acc);
            AOp A{CB(C_CKV), 128, row0, nullptr};
            gemm_core<128>(acc, A, WB(W_UKV + (size_t)l * 1024 * 128 + (size_t)nt * 128 * 128), 128, 128, smem);
            __syncthreads();
            acc_to_ct<128>(acc, ct);
            ep_rstd(CB(C_CKV), 128, row0, 128, rstd);
            __syncthreads();
            ep_scale_rows(ct, 0, 128, rstd, 1.f); __syncthreads();
            ep_store_rows<64>(ct, 0, CB(C_KN) + nt * 64, 512, row0);
            ep_store_T(ct, 64, 64, CB(C_VMT) + ((size_t)b * 8 + nt) * 64 * TPB, TPB, t0);
            __syncthreads();
        }
    }
}

template <int DK, bool MLA>
DEVI void attn_naive_wave(const Params& p, int b, int t0, int hq) {
    const int lane = TIDX & 63;
    const int t = t0 + lane, row = b * TPB + t;
    const int nkeys = (t0 < CTXL) ? CTXL : TPB;
    float q[DK];
    const bf16_t* qp = MLA ? CB(C_MQ) + (size_t)row * 768 + hq * 96 : CB(C_GQ) + (size_t)row * 512 + hq * 64;
#pragma unroll
    for (int c = 0; c < DK / 8; ++c) {
        bf16x8 tq = *(const bf16x8*)(qp + c * 8);
#pragma unroll
        for (int e = 0; e < 8; ++e) q[c * 8 + e] = bf2f((bf16_t)tq[e]);
    }
    float acc[64];
#pragma unroll
    for (int d = 0; d < 64; ++d) acc[d] = 0.f;
    float m = -1e30f, lsum = 0.f;
    const int hk = MLA ? hq : (hq >> 2);
    const bf16_t* vT = MLA ? CB(C_VMT) + ((size_t)b * 8 + hk) * 64 * TPB : CB(C_GVT) + ((size_t)b * 2 + hk) * 64 * TPB;
    for (int kt = 0; kt < nkeys; ++kt) {
        const size_t krow = (size_t)b * TPB + kt;
        float s = 0.f;
        const bf16_t* kp = MLA ? CB(C_KN) + krow * 512 + hk * 64 : CB(C_GK) + krow * 128 + hk * 64;
#pragma unroll
        for (int c = 0; c < 8; ++c) {
            bf16x8 tk = *(const bf16x8*)(kp + c * 8);
#pragma unroll
            for (int e = 0; e < 8; ++e) s += q[c * 8 + e] * bf2f((bf16_t)tk[e]);
        }
        if (MLA) {
            const bf16_t* rp = CB(C_KR) + krow * 32;
#pragma unroll
            for (int c = 0; c < 4; ++c) {
                bf16x8 tk = *(const bf16x8*)(rp + c * 8);
#pragma unroll
                for (int e = 0; e < 8; ++e) s += q[(DK - 32) + c * 8 + e] * bf2f((bf16_t)tk[e]);
            }
        }
        const float mn = fmaxf(m, s);
        const float alpha = exp2f(m - mn), pp = exp2f(s - mn);
        lsum = lsum * alpha + pp;
#pragma unroll
        for (int d = 0; d < 64; ++d) acc[d] = acc[d] * alpha + pp * bf2f(vT[(size_t)d * TPB + kt]);
        m = mn;
    }
    const float inv = 1.f / lsum;
    bf16_t* op = (MLA ? DB(D_YA) : DB(D_YD)) + (size_t)row * 512 + hq * 64;
#pragma unroll
    for (int c = 0; c < 8; ++c) {
        bf16x8 o;
#pragma unroll
        for (int e = 0; e < 8; ++e) o[e] = (short)f2bf(acc[c * 8 + e] * inv);
        *(bf16x8*)(op + c * 8) = o;
    }
}


template <int DK, bool MLA>
DEVI void attn_task(const Params& p, int b, int hsel, int tq0, int nkeys, unsigned char* smem) {
    constexpr int KLD = DK + 8;
    constexpr int CK = DK / 8;
    constexpr int NKC = 64 * CK / 256;
    constexpr int VLD = 68;
    constexpr int KBYTES = 64 * KLD * 2, VBYTES = 64 * VLD * 2, STAGE = KBYTES + VBYTES;
    static_assert(2 * STAGE <= SMEM_BYTES, "attn lds");
    const int tid = TIDX, lane = tid & 63, w = tid >> 6, qc = lane & 31, hh = lane >> 5;
    const int tq = MLA ? tq0 + w * 32 + qc : tq0 + qc;
    const int hq = MLA ? hsel : hsel * 4 + w;
    const size_t qrow = (size_t)b * TPB + tq;
    const bf16_t* qp = MLA ? CB(C_MQ) + qrow * 768 + hq * 96 : CB(C_GQ) + qrow * 512 + hq * 64;
    bf16x8 qf[DK / 16];
#pragma unroll
    for (int ks = 0; ks < DK / 16; ++ks) qf[ks] = *(const bf16x8*)(qp + ks * 16 + hh * 8);
    const bf16_t* ksrc[NKC]; int kstep[NKC], kdst[NKC];
#pragma unroll
    for (int i = 0; i < NKC; ++i) {
        const int q = tid + 256 * i, key = q / CK, ch = q % CK;
        if (MLA) {
            if (ch < 8) { ksrc[i] = CB(C_KN) + ((size_t)b * TPB + key) * 512 + hsel * 64 + ch * 8; kstep[i] = 64 * 512; }
            else { ksrc[i] = CB(C_KR) + ((size_t)b * TPB + key) * 32 + (ch - 8) * 8; kstep[i] = 64 * 32; }
        } else { ksrc[i] = CB(C_GK) + ((size_t)b * TPB + key) * 128 + hsel * 64 + ch * 8; kstep[i] = 64 * 128; }
        kdst[i] = (key * KLD + ch * 8) * 2;
    }
    const bf16_t* vT = MLA ? CB(C_VMT) + ((size_t)b * 8 + hsel) * 64 * TPB : CB(C_GVT) + ((size_t)b * 2 + hsel) * 64 * TPB;
    const bf16_t* vsrc[2]; int vdst[2];
#pragma unroll
    for (int i = 0; i < 2; ++i) {
        const int q = tid + 256 * i, dv = q >> 3, ch = q & 7;
        vsrc[i] = vT + (size_t)dv * TPB + ch * 8;
        vdst[i] = KBYTES + (dv * VLD + ch * 8) * 2;
    }
    bf16x8 kr[NKC], vr[2];
#pragma unroll
    for (int i = 0; i < NKC; ++i) kr[i] = *(const bf16x8*)(ksrc[i]);
#pragma unroll
    for (int i = 0; i < 2; ++i) vr[i] = *(const bf16x8*)(vsrc[i]);
    __syncthreads();
#pragma unroll
    for (int i = 0; i < NKC; ++i) *(bf16x8*)(smem + kdst[i]) = kr[i];
#pragma unroll
    for (int i = 0; i < 2; ++i) {
        *(bf16x4*)(smem + vdst[i]) = bf16x4{vr[i][0], vr[i][1], vr[i][2], vr[i][3]};
        *(bf16x4*)(smem + vdst[i] + 8) = bf16x4{vr[i][4], vr[i][5], vr[i][6], vr[i][7]};
    }
    __syncthreads();
    f32x16 o0, o1;
#pragma unroll
    for (int r = 0; r < 16; ++r) { o0[r] = 0.f; o1[r] = 0.f; }
    float m = -1e30f, lsum = 0.f;
    const int nt = nkeys >> 6;
    for (int it = 0; it < nt; ++it) {
        const unsigned char* cur = smem + (it & 1) * STAGE;
        if (it + 1 < nt) {
#pragma unroll
            for (int i = 0; i < NKC; ++i) kr[i] = *(const bf16x8*)(ksrc[i] + (size_t)(it + 1) * kstep[i]);
#pragma unroll
            for (int i = 0; i < 2; ++i) vr[i] = *(const bf16x8*)(vsrc[i] + (it + 1) * 64);
        }
        f32x16 s0, s1;
#pragma unroll
        for (int r = 0; r < 16; ++r) { s0[r] = 0.f; s1[r] = 0.f; }
#pragma unroll
        for (int ks = 0; ks < DK / 16; ++ks) {
            bf16x8 a0 = *(const bf16x8*)(cur + (qc * KLD + ks * 16 + hh * 8) * 2);
            bf16x8 a1 = *(const bf16x8*)(cur + ((32 + qc) * KLD + ks * 16 + hh * 8) * 2);
            s0 = __builtin_amdgcn_mfma_f32_32x32x16_bf16(a0, qf[ks], s0, 0, 0, 0);
            s1 = __builtin_amdgcn_mfma_f32_32x32x16_bf16(a1, qf[ks], s1, 0, 0, 0);
        }
        float mx = s0[0];
#pragma unroll
        for (int r = 1; r < 16; ++r) mx = fmaxf(mx, s0[r]);
#pragma unroll
        for (int r = 0; r < 16; ++r) mx = fmaxf(mx, s1[r]);
        mx = fmaxf(mx, __shfl_xor(mx, 32));
        const float mn = fmaxf(m, mx);
        const float alpha = __builtin_amdgcn_exp2f(m - mn);
        m = mn;
        float ps = 0.f;
#pragma unroll
        for (int r = 0; r < 16; ++r) { s0[r] = __builtin_amdgcn_exp2f(s0[r] - mn); ps += s0[r]; }
#pragma unroll
        for (int r = 0; r < 16; ++r) { s1[r] = __builtin_amdgcn_exp2f(s1[r] - mn); ps += s1[r]; }
        lsum = lsum * alpha + ps;
#pragma unroll
        for (int r = 0; r < 16; ++r) { o0[r] *= alpha; o1[r] *= alpha; }
        bf16x8 pf[2][2];
#pragma unroll
        for (int s = 0; s < 2; ++s)
#pragma unroll
            for (int j = 0; j < 8; ++j) { pf[0][s][j] = (short)f2bf(s0[8 * s + j]); pf[1][s][j] = (short)f2bf(s1[8 * s + j]); }
        const unsigned char* cv = cur + KBYTES;
#pragma unroll
        for (int a = 0; a < 2; ++a)
#pragma unroll
            for (int s = 0; s < 2; ++s) {
                const int keyoff = a * 32 + 16 * s + 4 * hh;
                bf16x4 l0 = *(const bf16x4*)(cv + (qc * VLD + keyoff) * 2);
                bf16x4 h0 = *(const bf16x4*)(cv + (qc * VLD + keyoff + 8) * 2);
                bf16x4 l1 = *(const bf16x4*)(cv + ((32 + qc) * VLD + keyoff) * 2);
                bf16x4 h1 = *(const bf16x4*)(cv + ((32 + qc) * VLD + keyoff + 8) * 2);
                bf16x8 v0 = bf16x8{l0[0], l0[1], l0[2], l0[3], h0[0], h0[1], h0[2], h0[3]};
                bf16x8 v1 = bf16x8{l1[0], l1[1], l1[2], l1[3], h1[0], h1[1], h1[2], h1[3]};
                o0 = __builtin_amdgcn_mfma_f32_32x32x16_bf16(v0, pf[a][s], o0, 0, 0, 0);
                o1 = __builtin_amdgcn_mfma_f32_32x32x16_bf16(v1, pf[a][s], o1, 0, 0, 0);
            }
        if (it + 1 < nt) {
            unsigned char* nxt = smem + ((it + 1) & 1) * STAGE;
#pragma unroll
            for (int i = 0; i < NKC; ++i) *(bf16x8*)(nxt + kdst[i]) = kr[i];
#pragma unroll
            for (int i = 0; i < 2; ++i) {
                *(bf16x4*)(nxt + vdst[i]) = bf16x4{vr[i][0], vr[i][1], vr[i][2], vr[i][3]};
                *(bf16x4*)(nxt + vdst[i] + 8) = bf16x4{vr[i][4], vr[i][5], vr[i][6], vr[i][7]};
            }
        }
        __syncthreads();
    }
    lsum += __shfl_xor(lsum, 32);
    const float inv = 1.f / lsum;
    bf16_t* op = (MLA ? DB(D_YA) : DB(D_YD)) + qrow * 512 + hq * 64;
#pragma unroll
    for (int g = 0; g < 4; ++g) {
        bf16x4 a, c;
#pragma unroll
        for (int e = 0; e < 4; ++e) { a[e] = (short)f2bf(o0[g * 4 + e] * inv); c[e] = (short)f2bf(o1[g * 4 + e] * inv); }
        *(bf16x4*)(op + 8 * g + 4 * hh) = a;
        *(bf16x4*)(op + 32 + 8 * g + 4 * hh) = c;
    }
}

DEVI int proc_tok(int dir, int pidx) { return dir == 0 ? pidx : (pidx < CTXL ? CTXL - 1 - pidx : (CTXL + TPB - 1) - pidx); }

DEVI void retention_naive(const Params& p, int l, int task) {
    const int b = task >> 2, h = task & 3;
    const int dir = TIDX >> 7, dv = TIDX & 127;
    const float dec = p.in[I_RDEC][l * 8 + dir * 4 + h];
    const float lg = -log1pf(expf(-dec));
    const float g = expf(lg);
    float S[64];
#pragma unroll
    for (int d = 0; d < 64; ++d) S[d] = 0.f;
    const bf16_t* vT = CB(C_RVT) + (((size_t)b * 4 + h) * 128 + dv) * TPB;
    bf16_t* outp = (dir == 0 ? DB(D_OF) : DB(D_OB));
    for (int pi = 0; pi < TPB; ++pi) {
        const int u = proc_tok(dir, pi);
        const size_t row = (size_t)b * TPB + u;
        const bf16_t* qp = CB(C_RQ) + row * 256 + h * 64;
        const bf16_t* kp = CB(C_RK) + row * 256 + h * 64;
        const float v = bf2f(vT[u]);
        float o = 0.f;
#pragma unroll
        for (int c = 0; c < 8; ++c) {
            bf16x8 tq = *(const bf16x8*)(qp + c * 8);
            bf16x8 tk = *(const bf16x8*)(kp + c * 8);
#pragma unroll
            for (int e = 0; e < 8; ++e) {
                const int d = c * 8 + e;
                const float qd = bf2f((bf16_t)tq[e]), kd = bf2f((bf16_t)tk[e]);
                if (dir == 0) { S[d] = g * S[d] + kd * v; o += qd * S[d]; }
                else { S[d] = g * S[d]; o += qd * S[d]; S[d] += kd * v; }
            }
        }
        outp[row * 512 + h * 128 + dv] = f2bf(o);
    }
}

DEVI void lru_naive_wave(const Params& p, int l, int task) {
    const int lane = TIDX & 63;
    const int b = task >> 4, d = (task >> 3) & 1, blk = task & 7;
    const int ch = blk * 64 + lane;
    float cw[4];
#pragma unroll
    for (int j = 0; j < 4; ++j) cw[j] = p.in[I_LCW][(l * 4 + j) * 512 + ch];
    const float cb = p.in[I_LCB][l * 512 + ch];
    const float ba = p.in[I_LBA][(l * 2 + d) * 512 + ch], bx = p.in[I_LBX][(l * 2 + d) * 512 + ch];
    const float lam = p.in[I_LLAM][(l * 2 + d) * 512 + ch];
    const float sp = log1pf(expf(-lam));
    const float* Wa = p.in[I_LWA] + ((size_t)(l * 2 + d) * 8 + blk) * 4096;
    const float* Wx = p.in[I_LWX] + ((size_t)(l * 2 + d) * 8 + blk) * 4096;
    float h = 0.f;
    bf16_t* outp = (d == 0 ? DB(D_LH0) : DB(D_LH1));
    for (int pi = 0; pi < TPB; ++pi) {
        const int u = proc_tok(d, pi);
        const int lo = u < CTXL ? 0 : CTXL, hi = u < CTXL ? CTXL : TPB;
        const size_t row = (size_t)b * TPB + u;
        float uval = cb;
#pragma unroll
        for (int j = 0; j < 4; ++j) {
            const int tt = u - 2 + j;
            if (tt >= lo && tt < hi) uval += cw[j] * bf2f(CB(C_LX)[((size_t)b * TPB + tt) * 512 + ch]);
        }
        float rp = 0.f, ip = 0.f;
        for (int c = 0; c < 64; ++c) {
            const float uc = __shfl(uval, c);
            rp += uc * Wa[c * 64 + lane];
            ip += uc * Wx[c * 64 + lane];
        }
        const float r = sigmoidf_(rp + ba), ig = sigmoidf_(ip + bx);
        const float la = -8.f * r * sp;
        const float a = expf(la);
        const float bb = sqrtf(-expm1f(2.f * la)) * (ig * uval);
        h = a * h + bb;
        outp[row * 512 + ch] = f2bf(h);
    }
}


DEVI void retention_walk(const Params& p, int l, int task, unsigned char* smem) {
    constexpr int PLD = 136;
    const int b = task >> 3, h = (task >> 1) & 3, dir = task & 1;
    const int tid = TIDX, lane = tid & 63, w = tid >> 6, qc = lane & 31, hh = lane >> 5;
    const float dec = p.in[I_RDEC][l * 8 + dir * 4 + h];
    const float lg2 = -log1pf(expf(-dec)) * LOG2E;
    const float cdec = exp2f(lg2 * 128.f);
    bf16_t* P = (bf16_t*)smem;
    f32x16 S0, S1;
#pragma unroll
    for (int r = 0; r < 16; ++r) { S0[r] = 0.f; S1[r] = 0.f; }
    const bf16_t* Kg = CB(C_RK) + (size_t)b * TPB * 256 + h * 64;
    const bf16_t* Qg = CB(C_RQ) + (size_t)b * TPB * 256 + h * 64;
    const bf16_t* KTg = CB(C_RKT) + ((size_t)b * 4 + h) * 64 * TPB;
    const bf16_t* VTg = CB(C_RVT) + (((size_t)b * 4 + h) * 128 + w * 32 + qc) * TPB;
    bf16_t* outp = (dir == 0 ? DB(D_OF) : DB(D_OB)) + (size_t)b * TPB * 512 + h * 128 + w * 32;
    const int iq = 32 * w + qc;
    for (int cc = 0; cc < 18; ++cc) {
        const int mch = dir == 0 ? cc : (cc < 2 ? 1 - cc : 19 - cc);
        const int t0 = mch * 128;
        bf16x8 vf[8];
#pragma unroll
        for (int ks = 0; ks < 8; ++ks) vf[ks] = *(const bf16x8*)(VTg + t0 + ks * 16 + hh * 8);
        bf16x8 qf[4];
        {
            const bf16_t* qrow = Qg + (size_t)(t0 + iq) * 256;
#pragma unroll
            for (int ks = 0; ks < 4; ++ks) qf[ks] = *(const bf16x8*)(qrow + ks * 16 + hh * 8);
        }
        __syncthreads();
#pragma unroll 1
        for (int js = 0; js < 4; ++js) {
            f32x16 sc;
#pragma unroll
            for (int r = 0; r < 16; ++r) sc[r] = 0.f;
            const bf16_t* krow = Kg + (size_t)(t0 + 32 * js + qc) * 256;
#pragma unroll
            for (int ks = 0; ks < 4; ++ks) {
                bf16x8 a = *(const bf16x8*)(krow + ks * 16 + hh * 8);
                sc = __builtin_amdgcn_mfma_f32_32x32x16_bf16(a, qf[ks], sc, 0, 0, 0);
            }
#pragma unroll
            for (int g = 0; g < 4; ++g) {
                bf16x4 pk;
#pragma unroll
                for (int e = 0; e < 4; ++e) {
                    const int j = 32 * js + 8 * g + 4 * hh + e;
                    const int d = iq - j;
                    float wgt;
                    if (dir == 0) wgt = d >= 0 ? __builtin_amdgcn_exp2f(lg2 * (float)d) : 0.f;
                    else wgt = d < 0 ? __builtin_amdgcn_exp2f(lg2 * (float)(-d)) : 0.f;
                    pk[e] = (short)f2bf(sc[4 * g + e] * wgt);
                }
                *(bf16x4*)(P + iq * PLD + 32 * js + 8 * g + 4 * hh) = pk;
            }
        }
        __syncthreads();
        bf16x8 sf[2][2];
#pragma unroll
        for (int s = 0; s < 2; ++s)
#pragma unroll
            for (int j = 0; j < 8; ++j) { sf[0][s][j] = (short)f2bf(S0[8 * s + j]); sf[1][s][j] = (short)f2bf(S1[8 * s + j]); }
#pragma unroll 1
        for (int isub = 0; isub < 4; ++isub) {
            const int ii = 32 * isub + qc;
            const bf16_t* qr = Qg + (size_t)(t0 + ii) * 256;
            f32x16 o;
#pragma unroll
            for (int r = 0; r < 16; ++r) o[r] = 0.f;
#pragma unroll
            for (int sub = 0; sub < 2; ++sub)
#pragma unroll
                for (int s = 0; s < 2; ++s) {
                    const int dk0 = 32 * sub + 16 * s + 4 * hh;
                    bf16x4 lo = *(const bf16x4*)(qr + dk0), hi = *(const bf16x4*)(qr + dk0 + 8);
                    bf16x8 bq = bf16x8{lo[0], lo[1], lo[2], lo[3], hi[0], hi[1], hi[2], hi[3]};
                    o = __builtin_amdgcn_mfma_f32_32x32x16_bf16(sf[sub][s], bq, o, 0, 0, 0);
                }
            const float qd = dir == 0 ? __builtin_amdgcn_exp2f(lg2 * (float)(ii + 1)) : __builtin_amdgcn_exp2f(lg2 * (float)(128 - ii));
#pragma unroll
            for (int r = 0; r < 16; ++r) o[r] *= qd;
#pragma unroll
            for (int ks = 0; ks < 8; ++ks) {
                bf16x8 pf = *(const bf16x8*)(P + ii * PLD + 16 * ks + 8 * hh);
                o = __builtin_amdgcn_mfma_f32_32x32x16_bf16(vf[ks], pf, o, 0, 0, 0);
            }
            bf16_t* orow = outp + (size_t)(t0 + ii) * 512;
#pragma unroll
            for (int g = 0; g < 4; ++g) {
                bf16x4 pk;
#pragma unroll
                for (int e = 0; e < 4; ++e) pk[e] = (short)f2bf(o[4 * g + e]);
                *(bf16x4*)(orow + 8 * g + 4 * hh) = pk;
            }
        }
#pragma unroll
        for (int r = 0; r < 16; ++r) { S0[r] *= cdec; S1[r] *= cdec; }
#pragma unroll
        for (int ks = 0; ks < 8; ++ks) {
            bf16x8 vs;
#pragma unroll
            for (int e = 0; e < 8; ++e) {
                const int j = 16 * ks + 8 * hh + e;
                const float kd = dir == 0 ? __builtin_amdgcn_exp2f(lg2 * (float)(127 - j)) : __builtin_amdgcn_exp2f(lg2 * (float)j);
                vs[e] = (short)f2bf(bf2f((bf16_t)vf[ks][e]) * kd);
            }
            bf16x8 a0 = *(const bf16x8*)(KTg + (size_t)qc * TPB + t0 + 16 * ks + 8 * hh);
            bf16x8 a1 = *(const bf16x8*)(KTg + (size_t)(32 + qc) * TPB + t0 + 16 * ks + 8 * hh);
            S0 = __builtin_amdgcn_mfma_f32_32x32x16_bf16(a0, vs, S0, 0, 0, 0);
            S1 = __builtin_amdgcn_mfma_f32_32x32x16_bf16(a1, vs, S1, 0, 0, 0);
        }
    }
    __syncthreads();
}

DEVI float fsig(float x) { return __builtin_amdgcn_rcpf(1.f + __expf(-x)); }
DEVI void lru_walk(const Params& p, int l, int task, unsigned char* smem) {
    const int b = task >> 4, d = (task >> 3) & 1, blk = task & 7;
    const int tid = TIDX, lane = tid & 63, w = tid >> 6, ln = lane & 15, g = lane >> 4;
    bf16_t* Wt = (bf16_t*)smem;
    float* uw = (float*)(smem + 18432) + w * 1024;
    float* cpar = (float*)(smem + 34816);
    float* agg = (float*)(smem + 36096);
    __syncthreads();
    {
        const bf16_t* wsrc = WB(W_LRU + ((size_t)(l * 2 + d) * 8 + blk) * 8192);
        for (int c = tid; c < 128 * 8; c += 256) {
            const int n = c >> 3, kc = c & 7;
            *(bf16x8*)(Wt + n * 72 + kc * 8) = *(const bf16x8*)(wsrc + n * 64 + kc * 8);
        }
        if (tid < 64) {
            const int ch = blk * 64 + tid;
#pragma unroll
            for (int j = 0; j < 4; ++j) cpar[j * 64 + tid] = p.in[I_LCW][(l * 4 + j) * 512 + ch];
            cpar[256 + tid] = p.in[I_LCB][l * 512 + ch];
        }
    }
    __syncthreads();
    float ba[4], bx[4], sp[4], hc[4];
#pragma unroll
    for (int ct = 0; ct < 4; ++ct) {
        const int ch = blk * 64 + 16 * ct + ln;
        ba[ct] = p.in[I_LBA][(l * 2 + d) * 512 + ch];
        bx[ct] = p.in[I_LBX][(l * 2 + d) * 512 + ch];
        sp[ct] = log1pf(expf(-p.in[I_LLAM][(l * 2 + d) * 512 + ch]));
        hc[ct] = 0.f;
    }
    const bf16_t* X = CB(C_LX) + (size_t)b * TPB * 512 + blk * 64;
    bf16_t* outp = (d == 0 ? DB(D_LH0) : DB(D_LH1)) + (size_t)b * TPB * 512 + blk * 64;
    for (int c = 0; c < 36; ++c) {
        const int tok = proc_tok(d, 64 * c + 16 * w + ln);
        const int lo = tok < CTXL ? 0 : CTXL, hi = tok < CTXL ? CTXL : TPB;
        bf16x8 af[2];
#pragma unroll
        for (int ks = 0; ks < 2; ++ks) {
            const int c0 = 32 * ks + 8 * g;
            float u8[8];
#pragma unroll
            for (int e = 0; e < 8; ++e) u8[e] = cpar[256 + c0 + e];
#pragma unroll
            for (int j = 0; j < 4; ++j) {
                const int tt = tok - 2 + j;
                if (tt >= lo && tt < hi) {
                    bf16x8 xv = *(const bf16x8*)(X + (size_t)tt * 512 + c0);
#pragma unroll
                    for (int e = 0; e < 8; ++e) u8[e] += cpar[j * 64 + c0 + e] * bf2f((bf16_t)xv[e]);
                }
            }
#pragma unroll
            for (int e = 0; e < 8; ++e) { uw[ln * 64 + c0 + e] = u8[e]; af[ks][e] = (short)f2bf(u8[e]); }
        }
        __builtin_amdgcn_wave_barrier();
        f32x4 acc[8];
#pragma unroll
        for (int nt = 0; nt < 8; ++nt) acc[nt] = f32x4{0.f, 0.f, 0.f, 0.f};
#pragma unroll
        for (int ks = 0; ks < 2; ++ks)
#pragma unroll
            for (int nt = 0; nt < 8; ++nt) {
                bf16x8 bfr = *(const bf16x8*)(Wt + (16 * nt + ln) * 72 + 32 * ks + 8 * g);
                acc[nt] = __builtin_amdgcn_mfma_f32_16x16x32_bf16(af[ks], bfr, acc[nt], 0, 0, 0);
            }
        float A[4][4], B[4][4];
#pragma unroll
        for (int ct = 0; ct < 4; ++ct) {
            float pa = 1.f, pb = 0.f;
#pragma unroll
            for (int j = 0; j < 4; ++j) {
                const float r = fsig(acc[ct][j] + ba[ct]);
                const float ig = fsig(acc[4 + ct][j] + bx[ct]);
                const float la = -8.f * r * sp[ct];
                const float a = __expf(la);
                const float uu = uw[(4 * g + j) * 64 + 16 * ct + ln];
                const float bb = __builtin_amdgcn_sqrtf(fmaxf(1.f - a * a, 0.f)) * ig * uu;
                pb = a * pb + bb; pa = a * pa;
                A[ct][j] = pa; B[ct][j] = pb;
            }
            float ia = pa, ib = pb;
#pragma unroll
            for (int dd = 1; dd <= 2; dd <<= 1) {
                const float qa = __shfl_up(ia, 16 * dd), qb = __shfl_up(ib, 16 * dd);
                if (g >= dd) { ib = ia * qb + ib; ia = ia * qa; }
            }
            float ea = __shfl_up(ia, 16), eb = __shfl_up(ib, 16);
            if (g == 0) { ea = 1.f; eb = 0.f; }
#pragma unroll
            for (int j = 0; j < 4; ++j) { B[ct][j] = A[ct][j] * eb + B[ct][j]; A[ct][j] = A[ct][j] * ea; }
            if (g == 3) {
                float* ag = agg + (((c & 1) * 4 + w) * 64 + 16 * ct + ln) * 2;
                ag[0] = ia; ag[1] = ib;
            }
        }
        __syncthreads();
#pragma unroll
        for (int ct = 0; ct < 4; ++ct) {
            float hrun = hc[ct], hin = 0.f;
#pragma unroll
            for (int w2 = 0; w2 < 4; ++w2) {
                const float* ag = agg + (((c & 1) * 4 + w2) * 64 + 16 * ct + ln) * 2;
                if (w2 == w) hin = hrun;
                hrun = ag[0] * hrun + ag[1];
            }
            hc[ct] = hrun;
#pragma unroll
            for (int j = 0; j < 4; ++j) {
                const int tok2 = proc_tok(d, 64 * c + 16 * w + 4 * g + j);
                outp[(size_t)tok2 * 512 + 16 * ct + ln] = f2bf(A[ct][j] * hin + B[ct][j]);
            }
        }
    }
    __syncthreads();
}

DEVI void phase_mix(const Params& p, int l, unsigned char* smem) {
    const int w = TIDX >> 6;
    const int NRET = 64, NLRU = 128;
    const int NLAT = 1024, NCTX = (l == 0 ? 128 : 0);
    const int ntask = NRET + NLRU + 2 * NLAT + 2 * NCTX;
    for (int task = BIDX; task < ntask; task += gridDim.x) {
        if (task < NRET) retention_walk(p, l, task, smem);
        else if (task < NRET + NLRU) lru_walk(p, l, task - NRET, smem);
        else {
            int a = task - NRET - NLRU;
            int kind, b, hsel, tq0, nkeys;
            if (a < NLAT) { kind = 0; b = a >> 7; const int r = a & 127; hsel = r >> 4; tq0 = CTXL + (r & 15) * 128; nkeys = TPB; }
            else if (a < 2 * NLAT) { a -= NLAT; kind = 1; b = a >> 7; const int r = a & 127; hsel = r >> 6; tq0 = CTXL + (r & 63) * 32; nkeys = TPB; }
            else if (a < 2 * NLAT + NCTX) { a -= 2 * NLAT; kind = 0; b = a >> 4; const int r = a & 15; hsel = r >> 1; tq0 = (r & 1) * 128; nkeys = CTXL; }
            else { a -= 2 * NLAT + NCTX; kind = 1; b = a >> 4; const int r = a & 15; hsel = r >> 3; tq0 = (r & 7) * 32; nkeys = CTXL; }
            if (kind == 0) attn_task<96, true>(p, b, hsel, tq0, nkeys, smem);
            else attn_task<64, false>(p, b, hsel, tq0, nkeys, smem);
        }
    }
}

DEVI void phase_fin(const Params& p, int l) {
    const int lane = TIDX & 63, w = TIDX >> 6;
    for (int row = BIDX * 4 + w; row < TT; row += gridDim.x * 4) {
        if (l == 1 && (row % TPB) < CTXL) continue;
        const size_t o = (size_t)row * 512 + lane * 8;
        bf16x8 f = *(const bf16x8*)(DB(D_OF) + o), bk = *(const bf16x8*)(DB(D_OB) + o), gt = *(const bf16x8*)(CB(C_RG) + o);
        float v[8], s = 0.f;
#pragma unroll
        for (int e = 0; e < 8; ++e) { v[e] = bf2f((bf16_t)f[e]) + bf2f((bf16_t)bk[e]); s += v[e]; }
#pragma unroll
        for (int off = 1; off < 16; off <<= 1) s += __shfl_xor(s, off);
        const float mu = s * (1.f / 128.f);
        float q = 0.f;
#pragma unroll
        for (int e = 0; e < 8; ++e) { v[e] -= mu; q += v[e] * v[e]; }
#pragma unroll
        for (int off = 1; off < 16; off <<= 1) q += __shfl_xor(q, off);
        const float rs = rsqrtf(q * (1.f / 128.f) + EPSV);
        const float* gn = p.in[I_RNORM] + l * 512 + lane * 8;
        bf16x8 ob;
#pragma unroll
        for (int e = 0; e < 8; ++e) ob[e] = (short)f2bf(siluf_(bf2f((bf16_t)gt[e])) * (v[e] * rs * gn[e]));
        *(bf16x8*)(DB(D_OF) + o) = ob;
        bf16x8 h0 = *(const bf16x8*)(DB(D_LH0) + o), h1 = *(const bf16x8*)(DB(D_LH1) + o), lg = *(const bf16x8*)(CB(C_LG) + o);
        bf16x8 oc;
#pragma unroll
        for (int e = 0; e < 8; ++e) oc[e] = (short)f2bf((bf2f((bf16_t)h0[e]) + bf2f((bf16_t)h1[e])) * gelu_tanh(bf2f((bf16_t)lg[e])));
        *(bf16x8*)(DB(D_LH0) + o) = oc;
    }
}

DEVI void phase_merge(const Params& p, int l, unsigned char* smem) {
    bf16_t* ct = (bf16_t*)smem;
    const int lane = TIDX & 63, wc = (TIDX >> 6) & 1;
    const int nmt = (l == 0 ? 144 : 128);
    for (int tile = BIDX; tile < nmt * 16; tile += gridDim.x) {
        const int mt = mt_of(tile >> 4, l != 0), nt = tile & 15;
        const int row0 = mt * 128;
        f32x4 m[4][2];
        acc_zero<64>(m);
        for (int n = 0; n < 4; ++n) {
            f32x4 ag[4][2], ap[4][2];
            acc_zero<64>(ag); acc_zero<64>(ap);
            AOp A1{HB, 1024, row0, nullptr};
            gemm_core<64>(ag, A1, WB(W_MG + (size_t)l * 4096 * 1024 + (size_t)(n * 1024 + nt * 64) * 1024), 1024, 1024, smem);
            const bf16_t* yb = n == 0 ? DB(D_YA) : (n == 1 ? DB(D_OF) : (n == 2 ? DB(D_LH0) : DB(D_YD)));
            AOp A2{yb, 512, row0, nullptr};
            gemm_core<64>(ap, A2, WB(W_BR + ((size_t)l * 4 + n) * 1024 * 512 + (size_t)(nt * 64) * 512), 512, 512, smem);
            const float* bm = p.in[I_BMG] + l * 4096 + n * 1024 + nt * 64 + wc * 32 + (lane & 15);
#pragma unroll
            for (int ni = 0; ni < 2; ++ni) {
                const float bias = bm[ni * 16];
#pragma unroll
                for (int mi = 0; mi < 4; ++mi)
#pragma unroll
                    for (int j = 0; j < 4; ++j) m[mi][ni][j] += sigmoidf_(ag[mi][ni][j] + bias) * ap[mi][ni][j];
            }
        }
        __syncthreads();
        acc_to_ct<64>(m, ct);
        __syncthreads();
        ep_store_rows<64>(ct, 0, CB(C_M) + nt * 64, 1024, row0);
        __syncthreads();
    }
}

DEVI void phase_wout(const Params& p, int l, unsigned char* smem) {
    bf16_t* ct = (bf16_t*)smem;
    const int nmt = (l == 0 ? 144 : 128);
    const int ngemm = nmt * 8, ncvt = 24576;
    for (int task = BIDX; task < ngemm + ncvt; task += gridDim.x) {
        if (task < ngemm) {
            const int mt = mt_of(task >> 3, l != 0), nt = task & 7;
            const int row0 = mt * 128, b = mt / 18, t0 = (mt % 18) * 128;
            const bool isctx = (mt % 18) < 2;
            const int bi = isctx ? 8 : b;
            f32x4 acc[4][4];
            acc_zero<128>(acc);
            AOp A{CB(C_M), 1024, row0, nullptr};
            gemm_core<128>(acc, A, WB(W_OUT + (size_t)l * 1024 * 1024 + (size_t)nt * 128 * 1024), 1024, 1024, smem);
            __syncthreads();
            acc_to_ct<128>(acc, ct);
            __syncthreads();
            const float* gate = WSF(OFF_MOD) + (size_t)(l * 9 + bi) * 6144 + 2 * 1024 + nt * 128;
            for (int c = TIDX; c < 128 * 32; c += 256) {
                const int i = c >> 5, jc = c & 31;
                const int t = t0 + i;
                const float* xs;
                if (l == 0) xs = isctx ? p.in[I_CTX] + ((size_t)b * CTXL + t) * DM : p.in[I_X] + ((size_t)b * SEQL + (t - CTXL)) * DM;
                else xs = XCUR + (size_t)(row0 + i) * DM;
                float4 x4 = *(const float4*)(xs + nt * 128 + jc * 4);
                float4 g4 = *(const float4*)(gate + jc * 4);
                uint2 y = *(const uint2*)(ct + i * CT_LD + jc * 4);
                x4.x += g4.x * __uint_as_float(y.x << 16);
                x4.y += g4.y * __uint_as_float(y.x & 0xffff0000u);
                x4.z += g4.z * __uint_as_float(y.y << 16);
                x4.w += g4.w * __uint_as_float(y.y & 0xffff0000u);
                *(float4*)(XCUR + (size_t)(row0 + i) * DM + nt * 128 + jc * 4) = x4;
            }
            __syncthreads();
        } else {
            int t = task - ngemm;
            const int k = t >> 13; t &= 8191;
            CvtJob j = get_moe_job(p, l, k);
            cvt_tile(j, t, (float*)smem);
        }
    }
}

DEVI void phase_route(const Params& p, int l, unsigned char* smem) {
    const int lane = TIDX & 63, w = TIDX >> 6;
    float* hb = (float*)smem + w * 1024;
    const float* g2 = p.in[I_N2G] + l * 1024;
    const float* rw = p.in[I_RW];
    const float rbias = p.in[I_RB][lane];
    int* cnt = WSI(OFF_CNT) + l * 64;
    int* list = WSI(OFF_LIST);
    for (int row = BIDX * 4 + w; row < TT; row += gridDim.x * 4) {
        const int b = row / TPB, t = row % TPB;
        const bool isctx = t < CTXL;
        if (l == 1 && isctx) continue;
        const int bi = isctx ? 8 : b;
        const float* xr = XCUR + (size_t)row * DM;
        float v[16];
        float ss = 0.f;
#pragma unroll
        for (int i = 0; i < 4; ++i) {
            float4 x4 = *(const float4*)(xr + i * 256 + lane * 4);
            v[i * 4] = x4.x; v[i * 4 + 1] = x4.y; v[i * 4 + 2] = x4.z; v[i * 4 + 3] = x4.w;
            ss += x4.x * x4.x + x4.y * x4.y + x4.z * x4.z + x4.w * x4.w;
        }
        ss = wave_sum(ss);
        const float rstd = rsqrtf(ss * (1.f / 1024.f) + EPSV);
        const float* md = WSF(OFF_MOD) + (size_t)(l * 9 + bi) * 6144 + 3 * 1024;
        bf16_t* ho = HB + (size_t)row * DM;
#pragma unroll
        for (int i = 0; i < 4; ++i) {
            const int c = i * 256 + lane * 4;
            float4 g4 = *(const float4*)(g2 + c);
            float4 sh = *(const float4*)(md + c);
            float4 sc = *(const float4*)(md + 1024 + c);
            float4 h4;
            h4.x = v[i * 4] * rstd * g4.x * (1.f + sc.x) + sh.x;
            h4.y = v[i * 4 + 1] * rstd * g4.y * (1.f + sc.y) + sh.y;
            h4.z = v[i * 4 + 2] * rstd * g4.z * (1.f + sc.z) + sh.z;
            h4.w = v[i * 4 + 3] * rstd * g4.w * (1.f + sc.w) + sh.w;
            uint2 o2;
            o2.x = (unsigned)f2bf(h4.x) | ((unsigned)f2bf(h4.y) << 16);
            o2.y = (unsigned)f2bf(h4.z) | ((unsigned)f2bf(h4.w) << 16);
            *(uint2*)(ho + c) = o2;
            *(float4*)(hb + c) = h4;
        }
        __builtin_amdgcn_wave_barrier();
        float lg = 0.f;
#pragma unroll 8
        for (int k = 0; k < 1024; ++k) lg += hb[k] * rw[k * 64 + lane];
        __builtin_amdgcn_wave_barrier();
        const float score = sigmoidf_(lg);
        const float biased = score + rbias;
        float v1 = biased; int i1 = lane;
#pragma unroll
        for (int off = 1; off < 8; off <<= 1) {
            float ov = __shfl_xor(v1, off); int oi = __shfl_xor(i1, off);
            if (ov > v1 || (ov == v1 && oi < i1)) { v1 = ov; i1 = oi; }
        }
        float v2 = (lane == i1) ? -3.0e38f : biased; int i2 = lane;
#pragma unroll
        for (int off = 1; off < 8; off <<= 1) {
            float ov = __shfl_xor(v2, off); int oi = __shfl_xor(i2, off);
            if (ov > v2 || (ov == v2 && oi < i2)) { v2 = ov; i2 = oi; }
        }
        float gv = v1 + v2; int gi = lane >> 3;
#pragma unroll
        for (int off = 8; off < 64; off <<= 1) {
            float ov = __shfl_xor(gv, off); int oi = __shfl_xor(gi, off);
            if (ov > gv || (ov == gv && oi < gi)) { gv = ov; gi = oi; }
        }
        const int e0 = __shfl(i1, gi * 8), e1 = __shfl(i2, gi * 8);
        const float s0 = __shfl(score, e0), s1 = __shfl(score, e1);
        if (lane == 0) {
            Rec rc;
            rc.e0 = e0; rc.e1 = e1;
            rc.p0 = atomicAdd(&cnt[e0], 1);
            rc.p1 = atomicAdd(&cnt[e1], 1);
            const float inv = 1.f / (s0 + s1);
            rc.w0 = s0 * inv; rc.w1 = s1 * inv; rc.pad0 = 0; rc.pad1 = 0;
            list[(size_t)e0 * TT + rc.p0] = row;
            list[(size_t)e1 * TT + rc.p1] = row;
            ((Rec*)(p.ws + OFF_REC))[row] = rc;
        }
    }
}

DEVI void phase_moe1(const Params& p, int l, unsigned char* smem) {
    bf16_t* ct = (bf16_t*)smem;
    int* ridx = (int*)(smem + AUX_OFF);
    MoeTab mt = moe_tables(p, l, smem);
    const int* list = WSI(OFF_LIST);
    const int ntile = mt.tp[64] * 4;
    for (int tile = BIDX; tile < ntile; tile += gridDim.x) {
        const int rt = tile >> 2, nt = tile & 3;
        int e = 0;
        while (mt.tp[e + 1] <= rt) ++e;
        const int jt = rt - mt.tp[e];
        if (TIDX < 128) {
            const int idx = jt * 128 + TIDX;
            ridx[TIDX] = list[(size_t)e * TT + (idx < mt.cnt[e] ? idx : 0)];
        }
        __syncthreads();
        f32x4 acc[4][4];
        acc_zero<128>(acc);
        AOp A{HB, 1024, 0, ridx};
        gemm_core<128>(acc, A, CB(C_W13) + ((size_t)e * 512 + nt * 128) * 1024, 1024, 1024, smem);
        __syncthreads();
        acc_to_ct<128>(acc, ct);
        __syncthreads();
        const int slot0 = mt.seg[e] + jt * 128;
        for (int c = TIDX; c < 128 * 8; c += 256) {
            const int i = c >> 3, jc = c & 7;
            bf16x8 a = *(const bf16x8*)(ct + i * CT_LD + jc * 8), g = *(const bf16x8*)(ct + i * CT_LD + 64 + jc * 8), o;
#pragma unroll
            for (int q = 0; q < 8; ++q) o[q] = (short)f2bf(siluf_(bf2f((bf16_t)a[q])) * bf2f((bf16_t)g[q]));
            *(bf16x8*)(DB(D_ACT) + (size_t)(slot0 + i) * 256 + nt * 64 + jc * 8) = o;
        }
        __syncthreads();
    }
}
DEVI void phase_moe2(const Params& p, int l, unsigned char* smem) {
    bf16_t* ct = (bf16_t*)smem;
    MoeTab mt = moe_tables(p, l, smem);
    const int ntile = mt.tp[64] * 8;
    for (int tile = BIDX; tile < ntile; tile += gridDim.x) {
        const int rt = tile >> 3, nt = tile & 7;
        int e = 0;
        while (mt.tp[e + 1] <= rt) ++e;
        const int jt = rt - mt.tp[e];
        const int slot0 = mt.seg[e] + jt * 128;
        f32x4 acc[4][4];
        acc_zero<128>(acc);
        AOp A{DB(D_ACT), 256, slot0, nullptr};
        gemm_core<128>(acc, A, CB(C_W2) + ((size_t)e * 1024 + nt * 128) * 256, 256, 256, smem);
        __syncthreads();
        acc_to_ct<128>(acc, ct);
        __syncthreads();
        ep_store_rows<128>(ct, 0, DB(D_YS) + nt * 128, 1024, slot0);
        __syncthreads();
    }
}

constexpr int NPHASE = 22;
DEVI void run_phase(const Params& p, int ph, unsigned char* smem) {
#ifndef ONLYK
    if (ph == 0) { phase0(p, smem); return; }
    if (ph == 21) { phase_norm1(p, 1, 1, smem); return; }
#endif
    const int l = (ph - 1) / 10, k = (ph - 1) % 10;
#ifdef ONLYK
    if (k != ONLYK) return;
#endif
    switch (k) {
    case 0: phase_norm1(p, l, 0, smem); break;
    case 1: phase_win(p, l, smem); break;
    case 2: phase_mla_up(p, l, smem); break;
    case 3: phase_mix(p, l, smem); break;
    case 4: phase_fin(p, l); break;
    case 5: phase_merge(p, l, smem); break;
    case 6: phase_wout(p, l, smem); break;
    case 7: phase_route(p, l, smem); break;
    case 8: phase_moe1(p, l, smem); break;
    default: phase_moe2(p, l, smem); break;
    }
}

__global__ void __launch_bounds__(256, 2) k_main(Params p, int ph_lo, int ph_hi) {
    __shared__ __attribute__((aligned(16))) unsigned char smem[SMEM_BYTES];
    for (int ph = ph_lo; ph < ph_hi; ++ph) {
        run_phase(p, ph, smem);
        if (ph + 1 < ph_hi) { cg::this_grid().sync(); }
    }
}

extern "C" void kernel_launch(void* const* d_in, const int* in_sizes, int n_in, void* d_out, int out_size, void* d_ws, size_t ws_size,
                              hipStream_t stream) {
    if (ws_size < WS_NEED || n_in < N_IN) { fprintf(stderr, "workspace too small: %zu < %zu\n", ws_size, (size_t)WS_NEED); return; }
    Params p{};
    for (int i = 0; i < N_IN; ++i) p.in[i] = (const float*)d_in[i];
    p.out = (float*)d_out;
    p.ws = (unsigned char*)d_ws;
    static int grid_blocks = 0;
    if (!grid_blocks) {
        int dev = 0, cus = 0, per_cu = 0;
        hipGetDevice(&dev);
        hipDeviceGetAttribute(&cus, hipDeviceAttributeMultiprocessorCount, dev);
        hipOccupancyMaxActiveBlocksPerMultiprocessor(&per_cu, k_main, 256, 0);
        if (per_cu > 2) per_cu = 2;
        if (per_cu < 1) per_cu = 1;
        grid_blocks = cus * per_cu;
    }
#if ONE_LAUNCH
    int lo = 0, hi = NPHASE;
    void* args[] = {&p, &lo, &hi};
    hipError_t e = hipLaunchCooperativeKernel((void*)k_main, dim3(grid_blocks), dim3(256), args, 0, stream);
    if (e != hipSuccess) fprintf(stderr, "cooperative launch failed: %s (grid %d)\n", hipGetErrorString(e), grid_blocks);
#else
    for (int ph = 0; ph < NPHASE; ++ph) hipLaunchKernelGGL(k_main, dim3(grid_blocks), dim3(256), 0, stream, p, ph, ph + 1);
#endif
}
```

```cpp
#include <hip/hip_runtime.h>
#include <hip/hip_cooperative_groups.h>
#include <stdint.h>
#include <stdio.h>
namespace cg = cooperative_groups;

#define DEVI __device__ __forceinline__
typedef unsigned short bf16_t;
typedef __attribute__((ext_vector_type(8))) short bf16x8;
typedef __attribute__((ext_vector_type(4))) float f32x4;
typedef __attribute__((ext_vector_type(16))) float f32x16;
typedef __attribute__((ext_vector_type(4))) short bf16x4;

#ifndef NAIVE_GEMM
#define NAIVE_GEMM 0
#endif
#ifndef ONE_LAUNCH
#define ONE_LAUNCH 1
#endif

constexpr int DM = 1024, NBT = 8, SEQL = 2048, CTXL = 256, TPB = 2304, TT = 18432;
constexpr int DINP = 3840;
constexpr float LOG2E = 1.4426950408889634f;
constexpr float EPSV = 1e-6f;
constexpr int NSLOT = 2 * TT + 64 * 128;

enum { I_X = 0, I_C, I_CTX, I_CCTX, I_ADAW, I_ADAB, I_N1G, I_N2G, I_WIN, I_MQN, I_MKVN, I_WUQ, I_WUKV, I_RDEC, I_RNORM,
       I_LCW, I_LCB, I_LWA, I_LBA, I_LWX, I_LBX, I_LLAM, I_GQN, I_GKN, I_WBR, I_WMG, I_BMG, I_WOUT, I_RW, I_RB,
       I_W1, I_W3, I_W2, I_FN, N_IN };

constexpr size_t AL(size_t x) { return (x + 255) & ~(size_t)255; }
constexpr size_t OFF_BAR = 0;
constexpr size_t OFF_CNT = 16384;
constexpr size_t OFF_MOD = OFF_CNT + 4096;
constexpr size_t OFF_R64 = AL(OFF_MOD + (size_t)2 * 9 * 6144 * 4);
constexpr size_t OFF_R32 = OFF_R64 + (size_t)2048 * 64 * 4;
constexpr size_t OFF_REC = OFF_R32 + (size_t)2048 * 32 * 4;
constexpr size_t OFF_LIST = OFF_REC + (size_t)TT * 32;
constexpr size_t OFF_W = AL(OFF_LIST + (size_t)64 * TT * 4);
constexpr size_t W_IN = 0;
constexpr size_t W_UQ = W_IN + (size_t)2 * 3840 * 1024;
constexpr size_t W_UKV = W_UQ + (size_t)2 * 768 * 256;
constexpr size_t W_BR = W_UKV + (size_t)2 * 1024 * 128;
constexpr size_t W_MG = W_BR + (size_t)2 * 4 * 1024 * 512;
constexpr size_t W_OUT = W_MG + (size_t)2 * 4096 * 1024;
constexpr size_t W_LRU = W_OUT + (size_t)2 * 1024 * 1024;
constexpr size_t W_END = W_LRU + (size_t)2 * 2 * 8 * 2 * 64 * 64;
constexpr size_t OFF_XCUR = AL(OFF_W + W_END * 2);
constexpr size_t OFF_H = OFF_XCUR + (size_t)TT * 1024 * 4;
constexpr size_t OFF_C = OFF_H + (size_t)TT * 1024 * 2;
constexpr size_t C_CQ = 0;
constexpr size_t C_CKV = C_CQ + (size_t)TT * 256;
constexpr size_t C_KR = C_CKV + (size_t)TT * 128;
constexpr size_t C_MQ = C_KR + (size_t)TT * 32;
constexpr size_t C_KN = C_MQ + (size_t)TT * 768;
constexpr size_t C_VMT = C_KN + (size_t)TT * 512;
constexpr size_t C_RQ = C_VMT + (size_t)TT * 512;
constexpr size_t C_RK = C_RQ + (size_t)TT * 256;
constexpr size_t C_RKT = C_RK + (size_t)TT * 256;
constexpr size_t C_RVT = C_RKT + (size_t)TT * 256;
constexpr size_t C_RG = C_RVT + (size_t)TT * 512;
constexpr size_t C_LX = C_RG + (size_t)TT * 512;
constexpr size_t C_LG = C_LX + (size_t)TT * 512;
constexpr size_t C_GQ = C_LG + (size_t)TT * 512;
constexpr size_t C_GK = C_GQ + (size_t)TT * 512;
constexpr size_t C_GVT = C_GK + (size_t)TT * 128;
constexpr size_t C_END = C_GVT + (size_t)TT * 128;
constexpr size_t C_M = 0;
constexpr size_t C_W13 = (size_t)24 * 1024 * 1024;
constexpr size_t C_W2 = C_W13 + (size_t)64 * 512 * 1024;
static_assert(C_W2 + (size_t)64 * 1024 * 256 <= C_END, "moe alias");
static_assert((size_t)TT * 1024 <= C_W13, "m alias");
constexpr size_t OFF_D = OFF_C + C_END * 2;
constexpr size_t D_YA = 0;
constexpr size_t D_YD = (size_t)TT * 512;
constexpr size_t D_OF = (size_t)2 * TT * 512;
constexpr size_t D_OB = (size_t)3 * TT * 512;
constexpr size_t D_LH0 = (size_t)4 * TT * 512;
constexpr size_t D_LH1 = (size_t)5 * TT * 512;
constexpr size_t D_ACT = 0;
constexpr size_t D_YS = (size_t)12 * 1024 * 1024;
constexpr size_t D_END = D_YS + (size_t)NSLOT * 1024;
static_assert((size_t)NSLOT * 256 <= D_YS, "act alias");
static_assert((size_t)6 * TT * 512 <= D_END, "d size");
constexpr size_t WS_NEED = OFF_D + D_END * 2;

struct Params {
    const float* in[N_IN];
    float* out;
    unsigned char* ws;
};

#define WSF(off) ((float*)(p.ws + (off)))
#define WSI(off) ((int*)(p.ws + (off)))
#define WB(el) ((bf16_t*)(p.ws + OFF_W) + (el))
#define CB(el) ((bf16_t*)(p.ws + OFF_C) + (el))
#define DB(el) ((bf16_t*)(p.ws + OFF_D) + (el))
#define HB ((bf16_t*)(p.ws + OFF_H))
#define XCUR ((float*)(p.ws + OFF_XCUR))

constexpr int SMEM_BYTES = 49152;
constexpr int CT_LD = 136;
constexpr int AUX_OFF = 36864;

DEVI int launder_tid() { int t = __builtin_amdgcn_workitem_id_x(); asm volatile("" : "+v"(t)); return t; }
DEVI int launder_bid() { int t = __builtin_amdgcn_workgroup_id_x(); asm volatile("" : "+s"(t)); return t; }
#define TIDX launder_tid()
#define BIDX launder_bid()
DEVI float bf2f(bf16_t v) { return __uint_as_float(((unsigned)v) << 16); }
DEVI bf16_t f2bf(float f) {
    __bf16 h = (__bf16)f;
    return __builtin_bit_cast(unsigned short, h);
}
DEVI float sigmoidf_(float x) { return 1.f / (1.f + __expf(-x)); }
DEVI float siluf_(float x) { return x / (1.f + __expf(-x)); }
DEVI float gelu_tanh(float x) {
    float u = 0.7978845608028654f * (x + 0.044715f * x * x * x);
    return 0.5f * x * (1.f + tanhf(u));
}
DEVI float wave_sum(float v) {
#pragma unroll
    for (int o = 32; o > 0; o >>= 1) v += __shfl_xor(v, o);
    return v;
}
DEVI int mt_of(int q, bool latonly) { return latonly ? (q >> 4) * 18 + 2 + (q & 15) : q; }

struct CvtJob { const float* src; bf16_t* dst; const float* ks; int K, N, ldd, batch; size_t sbs, dbs; int mode; };
DEVI int cvt_rowmap(int mode, int n) {
    if (mode == 1) return n < 384 ? n : (n < 416 ? n - 384 + 3712 : n - 32);
    if (mode == 2) { int h = n / 96, j = n % 96; return j < 64 ? h * 64 + j : 512 + h * 32 + (j - 64); }
    if (mode == 3) return (n >> 6) * 128 + (n & 63);
    return n;
}
DEVI void cvt_tile(const CvtJob& j, int tile, float* lds) {
    const int tn = j.N / 32, tk = j.K / 64, per = tn * tk;
    const int bb = tile / per, r = tile % per, kt = r / tn, nt = r % tn;
    const float* s = j.src + (size_t)bb * j.sbs + (size_t)(kt * 64) * j.N + nt * 32;
    const int tx = TIDX & 31, ty = TIDX >> 5;
#pragma unroll
    for (int i = 0; i < 8; ++i) {
        int k = ty + 8 * i;
        float v = s[(size_t)k * j.N + tx];
        if (j.ks) v *= j.ks[kt * 64 + k];
        lds[k * 33 + tx] = v;
    }
    __syncthreads();
    bf16_t* d = j.dst + (size_t)bb * j.dbs;
#pragma unroll
    for (int i = 0; i < 4; ++i) {
        int n = ty + 8 * i, kk = tx * 2;
        unsigned lo = f2bf(lds[kk * 33 + n]), hi = f2bf(lds[(kk + 1) * 33 + n]);
        int row = cvt_rowmap(j.mode, nt * 32 + n);
        *(unsigned*)(d + (size_t)row * j.ldd + kt * 64 + kk) = lo | (hi << 16);
    }
    __syncthreads();
}

DEVI void cvt_tile256(const CvtJob& j, int tile, unsigned char* smem) {
    constexpr int NS = 260;
    bf16_t* T = (bf16_t*)smem;
    const int tn = j.N / 256, tk = j.K / 64, per = tn * tk;
    const int bb = tile / per, r = tile % per, kt = r / tn, nt = r % tn;
    const float* s = j.src + (size_t)bb * j.sbs + (size_t)(kt * 64) * j.N + nt * 256;
    const int tid = TIDX, lane = tid & 63, w = tid >> 6;
    float4 v[16];
#pragma unroll
    for (int i = 0; i < 16; ++i) v[i] = *(const float4*)(s + (size_t)(w + 4 * i) * j.N + lane * 4);
    __syncthreads();
#pragma unroll
    for (int i = 0; i < 16; ++i) {
        const int k = w + 4 * i;
        uint2 o;
        o.x = (unsigned)f2bf(v[i].x) | ((unsigned)f2bf(v[i].y) << 16);
        o.y = (unsigned)f2bf(v[i].z) | ((unsigned)f2bf(v[i].w) << 16);
        *(uint2*)(T + k * NS + lane * 4) = o;
    }
    __syncthreads();
    bf16_t* d = j.dst + (size_t)bb * j.dbs;
#pragma unroll
    for (int i = 0; i < 8; ++i) {
        const int c = tid + 256 * i, n = c >> 3, kc = c & 7;
        bf16x8 o;
#pragma unroll
        for (int e = 0; e < 8; ++e) o[e] = (short)T[(kc * 8 + e) * NS + n];
        const int row = cvt_rowmap(j.mode, nt * 256 + n);
        *(bf16x8*)(d + (size_t)row * j.ldd + kt * 64 + kc * 8) = o;
    }
}
__constant__ const int CVT_TILES[8] = {1872, 96, 64, 1024, 2048, 512, 32, 32};
constexpr int CVT_PER_LAYER = 1872 + 96 + 64 + 1024 + 2048 + 512 + 32 + 32;
DEVI CvtJob get_job(const Params& p, int l, int k) {
    CvtJob j; j.ks = nullptr; j.batch = 1; j.sbs = 0; j.dbs = 0; j.mode = 0;
    switch (k) {
    case 0: j.src = p.in[I_WIN] + (size_t)l * 1024 * 3744; j.dst = WB(W_IN + (size_t)l * 3840 * 1024); j.K = 1024; j.N = 3744; j.ldd = 1024; j.mode = 1; break;
    case 1: j.src = p.in[I_WUQ] + (size_t)l * 256 * 768; j.dst = WB(W_UQ + (size_t)l * 768 * 256); j.K = 256; j.N = 768; j.ldd = 256; j.ks = p.in[I_MQN] + l * 256; j.mode = 2; break;
    case 2: j.src = p.in[I_WUKV] + (size_t)l * 128 * 1024; j.dst = WB(W_UKV + (size_t)l * 1024 * 128); j.K = 128; j.N = 1024; j.ldd = 128; j.ks = p.in[I_MKVN] + l * 128; break;
    case 3: j.src = p.in[I_WBR] + (size_t)l * 4 * 512 * 1024; j.dst = WB(W_BR + (size_t)l * 4 * 1024 * 512); j.K = 512; j.N = 1024; j.ldd = 512; j.batch = 4; j.sbs = 512 * 1024; j.dbs = 1024 * 512; break;
    case 4: j.src = p.in[I_WMG] + (size_t)l * 1024 * 4096; j.dst = WB(W_MG + (size_t)l * 4096 * 1024); j.K = 1024; j.N = 4096; j.ldd = 1024; break;
    case 5: j.src = p.in[I_WOUT] + (size_t)l * 1024 * 1024; j.dst = WB(W_OUT + (size_t)l * 1024 * 1024); j.K = 1024; j.N = 1024; j.ldd = 1024; break;
    case 6: j.src = p.in[I_LWA] + (size_t)l * 16 * 4096; j.dst = WB(W_LRU + (size_t)l * 16 * 8192); j.K = 64; j.N = 64; j.ldd = 64; j.batch = 16; j.sbs = 4096; j.dbs = 8192; break;
    default: j.src = p.in[I_LWX] + (size_t)l * 16 * 4096; j.dst = WB(W_LRU + (size_t)l * 16 * 8192 + 4096); j.K = 64; j.N = 64; j.ldd = 64; j.batch = 16; j.sbs = 4096; j.dbs = 8192; break;
    }
    return j;
}
DEVI CvtJob get_moe_job(const Params& p, int l, int k) {
    CvtJob j; j.ks = nullptr; j.batch = 64; j.sbs = 262144;
    if (k == 0) { j.src = p.in[I_W1] + (size_t)l * 64 * 262144; j.dst = CB(C_W13); j.K = 1024; j.N = 256; j.ldd = 1024; j.dbs = 512 * 1024; j.mode = 3; }
    else if (k == 1) { j.src = p.in[I_W3] + (size_t)l * 64 * 262144; j.dst = CB(C_W13 + 64 * 1024); j.K = 1024; j.N = 256; j.ldd = 1024; j.dbs = 512 * 1024; j.mode = 3; }
    else { j.src = p.in[I_W2] + (size_t)l * 64 * 262144; j.dst = CB(C_W2); j.K = 256; j.N = 1024; j.ldd = 256; j.dbs = 262144; j.mode = 0; }
    return j;
}

struct AOp { const bf16_t* base; int ld; int row0; const int* ridx; };
DEVI const bf16_t* arow(const AOp& a, int i) {
    int r = a.ridx ? a.ridx[i] : a.row0 + i;
    return a.base + (size_t)r * a.ld;
}

#if NAIVE_GEMM
template <int BN>
DEVI void gemm_core(f32x4 (&acc)[4][BN / 32], const AOp& A, const bf16_t* B, int ldb, int K, unsigned char* smem) {
    constexpr int NI = BN / 32;
    const int tid = TIDX, lane = tid & 63, wid = tid >> 6, wr = wid >> 1, wc = wid & 1;
    for (int k0 = 0; k0 < K; k0 += 8) {
        bf16x8 bv[NI];
#pragma unroll
        for (int ni = 0; ni < NI; ++ni) bv[ni] = *(const bf16x8*)(B + (size_t)(wc * (BN / 2) + ni * 16 + (lane & 15)) * ldb + k0);
#pragma unroll
        for (int mi = 0; mi < 4; ++mi)
#pragma unroll
            for (int j = 0; j < 4; ++j) {
                bf16x8 av = *(const bf16x8*)(arow(A, wr * 64 + mi * 16 + (lane >> 4) * 4 + j) + k0);
#pragma unroll
                for (int ni = 0; ni < NI; ++ni) {
                    float s = 0.f;
#pragma unroll
                    for (int e = 0; e < 8; ++e) s += bf2f((bf16_t)av[e]) * bf2f((bf16_t)bv[ni][e]);
                    acc[mi][ni][j] += s;
                }
            }
    }
}
#else
template <int BN>
DEVI void gemm_core(f32x4 (&acc)[4][BN / 32], const AOp& A, const bf16_t* B, int ldb, int K, unsigned char* smem) {
    constexpr int NI = BN / 32;
    constexpr int NBL = BN / 32;
    const int tid = TIDX, lane = tid & 63, wid = tid >> 6, wr = wid >> 1, wc = wid & 1;
    unsigned char* sA = smem;
    unsigned char* sB = smem + 16384;
    const int lr = tid >> 3, lc = tid & 7;
    const bf16_t* ap[4];
    const bf16_t* bp[NBL];
#pragma unroll
    for (int i = 0; i < 4; ++i) ap[i] = arow(A, lr + 32 * i) + lc * 8;
#pragma unroll
    for (int i = 0; i < NBL; ++i) bp[i] = B + (size_t)(lr + 32 * i) * ldb + lc * 8;
    const int wofs = lr * 128 + ((lc ^ (lr & 7)) << 4);
    bf16x8 ra[4], rb[NBL];
#pragma unroll
    for (int i = 0; i < 4; ++i) ra[i] = *(const bf16x8*)(ap[i]);
#pragma unroll
    for (int i = 0; i < NBL; ++i) rb[i] = *(const bf16x8*)(bp[i]);
    const int nk = K >> 6;
    const int arow_off = (wr * 64 + (lane & 15)) * 128;
    const int brow_off = (wc * (BN / 2) + (lane & 15)) * 128;
    for (int kt = 0; kt < nk; ++kt) {
        __syncthreads();
#pragma unroll
        for (int i = 0; i < 4; ++i) *(bf16x8*)(sA + wofs + i * 4096) = ra[i];
#pragma unroll
        for (int i = 0; i < NBL; ++i) *(bf16x8*)(sB + wofs + i * 4096) = rb[i];
        __syncthreads();
        if (kt + 1 < nk) {
            const int ko = (kt + 1) * 64;
#pragma unroll
            for (int i = 0; i < 4; ++i) ra[i] = *(const bf16x8*)(ap[i] + ko);
#pragma unroll
            for (int i = 0; i < NBL; ++i) rb[i] = *(const bf16x8*)(bp[i] + ko);
        }
#pragma unroll
        for (int ks = 0; ks < 2; ++ks) {
            const int pch = ((ks * 4 + (lane >> 4)) ^ (lane & 7)) << 4;
            bf16x8 af[4], bfr[NI];
#pragma unroll
            for (int mi = 0; mi < 4; ++mi) af[mi] = *(const bf16x8*)(sA + arow_off + mi * 2048 + pch);
#pragma unroll
            for (int ni = 0; ni < NI; ++ni) bfr[ni] = *(const bf16x8*)(sB + brow_off + ni * 2048 + pch);
#pragma unroll
            for (int mi = 0; mi < 4; ++mi)
#pragma unroll
                for (int ni = 0; ni < NI; ++ni)
                    acc[mi][ni] = __builtin_amdgcn_mfma_f32_16x16x32_bf16(af[mi], bfr[ni], acc[mi][ni], 0, 0, 0);
        }
    }
}
#endif

template <int BN>
DEVI void acc_zero(f32x4 (&acc)[4][BN / 32]) {
#pragma unroll
    for (int mi = 0; mi < 4; ++mi)
#pragma unroll
        for (int ni = 0; ni < BN / 32; ++ni) acc[mi][ni] = f32x4{0.f, 0.f, 0.f, 0.f};
}
template <int BN>
DEVI void acc_to_ct(const f32x4 (&acc)[4][BN / 32], bf16_t* ct) {
    const int tid = TIDX, lane = tid & 63, wid = tid >> 6, wr = wid >> 1, wc = wid & 1;
#pragma unroll
    for (int mi = 0; mi < 4; ++mi)
#pragma unroll
        for (int ni = 0; ni < BN / 32; ++ni)
#pragma unroll
            for (int j = 0; j < 4; ++j)
                ct[(wr * 64 + mi * 16 + (lane >> 4) * 4 + j) * CT_LD + wc * (BN / 2) + ni * 16 + (lane & 15)] = f2bf(acc[mi][ni][j]);
}

template <int NC>
DEVI void ep_store_rows(const bf16_t* ct, int c0, bf16_t* dst, int ldd, int row0) {
    constexpr int CPR = NC / 8;
    for (int c = TIDX; c < 128 * CPR; c += 256) {
        int i = c / CPR, jc = c % CPR;
        *(bf16x8*)(dst + (size_t)(row0 + i) * ldd + jc * 8) = *(const bf16x8*)(ct + i * CT_LD + c0 + jc * 8);
    }
}
DEVI void ep_store_T(const bf16_t* ct, int c0, int nc, bf16_t* dstT, int ldT, int t0) {
    for (int c = TIDX; c < nc * 16; c += 256) {
        int j = c >> 4, ic = c & 15;
        bf16x8 v;
#pragma unroll
        for (int e = 0; e < 8; ++e) v[e] = (short)ct[(ic * 8 + e) * CT_LD + c0 + j];
        *(bf16x8*)(dstT + (size_t)j * ldT + t0 + ic * 8) = v;
    }
}
DEVI void ep_rope64(bf16_t* ct, const float* gain, float scale, bool lat, int pos0, const float* cs64) {
    const int row = TIDX >> 1, half = TIDX & 1;
    bf16_t* pr = ct + row * CT_LD + half * 64;
    float v[64];
#pragma unroll
    for (int c = 0; c < 8; ++c) {
        bf16x8 t = *(const bf16x8*)(pr + c * 8);
#pragma unroll
        for (int e = 0; e < 8; ++e) v[c * 8 + e] = bf2f((bf16_t)t[e]);
    }
    if (gain) {
        float ss = 0.f;
#pragma unroll
        for (int d = 0; d < 64; ++d) ss += v[d] * v[d];
        float rstd = rsqrtf(ss * (1.f / 64.f) + EPSV);
#pragma unroll
        for (int d = 0; d < 64; ++d) v[d] = v[d] * rstd * gain[d];
    }
    if (lat) {
        const float* cs = cs64 + (size_t)(pos0 + row) * 64;
#pragma unroll
        for (int i = 0; i < 16; ++i) {
            float a = v[i], b = v[i + 16], c = cs[i], s = cs[32 + i];
            v[i] = a * c - b * s; v[i + 16] = b * c + a * s;
            a = v[32 + i]; b = v[48 + i]; c = cs[16 + i]; s = cs[48 + i];
            v[32 + i] = a * c - b * s; v[48 + i] = b * c + a * s;
        }
    }
#pragma unroll
    for (int c = 0; c < 8; ++c) {
        bf16x8 t;
#pragma unroll
        for (int e = 0; e < 8; ++e) t[e] = (short)f2bf(v[c * 8 + e] * scale);
        *(bf16x8*)(pr + c * 8) = t;
    }
}
DEVI void ep_rope32(bf16_t* ct, int ngroups, const float* rstd, float scale, bool lat, int pos0, const float* cs32) {
    const int row = TIDX >> 1, half = TIDX & 1;
    const float rs = (rstd ? rstd[row] : 1.f) * scale;
#pragma unroll
    for (int gg = 0; gg < 2; ++gg) {
        const int g = half * 2 + gg;
        if (g < ngroups) {
            bf16_t* pr = ct + row * CT_LD + g * 32;
            float v[32];
#pragma unroll
            for (int c = 0; c < 4; ++c) {
                bf16x8 t = *(const bf16x8*)(pr + c * 8);
#pragma unroll
                for (int e = 0; e < 8; ++e) v[c * 8 + e] = bf2f((bf16_t)t[e]);
            }
            if (lat) {
                const float* cs = cs32 + (size_t)(pos0 + row) * 32;
#pragma unroll
                for (int i = 0; i < 8; ++i) {
                    float a = v[i], b = v[i + 8], c = cs[i], s = cs[16 + i];
                    v[i] = a * c - b * s; v[i + 8] = b * c + a * s;
                    a = v[16 + i]; b = v[24 + i]; c = cs[8 + i]; s = cs[24 + i];
                    v[16 + i] = a * c - b * s; v[24 + i] = b * c + a * s;
                }
            }
#pragma unroll
            for (int c = 0; c < 4; ++c) {
                bf16x8 t;
#pragma unroll
                for (int e = 0; e < 8; ++e) t[e] = (short)f2bf(v[c * 8 + e] * rs);
                *(bf16x8*)(pr + c * 8) = t;
            }
        }
    }
}
DEVI void ep_scale_rows(bf16_t* ct, int c0, int nc, const float* rstd, float scale) {
    const int cpr = nc / 8;
    for (int c = TIDX; c < 128 * cpr; c += 256) {
        int i = c / cpr, jc = c % cpr;
        bf16_t* pr = ct + i * CT_LD + c0 + jc * 8;
        bf16x8 t = *(const bf16x8*)pr;
        float rs = rstd[i] * scale;
#pragma unroll
        for (int e = 0; e < 8; ++e) t[e] = (short)f2bf(bf2f((bf16_t)t[e]) * rs);
        *(bf16x8*)pr = t;
    }
}
DEVI void ep_rstd(const bf16_t* A, int ld, int row0, int K, float* rstd) {
    const int row = TIDX >> 1, half = TIDX & 1;
    const bf16_t* pr = A + (size_t)(row0 + row) * ld + half * (K / 2);
    float ss = 0.f;
    for (int c = 0; c < K / 16; ++c) {
        bf16x8 t = *(const bf16x8*)(pr + c * 8);
#pragma unroll
        for (int e = 0; e < 8; ++e) { float f = bf2f((bf16_t)t[e]); ss += f * f; }
    }
    ss += __shfl_xor(ss, 1);
    if (half == 0) rstd[row] = rsqrtf(ss / (float)K + EPSV);
}

DEVI void phase0(const Params& p, unsigned char* smem) {
    const int tid = TIDX, lane = tid & 63, w = tid >> 6;
    const int NG = 192, NCV = 2 * CVT_PER_LAYER, NR = 8;
    const int ntask = NG + NCV + NR + 1;
    for (int task = BIDX; task < ntask; task += gridDim.x) {
        if (task < NG) {
            const int l = task / 96, n0 = (task % 96) * 64;
            float* sv = (float*)smem;
            float* red = (float*)(smem + 36864);
            for (int idx = lane; idx < 9 * 256; idx += 64) {
                int bi = idx >> 8, kk = idx & 255, k = 256 * w + kk;
                float c = bi < 8 ? p.in[I_C][bi * 1024 + k] : p.in[I_CCTX][k];
                sv[(w * 9 + bi) * 256 + kk] = siluf_(c);
            }
            __syncthreads();
            float acc[9];
#pragma unroll
            for (int bi = 0; bi < 9; ++bi) acc[bi] = 0.f;
            const float* wp = p.in[I_ADAW] + (size_t)l * 1024 * 6144 + (size_t)(256 * w) * 6144 + n0 + lane;
#pragma unroll 8
            for (int kk = 0; kk < 256; ++kk) {
                float wv = wp[(size_t)kk * 6144];
#pragma unroll
                for (int bi = 0; bi < 9; ++bi) acc[bi] += sv[(w * 9 + bi) * 256 + kk] * wv;
            }
#pragma unroll
            for (int bi = 0; bi < 9; ++bi) red[(w * 9 + bi) * 64 + lane] = acc[bi];
            __syncthreads();
            for (int idx = tid; idx < 9 * 64; idx += 256) {
                int bi = idx >> 6, c = idx & 63;
                float s = p.in[I_ADAB][l * 6144 + n0 + c];
#pragma unroll
                for (int ww = 0; ww < 4; ++ww) s += red[(ww * 9 + bi) * 64 + c];
                WSF(OFF_MOD)[(size_t)(l * 9 + bi) * 6144 + n0 + c] = s;
            }
            __syncthreads();
        } else if (task < NG + NCV) {
            int t = task - NG;
            int l = t / CVT_PER_LAYER; t %= CVT_PER_LAYER;
            int k = 0;
            while (t >= CVT_TILES[k]) { t -= CVT_TILES[k]; ++k; }
            CvtJob j = get_job(p, l, k);
            cvt_tile(j, t, (float*)smem);
        } else if (task < NG + NCV + NR) {
            int pos = (task - NG - NCV) * 256 + tid;
            float rp = (float)(pos >> 6), cp = (float)(pos & 63);
            float* t64 = WSF(OFF_R64) + (size_t)pos * 64;
            float* t32 = WSF(OFF_R32) + (size_t)pos * 32;
            for (int i = 0; i < 16; ++i) {
                float inv = powf(10000.f, -(float)(2 * i) / 32.f);
                float ar = rp * inv, ac = cp * inv;
                t64[i] = cosf(ar); t64[16 + i] = cosf(ac); t64[32 + i] = sinf(ar); t64[48 + i] = sinf(ac);
            }
            for (int i = 0; i < 8; ++i) {
                float inv = powf(10000.f, -(float)(2 * i) / 16.f);
                float ar = rp * inv, ac = cp * inv;
                t32[i] = cosf(ar); t32[8 + i] = cosf(ac); t32[16 + i] = sinf(ar); t32[24 + i] = sinf(ac);
            }
        } else {
            if (tid < 128) WSI(OFF_CNT)[tid] = 0;
            for (int l = 0; l < 2; ++l) {
                unsigned* z = (unsigned*)WB(W_IN + (size_t)l * 3840 * 1024 + (size_t)3744 * 1024);
                for (int i = tid; i < 96 * 1024 / 2; i += 256) z[i] = 0u;
            }
        }
    }
}

struct MoeTab { int* cnt; int* tp; int* seg; };
DEVI MoeTab moe_tables(const Params& p, int l, unsigned char* smem) {
    int* aux = (int*)(smem + AUX_OFF);
    MoeTab t; t.cnt = aux + 256; t.tp = aux + 320; t.seg = aux + 400;
    __syncthreads();
    if (TIDX < 64) t.cnt[TIDX] = WSI(OFF_CNT)[l * 64 + TIDX];
    __syncthreads();
    if (TIDX == 0) {
        int a = 0, s = 0;
        for (int e = 0; e < 64; ++e) {
            t.tp[e] = a; t.seg[e] = s;
            int nt = (t.cnt[e] + 127) >> 7;
            a += nt; s += nt * 128;
        }
        t.tp[64] = a; t.seg[64] = s;
    }
    __syncthreads();
    return t;
}
struct Rec { int e0, p0, e1, p1; float w0, w1; int pad0, pad1; };

DEVI void phase_norm1(const Params& p, int l, int mode, unsigned char* smem) {
    const int lane = TIDX & 63, w = TIDX >> 6;
    MoeTab mt;
    const bool comb = (l > 0) || mode == 1;
    const int lp = mode == 1 ? 1 : l - 1;
    if (comb) mt = moe_tables(p, lp, smem);
    const float* g1 = mode == 1 ? p.in[I_FN] : p.in[I_N1G] + l * 1024;
    for (int row = BIDX * 4 + w; row < TT; row += gridDim.x * 4) {
        const int b = row / TPB, t = row % TPB;
        const bool isctx = t < CTXL;
        if (mode == 1 && isctx) continue;
        const int bi = isctx ? 8 : b;
        float v[16];
        if (!comb) {
            const float* src = isctx ? p.in[I_CTX] + ((size_t)b * CTXL + t) * DM : p.in[I_X] + ((size_t)b * SEQL + (t - CTXL)) * DM;
#pragma unroll
            for (int i = 0; i < 4; ++i) {
                float4 x4 = *(const float4*)(src + i * 256 + lane * 4);
                v[i * 4] = x4.x; v[i * 4 + 1] = x4.y; v[i * 4 + 2] = x4.z; v[i * 4 + 3] = x4.w;
            }
        } else {
            float* xr = XCUR + (size_t)row * DM;
            const Rec rc = ((const Rec*)(p.ws + OFF_REC))[row];
            const bf16_t* y0 = DB(D_YS) + (size_t)(mt.seg[rc.e0] + rc.p0) * 1024;
            const bf16_t* y1 = DB(D_YS) + (size_t)(mt.seg[rc.e1] + rc.p1) * 1024;
            const float* gate = WSF(OFF_MOD) + (size_t)(lp * 9 + bi) * 6144 + 5 * 1024;
#pragma unroll
            for (int i = 0; i < 4; ++i) {
                const int c = i * 256 + lane * 4;
                float4 x4 = *(const float4*)(xr + c);
                float4 g4 = *(const float4*)(gate + c);
                uint2 a = *(const uint2*)(y0 + c), bb = *(const uint2*)(y1 + c);
                float f0 = rc.w0 * __uint_as_float(a.x << 16) + rc.w1 * __uint_as_float(bb.x << 16);
                float f1 = rc.w0 * __uint_as_float(a.x & 0xffff0000u) + rc.w1 * __uint_as_float(bb.x & 0xffff0000u);
                float f2 = rc.w0 * __uint_as_float(a.y << 16) + rc.w1 * __uint_as_float(bb.y << 16);
                float f3 = rc.w0 * __uint_as_float(a.y & 0xffff0000u) + rc.w1 * __uint_as_float(bb.y & 0xffff0000u);
                x4.x += g4.x * f0; x4.y += g4.y * f1; x4.z += g4.z * f2; x4.w += g4.w * f3;
                if (mode == 0) *(float4*)(xr + c) = x4;
                v[i * 4] = x4.x; v[i * 4 + 1] = x4.y; v[i * 4 + 2] = x4.z; v[i * 4 + 3] = x4.w;
            }
        }
        float ss = 0.f;
#pragma unroll
        for (int i = 0; i < 16; ++i) ss += v[i] * v[i];
        ss = wave_sum(ss);
        const float rstd = rsqrtf(ss * (1.f / 1024.f) + EPSV);
        if (mode == 1) {
            float* o = p.out + ((size_t)b * SEQL + (t - CTXL)) * DM;
#pragma unroll
            for (int i = 0; i < 4; ++i) {
                const int c = i * 256 + lane * 4;
                float4 g4 = *(const float4*)(g1 + c);
                float4 r4;
                r4.x = v[i * 4] * rstd * g4.x; r4.y = v[i * 4 + 1] * rstd * g4.y; r4.z = v[i * 4 + 2] * rstd * g4.z; r4.w = v[i * 4 + 3] * rstd * g4.w;
                *(float4*)(o + c) = r4;
            }
        } else {
            const float* md = WSF(OFF_MOD) + (size_t)(l * 9 + bi) * 6144;
            bf16_t* ho = HB + (size_t)row * DM;
#pragma unroll
            for (int i = 0; i < 4; ++i) {
                const int c = i * 256 + lane * 4;
                float4 g4 = *(const float4*)(g1 + c);
                float4 sh = *(const float4*)(md + c);
                float4 sc = *(const float4*)(md + 1024 + c);
                float h0 = v[i * 4] * rstd * g4.x * (1.f + sc.x) + sh.x;
                float h1 = v[i * 4 + 1] * rstd * g4.y * (1.f + sc.y) + sh.y;
                float h2 = v[i * 4 + 2] * rstd * g4.z * (1.f + sc.z) + sh.z;
                float h3 = v[i * 4 + 3] * rstd * g4.w * (1.f + sc.w) + sh.w;
                uint2 o2;
                o2.x = (unsigned)f2bf(h0) | ((unsigned)f2bf(h1) << 16);
                o2.y = (unsigned)f2bf(h2) | ((unsigned)f2bf(h3) << 16);
                *(uint2*)(ho + c) = o2;
            }
        }
    }
}

DEVI void phase_win(const Params& p, int l, unsigned char* smem) {
    bf16_t* ct = (bf16_t*)smem;
    const float* cs64 = WSF(OFF_R64);
    const float* cs32 = WSF(OFF_R32);
    const int ntile = 144 * 30;
    for (int tile = BIDX; tile < ntile; tile += gridDim.x) {
        const int mt = tile / 30, nt = tile % 30;
        const int row0 = mt * 128, b = mt / 18, t0 = (mt % 18) * 128;
        const bool lat = (mt % 18) >= 2;
        const int pos0 = t0 - CTXL;
        f32x4 acc[4][4];
        acc_zero<128>(acc);
        AOp A{HB, 1024, row0, nullptr};
        gemm_core<128>(acc, A, WB(W_IN + (size_t)l * 3840 * 1024 + (size_t)nt * 128 * 1024), 1024, 1024, smem);
        __syncthreads();
        acc_to_ct<128>(acc, ct);
        __syncthreads();
        if (nt < 2) ep_store_rows<128>(ct, 0, CB(C_CQ) + nt * 128, 256, row0);
        else if (nt == 2) ep_store_rows<128>(ct, 0, CB(C_CKV), 128, row0);
        else if (nt < 5) { ep_rope64(ct, nullptr, 1.f, lat, pos0, cs64); __syncthreads(); ep_store_rows<128>(ct, 0, CB(C_RQ) + (nt - 3) * 128, 256, row0); }
        else if (nt < 7) {
            ep_rope64(ct, nullptr, 0.125f, lat, pos0, cs64); __syncthreads();
            ep_store_rows<128>(ct, 0, CB(C_RK) + (nt - 5) * 128, 256, row0);
            ep_store_T(ct, 0, 128, CB(C_RKT) + ((size_t)b * 256 + (nt - 5) * 128) * TPB, TPB, t0);
        }
        else if (nt < 11) ep_store_T(ct, 0, 128, CB(C_RVT) + ((size_t)b * 4 + (nt - 7)) * 128 * TPB, TPB, t0);
        else if (nt < 15) ep_store_rows<128>(ct, 0, CB(C_RG) + (nt - 11) * 128, 512, row0);
        else if (nt < 19) ep_store_rows<128>(ct, 0, CB(C_LX) + (nt - 15) * 128, 512, row0);
        else if (nt < 23) ep_store_rows<128>(ct, 0, CB(C_LG) + (nt - 19) * 128, 512, row0);
        else if (nt < 27) { ep_rope64(ct, p.in[I_GQN] + l * 64, 0.125f * LOG2E, lat, pos0, cs64); __syncthreads(); ep_store_rows<128>(ct, 0, CB(C_GQ) + (nt - 23) * 128, 512, row0); }
        else if (nt == 27) { ep_rope64(ct, p.in[I_GKN] + l * 64, 1.f, lat, pos0, cs64); __syncthreads(); ep_store_rows<128>(ct, 0, CB(C_GK), 128, row0); }
        else if (nt == 28) ep_store_T(ct, 0, 128, CB(C_GVT) + (size_t)b * 128 * TPB, TPB, t0);
        else { ep_rope32(ct, 1, nullptr, 1.f, lat, pos0, cs32); __syncthreads(); ep_store_rows<32>(ct, 0, CB(C_KR), 32, row0); }
        __syncthreads();
    }
}

DEVI void phase_mla_up(const Params& p, int l, unsigned char* smem) {
    bf16_t* ct = (bf16_t*)smem;
    float* rstd = (float*)(smem + AUX_OFF);
    const float* cs32 = WSF(OFF_R32);
    const float qscale = 0.10206207261596575f * LOG2E;
    const int nq = (l == 0 ? 144 : 128) * 6;
    const int nkv = 144 * 8;
    for (int tile = BIDX; tile < nq + nkv; tile += gridDim.x) {
        if (tile < nq) {
            const int mt = mt_of(tile / 6, l != 0), nt = tile % 6;
            const int row0 = mt * 128, t0 = (mt % 18) * 128;
            const bool lat = (mt % 18) >= 2;
            f32x4 acc[4][4];
            acc_zero<128>(acc);
            AOp A{CB(C_CQ), 256, row0, nullptr};
            gemm_core<128>(acc, A, WB(W_UQ + (size_t)l * 768 * 256 + (size_t)nt * 128 * 256), 256, 256, smem);
            __syncthreads();
            acc_to_ct<128>(acc, ct);
            ep_rstd(CB(C_CQ), 256, row0, 256, rstd);
            __syncthreads();
            if (nt < 4) {
                ep_scale_rows(ct, 0, 128, rstd, qscale); __syncthreads();
                ep_store_rows<64>(ct, 0, CB(C_MQ) + (nt * 2) * 96, 768, row0);
                ep_store_rows<64>(ct, 64, CB(C_MQ) + (nt * 2 + 1) * 96, 768, row0);
            } else {
                ep_rope32(ct, 4, rstd, qscale, lat, t0 - CTXL, cs32); __syncthreads();
#pragma unroll
                for (int g = 0; g < 4; ++g) ep_store_rows<32>(ct, g * 32, CB(C_MQ) + ((nt - 4) * 4 + g) * 96 + 64, 768, row0);
            }
            __syncthreads();
        } else {
            const int tk = tile - nq;
            const int mt = tk / 8, nt = tk % 8;
            const int row0 = mt * 128, b = mt / 18, t0 = (mt % 18) * 128;
            f32x4 acc[4][4];
            acc_zero<128>(acc);
            AOp A{CB(C_CKV), 128, row0, nullptr};
            gemm_core<128>(acc, A, WB(W_UKV + (size_t)l * 1024 * 128 + (size_t)nt * 128 * 128), 128, 128, smem);
            __syncthreads();
            acc_to_ct<128>(acc, ct);
            ep_rstd(CB(C_CKV), 128, row0, 128, rstd);
            __syncthreads();
            ep_scale_rows(ct, 0, 128, rstd, 1.f); __syncthreads();
            ep_store_rows<64>(ct, 0, CB(C_KN) + nt * 64, 512, row0);
            ep_store_T(ct, 64, 64, CB(C_VMT) + ((size_t)b * 8 + nt) * 64 * TPB, TPB, t0);
            __syncthreads();
        }
    }
}

template <int DK, bool MLA>
DEVI void attn_naive_wave(const Params& p, int b, int t0, int hq) {
    const int lane = TIDX & 63;
    const int t = t0 + lane, row = b * TPB + t;
    const int nkeys = (t0 < CTXL) ? CTXL : TPB;
    float q[DK];
    const bf16_t* qp = MLA ? CB(C_MQ) + (size_t)row * 768 + hq * 96 : CB(C_GQ) + (size_t)row * 512 + hq * 64;
#pragma unroll
    for (int c = 0; c < DK / 8; ++c) {
        bf16x8 tq = *(const bf16x8*)(qp + c * 8);
#pragma unroll
        for (int e = 0; e < 8; ++e) q[c * 8 + e] = bf2f((bf16_t)tq[e]);
    }
    float acc[64];
#pragma unroll
    for (int d = 0; d < 64; ++d) acc[d] = 0.f;
    float m = -1e30f, lsum = 0.f;
    const int hk = MLA ? hq : (hq >> 2);
    const bf16_t* vT = MLA ? CB(C_VMT) + ((size_t)b * 8 + hk) * 64 * TPB : CB(C_GVT) + ((size_t)b * 2 + hk) * 64 * TPB;
    for (int kt = 0; kt < nkeys; ++kt) {
        const size_t krow = (size_t)b * TPB + kt;
        float s = 0.f;
        const bf16_t* kp = MLA ? CB(C_KN) + krow * 512 + hk * 64 : CB(C_GK) + krow * 128 + hk * 64;
#pragma unroll
        for (int c = 0; c < 8; ++c) {
            bf16x8 tk = *(const bf16x8*)(kp + c * 8);
#pragma unroll
            for (int e = 0; e < 8; ++e) s += q[c * 8 + e] * bf2f((bf16_t)tk[e]);
        }
        if (MLA) {
            const bf16_t* rp = CB(C_KR) + krow * 32;
#pragma unroll
            for (int c = 0; c < 4; ++c) {
                bf16x8 tk = *(const bf16x8*)(rp + c * 8);
#pragma unroll
                for (int e = 0; e < 8; ++e) s += q[(DK - 32) + c * 8 + e] * bf2f((bf16_t)tk[e]);
            }
        }
        const float mn = fmaxf(m, s);
        const float alpha = exp2f(m - mn), pp = exp2f(s - mn);
        lsum = lsum * alpha + pp;
#pragma unroll
        for (int d = 0; d < 64; ++d) acc[d] = acc[d] * alpha + pp * bf2f(vT[(size_t)d * TPB + kt]);
        m = mn;
    }
    const float inv = 1.f / lsum;
    bf16_t* op = (MLA ? DB(D_YA) : DB(D_YD)) + (size_t)row * 512 + hq * 64;
#pragma unroll
    for (int c = 0; c < 8; ++c) {
        bf16x8 o;
#pragma unroll
        for (int e = 0; e < 8; ++e) o[e] = (short)f2bf(acc[c * 8 + e] * inv);
        *(bf16x8*)(op + c * 8) = o;
    }
}


template <int DK, bool MLA>
DEVI void attn_task(const Params& p, int b, int hsel, int tq0, int nkeys, unsigned char* smem) {
    constexpr int KLD = DK + 8;
    constexpr int CK = DK / 8;
    constexpr int NKC = 64 * CK / 256;
    constexpr int VLD = 68;
    constexpr int KBYTES = 64 * KLD * 2, VBYTES = 64 * VLD * 2, STAGE = KBYTES + VBYTES;
    static_assert(2 * STAGE <= SMEM_BYTES, "attn lds");
    const int tid = TIDX, lane = tid & 63, w = tid >> 6, qc = lane & 31, hh = lane >> 5;
    const int tq = MLA ? tq0 + w * 32 + qc : tq0 + qc;
    const int hq = MLA ? hsel : hsel * 4 + w;
    const size_t qrow = (size_t)b * TPB + tq;
    const bf16_t* qp = MLA ? CB(C_MQ) + qrow * 768 + hq * 96 : CB(C_GQ) + qrow * 512 + hq * 64;
    bf16x8 qf[DK / 16];
#pragma unroll
    for (int ks = 0; ks < DK / 16; ++ks) qf[ks] = *(const bf16x8*)(qp + ks * 16 + hh * 8);
    const bf16_t* ksrc[NKC]; int kstep[NKC], kdst[NKC];
#pragma unroll
    for (int i = 0; i < NKC; ++i) {
        const int q = tid + 256 * i, key = q / CK, ch = q % CK;
        if (MLA) {
            if (ch < 8) { ksrc[i] = CB(C_KN) + ((size_t)b * TPB + key) * 512 + hsel * 64 + ch * 8; kstep[i] = 64 * 512; }
            else { ksrc[i] = CB(C_KR) + ((size_t)b * TPB + key) * 32 + (ch - 8) * 8; kstep[i] = 64 * 32; }
        } else { ksrc[i] = CB(C_GK) + ((size_t)b * TPB + key) * 128 + hsel * 64 + ch * 8; kstep[i] = 64 * 128; }
        kdst[i] = (key * KLD + ch * 8) * 2;
    }
    const bf16_t* vT = MLA ? CB(C_VMT) + ((size_t)b * 8 + hsel) * 64 * TPB : CB(C_GVT) + ((size_t)b * 2 + hsel) * 64 * TPB;
    const bf16_t* vsrc[2]; int vdst[2];
#pragma unroll
    for (int i = 0; i < 2; ++i) {
        const int q = tid + 256 * i, dv = q >> 3, ch = q & 7;
        vsrc[i] = vT + (size_t)dv * TPB + ch * 8;
        vdst[i] = KBYTES + (dv * VLD + ch * 8) * 2;
    }
    bf16x8 kr[NKC], vr[2];
#pragma unroll
    for (int i = 0; i < NKC; ++i) kr[i] = *(const bf16x8*)(ksrc[i]);
#pragma unroll
    for (int i = 0; i < 2; ++i) vr[i] = *(const bf16x8*)(vsrc[i]);
    __syncthreads();
#pragma unroll
    for (int i = 0; i < NKC; ++i) *(bf16x8*)(smem + kdst[i]) = kr[i];
#pragma unroll
    for (int i = 0; i < 2; ++i) {
        *(bf16x4*)(smem + vdst[i]) = bf16x4{vr[i][0], vr[i][1], vr[i][2], vr[i][3]};
        *(bf16x4*)(smem + vdst[i] + 8) = bf16x4{vr[i][4], vr[i][5], vr[i][6], vr[i][7]};
    }
    __syncthreads();
    f32x16 o0, o1;
#pragma unroll
    for (int r = 0; r < 16; ++r) { o0[r] = 0.f; o1[r] = 0.f; }
    float m = -1e30f, lsum = 0.f;
    const int nt = nkeys >> 6;
    for (int it = 0; it < nt; ++it) {
        const unsigned char* cur = smem + (it & 1) * STAGE;
        if (it + 1 < nt) {
#pragma unroll
            for (int i = 0; i < NKC; ++i) kr[i] = *(const bf16x8*)(ksrc[i] + (size_t)(it + 1) * kstep[i]);
#pragma unroll
            for (int i = 0; i < 2; ++i) vr[i] = *(const bf16x8*)(vsrc[i] + (it + 1) * 64);
        }
        f32x16 s0, s1;
#pragma unroll
        for (int r = 0; r < 16; ++r) { s0[r] = 0.f; s1[r] = 0.f; }
#pragma unroll
        for (int ks = 0; ks < DK / 16; ++ks) {
            bf16x8 a0 = *(const bf16x8*)(cur + (qc * KLD + ks * 16 + hh * 8) * 2);
            bf16x8 a1 = *(const bf16x8*)(cur + ((32 + qc) * KLD + ks * 16 + hh * 8) * 2);
            s0 = __builtin_amdgcn_mfma_f32_32x32x16_bf16(a0, qf[ks], s0, 0, 0, 0);
            s1 = __builtin_amdgcn_mfma_f32_32x32x16_bf16(a1, qf[ks], s1, 0, 0, 0);
        }
        float mx = s0[0];
#pragma unroll
        for (int r = 1; r < 16; ++r) mx = fmaxf(mx, s0[r]);
#pragma unroll
        for (int r = 0; r < 16; ++r) mx = fmaxf(mx, s1[r]);
        mx = fmaxf(mx, __shfl_xor(mx, 32));
        const float mn = fmaxf(m, mx);
        const float alpha = __builtin_amdgcn_exp2f(m - mn);
        m = mn;
        float ps = 0.f;
#pragma unroll
        for (int r = 0; r < 16; ++r) { s0[r] = __builtin_amdgcn_exp2f(s0[r] - mn); ps += s0[r]; }
#pragma unroll
        for (int r = 0; r < 16; ++r) { s1[r] = __builtin_amdgcn_exp2f(s1[r] - mn); ps += s1[r]; }
        lsum = lsum * alpha + ps;
#pragma unroll
        for (int r = 0; r < 16; ++r) { o0[r] *= alpha; o1[r] *= alpha; }
        bf16x8 pf[2][2];
#pragma unroll
        for (int s = 0; s < 2; ++s)
#pragma unroll
            for (int j = 0; j < 8; ++j) { pf[0][s][j] = (short)f2bf(s0[8 * s + j]); pf[1][s][j] = (short)f2bf(s1[8 * s + j]); }
        const unsigned char* cv = cur + KBYTES;
#pragma unroll
        for (int a = 0; a < 2; ++a)
#pragma unroll
            for (int s = 0; s < 2; ++s) {
                const int keyoff = a * 32 + 16 * s + 4 * hh;
                bf16x4 l0 = *(const bf16x4*)(cv + (qc * VLD + keyoff) * 2);
                bf16x4 h0 = *(const bf16x4*)(cv + (qc * VLD + keyoff + 8) * 2);
                bf16x4 l1 = *(const bf16x4*)(cv + ((32 + qc) * VLD + keyoff) * 2);
                bf16x4 h1 = *(const bf16x4*)(cv + ((32 + qc) * VLD + keyoff + 8) * 2);
                bf16x8 v0 = bf16x8{l0[0], l0[1], l0[2], l0[3], h0[0], h0[1], h0[2], h0[3]};
                bf16x8 v1 = bf16x8{l1[0], l1[1], l1[2], l1[3], h1[0], h1[1], h1[2], h1[3]};
                o0 = __builtin_amdgcn_mfma_f32_32x32x16_bf16(v0, pf[a][s], o0, 0, 0, 0);
                o1 = __builtin_amdgcn_mfma_f32_32x32x16_bf16(v1, pf[a][s], o1, 0, 0, 0);
            }
        if (it + 1 < nt) {
            unsigned char* nxt = smem + ((it + 1) & 1) * STAGE;
#pragma unroll
            for (int i = 0; i < NKC; ++i) *(bf16x8*)(nxt + kdst[i]) = kr[i];
#pragma unroll
            for (int i = 0; i < 2; ++i) {
                *(bf16x4*)(nxt + vdst[i]) = bf16x4{vr[i][0], vr[i][1], vr[i][2], vr[i][3]};
                *(bf16x4*)(nxt + vdst[i] + 8) = bf16x4{vr[i][4], vr[i][5], vr[i][6], vr[i][7]};
            }
        }
        __syncthreads();
    }
    lsum += __shfl_xor(lsum, 32);
    const float inv = 1.f / lsum;
    bf16_t* op = (MLA ? DB(D_YA) : DB(D_YD)) + qrow * 512 + hq * 64;
#pragma unroll
    for (int g = 0; g < 4; ++g) {
        bf16x4 a, c;
#pragma unroll
        for (int e = 0; e < 4; ++e) { a[e] = (short)f2bf(o0[g * 4 + e] * inv); c[e] = (short)f2bf(o1[g * 4 + e] * inv); }
        *(bf16x4*)(op + 8 * g + 4 * hh) = a;
        *(bf16x4*)(op + 32 + 8 * g + 4 * hh) = c;
    }
}

DEVI int proc_tok(int dir, int pidx) { return dir == 0 ? pidx : (pidx < CTXL ? CTXL - 1 - pidx : (CTXL + TPB - 1) - pidx); }

DEVI void retention_naive(const Params& p, int l, int task) {
    const int b = task >> 2, h = task & 3;
    const int dir = TIDX >> 7, dv = TIDX & 127;
    const float dec = p.in[I_RDEC][l * 8 + dir * 4 + h];
    const float lg = -log1pf(expf(-dec));
    const float g = expf(lg);
    float S[64];
#pragma unroll
    for (int d = 0; d < 64; ++d) S[d] = 0.f;
    const bf16_t* vT = CB(C_RVT) + (((size_t)b * 4 + h) * 128 + dv) * TPB;
    bf16_t* outp = (dir == 0 ? DB(D_OF) : DB(D_OB));
    for (int pi = 0; pi < TPB; ++pi) {
        const int u = proc_tok(dir, pi);
        const size_t row = (size_t)b * TPB + u;
        const bf16_t* qp = CB(C_RQ) + row * 256 + h * 64;
        const bf16_t* kp = CB(C_RK) + row * 256 + h * 64;
        const float v = bf2f(vT[u]);
        float o = 0.f;
#pragma unroll
        for (int c = 0; c < 8; ++c) {
            bf16x8 tq = *(const bf16x8*)(qp + c * 8);
            bf16x8 tk = *(const bf16x8*)(kp + c * 8);
#pragma unroll
            for (int e = 0; e < 8; ++e) {
                const int d = c * 8 + e;
                const float qd = bf2f((bf16_t)tq[e]), kd = bf2f((bf16_t)tk[e]);
                if (dir == 0) { S[d] = g * S[d] + kd * v; o += qd * S[d]; }
                else { S[d] = g * S[d]; o += qd * S[d]; S[d] += kd * v; }
            }
        }
        outp[row * 512 + h * 128 + dv] = f2bf(o);
    }
}

DEVI void lru_naive_wave(const Params& p, int l, int task) {
    const int lane = TIDX & 63;
    const int b = task >> 4, d = (task >> 3) & 1, blk = task & 7;
    const int ch = blk * 64 + lane;
    float cw[4];
#pragma unroll
    for (int j = 0; j < 4; ++j) cw[j] = p.in[I_LCW][(l * 4 + j) * 512 + ch];
    const float cb = p.in[I_LCB][l * 512 + ch];
    const float ba = p.in[I_LBA][(l * 2 + d) * 512 + ch], bx = p.in[I_LBX][(l * 2 + d) * 512 + ch];
    const float lam = p.in[I_LLAM][(l * 2 + d) * 512 + ch];
    const float sp = log1pf(expf(-lam));
    const float* Wa = p.in[I_LWA] + ((size_t)(l * 2 + d) * 8 + blk) * 4096;
    const float* Wx = p.in[I_LWX] + ((size_t)(l * 2 + d) * 8 + blk) * 4096;
    float h = 0.f;
    bf16_t* outp = (d == 0 ? DB(D_LH0) : DB(D_LH1));
    for (int pi = 0; pi < TPB; ++pi) {
        const int u = proc_tok(d, pi);
        const int lo = u < CTXL ? 0 : CTXL, hi = u < CTXL ? CTXL : TPB;
        const size_t row = (size_t)b * TPB + u;
        float uval = cb;
#pragma unroll
        for (int j = 0; j < 4; ++j) {
            const int tt = u - 2 + j;
            if (tt >= lo && tt < hi) uval += cw[j] * bf2f(CB(C_LX)[((size_t)b * TPB + tt) * 512 + ch]);
        }
        float rp = 0.f, ip = 0.f;
        for (int c = 0; c < 64; ++c) {
            const float uc = __shfl(uval, c);
            rp += uc * Wa[c * 64 + lane];
            ip += uc * Wx[c * 64 + lane];
        }
        const float r = sigmoidf_(rp + ba), ig = sigmoidf_(ip + bx);
        const float la = -8.f * r * sp;
        const float a = expf(la);
        const float bb = sqrtf(-expm1f(2.f * la)) * (ig * uval);
        h = a * h + bb;
        outp[row * 512 + ch] = f2bf(h);
    }
}


DEVI void retention_walk(const Params& p, int l, int task, unsigned char* smem) {
    constexpr int PLD = 136;
    const int b = task >> 3, h = (task >> 1) & 3, dir = task & 1;
    const int tid = TIDX, lane = tid & 63, w = tid >> 6, qc = lane & 31, hh = lane >> 5;
    const float dec = p.in[I_RDEC][l * 8 + dir * 4 + h];
    const float lg2 = -log1pf(expf(-dec)) * LOG2E;
    const float cdec = exp2f(lg2 * 128.f);
    bf16_t* P = (bf16_t*)smem;
    f32x16 S0, S1;
#pragma unroll
    for (int r = 0; r < 16; ++r) { S0[r] = 0.f; S1[r] = 0.f; }
    const bf16_t* Kg = CB(C_RK) + (size_t)b * TPB * 256 + h * 64;
    const bf16_t* Qg = CB(C_RQ) + (size_t)b * TPB * 256 + h * 64;
    const bf16_t* KTg = CB(C_RKT) + ((size_t)b * 4 + h) * 64 * TPB;
    const bf16_t* VTg = CB(C_RVT) + (((size_t)b * 4 + h) * 128 + w * 32 + qc) * TPB;
    bf16_t* outp = (dir == 0 ? DB(D_OF) : DB(D_OB)) + (size_t)b * TPB * 512 + h * 128 + w * 32;
    const int iq = 32 * w + qc;
    for (int cc = 0; cc < 18; ++cc) {
        const int mch = dir == 0 ? cc : (cc < 2 ? 1 - cc : 19 - cc);
        const int t0 = mch * 128;
        bf16x8 vf[8];
#pragma unroll
        for (int ks = 0; ks < 8; ++ks) vf[ks] = *(const bf16x8*)(VTg + t0 + ks * 16 + hh * 8);
        bf16x8 qf[4];
        {
            const bf16_t* qrow = Qg + (size_t)(t0 + iq) * 256;
#pragma unroll
            for (int ks = 0; ks < 4; ++ks) qf[ks] = *(const bf16x8*)(qrow + ks * 16 + hh * 8);
        }
        __syncthreads();
#pragma unroll 1
        for (int js = 0; js < 4; ++js) {
            f32x16 sc;
#pragma unroll
            for (int r = 0; r < 16; ++r) sc[r] = 0.f;
            const bf16_t* krow = Kg + (size_t)(t0 + 32 * js + qc) * 256;
#pragma unroll
            for (int ks = 0; ks < 4; ++ks) {
                bf16x8 a = *(const bf16x8*)(krow + ks * 16 + hh * 8);
                sc = __builtin_amdgcn_mfma_f32_32x32x16_bf16(a, qf[ks], sc, 0, 0, 0);
            }
#pragma unroll
            for (int g = 0; g < 4; ++g) {
                bf16x4 pk;
#pragma unroll
                for (int e = 0; e < 4; ++e) {
                    const int j = 32 * js + 8 * g + 4 * hh + e;
                    const int d = iq - j;
                    float wgt;
                    if (dir == 0) wgt = d >= 0 ? __builtin_amdgcn_exp2f(lg2 * (float)d) : 0.f;
                    else wgt = d < 0 ? __builtin_amdgcn_exp2f(lg2 * (float)(-d)) : 0.f;
                    pk[e] = (short)f2bf(sc[4 * g + e] * wgt);
                }
                *(bf16x4*)(P + iq * PLD + 32 * js + 8 * g + 4 * hh) = pk;
            }
        }
        __syncthreads();
        bf16x8 sf[2][2];
#pragma unroll
        for (int s = 0; s < 2; ++s)
#pragma unroll
            for (int j = 0; j < 8; ++j) { sf[0][s][j] = (short)f2bf(S0[8 * s + j]); sf[1][s][j] = (short)f2bf(S1[8 * s + j]); }
#pragma unroll 1
        for (int isub = 0; isub < 4; ++isub) {
            const int ii = 32 * isub + qc;
            const bf16_t* qr = Qg + (size_t)(t0 + ii) * 256;
            f32x16 o;
#pragma unroll
            for (int r = 0; r < 16; ++r) o[r] = 0.f;
#pragma unroll
            for (int sub = 0; sub < 2; ++sub)
#pragma unroll
                for (int s = 0; s < 2; ++s) {
                    const int dk0 = 32 * sub + 16 * s + 4 * hh;
                    bf16x4 lo = *(const bf16x4*)(qr + dk0), hi = *(const bf16x4*)(qr + dk0 + 8);
                    bf16x8 bq = bf16x8{lo[0], lo[1], lo[2], lo[3], hi[0], hi[1], hi[2], hi[3]};
                    o = __builtin_amdgcn_mfma_f32_32x32x16_bf16(sf[sub][s], bq, o, 0, 0, 0);
                }
            const float qd = dir == 0 ? __builtin_amdgcn_exp2f(lg2 * (float)(ii + 1)) : __builtin_amdgcn_exp2f(lg2 * (float)(128 - ii));
#pragma unroll
            for (int r = 0; r < 16; ++r) o[r] *= qd;
#pragma unroll
            for (int ks = 0; ks < 8; ++ks) {
                bf16x8 pf = *(const bf16x8*)(P + ii * PLD + 16 * ks + 8 * hh);
                o = __builtin_amdgcn_mfma_f32_32x32x16_bf16(vf[ks], pf, o, 0, 0, 0);
            }
            bf16_t* orow = outp + (size_t)(t0 + ii) * 512;
#pragma unroll
            for (int g = 0; g < 4; ++g) {
                bf16x4 pk;
#pragma unroll
                for (int e = 0; e < 4; ++e) pk[e] = (short)f2bf(o[4 * g + e]);
                *(bf16x4*)(orow + 8 * g + 4 * hh) = pk;
            }
        }
#pragma unroll
        for (int r = 0; r < 16; ++r) { S0[r] *= cdec; S1[r] *= cdec; }
#pragma unroll
        for (int ks = 0; ks < 8; ++ks) {
            bf16x8 vs;
#pragma unroll
            for (int e = 0; e < 8; ++e) {
                const int j = 16 * ks + 8 * hh + e;
                const float kd = dir == 0 ? __builtin_amdgcn_exp2f(lg2 * (float)(127 - j)) : __builtin_amdgcn_exp2f(lg2 * (float)j);
                vs[e] = (short)f2bf(bf2f((bf16_t)vf[ks][e]) * kd);
            }
            bf16x8 a0 = *(const bf16x8*)(KTg + (size_t)qc * TPB + t0 + 16 * ks + 8 * hh);
            bf16x8 a1 = *(const bf16x8*)(KTg + (size_t)(32 + qc) * TPB + t0 + 16 * ks + 8 * hh);
            S0 = __builtin_amdgcn_mfma_f32_32x32x16_bf16(a0, vs, S0, 0, 0, 0);
            S1 = __builtin_amdgcn_mfma_f32_32x32x16_bf16(a1, vs, S1, 0, 0, 0);
        }
    }
    __syncthreads();
}

DEVI float fsig(float x) { return __builtin_amdgcn_rcpf(1.f + __expf(-x)); }
DEVI void lru_walk(const Params& p, int l, int task, unsigned char* smem) {
    const int b = task >> 4, d = (task >> 3) & 1, blk = task & 7;
    const int tid = TIDX, lane = tid & 63, w = tid >> 6, ln = lane & 15, g = lane >> 4;
    bf16_t* Wt = (bf16_t*)smem;
    float* uw = (float*)(smem + 18432) + w * 1024;
    float* cpar = (float*)(smem + 34816);
    float* agg = (float*)(smem + 36096);
    __syncthreads();
    {
        const bf16_t* wsrc = WB(W_LRU + ((size_t)(l * 2 + d) * 8 + blk) * 8192);
        for (int c = tid; c < 128 * 8; c += 256) {
            const int n = c >> 3, kc = c & 7;
            *(bf16x8*)(Wt + n * 72 + kc * 8) = *(const bf16x8*)(wsrc + n * 64 + kc * 8);
        }
        if (tid < 64) {
            const int ch = blk * 64 + tid;
#pragma unroll
            for (int j = 0; j < 4; ++j) cpar[j * 64 + tid] = p.in[I_LCW][(l * 4 + j) * 512 + ch];
            cpar[256 + tid] = p.in[I_LCB][l * 512 + ch];
        }
    }
    __syncthreads();
    float ba[4], bx[4], sp[4], hc[4];
#pragma unroll
    for (int ct = 0; ct < 4; ++ct) {
        const int ch = blk * 64 + 16 * ct + ln;
        ba[ct] = p.in[I_LBA][(l * 2 + d) * 512 + ch];
        bx[ct] = p.in[I_LBX][(l * 2 + d) * 512 + ch];
        sp[ct] = log1pf(expf(-p.in[I_LLAM][(l * 2 + d) * 512 + ch]));
        hc[ct] = 0.f;
    }
    const bf16_t* X = CB(C_LX) + (size_t)b * TPB * 512 + blk * 64;
    bf16_t* outp = (d == 0 ? DB(D_LH0) : DB(D_LH1)) + (size_t)b * TPB * 512 + blk * 64;
    for (int c = 0; c < 36; ++c) {
        const int tok = proc_tok(d, 64 * c + 16 * w + ln);
        const int lo = tok < CTXL ? 0 : CTXL, hi = tok < CTXL ? CTXL : TPB;
        bf16x8 af[2];
#pragma unroll
        for (int ks = 0; ks < 2; ++ks) {
            const int c0 = 32 * ks + 8 * g;
            float u8[8];
#pragma unroll
            for (int e = 0; e < 8; ++e) u8[e] = cpar[256 + c0 + e];
#pragma unroll
            for (int j = 0; j < 4; ++j) {
                const int tt = tok - 2 + j;
                if (tt >= lo && tt < hi) {
                    bf16x8 xv = *(const bf16x8*)(X + (size_t)tt * 512 + c0);
#pragma unroll
                    for (int e = 0; e < 8; ++e) u8[e] += cpar[j * 64 + c0 + e] * bf2f((bf16_t)xv[e]);
                }
            }
#pragma unroll
            for (int e = 0; e < 8; ++e) { uw[ln * 64 + c0 + e] = u8[e]; af[ks][e] = (short)f2bf(u8[e]); }
        }
        __builtin_amdgcn_wave_barrier();
        f32x4 acc[8];
#pragma unroll
        for (int nt = 0; nt < 8; ++nt) acc[nt] = f32x4{0.f, 0.f, 0.f, 0.f};
#pragma unroll
        for (int ks = 0; ks < 2; ++ks)
#pragma unroll
            for (int nt = 0; nt < 8; ++nt) {
                bf16x8 bfr = *(const bf16x8*)(Wt + (16 * nt + ln) * 72 + 32 * ks + 8 * g);
                acc[nt] = __builtin_amdgcn_mfma_f32_16x16x32_bf16(af[ks], bfr, acc[nt], 0, 0, 0);
            }
        float A[4][4], B[4][4];
#pragma unroll
        for (int ct = 0; ct < 4; ++ct) {
            float pa = 1.f, pb = 0.f;
#pragma unroll
            for (int j = 0; j < 4; ++j) {
                const float r = fsig(acc[ct][j] + ba[ct]);
                const float ig = fsig(acc[4 + ct][j] + bx[ct]);
                const float la = -8.f * r * sp[ct];
                const float a = __expf(la);
                const float uu = uw[(4 * g + j) * 64 + 16 * ct + ln];
                const float bb = __builtin_amdgcn_sqrtf(fmaxf(1.f - a * a, 0.f)) * ig * uu;
                pb = a * pb + bb; pa = a * pa;
                A[ct][j] = pa; B[ct][j] = pb;
            }
            float ia = pa, ib = pb;
#pragma unroll
            for (int dd = 1; dd <= 2; dd <<= 1) {
                const float qa = __shfl_up(ia, 16 * dd), qb = __shfl_up(ib, 16 * dd);
                if (g >= dd) { ib = ia * qb + ib; ia = ia * qa; }
            }
            float ea = __shfl_up(ia, 16), eb = __shfl_up(ib, 16);
            if (g == 0) { ea = 1.f; eb = 0.f; }
#pragma unroll
            for (int j = 0; j < 4; ++j) { B[ct][j] = A[ct][j] * eb + B[ct][j]; A[ct][j] = A[ct][j] * ea; }
            if (g == 3) {
                float* ag = agg + (((c & 1) * 4 + w) * 64 + 16 * ct + ln) * 2;
                ag[0] = ia; ag[1] = ib;
            }
        }
        __syncthreads();
#pragma unroll
        for (int ct = 0; ct < 4; ++ct) {
            float hrun = hc[ct], hin = 0.f;
#pragma unroll
            for (int w2 = 0; w2 < 4; ++w2) {
                const float* ag = agg + (((c & 1) * 4 + w2) * 64 + 16 * ct + ln) * 2;
                if (w2 == w) hin = hrun;
                hrun = ag[0] * hrun + ag[1];
            }
            hc[ct] = hrun;
#pragma unroll
            for (int j = 0; j < 4; ++j) {
                const int tok2 = proc_tok(d, 64 * c + 16 * w + 4 * g + j);
                outp[(size_t)tok2 * 512 + 16 * ct + ln] = f2bf(A[ct][j] * hin + B[ct][j]);
            }
        }
    }
    __syncthreads();
}

DEVI void phase_mix(const Params& p, int l, unsigned char* smem) {
    const int w = TIDX >> 6;
    const int NRET = 64, NLRU = 128;
    const int NLAT = 1024, NCTX = (l == 0 ? 128 : 0);
    const int ntask = NRET + NLRU + 2 * NLAT + 2 * NCTX;
    for (int task = BIDX; task < ntask; task += gridDim.x) {
        if (task < NRET) retention_walk(p, l, task, smem);
        else if (task < NRET + NLRU) lru_walk(p, l, task - NRET, smem);
        else {
            int a = task - NRET - NLRU;
            int kind, b, hsel, tq0, nkeys;
            if (a < NLAT) { kind = 0; b = a >> 7; const int r = a & 127; hsel = r >> 4; tq0 = CTXL + (r & 15) * 128; nkeys = TPB; }
            else if (a < 2 * NLAT) { a -= NLAT; kind = 1; b = a >> 7; const int r = a & 127; hsel = r >> 6; tq0 = CTXL + (r & 63) * 32; nkeys = TPB; }
            else if (a < 2 * NLAT + NCTX) { a -= 2 * NLAT; kind = 0; b = a >> 4; const int r = a & 15; hsel = r >> 1; tq0 = (r & 1) * 128; nkeys = CTXL; }
            else { a -= 2 * NLAT + NCTX; kind = 1; b = a >> 4; const int r = a & 15; hsel = r >> 3; tq0 = (r & 7) * 32; nkeys = CTXL; }
            if (kind == 0) attn_task<96, true>(p, b, hsel, tq0, nkeys, smem);
            else attn_task<64, false>(p, b, hsel, tq0, nkeys, smem);
        }
    }
}

DEVI void phase_fin(const Params& p, int l) {
    const int lane = TIDX & 63, w = TIDX >> 6;
    for (int row = BIDX * 4 + w; row < TT; row += gridDim.x * 4) {
        if (l == 1 && (row % TPB) < CTXL) continue;
        const size_t o = (size_t)row * 512 + lane * 8;
        bf16x8 f = *(const bf16x8*)(DB(D_OF) + o), bk = *(const bf16x8*)(DB(D_OB) + o), gt = *(const bf16x8*)(CB(C_RG) + o);
        float v[8], s = 0.f;
#pragma unroll
        for (int e = 0; e < 8; ++e) { v[e] = bf2f((bf16_t)f[e]) + bf2f((bf16_t)bk[e]); s += v[e]; }
#pragma unroll
        for (int off = 1; off < 16; off <<= 1) s += __shfl_xor(s, off);
        const float mu = s * (1.f / 128.f);
        float q = 0.f;
#pragma unroll
        for (int e = 0; e < 8; ++e) { v[e] -= mu; q += v[e] * v[e]; }
#pragma unroll
        for (int off = 1; off < 16; off <<= 1) q += __shfl_xor(q, off);
        const float rs = rsqrtf(q * (1.f / 128.f) + EPSV);
        const float* gn = p.in[I_RNORM] + l * 512 + lane * 8;
        bf16x8 ob;
#pragma unroll
        for (int e = 0; e < 8; ++e) ob[e] = (short)f2bf(siluf_(bf2f((bf16_t)gt[e])) * (v[e] * rs * gn[e]));
        *(bf16x8*)(DB(D_OF) + o) = ob;
        bf16x8 h0 = *(const bf16x8*)(DB(D_LH0) + o), h1 = *(const bf16x8*)(DB(D_LH1) + o), lg = *(const bf16x8*)(CB(C_LG) + o);
        bf16x8 oc;
#pragma unroll
        for (int e = 0; e < 8; ++e) oc[e] = (short)f2bf((bf2f((bf16_t)h0[e]) + bf2f((bf16_t)h1[e])) * gelu_tanh(bf2f((bf16_t)lg[e])));
        *(bf16x8*)(DB(D_LH0) + o) = oc;
    }
}

DEVI void phase_merge(const Params& p, int l, unsigned char* smem) {
    bf16_t* ct = (bf16_t*)smem;
    const int lane = TIDX & 63, wc = (TIDX >> 6) & 1;
    const int nmt = (l == 0 ? 144 : 128);
    for (int tile = BIDX; tile < nmt * 16; tile += gridDim.x) {
        const int mt = mt_of(tile >> 4, l != 0), nt = tile & 15;
        const int row0 = mt * 128;
        f32x4 m[4][2];
        acc_zero<64>(m);
        for (int n = 0; n < 4; ++n) {
            f32x4 ag[4][2], ap[4][2];
            acc_zero<64>(ag); acc_zero<64>(ap);
            AOp A1{HB, 1024, row0, nullptr};
            gemm_core<64>(ag, A1, WB(W_MG + (size_t)l * 4096 * 1024 + (size_t)(n * 1024 + nt * 64) * 1024), 1024, 1024, smem);
            const bf16_t* yb = n == 0 ? DB(D_YA) : (n == 1 ? DB(D_OF) : (n == 2 ? DB(D_LH0) : DB(D_YD)));
            AOp A2{yb, 512, row0, nullptr};
            gemm_core<64>(ap, A2, WB(W_BR + ((size_t)l * 4 + n) * 1024 * 512 + (size_t)(nt * 64) * 512), 512, 512, smem);
            const float* bm = p.in[I_BMG] + l * 4096 + n * 1024 + nt * 64 + wc * 32 + (lane & 15);
#pragma unroll
            for (int ni = 0; ni < 2; ++ni) {
                const float bias = bm[ni * 16];
#pragma unroll
                for (int mi = 0; mi < 4; ++mi)
#pragma unroll
                    for (int j = 0; j < 4; ++j) m[mi][ni][j] += sigmoidf_(ag[mi][ni][j] + bias) * ap[mi][ni][j];
            }
        }
        __syncthreads();
        acc_to_ct<64>(m, ct);
        __syncthreads();
        ep_store_rows<64>(ct, 0, CB(C_M) + nt * 64, 1024, row0);
        __syncthreads();
    }
}

DEVI void phase_wout(const Params& p, int l, unsigned char* smem) {
    bf16_t* ct = (bf16_t*)smem;
    const int nmt = (l == 0 ? 144 : 128);
    const int ngemm = nmt * 8, ncvt = 3072;
    for (int task = BIDX; task < ngemm + ncvt; task += gridDim.x) {
        if (task < ngemm) {
            const int mt = mt_of(task >> 3, l != 0), nt = task & 7;
            const int row0 = mt * 128, b = mt / 18, t0 = (mt % 18) * 128;
            const bool isctx = (mt % 18) < 2;
            const int bi = isctx ? 8 : b;
            f32x4 acc[4][4];
            acc_zero<128>(acc);
            AOp A{CB(C_M), 1024, row0, nullptr};
            gemm_core<128>(acc, A, WB(W_OUT + (size_t)l * 1024 * 1024 + (size_t)nt * 128 * 1024), 1024, 1024, smem);
            __syncthreads();
            acc_to_ct<128>(acc, ct);
            __syncthreads();
            const float* gate = WSF(OFF_MOD) + (size_t)(l * 9 + bi) * 6144 + 2 * 1024 + nt * 128;
            for (int c = TIDX; c < 128 * 32; c += 256) {
                const int i = c >> 5, jc = c & 31;
                const int t = t0 + i;
                const float* xs;
                if (l == 0) xs = isctx ? p.in[I_CTX] + ((size_t)b * CTXL + t) * DM : p.in[I_X] + ((size_t)b * SEQL + (t - CTXL)) * DM;
                else xs = XCUR + (size_t)(row0 + i) * DM;
                float4 x4 = *(const float4*)(xs + nt * 128 + jc * 4);
                float4 g4 = *(const float4*)(gate + jc * 4);
                uint2 y = *(const uint2*)(ct + i * CT_LD + jc * 4);
                x4.x += g4.x * __uint_as_float(y.x << 16);
                x4.y += g4.y * __uint_as_float(y.x & 0xffff0000u);
                x4.z += g4.z * __uint_as_float(y.y << 16);
                x4.w += g4.w * __uint_as_float(y.y & 0xffff0000u);
                *(float4*)(XCUR + (size_t)(row0 + i) * DM + nt * 128 + jc * 4) = x4;
            }
            __syncthreads();
        } else {
            int t = task - ngemm;
            const int k = t >> 10; t &= 1023;
            CvtJob j = get_moe_job(p, l, k);
            cvt_tile256(j, t, smem);
        }
    }
}

DEVI void phase_route(const Params& p, int l, unsigned char* smem) {
    const int tid = TIDX, lane = tid & 63, w = tid >> 6;
    float* hb = (float*)smem;
    float* red = (float*)(smem + 32768);
    const float* g2 = p.in[I_N2G] + l * 1024;
    const float* rw = p.in[I_RW];
    const float rbias = p.in[I_RB][lane];
    int* cnt = WSI(OFF_CNT) + l * 64;
    int* list = WSI(OFF_LIST);
    const int ngroups = (l == 0 ? TT : NBT * SEQL) / 8;
    for (int grp = BIDX; grp < ngroups; grp += gridDim.x) {
        const int row0 = l == 0 ? grp * 8 : (grp >> 8) * TPB + CTXL + (grp & 255) * 8;
        const int b = row0 / TPB;
        const bool isctx = (row0 % TPB) < CTXL;
        const int bi = isctx ? 8 : b;
        const float* md = WSF(OFF_MOD) + (size_t)(l * 9 + bi) * 6144 + 3 * 1024;
#pragma unroll
        for (int rr = 0; rr < 2; ++rr) {
            const int r = 2 * w + rr, row = row0 + r;
            const float* xr = XCUR + (size_t)row * DM;
            float v[16];
            float ss = 0.f;
#pragma unroll
            for (int i = 0; i < 4; ++i) {
                float4 x4 = *(const float4*)(xr + i * 256 + lane * 4);
                v[i * 4] = x4.x; v[i * 4 + 1] = x4.y; v[i * 4 + 2] = x4.z; v[i * 4 + 3] = x4.w;
                ss += x4.x * x4.x + x4.y * x4.y + x4.z * x4.z + x4.w * x4.w;
            }
            ss = wave_sum(ss);
            const float rstd = rsqrtf(ss * (1.f / 1024.f) + EPSV);
            bf16_t* ho = HB + (size_t)row * DM;
#pragma unroll
            for (int i = 0; i < 4; ++i) {
                const int c = i * 256 + lane * 4;
                float4 g4 = *(const float4*)(g2 + c);
                float4 sh = *(const float4*)(md + c);
                float4 sc = *(const float4*)(md + 1024 + c);
                float4 h4;
                h4.x = v[i * 4] * rstd * g4.x * (1.f + sc.x) + sh.x;
                h4.y = v[i * 4 + 1] * rstd * g4.y * (1.f + sc.y) + sh.y;
                h4.z = v[i * 4 + 2] * rstd * g4.z * (1.f + sc.z) + sh.z;
                h4.w = v[i * 4 + 3] * rstd * g4.w * (1.f + sc.w) + sh.w;
                uint2 o2;
                o2.x = (unsigned)f2bf(h4.x) | ((unsigned)f2bf(h4.y) << 16);
                o2.y = (unsigned)f2bf(h4.z) | ((unsigned)f2bf(h4.w) << 16);
                *(uint2*)(ho + c) = o2;
                hb[(c + 0) * 8 + r] = h4.x; hb[(c + 1) * 8 + r] = h4.y; hb[(c + 2) * 8 + r] = h4.z; hb[(c + 3) * 8 + r] = h4.w;
            }
        }
        __syncthreads();
        {
            float acc[8];
#pragma unroll
            for (int r = 0; r < 8; ++r) acc[r] = 0.f;
            const float* rwp = rw + (size_t)(256 * w) * 64 + lane;
            const float* hp = hb + (256 * w) * 8;
#pragma unroll 8
            for (int kk = 0; kk < 256; ++kk) {
                const float wv = rwp[kk * 64];
                const float4 h0 = *(const float4*)(hp + kk * 8), h1 = *(const float4*)(hp + kk * 8 + 4);
                acc[0] += wv * h0.x; acc[1] += wv * h0.y; acc[2] += wv * h0.z; acc[3] += wv * h0.w;
                acc[4] += wv * h1.x; acc[5] += wv * h1.y; acc[6] += wv * h1.z; acc[7] += wv * h1.w;
            }
#pragma unroll
            for (int r = 0; r < 8; ++r) red[(w * 8 + r) * 64 + lane] = acc[r];
        }
        __syncthreads();
#pragma unroll
        for (int rr = 0; rr < 2; ++rr) {
            const int r = 2 * w + rr, row = row0 + r;
            const float lg = red[(0 * 8 + r) * 64 + lane] + red[(1 * 8 + r) * 64 + lane] + red[(2 * 8 + r) * 64 + lane] + red[(3 * 8 + r) * 64 + lane];
            const float score = sigmoidf_(lg);
            const float biased = score + rbias;
            float v1 = biased; int i1 = lane;
#pragma unroll
            for (int off = 1; off < 8; off <<= 1) {
                float ov = __shfl_xor(v1, off); int oi = __shfl_xor(i1, off);
                if (ov > v1 || (ov == v1 && oi < i1)) { v1 = ov; i1 = oi; }
            }
            float v2 = (lane == i1) ? -3.0e38f : biased; int i2 = lane;
#pragma unroll
            for (int off = 1; off < 8; off <<= 1) {
                float ov = __shfl_xor(v2, off); int oi = __shfl_xor(i2, off);
                if (ov > v2 || (ov == v2 && oi < i2)) { v2 = ov; i2 = oi; }
            }
            float gv = v1 + v2; int gi = lane >> 3;
#pragma unroll
            for (int off = 8; off < 64; off <<= 1) {
                float ov = __shfl_xor(gv, off); int oi = __shfl_xor(gi, off);
                if (ov > gv || (ov == gv && oi < gi)) { gv = ov; gi = oi; }
            }
            const int e0 = __shfl(i1, gi * 8), e1 = __shfl(i2, gi * 8);
            const float s0 = __shfl(score, e0), s1 = __shfl(score, e1);
            if (lane == 0) {
                Rec rc;
                rc.e0 = e0; rc.e1 = e1;
                rc.p0 = atomicAdd(&cnt[e0], 1);
                rc.p1 = atomicAdd(&cnt[e1], 1);
                const float inv = 1.f / (s0 + s1);
                rc.w0 = s0 * inv; rc.w1 = s1 * inv; rc.pad0 = 0; rc.pad1 = 0;
                list[(size_t)e0 * TT + rc.p0] = row;
                list[(size_t)e1 * TT + rc.p1] = row;
                ((Rec*)(p.ws + OFF_REC))[row] = rc;
            }
        }
    }
}

DEVI void phase_moe1(const Params& p, int l, unsigned char* smem) {
    bf16_t* ct = (bf16_t*)smem;
    int* ridx = (int*)(smem + AUX_OFF);
    MoeTab mt = moe_tables(p, l, smem);
    const int* list = WSI(OFF_LIST);
    const int ntile = mt.tp[64] * 4;
    for (int tile = BIDX; tile < ntile; tile += gridDim.x) {
        const int rt = tile >> 2, nt = tile & 3;
        int e = 0;
        while (mt.tp[e + 1] <= rt) ++e;
        const int jt = rt - mt.tp[e];
        if (TIDX < 128) {
            const int idx = jt * 128 + TIDX;
            ridx[TIDX] = list[(size_t)e * TT + (idx < mt.cnt[e] ? idx : 0)];
        }
        __syncthreads();
        f32x4 acc[4][4];
        acc_zero<128>(acc);
        AOp A{HB, 1024, 0, ridx};
        gemm_core<128>(acc, A, CB(C_W13) + ((size_t)e * 512 + nt * 128) * 1024, 1024, 1024, smem);
        __syncthreads();
        acc_to_ct<128>(acc, ct);
        __syncthreads();
        const int slot0 = mt.seg[e] + jt * 128;
        for (int c = TIDX; c < 128 * 8; c += 256) {
            const int i = c >> 3, jc = c & 7;
            bf16x8 a = *(const bf16x8*)(ct + i * CT_LD + jc * 8), g = *(const bf16x8*)(ct + i * CT_LD + 64 + jc * 8), o;
#pragma unroll
            for (int q = 0; q < 8; ++q) o[q] = (short)f2bf(siluf_(bf2f((bf16_t)a[q])) * bf2f((bf16_t)g[q]));
            *(bf16x8*)(DB(D_ACT) + (size_t)(slot0 + i) * 256 + nt * 64 + jc * 8) = o;
        }
        __syncthreads();
    }
}
DEVI void phase_moe2(const Params& p, int l, unsigned char* smem) {
    bf16_t* ct = (bf16_t*)smem;
    MoeTab mt = moe_tables(p, l, smem);
    const int ntile = mt.tp[64] * 8;
    for (int tile = BIDX; tile < ntile; tile += gridDim.x) {
        const int rt = tile >> 3, nt = tile & 7;
        int e = 0;
        while (mt.tp[e + 1] <= rt) ++e;
        const int jt = rt - mt.tp[e];
        const int slot0 = mt.seg[e] + jt * 128;
        f32x4 acc[4][4];
        acc_zero<128>(acc);
        AOp A{DB(D_ACT), 256, slot0, nullptr};
        gemm_core<128>(acc, A, CB(C_W2) + ((size_t)e * 1024 + nt * 128) * 256, 256, 256, smem);
        __syncthreads();
        acc_to_ct<128>(acc, ct);
        __syncthreads();
        ep_store_rows<128>(ct, 0, DB(D_YS) + nt * 128, 1024, slot0);
        __syncthreads();
    }
}


#define XB_TMO      128
#define XB_XCNT(j)  (256  + 64 * (j))
#define XB_XSUB(j)  (1280 + 64 * (j))
#define XB_XGEN(j)  (2304 + 64 * (j))
#define XB_TOP      3328
#define XB_TOPGEN   3392
#define XB_SPIN_CAP (1u << 22)
#define LAS __attribute__((address_space(3)))
DEVI unsigned xb_ld(unsigned* p) { return __hip_atomic_load(p, __ATOMIC_RELAXED, __HIP_MEMORY_SCOPE_AGENT); }
DEVI unsigned xb_add(unsigned* p, unsigned v) { return __hip_atomic_fetch_add(p, v, __ATOMIC_RELAXED, __HIP_MEMORY_SCOPE_AGENT); }
DEVI unsigned xb_xcc_id() { return (unsigned)__builtin_amdgcn_s_getreg((3 << 11) | 20) & 0xFu; }
#define XB_SPIN(cond, bar) do { unsigned _sp = 0; while (cond) { __builtin_amdgcn_s_sleep(1); \
    if ((++_sp & 255u) == 0u) { if (xb_ld(&(bar)[XB_TMO])) break; if (_sp > XB_SPIN_CAP) { atomicAdd(&(bar)[XB_TMO], 1u); break; } } } } while (0)
struct XcdBarrier { unsigned* bar; unsigned x; volatile LAS unsigned* st; };
DEVI XcdBarrier xcd_barrier_post(unsigned* bar, volatile LAS unsigned* st) {
    XcdBarrier b; b.bar = bar; b.x = xb_xcc_id(); b.st = st;
    if (__builtin_amdgcn_workitem_id_x() == 0) (void)xb_add(&bar[XB_XCNT(b.x)], 1u);
    return b;
}
DEVI void xcd_barrier_complete(unsigned* bar, unsigned x, unsigned& nloc, unsigned& nx) {
    const unsigned G = gridDim.x * gridDim.y * gridDim.z;
    unsigned sum, cnt, mine, sp = 0u;
    for (;;) {
        sum = 0u; cnt = 0u; mine = 0u;
#pragma unroll
        for (unsigned j = 0; j < 16; ++j) { const unsigned c = xb_ld(&bar[XB_XCNT(j)]); sum += c; cnt += (c > 0u) ? 1u : 0u; mine = (j == x) ? c : mine; }
        if (sum == G) break;
        __builtin_amdgcn_s_sleep(1);
        if ((++sp & 255u) == 0u) { if (xb_ld(&bar[XB_TMO])) break; if (sp > XB_SPIN_CAP) { atomicAdd(&bar[XB_TMO], 1u); break; } }
    }
    nloc = mine > 0u ? mine : 1u; nx = cnt > 0u ? cnt : 1u;
}
DEVI void xcd_barrier(const XcdBarrier& b) {
    asm volatile("s_waitcnt vmcnt(0)" ::: "memory");
    __syncthreads();
    if (__builtin_amdgcn_workitem_id_x() == 0) {
        unsigned* bar = b.bar;
        __builtin_amdgcn_s_waitcnt(0);
        unsigned nloc = b.st[0], nx = b.st[1];
        if (nloc == 0u) { xcd_barrier_complete(bar, b.x, nloc, nx); b.st[0] = nloc; b.st[1] = nx; }
        const unsigned old = xb_add(&bar[XB_XSUB(b.x)], 1u);
        const unsigned gen = old / nloc;
        if (old + 1u == (gen + 1u) * nloc) {
            __builtin_amdgcn_fence(__ATOMIC_RELEASE, "agent");
            asm volatile("s_waitcnt vmcnt(0)" ::: "memory");
            const unsigned og = xb_add(&bar[XB_TOP], 1u);
            const unsigned tg = og / nx;
            if (og + 1u == (tg + 1u) * nx) xb_add(&bar[XB_TOPGEN], 1u);
            else XB_SPIN(xb_ld(&bar[XB_TOPGEN]) == tg, bar);
            __builtin_amdgcn_fence(__ATOMIC_ACQUIRE, "agent");
            xb_add(&bar[XB_XGEN(b.x)], 1u);
            asm volatile("s_waitcnt vmcnt(0)" ::: "memory");
        } else {
            XB_SPIN(xb_ld(&bar[XB_XGEN(b.x)]) == gen, bar);
            __builtin_amdgcn_fence(__ATOMIC_ACQUIRE, "agent");
            asm volatile("s_waitcnt vmcnt(0)" ::: "memory");
        }
    }
    __syncthreads();
}

constexpr int NPHASE = 22;
DEVI void run_phase(const Params& p, int ph, unsigned char* smem) {
#ifndef ONLYK
    if (ph == 0) { phase0(p, smem); return; }
    if (ph == 21) { phase_norm1(p, 1, 1, smem); return; }
#endif
    const int l = (ph - 1) / 10, k = (ph - 1) % 10;
#ifdef ONLYK
    if (k != ONLYK) return;
#endif
    switch (k) {
    case 0: phase_norm1(p, l, 0, smem); break;
    case 1: phase_win(p, l, smem); break;
    case 2: phase_mla_up(p, l, smem); break;
    case 3: phase_mix(p, l, smem); break;
    case 4: phase_fin(p, l); break;
    case 5: phase_merge(p, l, smem); break;
    case 6: phase_wout(p, l, smem); break;
    case 7: phase_route(p, l, smem); break;
    case 8: phase_moe1(p, l, smem); break;
    default: phase_moe2(p, l, smem); break;
    }
}

__global__ void __launch_bounds__(256, 2) k_main(Params p, int ph_lo, int ph_hi) {
    __shared__ __attribute__((aligned(16))) unsigned char smem[SMEM_BYTES];
    __shared__ uint4 xb_words;
    if (__builtin_amdgcn_workitem_id_x() == 0) xb_words = make_uint4(0u, 0u, 0u, 0u);
    __syncthreads();
    XcdBarrier xb = xcd_barrier_post((unsigned*)(p.ws + OFF_BAR), (volatile LAS unsigned*)&xb_words);
    for (int ph = ph_lo; ph < ph_hi; ++ph) {
        run_phase(p, ph, smem);
#ifdef DUPK
        if (ph >= 1 && ph <= 20 && ((ph - 1) % 10) == DUPK) run_phase(p, ph, smem);
        if (DUPK == 10 && ph == 0) run_phase(p, ph, smem);
#endif
        if (ph + 1 < ph_hi) {
            if (ph == ph_lo) cg::this_grid().sync();
            else xcd_barrier(xb);
        }
    }
}

extern "C" void kernel_launch(void* const* d_in, const int* in_sizes, int n_in, void* d_out, int out_size, void* d_ws, size_t ws_size,
                              hipStream_t stream) {
    if (ws_size < WS_NEED || n_in < N_IN) { fprintf(stderr, "workspace too small: %zu < %zu\n", ws_size, (size_t)WS_NEED); return; }
    Params p{};
    for (int i = 0; i < N_IN; ++i) p.in[i] = (const float*)d_in[i];
    p.out = (float*)d_out;
    p.ws = (unsigned char*)d_ws;
    static int grid_blocks = 0;
    if (!grid_blocks) {
        int dev = 0, cus = 0, per_cu = 0;
        hipGetDevice(&dev);
        hipDeviceGetAttribute(&cus, hipDeviceAttributeMultiprocessorCount, dev);
        hipOccupancyMaxActiveBlocksPerMultiprocessor(&per_cu, k_main, 256, 0);
        if (per_cu > 2) per_cu = 2;
        if (per_cu < 1) per_cu = 1;
        grid_blocks = cus * per_cu;
    }
    hipMemsetAsync(p.ws + OFF_BAR, 0, 16384, stream);
#if ONE_LAUNCH
    int lo = 0, hi = NPHASE;
    void* args[] = {&p, &lo, &hi};
    hipError_t e = hipLaunchCooperativeKernel((void*)k_main, dim3(grid_blocks), dim3(256), args, 0, stream);
    if (e != hipSuccess) fprintf(stderr, "cooperative launch failed: %s (grid %d)\n", hipGetErrorString(e), grid_blocks);
#else
    for (int ph = 0; ph < NPHASE; ++ph) hipLaunchKernelGGL(k_main, dim3(grid_blocks), dim3(256), 0, stream, p, ph, ph + 1);
#endif
}
```

```cpp
#include <hip/hip_runtime.h>
#include <hip/hip_cooperative_groups.h>
#include <stdint.h>
#include <stdio.h>
namespace cg = cooperative_groups;

#define DEVI __device__ __forceinline__
#define LAS __attribute__((address_space(3)))
typedef unsigned short bf16_t;
typedef __attribute__((ext_vector_type(8))) short bf16x8;
typedef __attribute__((ext_vector_type(4))) float f32x4;
typedef __attribute__((ext_vector_type(16))) float f32x16;
typedef __attribute__((ext_vector_type(4))) short bf16x4;

#ifndef NAIVE_GEMM
#define NAIVE_GEMM 0
#endif
#ifndef ONE_LAUNCH
#define ONE_LAUNCH 1
#endif

constexpr int DM = 1024, NBT = 8, SEQL = 2048, CTXL = 256, TPB = 2304, TT = 18432;
constexpr int DINP = 3840;
constexpr float LOG2E = 1.4426950408889634f;
constexpr float EPSV = 1e-6f;
constexpr int NSLOT = 2 * TT + 64 * 128;

enum { I_X = 0, I_C, I_CTX, I_CCTX, I_ADAW, I_ADAB, I_N1G, I_N2G, I_WIN, I_MQN, I_MKVN, I_WUQ, I_WUKV, I_RDEC, I_RNORM,
       I_LCW, I_LCB, I_LWA, I_LBA, I_LWX, I_LBX, I_LLAM, I_GQN, I_GKN, I_WBR, I_WMG, I_BMG, I_WOUT, I_RW, I_RB,
       I_W1, I_W3, I_W2, I_FN, N_IN };

constexpr size_t AL(size_t x) { return (x + 255) & ~(size_t)255; }
constexpr size_t OFF_BAR = 0;
constexpr size_t OFF_CNT = 16384;
constexpr size_t OFF_MOD = OFF_CNT + 4096;
constexpr size_t OFF_R64 = AL(OFF_MOD + (size_t)2 * 9 * 6144 * 4);
constexpr size_t OFF_R32 = OFF_R64 + (size_t)2048 * 64 * 4;
constexpr size_t OFF_REC = OFF_R32 + (size_t)2048 * 32 * 4;
constexpr size_t OFF_LIST = OFF_REC + (size_t)TT * 32;
constexpr size_t OFF_PRIV = AL(OFF_LIST + (size_t)64 * TT * 4);
constexpr size_t OFF_W = OFF_PRIV + (size_t)2048 * 1024;
constexpr size_t W_IN = 0;
constexpr size_t W_UQ = W_IN + (size_t)2 * 3840 * 1024;
constexpr size_t W_UKV = W_UQ + (size_t)2 * 768 * 256;
constexpr size_t W_BR = W_UKV + (size_t)2 * 1024 * 128;
constexpr size_t W_MG = W_BR + (size_t)2 * 4 * 1024 * 512;
constexpr size_t W_OUT = W_MG + (size_t)2 * 4096 * 1024;
constexpr size_t W_LRU = W_OUT + (size_t)2 * 1024 * 1024;
constexpr size_t W_RT = W_LRU + (size_t)2 * 2 * 8 * 2 * 64 * 64;
constexpr size_t W_END = W_RT + (size_t)64 * 1024;
constexpr size_t OFF_XCUR = AL(OFF_W + W_END * 2);
constexpr size_t OFF_H = OFF_XCUR + (size_t)TT * 1024 * 4;
constexpr size_t OFF_C = OFF_H + (size_t)TT * 1024 * 2;
constexpr size_t C_CQ = 0;
constexpr size_t C_CKV = C_CQ + (size_t)TT * 256;
constexpr size_t C_KR = C_CKV + (size_t)TT * 128;
constexpr size_t C_MQ = C_KR + (size_t)TT * 32;
constexpr size_t C_KN = C_MQ + (size_t)TT * 768;
constexpr size_t C_VMT = C_KN + (size_t)TT * 512;
constexpr size_t C_RQ = C_VMT + (size_t)TT * 512;
constexpr size_t C_RK = C_RQ + (size_t)TT * 256;
constexpr size_t C_RKT = C_RK + (size_t)TT * 256;
constexpr size_t C_RVT = C_RKT + (size_t)TT * 256;
constexpr size_t C_RG = C_RVT + (size_t)TT * 512;
constexpr size_t C_LX = C_RG + (size_t)TT * 512;
constexpr size_t C_LG = C_LX + (size_t)TT * 512;
constexpr size_t C_GQ = C_LG + (size_t)TT * 512;
constexpr size_t C_GK = C_GQ + (size_t)TT * 512;
constexpr size_t C_GVT = C_GK + (size_t)TT * 128;
constexpr size_t C_END = C_GVT + (size_t)TT * 128;
constexpr size_t C_M = 0;
constexpr size_t C_W13 = (size_t)24 * 1024 * 1024;
constexpr size_t C_W2 = C_W13 + (size_t)64 * 512 * 1024;
static_assert(C_W2 + (size_t)64 * 1024 * 256 <= C_END, "moe alias");
static_assert((size_t)TT * 1024 <= C_W13, "m alias");
constexpr size_t OFF_D = OFF_C + C_END * 2;
constexpr size_t D_YA = 0;
constexpr size_t D_YD = (size_t)TT * 512;
constexpr size_t D_OF = (size_t)2 * TT * 512;
constexpr size_t D_OB = (size_t)3 * TT * 512;
constexpr size_t D_LH0 = (size_t)4 * TT * 512;
constexpr size_t D_LH1 = (size_t)5 * TT * 512;
constexpr size_t D_ACT = 0;
constexpr size_t D_YS = (size_t)12 * 1024 * 1024;
constexpr size_t D_END = D_YS + (size_t)NSLOT * 1024;
static_assert((size_t)NSLOT * 256 <= D_YS, "act alias");
static_assert((size_t)6 * TT * 512 <= D_END, "d size");
constexpr size_t OFF_MOEW = AL(OFF_D + D_END * 2);
constexpr size_t MW_13 = 0, MW_2 = (size_t)64 * 512 * 1024, MW_END = MW_2 + (size_t)64 * 1024 * 256;
constexpr size_t WS_NEED = OFF_MOEW + MW_END * 2;

struct Params {
    const float* in[N_IN];
    float* out;
    unsigned char* ws;
};

#define WSF(off) ((float*)(p.ws + (off)))
#define WSI(off) ((int*)(p.ws + (off)))
#define WB(el) ((bf16_t*)(p.ws + OFF_W) + (el))
#define CB(el) ((bf16_t*)(p.ws + OFF_C) + (el))
#define DB(el) ((bf16_t*)(p.ws + OFF_D) + (el))
#define MWB(el) ((bf16_t*)(p.ws + OFF_MOEW) + (el))
#define HB ((bf16_t*)(p.ws + OFF_H))
#define XCUR ((float*)(p.ws + OFF_XCUR))

constexpr int SMEM_BYTES = 65536;
constexpr int DYN_LDS = 0;
constexpr int CT_LD = 136;
constexpr int AUX_OFF = 36864;

DEVI int launder_tid() { int t = __builtin_amdgcn_workitem_id_x(); asm volatile("" : "+v"(t)); return t; }
DEVI int launder_bid() { int t = __builtin_amdgcn_workgroup_id_x(); asm volatile("" : "+s"(t)); return t; }
#define TIDX launder_tid()
#define BIDX launder_bid()
DEVI float bf2f(bf16_t v) { return __uint_as_float(((unsigned)v) << 16); }
DEVI bf16_t f2bf(float f) {
    __bf16 h = (__bf16)f;
    return __builtin_bit_cast(unsigned short, h);
}
DEVI float sigmoidf_(float x) { return 1.f / (1.f + __expf(-x)); }
DEVI float siluf_(float x) { return x / (1.f + __expf(-x)); }
DEVI float gelu_tanh(float x) {
    float u = 0.7978845608028654f * (x + 0.044715f * x * x * x);
    return 0.5f * x * (1.f + tanhf(u));
}
DEVI float wave_sum(float v) {
#pragma unroll
    for (int o = 32; o > 0; o >>= 1) v += __shfl_xor(v, o);
    return v;
}
DEVI int mt_of(int q, bool latonly) { return latonly ? (q >> 4) * 18 + 2 + (q & 15) : q; }

struct CvtJob { const float* src; bf16_t* dst; const float* ks; int K, N, ldd, batch; size_t sbs, dbs; int mode; };
DEVI int cvt_rowmap(int mode, int n) {
    if (mode == 1) return n < 384 ? n : (n < 416 ? n - 384 + 3712 : n - 32);
    if (mode == 2) { int h = n / 96, j = n % 96; return j < 64 ? h * 64 + j : 512 + h * 32 + (j - 64); }
    if (mode == 3) return (n >> 6) * 128 + (n & 63);
    return n;
}
DEVI void cvt_tile(const CvtJob& j, int tile, float* lds) {
    const int tn = j.N / 32, tk = j.K / 64, per = tn * tk;
    const int bb = tile / per, r = tile % per, kt = r / tn, nt = r % tn;
    const float* s = j.src + (size_t)bb * j.sbs + (size_t)(kt * 64) * j.N + nt * 32;
    const int tx = TIDX & 31, ty = TIDX >> 5;
#pragma unroll
    for (int i = 0; i < 8; ++i) {
        int k = ty + 8 * i;
        float v = s[(size_t)k * j.N + tx];
        if (j.ks) v *= j.ks[kt * 64 + k];
        lds[k * 33 + tx] = v;
    }
    __syncthreads();
    bf16_t* d = j.dst + (size_t)bb * j.dbs;
#pragma unroll
    for (int i = 0; i < 4; ++i) {
        int n = ty + 8 * i, kk = tx * 2;
        unsigned lo = f2bf(lds[kk * 33 + n]), hi = f2bf(lds[(kk + 1) * 33 + n]);
        int row = cvt_rowmap(j.mode, nt * 32 + n);
        *(unsigned*)(d + (size_t)row * j.ldd + kt * 64 + kk) = lo | (hi << 16);
    }
    __syncthreads();
}

DEVI void cvt_tile256(const CvtJob& j, int tile, unsigned char* smem) {
    constexpr int NS = 260;
    bf16_t* T = (bf16_t*)smem;
    const int tn = j.N / 256, tk = j.K / 64, per = tn * tk;
    const int bb = tile / per, r = tile % per, kt = r / tn, nt = r % tn;
    const float* s = j.src + (size_t)bb * j.sbs + (size_t)(kt * 64) * j.N + nt * 256;
    const int tid = TIDX, lane = tid & 63, w = tid >> 6;
    float4 v[16];
#pragma unroll
    for (int i = 0; i < 16; ++i) v[i] = *(const float4*)(s + (size_t)(w + 4 * i) * j.N + lane * 4);
    __syncthreads();
#pragma unroll
    for (int i = 0; i < 16; ++i) {
        const int k = w + 4 * i;
        uint2 o;
        o.x = (unsigned)f2bf(v[i].x) | ((unsigned)f2bf(v[i].y) << 16);
        o.y = (unsigned)f2bf(v[i].z) | ((unsigned)f2bf(v[i].w) << 16);
        *(uint2*)(T + k * NS + lane * 4) = o;
    }
    __syncthreads();
    bf16_t* d = j.dst + (size_t)bb * j.dbs;
#pragma unroll
    for (int i = 0; i < 8; ++i) {
        const int c = tid + 256 * i, n = c >> 3, kc = c & 7;
        bf16x8 o;
#pragma unroll
        for (int e = 0; e < 8; ++e) o[e] = (short)T[(kc * 8 + e) * NS + n];
        const int row = cvt_rowmap(j.mode, nt * 256 + n);
        *(bf16x8*)(d + (size_t)row * j.ldd + kt * 64 + kc * 8) = o;
    }
}
__constant__ const int CVT_TILES[9] = {1872, 96, 64, 1024, 2048, 512, 32, 32, 32};
constexpr int CVT_PER_LAYER = 1872 + 96 + 64 + 1024 + 2048 + 512 + 32 + 32 + 32;
DEVI CvtJob get_job(const Params& p, int l, int k) {
    CvtJob j; j.ks = nullptr; j.batch = 1; j.sbs = 0; j.dbs = 0; j.mode = 0;
    switch (k) {
    case 0: j.src = p.in[I_WIN] + (size_t)l * 1024 * 3744; j.dst = WB(W_IN + (size_t)l * 3840 * 1024); j.K = 1024; j.N = 3744; j.ldd = 1024; j.mode = 1; break;
    case 1: j.src = p.in[I_WUQ] + (size_t)l * 256 * 768; j.dst = WB(W_UQ + (size_t)l * 768 * 256); j.K = 256; j.N = 768; j.ldd = 256; j.ks = p.in[I_MQN] + l * 256; j.mode = 2; break;
    case 2: j.src = p.in[I_WUKV] + (size_t)l * 128 * 1024; j.dst = WB(W_UKV + (size_t)l * 1024 * 128); j.K = 128; j.N = 1024; j.ldd = 128; j.ks = p.in[I_MKVN] + l * 128; break;
    case 3: j.src = p.in[I_WBR] + (size_t)l * 4 * 512 * 1024; j.dst = WB(W_BR + (size_t)l * 4 * 1024 * 512); j.K = 512; j.N = 1024; j.ldd = 512; j.batch = 4; j.sbs = 512 * 1024; j.dbs = 1024 * 512; break;
    case 4: j.src = p.in[I_WMG] + (size_t)l * 1024 * 4096; j.dst = WB(W_MG + (size_t)l * 4096 * 1024); j.K = 1024; j.N = 4096; j.ldd = 1024; break;
    case 5: j.src = p.in[I_WOUT] + (size_t)l * 1024 * 1024; j.dst = WB(W_OUT + (size_t)l * 1024 * 1024); j.K = 1024; j.N = 1024; j.ldd = 1024; break;
    case 6: j.src = p.in[I_LWA] + (size_t)l * 16 * 4096; j.dst = WB(W_LRU + (size_t)l * 16 * 8192); j.K = 64; j.N = 64; j.ldd = 64; j.batch = 16; j.sbs = 4096; j.dbs = 8192; break;
    case 8: j.src = p.in[I_RW]; j.dst = WB(W_RT); j.K = 1024; j.N = 64; j.ldd = 1024; break;
    default: j.src = p.in[I_LWX] + (size_t)l * 16 * 4096; j.dst = WB(W_LRU + (size_t)l * 16 * 8192 + 4096); j.K = 64; j.N = 64; j.ldd = 64; j.batch = 16; j.sbs = 4096; j.dbs = 8192; break;
    }
    return j;
}
DEVI CvtJob get_moe_job(const Params& p, int l, int k) {
    CvtJob j; j.ks = nullptr; j.batch = 64; j.sbs = 262144;
    if (k == 0) { j.src = p.in[I_W1] + (size_t)l * 64 * 262144; j.dst = MWB(MW_13); j.K = 1024; j.N = 256; j.ldd = 1024; j.dbs = 512 * 1024; j.mode = 3; }
    else if (k == 1) { j.src = p.in[I_W3] + (size_t)l * 64 * 262144; j.dst = MWB(MW_13 + 64 * 1024); j.K = 1024; j.N = 256; j.ldd = 1024; j.dbs = 512 * 1024; j.mode = 3; }
    else { j.src = p.in[I_W2] + (size_t)l * 64 * 262144; j.dst = MWB(MW_2); j.K = 256; j.N = 1024; j.ldd = 256; j.dbs = 262144; j.mode = 0; }
    return j;
}

struct AOp { const bf16_t* base; int ld; int row0; const int* ridx; };
DEVI const bf16_t* arow(const AOp& a, int i) {
    int r = a.ridx ? a.ridx[i] : a.row0 + i;
    return a.base + (size_t)r * a.ld;
}

#if NAIVE_GEMM
template <int BN>
DEVI void gemm_core(f32x4 (&acc)[4][BN / 32], const AOp& A, const bf16_t* B, int ldb, int K, unsigned char* smem) {
    constexpr int NI = BN / 32;
    const int tid = TIDX, lane = tid & 63, wid = tid >> 6, wr = wid >> 1, wc = wid & 1;
    for (int k0 = 0; k0 < K; k0 += 8) {
        bf16x8 bv[NI];
#pragma unroll
        for (int ni = 0; ni < NI; ++ni) bv[ni] = *(const bf16x8*)(B + (size_t)(wc * (BN / 2) + ni * 16 + (lane & 15)) * ldb + k0);
#pragma unroll
        for (int mi = 0; mi < 4; ++mi)
#pragma unroll
            for (int j = 0; j < 4; ++j) {
                bf16x8 av = *(const bf16x8*)(arow(A, wr * 64 + mi * 16 + (lane >> 4) * 4 + j) + k0);
#pragma unroll
                for (int ni = 0; ni < NI; ++ni) {
                    float s = 0.f;
#pragma unroll
                    for (int e = 0; e < 8; ++e) s += bf2f((bf16_t)av[e]) * bf2f((bf16_t)bv[ni][e]);
                    acc[mi][ni][j] += s;
                }
            }
    }
}
#else
#define GAS __attribute__((address_space(1)))
template <int BN>
DEVI void gemm_core(f32x4 (&acc)[4][BN / 32], const AOp& A, const bf16_t* B, int ldb, int K, unsigned char* smem) {
    constexpr int NI = BN / 32;
    constexpr int NBL = BN / 32;
    constexpr int STG = 32768;
    const int tid = TIDX, lane = tid & 63, wid = tid >> 6, wr = wid >> 1, wc = wid & 1;
    const int lr = tid >> 3;
    const int kc = (tid & 7) ^ (lr & 7);
    const bf16_t* ap[4];
    const bf16_t* bp[NBL];
#pragma unroll
    for (int i = 0; i < 4; ++i) ap[i] = arow(A, lr + 32 * i) + kc * 8;
#pragma unroll
    for (int i = 0; i < NBL; ++i) bp[i] = B + (size_t)(lr + 32 * i) * ldb + kc * 8;
    LAS unsigned char* lA = (LAS unsigned char*)smem + tid * 16;
    LAS unsigned char* lB = lA + 16384;
    const int nk = K >> 6;
    const int arow_off = (wr * 64 + (lane & 15)) * 128;
    const int brow_off = 16384 + (wc * (BN / 2) + (lane & 15)) * 128;
    __syncthreads();
#pragma unroll
    for (int i = 0; i < 4; ++i) __builtin_amdgcn_global_load_lds((const GAS unsigned*)(ap[i]), (LAS unsigned*)(lA + i * 4096), 16, 0, 0);
#pragma unroll
    for (int i = 0; i < NBL; ++i) __builtin_amdgcn_global_load_lds((const GAS unsigned*)(bp[i]), (LAS unsigned*)(lB + i * 4096), 16, 0, 0);
    for (int kt = 0; kt < nk; ++kt) {
        __syncthreads();
        if (kt + 1 < nk) {
            const int ko = (kt + 1) * 64;
            const int so = ((kt + 1) & 1) * STG;
#pragma unroll
            for (int i = 0; i < 4; ++i) __builtin_amdgcn_global_load_lds((const GAS unsigned*)(ap[i] + ko), (LAS unsigned*)(lA + so + i * 4096), 16, 0, 0);
#pragma unroll
            for (int i = 0; i < NBL; ++i) __builtin_amdgcn_global_load_lds((const GAS unsigned*)(bp[i] + ko), (LAS unsigned*)(lB + so + i * 4096), 16, 0, 0);
        }
        const unsigned char* cs = smem + (kt & 1) * STG;
#pragma unroll
        for (int ks = 0; ks < 2; ++ks) {
            const int pch = ((ks * 4 + (lane >> 4)) ^ (lane & 7)) << 4;
            bf16x8 af[4], bfr[NI];
#pragma unroll
            for (int mi = 0; mi < 4; ++mi) af[mi] = *(const bf16x8*)(cs + arow_off + mi * 2048 + pch);
#pragma unroll
            for (int ni = 0; ni < NI; ++ni) bfr[ni] = *(const bf16x8*)(cs + brow_off + ni * 2048 + pch);
#pragma unroll
            for (int mi = 0; mi < 4; ++mi)
#pragma unroll
                for (int ni = 0; ni < NI; ++ni)
                    acc[mi][ni] = __builtin_amdgcn_mfma_f32_16x16x32_bf16(af[mi], bfr[ni], acc[mi][ni], 0, 0, 0);
        }
    }
}
#endif

template <int BN>
DEVI void acc_zero(f32x4 (&acc)[4][BN / 32]) {
#pragma unroll
    for (int mi = 0; mi < 4; ++mi)
#pragma unroll
        for (int ni = 0; ni < BN / 32; ++ni) acc[mi][ni] = f32x4{0.f, 0.f, 0.f, 0.f};
}
template <int BN>
DEVI void acc_to_ct(const f32x4 (&acc)[4][BN / 32], bf16_t* ct) {
    const int tid = TIDX, lane = tid & 63, wid = tid >> 6, wr = wid >> 1, wc = wid & 1;
#pragma unroll
    for (int mi = 0; mi < 4; ++mi)
#pragma unroll
        for (int ni = 0; ni < BN / 32; ++ni)
#pragma unroll
            for (int j = 0; j < 4; ++j)
                ct[(wr * 64 + mi * 16 + (lane >> 4) * 4 + j) * CT_LD + wc * (BN / 2) + ni * 16 + (lane & 15)] = f2bf(acc[mi][ni][j]);
}

template <int NC>
DEVI void ep_store_rows(const bf16_t* ct, int c0, bf16_t* dst, int ldd, int row0) {
    constexpr int CPR = NC / 8;
    for (int c = TIDX; c < 128 * CPR; c += 256) {
        int i = c / CPR, jc = c % CPR;
        *(bf16x8*)(dst + (size_t)(row0 + i) * ldd + jc * 8) = *(const bf16x8*)(ct + i * CT_LD + c0 + jc * 8);
    }
}
DEVI void ep_store_T(const bf16_t* ct, int c0, int nc, bf16_t* dstT, int ldT, int t0) {
    for (int c = TIDX; c < nc * 16; c += 256) {
        int j = c >> 4, ic = c & 15;
        bf16x8 v;
#pragma unroll
        for (int e = 0; e < 8; ++e) v[e] = (short)ct[(ic * 8 + e) * CT_LD + c0 + j];
        *(bf16x8*)(dstT + (size_t)j * ldT + t0 + ic * 8) = v;
    }
}
DEVI void ep_rope64(bf16_t* ct, const float* gain, float scale, bool lat, int pos0, const float* cs64) {
    const int row = TIDX >> 1, half = TIDX & 1;
    bf16_t* pr = ct + row * CT_LD + half * 64;
    float v[64];
#pragma unroll
    for (int c = 0; c < 8; ++c) {
        bf16x8 t = *(const bf16x8*)(pr + c * 8);
#pragma unroll
        for (int e = 0; e < 8; ++e) v[c * 8 + e] = bf2f((bf16_t)t[e]);
    }
    if (gain) {
        float ss = 0.f;
#pragma unroll
        for (int d = 0; d < 64; ++d) ss += v[d] * v[d];
        float rstd = rsqrtf(ss * (1.f / 64.f) + EPSV);
#pragma unroll
        for (int d = 0; d < 64; ++d) v[d] = v[d] * rstd * gain[d];
    }
    if (lat) {
        const float* cs = cs64 + (size_t)(pos0 + row) * 64;
#pragma unroll
        for (int i = 0; i < 16; ++i) {
            float a = v[i], b = v[i + 16], c = cs[i], s = cs[32 + i];
            v[i] = a * c - b * s; v[i + 16] = b * c + a * s;
            a = v[32 + i]; b = v[48 + i]; c = cs[16 + i]; s = cs[48 + i];
            v[32 + i] = a * c - b * s; v[48 + i] = b * c + a * s;
        }
    }
#pragma unroll
    for (int c = 0; c < 8; ++c) {
        bf16x8 t;
#pragma unroll
        for (int e = 0; e < 8; ++e) t[e] = (short)f2bf(v[c * 8 + e] * scale);
        *(bf16x8*)(pr + c * 8) = t;
    }
}
DEVI void ep_rope32(bf16_t* ct, int ngroups, const float* rstd, float scale, bool lat, int pos0, const float* cs32) {
    const int row = TIDX >> 1, half = TIDX & 1;
    const float rs = (rstd ? rstd[row] : 1.f) * scale;
#pragma unroll
    for (int gg = 0; gg < 2; ++gg) {
        const int g = half * 2 + gg;
        if (g < ngroups) {
            bf16_t* pr = ct + row * CT_LD + g * 32;
            float v[32];
#pragma unroll
            for (int c = 0; c < 4; ++c) {
                bf16x8 t = *(const bf16x8*)(pr + c * 8);
#pragma unroll
                for (int e = 0; e < 8; ++e) v[c * 8 + e] = bf2f((bf16_t)t[e]);
            }
            if (lat) {
                const float* cs = cs32 + (size_t)(pos0 + row) * 32;
#pragma unroll
                for (int i = 0; i < 8; ++i) {
                    float a = v[i], b = v[i + 8], c = cs[i], s = cs[16 + i];
                    v[i] = a * c - b * s; v[i + 8] = b * c + a * s;
                    a = v[16 + i]; b = v[24 + i]; c = cs[8 + i]; s = cs[24 + i];
                    v[16 + i] = a * c - b * s; v[24 + i] = b * c + a * s;
                }
            }
#pragma unroll
            for (int c = 0; c < 4; ++c) {
                bf16x8 t;
#pragma unroll
                for (int e = 0; e < 8; ++e) t[e] = (short)f2bf(v[c * 8 + e] * rs);
                *(bf16x8*)(pr + c * 8) = t;
            }
        }
    }
}
DEVI void ep_scale_rows(bf16_t* ct, int c0, int nc, const float* rstd, float scale) {
    const int cpr = nc / 8;
    for (int c = TIDX; c < 128 * cpr; c += 256) {
        int i = c / cpr, jc = c % cpr;
        bf16_t* pr = ct + i * CT_LD + c0 + jc * 8;
        bf16x8 t = *(const bf16x8*)pr;
        float rs = rstd[i] * scale;
#pragma unroll
        for (int e = 0; e < 8; ++e) t[e] = (short)f2bf(bf2f((bf16_t)t[e]) * rs);
        *(bf16x8*)pr = t;
    }
}
DEVI void ep_rstd(const bf16_t* A, int ld, int row0, int K, float* rstd) {
    const int row = TIDX >> 1, half = TIDX & 1;
    const bf16_t* pr = A + (size_t)(row0 + row) * ld + half * (K / 2);
    float ss = 0.f;
    for (int c = 0; c < K / 16; ++c) {
        bf16x8 t = *(const bf16x8*)(pr + c * 8);
#pragma unroll
        for (int e = 0; e < 8; ++e) { float f = bf2f((bf16_t)t[e]); ss += f * f; }
    }
    ss += __shfl_xor(ss, 1);
    if (half == 0) rstd[row] = rsqrtf(ss / (float)K + EPSV);
}


DEVI bool super_tile(int it, int NMT, int NNT, int SM, int SN, int& mt, int& nt) {
    const int b = BIDX, G = gridDim.x;
    const int ngrp = (G >= 8 && (G & 7) == 0) ? 8 : 1;
    const int xcd = b % ngrp, j = b / ngrp, per = G / ngrp;
    const int ST = SM * SN, passes = (ST + per - 1) / per;
    const int nsn = (NNT + SN - 1) / SN, nsm = (NMT + SM - 1) / SM;
    const int s = (it / passes) * ngrp + xcd;
    if (s >= nsm * nsn) return false;
    const int idx = (it % passes) * per + j;
    mt = -1; nt = 0;
    if (idx < ST) {
        const int m = (s / nsn) * SM + idx / SN, n = (s % nsn) * SN + idx % SN;
        if (m < NMT && n < NNT) { mt = m; nt = n; }
    }
    return true;
}

DEVI void phase0(const Params& p, unsigned char* smem) {
    const int tid = TIDX, lane = tid & 63, w = tid >> 6;
    const int NG = 192, NCV = 2 * CVT_PER_LAYER, NR = 8;
    const int ntask = NG + NCV + NR + 1;
    for (int task = BIDX; task < ntask; task += gridDim.x) {
        if (task < NG) {
            const int l = task / 96, n0 = (task % 96) * 64;
            float* sv = (float*)smem;
            float* red = (float*)(smem + 36864);
            for (int idx = lane; idx < 9 * 256; idx += 64) {
                int bi = idx >> 8, kk = idx & 255, k = 256 * w + kk;
                float c = bi < 8 ? p.in[I_C][bi * 1024 + k] : p.in[I_CCTX][k];
                sv[(w * 9 + bi) * 256 + kk] = siluf_(c);
            }
            __syncthreads();
            float acc[9];
#pragma unroll
            for (int bi = 0; bi < 9; ++bi) acc[bi] = 0.f;
            const float* wp = p.in[I_ADAW] + (size_t)l * 1024 * 6144 + (size_t)(256 * w) * 6144 + n0 + lane;
#pragma unroll 8
            for (int kk = 0; kk < 256; ++kk) {
                float wv = wp[(size_t)kk * 6144];
#pragma unroll
                for (int bi = 0; bi < 9; ++bi) acc[bi] += sv[(w * 9 + bi) * 256 + kk] * wv;
            }
#pragma unroll
            for (int bi = 0; bi < 9; ++bi) red[(w * 9 + bi) * 64 + lane] = acc[bi];
            __syncthreads();
            for (int idx = tid; idx < 9 * 64; idx += 256) {
                int bi = idx >> 6, c = idx & 63;
                float s = p.in[I_ADAB][l * 6144 + n0 + c];
#pragma unroll
                for (int ww = 0; ww < 4; ++ww) s += red[(ww * 9 + bi) * 64 + c];
                WSF(OFF_MOD)[(size_t)(l * 9 + bi) * 6144 + n0 + c] = s;
            }
            __syncthreads();
        } else if (task < NG + NCV) {
            int t = task - NG;
            int l = t / CVT_PER_LAYER; t %= CVT_PER_LAYER;
            int k = 0;
            while (t >= CVT_TILES[k]) { t -= CVT_TILES[k]; ++k; }
            CvtJob j = get_job(p, l, k);
            cvt_tile(j, t, (float*)smem);
        } else if (task < NG + NCV + NR) {
            int pos = (task - NG - NCV) * 256 + tid;
            float rp = (float)(pos >> 6), cp = (float)(pos & 63);
            float* t64 = WSF(OFF_R64) + (size_t)pos * 64;
            float* t32 = WSF(OFF_R32) + (size_t)pos * 32;
            for (int i = 0; i < 16; ++i) {
                float inv = powf(10000.f, -(float)(2 * i) / 32.f);
                float ar = rp * inv, ac = cp * inv;
                t64[i] = cosf(ar); t64[16 + i] = cosf(ac); t64[32 + i] = sinf(ar); t64[48 + i] = sinf(ac);
            }
            for (int i = 0; i < 8; ++i) {
                float inv = powf(10000.f, -(float)(2 * i) / 16.f);
                float ar = rp * inv, ac = cp * inv;
                t32[i] = cosf(ar); t32[8 + i] = cosf(ac); t32[16 + i] = sinf(ar); t32[24 + i] = sinf(ac);
            }
        } else {
            if (tid < 128) WSI(OFF_CNT)[tid] = 0;
            for (int l = 0; l < 2; ++l) {
                unsigned* z = (unsigned*)WB(W_IN + (size_t)l * 3840 * 1024 + (size_t)3744 * 1024);
                for (int i = tid; i < 96 * 1024 / 2; i += 256) z[i] = 0u;
            }
        }
    }
}

struct MoeTab {
    int* base;
    DEVI int cnt(int e) const { return __hip_atomic_load(base + e, __ATOMIC_RELAXED, __HIP_MEMORY_SCOPE_AGENT); }
    DEVI int tp(int e) const { return __hip_atomic_load(base + 64 + e, __ATOMIC_RELAXED, __HIP_MEMORY_SCOPE_AGENT); }
    DEVI int seg(int e) const { return __hip_atomic_load(base + 136 + e, __ATOMIC_RELAXED, __HIP_MEMORY_SCOPE_AGENT); }
};
DEVI MoeTab moe_tables(const Params& p, int l, unsigned char* smem) {
    MoeTab t; t.base = (int*)(p.ws + OFF_PRIV + (size_t)BIDX * 1024);
    __syncthreads();
    if (TIDX == 0) {
        int a = 0, sg = 0;
        for (int e = 0; e < 64; ++e) {
            const int c = WSI(OFF_CNT)[l * 64 + e];
            __hip_atomic_store(t.base + e, c, __ATOMIC_RELAXED, __HIP_MEMORY_SCOPE_AGENT);
            __hip_atomic_store(t.base + 64 + e, a, __ATOMIC_RELAXED, __HIP_MEMORY_SCOPE_AGENT);
            __hip_atomic_store(t.base + 136 + e, sg, __ATOMIC_RELAXED, __HIP_MEMORY_SCOPE_AGENT);
            const int nt = (c + 127) >> 7;
            a += nt; sg += nt * 128;
        }
        __hip_atomic_store(t.base + 64 + 64, a, __ATOMIC_RELAXED, __HIP_MEMORY_SCOPE_AGENT);
        __hip_atomic_store(t.base + 136 + 64, sg, __ATOMIC_RELAXED, __HIP_MEMORY_SCOPE_AGENT);
    }
    asm volatile("s_waitcnt vmcnt(0)" ::: "memory");
    __syncthreads();
    return t;
}
struct Rec { int e0, p0, e1, p1; float w0, w1; int pad0, pad1; };

DEVI void phase_norm1(const Params& p, int l, int mode, unsigned char* smem) {
    const int lane = TIDX & 63, w = TIDX >> 6;
    MoeTab mt;
    const bool comb = (mode == 0 && l > 0) || mode == 1;
    const int lp = mode == 1 ? 1 : l - 1;
    if (comb) mt = moe_tables(p, lp, smem);
    const float* g1 = mode == 1 ? p.in[I_FN] : (mode == 2 ? p.in[I_N2G] + l * 1024 : p.in[I_N1G] + l * 1024);
    const bool latonly = (mode == 1) || (mode == 2 && l == 1);
    const int nrows = latonly ? NBT * SEQL : TT;
    const int stride = gridDim.x * 4;
    int ri = BIDX * 4 + w;
    float4 xn[4];
    auto rowof = [&](int r) { return latonly ? (r >> 11) * TPB + CTXL + (r & 2047) : r; };
    auto srcof = [&](int row) -> const float* {
        if (mode == 0 && l == 0) {
            const int b = row / TPB, t = row % TPB;
            return t < CTXL ? p.in[I_CTX] + ((size_t)b * CTXL + t) * DM : p.in[I_X] + ((size_t)b * SEQL + (t - CTXL)) * DM;
        }
        return XCUR + (size_t)row * DM;
    };
    if (ri < nrows) {
        const float* src = srcof(rowof(ri));
#pragma unroll
        for (int i = 0; i < 4; ++i) xn[i] = *(const float4*)(src + i * 256 + lane * 4);
    }
    for (; ri < nrows; ri += stride) {
        const int row = rowof(ri);
        const int b = row / TPB, t = row % TPB;
        const bool isctx = t < CTXL;
        const int bi = isctx ? 8 : b;
        float v[16];
#pragma unroll
        for (int i = 0; i < 4; ++i) { v[i * 4] = xn[i].x; v[i * 4 + 1] = xn[i].y; v[i * 4 + 2] = xn[i].z; v[i * 4 + 3] = xn[i].w; }
        if (ri + stride < nrows) {
            const float* src = srcof(rowof(ri + stride));
#pragma unroll
            for (int i = 0; i < 4; ++i) xn[i] = *(const float4*)(src + i * 256 + lane * 4);
        }
        if (comb) {
            float* xr = XCUR + (size_t)row * DM;
            const Rec rc = ((const Rec*)(p.ws + OFF_REC))[row];
            const bf16_t* y0 = DB(D_YS) + (size_t)(mt.seg(rc.e0) + rc.p0) * 1024;
            const bf16_t* y1 = DB(D_YS) + (size_t)(mt.seg(rc.e1) + rc.p1) * 1024;
            const float* gate = WSF(OFF_MOD) + (size_t)(lp * 9 + bi) * 6144 + 5 * 1024;
#pragma unroll
            for (int i = 0; i < 4; ++i) {
                const int c = i * 256 + lane * 4;
                float4 g4 = *(const float4*)(gate + c);
                uint2 a = *(const uint2*)(y0 + c), bb = *(const uint2*)(y1 + c);
                float f0 = rc.w0 * __uint_as_float(a.x << 16) + rc.w1 * __uint_as_float(bb.x << 16);
                float f1 = rc.w0 * __uint_as_float(a.x & 0xffff0000u) + rc.w1 * __uint_as_float(bb.x & 0xffff0000u);
                float f2 = rc.w0 * __uint_as_float(a.y << 16) + rc.w1 * __uint_as_float(bb.y << 16);
                float f3 = rc.w0 * __uint_as_float(a.y & 0xffff0000u) + rc.w1 * __uint_as_float(bb.y & 0xffff0000u);
                v[i * 4] += g4.x * f0; v[i * 4 + 1] += g4.y * f1; v[i * 4 + 2] += g4.z * f2; v[i * 4 + 3] += g4.w * f3;
                if (mode == 0) *(float4*)(xr + c) = make_float4(v[i * 4], v[i * 4 + 1], v[i * 4 + 2], v[i * 4 + 3]);
            }
        }
        float ss = 0.f;
#pragma unroll
        for (int i = 0; i < 16; ++i) ss += v[i] * v[i];
        ss = wave_sum(ss);
        const float rstd = rsqrtf(ss * (1.f / 1024.f) + EPSV);
        if (mode == 1) {
            float* o = p.out + ((size_t)b * SEQL + (t - CTXL)) * DM;
#pragma unroll
            for (int i = 0; i < 4; ++i) {
                const int c = i * 256 + lane * 4;
                float4 g4 = *(const float4*)(g1 + c);
                float4 r4;
                r4.x = v[i * 4] * rstd * g4.x; r4.y = v[i * 4 + 1] * rstd * g4.y; r4.z = v[i * 4 + 2] * rstd * g4.z; r4.w = v[i * 4 + 3] * rstd * g4.w;
                *(float4*)(o + c) = r4;
            }
        } else {
            const float* md = WSF(OFF_MOD) + (size_t)(l * 9 + bi) * 6144 + (mode == 2 ? 3 * 1024 : 0);
            bf16_t* ho = HB + (size_t)row * DM;
#pragma unroll
            for (int i = 0; i < 4; ++i) {
                const int c = i * 256 + lane * 4;
                float4 g4 = *(const float4*)(g1 + c);
                float4 sh = *(const float4*)(md + c);
                float4 sc = *(const float4*)(md + 1024 + c);
                float h0 = v[i * 4] * rstd * g4.x * (1.f + sc.x) + sh.x;
                float h1 = v[i * 4 + 1] * rstd * g4.y * (1.f + sc.y) + sh.y;
                float h2 = v[i * 4 + 2] * rstd * g4.z * (1.f + sc.z) + sh.z;
                float h3 = v[i * 4 + 3] * rstd * g4.w * (1.f + sc.w) + sh.w;
                uint2 o2;
                o2.x = (unsigned)f2bf(h0) | ((unsigned)f2bf(h1) << 16);
                o2.y = (unsigned)f2bf(h2) | ((unsigned)f2bf(h3) << 16);
                *(uint2*)(ho + c) = o2;
            }
        }
    }
}

DEVI void phase_win(const Params& p, int l, unsigned char* smem) {
    bf16_t* ct = (bf16_t*)smem;
    const float* cs64 = WSF(OFF_R64);
    const float* cs32 = WSF(OFF_R32);
    for (int it = 0;; ++it) {
        int mt, nt;
        if (!super_tile(it, 144, 30, 12, 5, mt, nt)) break;
        if (mt < 0) continue;
        const int row0 = mt * 128, b = mt / 18, t0 = (mt % 18) * 128;
        const bool lat = (mt % 18) >= 2;
        const int pos0 = t0 - CTXL;
        f32x4 acc[4][4];
        acc_zero<128>(acc);
        AOp A{HB, 1024, row0, nullptr};
        gemm_core<128>(acc, A, WB(W_IN + (size_t)l * 3840 * 1024 + (size_t)nt * 128 * 1024), 1024, 1024, smem);
        __syncthreads();
        acc_to_ct<128>(acc, ct);
        __syncthreads();
        if (nt < 2) ep_store_rows<128>(ct, 0, CB(C_CQ) + nt * 128, 256, row0);
        else if (nt == 2) ep_store_rows<128>(ct, 0, CB(C_CKV), 128, row0);
        else if (nt < 5) { ep_rope64(ct, nullptr, 1.f, lat, pos0, cs64); __syncthreads(); ep_store_rows<128>(ct, 0, CB(C_RQ) + (nt - 3) * 128, 256, row0); }
        else if (nt < 7) {
            ep_rope64(ct, nullptr, 0.125f, lat, pos0, cs64); __syncthreads();
            ep_store_rows<128>(ct, 0, CB(C_RK) + (nt - 5) * 128, 256, row0);
            ep_store_T(ct, 0, 128, CB(C_RKT) + ((size_t)b * 256 + (nt - 5) * 128) * TPB, TPB, t0);
        }
        else if (nt < 11) ep_store_T(ct, 0, 128, CB(C_RVT) + ((size_t)b * 4 + (nt - 7)) * 128 * TPB, TPB, t0);
        else if (nt < 15) ep_store_rows<128>(ct, 0, CB(C_RG) + (nt - 11) * 128, 512, row0);
        else if (nt < 19) ep_store_rows<128>(ct, 0, CB(C_LX) + (nt - 15) * 128, 512, row0);
        else if (nt < 23) ep_store_rows<128>(ct, 0, CB(C_LG) + (nt - 19) * 128, 512, row0);
        else if (nt < 27) { ep_rope64(ct, p.in[I_GQN] + l * 64, 0.125f * LOG2E, lat, pos0, cs64); __syncthreads(); ep_store_rows<128>(ct, 0, CB(C_GQ) + (nt - 23) * 128, 512, row0); }
        else if (nt == 27) { ep_rope64(ct, p.in[I_GKN] + l * 64, 1.f, lat, pos0, cs64); __syncthreads(); ep_store_rows<128>(ct, 0, CB(C_GK), 128, row0); }
        else if (nt == 28) ep_store_T(ct, 0, 128, CB(C_GVT) + (size_t)b * 128 * TPB, TPB, t0);
        else { ep_rope32(ct, 1, nullptr, 1.f, lat, pos0, cs32); __syncthreads(); ep_store_rows<32>(ct, 0, CB(C_KR), 32, row0); }
        __syncthreads();
    }
}

DEVI void phase_mla_up(const Params& p, int l, unsigned char* smem) {
    bf16_t* ct = (bf16_t*)smem;
    float* rstd = (float*)(smem + AUX_OFF);
    const float* cs32 = WSF(OFF_R32);
    const float qscale = 0.10206207261596575f * LOG2E;
    const int nq = (l == 0 ? 144 : 128) * 6;
    const int nkv = 144 * 8;
    for (int tile = BIDX; tile < nq + nkv; tile += gridDim.x) {
        if (tile < nq) {
            const int mt = mt_of(tile / 6, l != 0), nt = tile % 6;
            const int row0 = mt * 128, t0 = (mt % 18) * 128;
            const bool lat = (mt % 18) >= 2;
            f32x4 acc[4][4];
            acc_zero<128>(acc);
            AOp A{CB(C_CQ), 256, row0, nullptr};
            gemm_core<128>(acc, A, WB(W_UQ + (size_t)l * 768 * 256 + (size_t)nt * 128 * 256), 256, 256, smem);
            __syncthreads();
            acc_to_ct<128>(acc, ct);
            ep_rstd(CB(C_CQ), 256, row0, 256, rstd);
            __syncthreads();
            if (nt < 4) {
                ep_scale_rows(ct, 0, 128, rstd, qscale); __syncthreads();
                ep_store_rows<64>(ct, 0, CB(C_MQ) + (nt * 2) * 96, 768, row0);
                ep_store_rows<64>(ct, 64, CB(C_MQ) + (nt * 2 + 1) * 96, 768, row0);
            } else {
                ep_rope32(ct, 4, rstd, qscale, lat, t0 - CTXL, cs32); __syncthreads();
#pragma unroll
                for (int g = 0; g < 4; ++g) ep_store_rows<32>(ct, g * 32, CB(C_MQ) + ((nt - 4) * 4 + g) * 96 + 64, 768, row0);
            }
            __syncthreads();
        } else {
            const int tk = tile - nq;
            const int mt = tk / 8, nt = tk % 8;
            const int row0 = mt * 128, b = mt / 18, t0 = (mt % 18) * 128;
            f32x4 acc[4][4];
            acc_zero<128>(acc);
            AOp A{CB(C_CKV), 128, row0, nullptr};
            gemm_core<128>(acc, A, WB(W_UKV + (size_t)l * 1024 * 128 + (size_t)nt * 128 * 128), 128, 128, smem);
            __syncthreads();
            acc_to_ct<128>(acc, ct);
            ep_rstd(CB(C_CKV), 128, row0, 128, rstd);
            __syncthreads();
            ep_scale_rows(ct, 0, 128, rstd, 1.f); __syncthreads();
            ep_store_rows<64>(ct, 0, CB(C_KN) + nt * 64, 512, row0);
            ep_store_T(ct, 64, 64, CB(C_VMT) + ((size_t)b * 8 + nt) * 64 * TPB, TPB, t0);
            __syncthreads();
        }
    }
}

template <int DK, bool MLA>
DEVI void attn_naive_wave(const Params& p, int b, int t0, int hq) {
    const int lane = TIDX & 63;
    const int t = t0 + lane, row = b * TPB + t;
    const int nkeys = (t0 < CTXL) ? CTXL : TPB;
    float q[DK];
    const bf16_t* qp = MLA ? CB(C_MQ) + (size_t)row * 768 + hq * 96 : CB(C_GQ) + (size_t)row * 512 + hq * 64;
#pragma unroll
    for (int c = 0; c < DK / 8; ++c) {
        bf16x8 tq = *(const bf16x8*)(qp + c * 8);
#pragma unroll
        for (int e = 0; e < 8; ++e) q[c * 8 + e] = bf2f((bf16_t)tq[e]);
    }
    float acc[64];
#pragma unroll
    for (int d = 0; d < 64; ++d) acc[d] = 0.f;
    float m = -1e30f, lsum = 0.f;
    const int hk = MLA ? hq : (hq >> 2);
    const bf16_t* vT = MLA ? CB(C_VMT) + ((size_t)b * 8 + hk) * 64 * TPB : CB(C_GVT) + ((size_t)b * 2 + hk) * 64 * TPB;
    for (int kt = 0; kt < nkeys; ++kt) {
        const size_t krow = (size_t)b * TPB + kt;
        float s = 0.f;
        const bf16_t* kp = MLA ? CB(C_KN) + krow * 512 + hk * 64 : CB(C_GK) + krow * 128 + hk * 64;
#pragma unroll
        for (int c = 0; c < 8; ++c) {
            bf16x8 tk = *(const bf16x8*)(kp + c * 8);
#pragma unroll
            for (int e = 0; e < 8; ++e) s += q[c * 8 + e] * bf2f((bf16_t)tk[e]);
        }
        if (MLA) {
            const bf16_t* rp = CB(C_KR) + krow * 32;
#pragma unroll
            for (int c = 0; c < 4; ++c) {
                bf16x8 tk = *(const bf16x8*)(rp + c * 8);
#pragma unroll
                for (int e = 0; e < 8; ++e) s += q[(DK - 32) + c * 8 + e] * bf2f((bf16_t)tk[e]);
            }
        }
        const float mn = fmaxf(m, s);
        const float alpha = exp2f(m - mn), pp = exp2f(s - mn);
        lsum = lsum * alpha + pp;
#pragma unroll
        for (int d = 0; d < 64; ++d) acc[d] = acc[d] * alpha + pp * bf2f(vT[(size_t)d * TPB + kt]);
        m = mn;
    }
    const float inv = 1.f / lsum;
    bf16_t* op = (MLA ? DB(D_YA) : DB(D_YD)) + (size_t)row * 512 + hq * 64;
#pragma unroll
    for (int c = 0; c < 8; ++c) {
        bf16x8 o;
#pragma unroll
        for (int e = 0; e < 8; ++e) o[e] = (short)f2bf(acc[c * 8 + e] * inv);
        *(bf16x8*)(op + c * 8) = o;
    }
}


template <int DK, bool MLA>
DEVI void attn_task(const Params& p, int b, int hsel, int tq0, int nkeys, unsigned char* smem) {
    constexpr int KLD = DK + 8;
    constexpr int CK = DK / 8;
    constexpr int NKC = 64 * CK / 256;
    constexpr int VLD = 68;
    constexpr int KBYTES = 64 * KLD * 2, VBYTES = 64 * VLD * 2, STAGE = KBYTES + VBYTES;
    static_assert(2 * STAGE <= SMEM_BYTES, "attn lds");
    const int tid = TIDX, lane = tid & 63, w = tid >> 6, qc = lane & 31, hh = lane >> 5;
    const int tq = MLA ? tq0 + w * 32 + qc : tq0 + qc;
    const int hq = MLA ? hsel : hsel * 4 + w;
    const size_t qrow = (size_t)b * TPB + tq;
    const bf16_t* qp = MLA ? CB(C_MQ) + qrow * 768 + hq * 96 : CB(C_GQ) + qrow * 512 + hq * 64;
    bf16x8 qf[DK / 16];
#pragma unroll
    for (int ks = 0; ks < DK / 16; ++ks) qf[ks] = *(const bf16x8*)(qp + ks * 16 + hh * 8);
    const bf16_t* ksrc[NKC]; int kstep[NKC], kdst[NKC];
#pragma unroll
    for (int i = 0; i < NKC; ++i) {
        const int q = tid + 256 * i, key = q / CK, ch = q % CK;
        if (MLA) {
            if (ch < 8) { ksrc[i] = CB(C_KN) + ((size_t)b * TPB + key) * 512 + hsel * 64 + ch * 8; kstep[i] = 64 * 512; }
            else { ksrc[i] = CB(C_KR) + ((size_t)b * TPB + key) * 32 + (ch - 8) * 8; kstep[i] = 64 * 32; }
        } else { ksrc[i] = CB(C_GK) + ((size_t)b * TPB + key) * 128 + hsel * 64 + ch * 8; kstep[i] = 64 * 128; }
        kdst[i] = (key * KLD + ch * 8) * 2;
    }
    const bf16_t* vT = MLA ? CB(C_VMT) + ((size_t)b * 8 + hsel) * 64 * TPB : CB(C_GVT) + ((size_t)b * 2 + hsel) * 64 * TPB;
    const bf16_t* vsrc[2]; int vdst[2];
#pragma unroll
    for (int i = 0; i < 2; ++i) {
        const int q = tid + 256 * i, dv = q >> 3, ch = q & 7;
        vsrc[i] = vT + (size_t)dv * TPB + ch * 8;
        vdst[i] = KBYTES + (dv * VLD + ch * 8) * 2;
    }
    bf16x8 kr[NKC], vr[2];
#pragma unroll
    for (int i = 0; i < NKC; ++i) kr[i] = *(const bf16x8*)(ksrc[i]);
#pragma unroll
    for (int i = 0; i < 2; ++i) vr[i] = *(const bf16x8*)(vsrc[i]);
    __syncthreads();
#pragma unroll
    for (int i = 0; i < NKC; ++i) *(bf16x8*)(smem + kdst[i]) = kr[i];
#pragma unroll
    for (int i = 0; i < 2; ++i) {
        *(bf16x4*)(smem + vdst[i]) = bf16x4{vr[i][0], vr[i][1], vr[i][2], vr[i][3]};
        *(bf16x4*)(smem + vdst[i] + 8) = bf16x4{vr[i][4], vr[i][5], vr[i][6], vr[i][7]};
    }
    __syncthreads();
    f32x16 o0, o1;
#pragma unroll
    for (int r = 0; r < 16; ++r) { o0[r] = 0.f; o1[r] = 0.f; }
    float m = -1e30f, lsum = 0.f;
    const int nt = nkeys >> 6;
    for (int it = 0; it < nt; ++it) {
        const unsigned char* cur = smem + (it & 1) * STAGE;
        if (it + 1 < nt) {
#pragma unroll
            for (int i = 0; i < NKC; ++i) kr[i] = *(const bf16x8*)(ksrc[i] + (size_t)(it + 1) * kstep[i]);
#pragma unroll
            for (int i = 0; i < 2; ++i) vr[i] = *(const bf16x8*)(vsrc[i] + (it + 1) * 64);
        }
        f32x16 s0, s1;
#pragma unroll
        for (int r = 0; r < 16; ++r) { s0[r] = 0.f; s1[r] = 0.f; }
#pragma unroll
        for (int ks = 0; ks < DK / 16; ++ks) {
            bf16x8 a0 = *(const bf16x8*)(cur + (qc * KLD + ks * 16 + hh * 8) * 2);
            bf16x8 a1 = *(const bf16x8*)(cur + ((32 + qc) * KLD + ks * 16 + hh * 8) * 2);
            s0 = __builtin_amdgcn_mfma_f32_32x32x16_bf16(a0, qf[ks], s0, 0, 0, 0);
            s1 = __builtin_amdgcn_mfma_f32_32x32x16_bf16(a1, qf[ks], s1, 0, 0, 0);
        }
        float mx = s0[0];
#pragma unroll
        for (int r = 1; r < 16; ++r) mx = fmaxf(mx, s0[r]);
#pragma unroll
        for (int r = 0; r < 16; ++r) mx = fmaxf(mx, s1[r]);
        mx = fmaxf(mx, __shfl_xor(mx, 32));
        const float mn = fmaxf(m, mx);
        const float alpha = __builtin_amdgcn_exp2f(m - mn);
        m = mn;
        float ps = 0.f;
#pragma unroll
        for (int r = 0; r < 16; ++r) { s0[r] = __builtin_amdgcn_exp2f(s0[r] - mn); ps += s0[r]; }
#pragma unroll
        for (int r = 0; r < 16; ++r) { s1[r] = __builtin_amdgcn_exp2f(s1[r] - mn); ps += s1[r]; }
        lsum = lsum * alpha + ps;
#pragma unroll
        for (int r = 0; r < 16; ++r) { o0[r] *= alpha; o1[r] *= alpha; }
        bf16x8 pf[2][2];
#pragma unroll
        for (int s = 0; s < 2; ++s)
#pragma unroll
            for (int j = 0; j < 8; ++j) { pf[0][s][j] = (short)f2bf(s0[8 * s + j]); pf[1][s][j] = (short)f2bf(s1[8 * s + j]); }
        const unsigned char* cv = cur + KBYTES;
#pragma unroll
        for (int a = 0; a < 2; ++a)
#pragma unroll
            for (int s = 0; s < 2; ++s) {
                const int keyoff = a * 32 + 16 * s + 4 * hh;
                bf16x4 l0 = *(const bf16x4*)(cv + (qc * VLD + keyoff) * 2);
                bf16x4 h0 = *(const bf16x4*)(cv + (qc * VLD + keyoff + 8) * 2);
                bf16x4 l1 = *(const bf16x4*)(cv + ((32 + qc) * VLD + keyoff) * 2);
                bf16x4 h1 = *(const bf16x4*)(cv + ((32 + qc) * VLD + keyoff + 8) * 2);
                bf16x8 v0 = bf16x8{l0[0], l0[1], l0[2], l0[3], h0[0], h0[1], h0[2], h0[3]};
                bf16x8 v1 = bf16x8{l1[0], l1[1], l1[2], l1[3], h1[0], h1[1], h1[2], h1[3]};
                o0 = __builtin_amdgcn_mfma_f32_32x32x16_bf16(v0, pf[a][s], o0, 0, 0, 0);
                o1 = __builtin_amdgcn_mfma_f32_32x32x16_bf16(v1, pf[a][s], o1, 0, 0, 0);
            }
        if (it + 1 < nt) {
            unsigned char* nxt = smem + ((it + 1) & 1) * STAGE;
#pragma unroll
            for (int i = 0; i < NKC; ++i) *(bf16x8*)(nxt + kdst[i]) = kr[i];
#pragma unroll
            for (int i = 0; i < 2; ++i) {
                *(bf16x4*)(nxt + vdst[i]) = bf16x4{vr[i][0], vr[i][1], vr[i][2], vr[i][3]};
                *(bf16x4*)(nxt + vdst[i] + 8) = bf16x4{vr[i][4], vr[i][5], vr[i][6], vr[i][7]};
            }
        }
        __syncthreads();
    }
    lsum += __shfl_xor(lsum, 32);
    const float inv = 1.f / lsum;
    bf16_t* op = (MLA ? DB(D_YA) : DB(D_YD)) + qrow * 512 + hq * 64;
#pragma unroll
    for (int g = 0; g < 4; ++g) {
        bf16x4 a, c;
#pragma unroll
        for (int e = 0; e < 4; ++e) { a[e] = (short)f2bf(o0[g * 4 + e] * inv); c[e] = (short)f2bf(o1[g * 4 + e] * inv); }
        *(bf16x4*)(op + 8 * g + 4 * hh) = a;
        *(bf16x4*)(op + 32 + 8 * g + 4 * hh) = c;
    }
}

DEVI int proc_tok(int dir, int pidx) { return dir == 0 ? pidx : (pidx < CTXL ? CTXL - 1 - pidx : (CTXL + TPB - 1) - pidx); }

DEVI void retention_naive(const Params& p, int l, int task) {
    const int b = task >> 2, h = task & 3;
    const int dir = TIDX >> 7, dv = TIDX & 127;
    const float dec = p.in[I_RDEC][l * 8 + dir * 4 + h];
    const float lg = -log1pf(expf(-dec));
    const float g = expf(lg);
    float S[64];
#pragma unroll
    for (int d = 0; d < 64; ++d) S[d] = 0.f;
    const bf16_t* vT = CB(C_RVT) + (((size_t)b * 4 + h) * 128 + dv) * TPB;
    bf16_t* outp = (dir == 0 ? DB(D_OF) : DB(D_OB));
    for (int pi = 0; pi < TPB; ++pi) {
        const int u = proc_tok(dir, pi);
        const size_t row = (size_t)b * TPB + u;
        const bf16_t* qp = CB(C_RQ) + row * 256 + h * 64;
        const bf16_t* kp = CB(C_RK) + row * 256 + h * 64;
        const float v = bf2f(vT[u]);
        float o = 0.f;
#pragma unroll
        for (int c = 0; c < 8; ++c) {
            bf16x8 tq = *(const bf16x8*)(qp + c * 8);
            bf16x8 tk = *(const bf16x8*)(kp + c * 8);
#pragma unroll
            for (int e = 0; e < 8; ++e) {
                const int d = c * 8 + e;
                const float qd = bf2f((bf16_t)tq[e]), kd = bf2f((bf16_t)tk[e]);
                if (dir == 0) { S[d] = g * S[d] + kd * v; o += qd * S[d]; }
                else { S[d] = g * S[d]; o += qd * S[d]; S[d] += kd * v; }
            }
        }
        outp[row * 512 + h * 128 + dv] = f2bf(o);
    }
}

DEVI void lru_naive_wave(const Params& p, int l, int task) {
    const int lane = TIDX & 63;
    const int b = task >> 4, d = (task >> 3) & 1, blk = task & 7;
    const int ch = blk * 64 + lane;
    float cw[4];
#pragma unroll
    for (int j = 0; j < 4; ++j) cw[j] = p.in[I_LCW][(l * 4 + j) * 512 + ch];
    const float cb = p.in[I_LCB][l * 512 + ch];
    const float ba = p.in[I_LBA][(l * 2 + d) * 512 + ch], bx = p.in[I_LBX][(l * 2 + d) * 512 + ch];
    const float lam = p.in[I_LLAM][(l * 2 + d) * 512 + ch];
    const float sp = log1pf(expf(-lam));
    const float* Wa = p.in[I_LWA] + ((size_t)(l * 2 + d) * 8 + blk) * 4096;
    const float* Wx = p.in[I_LWX] + ((size_t)(l * 2 + d) * 8 + blk) * 4096;
    float h = 0.f;
    bf16_t* outp = (d == 0 ? DB(D_LH0) : DB(D_LH1));
    for (int pi = 0; pi < TPB; ++pi) {
        const int u = proc_tok(d, pi);
        const int lo = u < CTXL ? 0 : CTXL, hi = u < CTXL ? CTXL : TPB;
        const size_t row = (size_t)b * TPB + u;
        float uval = cb;
#pragma unroll
        for (int j = 0; j < 4; ++j) {
            const int tt = u - 2 + j;
            if (tt >= lo && tt < hi) uval += cw[j] * bf2f(CB(C_LX)[((size_t)b * TPB + tt) * 512 + ch]);
        }
        float rp = 0.f, ip = 0.f;
        for (int c = 0; c < 64; ++c) {
            const float uc = __shfl(uval, c);
            rp += uc * Wa[c * 64 + lane];
            ip += uc * Wx[c * 64 + lane];
        }
        const float r = sigmoidf_(rp + ba), ig = sigmoidf_(ip + bx);
        const float la = -8.f * r * sp;
        const float a = expf(la);
        const float bb = sqrtf(-expm1f(2.f * la)) * (ig * uval);
        h = a * h + bb;
        outp[row * 512 + ch] = f2bf(h);
    }
}


DEVI void retention_walk(const Params& p, int l, int task, unsigned char* smem) {
    constexpr int PLD = 136;
    const int b = task >> 3, h = (task >> 1) & 3, dir = task & 1;
    const int tid = TIDX, lane = tid & 63, w = tid >> 6, qc = lane & 31, hh = lane >> 5;
    const float dec = p.in[I_RDEC][l * 8 + dir * 4 + h];
    const float lg2 = -log1pf(expf(-dec)) * LOG2E;
    const float cdec = exp2f(lg2 * 128.f);
    bf16_t* P = (bf16_t*)smem;
    f32x16 S0, S1;
#pragma unroll
    for (int r = 0; r < 16; ++r) { S0[r] = 0.f; S1[r] = 0.f; }
    const bf16_t* Kg = CB(C_RK) + (size_t)b * TPB * 256 + h * 64;
    const bf16_t* Qg = CB(C_RQ) + (size_t)b * TPB * 256 + h * 64;
    const bf16_t* KTg = CB(C_RKT) + ((size_t)b * 4 + h) * 64 * TPB;
    const bf16_t* VTg = CB(C_RVT) + (((size_t)b * 4 + h) * 128 + w * 32 + qc) * TPB;
    bf16_t* outp = (dir == 0 ? DB(D_OF) : DB(D_OB)) + (size_t)b * TPB * 512 + h * 128 + w * 32;
    const int iq = 32 * w + qc;
    for (int cc = 0; cc < 18; ++cc) {
        const int mch = dir == 0 ? cc : (cc < 2 ? 1 - cc : 19 - cc);
        const int t0 = mch * 128;
        bf16x8 vf[8];
#pragma unroll
        for (int ks = 0; ks < 8; ++ks) vf[ks] = *(const bf16x8*)(VTg + t0 + ks * 16 + hh * 8);
        bf16x8 qf[4];
        {
            const bf16_t* qrow = Qg + (size_t)(t0 + iq) * 256;
#pragma unroll
            for (int ks = 0; ks < 4; ++ks) qf[ks] = *(const bf16x8*)(qrow + ks * 16 + hh * 8);
        }
        __syncthreads();
#pragma unroll 1
        for (int js = 0; js < 4; ++js) {
            f32x16 sc;
#pragma unroll
            for (int r = 0; r < 16; ++r) sc[r] = 0.f;
            const bf16_t* krow = Kg + (size_t)(t0 + 32 * js + qc) * 256;
#pragma unroll
            for (int ks = 0; ks < 4; ++ks) {
                bf16x8 a = *(const bf16x8*)(krow + ks * 16 + hh * 8);
                sc = __builtin_amdgcn_mfma_f32_32x32x16_bf16(a, qf[ks], sc, 0, 0, 0);
            }
#pragma unroll
            for (int g = 0; g < 4; ++g) {
                bf16x4 pk;
#pragma unroll
                for (int e = 0; e < 4; ++e) {
                    const int j = 32 * js + 8 * g + 4 * hh + e;
                    const int d = iq - j;
                    float wgt;
                    if (dir == 0) wgt = d >= 0 ? __builtin_amdgcn_exp2f(lg2 * (float)d) : 0.f;
                    else wgt = d < 0 ? __builtin_amdgcn_exp2f(lg2 * (float)(-d)) : 0.f;
                    pk[e] = (short)f2bf(sc[4 * g + e] * wgt);
                }
                *(bf16x4*)(P + iq * PLD + 32 * js + 8 * g + 4 * hh) = pk;
            }
        }
        __syncthreads();
        bf16x8 sf[2][2];
#pragma unroll
        for (int s = 0; s < 2; ++s)
#pragma unroll
            for (int j = 0; j < 8; ++j) { sf[0][s][j] = (short)f2bf(S0[8 * s + j]); sf[1][s][j] = (short)f2bf(S1[8 * s + j]); }
#pragma unroll 1
        for (int isub = 0; isub < 4; ++isub) {
            const int ii = 32 * isub + qc;
            const bf16_t* qr = Qg + (size_t)(t0 + ii) * 256;
            f32x16 o;
#pragma unroll
            for (int r = 0; r < 16; ++r) o[r] = 0.f;
#pragma unroll
            for (int sub = 0; sub < 2; ++sub)
#pragma unroll
                for (int s = 0; s < 2; ++s) {
                    const int dk0 = 32 * sub + 16 * s + 4 * hh;
                    bf16x4 lo = *(const bf16x4*)(qr + dk0), hi = *(const bf16x4*)(qr + dk0 + 8);
                    bf16x8 bq = bf16x8{lo[0], lo[1], lo[2], lo[3], hi[0], hi[1], hi[2], hi[3]};
                    o = __builtin_amdgcn_mfma_f32_32x32x16_bf16(sf[sub][s], bq, o, 0, 0, 0);
                }
            const float qd = dir == 0 ? __builtin_amdgcn_exp2f(lg2 * (float)(ii + 1)) : __builtin_amdgcn_exp2f(lg2 * (float)(128 - ii));
#pragma unroll
            for (int r = 0; r < 16; ++r) o[r] *= qd;
#pragma unroll
            for (int ks = 0; ks < 8; ++ks) {
                bf16x8 pf = *(const bf16x8*)(P + ii * PLD + 16 * ks + 8 * hh);
                o = __builtin_amdgcn_mfma_f32_32x32x16_bf16(vf[ks], pf, o, 0, 0, 0);
            }
            bf16_t* orow = outp + (size_t)(t0 + ii) * 512;
#pragma unroll
            for (int g = 0; g < 4; ++g) {
                bf16x4 pk;
#pragma unroll
                for (int e = 0; e < 4; ++e) pk[e] = (short)f2bf(o[4 * g + e]);
                *(bf16x4*)(orow + 8 * g + 4 * hh) = pk;
            }
        }
#pragma unroll
        for (int r = 0; r < 16; ++r) { S0[r] *= cdec; S1[r] *= cdec; }
#pragma unroll
        for (int ks = 0; ks < 8; ++ks) {
            bf16x8 vs;
#pragma unroll
            for (int e = 0; e < 8; ++e) {
                const int j = 16 * ks + 8 * hh + e;
                const float kd = dir == 0 ? __builtin_amdgcn_exp2f(lg2 * (float)(127 - j)) : __builtin_amdgcn_exp2f(lg2 * (float)j);
                vs[e] = (short)f2bf(bf2f((bf16_t)vf[ks][e]) * kd);
            }
            bf16x8 a0 = *(const bf16x8*)(KTg + (size_t)qc * TPB + t0 + 16 * ks + 8 * hh);
            bf16x8 a1 = *(const bf16x8*)(KTg + (size_t)(32 + qc) * TPB + t0 + 16 * ks + 8 * hh);
            S0 = __builtin_amdgcn_mfma_f32_32x32x16_bf16(a0, vs, S0, 0, 0, 0);
            S1 = __builtin_amdgcn_mfma_f32_32x32x16_bf16(a1, vs, S1, 0, 0, 0);
        }
    }
    __syncthreads();
}

DEVI float fsig(float x) { return __builtin_amdgcn_rcpf(1.f + __expf(-x)); }
DEVI void lru_walk(const Params& p, int l, int task, unsigned char* smem) {
    const int b = task >> 4, d = (task >> 3) & 1, blk = task & 7;
    const int tid = TIDX, lane = tid & 63, w = tid >> 6, ln = lane & 15, g = lane >> 4;
    bf16_t* Wt = (bf16_t*)smem;
    float* uw = (float*)(smem + 18432) + w * 1024;
    float* cpar = (float*)(smem + 34816);
    float* agg = (float*)(smem + 36096);
    __syncthreads();
    {
        const bf16_t* wsrc = WB(W_LRU + ((size_t)(l * 2 + d) * 8 + blk) * 8192);
        for (int c = tid; c < 128 * 8; c += 256) {
            const int n = c >> 3, kc = c & 7;
            *(bf16x8*)(Wt + n * 72 + kc * 8) = *(const bf16x8*)(wsrc + n * 64 + kc * 8);
        }
        if (tid < 64) {
            const int ch = blk * 64 + tid;
#pragma unroll
            for (int j = 0; j < 4; ++j) cpar[j * 64 + tid] = p.in[I_LCW][(l * 4 + j) * 512 + ch];
            cpar[256 + tid] = p.in[I_LCB][l * 512 + ch];
        }
    }
    __syncthreads();
    float ba[4], bx[4], sp[4], hc[4];
#pragma unroll
    for (int ct = 0; ct < 4; ++ct) {
        const int ch = blk * 64 + 16 * ct + ln;
        ba[ct] = p.in[I_LBA][(l * 2 + d) * 512 + ch];
        bx[ct] = p.in[I_LBX][(l * 2 + d) * 512 + ch];
        sp[ct] = log1pf(expf(-p.in[I_LLAM][(l * 2 + d) * 512 + ch]));
        hc[ct] = 0.f;
    }
    const bf16_t* X = CB(C_LX) + (size_t)b * TPB * 512 + blk * 64;
    bf16_t* outp = (d == 0 ? DB(D_LH0) : DB(D_LH1)) + (size_t)b * TPB * 512 + blk * 64;
    for (int c = 0; c < 36; ++c) {
        const int tok = proc_tok(d, 64 * c + 16 * w + ln);
        const int lo = tok < CTXL ? 0 : CTXL, hi = tok < CTXL ? CTXL : TPB;
        bf16x8 af[2];
#pragma unroll
        for (int ks = 0; ks < 2; ++ks) {
            const int c0 = 32 * ks + 8 * g;
            float u8[8];
#pragma unroll
            for (int e = 0; e < 8; ++e) u8[e] = cpar[256 + c0 + e];
#pragma unroll
            for (int j = 0; j < 4; ++j) {
                const int tt = tok - 2 + j;
                if (tt >= lo && tt < hi) {
                    bf16x8 xv = *(const bf16x8*)(X + (size_t)tt * 512 + c0);
#pragma unroll
                    for (int e = 0; e < 8; ++e) u8[e] += cpar[j * 64 + c0 + e] * bf2f((bf16_t)xv[e]);
                }
            }
#pragma unroll
            for (int e = 0; e < 8; ++e) { uw[ln * 64 + c0 + e] = u8[e]; af[ks][e] = (short)f2bf(u8[e]); }
        }
        __builtin_amdgcn_wave_barrier();
        f32x4 acc[8];
#pragma unroll
        for (int nt = 0; nt < 8; ++nt) acc[nt] = f32x4{0.f, 0.f, 0.f, 0.f};
#pragma unroll
        for (int ks = 0; ks < 2; ++ks)
#pragma unroll
            for (int nt = 0; nt < 8; ++nt) {
                bf16x8 bfr = *(const bf16x8*)(Wt + (16 * nt + ln) * 72 + 32 * ks + 8 * g);
                acc[nt] = __builtin_amdgcn_mfma_f32_16x16x32_bf16(af[ks], bfr, acc[nt], 0, 0, 0);
            }
        float A[4][4], B[4][4];
#pragma unroll
        for (int ct = 0; ct < 4; ++ct) {
            float pa = 1.f, pb = 0.f;
#pragma unroll
            for (int j = 0; j < 4; ++j) {
                const float r = fsig(acc[ct][j] + ba[ct]);
                const float ig = fsig(acc[4 + ct][j] + bx[ct]);
                const float la = -8.f * r * sp[ct];
                const float a = __expf(la);
                const float uu = uw[(4 * g + j) * 64 + 16 * ct + ln];
                const float bb = __builtin_amdgcn_sqrtf(fmaxf(1.f - a * a, 0.f)) * ig * uu;
                pb = a * pb + bb; pa = a * pa;
                A[ct][j] = pa; B[ct][j] = pb;
            }
            float ia = pa, ib = pb;
#pragma unroll
            for (int dd = 1; dd <= 2; dd <<= 1) {
                const float qa = __shfl_up(ia, 16 * dd), qb = __shfl_up(ib, 16 * dd);
                if (g >= dd) { ib = ia * qb + ib; ia = ia * qa; }
            }
            float ea = __shfl_up(ia, 16), eb = __shfl_up(ib, 16);
            if (g == 0) { ea = 1.f; eb = 0.f; }
#pragma unroll
            for (int j = 0; j < 4; ++j) { B[ct][j] = A[ct][j] * eb + B[ct][j]; A[ct][j] = A[ct][j] * ea; }
            if (g == 3) {
                float* ag = agg + (((c & 1) * 4 + w) * 64 + 16 * ct + ln) * 2;
                ag[0] = ia; ag[1] = ib;
            }
        }
        __syncthreads();
#pragma unroll
        for (int ct = 0; ct < 4; ++ct) {
            float hrun = hc[ct], hin = 0.f;
#pragma unroll
            for (int w2 = 0; w2 < 4; ++w2) {
                const float* ag = agg + (((c & 1) * 4 + w2) * 64 + 16 * ct + ln) * 2;
                if (w2 == w) hin = hrun;
                hrun = ag[0] * hrun + ag[1];
            }
            hc[ct] = hrun;
#pragma unroll
            for (int j = 0; j < 4; ++j) {
                const int tok2 = proc_tok(d, 64 * c + 16 * w + 4 * g + j);
                outp[(size_t)tok2 * 512 + 16 * ct + ln] = f2bf(A[ct][j] * hin + B[ct][j]);
            }
        }
    }
    __syncthreads();
}

DEVI void phase_mix(const Params& p, int l, unsigned char* smem) {
    const int w = TIDX >> 6;
    const int NRET = 64, NLRU = 128;
    const int NLAT = 1024, NCTX = (l == 0 ? 128 : 0);
    const int ntask = NRET + NLRU + 2 * NLAT + 2 * NCTX;
    const int ncvt = 3072;
    int cv = BIDX;
    for (int task = BIDX; task < ntask; task += gridDim.x) {
        for (int r = 0; r < 2 && cv < ncvt; ++r, cv += gridDim.x) { CvtJob j = get_moe_job(p, l, cv >> 10); cvt_tile256(j, cv & 1023, smem); }
        if (task < NRET) retention_walk(p, l, task, smem);
        else if (task < NRET + NLRU) lru_walk(p, l, task - NRET, smem);
        else {
            int a = task - NRET - NLRU;
            int kind, b, hsel, tq0, nkeys;
            if (a < NLAT) { kind = 0; b = a >> 7; const int r = a & 127; hsel = r >> 4; tq0 = CTXL + (r & 15) * 128; nkeys = TPB; }
            else if (a < 2 * NLAT) { a -= NLAT; kind = 1; b = a >> 7; const int r = a & 127; hsel = r >> 6; tq0 = CTXL + (r & 63) * 32; nkeys = TPB; }
            else if (a < 2 * NLAT + NCTX) { a -= 2 * NLAT; kind = 0; b = a >> 4; const int r = a & 15; hsel = r >> 1; tq0 = (r & 1) * 128; nkeys = CTXL; }
            else { a -= 2 * NLAT + NCTX; kind = 1; b = a >> 4; const int r = a & 15; hsel = r >> 3; tq0 = (r & 7) * 32; nkeys = CTXL; }
            if (kind == 0) attn_task<96, true>(p, b, hsel, tq0, nkeys, smem);
            else attn_task<64, false>(p, b, hsel, tq0, nkeys, smem);
        }
    }
    for (; cv < ncvt; cv += gridDim.x) { CvtJob j = get_moe_job(p, l, cv >> 10); cvt_tile256(j, cv & 1023, smem); }
}

DEVI void phase_fin(const Params& p, int l) {
    const int lane = TIDX & 63, w = TIDX >> 6;
    for (int row = BIDX * 4 + w; row < TT; row += gridDim.x * 4) {
        if (l == 1 && (row % TPB) < CTXL) continue;
        const size_t o = (size_t)row * 512 + lane * 8;
        bf16x8 f = *(const bf16x8*)(DB(D_OF) + o), bk = *(const bf16x8*)(DB(D_OB) + o), gt = *(const bf16x8*)(CB(C_RG) + o);
        float v[8], s = 0.f;
#pragma unroll
        for (int e = 0; e < 8; ++e) { v[e] = bf2f((bf16_t)f[e]) + bf2f((bf16_t)bk[e]); s += v[e]; }
#pragma unroll
        for (int off = 1; off < 16; off <<= 1) s += __shfl_xor(s, off);
        const float mu = s * (1.f / 128.f);
        float q = 0.f;
#pragma unroll
        for (int e = 0; e < 8; ++e) { v[e] -= mu; q += v[e] * v[e]; }
#pragma unroll
        for (int off = 1; off < 16; off <<= 1) q += __shfl_xor(q, off);
        const float rs = rsqrtf(q * (1.f / 128.f) + EPSV);
        const float* gn = p.in[I_RNORM] + l * 512 + lane * 8;
        bf16x8 ob;
#pragma unroll
        for (int e = 0; e < 8; ++e) ob[e] = (short)f2bf(siluf_(bf2f((bf16_t)gt[e])) * (v[e] * rs * gn[e]));
        *(bf16x8*)(DB(D_OF) + o) = ob;
        bf16x8 h0 = *(const bf16x8*)(DB(D_LH0) + o), h1 = *(const bf16x8*)(DB(D_LH1) + o), lg = *(const bf16x8*)(CB(C_LG) + o);
        bf16x8 oc;
#pragma unroll
        for (int e = 0; e < 8; ++e) oc[e] = (short)f2bf((bf2f((bf16_t)h0[e]) + bf2f((bf16_t)h1[e])) * gelu_tanh(bf2f((bf16_t)lg[e])));
        *(bf16x8*)(DB(D_LH0) + o) = oc;
    }
}

DEVI void phase_merge(const Params& p, int l, unsigned char* smem) {
    bf16_t* ct = (bf16_t*)smem;
    const int lane = TIDX & 63, wc = (TIDX >> 6) & 1;
    const int nmt = (l == 0 ? 144 : 128);
    for (int it = 0;; ++it) {
        int mq, nt;
        if (!super_tile(it, nmt, 16, 4, 16, mq, nt)) break;
        if (mq < 0) continue;
        const int mt = mt_of(mq, l != 0);
        const int row0 = mt * 128;
        f32x4 m[4][2];
        acc_zero<64>(m);
        for (int n = 0; n < 4; ++n) {
            f32x4 ag[4][2], ap[4][2];
            acc_zero<64>(ag); acc_zero<64>(ap);
            AOp A1{HB, 1024, row0, nullptr};
            gemm_core<64>(ag, A1, WB(W_MG + (size_t)l * 4096 * 1024 + (size_t)(n * 1024 + nt * 64) * 1024), 1024, 1024, smem);
            const bf16_t* yb = n == 0 ? DB(D_YA) : (n == 1 ? DB(D_OF) : (n == 2 ? DB(D_LH0) : DB(D_YD)));
            AOp A2{yb, 512, row0, nullptr};
            gemm_core<64>(ap, A2, WB(W_BR + ((size_t)l * 4 + n) * 1024 * 512 + (size_t)(nt * 64) * 512), 512, 512, smem);
            const float* bm = p.in[I_BMG] + l * 4096 + n * 1024 + nt * 64 + wc * 32 + (lane & 15);
#pragma unroll
            for (int ni = 0; ni < 2; ++ni) {
                const float bias = bm[ni * 16];
#pragma unroll
                for (int mi = 0; mi < 4; ++mi)
#pragma unroll
                    for (int j = 0; j < 4; ++j) m[mi][ni][j] += sigmoidf_(ag[mi][ni][j] + bias) * ap[mi][ni][j];
            }
        }
        __syncthreads();
        acc_to_ct<64>(m, ct);
        __syncthreads();
        ep_store_rows<64>(ct, 0, CB(C_M) + nt * 64, 1024, row0);
        __syncthreads();
    }
}

DEVI void phase_wout(const Params& p, int l, unsigned char* smem) {
    bf16_t* ct = (bf16_t*)smem;
    const int nmt = (l == 0 ? 144 : 128);
    for (int it = 0;; ++it) {
        int mq, nt;
        if (!super_tile(it, nmt, 8, 8, 8, mq, nt)) break;
        if (mq < 0) continue;
        {
            const int mt = mt_of(mq, l != 0);
            const int row0 = mt * 128, b = mt / 18, t0 = (mt % 18) * 128;
            const bool isctx = (mt % 18) < 2;
            const int bi = isctx ? 8 : b;
            f32x4 acc[4][4];
            acc_zero<128>(acc);
            AOp A{CB(C_M), 1024, row0, nullptr};
            gemm_core<128>(acc, A, WB(W_OUT + (size_t)l * 1024 * 1024 + (size_t)nt * 128 * 1024), 1024, 1024, smem);
            __syncthreads();
            acc_to_ct<128>(acc, ct);
            __syncthreads();
            const float* gate = WSF(OFF_MOD) + (size_t)(l * 9 + bi) * 6144 + 2 * 1024 + nt * 128;
            for (int c = TIDX; c < 128 * 32; c += 256) {
                const int i = c >> 5, jc = c & 31;
                const int t = t0 + i;
                const float* xs;
                if (l == 0) xs = isctx ? p.in[I_CTX] + ((size_t)b * CTXL + t) * DM : p.in[I_X] + ((size_t)b * SEQL + (t - CTXL)) * DM;
                else xs = XCUR + (size_t)(row0 + i) * DM;
                float4 x4 = *(const float4*)(xs + nt * 128 + jc * 4);
                float4 g4 = *(const float4*)(gate + jc * 4);
                uint2 y = *(const uint2*)(ct + i * CT_LD + jc * 4);
                x4.x += g4.x * __uint_as_float(y.x << 16);
                x4.y += g4.y * __uint_as_float(y.x & 0xffff0000u);
                x4.z += g4.z * __uint_as_float(y.y << 16);
                x4.w += g4.w * __uint_as_float(y.y & 0xffff0000u);
                *(float4*)(XCUR + (size_t)(row0 + i) * DM + nt * 128 + jc * 4) = x4;
            }
            __syncthreads();
        }
    }
}

DEVI void phase_route(const Params& p, int l, unsigned char* smem) {
    const int tid = TIDX, lane = tid & 63, w = tid >> 6, wr = w >> 1, wc = w & 1;
    float* lgt = (float*)smem;
    const float rbias = p.in[I_RB][lane];
    int* cnt = WSI(OFF_CNT) + l * 64;
    int* list = WSI(OFF_LIST);
    const int ntile = l == 0 ? 144 : 128;
    for (int q = BIDX; q < ntile; q += gridDim.x) {
        const int mt = mt_of(q, l != 0);
        const int row0 = mt * 128;
        f32x4 acc[4][2];
        acc_zero<64>(acc);
        AOp A{HB, 1024, row0, nullptr};
        gemm_core<64>(acc, A, WB(W_RT), 1024, 1024, smem);
        __syncthreads();
#pragma unroll
        for (int mi = 0; mi < 4; ++mi)
#pragma unroll
            for (int ni = 0; ni < 2; ++ni)
#pragma unroll
                for (int j = 0; j < 4; ++j)
                    lgt[(wr * 64 + mi * 16 + (lane >> 4) * 4 + j) * 68 + wc * 32 + ni * 16 + (lane & 15)] = acc[mi][ni][j];
        __syncthreads();
        for (int i = 0; i < 32; ++i) {
            const int row = row0 + w * 32 + i;
            const float lg = lgt[(w * 32 + i) * 68 + lane];
            const float score = sigmoidf_(lg);
            const float biased = score + rbias;
            float v1 = biased; int i1 = lane;
#pragma unroll
            for (int off = 1; off < 8; off <<= 1) {
                float ov = __shfl_xor(v1, off); int oi = __shfl_xor(i1, off);
                if (ov > v1 || (ov == v1 && oi < i1)) { v1 = ov; i1 = oi; }
            }
            float v2 = (lane == i1) ? -3.0e38f : biased; int i2 = lane;
#pragma unroll
            for (int off = 1; off < 8; off <<= 1) {
                float ov = __shfl_xor(v2, off); int oi = __shfl_xor(i2, off);
                if (ov > v2 || (ov == v2 && oi < i2)) { v2 = ov; i2 = oi; }
            }
            float gv = v1 + v2; int gi = lane >> 3;
#pragma unroll
            for (int off = 8; off < 64; off <<= 1) {
                float ov = __shfl_xor(gv, off); int oi = __shfl_xor(gi, off);
                if (ov > gv || (ov == gv && oi < gi)) { gv = ov; gi = oi; }
            }
            const int e0 = __shfl(i1, gi * 8), e1 = __shfl(i2, gi * 8);
            const float s0 = __shfl(score, e0), s1 = __shfl(score, e1);
            if (lane == 0) {
                Rec rc;
                rc.e0 = e0; rc.e1 = e1;
                rc.p0 = atomicAdd(&cnt[e0], 1);
                rc.p1 = atomicAdd(&cnt[e1], 1);
                const float inv = 1.f / (s0 + s1);
                rc.w0 = s0 * inv; rc.w1 = s1 * inv; rc.pad0 = 0; rc.pad1 = 0;
                list[(size_t)e0 * TT + rc.p0] = row;
                list[(size_t)e1 * TT + rc.p1] = row;
                ((Rec*)(p.ws + OFF_REC))[row] = rc;
            }
        }
        __syncthreads();
    }
}

DEVI bool moe_tile(const MoeTab& mt, int it, int NT, int& e, int& jt, int& nt) {
    const int b = BIDX, G = gridDim.x;
    const int ngrp = (G >= 8 && (G & 7) == 0) ? 8 : 1;
    const int xcd = b % ngrp, j = b / ngrp, per = G / ngrp, epg = 64 / ngrp;
    int rem = j + per * it;
    for (int q = 0; q < epg; ++q) {
        const int ee = xcd * epg + q;
        const int ne = ((mt.cnt(ee) + 127) >> 7) * NT;
        if (rem < ne) { e = ee; jt = rem / NT; nt = rem % NT; return true; }
        rem -= ne;
    }
    return false;
}
DEVI void phase_moe1(const Params& p, int l, unsigned char* smem) {
    bf16_t* ct = (bf16_t*)smem;
    int* ridx = (int*)(smem + AUX_OFF);
    MoeTab mt = moe_tables(p, l, smem);
    const int* list = WSI(OFF_LIST);
    for (int it = 0;; ++it) {
        int e, jt, nt;
        if (!moe_tile(mt, it, 4, e, jt, nt)) break;
        if (TIDX < 128) {
            const int idx = jt * 128 + TIDX;
            ridx[TIDX] = list[(size_t)e * TT + (idx < mt.cnt(e) ? idx : 0)];
        }
        __syncthreads();
        f32x4 acc[4][4];
        acc_zero<128>(acc);
        AOp A{HB, 1024, 0, ridx};
        gemm_core<128>(acc, A, MWB(MW_13) + ((size_t)e * 512 + nt * 128) * 1024, 1024, 1024, smem);
        __syncthreads();
        acc_to_ct<128>(acc, ct);
        __syncthreads();
        const int slot0 = mt.seg(e) + jt * 128;
        for (int c = TIDX; c < 128 * 8; c += 256) {
            const int i = c >> 3, jc = c & 7;
            bf16x8 a = *(const bf16x8*)(ct + i * CT_LD + jc * 8), g = *(const bf16x8*)(ct + i * CT_LD + 64 + jc * 8), o;
#pragma unroll
            for (int q = 0; q < 8; ++q) o[q] = (short)f2bf(siluf_(bf2f((bf16_t)a[q])) * bf2f((bf16_t)g[q]));
            *(bf16x8*)(DB(D_ACT) + (size_t)(slot0 + i) * 256 + nt * 64 + jc * 8) = o;
        }
        __syncthreads();
    }
}
DEVI void phase_moe2(const Params& p, int l, unsigned char* smem) {
    bf16_t* ct = (bf16_t*)smem;
    MoeTab mt = moe_tables(p, l, smem);
    for (int it = 0;; ++it) {
        int e, jt, nt;
        if (!moe_tile(mt, it, 8, e, jt, nt)) break;
        const int slot0 = mt.seg(e) + jt * 128;
        f32x4 acc[4][4];
        acc_zero<128>(acc);
        AOp A{DB(D_ACT), 256, slot0, nullptr};
        gemm_core<128>(acc, A, MWB(MW_2) + ((size_t)e * 1024 + nt * 128) * 256, 256, 256, smem);
        __syncthreads();
        acc_to_ct<128>(acc, ct);
        __syncthreads();
        ep_store_rows<128>(ct, 0, DB(D_YS) + nt * 128, 1024, slot0);
        __syncthreads();
    }
}

#define XB_TMO      128
#define XB_XCNT(j)  (256  + 64 * (j))
#define XB_XSUB(j)  (1280 + 64 * (j))
#define XB_XGEN(j)  (2304 + 64 * (j))
#define XB_TOP      3328
#define XB_TOPGEN   3392
#define XB_SPIN_CAP (1u << 22)
DEVI unsigned xb_ld(unsigned* p) { return __hip_atomic_load(p, __ATOMIC_RELAXED, __HIP_MEMORY_SCOPE_AGENT); }
DEVI unsigned xb_add(unsigned* p, unsigned v) { return __hip_atomic_fetch_add(p, v, __ATOMIC_RELAXED, __HIP_MEMORY_SCOPE_AGENT); }
DEVI unsigned xb_xcc_id() { return (unsigned)__builtin_amdgcn_s_getreg((3 << 11) | 20) & 0xFu; }
#define XB_SPIN(cond, bar) do { unsigned _sp = 0; while (cond) { __builtin_amdgcn_s_sleep(1); \
    if ((++_sp & 255u) == 0u) { if (xb_ld(&(bar)[XB_TMO])) break; if (_sp > XB_SPIN_CAP) { atomicAdd(&(bar)[XB_TMO], 1u); break; } } } } while (0)
struct XcdBarrier { unsigned* bar; unsigned x; unsigned* st; };
DEVI XcdBarrier xcd_barrier_post(unsigned* bar, unsigned* st) {
    XcdBarrier b; b.bar = bar; b.x = xb_xcc_id(); b.st = st;
    if (__builtin_amdgcn_workitem_id_x() == 0) (void)xb_add(&bar[XB_XCNT(b.x)], 1u);
    return b;
}
DEVI void xcd_barrier_complete(unsigned* bar, unsigned x, unsigned& nloc, unsigned& nx) {
    const unsigned G = gridDim.x * gridDim.y * gridDim.z;
    unsigned sum, cnt, mine, sp = 0u;
    for (;;) {
        sum = 0u; cnt = 0u; mine = 0u;
#pragma unroll
        for (unsigned j = 0; j < 16; ++j) { const unsigned c = xb_ld(&bar[XB_XCNT(j)]); sum += c; cnt += (c > 0u) ? 1u : 0u; mine = (j == x) ? c : mine; }
        if (sum == G) break;
        __builtin_amdgcn_s_sleep(1);
        if ((++sp & 255u) == 0u) { if (xb_ld(&bar[XB_TMO])) break; if (sp > XB_SPIN_CAP) { atomicAdd(&bar[XB_TMO], 1u); break; } }
    }
    nloc = mine > 0u ? mine : 1u; nx = cnt > 0u ? cnt : 1u;
}
DEVI void xcd_barrier(const XcdBarrier& b) {
    asm volatile("s_waitcnt vmcnt(0)" ::: "memory");
    __syncthreads();
    if (__builtin_amdgcn_workitem_id_x() == 0) {
        unsigned* bar = b.bar;
        __builtin_amdgcn_s_waitcnt(0);
        unsigned nloc = xb_ld(&b.st[0]), nx = xb_ld(&b.st[1]);
        if (nloc == 0u) { xcd_barrier_complete(bar, b.x, nloc, nx); __hip_atomic_store(&b.st[0], nloc, __ATOMIC_RELAXED, __HIP_MEMORY_SCOPE_AGENT); __hip_atomic_store(&b.st[1], nx, __ATOMIC_RELAXED, __HIP_MEMORY_SCOPE_AGENT); }
        const unsigned old = xb_add(&bar[XB_XSUB(b.x)], 1u);
        const unsigned gen = old / nloc;
        if (old + 1u == (gen + 1u) * nloc) {
            __builtin_amdgcn_fence(__ATOMIC_RELEASE, "agent");
            asm volatile("s_waitcnt vmcnt(0)" ::: "memory");
            const unsigned og = xb_add(&bar[XB_TOP], 1u);
            const unsigned tg = og / nx;
            if (og + 1u == (tg + 1u) * nx) xb_add(&bar[XB_TOPGEN], 1u);
            else XB_SPIN(xb_ld(&bar[XB_TOPGEN]) == tg, bar);
            __builtin_amdgcn_fence(__ATOMIC_ACQUIRE, "agent");
            xb_add(&bar[XB_XGEN(b.x)], 1u);
            asm volatile("s_waitcnt vmcnt(0)" ::: "memory");
        } else {
            XB_SPIN(xb_ld(&bar[XB_XGEN(b.x)]) == gen, bar);
            __builtin_amdgcn_fence(__ATOMIC_ACQUIRE, "agent");
            asm volatile("s_waitcnt vmcnt(0)" ::: "memory");
        }
    }
    __syncthreads();
}

constexpr int NPHASE = 24;
DEVI void run_phase(const Params& p, int ph, unsigned char* smem) {
#ifndef ONLYK
    if (ph == 0) { phase0(p, smem); return; }
    if (ph == 23) { phase_norm1(p, 1, 1, smem); return; }
#endif
    const int l = (ph - 1) / 11, k = (ph - 1) % 11;
#ifdef ONLYK
    if (k != ONLYK) return;
#endif
    switch (k) {
    case 0: phase_norm1(p, l, 0, smem); break;
    case 1: phase_win(p, l, smem); break;
    case 2: phase_mla_up(p, l, smem); break;
    case 3: phase_mix(p, l, smem); break;
    case 4: phase_fin(p, l); break;
    case 5: phase_merge(p, l, smem); break;
    case 6: phase_wout(p, l, smem); break;
    case 7: phase_norm1(p, l, 2, smem); break;
    case 8: phase_route(p, l, smem); break;
    case 9: phase_moe1(p, l, smem); break;
    default: phase_moe2(p, l, smem); break;
    }
}

__global__ void __launch_bounds__(256, 2) k_main(Params p, int ph_lo, int ph_hi) {
    __shared__ __attribute__((aligned(16))) unsigned char smem[SMEM_BYTES];
    unsigned* xb_priv = (unsigned*)(p.ws + OFF_PRIV + (size_t)__builtin_amdgcn_workgroup_id_x() * 1024 + 896);
    if (__builtin_amdgcn_workitem_id_x() == 0) { __hip_atomic_store(xb_priv, 0u, __ATOMIC_RELAXED, __HIP_MEMORY_SCOPE_AGENT); __hip_atomic_store(xb_priv + 1, 0u, __ATOMIC_RELAXED, __HIP_MEMORY_SCOPE_AGENT); }
    XcdBarrier xb = xcd_barrier_post((unsigned*)(p.ws + OFF_BAR), xb_priv);
    for (int ph = ph_lo; ph < ph_hi; ++ph) {
        run_phase(p, ph, smem);
#ifdef DUPK
        if (ph >= 1 && ph <= 22 && ((ph - 1) % 11) == DUPK) run_phase(p, ph, smem);
        if (DUPK == 10 && ph == 0) run_phase(p, ph, smem);
#endif
        if (ph + 1 < ph_hi) {
            if (ph == ph_lo) cg::this_grid().sync();
            else xcd_barrier(xb);
        }
    }
}

extern "C" void kernel_launch(void* const* d_in, const int* in_sizes, int n_in, void* d_out, int out_size, void* d_ws, size_t ws_size,
                              hipStream_t stream) {
    if (ws_size < WS_NEED || n_in < N_IN) { fprintf(stderr, "workspace too small: %zu < %zu\n", ws_size, (size_t)WS_NEED); return; }
    Params p{};
    for (int i = 0; i < N_IN; ++i) p.in[i] = (const float*)d_in[i];
    p.out = (float*)d_out;
    p.ws = (unsigned char*)d_ws;
    static int grid_blocks = 0;
    if (!grid_blocks) {
        int dev = 0, cus = 0, per_cu = 0;
        hipGetDevice(&dev);
        hipDeviceGetAttribute(&cus, hipDeviceAttributeMultiprocessorCount, dev);
        hipOccupancyMaxActiveBlocksPerMultiprocessor(&per_cu, k_main, 256, DYN_LDS);
        if (per_cu > 2) per_cu = 2;
        if (per_cu < 1) per_cu = 1;
        grid_blocks = cus * per_cu;
    }
    hipMemsetAsync(p.ws + OFF_BAR, 0, 16384, stream);
#if ONE_LAUNCH
    int lo = 0, hi = NPHASE;
    void* args[] = {&p, &lo, &hi};
    hipError_t e = hipLaunchCooperativeKernel((void*)k_main, dim3(grid_blocks), dim3(256), args, DYN_LDS, stream);
    if (e != hipSuccess) fprintf(stderr, "cooperative launch failed: %s (grid %d)\n", hipGetErrorString(e), grid_blocks);
#else
    for (int ph = 0; ph < NPHASE; ++ph) hipLaunchKernelGGL(k_main, dim3(grid_blocks), dim3(256), DYN_LDS, stream, p, ph, ph + 1);
#endif
}
```

```cpp
#include <hip/hip_runtime.h>
#include <hip/hip_cooperative_groups.h>
#include <stdint.h>
#include <stdio.h>
namespace cg = cooperative_groups;

#define DEVI __device__ __forceinline__
#define LAS __attribute__((address_space(3)))
typedef unsigned short bf16_t;
typedef __attribute__((ext_vector_type(8))) short bf16x8;
typedef __attribute__((ext_vector_type(4))) float f32x4;
typedef __attribute__((ext_vector_type(16))) float f32x16;
typedef __attribute__((ext_vector_type(4))) short bf16x4;

#ifndef NAIVE_GEMM
#define NAIVE_GEMM 0
#endif
#ifndef ONE_LAUNCH
#define ONE_LAUNCH 1
#endif

constexpr int DM = 1024, NBT = 8, SEQL = 2048, CTXL = 256, TPB = 2304, TT = 18432;
constexpr int DINP = 3840;
constexpr float LOG2E = 1.4426950408889634f;
constexpr float EPSV = 1e-6f;
constexpr int NSLOT = 2 * TT + 64 * 128;

enum { I_X = 0, I_C, I_CTX, I_CCTX, I_ADAW, I_ADAB, I_N1G, I_N2G, I_WIN, I_MQN, I_MKVN, I_WUQ, I_WUKV, I_RDEC, I_RNORM,
       I_LCW, I_LCB, I_LWA, I_LBA, I_LWX, I_LBX, I_LLAM, I_GQN, I_GKN, I_WBR, I_WMG, I_BMG, I_WOUT, I_RW, I_RB,
       I_W1, I_W3, I_W2, I_FN, N_IN };

constexpr size_t AL(size_t x) { return (x + 255) & ~(size_t)255; }
constexpr size_t OFF_BAR = 0;
constexpr size_t OFF_CNT = 16384;
constexpr size_t OFF_MOD = OFF_CNT + 4096;
constexpr size_t OFF_R64 = AL(OFF_MOD + (size_t)2 * 9 * 6144 * 4);
constexpr size_t OFF_R32 = OFF_R64 + (size_t)2048 * 64 * 4;
constexpr size_t OFF_REC = OFF_R32 + (size_t)2048 * 32 * 4;
constexpr size_t OFF_LIST = OFF_REC + (size_t)TT * 32;
constexpr size_t OFF_PRIV = AL(OFF_LIST + (size_t)64 * TT * 4);
constexpr size_t OFF_W = OFF_PRIV + (size_t)2048 * 1024;
constexpr size_t W_IN = 0;
constexpr size_t W_UQ = W_IN + (size_t)2 * 3840 * 1024;
constexpr size_t W_UKV = W_UQ + (size_t)2 * 768 * 256;
constexpr size_t W_BR = W_UKV + (size_t)2 * 1024 * 128;
constexpr size_t W_MG = W_BR + (size_t)2 * 4 * 1024 * 512;
constexpr size_t W_OUT = W_MG + (size_t)2 * 4096 * 1024;
constexpr size_t W_LRU = W_OUT + (size_t)2 * 1024 * 1024;
constexpr size_t W_RT = W_LRU + (size_t)2 * 2 * 8 * 2 * 64 * 64;
constexpr size_t W_END = W_RT + (size_t)64 * 1024;
constexpr size_t OFF_XCUR = AL(OFF_W + W_END * 2);
constexpr size_t OFF_H = OFF_XCUR + (size_t)TT * 1024 * 4;
constexpr size_t OFF_C = OFF_H + (size_t)TT * 1024 * 2;
constexpr size_t C_CQ = 0;
constexpr size_t C_CKV = C_CQ + (size_t)TT * 256;
constexpr size_t C_KR = C_CKV + (size_t)TT * 128;
constexpr size_t C_MQ = C_KR + (size_t)TT * 32;
constexpr size_t C_KN = C_MQ + (size_t)TT * 768;
constexpr size_t C_VMT = C_KN + (size_t)TT * 512;
constexpr size_t C_RQ = C_VMT + (size_t)TT * 512;
constexpr size_t C_RK = C_RQ + (size_t)TT * 256;
constexpr size_t C_RKT = C_RK + (size_t)TT * 256;
constexpr size_t C_RVT = C_RKT + (size_t)TT * 256;
constexpr size_t C_RG = C_RVT + (size_t)TT * 512;
constexpr size_t C_LX = C_RG + (size_t)TT * 512;
constexpr size_t C_LG = C_LX + (size_t)TT * 512;
constexpr size_t C_GQ = C_LG + (size_t)TT * 512;
constexpr size_t C_GK = C_GQ + (size_t)TT * 512;
constexpr size_t C_GVT = C_GK + (size_t)TT * 128;
constexpr size_t C_END = C_GVT + (size_t)TT * 128;
constexpr size_t C_M = 0;
constexpr size_t C_W13 = (size_t)24 * 1024 * 1024;
constexpr size_t C_W2 = C_W13 + (size_t)64 * 512 * 1024;
static_assert(C_W2 + (size_t)64 * 1024 * 256 <= C_END, "moe alias");
static_assert((size_t)TT * 1024 <= C_W13, "m alias");
constexpr size_t OFF_D = OFF_C + C_END * 2;
constexpr size_t D_YA = 0;
constexpr size_t D_YD = (size_t)TT * 512;
constexpr size_t D_OF = (size_t)2 * TT * 512;
constexpr size_t D_OB = (size_t)3 * TT * 512;
constexpr size_t D_LH0 = (size_t)4 * TT * 512;
constexpr size_t D_LH1 = (size_t)5 * TT * 512;
constexpr size_t D_ACT = 0;
constexpr size_t D_YS = (size_t)12 * 1024 * 1024;
constexpr size_t D_END = D_YS + (size_t)NSLOT * 1024;
static_assert((size_t)NSLOT * 256 <= D_YS, "act alias");
static_assert((size_t)6 * TT * 512 <= D_END, "d size");
constexpr size_t OFF_MOEW = AL(OFF_D + D_END * 2);
constexpr size_t MW_13 = 0, MW_2 = (size_t)64 * 512 * 1024, MW_END = MW_2 + (size_t)64 * 1024 * 256;
constexpr size_t WS_NEED = OFF_MOEW + MW_END * 2;

struct Params {
    const float* in[N_IN];
    float* out;
    unsigned char* ws;
};

#define WSF(off) ((float*)(p.ws + (off)))
#define WSI(off) ((int*)(p.ws + (off)))
#define WB(el) ((bf16_t*)(p.ws + OFF_W) + (el))
#define CB(el) ((bf16_t*)(p.ws + OFF_C) + (el))
#define DB(el) ((bf16_t*)(p.ws + OFF_D) + (el))
#define MWB(el) ((bf16_t*)(p.ws + OFF_MOEW) + (el))
#define HB ((bf16_t*)(p.ws + OFF_H))
#define XCUR ((float*)(p.ws + OFF_XCUR))

constexpr int SMEM_BYTES = 65536;
constexpr int DYN_LDS = 0;
constexpr int CT_LD = 136;
constexpr int AUX_OFF = 36864;

#ifdef TPROBE
#define T_SLOT(id) ((unsigned long long*)(p.ws + OFF_BAR + 14400) + (id))
#define T_BEGIN(id) const unsigned long long _tb##id = __builtin_amdgcn_s_memrealtime()
#define T_END(id, cond) do { if ((cond) && __builtin_amdgcn_workitem_id_x() == 0) atomicAdd(T_SLOT(id), __builtin_amdgcn_s_memrealtime() - _tb##id); } while (0)
#else
#define T_BEGIN(id)
#define T_END(id, cond)
#endif
DEVI int launder_tid() { int t = __builtin_amdgcn_workitem_id_x(); asm volatile("" : "+v"(t)); return t; }
DEVI int launder_bid() { int t = __builtin_amdgcn_workgroup_id_x(); asm volatile("" : "+s"(t)); return t; }
#define TIDX launder_tid()
#define BIDX launder_bid()
DEVI float bf2f(bf16_t v) { return __uint_as_float(((unsigned)v) << 16); }
DEVI bf16_t f2bf(float f) {
    __bf16 h = (__bf16)f;
    return __builtin_bit_cast(unsigned short, h);
}
DEVI float sigmoidf_(float x) { return 1.f / (1.f + __expf(-x)); }
DEVI float siluf_(float x) { return x / (1.f + __expf(-x)); }
DEVI float gelu_tanh(float x) {
    float u = 0.7978845608028654f * (x + 0.044715f * x * x * x);
    return 0.5f * x * (1.f + tanhf(u));
}
DEVI float wave_sum(float v) {
#pragma unroll
    for (int o = 32; o > 0; o >>= 1) v += __shfl_xor(v, o);
    return v;
}
DEVI int mt_of(int q, bool latonly) { return latonly ? (q >> 4) * 18 + 2 + (q & 15) : q; }

struct CvtJob { const float* src; bf16_t* dst; const float* ks; int K, N, ldd, batch; size_t sbs, dbs; int mode; int lds, n0, wide; };
DEVI int cvt_rowmap(int mode, int n) {
    if (mode == 1) return n < 384 ? n : (n < 416 ? n - 384 + 3712 : n - 32);
    if (mode == 2) { int h = n / 96, j = n % 96; return j < 64 ? h * 64 + j : 512 + h * 32 + (j - 64); }
    if (mode == 3) return (n >> 6) * 128 + (n & 63);
    return n;
}
DEVI void cvt_tile(const CvtJob& j, int tile, float* lds) {
    const int tn = j.N / 32, tk = j.K / 64, per = tn * tk;
    const int bb = tile / per, r = tile % per, kt = r / tn, nt = r % tn;
    const float* s = j.src + (size_t)bb * j.sbs + (size_t)(kt * 64) * j.lds + j.n0 + nt * 32;
    const int tx = TIDX & 31, ty = TIDX >> 5;
#pragma unroll
    for (int i = 0; i < 8; ++i) {
        int k = ty + 8 * i;
        float v = s[(size_t)k * j.lds + tx];
        if (j.ks) v *= j.ks[kt * 64 + k];
        lds[k * 33 + tx] = v;
    }
    __syncthreads();
    bf16_t* d = j.dst + (size_t)bb * j.dbs;
#pragma unroll
    for (int i = 0; i < 4; ++i) {
        int n = ty + 8 * i, kk = tx * 2;
        unsigned lo = f2bf(lds[kk * 33 + n]), hi = f2bf(lds[(kk + 1) * 33 + n]);
        int row = cvt_rowmap(j.mode, j.n0 + nt * 32 + n);
        *(unsigned*)(d + (size_t)row * j.ldd + kt * 64 + kk) = lo | (hi << 16);
    }
    __syncthreads();
}

DEVI void cvt_tile256(const CvtJob& j, int tile, unsigned char* smem) {
    constexpr int NS = 68;
    bf16_t* T = (bf16_t*)smem;
    const int tn = j.N / 256, tk = j.K / 64, per = tn * tk;
    const int bb = tile / per, r = tile % per, kt = r / tn, nt = r % tn;
    const float* s = j.src + (size_t)bb * j.sbs + (size_t)(kt * 64) * j.lds + j.n0 + nt * 256;
    const int tid = TIDX, lane = tid & 63, w = tid >> 6;
    float4 v[16];
#pragma unroll
    for (int i = 0; i < 16; ++i) v[i] = *(const float4*)(s + (size_t)(w * 16 + i) * j.lds + lane * 4);
    if (j.ks) {
#pragma unroll
        for (int i = 0; i < 16; ++i) { const float sc = j.ks[kt * 64 + w * 16 + i]; v[i].x *= sc; v[i].y *= sc; v[i].z *= sc; v[i].w *= sc; }
    }
    __syncthreads();
#pragma unroll
    for (int h = 0; h < 2; ++h) {
        bf16x4 q0a, q0b, q1a, q1b, q2a, q2b, q3a, q3b;
#pragma unroll
        for (int e = 0; e < 4; ++e) {
            q0a[e] = (short)f2bf(v[h * 8 + e].x); q0b[e] = (short)f2bf(v[h * 8 + 4 + e].x);
            q1a[e] = (short)f2bf(v[h * 8 + e].y); q1b[e] = (short)f2bf(v[h * 8 + 4 + e].y);
            q2a[e] = (short)f2bf(v[h * 8 + e].z); q2b[e] = (short)f2bf(v[h * 8 + 4 + e].z);
            q3a[e] = (short)f2bf(v[h * 8 + e].w); q3b[e] = (short)f2bf(v[h * 8 + 4 + e].w);
        }
        bf16_t* tp = T + (lane * 4) * NS + w * 16 + h * 8;
        *(bf16x4*)(tp) = q0a; *(bf16x4*)(tp + 4) = q0b;
        *(bf16x4*)(tp + NS) = q1a; *(bf16x4*)(tp + NS + 4) = q1b;
        *(bf16x4*)(tp + 2 * NS) = q2a; *(bf16x4*)(tp + 2 * NS + 4) = q2b;
        *(bf16x4*)(tp + 3 * NS) = q3a; *(bf16x4*)(tp + 3 * NS + 4) = q3b;
    }
    __syncthreads();
    bf16_t* d = j.dst + (size_t)bb * j.dbs;
#pragma unroll
    for (int i = 0; i < 8; ++i) {
        const int c = tid + 256 * i, n = c >> 3, kc = c & 7;
        const bf16x4 lo = *(const bf16x4*)(T + n * NS + kc * 8), hi = *(const bf16x4*)(T + n * NS + kc * 8 + 4);
        const int row = cvt_rowmap(j.mode, j.n0 + nt * 256 + n);
        *(bf16x8*)(d + (size_t)row * j.ldd + kt * 64 + kc * 8) = bf16x8{lo[0], lo[1], lo[2], lo[3], hi[0], hi[1], hi[2], hi[3]};
    }
}
__constant__ const int CVT_TILES[10] = {224, 80, 12, 8, 128, 256, 64, 32, 32, 32};
constexpr int CVT_PER_LAYER = 224 + 80 + 12 + 8 + 128 + 256 + 64 + 32 + 32 + 32;
DEVI CvtJob get_job(const Params& p, int l, int k) {
    CvtJob j; j.ks = nullptr; j.batch = 1; j.sbs = 0; j.dbs = 0; j.mode = 0; j.n0 = 0; j.wide = 1;
    switch (k) {
    case 0: j.src = p.in[I_WIN] + (size_t)l * 1024 * 3744; j.dst = WB(W_IN + (size_t)l * 3840 * 1024); j.K = 1024; j.N = 3584; j.lds = 3744; j.ldd = 1024; j.mode = 1; break;
    case 1: j.src = p.in[I_WIN] + (size_t)l * 1024 * 3744; j.dst = WB(W_IN + (size_t)l * 3840 * 1024); j.K = 1024; j.N = 160; j.lds = 3744; j.n0 = 3584; j.ldd = 1024; j.mode = 1; j.wide = 0; break;
    case 2: j.src = p.in[I_WUQ] + (size_t)l * 256 * 768; j.dst = WB(W_UQ + (size_t)l * 768 * 256); j.K = 256; j.N = 768; j.lds = 768; j.ldd = 256; j.ks = p.in[I_MQN] + l * 256; j.mode = 2; break;
    case 3: j.src = p.in[I_WUKV] + (size_t)l * 128 * 1024; j.dst = WB(W_UKV + (size_t)l * 1024 * 128); j.K = 128; j.N = 1024; j.lds = 1024; j.ldd = 128; j.ks = p.in[I_MKVN] + l * 128; break;
    case 4: j.src = p.in[I_WBR] + (size_t)l * 4 * 512 * 1024; j.dst = WB(W_BR + (size_t)l * 4 * 1024 * 512); j.K = 512; j.N = 1024; j.lds = 1024; j.ldd = 512; j.batch = 4; j.sbs = 512 * 1024; j.dbs = 1024 * 512; break;
    case 5: j.src = p.in[I_WMG] + (size_t)l * 1024 * 4096; j.dst = WB(W_MG + (size_t)l * 4096 * 1024); j.K = 1024; j.N = 4096; j.lds = 4096; j.ldd = 1024; break;
    case 6: j.src = p.in[I_WOUT] + (size_t)l * 1024 * 1024; j.dst = WB(W_OUT + (size_t)l * 1024 * 1024); j.K = 1024; j.N = 1024; j.lds = 1024; j.ldd = 1024; break;
    case 7: j.src = p.in[I_LWA] + (size_t)l * 16 * 4096; j.dst = WB(W_LRU + (size_t)l * 16 * 8192); j.K = 64; j.N = 64; j.lds = 64; j.ldd = 64; j.batch = 16; j.sbs = 4096; j.dbs = 8192; j.wide = 0; break;
    case 8: j.src = p.in[I_LWX] + (size_t)l * 16 * 4096; j.dst = WB(W_LRU + (size_t)l * 16 * 8192 + 4096); j.K = 64; j.N = 64; j.lds = 64; j.ldd = 64; j.batch = 16; j.sbs = 4096; j.dbs = 8192; j.wide = 0; break;
    default: j.src = p.in[I_RW]; j.dst = WB(W_RT); j.K = 1024; j.N = 64; j.lds = 64; j.ldd = 1024; j.wide = 0; break;
    }
    return j;
}
DEVI CvtJob get_moe_job(const Params& p, int l, int k) {
    CvtJob j; j.ks = nullptr; j.batch = 64; j.sbs = 262144; j.n0 = 0; j.wide = 1;
    if (k == 0) { j.src = p.in[I_W1] + (size_t)l * 64 * 262144; j.dst = MWB(MW_13); j.K = 1024; j.N = 256; j.lds = 256; j.ldd = 1024; j.dbs = 512 * 1024; j.mode = 3; }
    else if (k == 1) { j.src = p.in[I_W3] + (size_t)l * 64 * 262144; j.dst = MWB(MW_13 + 64 * 1024); j.K = 1024; j.N = 256; j.lds = 256; j.ldd = 1024; j.dbs = 512 * 1024; j.mode = 3; }
    else { j.src = p.in[I_W2] + (size_t)l * 64 * 262144; j.dst = MWB(MW_2); j.K = 256; j.N = 1024; j.lds = 1024; j.ldd = 256; j.dbs = 262144; j.mode = 0; }
    return j;
}

struct AOp { const bf16_t* base; int ld; int row0; const int* ridx; };
DEVI const bf16_t* arow(const AOp& a, int i) {
    int r = a.ridx ? a.ridx[i] : a.row0 + i;
    return a.base + (size_t)r * a.ld;
}

#if NAIVE_GEMM
template <int BN>
DEVI void gemm_core(f32x4 (&acc)[4][BN / 32], const AOp& A, const bf16_t* B, int ldb, int K, unsigned char* smem) {
    constexpr int NI = BN / 32;
    const int tid = TIDX, lane = tid & 63, wid = tid >> 6, wr = wid >> 1, wc = wid & 1;
    for (int k0 = 0; k0 < K; k0 += 8) {
        bf16x8 bv[NI];
#pragma unroll
        for (int ni = 0; ni < NI; ++ni) bv[ni] = *(const bf16x8*)(B + (size_t)(wc * (BN / 2) + ni * 16 + (lane & 15)) * ldb + k0);
#pragma unroll
        for (int mi = 0; mi < 4; ++mi)
#pragma unroll
            for (int j = 0; j < 4; ++j) {
                bf16x8 av = *(const bf16x8*)(arow(A, wr * 64 + mi * 16 + (lane >> 4) * 4 + j) + k0);
#pragma unroll
                for (int ni = 0; ni < NI; ++ni) {
                    float s = 0.f;
#pragma unroll
                    for (int e = 0; e < 8; ++e) s += bf2f((bf16_t)av[e]) * bf2f((bf16_t)bv[ni][e]);
                    acc[mi][ni][j] += s;
                }
            }
    }
}
#else
#define GAS __attribute__((address_space(1)))
template <int BN, bool GATHER = false>
DEVI void gemm_core(f32x4 (&acc)[4][BN / 32], const AOp& A, const bf16_t* B, int ldb, int K, unsigned char* smem) {
    constexpr int NI = BN / 32;
    constexpr int NBL = BN / 32;
    constexpr int STG = 32768;
    const int tid = TIDX, lane = tid & 63, wid = tid >> 6, wr = wid >> 1, wc = wid & 1;
    const int lr = tid >> 3;
    const int kc = (tid & 7) ^ (lr & 7);
    const bf16_t* ap[GATHER ? 4 : 1];
    if (GATHER) {
#pragma unroll
        for (int i = 0; i < (GATHER ? 4 : 1); ++i) ap[i] = arow(A, lr + 32 * i) + kc * 8;
    } else ap[0] = A.base + (size_t)(A.row0 + lr) * A.ld + kc * 8;
    const size_t astep = (size_t)32 * A.ld;
    const bf16_t* bp = B + (size_t)lr * ldb + kc * 8;
    const size_t bstep = (size_t)32 * ldb;
    LAS unsigned char* lA = (LAS unsigned char*)smem + tid * 16;
    LAS unsigned char* lB = lA + 16384;
    const int nk = K >> 6;
    const int arow_off = (wr * 64 + (lane & 15)) * 128;
    const int brow_off = 16384 + (wc * (BN / 2) + (lane & 15)) * 128;
    __syncthreads();
#pragma unroll
    for (int i = 0; i < 4; ++i) __builtin_amdgcn_global_load_lds((const GAS unsigned*)(GATHER ? ap[GATHER ? i : 0] : ap[0] + i * astep), (LAS unsigned*)(lA + i * 4096), 16, 0, 0);
#pragma unroll
    for (int i = 0; i < NBL; ++i) __builtin_amdgcn_global_load_lds((const GAS unsigned*)(bp + i * bstep), (LAS unsigned*)(lB + i * 4096), 16, 0, 0);
    for (int kt = 0; kt < nk; ++kt) {
        __syncthreads();
        if (kt + 1 < nk) {
            const int ko = (kt + 1) * 64;
            const int so = ((kt + 1) & 1) * STG;
#pragma unroll
            for (int i = 0; i < 4; ++i) __builtin_amdgcn_global_load_lds((const GAS unsigned*)((GATHER ? ap[GATHER ? i : 0] : ap[0] + i * astep) + ko), (LAS unsigned*)(lA + so + i * 4096), 16, 0, 0);
#pragma unroll
            for (int i = 0; i < NBL; ++i) __builtin_amdgcn_global_load_lds((const GAS unsigned*)(bp + i * bstep + ko), (LAS unsigned*)(lB + so + i * 4096), 16, 0, 0);
        }
        const unsigned char* cs = smem + (kt & 1) * STG;
#pragma unroll
        for (int ks = 0; ks < 2; ++ks) {
            const int pch = ((ks * 4 + (lane >> 4)) ^ (lane & 7)) << 4;
            bf16x8 bfr[NI];
#pragma unroll
            for (int ni = 0; ni < NI; ++ni) bfr[ni] = *(const bf16x8*)(cs + brow_off + ni * 2048 + pch);
#pragma unroll
            for (int mi = 0; mi < 4; mi += 2) {
                const bf16x8 a0 = *(const bf16x8*)(cs + arow_off + mi * 2048 + pch);
                const bf16x8 a1 = *(const bf16x8*)(cs + arow_off + (mi + 1) * 2048 + pch);
#pragma unroll
                for (int ni = 0; ni < NI; ++ni) acc[mi][ni] = __builtin_amdgcn_mfma_f32_16x16x32_bf16(a0, bfr[ni], acc[mi][ni], 0, 0, 0);
#pragma unroll
                for (int ni = 0; ni < NI; ++ni) acc[mi + 1][ni] = __builtin_amdgcn_mfma_f32_16x16x32_bf16(a1, bfr[ni], acc[mi + 1][ni], 0, 0, 0);
            }
        }
    }
}
#endif

template <int BN>
DEVI void acc_zero(f32x4 (&acc)[4][BN / 32]) {
#pragma unroll
    for (int mi = 0; mi < 4; ++mi)
#pragma unroll
        for (int ni = 0; ni < BN / 32; ++ni) acc[mi][ni] = f32x4{0.f, 0.f, 0.f, 0.f};
}
template <int BN>
DEVI void acc_to_ct(const f32x4 (&acc)[4][BN / 32], bf16_t* ct) {
    const int tid = TIDX, lane = tid & 63, wid = tid >> 6, wr = wid >> 1, wc = wid & 1;
#pragma unroll
    for (int mi = 0; mi < 4; ++mi)
#pragma unroll
        for (int ni = 0; ni < BN / 32; ++ni)
#pragma unroll
            for (int j = 0; j < 4; ++j)
                ct[(wr * 64 + mi * 16 + (lane >> 4) * 4 + j) * CT_LD + wc * (BN / 2) + ni * 16 + (lane & 15)] = f2bf(acc[mi][ni][j]);
}

template <int NC>
DEVI void ep_store_rows(const bf16_t* ct, int c0, bf16_t* dst, int ldd, int row0) {
    constexpr int CPR = NC / 8;
    for (int c = TIDX; c < 128 * CPR; c += 256) {
        int i = c / CPR, jc = c % CPR;
        *(bf16x8*)(dst + (size_t)(row0 + i) * ldd + jc * 8) = *(const bf16x8*)(ct + i * CT_LD + c0 + jc * 8);
    }
}
DEVI void ep_store_T(const bf16_t* ct, int c0, int nc, bf16_t* dstT, int ldT, int t0) {
    for (int c = TIDX; c < nc * 16; c += 256) {
        int j = c >> 4, ic = c & 15;
        bf16x8 v;
#pragma unroll
        for (int e = 0; e < 8; ++e) v[e] = (short)ct[(ic * 8 + e) * CT_LD + c0 + j];
        *(bf16x8*)(dstT + (size_t)j * ldT + t0 + ic * 8) = v;
    }
}
DEVI void ep_rope64(bf16_t* ct, const float* gain, float scale, bool lat, int pos0, const float* cs64) {
    const int row = TIDX >> 1, half = TIDX & 1;
    bf16_t* pr = ct + row * CT_LD + half * 64;
    float v[64];
#pragma unroll
    for (int c = 0; c < 8; ++c) {
        bf16x8 t = *(const bf16x8*)(pr + c * 8);
#pragma unroll
        for (int e = 0; e < 8; ++e) v[c * 8 + e] = bf2f((bf16_t)t[e]);
    }
    if (gain) {
        float ss = 0.f;
#pragma unroll
        for (int d = 0; d < 64; ++d) ss += v[d] * v[d];
        float rstd = rsqrtf(ss * (1.f / 64.f) + EPSV);
#pragma unroll
        for (int d = 0; d < 64; ++d) v[d] = v[d] * rstd * gain[d];
    }
    if (lat) {
        const float* cs = cs64 + (size_t)(pos0 + row) * 64;
#pragma unroll
        for (int i = 0; i < 16; ++i) {
            float a = v[i], b = v[i + 16], c = cs[i], s = cs[32 + i];
            v[i] = a * c - b * s; v[i + 16] = b * c + a * s;
            a = v[32 + i]; b = v[48 + i]; c = cs[16 + i]; s = cs[48 + i];
            v[32 + i] = a * c - b * s; v[48 + i] = b * c + a * s;
        }
    }
#pragma unroll
    for (int c = 0; c < 8; ++c) {
        bf16x8 t;
#pragma unroll
        for (int e = 0; e < 8; ++e) t[e] = (short)f2bf(v[c * 8 + e] * scale);
        *(bf16x8*)(pr + c * 8) = t;
    }
}
DEVI void ep_rope32(bf16_t* ct, int ngroups, const float* rstd, float scale, bool lat, int pos0, const float* cs32) {
    const int row = TIDX >> 1, half = TIDX & 1;
    const float rs = (rstd ? rstd[row] : 1.f) * scale;
#pragma unroll
    for (int gg = 0; gg < 2; ++gg) {
        const int g = half * 2 + gg;
        if (g < ngroups) {
            bf16_t* pr = ct + row * CT_LD + g * 32;
            float v[32];
#pragma unroll
            for (int c = 0; c < 4; ++c) {
                bf16x8 t = *(const bf16x8*)(pr + c * 8);
#pragma unroll
                for (int e = 0; e < 8; ++e) v[c * 8 + e] = bf2f((bf16_t)t[e]);
            }
            if (lat) {
                const float* cs = cs32 + (size_t)(pos0 + row) * 32;
#pragma unroll
                for (int i = 0; i < 8; ++i) {
                    float a = v[i], b = v[i + 8], c = cs[i], s = cs[16 + i];
                    v[i] = a * c - b * s; v[i + 8] = b * c + a * s;
                    a = v[16 + i]; b = v[24 + i]; c = cs[8 + i]; s = cs[24 + i];
                    v[16 + i] = a * c - b * s; v[24 + i] = b * c + a * s;
                }
            }
#pragma unroll
            for (int c = 0; c < 4; ++c) {
                bf16x8 t;
#pragma unroll
                for (int e = 0; e < 8; ++e) t[e] = (short)f2bf(v[c * 8 + e] * rs);
                *(bf16x8*)(pr + c * 8) = t;
            }
        }
    }
}
DEVI void ep_scale_rows(bf16_t* ct, int c0, int nc, const float* rstd, float scale) {
    const int cpr = nc / 8;
    for (int c = TIDX; c < 128 * cpr; c += 256) {
        int i = c / cpr, jc = c % cpr;
        bf16_t* pr = ct + i * CT_LD + c0 + jc * 8;
        bf16x8 t = *(const bf16x8*)pr;
        float rs = rstd[i] * scale;
#pragma unroll
        for (int e = 0; e < 8; ++e) t[e] = (short)f2bf(bf2f((bf16_t)t[e]) * rs);
        *(bf16x8*)pr = t;
    }
}
DEVI void ep_rstd(const bf16_t* A, int ld, int row0, int K, float* rstd) {
    const int row = TIDX >> 1, half = TIDX & 1;
    const bf16_t* pr = A + (size_t)(row0 + row) * ld + half * (K / 2);
    float ss = 0.f;
    for (int c = 0; c < K / 16; ++c) {
        bf16x8 t = *(const bf16x8*)(pr + c * 8);
#pragma unroll
        for (int e = 0; e < 8; ++e) { float f = bf2f((bf16_t)t[e]); ss += f * f; }
    }
    ss += __shfl_xor(ss, 1);
    if (half == 0) rstd[row] = rsqrtf(ss / (float)K + EPSV);
}


struct GrpInfo { int xcd, j, per, ngrp; };
DEVI GrpInfo grp_info(const Params& p) {
    const unsigned* pv = (const unsigned*)(p.ws + OFF_PRIV + (size_t)BIDX * 1024 + 896);
    GrpInfo g;
    g.xcd = (int)__hip_atomic_load(pv + 2, __ATOMIC_RELAXED, __HIP_MEMORY_SCOPE_AGENT);
    g.j = (int)__hip_atomic_load(pv + 3, __ATOMIC_RELAXED, __HIP_MEMORY_SCOPE_AGENT);
    g.per = (int)__hip_atomic_load((const unsigned*)(p.ws + OFF_BAR) + 256 + 64 * g.xcd, __ATOMIC_RELAXED, __HIP_MEMORY_SCOPE_AGENT);
    g.ngrp = 8;
    if (g.xcd >= 8 || g.per <= 0) { g.xcd = 0; g.j = BIDX; g.per = gridDim.x; g.ngrp = 1; }
    return g;
}
DEVI bool super_tile(const GrpInfo& gi, int it, int NMT, int NNT, int SM, int SN, int& mt, int& nt) {
    const int ST = SM * SN, passes = (ST + gi.per - 1) / gi.per;
    const int nsn = (NNT + SN - 1) / SN, nsm = (NMT + SM - 1) / SM;
    const int s = (it / passes) * gi.ngrp + gi.xcd;
    if (s >= nsm * nsn) return false;
    const int idx = (it % passes) * gi.per + gi.j;
    mt = -1; nt = 0;
    if (idx < ST) {
        const int m = (s / nsn) * SM + idx / SN, n = (s % nsn) * SN + idx % SN;
        if (m < NMT && n < NNT) { mt = m; nt = n; }
    }
    return true;
}

DEVI void phase0(const Params& p, unsigned char* smem) {
    const int tid = TIDX, lane = tid & 63, w = tid >> 6;
    const int NG = 192, NCV = 2 * CVT_PER_LAYER, NR = 8;
    const int ntask = NG + NCV + NR + 1;
    for (int task = BIDX; task < ntask; task += gridDim.x) {
        if (task < NG) {
            const int l = task / 96, n0 = (task % 96) * 64;
            float* sv = (float*)smem;
            float* red = (float*)(smem + 36864);
            for (int idx = lane; idx < 9 * 256; idx += 64) {
                int bi = idx >> 8, kk = idx & 255, k = 256 * w + kk;
                float c = bi < 8 ? p.in[I_C][bi * 1024 + k] : p.in[I_CCTX][k];
                sv[(w * 9 + bi) * 256 + kk] = siluf_(c);
            }
            __syncthreads();
            float acc[9];
#pragma unroll
            for (int bi = 0; bi < 9; ++bi) acc[bi] = 0.f;
            const float* wp = p.in[I_ADAW] + (size_t)l * 1024 * 6144 + (size_t)(256 * w) * 6144 + n0 + lane;
#pragma unroll 8
            for (int kk = 0; kk < 256; ++kk) {
                float wv = wp[(size_t)kk * 6144];
#pragma unroll
                for (int bi = 0; bi < 9; ++bi) acc[bi] += sv[(w * 9 + bi) * 256 + kk] * wv;
            }
#pragma unroll
            for (int bi = 0; bi < 9; ++bi) red[(w * 9 + bi) * 64 + lane] = acc[bi];
            __syncthreads();
            for (int idx = tid; idx < 9 * 64; idx += 256) {
                int bi = idx >> 6, c = idx & 63;
                float s = p.in[I_ADAB][l * 6144 + n0 + c];
#pragma unroll
                for (int ww = 0; ww < 4; ++ww) s += red[(ww * 9 + bi) * 64 + c];
                WSF(OFF_MOD)[(size_t)(l * 9 + bi) * 6144 + n0 + c] = s;
            }
            __syncthreads();
        } else if (task < NG + NCV) {
            int t = task - NG;
            int l = t / CVT_PER_LAYER; t %= CVT_PER_LAYER;
            int k = 0;
            while (t >= CVT_TILES[k]) { t -= CVT_TILES[k]; ++k; }
            CvtJob j = get_job(p, l, k);
            if (j.wide) cvt_tile256(j, t, smem); else cvt_tile(j, t, (float*)smem);
        } else if (task < NG + NCV + NR) {
            int pos = (task - NG - NCV) * 256 + tid;
            float rp = (float)(pos >> 6), cp = (float)(pos & 63);
            float* t64 = WSF(OFF_R64) + (size_t)pos * 64;
            float* t32 = WSF(OFF_R32) + (size_t)pos * 32;
            for (int i = 0; i < 16; ++i) {
                float inv = powf(10000.f, -(float)(2 * i) / 32.f);
                float ar = rp * inv, ac = cp * inv;
                t64[i] = cosf(ar); t64[16 + i] = cosf(ac); t64[32 + i] = sinf(ar); t64[48 + i] = sinf(ac);
            }
            for (int i = 0; i < 8; ++i) {
                float inv = powf(10000.f, -(float)(2 * i) / 16.f);
                float ar = rp * inv, ac = cp * inv;
                t32[i] = cosf(ar); t32[8 + i] = cosf(ac); t32[16 + i] = sinf(ar); t32[24 + i] = sinf(ac);
            }
        } else {
            WSI(OFF_CNT)[tid] = 0;
            for (int l = 0; l < 2; ++l) {
                unsigned* z = (unsigned*)WB(W_IN + (size_t)l * 3840 * 1024 + (size_t)3744 * 1024);
                for (int i = tid; i < 96 * 1024 / 2; i += 256) z[i] = 0u;
            }
        }
    }
}

struct MoeTab {
    int* base;
    DEVI int cnt(int e) const { return __hip_atomic_load(base + e, __ATOMIC_RELAXED, __HIP_MEMORY_SCOPE_AGENT); }
    DEVI int tp(int e) const { return __hip_atomic_load(base + 64 + e, __ATOMIC_RELAXED, __HIP_MEMORY_SCOPE_AGENT); }
    DEVI int seg(int e) const { return __hip_atomic_load(base + 136 + e, __ATOMIC_RELAXED, __HIP_MEMORY_SCOPE_AGENT); }
};
DEVI MoeTab moe_tables(const Params& p, int l, unsigned char* smem) {
    MoeTab t; t.base = (int*)(p.ws + OFF_PRIV + (size_t)BIDX * 1024);
    __syncthreads();
    if (TIDX == 0) {
        int a = 0, sg = 0;
        for (int e = 0; e < 64; ++e) {
            const int c = WSI(OFF_CNT)[l * 64 + e];
            __hip_atomic_store(t.base + e, c, __ATOMIC_RELAXED, __HIP_MEMORY_SCOPE_AGENT);
            __hip_atomic_store(t.base + 64 + e, a, __ATOMIC_RELAXED, __HIP_MEMORY_SCOPE_AGENT);
            __hip_atomic_store(t.base + 136 + e, sg, __ATOMIC_RELAXED, __HIP_MEMORY_SCOPE_AGENT);
            const int nt = (c + 127) >> 7;
            a += nt; sg += nt * 128;
        }
        __hip_atomic_store(t.base + 64 + 64, a, __ATOMIC_RELAXED, __HIP_MEMORY_SCOPE_AGENT);
        __hip_atomic_store(t.base + 136 + 64, sg, __ATOMIC_RELAXED, __HIP_MEMORY_SCOPE_AGENT);
    }
    asm volatile("s_waitcnt vmcnt(0)" ::: "memory");
    __syncthreads();
    return t;
}
struct Rec { int e0, p0, e1, p1; float w0, w1; int pad0, pad1; };

DEVI void phase_norm1(const Params& p, int l, int mode, unsigned char* smem) {
    const int lane = TIDX & 63, w = TIDX >> 6;
    MoeTab mt;
    const bool comb = (mode == 0 && l > 0) || mode == 1;
    const int lp = mode == 1 ? 1 : l - 1;
    if (comb) mt = moe_tables(p, lp, smem);
    const float* g1 = mode == 1 ? p.in[I_FN] : (mode == 2 ? p.in[I_N2G] + l * 1024 : p.in[I_N1G] + l * 1024);
    const bool latonly = (mode == 1) || (mode == 2 && l == 1);
    const int nrows = latonly ? NBT * SEQL : TT;
    const int stride = gridDim.x * 4;
    int ri = BIDX * 4 + w;
    float4 xn[4];
    auto rowof = [&](int r) { return latonly ? (r >> 11) * TPB + CTXL + (r & 2047) : r; };
    auto srcof = [&](int row) -> const float* {
        if (mode == 0 && l == 0) {
            const int b = row / TPB, t = row % TPB;
            return t < CTXL ? p.in[I_CTX] + ((size_t)b * CTXL + t) * DM : p.in[I_X] + ((size_t)b * SEQL + (t - CTXL)) * DM;
        }
        return XCUR + (size_t)row * DM;
    };
    if (ri < nrows) {
        const float* src = srcof(rowof(ri));
#pragma unroll
        for (int i = 0; i < 4; ++i) xn[i] = *(const float4*)(src + i * 256 + lane * 4);
    }
    for (; ri < nrows; ri += stride) {
        const int row = rowof(ri);
        const int b = row / TPB, t = row % TPB;
        const bool isctx = t < CTXL;
        const int bi = isctx ? 8 : b;
        float v[16];
#pragma unroll
        for (int i = 0; i < 4; ++i) { v[i * 4] = xn[i].x; v[i * 4 + 1] = xn[i].y; v[i * 4 + 2] = xn[i].z; v[i * 4 + 3] = xn[i].w; }
        if (ri + stride < nrows) {
            const float* src = srcof(rowof(ri + stride));
#pragma unroll
            for (int i = 0; i < 4; ++i) xn[i] = *(const float4*)(src + i * 256 + lane * 4);
        }
        if (comb) {
            float* xr = XCUR + (size_t)row * DM;
            const Rec rc = ((const Rec*)(p.ws + OFF_REC))[row];
            const bf16_t* y0 = DB(D_YS) + (size_t)(mt.seg(rc.e0) + rc.p0) * 1024;
            const bf16_t* y1 = DB(D_YS) + (size_t)(mt.seg(rc.e1) + rc.p1) * 1024;
            const float* gate = WSF(OFF_MOD) + (size_t)(lp * 9 + bi) * 6144 + 5 * 1024;
#pragma unroll
            for (int i = 0; i < 4; ++i) {
                const int c = i * 256 + lane * 4;
                float4 g4 = *(const float4*)(gate + c);
                uint2 a = *(const uint2*)(y0 + c), bb = *(const uint2*)(y1 + c);
                float f0 = rc.w0 * __uint_as_float(a.x << 16) + rc.w1 * __uint_as_float(bb.x << 16);
                float f1 = rc.w0 * __uint_as_float(a.x & 0xffff0000u) + rc.w1 * __uint_as_float(bb.x & 0xffff0000u);
                float f2 = rc.w0 * __uint_as_float(a.y << 16) + rc.w1 * __uint_as_float(bb.y << 16);
                float f3 = rc.w0 * __uint_as_float(a.y & 0xffff0000u) + rc.w1 * __uint_as_float(bb.y & 0xffff0000u);
                v[i * 4] += g4.x * f0; v[i * 4 + 1] += g4.y * f1; v[i * 4 + 2] += g4.z * f2; v[i * 4 + 3] += g4.w * f3;
                if (mode == 0) *(float4*)(xr + c) = make_float4(v[i * 4], v[i * 4 + 1], v[i * 4 + 2], v[i * 4 + 3]);
            }
        }
        float ss = 0.f;
#pragma unroll
        for (int i = 0; i < 16; ++i) ss += v[i] * v[i];
        ss = wave_sum(ss);
        const float rstd = rsqrtf(ss * (1.f / 1024.f) + EPSV);
        if (mode == 1) {
            float* o = p.out + ((size_t)b * SEQL + (t - CTXL)) * DM;
#pragma unroll
            for (int i = 0; i < 4; ++i) {
                const int c = i * 256 + lane * 4;
                float4 g4 = *(const float4*)(g1 + c);
                float4 r4;
                r4.x = v[i * 4] * rstd * g4.x; r4.y = v[i * 4 + 1] * rstd * g4.y; r4.z = v[i * 4 + 2] * rstd * g4.z; r4.w = v[i * 4 + 3] * rstd * g4.w;
                *(float4*)(o + c) = r4;
            }
        } else {
            const float* md = WSF(OFF_MOD) + (size_t)(l * 9 + bi) * 6144 + (mode == 2 ? 3 * 1024 : 0);
            bf16_t* ho = HB + (size_t)row * DM;
#pragma unroll
            for (int i = 0; i < 4; ++i) {
                const int c = i * 256 + lane * 4;
                float4 g4 = *(const float4*)(g1 + c);
                float4 sh = *(const float4*)(md + c);
                float4 sc = *(const float4*)(md + 1024 + c);
                float h0 = v[i * 4] * rstd * g4.x * (1.f + sc.x) + sh.x;
                float h1 = v[i * 4 + 1] * rstd * g4.y * (1.f + sc.y) + sh.y;
                float h2 = v[i * 4 + 2] * rstd * g4.z * (1.f + sc.z) + sh.z;
                float h3 = v[i * 4 + 3] * rstd * g4.w * (1.f + sc.w) + sh.w;
                uint2 o2;
                o2.x = (unsigned)f2bf(h0) | ((unsigned)f2bf(h1) << 16);
                o2.y = (unsigned)f2bf(h2) | ((unsigned)f2bf(h3) << 16);
                *(uint2*)(ho + c) = o2;
            }
        }
    }
}

DEVI void phase_win(const Params& p, int l, unsigned char* smem) {
    bf16_t* ct = (bf16_t*)smem;
    const float* cs64 = WSF(OFF_R64);
    const float* cs32 = WSF(OFF_R32);
    const GrpInfo gi = grp_info(p);
    for (int it = 0;; ++it) {
        int mt, nt;
        if (!super_tile(gi, it, 144, 30, 12, 5, mt, nt)) break;
        if (mt < 0) continue;
        const int row0 = mt * 128, b = mt / 18, t0 = (mt % 18) * 128;
        const bool lat = (mt % 18) >= 2;
        const int pos0 = t0 - CTXL;
        f32x4 acc[4][4];
        acc_zero<128>(acc);
        AOp A{HB, 1024, row0, nullptr};
        T_BEGIN(3);
        gemm_core<128>(acc, A, WB(W_IN + (size_t)l * 3840 * 1024 + (size_t)nt * 128 * 1024), 1024, 1024, smem);
        __syncthreads();
        T_END(3, l == 0 && BIDX == 8);
        T_BEGIN(4);
        acc_to_ct<128>(acc, ct);
        __syncthreads();
        if (nt < 2) ep_store_rows<128>(ct, 0, CB(C_CQ) + nt * 128, 256, row0);
        else if (nt == 2) ep_store_rows<128>(ct, 0, CB(C_CKV), 128, row0);
        else if (nt < 5) { ep_rope64(ct, nullptr, 1.f, lat, pos0, cs64); __syncthreads(); ep_store_rows<128>(ct, 0, CB(C_RQ) + (nt - 3) * 128, 256, row0); }
        else if (nt < 7) {
            ep_rope64(ct, nullptr, 0.125f, lat, pos0, cs64); __syncthreads();
            ep_store_rows<128>(ct, 0, CB(C_RK) + (nt - 5) * 128, 256, row0);
            ep_store_T(ct, 0, 128, CB(C_RKT) + ((size_t)b * 256 + (nt - 5) * 128) * TPB, TPB, t0);
        }
        else if (nt < 11) ep_store_T(ct, 0, 128, CB(C_RVT) + ((size_t)b * 4 + (nt - 7)) * 128 * TPB, TPB, t0);
        else if (nt < 15) ep_store_rows<128>(ct, 0, CB(C_RG) + (nt - 11) * 128, 512, row0);
        else if (nt < 19) ep_store_rows<128>(ct, 0, CB(C_LX) + (nt - 15) * 128, 512, row0);
        else if (nt < 23) ep_store_rows<128>(ct, 0, CB(C_LG) + (nt - 19) * 128, 512, row0);
        else if (nt < 27) { ep_rope64(ct, p.in[I_GQN] + l * 64, 0.125f * LOG2E, lat, pos0, cs64); __syncthreads(); ep_store_rows<128>(ct, 0, CB(C_GQ) + (nt - 23) * 128, 512, row0); }
        else if (nt == 27) { ep_rope64(ct, p.in[I_GKN] + l * 64, 1.f, lat, pos0, cs64); __syncthreads(); ep_store_rows<128>(ct, 0, CB(C_GK), 128, row0); }
        else if (nt == 28) ep_store_T(ct, 0, 128, CB(C_GVT) + (size_t)b * 128 * TPB, TPB, t0);
        else { ep_rope32(ct, 1, nullptr, 1.f, lat, pos0, cs32); __syncthreads(); ep_store_rows<32>(ct, 0, CB(C_KR), 32, row0); }
        __syncthreads();
        T_END(4, l == 0 && BIDX == 8);
    }
}

DEVI float ret_lg2(const Params& p, int l, int dir, int h) { return -log1pf(expf(-p.in[I_RDEC][l * 8 + dir * 4 + h])) * LOG2E; }
DEVI void ret_chunk_U(const Params& p, int l, int task) {
    const int b = task / 72, r = task % 72, h = r / 18, m = r % 18;
    const int tid = TIDX, lane = tid & 63, w = tid >> 6, qc = lane & 31, hh = lane >> 5;
    const int t0 = m * 128;
    const bf16_t* KTg = CB(C_RKT) + ((size_t)b * 4 + h) * 64 * TPB + t0 + 8 * hh;
    const bf16_t* VTg = CB(C_RVT) + (((size_t)b * 4 + h) * 128 + w * 32 + qc) * TPB + t0 + 8 * hh;
    bf16x8 vf[8], ka[2][8];
#pragma unroll
    for (int ks = 0; ks < 8; ++ks) vf[ks] = *(const bf16x8*)(VTg + ks * 16);
#pragma unroll
    for (int sub = 0; sub < 2; ++sub)
#pragma unroll
        for (int ks = 0; ks < 8; ++ks) ka[sub][ks] = *(const bf16x8*)(KTg + (size_t)(32 * sub + qc) * TPB + ks * 16);
#pragma unroll
    for (int dir = 0; dir < 2; ++dir) {
        const float lg2 = ret_lg2(p, l, dir, h);
        f32x16 U0, U1;
#pragma unroll
        for (int rr = 0; rr < 16; ++rr) { U0[rr] = 0.f; U1[rr] = 0.f; }
#pragma unroll
        for (int ks = 0; ks < 8; ++ks) {
            bf16x8 vs;
#pragma unroll
            for (int e = 0; e < 8; ++e) {
                const int j = 16 * ks + 8 * hh + e;
                const float kd = __builtin_amdgcn_exp2f(lg2 * (float)(dir == 0 ? 127 - j : j));
                vs[e] = (short)f2bf(bf2f((bf16_t)vf[ks][e]) * kd);
            }
            U0 = __builtin_amdgcn_mfma_f32_32x32x16_bf16(ka[0][ks], vs, U0, 0, 0, 0);
            U1 = __builtin_amdgcn_mfma_f32_32x32x16_bf16(ka[1][ks], vs, U1, 0, 0, 0);
        }
        bf16_t* up = DB(D_OB) + ((((size_t)(b * 4 + h) * 18 + m) * 2 + dir) * 128) * 64 + (size_t)(32 * w + qc) * 8 + 4 * hh;
#pragma unroll
        for (int g = 0; g < 4; ++g) {
            bf16x4 a, c;
#pragma unroll
            for (int e = 0; e < 4; ++e) { a[e] = (short)f2bf(U0[4 * g + e]); c[e] = (short)f2bf(U1[4 * g + e]); }
            *(bf16x4*)(up + (((g >> 1) * 2 + (g & 1)) * 128) * 8) = a;
            *(bf16x4*)(up + (((2 + (g >> 1)) * 2 + (g & 1)) * 128) * 8) = c;
        }
    }
}
DEVI void ret_out_task(const Params& p, int l, int b, int h, int m, unsigned char* smem) {
    constexpr int PLD = 136;
    bf16_t* P = (bf16_t*)smem;
    float* red = (float*)(smem + 34816);
    const int tid = TIDX, lane = tid & 63, w = tid >> 6, qc = lane & 31, hh = lane >> 5;
    const int t0 = m * 128, iq = 32 * w + qc;
    const float lgf = ret_lg2(p, l, 0, h), lgb = ret_lg2(p, l, 1, h);
    const float cdf = exp2f(lgf * 128.f), cdb = exp2f(lgb * 128.f);
    bf16x8 sff[4], sfb[4];
    {
        float Sf[4][8], Sb[4][8];
#pragma unroll
        for (int ks = 0; ks < 4; ++ks)
#pragma unroll
            for (int e = 0; e < 8; ++e) { Sf[ks][e] = 0.f; Sb[ks][e] = 0.f; }
        const bf16_t* Ub = DB(D_OB) + (size_t)(b * 4 + h) * 18 * 2 * 128 * 64 + (size_t)(hh * 128 + 32 * w + qc) * 8;
        const int pos = m < 2 ? 1 - m : 19 - m;
        const int nf4 = (m + 3) & ~3, nb4 = (pos + 3) & ~3;
        for (int c0 = 0; c0 < nf4; c0 += 4) {
            bf16x8 u[4][4]; float wg[4];
#pragma unroll
            for (int q = 0; q < 4; ++q) {
                const int c = c0 + q, cl = c < m ? c : 0;
                wg[q] = c < m ? __builtin_amdgcn_exp2f(lgf * 128.f * (float)(m - 1 - c)) : 0.f;
                const bf16_t* up = Ub + (size_t)(cl * 2 + 0) * 128 * 64;
#pragma unroll
                for (int ks = 0; ks < 4; ++ks) u[q][ks] = *(const bf16x8*)(up + ks * 2048);
            }
#pragma unroll
            for (int q = 0; q < 4; ++q)
#pragma unroll
                for (int ks = 0; ks < 4; ++ks)
#pragma unroll
                    for (int e = 0; e < 8; ++e) Sf[ks][e] += wg[q] * bf2f((bf16_t)u[q][ks][e]);
        }
        for (int c0 = 0; c0 < nb4; c0 += 4) {
            bf16x8 u[4][4]; float wg[4];
#pragma unroll
            for (int q = 0; q < 4; ++q) {
                const int cc = c0 + q, ccl = cc < pos ? cc : 0;
                const int c = ccl < 2 ? 1 - ccl : 19 - ccl;
                wg[q] = cc < pos ? __builtin_amdgcn_exp2f(lgb * 128.f * (float)(pos - 1 - cc)) : 0.f;
                const bf16_t* up = Ub + (size_t)(c * 2 + 1) * 128 * 64;
#pragma unroll
                for (int ks = 0; ks < 4; ++ks) u[q][ks] = *(const bf16x8*)(up + ks * 2048);
            }
#pragma unroll
            for (int q = 0; q < 4; ++q)
#pragma unroll
                for (int ks = 0; ks < 4; ++ks)
#pragma unroll
                    for (int e = 0; e < 8; ++e) Sb[ks][e] += wg[q] * bf2f((bf16_t)u[q][ks][e]);
        }
#pragma unroll
        for (int ks = 0; ks < 4; ++ks)
#pragma unroll
            for (int e = 0; e < 8; ++e) { sff[ks][e] = (short)f2bf(Sf[ks][e]); sfb[ks][e] = (short)f2bf(Sb[ks][e]); }
    }
    const bf16_t* Kg = CB(C_RK) + ((size_t)b * TPB + t0) * 256 + h * 64 + 8 * hh;
    const bf16_t* Qg = CB(C_RQ) + ((size_t)b * TPB + t0) * 256 + h * 64 + 8 * hh;
    const bf16_t* VTg = CB(C_RVT) + (((size_t)b * 4 + h) * 128 + w * 32 + qc) * TPB + t0 + 8 * hh;
    bf16x8 vf[8];
#pragma unroll
    for (int ks = 0; ks < 8; ++ks) vf[ks] = *(const bf16x8*)(VTg + ks * 16);
    {
        bf16x8 qf[4], ka[4][4];
#pragma unroll
        for (int ks = 0; ks < 4; ++ks) qf[ks] = *(const bf16x8*)(Qg + (size_t)iq * 256 + ks * 16);
#pragma unroll
        for (int js = 0; js < 4; ++js)
#pragma unroll
            for (int ks = 0; ks < 4; ++ks) ka[js][ks] = *(const bf16x8*)(Kg + (size_t)(32 * js + qc) * 256 + ks * 16);
        __syncthreads();
#pragma unroll
        for (int js = 0; js < 4; ++js) {
            f32x16 sc;
#pragma unroll
            for (int r = 0; r < 16; ++r) sc[r] = 0.f;
#pragma unroll
            for (int ks = 0; ks < 4; ++ks) sc = __builtin_amdgcn_mfma_f32_32x32x16_bf16(ka[js][ks], qf[ks], sc, 0, 0, 0);
#pragma unroll
            for (int g = 0; g < 4; ++g) {
                bf16x4 pk;
#pragma unroll
                for (int e = 0; e < 4; ++e) {
                    const int d = iq - (32 * js + 8 * g + 4 * hh + e);
                    const float wgt = d >= 0 ? __builtin_amdgcn_exp2f(lgf * (float)d) : __builtin_amdgcn_exp2f(lgb * (float)(-d));
                    pk[e] = (short)f2bf(sc[4 * g + e] * wgt);
                }
                *(bf16x4*)(P + iq * PLD + 32 * js + 8 * g + 4 * hh) = pk;
            }
        }
    }
    bf16x8 qa[4];
#pragma unroll
    for (int ks = 0; ks < 4; ++ks) qa[ks] = *(const bf16x8*)(Qg + (size_t)qc * 256 + ks * 16);
    __syncthreads();
    f32x16 o[4];
#pragma unroll
    for (int isub = 0; isub < 4; ++isub) {
        const int ii = 32 * isub + qc;
        bf16x8 qn[4];
        if (isub < 3) {
#pragma unroll
            for (int ks = 0; ks < 4; ++ks) qn[ks] = *(const bf16x8*)(Qg + (size_t)(ii + 32) * 256 + ks * 16);
        }
#pragma unroll
        for (int r = 0; r < 16; ++r) o[isub][r] = 0.f;
#pragma unroll
        for (int ks = 0; ks < 4; ++ks) o[isub] = __builtin_amdgcn_mfma_f32_32x32x16_bf16(sff[ks], qa[ks], o[isub], 0, 0, 0);
        const float qdf = __builtin_amdgcn_exp2f(lgf * (float)(ii + 1)), qdb = __builtin_amdgcn_exp2f(lgb * (float)(128 - ii));
        const float rat = qdf / qdb;
#pragma unroll
        for (int r = 0; r < 16; ++r) o[isub][r] *= rat;
#pragma unroll
        for (int ks = 0; ks < 4; ++ks) o[isub] = __builtin_amdgcn_mfma_f32_32x32x16_bf16(sfb[ks], qa[ks], o[isub], 0, 0, 0);
#pragma unroll
        for (int r = 0; r < 16; ++r) o[isub][r] *= qdb;
#pragma unroll
        for (int ks = 0; ks < 8; ++ks) {
            bf16x8 pf = *(const bf16x8*)(P + ii * PLD + 16 * ks + 8 * hh);
            o[isub] = __builtin_amdgcn_mfma_f32_32x32x16_bf16(vf[ks], pf, o[isub], 0, 0, 0);
        }
        float s1 = 0.f, s2 = 0.f;
#pragma unroll
        for (int r = 0; r < 16; ++r) { s1 += o[isub][r]; s2 += o[isub][r] * o[isub][r]; }
        s1 += __shfl_xor(s1, 32); s2 += __shfl_xor(s2, 32);
        if (hh == 0) { red[(w * 128 + ii) * 2] = s1; red[(w * 128 + ii) * 2 + 1] = s2; }
        if (isub < 3) {
#pragma unroll
            for (int ks = 0; ks < 4; ++ks) qa[ks] = qn[ks];
        }
    }
    __syncthreads();
    const float* gn = p.in[I_RNORM] + l * 512 + h * 128 + 32 * w + 4 * hh;
    float gnv[16];
#pragma unroll
    for (int g = 0; g < 4; ++g)
#pragma unroll
        for (int e = 0; e < 4; ++e) gnv[4 * g + e] = gn[8 * g + e];
#pragma unroll
    for (int isub = 0; isub < 4; ++isub) {
        const int ii = 32 * isub + qc;
        float t1 = 0.f, t2 = 0.f;
#pragma unroll
        for (int ww = 0; ww < 4; ++ww) { t1 += red[(ww * 128 + ii) * 2]; t2 += red[(ww * 128 + ii) * 2 + 1]; }
        const float mu = t1 * (1.f / 128.f);
        const float rs = rsqrtf(fmaxf(t2 * (1.f / 128.f) - mu * mu, 0.f) + EPSV);
#pragma unroll
        for (int g = 0; g < 4; ++g) {
            bf16x4 ov;
#pragma unroll
            for (int e = 0; e < 4; ++e) ov[e] = (short)f2bf((o[isub][4 * g + e] - mu) * rs * gnv[4 * g + e]);
            *(bf16x4*)(P + ii * PLD + 32 * w + 8 * g + 4 * hh) = ov;
        }
    }
    __syncthreads();
#pragma unroll
    for (int k = 0; k < 8; ++k) {
        const int c = tid + 256 * k, row = c >> 4, ch = c & 15;
        const size_t ro = ((size_t)b * TPB + t0 + row) * 512 + h * 128 + ch * 8;
        const bf16x8 nv = *(const bf16x8*)(P + row * PLD + ch * 8);
        const bf16x8 gt = *(const bf16x8*)(CB(C_RG) + ro);
        bf16x8 ov;
#pragma unroll
        for (int e = 0; e < 8; ++e) ov[e] = (short)f2bf(siluf_(bf2f((bf16_t)gt[e])) * bf2f((bf16_t)nv[e]));
        *(bf16x8*)(DB(D_OF) + ro) = ov;
    }
}

DEVI void phase_mla_up(const Params& p, int l, unsigned char* smem) {
    bf16_t* ct = (bf16_t*)smem;
    float* rstd = (float*)(smem + AUX_OFF);
    const float* cs32 = WSF(OFF_R32);
    const float qscale = 0.10206207261596575f * LOG2E;
    const int nq = (l == 0 ? 144 : 128) * 6;
    const int nkv = 144 * 8;
    for (int tile = BIDX; tile < nq + nkv + 576; tile += gridDim.x) {
        if (tile >= nq + nkv) { ret_chunk_U(p, l, tile - nq - nkv); continue; }
        if (tile < nq) {
            const int mt = mt_of(tile / 6, l != 0), nt = tile % 6;
            const int row0 = mt * 128, t0 = (mt % 18) * 128;
            const bool lat = (mt % 18) >= 2;
            f32x4 acc[4][4];
            acc_zero<128>(acc);
            AOp A{CB(C_CQ), 256, row0, nullptr};
            gemm_core<128>(acc, A, WB(W_UQ + (size_t)l * 768 * 256 + (size_t)nt * 128 * 256), 256, 256, smem);
            __syncthreads();
            acc_to_ct<128>(acc, ct);
            ep_rstd(CB(C_CQ), 256, row0, 256, rstd);
            __syncthreads();
            if (nt < 4) {
                ep_scale_rows(ct, 0, 128, rstd, qscale); __syncthreads();
                ep_store_rows<64>(ct, 0, CB(C_MQ) + (nt * 2) * 96, 768, row0);
                ep_store_rows<64>(ct, 64, CB(C_MQ) + (nt * 2 + 1) * 96, 768, row0);
            } else {
                ep_rope32(ct, 4, rstd, qscale, lat, t0 - CTXL, cs32); __syncthreads();
#pragma unroll
                for (int g = 0; g < 4; ++g) ep_store_rows<32>(ct, g * 32, CB(C_MQ) + ((nt - 4) * 4 + g) * 96 + 64, 768, row0);
            }
            __syncthreads();
        } else {
            const int tk = tile - nq;
            const int mt = tk / 8, nt = tk % 8;
            const int row0 = mt * 128, b = mt / 18, t0 = (mt % 18) * 128;
            f32x4 acc[4][4];
            acc_zero<128>(acc);
            AOp A{CB(C_CKV), 128, row0, nullptr};
            gemm_core<128>(acc, A, WB(W_UKV + (size_t)l * 1024 * 128 + (size_t)nt * 128 * 128), 128, 128, smem);
            __syncthreads();
            acc_to_ct<128>(acc, ct);
            ep_rstd(CB(C_CKV), 128, row0, 128, rstd);
            __syncthreads();
            ep_scale_rows(ct, 0, 128, rstd, 1.f); __syncthreads();
            ep_store_rows<64>(ct, 0, CB(C_KN) + nt * 64, 512, row0);
            ep_store_T(ct, 64, 64, CB(C_VMT) + ((size_t)b * 8 + nt) * 64 * TPB, TPB, t0);
            __syncthreads();
        }
    }
}

template <int DK, bool MLA>
DEVI void attn_naive_wave(const Params& p, int b, int t0, int hq) {
    const int lane = TIDX & 63;
    const int t = t0 + lane, row = b * TPB + t;
    const int nkeys = (t0 < CTXL) ? CTXL : TPB;
    float q[DK];
    const bf16_t* qp = MLA ? CB(C_MQ) + (size_t)row * 768 + hq * 96 : CB(C_GQ) + (size_t)row * 512 + hq * 64;
#pragma unroll
    for (int c = 0; c < DK / 8; ++c) {
        bf16x8 tq = *(const bf16x8*)(qp + c * 8);
#pragma unroll
        for (int e = 0; e < 8; ++e) q[c * 8 + e] = bf2f((bf16_t)tq[e]);
    }
    float acc[64];
#pragma unroll
    for (int d = 0; d < 64; ++d) acc[d] = 0.f;
    float m = -1e30f, lsum = 0.f;
    const int hk = MLA ? hq : (hq >> 2);
    const bf16_t* vT = MLA ? CB(C_VMT) + ((size_t)b * 8 + hk) * 64 * TPB : CB(C_GVT) + ((size_t)b * 2 + hk) * 64 * TPB;
    for (int kt = 0; kt < nkeys; ++kt) {
        const size_t krow = (size_t)b * TPB + kt;
        float s = 0.f;
        const bf16_t* kp = MLA ? CB(C_KN) + krow * 512 + hk * 64 : CB(C_GK) + krow * 128 + hk * 64;
#pragma unroll
        for (int c = 0; c < 8; ++c) {
            bf16x8 tk = *(const bf16x8*)(kp + c * 8);
#pragma unroll
            for (int e = 0; e < 8; ++e) s += q[c * 8 + e] * bf2f((bf16_t)tk[e]);
        }
        if (MLA) {
            const bf16_t* rp = CB(C_KR) + krow * 32;
#pragma unroll
            for (int c = 0; c < 4; ++c) {
                bf16x8 tk = *(const bf16x8*)(rp + c * 8);
#pragma unroll
                for (int e = 0; e < 8; ++e) s += q[(DK - 32) + c * 8 + e] * bf2f((bf16_t)tk[e]);
            }
        }
        const float mn = fmaxf(m, s);
        const float alpha = exp2f(m - mn), pp = exp2f(s - mn);
        lsum = lsum * alpha + pp;
#pragma unroll
        for (int d = 0; d < 64; ++d) acc[d] = acc[d] * alpha + pp * bf2f(vT[(size_t)d * TPB + kt]);
        m = mn;
    }
    const float inv = 1.f / lsum;
    bf16_t* op = (MLA ? DB(D_YA) : DB(D_YD)) + (size_t)row * 512 + hq * 64;
#pragma unroll
    for (int c = 0; c < 8; ++c) {
        bf16x8 o;
#pragma unroll
        for (int e = 0; e < 8; ++e) o[e] = (short)f2bf(acc[c * 8 + e] * inv);
        *(bf16x8*)(op + c * 8) = o;
    }
}


template <int DK, bool MLA>
DEVI void attn_task(const Params& p, int b, int hsel, int tq0, int nkeys, unsigned char* smem) {
    constexpr int KLD = DK + 8;
    constexpr int CK = DK / 8;
    constexpr int NKC = 64 * CK / 256;
    constexpr int VLD = 68;
    constexpr int KBYTES = 64 * KLD * 2, VBYTES = 64 * VLD * 2;
    constexpr int VOFF = 2 * KBYTES;
    static_assert(2 * (KBYTES + VBYTES) <= 60000, "attn lds");
    const int tid = TIDX, lane = tid & 63, w = tid >> 6, qc = lane & 31, hh = lane >> 5;
    const int tq = MLA ? tq0 + w * 32 + qc : tq0 + qc;
    const int hq = MLA ? hsel : hsel * 4 + w;
    const size_t qrow = (size_t)b * TPB + tq;
    const bf16_t* qp = MLA ? CB(C_MQ) + qrow * 768 + hq * 96 : CB(C_GQ) + qrow * 512 + hq * 64;
    bf16x8 qf[DK / 16];
#pragma unroll
    for (int ks = 0; ks < DK / 16; ++ks) qf[ks] = *(const bf16x8*)(qp + ks * 16 + hh * 8);
    const bf16_t* ksrc[NKC]; int kstep[NKC], kdst[NKC];
#pragma unroll
    for (int i = 0; i < NKC; ++i) {
        const int q = tid + 256 * i, key = q / CK, ch = q % CK;
        if (MLA) {
            if (ch < 8) { ksrc[i] = CB(C_KN) + ((size_t)b * TPB + key) * 512 + hsel * 64 + ch * 8; kstep[i] = 64 * 512; }
            else { ksrc[i] = CB(C_KR) + ((size_t)b * TPB + key) * 32 + (ch - 8) * 8; kstep[i] = 64 * 32; }
        } else { ksrc[i] = CB(C_GK) + ((size_t)b * TPB + key) * 128 + hsel * 64 + ch * 8; kstep[i] = 64 * 128; }
        kdst[i] = (key * KLD + ch * 8) * 2;
    }
    const bf16_t* vT = MLA ? CB(C_VMT) + ((size_t)b * 8 + hsel) * 64 * TPB : CB(C_GVT) + ((size_t)b * 2 + hsel) * 64 * TPB;
    const bf16_t* vsrc[2]; int vdst[2];
#pragma unroll
    for (int i = 0; i < 2; ++i) {
        const int q = tid + 256 * i, dv = q >> 3, ch = q & 7;
        vsrc[i] = vT + (size_t)dv * TPB + ch * 8;
        vdst[i] = VOFF + (dv * VLD + ch * 8) * 2;
    }
    const int nt = nkeys >> 6;
    bf16x8 kr[NKC], vr[2];
#pragma unroll
    for (int i = 0; i < NKC; ++i) kr[i] = *(const bf16x8*)(ksrc[i]);
#pragma unroll
    for (int i = 0; i < 2; ++i) vr[i] = *(const bf16x8*)(vsrc[i]);
    __syncthreads();
#pragma unroll
    for (int i = 0; i < NKC; ++i) *(bf16x8*)(smem + kdst[i]) = kr[i];
#pragma unroll
    for (int i = 0; i < 2; ++i) {
        *(bf16x4*)(smem + vdst[i]) = bf16x4{vr[i][0], vr[i][1], vr[i][2], vr[i][3]};
        *(bf16x4*)(smem + vdst[i] + 8) = bf16x4{vr[i][4], vr[i][5], vr[i][6], vr[i][7]};
    }
#pragma unroll
    for (int i = 0; i < NKC; ++i) kr[i] = *(const bf16x8*)(ksrc[i] + (size_t)kstep[i]);
    __syncthreads();
    f32x16 s0, s1;
#pragma unroll
    for (int r = 0; r < 16; ++r) { s0[r] = 0.f; s1[r] = 0.f; }
#pragma unroll
    for (int ks = 0; ks < DK / 16; ++ks) {
        bf16x8 a0 = *(const bf16x8*)(smem + (qc * KLD + ks * 16 + hh * 8) * 2);
        bf16x8 a1 = *(const bf16x8*)(smem + ((32 + qc) * KLD + ks * 16 + hh * 8) * 2);
        s0 = __builtin_amdgcn_mfma_f32_32x32x16_bf16(a0, qf[ks], s0, 0, 0, 0);
        s1 = __builtin_amdgcn_mfma_f32_32x32x16_bf16(a1, qf[ks], s1, 0, 0, 0);
    }
#pragma unroll
    for (int i = 0; i < NKC; ++i) *(bf16x8*)(smem + KBYTES + kdst[i]) = kr[i];
    f32x16 o0, o1;
#pragma unroll
    for (int r = 0; r < 16; ++r) { o0[r] = 0.f; o1[r] = 0.f; }
    float m = -1e30f, lsum = 0.f;
    for (int it = 0; it < nt; ++it) {
        __syncthreads();
        if (it + 2 < nt) {
#pragma unroll
            for (int i = 0; i < NKC; ++i) kr[i] = *(const bf16x8*)(ksrc[i] + (size_t)(it + 2) * kstep[i]);
        }
        if (it + 1 < nt) {
#pragma unroll
            for (int i = 0; i < 2; ++i) vr[i] = *(const bf16x8*)(vsrc[i] + (it + 1) * 64);
        }
        f32x16 n0, n1;
#pragma unroll
        for (int r = 0; r < 16; ++r) { n0[r] = 0.f; n1[r] = 0.f; }
        if (it + 1 < nt) {
            const unsigned char* ck = smem + ((it + 1) & 1) * KBYTES;
#pragma unroll
            for (int ks = 0; ks < DK / 16; ++ks) {
                bf16x8 a0 = *(const bf16x8*)(ck + (qc * KLD + ks * 16 + hh * 8) * 2);
                bf16x8 a1 = *(const bf16x8*)(ck + ((32 + qc) * KLD + ks * 16 + hh * 8) * 2);
                n0 = __builtin_amdgcn_mfma_f32_32x32x16_bf16(a0, qf[ks], n0, 0, 0, 0);
                n1 = __builtin_amdgcn_mfma_f32_32x32x16_bf16(a1, qf[ks], n1, 0, 0, 0);
            }
        }
        float mx = s0[0];
#pragma unroll
        for (int r = 1; r < 16; ++r) mx = fmaxf(mx, s0[r]);
#pragma unroll
        for (int r = 0; r < 16; ++r) mx = fmaxf(mx, s1[r]);
        mx = fmaxf(mx, __shfl_xor(mx, 32));
        if (!__all(mx <= m + 6.f)) {
            const float mn = fmaxf(m, mx);
            const float alpha = __builtin_amdgcn_exp2f(m - mn);
            m = mn;
            lsum *= alpha;
#pragma unroll
            for (int r = 0; r < 16; ++r) { o0[r] *= alpha; o1[r] *= alpha; }
        }
        float ps = 0.f;
#pragma unroll
        for (int r = 0; r < 16; ++r) { s0[r] = __builtin_amdgcn_exp2f(s0[r] - m); ps += s0[r]; }
#pragma unroll
        for (int r = 0; r < 16; ++r) { s1[r] = __builtin_amdgcn_exp2f(s1[r] - m); ps += s1[r]; }
        lsum += ps;
        bf16x8 pf[2][2];
#pragma unroll
        for (int s = 0; s < 2; ++s)
#pragma unroll
            for (int j = 0; j < 8; ++j) { pf[0][s][j] = (short)f2bf(s0[8 * s + j]); pf[1][s][j] = (short)f2bf(s1[8 * s + j]); }
        const unsigned char* cv = smem + VOFF + (it & 1) * VBYTES;
#pragma unroll
        for (int a = 0; a < 2; ++a)
#pragma unroll
            for (int s = 0; s < 2; ++s) {
                const int keyoff = a * 32 + 16 * s + 4 * hh;
                bf16x4 l0 = *(const bf16x4*)(cv + (qc * VLD + keyoff) * 2);
                bf16x4 h0 = *(const bf16x4*)(cv + (qc * VLD + keyoff + 8) * 2);
                bf16x4 l1 = *(const bf16x4*)(cv + ((32 + qc) * VLD + keyoff) * 2);
                bf16x4 h1 = *(const bf16x4*)(cv + ((32 + qc) * VLD + keyoff + 8) * 2);
                bf16x8 v0 = bf16x8{l0[0], l0[1], l0[2], l0[3], h0[0], h0[1], h0[2], h0[3]};
                bf16x8 v1 = bf16x8{l1[0], l1[1], l1[2], l1[3], h1[0], h1[1], h1[2], h1[3]};
                o0 = __builtin_amdgcn_mfma_f32_32x32x16_bf16(v0, pf[a][s], o0, 0, 0, 0);
                o1 = __builtin_amdgcn_mfma_f32_32x32x16_bf16(v1, pf[a][s], o1, 0, 0, 0);
            }
        if (it + 2 < nt) {
            unsigned char* nk = smem + (it & 1) * KBYTES;
#pragma unroll
            for (int i = 0; i < NKC; ++i) *(bf16x8*)(nk + kdst[i]) = kr[i];
        }
        if (it + 1 < nt) {
            unsigned char* nv = smem + ((it + 1) & 1) * VBYTES;
#pragma unroll
            for (int i = 0; i < 2; ++i) {
                *(bf16x4*)(nv + vdst[i]) = bf16x4{vr[i][0], vr[i][1], vr[i][2], vr[i][3]};
                *(bf16x4*)(nv + vdst[i] + 8) = bf16x4{vr[i][4], vr[i][5], vr[i][6], vr[i][7]};
            }
        }
        s0 = n0; s1 = n1;
    }
    lsum += __shfl_xor(lsum, 32);
    const float inv = 1.f / lsum;
    bf16_t* op = (MLA ? DB(D_YA) : DB(D_YD)) + qrow * 512 + hq * 64;
#pragma unroll
    for (int g = 0; g < 4; ++g) {
        bf16x4 a, c;
#pragma unroll
        for (int e = 0; e < 4; ++e) { a[e] = (short)f2bf(o0[g * 4 + e] * inv); c[e] = (short)f2bf(o1[g * 4 + e] * inv); }
        *(bf16x4*)(op + 8 * g + 4 * hh) = a;
        *(bf16x4*)(op + 32 + 8 * g + 4 * hh) = c;
    }
}

DEVI int proc_tok(int dir, int pidx) { return dir == 0 ? pidx : (pidx < CTXL ? CTXL - 1 - pidx : (CTXL + TPB - 1) - pidx); }

DEVI void retention_naive(const Params& p, int l, int task) {
    const int b = task >> 2, h = task & 3;
    const int dir = TIDX >> 7, dv = TIDX & 127;
    const float dec = p.in[I_RDEC][l * 8 + dir * 4 + h];
    const float lg = -log1pf(expf(-dec));
    const float g = expf(lg);
    float S[64];
#pragma unroll
    for (int d = 0; d < 64; ++d) S[d] = 0.f;
    const bf16_t* vT = CB(C_RVT) + (((size_t)b * 4 + h) * 128 + dv) * TPB;
    bf16_t* outp = (dir == 0 ? DB(D_OF) : DB(D_OB));
    for (int pi = 0; pi < TPB; ++pi) {
        const int u = proc_tok(dir, pi);
        const size_t row = (size_t)b * TPB + u;
        const bf16_t* qp = CB(C_RQ) + row * 256 + h * 64;
        const bf16_t* kp = CB(C_RK) + row * 256 + h * 64;
        const float v = bf2f(vT[u]);
        float o = 0.f;
#pragma unroll
        for (int c = 0; c < 8; ++c) {
            bf16x8 tq = *(const bf16x8*)(qp + c * 8);
            bf16x8 tk = *(const bf16x8*)(kp + c * 8);
#pragma unroll
            for (int e = 0; e < 8; ++e) {
                const int d = c * 8 + e;
                const float qd = bf2f((bf16_t)tq[e]), kd = bf2f((bf16_t)tk[e]);
                if (dir == 0) { S[d] = g * S[d] + kd * v; o += qd * S[d]; }
                else { S[d] = g * S[d]; o += qd * S[d]; S[d] += kd * v; }
            }
        }
        outp[row * 512 + h * 128 + dv] = f2bf(o);
    }
}

DEVI void lru_naive_wave(const Params& p, int l, int task) {
    const int lane = TIDX & 63;
    const int b = task >> 4, d = (task >> 3) & 1, blk = task & 7;
    const int ch = blk * 64 + lane;
    float cw[4];
#pragma unroll
    for (int j = 0; j < 4; ++j) cw[j] = p.in[I_LCW][(l * 4 + j) * 512 + ch];
    const float cb = p.in[I_LCB][l * 512 + ch];
    const float ba = p.in[I_LBA][(l * 2 + d) * 512 + ch], bx = p.in[I_LBX][(l * 2 + d) * 512 + ch];
    const float lam = p.in[I_LLAM][(l * 2 + d) * 512 + ch];
    const float sp = log1pf(expf(-lam));
    const float* Wa = p.in[I_LWA] + ((size_t)(l * 2 + d) * 8 + blk) * 4096;
    const float* Wx = p.in[I_LWX] + ((size_t)(l * 2 + d) * 8 + blk) * 4096;
    float h = 0.f;
    bf16_t* outp = (d == 0 ? DB(D_LH0) : DB(D_LH1));
    for (int pi = 0; pi < TPB; ++pi) {
        const int u = proc_tok(d, pi);
        const int lo = u < CTXL ? 0 : CTXL, hi = u < CTXL ? CTXL : TPB;
        const size_t row = (size_t)b * TPB + u;
        float uval = cb;
#pragma unroll
        for (int j = 0; j < 4; ++j) {
            const int tt = u - 2 + j;
            if (tt >= lo && tt < hi) uval += cw[j] * bf2f(CB(C_LX)[((size_t)b * TPB + tt) * 512 + ch]);
        }
        float rp = 0.f, ip = 0.f;
        for (int c = 0; c < 64; ++c) {
            const float uc = __shfl(uval, c);
            rp += uc * Wa[c * 64 + lane];
            ip += uc * Wx[c * 64 + lane];
        }
        const float r = sigmoidf_(rp + ba), ig = sigmoidf_(ip + bx);
        const float la = -8.f * r * sp;
        const float a = expf(la);
        const float bb = sqrtf(-expm1f(2.f * la)) * (ig * uval);
        h = a * h + bb;
        outp[row * 512 + ch] = f2bf(h);
    }
}


DEVI void retention_walk(const Params& p, int l, int task, unsigned char* smem) {
    constexpr int PLD = 136;
    const int b = task >> 3, h = (task >> 1) & 3, dir = task & 1;
    const int tid = TIDX, lane = tid & 63, w = tid >> 6, qc = lane & 31, hh = lane >> 5;
    const float dec = p.in[I_RDEC][l * 8 + dir * 4 + h];
    const float lg2 = -log1pf(expf(-dec)) * LOG2E;
    const float cdec = exp2f(lg2 * 128.f);
    bf16_t* P = (bf16_t*)smem;
    f32x16 S0, S1;
#pragma unroll
    for (int r = 0; r < 16; ++r) { S0[r] = 0.f; S1[r] = 0.f; }
    const bf16_t* Kg = CB(C_RK) + (size_t)b * TPB * 256 + h * 64;
    const bf16_t* Qg = CB(C_RQ) + (size_t)b * TPB * 256 + h * 64;
    const bf16_t* KTg = CB(C_RKT) + ((size_t)b * 4 + h) * 64 * TPB;
    const bf16_t* VTg = CB(C_RVT) + (((size_t)b * 4 + h) * 128 + w * 32 + qc) * TPB;
    bf16_t* outp = (dir == 0 ? DB(D_OF) : DB(D_OB)) + (size_t)b * TPB * 512 + h * 128 + w * 32;
    const int iq = 32 * w + qc;
    for (int cc = 0; cc < 18; ++cc) {
        const int mch = dir == 0 ? cc : (cc < 2 ? 1 - cc : 19 - cc);
        const int t0 = mch * 128;
        bf16x8 vf[8];
#pragma unroll
        for (int ks = 0; ks < 8; ++ks) vf[ks] = *(const bf16x8*)(VTg + t0 + ks * 16 + hh * 8);
        bf16x8 qf[4];
        {
            const bf16_t* qrow = Qg + (size_t)(t0 + iq) * 256;
#pragma unroll
            for (int ks = 0; ks < 4; ++ks) qf[ks] = *(const bf16x8*)(qrow + ks * 16 + hh * 8);
        }
        __syncthreads();
#pragma unroll 1
        for (int js = 0; js < 4; ++js) {
            f32x16 sc;
#pragma unroll
            for (int r = 0; r < 16; ++r) sc[r] = 0.f;
            const bf16_t* krow = Kg + (size_t)(t0 + 32 * js + qc) * 256;
#pragma unroll
            for (int ks = 0; ks < 4; ++ks) {
                bf16x8 a = *(const bf16x8*)(krow + ks * 16 + hh * 8);
                sc = __builtin_amdgcn_mfma_f32_32x32x16_bf16(a, qf[ks], sc, 0, 0, 0);
            }
#pragma unroll
            for (int g = 0; g < 4; ++g) {
                bf16x4 pk;
#pragma unroll
                for (int e = 0; e < 4; ++e) {
                    const int j = 32 * js + 8 * g + 4 * hh + e;
                    const int d = iq - j;
                    float wgt;
                    if (dir == 0) wgt = d >= 0 ? __builtin_amdgcn_exp2f(lg2 * (float)d) : 0.f;
                    else wgt = d < 0 ? __builtin_amdgcn_exp2f(lg2 * (float)(-d)) : 0.f;
                    pk[e] = (short)f2bf(sc[4 * g + e] * wgt);
                }
                *(bf16x4*)(P + iq * PLD + 32 * js + 8 * g + 4 * hh) = pk;
            }
        }
        __syncthreads();
        bf16x8 sf[2][2];
#pragma unroll
        for (int s = 0; s < 2; ++s)
#pragma unroll
            for (int j = 0; j < 8; ++j) { sf[0][s][j] = (short)f2bf(S0[8 * s + j]); sf[1][s][j] = (short)f2bf(S1[8 * s + j]); }
#pragma unroll 1
        for (int isub = 0; isub < 4; ++isub) {
            const int ii = 32 * isub + qc;
            const bf16_t* qr = Qg + (size_t)(t0 + ii) * 256;
            f32x16 o;
#pragma unroll
            for (int r = 0; r < 16; ++r) o[r] = 0.f;
#pragma unroll
            for (int sub = 0; sub < 2; ++sub)
#pragma unroll
                for (int s = 0; s < 2; ++s) {
                    const int dk0 = 32 * sub + 16 * s + 4 * hh;
                    bf16x4 lo = *(const bf16x4*)(qr + dk0), hi = *(const bf16x4*)(qr + dk0 + 8);
                    bf16x8 bq = bf16x8{lo[0], lo[1], lo[2], lo[3], hi[0], hi[1], hi[2], hi[3]};
                    o = __builtin_amdgcn_mfma_f32_32x32x16_bf16(sf[sub][s], bq, o, 0, 0, 0);
                }
            const float qd = dir == 0 ? __builtin_amdgcn_exp2f(lg2 * (float)(ii + 1)) : __builtin_amdgcn_exp2f(lg2 * (float)(128 - ii));
#pragma unroll
            for (int r = 0; r < 16; ++r) o[r] *= qd;
#pragma unroll
            for (int ks = 0; ks < 8; ++ks) {
                bf16x8 pf = *(const bf16x8*)(P + ii * PLD + 16 * ks + 8 * hh);
                o = __builtin_amdgcn_mfma_f32_32x32x16_bf16(vf[ks], pf, o, 0, 0, 0);
            }
            bf16_t* orow = outp + (size_t)(t0 + ii) * 512;
#pragma unroll
            for (int g = 0; g < 4; ++g) {
                bf16x4 pk;
#pragma unroll
                for (int e = 0; e < 4; ++e) pk[e] = (short)f2bf(o[4 * g + e]);
                *(bf16x4*)(orow + 8 * g + 4 * hh) = pk;
            }
        }
#pragma unroll
        for (int r = 0; r < 16; ++r) { S0[r] *= cdec; S1[r] *= cdec; }
#pragma unroll
        for (int ks = 0; ks < 8; ++ks) {
            bf16x8 vs;
#pragma unroll
            for (int e = 0; e < 8; ++e) {
                const int j = 16 * ks + 8 * hh + e;
                const float kd = dir == 0 ? __builtin_amdgcn_exp2f(lg2 * (float)(127 - j)) : __builtin_amdgcn_exp2f(lg2 * (float)j);
                vs[e] = (short)f2bf(bf2f((bf16_t)vf[ks][e]) * kd);
            }
            bf16x8 a0 = *(const bf16x8*)(KTg + (size_t)qc * TPB + t0 + 16 * ks + 8 * hh);
            bf16x8 a1 = *(const bf16x8*)(KTg + (size_t)(32 + qc) * TPB + t0 + 16 * ks + 8 * hh);
            S0 = __builtin_amdgcn_mfma_f32_32x32x16_bf16(a0, vs, S0, 0, 0, 0);
            S1 = __builtin_amdgcn_mfma_f32_32x32x16_bf16(a1, vs, S1, 0, 0, 0);
        }
    }
    __syncthreads();
}

DEVI float fsig(float x) { return __builtin_amdgcn_rcpf(1.f + __expf(-x)); }
DEVI void lru_walk(const Params& p, int l, int task, unsigned char* smem) {
    const int b = task >> 4, d = (task >> 3) & 1, blk = task & 7;
    const int tid = TIDX, lane = tid & 63, w = tid >> 6, ln = lane & 15, g = lane >> 4;
    bf16_t* Wt = (bf16_t*)smem;
    float* uw = (float*)(smem + 18432 + w * 4224);
    float* cpar = (float*)(smem + 35328);
    float* agg = (float*)(smem + 36608);
    __syncthreads();
    {
        const bf16_t* wsrc = WB(W_LRU + ((size_t)(l * 2 + d) * 8 + blk) * 8192);
        for (int c = tid; c < 128 * 8; c += 256) {
            const int n = c >> 3, kc = c & 7;
            *(bf16x8*)(Wt + n * 72 + kc * 8) = *(const bf16x8*)(wsrc + n * 64 + kc * 8);
        }
        if (tid < 64) {
            const int ch = blk * 64 + tid;
#pragma unroll
            for (int j = 0; j < 4; ++j) cpar[j * 64 + tid] = p.in[I_LCW][(l * 4 + j) * 512 + ch];
            cpar[256 + tid] = p.in[I_LCB][l * 512 + ch];
        }
    }
    __syncthreads();
    float ba[4], bx[4], sp[4], hc[4];
#pragma unroll
    for (int ct = 0; ct < 4; ++ct) {
        const int ch = blk * 64 + 16 * ct + ln;
        ba[ct] = p.in[I_LBA][(l * 2 + d) * 512 + ch];
        bx[ct] = p.in[I_LBX][(l * 2 + d) * 512 + ch];
        sp[ct] = log1pf(expf(-p.in[I_LLAM][(l * 2 + d) * 512 + ch]));
        hc[ct] = 0.f;
    }
    const bf16_t* X = CB(C_LX) + (size_t)b * TPB * 512 + blk * 64;
    bf16_t* outp = (d == 0 ? DB(D_LH0) : DB(D_LH1)) + (size_t)b * TPB * 512 + blk * 64;
    bf16x8 xr[2][4];
    float xm[4];
    {
        const int tok = proc_tok(d, 16 * w + ln);
        const int lo = tok < CTXL ? 0 : CTXL, hi = tok < CTXL ? CTXL : TPB;
#pragma unroll
        for (int ks = 0; ks < 2; ++ks)
#pragma unroll
            for (int j = 0; j < 4; ++j) {
                const int tt = tok - 2 + j;
                const int tc = tt < lo ? lo : (tt >= hi ? hi - 1 : tt);
                xr[ks][j] = *(const bf16x8*)(X + (size_t)tc * 512 + 32 * ks + 8 * g);
                xm[j] = (tt >= lo && tt < hi) ? 1.f : 0.f;
            }
    }
    for (int c = 0; c < 36; ++c) {
        bf16x8 af[2];
#pragma unroll
        for (int ks = 0; ks < 2; ++ks) {
            const int c0 = 32 * ks + 8 * g;
            float u8[8];
#pragma unroll
            for (int e = 0; e < 8; ++e) u8[e] = cpar[256 + c0 + e];
#pragma unroll
            for (int j = 0; j < 4; ++j)
#pragma unroll
                for (int e = 0; e < 8; ++e) u8[e] += (cpar[j * 64 + c0 + e] * xm[j]) * bf2f((bf16_t)xr[ks][j][e]);
#pragma unroll
            for (int e = 0; e < 8; ++e) { uw[ln * 65 + c0 + e] = u8[e]; af[ks][e] = (short)f2bf(u8[e]); }
        }
        if (c + 1 < 36) {
            const int tok = proc_tok(d, 64 * (c + 1) + 16 * w + ln);
            const int lo = tok < CTXL ? 0 : CTXL, hi = tok < CTXL ? CTXL : TPB;
#pragma unroll
            for (int ks = 0; ks < 2; ++ks)
#pragma unroll
                for (int j = 0; j < 4; ++j) {
                    const int tt = tok - 2 + j;
                    const int tc = tt < lo ? lo : (tt >= hi ? hi - 1 : tt);
                    xr[ks][j] = *(const bf16x8*)(X + (size_t)tc * 512 + 32 * ks + 8 * g);
                    xm[j] = (tt >= lo && tt < hi) ? 1.f : 0.f;
                }
        }
        __builtin_amdgcn_wave_barrier();
        f32x4 acc[8];
#pragma unroll
        for (int nt = 0; nt < 8; ++nt) acc[nt] = f32x4{0.f, 0.f, 0.f, 0.f};
#pragma unroll
        for (int ks = 0; ks < 2; ++ks)
#pragma unroll
            for (int nt = 0; nt < 8; ++nt) {
                bf16x8 bfr = *(const bf16x8*)(Wt + (16 * nt + ln) * 72 + 32 * ks + 8 * g);
                acc[nt] = __builtin_amdgcn_mfma_f32_16x16x32_bf16(af[ks], bfr, acc[nt], 0, 0, 0);
            }
        float A[4][4], B[4][4];
#pragma unroll
        for (int ct = 0; ct < 4; ++ct) {
            float pa = 1.f, pb = 0.f;
#pragma unroll
            for (int j = 0; j < 4; ++j) {
                const float r = fsig(acc[ct][j] + ba[ct]);
                const float ig = fsig(acc[4 + ct][j] + bx[ct]);
                const float la = -8.f * r * sp[ct];
                const float a = __expf(la);
                const float uu = uw[(4 * g + j) * 65 + 16 * ct + ln];
                const float bb = __builtin_amdgcn_sqrtf(fmaxf(1.f - a * a, 0.f)) * ig * uu;
                pb = a * pb + bb; pa = a * pa;
                A[ct][j] = pa; B[ct][j] = pb;
            }
            float ia = pa, ib = pb;
#pragma unroll
            for (int dd = 1; dd <= 2; dd <<= 1) {
                const float qa = __shfl_up(ia, 16 * dd), qb = __shfl_up(ib, 16 * dd);
                if (g >= dd) { ib = ia * qb + ib; ia = ia * qa; }
            }
            float ea = __shfl_up(ia, 16), eb = __shfl_up(ib, 16);
            if (g == 0) { ea = 1.f; eb = 0.f; }
#pragma unroll
            for (int j = 0; j < 4; ++j) { B[ct][j] = A[ct][j] * eb + B[ct][j]; A[ct][j] = A[ct][j] * ea; }
            if (g == 3) {
                float* ag = agg + (((c & 1) * 4 + w) * 64 + 16 * ct + ln) * 2;
                ag[0] = ia; ag[1] = ib;
            }
        }
        __syncthreads();
#pragma unroll
        for (int ct = 0; ct < 4; ++ct) {
            float hrun = hc[ct], hin = 0.f;
#pragma unroll
            for (int w2 = 0; w2 < 4; ++w2) {
                const float* ag = agg + (((c & 1) * 4 + w2) * 64 + 16 * ct + ln) * 2;
                if (w2 == w) hin = hrun;
                hrun = ag[0] * hrun + ag[1];
            }
            hc[ct] = hrun;
#pragma unroll
            for (int j = 0; j < 4; ++j) {
                const int tok2 = proc_tok(d, 64 * c + 16 * w + 4 * g + j);
                outp[(size_t)tok2 * 512 + 16 * ct + ln] = f2bf(A[ct][j] * hin + B[ct][j]);
            }
        }
    }
    __syncthreads();
}

DEVI void phase_mix(const Params& p, int l, unsigned char* smem) {
    const int NLRU = 128, NRET = (l == 0 ? 576 : 512);
    const int NLAT = 1024, NCTX = (l == 0 ? 128 : 0);
    const int ntask = NLRU + NRET + 2 * NLAT + 2 * NCTX;
    const int ncvt = 3072;
    int cv = BIDX;
    int* ctr = WSI(OFF_CNT) + 128 + l;
    volatile int* nxt = (volatile int*)(smem + 65520);
    for (;;) {
        __syncthreads();
        if (TIDX == 0) *nxt = atomicAdd(ctr, 1);
        __syncthreads();
        const int task = *nxt;
        if (task >= ntask) break;
        if (cv < ncvt) { CvtJob j = get_moe_job(p, l, cv >> 10); cvt_tile256(j, cv & 1023, smem); cv += gridDim.x; }
        if (task < NLRU) { T_BEGIN(0); lru_walk(p, l, task, smem); T_END(0, l == 0 && task == 0); }
        else if (task < NLRU + NRET) {
            const int a = task - NLRU;
            int b, h, m;
            if (l == 0) { b = a / 72; const int r = a % 72; h = r / 18; m = r % 18; }
            else { b = a >> 6; const int r = a & 63; h = r >> 4; m = 2 + (r & 15); }
            T_BEGIN(2); ret_out_task(p, l, b, h, m, smem); T_END(2, l == 0 && a == 300);
        } else {
            int a = task - NLRU - NRET;
            int kind, b, hsel, tq0, nkeys;
            if (a < NLAT) { kind = 0; b = a >> 7; const int r = a & 127; hsel = r >> 4; tq0 = CTXL + (r & 15) * 128; nkeys = TPB; }
            else if (a < 2 * NLAT) { a -= NLAT; kind = 1; b = a >> 7; const int r = a & 127; hsel = r >> 6; tq0 = CTXL + (r & 63) * 32; nkeys = TPB; }
            else if (a < 2 * NLAT + NCTX) { a -= 2 * NLAT; kind = 0; b = a >> 4; const int r = a & 15; hsel = r >> 1; tq0 = (r & 1) * 128; nkeys = CTXL; }
            else { a -= 2 * NLAT + NCTX; kind = 1; b = a >> 4; const int r = a & 15; hsel = r >> 3; tq0 = (r & 7) * 32; nkeys = CTXL; }
            T_BEGIN(1); T_BEGIN(7);
            if (kind == 0) attn_task<96, true>(p, b, hsel, tq0, nkeys, smem);
            else attn_task<64, false>(p, b, hsel, tq0, nkeys, smem);
            T_END(1, l == 0 && task == NLRU + NRET + 500);
            T_END(7, l == 0 && task == NLRU + NRET + 1024 + 500);
        }
    }
    for (; cv < ncvt; cv += gridDim.x) { CvtJob j = get_moe_job(p, l, cv >> 10); cvt_tile256(j, cv & 1023, smem); }
}

DEVI void phase_fin(const Params& p, int l) {
    const int lane = TIDX & 63, w = TIDX >> 6;
    for (int row = BIDX * 4 + w; row < TT; row += gridDim.x * 4) {
        if (l == 1 && (row % TPB) < CTXL) continue;
        const size_t o = (size_t)row * 512 + lane * 8;
        bf16x8 h0 = *(const bf16x8*)(DB(D_LH0) + o), h1 = *(const bf16x8*)(DB(D_LH1) + o), lg = *(const bf16x8*)(CB(C_LG) + o);
        bf16x8 oc;
#pragma unroll
        for (int e = 0; e < 8; ++e) oc[e] = (short)f2bf((bf2f((bf16_t)h0[e]) + bf2f((bf16_t)h1[e])) * gelu_tanh(bf2f((bf16_t)lg[e])));
        *(bf16x8*)(DB(D_LH0) + o) = oc;
    }
}

DEVI void phase_merge(const Params& p, int l, unsigned char* smem) {
    bf16_t* ct = (bf16_t*)smem;
    const int lane = TIDX & 63, wc = (TIDX >> 6) & 1;
    const int nmt = (l == 0 ? 144 : 128);
    const GrpInfo gi = grp_info(p);
    for (int it = 0;; ++it) {
        int mq, nt;
        if (!super_tile(gi, it, nmt, 8, 8, 8, mq, nt)) break;
        if (mq < 0) continue;
        const int mt = mt_of(mq, l != 0);
        const int row0 = mt * 128;
        unsigned mp[4][4][2];
#pragma unroll
        for (int mi = 0; mi < 4; ++mi)
#pragma unroll
            for (int ni = 0; ni < 4; ++ni) { mp[mi][ni][0] = 0u; mp[mi][ni][1] = 0u; }
#pragma unroll 1
        for (int n = 0; n < 4; ++n) {
            unsigned gp[4][4][2];
            {
                f32x4 ag[4][4];
                acc_zero<128>(ag);
                AOp A1{HB, 1024, row0, nullptr};
                gemm_core<128>(ag, A1, WB(W_MG + (size_t)l * 4096 * 1024 + (size_t)(n * 1024 + nt * 128) * 1024), 1024, 1024, smem);
                const float* bm = p.in[I_BMG] + l * 4096 + n * 1024 + nt * 128 + wc * 64 + (lane & 15);
#pragma unroll
                for (int ni = 0; ni < 4; ++ni) {
                    const float bias = bm[ni * 16];
#pragma unroll
                    for (int mi = 0; mi < 4; ++mi) {
                        gp[mi][ni][0] = (unsigned)f2bf(sigmoidf_(ag[mi][ni][0] + bias)) | ((unsigned)f2bf(sigmoidf_(ag[mi][ni][1] + bias)) << 16);
                        gp[mi][ni][1] = (unsigned)f2bf(sigmoidf_(ag[mi][ni][2] + bias)) | ((unsigned)f2bf(sigmoidf_(ag[mi][ni][3] + bias)) << 16);
                    }
                }
            }
            f32x4 ap[4][4];
            acc_zero<128>(ap);
            const bf16_t* yb = n == 0 ? DB(D_YA) : (n == 1 ? DB(D_OF) : (n == 2 ? DB(D_LH0) : DB(D_YD)));
            AOp A2{yb, 512, row0, nullptr};
            gemm_core<128>(ap, A2, WB(W_BR + ((size_t)l * 4 + n) * 1024 * 512 + (size_t)(nt * 128) * 512), 512, 512, smem);
#pragma unroll
            for (int mi = 0; mi < 4; ++mi)
#pragma unroll
                for (int ni = 0; ni < 4; ++ni) {
                    const float m0 = __uint_as_float(mp[mi][ni][0] << 16) + __uint_as_float(gp[mi][ni][0] << 16) * ap[mi][ni][0];
                    const float m1 = __uint_as_float(mp[mi][ni][0] & 0xffff0000u) + __uint_as_float(gp[mi][ni][0] & 0xffff0000u) * ap[mi][ni][1];
                    const float m2 = __uint_as_float(mp[mi][ni][1] << 16) + __uint_as_float(gp[mi][ni][1] << 16) * ap[mi][ni][2];
                    const float m3 = __uint_as_float(mp[mi][ni][1] & 0xffff0000u) + __uint_as_float(gp[mi][ni][1] & 0xffff0000u) * ap[mi][ni][3];
                    mp[mi][ni][0] = (unsigned)f2bf(m0) | ((unsigned)f2bf(m1) << 16);
                    mp[mi][ni][1] = (unsigned)f2bf(m2) | ((unsigned)f2bf(m3) << 16);
                }
        }
        __syncthreads();
        {
            const int wid = TIDX >> 6, wr = wid >> 1;
#pragma unroll
            for (int mi = 0; mi < 4; ++mi)
#pragma unroll
                for (int ni = 0; ni < 4; ++ni) {
                    bf16_t* cp = ct + (wr * 64 + mi * 16 + (lane >> 4) * 4) * CT_LD + wc * 64 + ni * 16 + (lane & 15);
                    cp[0] = (bf16_t)(mp[mi][ni][0] & 0xffffu); cp[CT_LD] = (bf16_t)(mp[mi][ni][0] >> 16);
                    cp[2 * CT_LD] = (bf16_t)(mp[mi][ni][1] & 0xffffu); cp[3 * CT_LD] = (bf16_t)(mp[mi][ni][1] >> 16);
                }
        }
        __syncthreads();
        ep_store_rows<128>(ct, 0, CB(C_M) + nt * 128, 1024, row0);
        __syncthreads();
    }
}

DEVI void phase_wout(const Params& p, int l, unsigned char* smem) {
    bf16_t* ct = (bf16_t*)smem;
    const int nmt = (l == 0 ? 144 : 128);
    const GrpInfo gi = grp_info(p);
    for (int it = 0;; ++it) {
        int mq, nt;
        if (!super_tile(gi, it, nmt, 8, 8, 8, mq, nt)) break;
        if (mq < 0) continue;
        {
            const int mt = mt_of(mq, l != 0);
            const int row0 = mt * 128, b = mt / 18, t0 = (mt % 18) * 128;
            const bool isctx = (mt % 18) < 2;
            const int bi = isctx ? 8 : b;
            f32x4 acc[4][4];
            acc_zero<128>(acc);
            AOp A{CB(C_M), 1024, row0, nullptr};
            gemm_core<128>(acc, A, WB(W_OUT + (size_t)l * 1024 * 1024 + (size_t)nt * 128 * 1024), 1024, 1024, smem);
            __syncthreads();
            acc_to_ct<128>(acc, ct);
            __syncthreads();
            const float* gate = WSF(OFF_MOD) + (size_t)(l * 9 + bi) * 6144 + 2 * 1024 + nt * 128;
            for (int c = TIDX; c < 128 * 32; c += 256) {
                const int i = c >> 5, jc = c & 31;
                const int t = t0 + i;
                const float* xs;
                if (l == 0) xs = isctx ? p.in[I_CTX] + ((size_t)b * CTXL + t) * DM : p.in[I_X] + ((size_t)b * SEQL + (t - CTXL)) * DM;
                else xs = XCUR + (size_t)(row0 + i) * DM;
                float4 x4 = *(const float4*)(xs + nt * 128 + jc * 4);
                float4 g4 = *(const float4*)(gate + jc * 4);
                uint2 y = *(const uint2*)(ct + i * CT_LD + jc * 4);
                x4.x += g4.x * __uint_as_float(y.x << 16);
                x4.y += g4.y * __uint_as_float(y.x & 0xffff0000u);
                x4.z += g4.z * __uint_as_float(y.y << 16);
                x4.w += g4.w * __uint_as_float(y.y & 0xffff0000u);
                *(float4*)(XCUR + (size_t)(row0 + i) * DM + nt * 128 + jc * 4) = x4;
            }
            __syncthreads();
        }
    }
}

DEVI void phase_route(const Params& p, int l, unsigned char* smem) {
    const int tid = TIDX, lane = tid & 63, w = tid >> 6, wr = w >> 1, wc = w & 1;
    float* lgt = (float*)smem;
    const float rbias = p.in[I_RB][lane];
    int* cnt = WSI(OFF_CNT) + l * 64;
    int* list = WSI(OFF_LIST);
    const int ntile = l == 0 ? 144 : 128;
    for (int q = BIDX; q < ntile; q += gridDim.x) {
        const int mt = mt_of(q, l != 0);
        const int row0 = mt * 128;
        f32x4 acc[4][2];
        acc_zero<64>(acc);
        AOp A{HB, 1024, row0, nullptr};
        gemm_core<64>(acc, A, WB(W_RT), 1024, 1024, smem);
        __syncthreads();
#pragma unroll
        for (int mi = 0; mi < 4; ++mi)
#pragma unroll
            for (int ni = 0; ni < 2; ++ni)
#pragma unroll
                for (int j = 0; j < 4; ++j)
                    lgt[(wr * 64 + mi * 16 + (lane >> 4) * 4 + j) * 68 + wc * 32 + ni * 16 + (lane & 15)] = acc[mi][ni][j];
        __syncthreads();
        for (int i = 0; i < 32; ++i) {
            const int row = row0 + w * 32 + i;
            const float lg = lgt[(w * 32 + i) * 68 + lane];
            const float score = sigmoidf_(lg);
            const float biased = score + rbias;
            float v1 = biased; int i1 = lane;
#pragma unroll
            for (int off = 1; off < 8; off <<= 1) {
                float ov = __shfl_xor(v1, off); int oi = __shfl_xor(i1, off);
                if (ov > v1 || (ov == v1 && oi < i1)) { v1 = ov; i1 = oi; }
            }
            float v2 = (lane == i1) ? -3.0e38f : biased; int i2 = lane;
#pragma unroll
            for (int off = 1; off < 8; off <<= 1) {
                float ov = __shfl_xor(v2, off); int oi = __shfl_xor(i2, off);
                if (ov > v2 || (ov == v2 && oi < i2)) { v2 = ov; i2 = oi; }
            }
            float gv = v1 + v2; int gi = lane >> 3;
#pragma unroll
            for (int off = 8; off < 64; off <<= 1) {
                float ov = __shfl_xor(gv, off); int oi = __shfl_xor(gi, off);
                if (ov > gv || (ov == gv && oi < gi)) { gv = ov; gi = oi; }
            }
            const int e0 = __shfl(i1, gi * 8), e1 = __shfl(i2, gi * 8);
            const float s0 = __shfl(score, e0), s1 = __shfl(score, e1);
            if (lane == 0) {
                Rec rc;
                rc.e0 = e0; rc.e1 = e1;
                rc.p0 = atomicAdd(&cnt[e0], 1);
                rc.p1 = atomicAdd(&cnt[e1], 1);
                const float inv = 1.f / (s0 + s1);
                rc.w0 = s0 * inv; rc.w1 = s1 * inv; rc.pad0 = 0; rc.pad1 = 0;
                list[(size_t)e0 * TT + rc.p0] = row;
                list[(size_t)e1 * TT + rc.p1] = row;
                ((Rec*)(p.ws + OFF_REC))[row] = rc;
            }
        }
        __syncthreads();
    }
}

struct MoeGrp { int ne[8], sg[8], cn[8]; };
DEVI MoeGrp moe_grp(const MoeTab& mt, const GrpInfo& gi) {
    MoeGrp g;
#pragma unroll
    for (int q = 0; q < 8; ++q) {
        const int ee = gi.ngrp == 8 ? gi.xcd * 8 + q : 0;
        g.cn[q] = mt.cnt(ee); g.sg[q] = mt.seg(ee); g.ne[q] = (g.cn[q] + 127) >> 7;
    }
    return g;
}
DEVI bool moe_tile(const MoeTab& mt, const MoeGrp& mg, const GrpInfo& gi, int it, int NT, int& e, int& jt, int& nt, int& cn, int& sg) {
    int rem = gi.j + gi.per * it;
    if (gi.ngrp == 8) {
#pragma unroll
        for (int q = 0; q < 8; ++q) {
            const int ne = mg.ne[q] * NT;
            if (rem < ne) { e = gi.xcd * 8 + q; jt = rem / NT; nt = rem % NT; cn = mg.cn[q]; sg = mg.sg[q]; return true; }
            rem -= ne;
        }
        return false;
    }
    for (int ee = 0; ee < 64; ++ee) {
        const int c = mt.cnt(ee);
        const int ne = ((c + 127) >> 7) * NT;
        if (rem < ne) { e = ee; jt = rem / NT; nt = rem % NT; cn = c; sg = mt.seg(ee); return true; }
        rem -= ne;
    }
    return false;
}
DEVI void phase_moe1(const Params& p, int l, unsigned char* smem) {
    bf16_t* ct = (bf16_t*)smem;
    int* ridx = (int*)(smem + AUX_OFF);
    MoeTab mt = moe_tables(p, l, smem);
    const GrpInfo gi = grp_info(p);
    const MoeGrp mg = moe_grp(mt, gi);
    const int* list = WSI(OFF_LIST);
    for (int it = 0;; ++it) {
        int e, jt, nt, cn, sg;
        if (!moe_tile(mt, mg, gi, it, 4, e, jt, nt, cn, sg)) break;
        if (TIDX < 128) {
            const int idx = jt * 128 + TIDX;
            ridx[TIDX] = list[(size_t)e * TT + (idx < cn ? idx : 0)];
        }
        __syncthreads();
        f32x4 acc[4][4];
        acc_zero<128>(acc);
        AOp A{HB, 1024, 0, ridx};
        gemm_core<128, true>(acc, A, MWB(MW_13) + ((size_t)e * 512 + nt * 128) * 1024, 1024, 1024, smem);
        __syncthreads();
        acc_to_ct<128>(acc, ct);
        __syncthreads();
        const int slot0 = sg + jt * 128;
        for (int c = TIDX; c < 128 * 8; c += 256) {
            const int i = c >> 3, jc = c & 7;
            bf16x8 a = *(const bf16x8*)(ct + i * CT_LD + jc * 8), g = *(const bf16x8*)(ct + i * CT_LD + 64 + jc * 8), o;
#pragma unroll
            for (int q = 0; q < 8; ++q) o[q] = (short)f2bf(siluf_(bf2f((bf16_t)a[q])) * bf2f((bf16_t)g[q]));
            *(bf16x8*)(DB(D_ACT) + (size_t)(slot0 + i) * 256 + nt * 64 + jc * 8) = o;
        }
        __syncthreads();
    }
}
DEVI void phase_moe2(const Params& p, int l, unsigned char* smem) {
    bf16_t* ct = (bf16_t*)smem;
    MoeTab mt = moe_tables(p, l, smem);
    const GrpInfo gi = grp_info(p);
    const MoeGrp mg = moe_grp(mt, gi);
    for (int it = 0;; ++it) {
        int e, jt, nt, cn, sg;
        if (!moe_tile(mt, mg, gi, it, 8, e, jt, nt, cn, sg)) break;
        const int slot0 = sg + jt * 128;
        f32x4 acc[4][4];
        acc_zero<128>(acc);
        AOp A{DB(D_ACT), 256, slot0, nullptr};
        gemm_core<128>(acc, A, MWB(MW_2) + ((size_t)e * 1024 + nt * 128) * 256, 256, 256, smem);
        __syncthreads();
        acc_to_ct<128>(acc, ct);
        __syncthreads();
        ep_store_rows<128>(ct, 0, DB(D_YS) + nt * 128, 1024, slot0);
        __syncthreads();
    }
}

#define XB_TMO      128
#define XB_XCNT(j)  (256  + 64 * (j))
#define XB_XSUB(j)  (1280 + 64 * (j))
#define XB_XGEN(j)  (2304 + 64 * (j))
#define XB_TOP      3328
#define XB_TOPGEN   3392
#define XB_SPIN_CAP (1u << 22)
DEVI unsigned xb_ld(unsigned* p) { return __hip_atomic_load(p, __ATOMIC_RELAXED, __HIP_MEMORY_SCOPE_AGENT); }
DEVI unsigned xb_add(unsigned* p, unsigned v) { return __hip_atomic_fetch_add(p, v, __ATOMIC_RELAXED, __HIP_MEMORY_SCOPE_AGENT); }
DEVI unsigned xb_xcc_id() { return (unsigned)__builtin_amdgcn_s_getreg((3 << 11) | 20) & 0xFu; }
#define XB_SPIN(cond, bar) do { unsigned _sp = 0; while (cond) { __builtin_amdgcn_s_sleep(1); \
    if ((++_sp & 255u) == 0u) { if (xb_ld(&(bar)[XB_TMO])) break; if (_sp > XB_SPIN_CAP) { atomicAdd(&(bar)[XB_TMO], 1u); break; } } } } while (0)
struct XcdBarrier { unsigned* bar; unsigned x; unsigned* st; };
DEVI XcdBarrier xcd_barrier_post(unsigned* bar, unsigned* st) {
    XcdBarrier b; b.bar = bar; b.x = xb_xcc_id(); b.st = st;
    if (__builtin_amdgcn_workitem_id_x() == 0) (void)xb_add(&bar[XB_XCNT(b.x)], 1u);
    return b;
}
DEVI void xcd_barrier_complete(unsigned* bar, unsigned x, unsigned& nloc, unsigned& nx) {
    const unsigned G = gridDim.x * gridDim.y * gridDim.z;
    unsigned sum, cnt, mine, sp = 0u;
    for (;;) {
        sum = 0u; cnt = 0u; mine = 0u;
#pragma unroll
        for (unsigned j = 0; j < 16; ++j) { const unsigned c = xb_ld(&bar[XB_XCNT(j)]); sum += c; cnt += (c > 0u) ? 1u : 0u; mine = (j == x) ? c : mine; }
        if (sum == G) break;
        __builtin_amdgcn_s_sleep(1);
        if ((++sp & 255u) == 0u) { if (xb_ld(&bar[XB_TMO])) break; if (sp > XB_SPIN_CAP) { atomicAdd(&bar[XB_TMO], 1u); break; } }
    }
    nloc = mine > 0u ? mine : 1u; nx = cnt > 0u ? cnt : 1u;
}
DEVI void xcd_barrier(const XcdBarrier& b) {
    asm volatile("s_waitcnt vmcnt(0)" ::: "memory");
    __syncthreads();
    if (__builtin_amdgcn_workitem_id_x() == 0) {
        unsigned* bar = b.bar;
        __builtin_amdgcn_s_waitcnt(0);
        unsigned nloc = xb_ld(&b.st[0]), nx = xb_ld(&b.st[1]);
        if (nloc == 0u) { xcd_barrier_complete(bar, b.x, nloc, nx); __hip_atomic_store(&b.st[0], nloc, __ATOMIC_RELAXED, __HIP_MEMORY_SCOPE_AGENT); __hip_atomic_store(&b.st[1], nx, __ATOMIC_RELAXED, __HIP_MEMORY_SCOPE_AGENT); }
        const unsigned old = xb_add(&bar[XB_XSUB(b.x)], 1u);
        const unsigned gen = old / nloc;
        if (old + 1u == (gen + 1u) * nloc) {
            __builtin_amdgcn_fence(__ATOMIC_RELEASE, "agent");
            asm volatile("s_waitcnt vmcnt(0)" ::: "memory");
            const unsigned og = xb_add(&bar[XB_TOP], 1u);
            const unsigned tg = og / nx;
            if (og + 1u == (tg + 1u) * nx) xb_add(&bar[XB_TOPGEN], 1u);
            else XB_SPIN(xb_ld(&bar[XB_TOPGEN]) == tg, bar);
            __builtin_amdgcn_fence(__ATOMIC_ACQUIRE, "agent");
            xb_add(&bar[XB_XGEN(b.x)], 1u);
            asm volatile("s_waitcnt vmcnt(0)" ::: "memory");
        } else {
            XB_SPIN(xb_ld(&bar[XB_XGEN(b.x)]) == gen, bar);
            __builtin_amdgcn_fence(__ATOMIC_ACQUIRE, "agent");
            asm volatile("s_waitcnt vmcnt(0)" ::: "memory");
        }
    }
    __syncthreads();
}

constexpr int NPHASE = 24;
DEVI void run_phase(const Params& p, int ph, unsigned char* smem) {
#ifndef ONLYK
    if (ph == 0) { phase0(p, smem); return; }
    if (ph == 23) { phase_norm1(p, 1, 1, smem); return; }
#endif
    const int l = (ph - 1) / 11, k = (ph - 1) % 11;
#ifdef ONLYK
    if (k != ONLYK) return;
#endif
    switch (k) {
    case 0: phase_norm1(p, l, 0, smem); break;
    case 1: phase_win(p, l, smem); break;
    case 2: phase_mla_up(p, l, smem); break;
    case 3: phase_mix(p, l, smem); break;
    case 4: phase_fin(p, l); break;
    case 5: phase_merge(p, l, smem); break;
    case 6: phase_wout(p, l, smem); break;
    case 7: phase_norm1(p, l, 2, smem); break;
    case 8: phase_route(p, l, smem); break;
    case 9: phase_moe1(p, l, smem); break;
    default: phase_moe2(p, l, smem); break;
    }
}

__global__ void __launch_bounds__(256, 2) k_main(Params p, int ph_lo, int ph_hi) {
    __shared__ __attribute__((aligned(16))) unsigned char smem[SMEM_BYTES];
    unsigned* xb_priv = (unsigned*)(p.ws + OFF_PRIV + (size_t)__builtin_amdgcn_workgroup_id_x() * 1024 + 896);
    if (__builtin_amdgcn_workitem_id_x() == 0) { __hip_atomic_store(xb_priv, 0u, __ATOMIC_RELAXED, __HIP_MEMORY_SCOPE_AGENT); __hip_atomic_store(xb_priv + 1, 0u, __ATOMIC_RELAXED, __HIP_MEMORY_SCOPE_AGENT); }
    XcdBarrier xb = xcd_barrier_post((unsigned*)(p.ws + OFF_BAR), xb_priv);
    if (__builtin_amdgcn_workitem_id_x() == 0) {
        const unsigned rk = xb_add((unsigned*)(p.ws + OFF_BAR) + 3456 + xb.x, 1u);
        __hip_atomic_store(xb_priv + 2, xb.x, __ATOMIC_RELAXED, __HIP_MEMORY_SCOPE_AGENT);
        __hip_atomic_store(xb_priv + 3, rk, __ATOMIC_RELAXED, __HIP_MEMORY_SCOPE_AGENT);
    }
    for (int ph = ph_lo; ph < ph_hi; ++ph) {
        run_phase(p, ph, smem);
#ifdef DUPK
        if (ph >= 1 && ph <= 22 && ((ph - 1) % 11) == DUPK) run_phase(p, ph, smem);
        if (DUPK == 10 && ph == 0) run_phase(p, ph, smem);
#endif
        if (ph + 1 < ph_hi) {
            if (ph == ph_lo) cg::this_grid().sync();
            else xcd_barrier(xb);
        }
    }
#ifdef TPROBE
    if (__builtin_amdgcn_workgroup_id_x() == 0 && __builtin_amdgcn_workitem_id_x() == 0) {
        const unsigned long long dt = __hip_atomic_load(T_SLOT(TPROBE), __ATOMIC_RELAXED, __HIP_MEMORY_SCOPE_AGENT) * TMULT;
        const unsigned long long t0 = __builtin_amdgcn_s_memrealtime();
        while (__builtin_amdgcn_s_memrealtime() - t0 < dt) __builtin_amdgcn_s_sleep(8);
    }
#endif
}

extern "C" void kernel_launch(void* const* d_in, const int* in_sizes, int n_in, void* d_out, int out_size, void* d_ws, size_t ws_size,
                              hipStream_t stream) {
    if (ws_size < WS_NEED || n_in < N_IN) { fprintf(stderr, "workspace too small: %zu < %zu\n", ws_size, (size_t)WS_NEED); return; }
    Params p{};
    for (int i = 0; i < N_IN; ++i) p.in[i] = (const float*)d_in[i];
    p.out = (float*)d_out;
    p.ws = (unsigned char*)d_ws;
    static int grid_blocks = 0;
    if (!grid_blocks) {
        int dev = 0, cus = 0, per_cu = 0;
        hipGetDevice(&dev);
        hipDeviceGetAttribute(&cus, hipDeviceAttributeMultiprocessorCount, dev);
        hipOccupancyMaxActiveBlocksPerMultiprocessor(&per_cu, k_main, 256, DYN_LDS);
        if (per_cu > 2) per_cu = 2;
        if (per_cu < 1) per_cu = 1;
        grid_blocks = cus * per_cu;
    }
    hipMemsetAsync(p.ws + OFF_BAR, 0, 16384, stream);
#if ONE_LAUNCH
    int lo = 0, hi = NPHASE;
    void* args[] = {&p, &lo, &hi};
    hipError_t e = hipLaunchCooperativeKernel((void*)k_main, dim3(grid_blocks), dim3(256), args, DYN_LDS, stream);
    if (e != hipSuccess) fprintf(stderr, "cooperative launch failed: %s (grid %d)\n", hipGetErrorString(e), grid_blocks);
#else
    for (int ph = 0; ph < NPHASE; ++ph) hipLaunchKernelGGL(k_main, dim3(grid_blocks), dim3(256), DYN_LDS, stream, p, ph, ph + 1);
#endif
}
```

```cpp
#include <hip/hip_runtime.h>
#include <hip/hip_cooperative_groups.h>
#include <stdint.h>
#include <stdio.h>
namespace cg = cooperative_groups;

#define DEVI __device__ __forceinline__
#define LAS __attribute__((address_space(3)))
typedef unsigned short bf16_t;
typedef __attribute__((ext_vector_type(8))) short bf16x8;
typedef __attribute__((ext_vector_type(4))) float f32x4;
typedef __attribute__((ext_vector_type(16))) float f32x16;
typedef __attribute__((ext_vector_type(4))) short bf16x4;

#ifndef NAIVE_GEMM
#define NAIVE_GEMM 0
#endif
#ifndef ONE_LAUNCH
#define ONE_LAUNCH 1
#endif

constexpr int DM = 1024, NBT = 8, SEQL = 2048, CTXL = 256, TPB = 2304, TT = 18432;
constexpr int DINP = 3840;
constexpr float LOG2E = 1.4426950408889634f;
constexpr float EPSV = 1e-6f;
constexpr int NSLOT = 2 * TT + 64 * 128;

enum { I_X = 0, I_C, I_CTX, I_CCTX, I_ADAW, I_ADAB, I_N1G, I_N2G, I_WIN, I_MQN, I_MKVN, I_WUQ, I_WUKV, I_RDEC, I_RNORM,
       I_LCW, I_LCB, I_LWA, I_LBA, I_LWX, I_LBX, I_LLAM, I_GQN, I_GKN, I_WBR, I_WMG, I_BMG, I_WOUT, I_RW, I_RB,
       I_W1, I_W3, I_W2, I_FN, N_IN };

constexpr size_t AL(size_t x) { return (x + 255) & ~(size_t)255; }
constexpr size_t OFF_BAR = 0;
constexpr size_t OFF_CNT = 16384;
constexpr size_t OFF_MOD = OFF_CNT + 16384;
constexpr size_t OFF_R64 = AL(OFF_MOD + (size_t)2 * 9 * 6144 * 4);
constexpr size_t OFF_R32 = OFF_R64 + (size_t)2048 * 64 * 4;
constexpr size_t OFF_REC = OFF_R32 + (size_t)2048 * 32 * 4;
constexpr size_t OFF_LIST = OFF_REC + (size_t)TT * 32;
constexpr size_t OFF_PRIV = AL(OFF_LIST + (size_t)64 * TT * 4);
constexpr size_t OFF_W = OFF_PRIV + (size_t)2048 * 1024;
constexpr size_t W_IN = 0;
constexpr size_t W_UQ = W_IN + (size_t)2 * 3840 * 1024;
constexpr size_t W_UKV = W_UQ + (size_t)2 * 768 * 256;
constexpr size_t W_BR = W_UKV + (size_t)2 * 1024 * 128;
constexpr size_t W_MG = W_BR + (size_t)2 * 4 * 1024 * 512;
constexpr size_t W_OUT = W_MG + (size_t)2 * 4096 * 1024;
constexpr size_t W_LRU = W_OUT + (size_t)2 * 1024 * 1024;
constexpr size_t W_RT = W_LRU + (size_t)2 * 2 * 8 * 2 * 64 * 64;
constexpr size_t W_END = W_RT + (size_t)64 * 1024;
constexpr size_t OFF_XCUR = AL(OFF_W + W_END * 2);
constexpr size_t OFF_H = OFF_XCUR + (size_t)TT * 1024 * 4;
constexpr size_t OFF_C = OFF_H + (size_t)TT * 1024 * 2;
constexpr size_t C_CQ = 0;
constexpr size_t C_CKV = C_CQ + (size_t)TT * 256;
constexpr size_t C_KR = C_CKV + (size_t)TT * 128;
constexpr size_t C_MQ = C_KR + (size_t)TT * 32;
constexpr size_t C_KN = C_MQ + (size_t)TT * 768;
constexpr size_t C_VMT = C_KN + (size_t)TT * 512;
constexpr size_t C_RQ = C_VMT + (size_t)TT * 512;
constexpr size_t C_RK = C_RQ + (size_t)TT * 256;
constexpr size_t C_RKT = C_RK + (size_t)TT * 256;
constexpr size_t C_RVT = C_RKT + (size_t)TT * 256;
constexpr size_t C_RG = C_RVT + (size_t)TT * 512;
constexpr size_t C_LX = C_RG + (size_t)TT * 512;
constexpr size_t C_LG = C_LX + (size_t)TT * 512;
constexpr size_t C_GQ = C_LG + (size_t)TT * 512;
constexpr size_t C_GK = C_GQ + (size_t)TT * 512;
constexpr size_t C_GVT = C_GK + (size_t)TT * 128;
constexpr size_t C_END = C_GVT + (size_t)TT * 128;
constexpr size_t C_M = 0;
constexpr size_t C_W13 = (size_t)24 * 1024 * 1024;
constexpr size_t C_W2 = C_W13 + (size_t)64 * 512 * 1024;
static_assert(C_W2 + (size_t)64 * 1024 * 256 <= C_END, "moe alias");
static_assert((size_t)TT * 1024 <= C_W13, "m alias");
constexpr size_t OFF_D = OFF_C + C_END * 2;
constexpr size_t D_YA = 0;
constexpr size_t D_YD = (size_t)TT * 512;
constexpr size_t D_OF = (size_t)2 * TT * 512;
constexpr size_t D_OB = (size_t)3 * TT * 512;
constexpr size_t D_LH0 = (size_t)4 * TT * 512;
constexpr size_t D_LH1 = (size_t)5 * TT * 512;
constexpr size_t D_ACT = 0;
constexpr size_t D_YS = (size_t)12 * 1024 * 1024;
constexpr size_t D_END = D_YS + (size_t)NSLOT * 1024;
static_assert((size_t)NSLOT * 256 <= D_YS, "act alias");
static_assert((size_t)6 * TT * 512 <= D_END, "d size");
constexpr size_t OFF_MOEW = AL(OFF_D + D_END * 2);
constexpr size_t MW_13 = 0, MW_2 = (size_t)64 * 512 * 1024, MW_END = MW_2 + (size_t)64 * 1024 * 256;
constexpr size_t WS_NEED = OFF_MOEW + MW_END * 2;

struct Params {
    const float* in[N_IN];
    float* out;
    unsigned char* ws;
};

#define WSF(off) ((float*)(p.ws + (off)))
#define WSI(off) ((int*)(p.ws + (off)))
#define WB(el) ((bf16_t*)(p.ws + OFF_W) + (el))
#define CB(el) ((bf16_t*)(p.ws + OFF_C) + (el))
#define DB(el) ((bf16_t*)(p.ws + OFF_D) + (el))
#define MWB(el) ((bf16_t*)(p.ws + OFF_MOEW) + (el))
#define HB ((bf16_t*)(p.ws + OFF_H))
#define XCUR ((float*)(p.ws + OFF_XCUR))

constexpr int SMEM_BYTES = 65536;
constexpr int DYN_LDS = 0;
constexpr int CT_LD = 136;
constexpr int AUX_OFF = 36864;

#ifdef TPROBE
#define T_SLOT(id) ((unsigned long long*)(p.ws + OFF_BAR + 14400) + (id))
#define T_BEGIN(id) const unsigned long long _tb##id = __builtin_amdgcn_s_memrealtime()
#define T_END(id, cond) do { if ((cond) && __builtin_amdgcn_workitem_id_x() == 0) atomicAdd(T_SLOT(id), __builtin_amdgcn_s_memrealtime() - _tb##id); } while (0)
#else
#define T_BEGIN(id)
#define T_END(id, cond)
#endif
DEVI int launder_tid() { int t = __builtin_amdgcn_workitem_id_x(); asm volatile("" : "+v"(t)); return t; }
DEVI int launder_bid() { int t = __builtin_amdgcn_workgroup_id_x(); asm volatile("" : "+s"(t)); return t; }
#define TIDX launder_tid()
#define BIDX launder_bid()
DEVI float bf2f(bf16_t v) { return __uint_as_float(((unsigned)v) << 16); }
DEVI bf16_t f2bf(float f) {
    __bf16 h = (__bf16)f;
    return __builtin_bit_cast(unsigned short, h);
}
DEVI float sigmoidf_(float x) { return 1.f / (1.f + __expf(-x)); }
DEVI float siluf_(float x) { return x / (1.f + __expf(-x)); }
DEVI float gelu_tanh(float x) {
    float u = 0.7978845608028654f * (x + 0.044715f * x * x * x);
    return 0.5f * x * (1.f + tanhf(u));
}
DEVI float wave_sum(float v) {
#pragma unroll
    for (int o = 32; o > 0; o >>= 1) v += __shfl_xor(v, o);
    return v;
}
DEVI int mt_of(int q, bool latonly) { return latonly ? (q >> 4) * 18 + 2 + (q & 15) : q; }

struct CvtJob { const float* src; bf16_t* dst; const float* ks; int K, N, ldd, batch; size_t sbs, dbs; int mode; int lds, n0, wide; };
DEVI int cvt_rowmap(int mode, int n) {
    if (mode == 1) return n < 384 ? n : (n < 416 ? n - 384 + 3712 : n - 32);
    if (mode == 2) { int h = n / 96, j = n % 96; return j < 64 ? h * 64 + j : 512 + h * 32 + (j - 64); }
    if (mode == 3) return (n >> 6) * 128 + (n & 63);
    return n;
}
DEVI void cvt_tile(const CvtJob& j, int tile, float* lds) {
    const int tn = j.N / 32, tk = j.K / 64, per = tn * tk;
    const int bb = tile / per, r = tile % per, kt = r / tn, nt = r % tn;
    const float* s = j.src + (size_t)bb * j.sbs + (size_t)(kt * 64) * j.lds + j.n0 + nt * 32;
    const int tx = TIDX & 31, ty = TIDX >> 5;
#pragma unroll
    for (int i = 0; i < 8; ++i) {
        int k = ty + 8 * i;
        float v = s[(size_t)k * j.lds + tx];
        if (j.ks) v *= j.ks[kt * 64 + k];
        lds[k * 33 + tx] = v;
    }
    __syncthreads();
    bf16_t* d = j.dst + (size_t)bb * j.dbs;
#pragma unroll
    for (int i = 0; i < 4; ++i) {
        int n = ty + 8 * i, kk = tx * 2;
        unsigned lo = f2bf(lds[kk * 33 + n]), hi = f2bf(lds[(kk + 1) * 33 + n]);
        int row = cvt_rowmap(j.mode, j.n0 + nt * 32 + n);
        *(unsigned*)(d + (size_t)row * j.ldd + kt * 64 + kk) = lo | (hi << 16);
    }
    __syncthreads();
}

DEVI void cvt_tile256(const CvtJob& j, int tile, unsigned char* smem) {
    constexpr int NS = 68;
    bf16_t* T = (bf16_t*)smem;
    const int tn = j.N / 256, tk = j.K / 64, per = tn * tk;
    const int bb = tile / per, r = tile % per, kt = r / tn, nt = r % tn;
    const float* s = j.src + (size_t)bb * j.sbs + (size_t)(kt * 64) * j.lds + j.n0 + nt * 256;
    const int tid = TIDX, lane = tid & 63, w = tid >> 6;
    float4 v[16];
#pragma unroll
    for (int i = 0; i < 16; ++i) v[i] = *(const float4*)(s + (size_t)(w * 16 + i) * j.lds + lane * 4);
    if (j.ks) {
#pragma unroll
        for (int i = 0; i < 16; ++i) { const float sc = j.ks[kt * 64 + w * 16 + i]; v[i].x *= sc; v[i].y *= sc; v[i].z *= sc; v[i].w *= sc; }
    }
    __syncthreads();
#pragma unroll
    for (int h = 0; h < 2; ++h) {
        bf16x4 q0a, q0b, q1a, q1b, q2a, q2b, q3a, q3b;
#pragma unroll
        for (int e = 0; e < 4; ++e) {
            q0a[e] = (short)f2bf(v[h * 8 + e].x); q0b[e] = (short)f2bf(v[h * 8 + 4 + e].x);
            q1a[e] = (short)f2bf(v[h * 8 + e].y); q1b[e] = (short)f2bf(v[h * 8 + 4 + e].y);
            q2a[e] = (short)f2bf(v[h * 8 + e].z); q2b[e] = (short)f2bf(v[h * 8 + 4 + e].z);
            q3a[e] = (short)f2bf(v[h * 8 + e].w); q3b[e] = (short)f2bf(v[h * 8 + 4 + e].w);
        }
        bf16_t* tp = T + (lane * 4) * NS + w * 16 + h * 8;
        *(bf16x4*)(tp) = q0a; *(bf16x4*)(tp + 4) = q0b;
        *(bf16x4*)(tp + NS) = q1a; *(bf16x4*)(tp + NS + 4) = q1b;
        *(bf16x4*)(tp + 2 * NS) = q2a; *(bf16x4*)(tp + 2 * NS + 4) = q2b;
        *(bf16x4*)(tp + 3 * NS) = q3a; *(bf16x4*)(tp + 3 * NS + 4) = q3b;
    }
    __syncthreads();
    bf16_t* d = j.dst + (size_t)bb * j.dbs;
#pragma unroll
    for (int i = 0; i < 8; ++i) {
        const int c = tid + 256 * i, n = c >> 3, kc = c & 7;
        const bf16x4 lo = *(const bf16x4*)(T + n * NS + kc * 8), hi = *(const bf16x4*)(T + n * NS + kc * 8 + 4);
        const int row = cvt_rowmap(j.mode, j.n0 + nt * 256 + n);
        *(bf16x8*)(d + (size_t)row * j.ldd + kt * 64 + kc * 8) = bf16x8{lo[0], lo[1], lo[2], lo[3], hi[0], hi[1], hi[2], hi[3]};
    }
}
typedef __attribute__((ext_vector_type(8))) int i32x8;
typedef __attribute__((ext_vector_type(4))) int i32x4;
DEVI int pk4_fp8(float a, float b, float c, float d) {
    int r = __builtin_amdgcn_cvt_pk_fp8_f32(a, b, 0, false);
    return __builtin_amdgcn_cvt_pk_fp8_f32(c, d, r, true);
}
constexpr float W8_SCALE = 32.f;
DEVI void cvt_tile256_fp8(const CvtJob& j, int tile, unsigned char* smem) {
    constexpr int RS = 80;
    const int tn = j.N / 256, tk = j.K / 64, per = tn * tk;
    const int r = tile % per, kt = r / tn, nt = r % tn;
    const float* s = j.src + (size_t)(kt * 64) * j.lds + nt * 256;
    const int tid = TIDX, lane = tid & 63, w = tid >> 6;
    float4 v[16];
#pragma unroll
    for (int i = 0; i < 16; ++i) v[i] = *(const float4*)(s + (size_t)(w * 16 + i) * j.lds + lane * 4);
    __syncthreads();
    i32x4 q0, q1, q2, q3;
#pragma unroll
    for (int c = 0; c < 4; ++c) {
        q0[c] = pk4_fp8(v[4 * c].x * W8_SCALE, v[4 * c + 1].x * W8_SCALE, v[4 * c + 2].x * W8_SCALE, v[4 * c + 3].x * W8_SCALE);
        q1[c] = pk4_fp8(v[4 * c].y * W8_SCALE, v[4 * c + 1].y * W8_SCALE, v[4 * c + 2].y * W8_SCALE, v[4 * c + 3].y * W8_SCALE);
        q2[c] = pk4_fp8(v[4 * c].z * W8_SCALE, v[4 * c + 1].z * W8_SCALE, v[4 * c + 2].z * W8_SCALE, v[4 * c + 3].z * W8_SCALE);
        q3[c] = pk4_fp8(v[4 * c].w * W8_SCALE, v[4 * c + 1].w * W8_SCALE, v[4 * c + 2].w * W8_SCALE, v[4 * c + 3].w * W8_SCALE);
    }
    unsigned char* tp = smem + (lane * 4) * RS + w * 16;
    *(i32x4*)(tp) = q0; *(i32x4*)(tp + RS) = q1; *(i32x4*)(tp + 2 * RS) = q2; *(i32x4*)(tp + 3 * RS) = q3;
    __syncthreads();
    unsigned char* d = (unsigned char*)j.dst;
#pragma unroll
    for (int i = 0; i < 4; ++i) {
        const int c = tid + 256 * i, n = c >> 2, kc = c & 3;
        *(i32x4*)(d + (size_t)(nt * 256 + n) * j.ldd + kt * 64 + kc * 16) = *(const i32x4*)(smem + n * RS + kc * 16);
    }
}
__constant__ const int CVT_TILES[10] = {224, 80, 12, 8, 128, 256, 64, 32, 32, 32};
constexpr int CVT_PER_LAYER = 224 + 80 + 12 + 8 + 128 + 256 + 64 + 32 + 32 + 32;
DEVI CvtJob get_job(const Params& p, int l, int k) {
    CvtJob j; j.ks = nullptr; j.batch = 1; j.sbs = 0; j.dbs = 0; j.mode = 0; j.n0 = 0; j.wide = 1;
    switch (k) {
    case 0: j.src = p.in[I_WIN] + (size_t)l * 1024 * 3744; j.dst = WB(W_IN + (size_t)l * 3840 * 1024); j.K = 1024; j.N = 3584; j.lds = 3744; j.ldd = 1024; j.mode = 1; break;
    case 1: j.src = p.in[I_WIN] + (size_t)l * 1024 * 3744; j.dst = WB(W_IN + (size_t)l * 3840 * 1024); j.K = 1024; j.N = 160; j.lds = 3744; j.n0 = 3584; j.ldd = 1024; j.mode = 1; j.wide = 0; break;
    case 2: j.src = p.in[I_WUQ] + (size_t)l * 256 * 768; j.dst = WB(W_UQ + (size_t)l * 768 * 256); j.K = 256; j.N = 768; j.lds = 768; j.ldd = 256; j.ks = p.in[I_MQN] + l * 256; j.mode = 2; break;
    case 3: j.src = p.in[I_WUKV] + (size_t)l * 128 * 1024; j.dst = WB(W_UKV + (size_t)l * 1024 * 128); j.K = 128; j.N = 1024; j.lds = 1024; j.ldd = 128; j.ks = p.in[I_MKVN] + l * 128; break;
    case 4: j.src = p.in[I_WBR] + (size_t)l * 4 * 512 * 1024; j.dst = WB(W_BR + (size_t)l * 4 * 1024 * 512); j.K = 512; j.N = 1024; j.lds = 1024; j.ldd = 512; j.batch = 4; j.sbs = 512 * 1024; j.dbs = 1024 * 512; break;
    case 5: j.src = p.in[I_WMG] + (size_t)l * 1024 * 4096; j.dst = WB(W_MG + (size_t)l * 4096 * 1024); j.K = 1024; j.N = 4096; j.lds = 4096; j.ldd = 1024; break;
    case 6: j.src = p.in[I_WOUT] + (size_t)l * 1024 * 1024; j.dst = WB(W_OUT + (size_t)l * 1024 * 1024); j.K = 1024; j.N = 1024; j.lds = 1024; j.ldd = 1024; break;
    case 7: j.src = p.in[I_LWA] + (size_t)l * 16 * 4096; j.dst = WB(W_LRU + (size_t)l * 16 * 8192); j.K = 64; j.N = 64; j.lds = 64; j.ldd = 64; j.batch = 16; j.sbs = 4096; j.dbs = 8192; j.wide = 0; break;
    case 8: j.src = p.in[I_LWX] + (size_t)l * 16 * 4096; j.dst = WB(W_LRU + (size_t)l * 16 * 8192 + 4096); j.K = 64; j.N = 64; j.lds = 64; j.ldd = 64; j.batch = 16; j.sbs = 4096; j.dbs = 8192; j.wide = 0; break;
    default: j.src = p.in[I_RW]; j.dst = WB(W_RT); j.K = 1024; j.N = 64; j.lds = 64; j.ldd = 1024; j.wide = 0; break;
    }
    return j;
}
DEVI CvtJob get_moe_job(const Params& p, int l, int k) {
    CvtJob j; j.ks = nullptr; j.batch = 64; j.sbs = 262144; j.n0 = 0; j.wide = 1;
    if (k == 0) { j.src = p.in[I_W1] + (size_t)l * 64 * 262144; j.dst = MWB(MW_13); j.K = 1024; j.N = 256; j.lds = 256; j.ldd = 1024; j.dbs = 512 * 1024; j.mode = 3; }
    else if (k == 1) { j.src = p.in[I_W3] + (size_t)l * 64 * 262144; j.dst = MWB(MW_13 + 64 * 1024); j.K = 1024; j.N = 256; j.lds = 256; j.ldd = 1024; j.dbs = 512 * 1024; j.mode = 3; }
    else { j.src = p.in[I_W2] + (size_t)l * 64 * 262144; j.dst = MWB(MW_2); j.K = 256; j.N = 1024; j.lds = 1024; j.ldd = 256; j.dbs = 262144; j.mode = 0; }
    return j;
}

struct AOp { const bf16_t* base; int ld; int row0; const int* ridx; };
DEVI const bf16_t* arow(const AOp& a, int i) {
    int r = a.ridx ? a.ridx[i] : a.row0 + i;
    return a.base + (size_t)r * a.ld;
}

#if NAIVE_GEMM
template <int BN>
DEVI void gemm_core(f32x4 (&acc)[4][BN / 32], const AOp& A, const bf16_t* B, int ldb, int K, unsigned char* smem) {
    constexpr int NI = BN / 32;
    const int tid = TIDX, lane = tid & 63, wid = tid >> 6, wr = wid >> 1, wc = wid & 1;
    for (int k0 = 0; k0 < K; k0 += 8) {
        bf16x8 bv[NI];
#pragma unroll
        for (int ni = 0; ni < NI; ++ni) bv[ni] = *(const bf16x8*)(B + (size_t)(wc * (BN / 2) + ni * 16 + (lane & 15)) * ldb + k0);
#pragma unroll
        for (int mi = 0; mi < 4; ++mi)
#pragma unroll
            for (int j = 0; j < 4; ++j) {
                bf16x8 av = *(const bf16x8*)(arow(A, wr * 64 + mi * 16 + (lane >> 4) * 4 + j) + k0);
#pragma unroll
                for (int ni = 0; ni < NI; ++ni) {
                    float s = 0.f;
#pragma unroll
                    for (int e = 0; e < 8; ++e) s += bf2f((bf16_t)av[e]) * bf2f((bf16_t)bv[ni][e]);
                    acc[mi][ni][j] += s;
                }
            }
    }
}
#else
#define GAS __attribute__((address_space(1)))
template <int BN, bool GATHER = false>
DEVI void gemm_core(f32x4 (&acc)[4][BN / 32], const AOp& A, const bf16_t* B, int ldb, int K, unsigned char* smem) {
    constexpr int NI = BN / 32;
    constexpr int NBL = BN / 32;
    constexpr int STG = 32768;
    const int tid = TIDX, lane = tid & 63, wid = tid >> 6, wr = wid >> 1, wc = wid & 1;
    const int lr = tid >> 3;
    const int kc = (tid & 7) ^ (lr & 7);
    const bf16_t* ap[GATHER ? 4 : 1];
    if (GATHER) {
#pragma unroll
        for (int i = 0; i < (GATHER ? 4 : 1); ++i) ap[i] = arow(A, lr + 32 * i) + kc * 8;
    } else ap[0] = A.base + (size_t)(A.row0 + lr) * A.ld + kc * 8;
    const size_t astep = (size_t)32 * A.ld;
    const bf16_t* bp = B + (size_t)lr * ldb + kc * 8;
    const size_t bstep = (size_t)32 * ldb;
    LAS unsigned char* lA = (LAS unsigned char*)smem + tid * 16;
    LAS unsigned char* lB = lA + 16384;
    const int nk = K >> 6;
    const int arow_off = (wr * 64 + (lane & 15)) * 128;
    const int brow_off = 16384 + (wc * (BN / 2) + (lane & 15)) * 128;
    __syncthreads();
#pragma unroll
    for (int i = 0; i < 4; ++i) __builtin_amdgcn_global_load_lds((const GAS unsigned*)(GATHER ? ap[GATHER ? i : 0] : ap[0] + i * astep), (LAS unsigned*)(lA + i * 4096), 16, 0, 0);
#pragma unroll
    for (int i = 0; i < NBL; ++i) __builtin_amdgcn_global_load_lds((const GAS unsigned*)(bp + i * bstep), (LAS unsigned*)(lB + i * 4096), 16, 0, 0);
    for (int kt = 0; kt < nk; ++kt) {
        __syncthreads();
        if (kt + 1 < nk) {
            const int ko = (kt + 1) * 64;
            const int so = ((kt + 1) & 1) * STG;
#pragma unroll
            for (int i = 0; i < 4; ++i) __builtin_amdgcn_global_load_lds((const GAS unsigned*)((GATHER ? ap[GATHER ? i : 0] : ap[0] + i * astep) + ko), (LAS unsigned*)(lA + so + i * 4096), 16, 0, 0);
#pragma unroll
            for (int i = 0; i < NBL; ++i) __builtin_amdgcn_global_load_lds((const GAS unsigned*)(bp + i * bstep + ko), (LAS unsigned*)(lB + so + i * 4096), 16, 0, 0);
        }
        const unsigned char* cs = smem + (kt & 1) * STG;
#pragma unroll
        for (int ks = 0; ks < 2; ++ks) {
            const int pch = ((ks * 4 + (lane >> 4)) ^ (lane & 7)) << 4;
            bf16x8 bfr[NI];
#pragma unroll
            for (int ni = 0; ni < NI; ++ni) bfr[ni] = *(const bf16x8*)(cs + brow_off + ni * 2048 + pch);
#pragma unroll
            for (int mi = 0; mi < 4; mi += 2) {
                const bf16x8 a0 = *(const bf16x8*)(cs + arow_off + mi * 2048 + pch);
                const bf16x8 a1 = *(const bf16x8*)(cs + arow_off + (mi + 1) * 2048 + pch);
#pragma unroll
                for (int ni = 0; ni < NI; ++ni) acc[mi][ni] = __builtin_amdgcn_mfma_f32_16x16x32_bf16(a0, bfr[ni], acc[mi][ni], 0, 0, 0);
#pragma unroll
                for (int ni = 0; ni < NI; ++ni) acc[mi + 1][ni] = __builtin_amdgcn_mfma_f32_16x16x32_bf16(a1, bfr[ni], acc[mi + 1][ni], 0, 0, 0);
            }
        }
    }
}
#endif

DEVI void gemm_core_fp8(f32x4 (&acc)[4][4], const unsigned char* Ab, size_t lda, int row0, const unsigned char* Bb, size_t ldb, int K, unsigned char* smem) {
    constexpr int STG = 32768;
    const int tid = TIDX, lane = tid & 63, wid = tid >> 6, wr = wid >> 1, wc = wid & 1;
    const int lr = tid >> 3;
    const int kc = (tid & 7) ^ (lr & 7);
    const unsigned char* ap = Ab + (size_t)(row0 + lr) * lda + kc * 16;
    const size_t astep = 32 * lda;
    const unsigned char* bp = Bb + (size_t)lr * ldb + kc * 16;
    const size_t bstep = 32 * ldb;
    LAS unsigned char* lA = (LAS unsigned char*)smem + tid * 16;
    LAS unsigned char* lB = lA + 16384;
    const int nk = K >> 7;
    const int arow_off = (wr * 64 + (lane & 15)) * 128;
    const int brow_off = 16384 + (wc * 64 + (lane & 15)) * 128;
    const int c0 = ((2 * (lane >> 4)) ^ (lane & 7)) << 4, c1 = ((2 * (lane >> 4) + 1) ^ (lane & 7)) << 4;
    __syncthreads();
#pragma unroll
    for (int i = 0; i < 4; ++i) __builtin_amdgcn_global_load_lds((const GAS unsigned*)(ap + i * astep), (LAS unsigned*)(lA + i * 4096), 16, 0, 0);
#pragma unroll
    for (int i = 0; i < 4; ++i) __builtin_amdgcn_global_load_lds((const GAS unsigned*)(bp + i * bstep), (LAS unsigned*)(lB + i * 4096), 16, 0, 0);
#pragma unroll 1
    for (int kt = 0; kt < nk; ++kt) {
        __syncthreads();
        if (kt + 1 < nk) {
            const int ko = (kt + 1) * 128;
            const int so = ((kt + 1) & 1) * STG;
#pragma unroll
            for (int i = 0; i < 4; ++i) __builtin_amdgcn_global_load_lds((const GAS unsigned*)(ap + i * astep + ko), (LAS unsigned*)(lA + so + i * 4096), 16, 0, 0);
#pragma unroll
            for (int i = 0; i < 4; ++i) __builtin_amdgcn_global_load_lds((const GAS unsigned*)(bp + i * bstep + ko), (LAS unsigned*)(lB + so + i * 4096), 16, 0, 0);
        }
        const unsigned char* cs = smem + (kt & 1) * STG;
        i32x8 bfr[4];
#pragma unroll
        for (int ni = 0; ni < 4; ++ni) {
            const i32x4 lo = *(const i32x4*)(cs + brow_off + ni * 2048 + c0), hi = *(const i32x4*)(cs + brow_off + ni * 2048 + c1);
            bfr[ni] = i32x8{lo[0], lo[1], lo[2], lo[3], hi[0], hi[1], hi[2], hi[3]};
        }
#pragma unroll
        for (int mi = 0; mi < 4; ++mi) {
            const i32x4 lo = *(const i32x4*)(cs + arow_off + mi * 2048 + c0), hi = *(const i32x4*)(cs + arow_off + mi * 2048 + c1);
            const i32x8 af = i32x8{lo[0], lo[1], lo[2], lo[3], hi[0], hi[1], hi[2], hi[3]};
#pragma unroll
            for (int ni = 0; ni < 4; ++ni)
                acc[mi][ni] = __builtin_amdgcn_mfma_scale_f32_16x16x128_f8f6f4(af, bfr[ni], acc[mi][ni], 0, 0, 0, 0x7f7f7f7f, 0, 0x7a7a7a7a);
        }
    }
}

template <int BN>
DEVI void acc_zero(f32x4 (&acc)[4][BN / 32]) {
#pragma unroll
    for (int mi = 0; mi < 4; ++mi)
#pragma unroll
        for (int ni = 0; ni < BN / 32; ++ni) acc[mi][ni] = f32x4{0.f, 0.f, 0.f, 0.f};
}
template <int BN>
DEVI void acc_to_ct(const f32x4 (&acc)[4][BN / 32], bf16_t* ct) {
    const int tid = TIDX, lane = tid & 63, wid = tid >> 6, wr = wid >> 1, wc = wid & 1;
#pragma unroll
    for (int mi = 0; mi < 4; ++mi)
#pragma unroll
        for (int ni = 0; ni < BN / 32; ++ni)
#pragma unroll
            for (int j = 0; j < 4; ++j)
                ct[(wr * 64 + mi * 16 + (lane >> 4) * 4 + j) * CT_LD + wc * (BN / 2) + ni * 16 + (lane & 15)] = f2bf(acc[mi][ni][j]);
}

template <int NC>
DEVI void ep_store_rows(const bf16_t* ct, int c0, bf16_t* dst, int ldd, int row0) {
    constexpr int CPR = NC / 8;
    for (int c = TIDX; c < 128 * CPR; c += 256) {
        int i = c / CPR, jc = c % CPR;
        *(bf16x8*)(dst + (size_t)(row0 + i) * ldd + jc * 8) = *(const bf16x8*)(ct + i * CT_LD + c0 + jc * 8);
    }
}
DEVI void ep_store_T(const bf16_t* ct, int c0, int nc, bf16_t* dstT, int ldT, int t0) {
    for (int c = TIDX; c < nc * 16; c += 256) {
        int j = c >> 4, ic = c & 15;
        bf16x8 v;
#pragma unroll
        for (int e = 0; e < 8; ++e) v[e] = (short)ct[(ic * 8 + e) * CT_LD + c0 + j];
        *(bf16x8*)(dstT + (size_t)j * ldT + t0 + ic * 8) = v;
    }
}
DEVI void ep_rope64(bf16_t* ct, const float* gain, float scale, bool lat, int pos0, const float* cs64) {
    const int row = TIDX >> 1, half = TIDX & 1;
    bf16_t* pr = ct + row * CT_LD + half * 64;
    float v[64];
#pragma unroll
    for (int c = 0; c < 8; ++c) {
        bf16x8 t = *(const bf16x8*)(pr + c * 8);
#pragma unroll
        for (int e = 0; e < 8; ++e) v[c * 8 + e] = bf2f((bf16_t)t[e]);
    }
    if (gain) {
        float ss = 0.f;
#pragma unroll
        for (int d = 0; d < 64; ++d) ss += v[d] * v[d];
        float rstd = rsqrtf(ss * (1.f / 64.f) + EPSV);
#pragma unroll
        for (int d = 0; d < 64; ++d) v[d] = v[d] * rstd * gain[d];
    }
    if (lat) {
        const float* cs = cs64 + (size_t)(pos0 + row) * 64;
#pragma unroll
        for (int i = 0; i < 16; ++i) {
            float a = v[i], b = v[i + 16], c = cs[i], s = cs[32 + i];
            v[i] = a * c - b * s; v[i + 16] = b * c + a * s;
            a = v[32 + i]; b = v[48 + i]; c = cs[16 + i]; s = cs[48 + i];
            v[32 + i] = a * c - b * s; v[48 + i] = b * c + a * s;
        }
    }
#pragma unroll
    for (int c = 0; c < 8; ++c) {
        bf16x8 t;
#pragma unroll
        for (int e = 0; e < 8; ++e) t[e] = (short)f2bf(v[c * 8 + e] * scale);
        *(bf16x8*)(pr + c * 8) = t;
    }
}
DEVI void ep_rope32(bf16_t* ct, int ngroups, const float* rstd, float scale, bool lat, int pos0, const float* cs32) {
    const int row = TIDX >> 1, half = TIDX & 1;
    const float rs = (rstd ? rstd[row] : 1.f) * scale;
#pragma unroll
    for (int gg = 0; gg < 2; ++gg) {
        const int g = half * 2 + gg;
        if (g < ngroups) {
            bf16_t* pr = ct + row * CT_LD + g * 32;
            float v[32];
#pragma unroll
            for (int c = 0; c < 4; ++c) {
                bf16x8 t = *(const bf16x8*)(pr + c * 8);
#pragma unroll
                for (int e = 0; e < 8; ++e) v[c * 8 + e] = bf2f((bf16_t)t[e]);
            }
            if (lat) {
                const float* cs = cs32 + (size_t)(pos0 + row) * 32;
#pragma unroll
                for (int i = 0; i < 8; ++i) {
                    float a = v[i], b = v[i + 8], c = cs[i], s = cs[16 + i];
                    v[i] = a * c - b * s; v[i + 8] = b * c + a * s;
                    a = v[16 + i]; b = v[24 + i]; c = cs[8 + i]; s = cs[24 + i];
                    v[16 + i] = a * c - b * s; v[24 + i] = b * c + a * s;
                }
            }
#pragma unroll
            for (int c = 0; c < 4; ++c) {
                bf16x8 t;
#pragma unroll
                for (int e = 0; e < 8; ++e) t[e] = (short)f2bf(v[c * 8 + e] * rs);
                *(bf16x8*)(pr + c * 8) = t;
            }
        }
    }
}
DEVI void ep_scale_rows(bf16_t* ct, int c0, int nc, const float* rstd, float scale) {
    const int cpr = nc / 8;
    for (int c = TIDX; c < 128 * cpr; c += 256) {
        int i = c / cpr, jc = c % cpr;
        bf16_t* pr = ct + i * CT_LD + c0 + jc * 8;
        bf16x8 t = *(const bf16x8*)pr;
        float rs = rstd[i] * scale;
#pragma unroll
        for (int e = 0; e < 8; ++e) t[e] = (short)f2bf(bf2f((bf16_t)t[e]) * rs);
        *(bf16x8*)pr = t;
    }
}
DEVI void ep_rstd(const bf16_t* A, int ld, int row0, int K, float* rstd) {
    const int row = TIDX >> 1, half = TIDX & 1;
    const bf16_t* pr = A + (size_t)(row0 + row) * ld + half * (K / 2);
    float ss = 0.f;
    for (int c = 0; c < K / 16; ++c) {
        bf16x8 t = *(const bf16x8*)(pr + c * 8);
#pragma unroll
        for (int e = 0; e < 8; ++e) { float f = bf2f((bf16_t)t[e]); ss += f * f; }
    }
    ss += __shfl_xor(ss, 1);
    if (half == 0) rstd[row] = rsqrtf(ss / (float)K + EPSV);
}


struct GrpInfo { int xcd, j, per, ngrp; };
DEVI GrpInfo grp_info(const Params& p) {
    const unsigned* pv = (const unsigned*)(p.ws + OFF_PRIV + (size_t)BIDX * 1024 + 896);
    GrpInfo g;
    g.xcd = (int)__hip_atomic_load(pv + 2, __ATOMIC_RELAXED, __HIP_MEMORY_SCOPE_AGENT);
    g.j = (int)__hip_atomic_load(pv + 3, __ATOMIC_RELAXED, __HIP_MEMORY_SCOPE_AGENT);
    g.per = (int)__hip_atomic_load((const unsigned*)(p.ws + OFF_BAR) + 256 + 64 * g.xcd, __ATOMIC_RELAXED, __HIP_MEMORY_SCOPE_AGENT);
    g.ngrp = 8;
    if (g.xcd >= 8 || g.per <= 0) { g.xcd = 0; g.j = BIDX; g.per = gridDim.x; g.ngrp = 1; }
    return g;
}
DEVI bool super_tile(const GrpInfo& gi, int it, int NMT, int NNT, int SM, int SN, int& mt, int& nt) {
    const int ST = SM * SN, passes = (ST + gi.per - 1) / gi.per;
    const int nsn = (NNT + SN - 1) / SN, nsm = (NMT + SM - 1) / SM;
    const int s = (it / passes) * gi.ngrp + gi.xcd;
    if (s >= nsm * nsn) return false;
    const int idx = (it % passes) * gi.per + gi.j;
    mt = -1; nt = 0;
    if (idx < ST) {
        const int m = (s / nsn) * SM + idx / SN, n = (s % nsn) * SN + idx % SN;
        if (m < NMT && n < NNT) { mt = m; nt = n; }
    }
    return true;
}

DEVI void phase0(const Params& p, unsigned char* smem) {
    const int tid = TIDX, lane = tid & 63, w = tid >> 6;
    const int NG = 192, NCV = 2 * CVT_PER_LAYER, NR = 8;
    const int ntask = NG + NCV + NR + 1;
    for (int task = BIDX; task < ntask; task += gridDim.x) {
        if (task < NG) {
            const int l = task / 96, n0 = (task % 96) * 64;
            float* sv = (float*)smem;
            float* red = (float*)(smem + 36864);
            for (int idx = lane; idx < 9 * 256; idx += 64) {
                int bi = idx >> 8, kk = idx & 255, k = 256 * w + kk;
                float c = bi < 8 ? p.in[I_C][bi * 1024 + k] : p.in[I_CCTX][k];
                sv[(w * 9 + bi) * 256 + kk] = siluf_(c);
            }
            __syncthreads();
            float acc[9];
#pragma unroll
            for (int bi = 0; bi < 9; ++bi) acc[bi] = 0.f;
            const float* wp = p.in[I_ADAW] + (size_t)l * 1024 * 6144 + (size_t)(256 * w) * 6144 + n0 + lane;
#pragma unroll 8
            for (int kk = 0; kk < 256; ++kk) {
                float wv = wp[(size_t)kk * 6144];
#pragma unroll
                for (int bi = 0; bi < 9; ++bi) acc[bi] += sv[(w * 9 + bi) * 256 + kk] * wv;
            }
#pragma unroll
            for (int bi = 0; bi < 9; ++bi) red[(w * 9 + bi) * 64 + lane] = acc[bi];
            __syncthreads();
            for (int idx = tid; idx < 9 * 64; idx += 256) {
                int bi = idx >> 6, c = idx & 63;
                float s = p.in[I_ADAB][l * 6144 + n0 + c];
#pragma unroll
                for (int ww = 0; ww < 4; ++ww) s += red[(ww * 9 + bi) * 64 + c];
                WSF(OFF_MOD)[(size_t)(l * 9 + bi) * 6144 + n0 + c] = s;
            }
            __syncthreads();
        } else if (task < NG + NCV) {
            int t = task - NG;
            int l = t / CVT_PER_LAYER; t %= CVT_PER_LAYER;
            int k = 0;
            while (t >= CVT_TILES[k]) { t -= CVT_TILES[k]; ++k; }
            CvtJob j = get_job(p, l, k);
            if (k == 5) cvt_tile256_fp8(j, t, smem); else if (j.wide) cvt_tile256(j, t, smem); else cvt_tile(j, t, (float*)smem);
        } else if (task < NG + NCV + NR) {
            int pos = (task - NG - NCV) * 256 + tid;
            float rp = (float)(pos >> 6), cp = (float)(pos & 63);
            float* t64 = WSF(OFF_R64) + (size_t)pos * 64;
            float* t32 = WSF(OFF_R32) + (size_t)pos * 32;
            for (int i = 0; i < 16; ++i) {
                float inv = powf(10000.f, -(float)(2 * i) / 32.f);
                float ar = rp * inv, ac = cp * inv;
                t64[i] = cosf(ar); t64[16 + i] = cosf(ac); t64[32 + i] = sinf(ar); t64[48 + i] = sinf(ac);
            }
            for (int i = 0; i < 8; ++i) {
                float inv = powf(10000.f, -(float)(2 * i) / 16.f);
                float ar = rp * inv, ac = cp * inv;
                t32[i] = cosf(ar); t32[8 + i] = cosf(ac); t32[16 + i] = sinf(ar); t32[24 + i] = sinf(ac);
            }
        } else {
            for (int i = tid; i < 4096; i += 256) WSI(OFF_CNT)[i] = 0;
            for (int l = 0; l < 2; ++l) {
                unsigned* z = (unsigned*)WB(W_IN + (size_t)l * 3840 * 1024 + (size_t)3744 * 1024);
                for (int i = tid; i < 96 * 1024 / 2; i += 256) z[i] = 0u;
            }
        }
    }
}

struct MoeTab {
    int* base;
    DEVI int cnt(int e) const { return __hip_atomic_load(base + e, __ATOMIC_RELAXED, __HIP_MEMORY_SCOPE_AGENT); }
    DEVI int tp(int e) const { return __hip_atomic_load(base + 64 + e, __ATOMIC_RELAXED, __HIP_MEMORY_SCOPE_AGENT); }
    DEVI int seg(int e) const { return __hip_atomic_load(base + 136 + e, __ATOMIC_RELAXED, __HIP_MEMORY_SCOPE_AGENT); }
};
DEVI MoeTab moe_tables(const Params& p, int l, unsigned char* smem) {
    MoeTab t; t.base = (int*)(p.ws + OFF_PRIV + (size_t)BIDX * 1024);
    __syncthreads();
    if (TIDX == 0) {
        int a = 0, sg = 0;
        for (int e = 0; e < 64; ++e) {
            const int c = WSI(OFF_CNT)[l * 64 + e];
            __hip_atomic_store(t.base + e, c, __ATOMIC_RELAXED, __HIP_MEMORY_SCOPE_AGENT);
            __hip_atomic_store(t.base + 64 + e, a, __ATOMIC_RELAXED, __HIP_MEMORY_SCOPE_AGENT);
            __hip_atomic_store(t.base + 136 + e, sg, __ATOMIC_RELAXED, __HIP_MEMORY_SCOPE_AGENT);
            const int nt = (c + 127) >> 7;
            a += nt; sg += nt * 128;
        }
        __hip_atomic_store(t.base + 64 + 64, a, __ATOMIC_RELAXED, __HIP_MEMORY_SCOPE_AGENT);
        __hip_atomic_store(t.base + 136 + 64, sg, __ATOMIC_RELAXED, __HIP_MEMORY_SCOPE_AGENT);
    }
    asm volatile("s_waitcnt vmcnt(0)" ::: "memory");
    __syncthreads();
    return t;
}
struct Rec { int e0, p0, e1, p1; float w0, w1; int pad0, pad1; };

DEVI void phase_norm1(const Params& p, int l, int mode, unsigned char* smem) {
    const int lane = TIDX & 63, w = TIDX >> 6;
    MoeTab mt;
    const bool comb = (mode == 0 && l > 0) || mode == 1;
    const int lp = mode == 1 ? 1 : l - 1;
    if (comb) mt = moe_tables(p, lp, smem);
    const float* g1 = mode == 1 ? p.in[I_FN] : (mode == 2 ? p.in[I_N2G] + l * 1024 : p.in[I_N1G] + l * 1024);
    const bool latonly = (mode == 1) || (mode == 2 && l == 1);
    const int nrows = latonly ? NBT * SEQL : TT;
    const int stride = gridDim.x * 4;
    int ri = BIDX * 4 + w;
    float4 xn[4];
    auto rowof = [&](int r) { return latonly ? (r >> 11) * TPB + CTXL + (r & 2047) : r; };
    auto srcof = [&](int row) -> const float* {
        if (mode == 0 && l == 0) {
            const int b = row / TPB, t = row % TPB;
            return t < CTXL ? p.in[I_CTX] + ((size_t)b * CTXL + t) * DM : p.in[I_X] + ((size_t)b * SEQL + (t - CTXL)) * DM;
        }
        return XCUR + (size_t)row * DM;
    };
    if (ri < nrows) {
        const float* src = srcof(rowof(ri));
#pragma unroll
        for (int i = 0; i < 4; ++i) xn[i] = *(const float4*)(src + i * 256 + lane * 4);
    }
    for (; ri < nrows; ri += stride) {
        const int row = rowof(ri);
        const int b = row / TPB, t = row % TPB;
        const bool isctx = t < CTXL;
        const int bi = isctx ? 8 : b;
        float v[16];
#pragma unroll
        for (int i = 0; i < 4; ++i) { v[i * 4] = xn[i].x; v[i * 4 + 1] = xn[i].y; v[i * 4 + 2] = xn[i].z; v[i * 4 + 3] = xn[i].w; }
        if (ri + stride < nrows) {
            const float* src = srcof(rowof(ri + stride));
#pragma unroll
            for (int i = 0; i < 4; ++i) xn[i] = *(const float4*)(src + i * 256 + lane * 4);
        }
        if (comb) {
            float* xr = XCUR + (size_t)row * DM;
            const Rec rc = ((const Rec*)(p.ws + OFF_REC))[row];
            const bf16_t* y0 = DB(D_YS) + (size_t)(mt.seg(rc.e0) + rc.p0) * 1024;
            const bf16_t* y1 = DB(D_YS) + (size_t)(mt.seg(rc.e1) + rc.p1) * 1024;
            const float* gate = WSF(OFF_MOD) + (size_t)(lp * 9 + bi) * 6144 + 5 * 1024;
#pragma unroll
            for (int i = 0; i < 4; ++i) {
                const int c = i * 256 + lane * 4;
                float4 g4 = *(const float4*)(gate + c);
                uint2 a = *(const uint2*)(y0 + c), bb = *(const uint2*)(y1 + c);
                float f0 = rc.w0 * __uint_as_float(a.x << 16) + rc.w1 * __uint_as_float(bb.x << 16);
                float f1 = rc.w0 * __uint_as_float(a.x & 0xffff0000u) + rc.w1 * __uint_as_float(bb.x & 0xffff0000u);
                float f2 = rc.w0 * __uint_as_float(a.y << 16) + rc.w1 * __uint_as_float(bb.y << 16);
                float f3 = rc.w0 * __uint_as_float(a.y & 0xffff0000u) + rc.w1 * __uint_as_float(bb.y & 0xffff0000u);
                v[i * 4] += g4.x * f0; v[i * 4 + 1] += g4.y * f1; v[i * 4 + 2] += g4.z * f2; v[i * 4 + 3] += g4.w * f3;
                if (mode == 0) *(float4*)(xr + c) = make_float4(v[i * 4], v[i * 4 + 1], v[i * 4 + 2], v[i * 4 + 3]);
            }
        }
        float ss = 0.f;
#pragma unroll
        for (int i = 0; i < 16; ++i) ss += v[i] * v[i];
        ss = wave_sum(ss);
        const float rstd = rsqrtf(ss * (1.f / 1024.f) + EPSV);
        if (mode == 1) {
            float* o = p.out + ((size_t)b * SEQL + (t - CTXL)) * DM;
#pragma unroll
            for (int i = 0; i < 4; ++i) {
                const int c = i * 256 + lane * 4;
                float4 g4 = *(const float4*)(g1 + c);
                float4 r4;
                r4.x = v[i * 4] * rstd * g4.x; r4.y = v[i * 4 + 1] * rstd * g4.y; r4.z = v[i * 4 + 2] * rstd * g4.z; r4.w = v[i * 4 + 3] * rstd * g4.w;
                *(float4*)(o + c) = r4;
            }
        } else {
            const float* md = WSF(OFF_MOD) + (size_t)(l * 9 + bi) * 6144 + (mode == 2 ? 3 * 1024 : 0);
            bf16_t* ho = HB + (size_t)row * DM;
#pragma unroll
            for (int i = 0; i < 4; ++i) {
                const int c = i * 256 + lane * 4;
                float4 g4 = *(const float4*)(g1 + c);
                float4 sh = *(const float4*)(md + c);
                float4 sc = *(const float4*)(md + 1024 + c);
                float h0 = v[i * 4] * rstd * g4.x * (1.f + sc.x) + sh.x;
                float h1 = v[i * 4 + 1] * rstd * g4.y * (1.f + sc.y) + sh.y;
                float h2 = v[i * 4 + 2] * rstd * g4.z * (1.f + sc.z) + sh.z;
                float h3 = v[i * 4 + 3] * rstd * g4.w * (1.f + sc.w) + sh.w;
                uint2 o2;
                o2.x = (unsigned)f2bf(h0) | ((unsigned)f2bf(h1) << 16);
                o2.y = (unsigned)f2bf(h2) | ((unsigned)f2bf(h3) << 16);
                *(uint2*)(ho + c) = o2;
            }
        }
    }
}

DEVI int fetch_task(int* ctr, unsigned char* smem) {
    __syncthreads();
    if (TIDX == 0) *(volatile int*)smem = atomicAdd(ctr, 1);
    __syncthreads();
    return *(volatile int*)smem;
}
DEVI void dep_signal(int* cnt) {
    asm volatile("s_waitcnt vmcnt(0)" ::: "memory");
    __syncthreads();
    if (TIDX == 0) {
        __builtin_amdgcn_fence(__ATOMIC_RELEASE, "agent");
        asm volatile("s_waitcnt vmcnt(0)" ::: "memory");
        __hip_atomic_fetch_add(cnt, 1, __ATOMIC_RELAXED, __HIP_MEMORY_SCOPE_AGENT);
    }
}
DEVI void dep_wait(int* cnt, int need) {
    if (TIDX == 0) {
        while (__hip_atomic_load(cnt, __ATOMIC_RELAXED, __HIP_MEMORY_SCOPE_AGENT) < need) __builtin_amdgcn_s_sleep(2);
        __builtin_amdgcn_fence(__ATOMIC_ACQUIRE, "agent");
        asm volatile("s_waitcnt vmcnt(0)" ::: "memory");
    }
    __syncthreads();
}

DEVI void phase_win(const Params& p, int l, unsigned char* smem) {
    bf16_t* ct = (bf16_t*)smem;
    const float* cs64 = WSF(OFF_R64);
    const float* cs32 = WSF(OFF_R32);
    int* ctr = WSI(OFF_CNT) + 134 + l;
    for (;;) {
        const int task = fetch_task(ctr, smem);
        if (task >= 144 * 30) break;
        const int mt = task / 30, nt = task % 30;
        const int row0 = mt * 128, b = mt / 18, t0 = (mt % 18) * 128;
        const bool lat = (mt % 18) >= 2;
        const int pos0 = t0 - CTXL;
        f32x4 acc[4][4];
        acc_zero<128>(acc);
        AOp A{HB, 1024, row0, nullptr};
        T_BEGIN(3);
        gemm_core<128>(acc, A, WB(W_IN + (size_t)l * 3840 * 1024 + (size_t)nt * 128 * 1024), 1024, 1024, smem);
        __syncthreads();
        T_END(3, l == 0 && BIDX == 8);
        T_BEGIN(4);
        acc_to_ct<128>(acc, ct);
        __syncthreads();
        if (nt < 2) ep_store_rows<128>(ct, 0, CB(C_CQ) + nt * 128, 256, row0);
        else if (nt == 2) ep_store_rows<128>(ct, 0, CB(C_CKV), 128, row0);
        else if (nt < 5) { ep_rope64(ct, nullptr, 1.f, lat, pos0, cs64); __syncthreads(); ep_store_rows<128>(ct, 0, CB(C_RQ) + (nt - 3) * 128, 256, row0); }
        else if (nt < 7) {
            ep_rope64(ct, nullptr, 0.125f, lat, pos0, cs64); __syncthreads();
            ep_store_rows<128>(ct, 0, CB(C_RK) + (nt - 5) * 128, 256, row0);
            ep_store_T(ct, 0, 128, CB(C_RKT) + ((size_t)b * 256 + (nt - 5) * 128) * TPB, TPB, t0);
        }
        else if (nt < 11) ep_store_T(ct, 0, 128, CB(C_RVT) + ((size_t)b * 4 + (nt - 7)) * 128 * TPB, TPB, t0);
        else if (nt < 15) ep_store_rows<128>(ct, 0, CB(C_RG) + (nt - 11) * 128, 512, row0);
        else if (nt < 19) ep_store_rows<128>(ct, 0, CB(C_LX) + (nt - 15) * 128, 512, row0);
        else if (nt < 23) ep_store_rows<128>(ct, 0, CB(C_LG) + (nt - 19) * 128, 512, row0);
        else if (nt < 27) { ep_rope64(ct, p.in[I_GQN] + l * 64, 0.125f * LOG2E, lat, pos0, cs64); __syncthreads(); ep_store_rows<128>(ct, 0, CB(C_GQ) + (nt - 23) * 128, 512, row0); }
        else if (nt == 27) { ep_rope64(ct, p.in[I_GKN] + l * 64, 1.f, lat, pos0, cs64); __syncthreads(); ep_store_rows<128>(ct, 0, CB(C_GK), 128, row0); }
        else if (nt == 28) ep_store_T(ct, 0, 128, CB(C_GVT) + (size_t)b * 128 * TPB, TPB, t0);
        else { ep_rope32(ct, 1, nullptr, 1.f, lat, pos0, cs32); __syncthreads(); ep_store_rows<32>(ct, 0, CB(C_KR), 32, row0); }
        __syncthreads();
        T_END(4, l == 0 && BIDX == 8);
    }
}

DEVI float ret_lg2(const Params& p, int l, int dir, int h) { return -log1pf(expf(-p.in[I_RDEC][l * 8 + dir * 4 + h])) * LOG2E; }
DEVI void ret_chunk_U(const Params& p, int l, int task) {
    const int b = task / 72, r = task % 72, h = r / 18, m = r % 18;
    const int tid = TIDX, lane = tid & 63, w = tid >> 6, qc = lane & 31, hh = lane >> 5;
    const int t0 = m * 128;
    const bf16_t* KTg = CB(C_RKT) + ((size_t)b * 4 + h) * 64 * TPB + t0 + 8 * hh;
    const bf16_t* VTg = CB(C_RVT) + (((size_t)b * 4 + h) * 128 + w * 32 + qc) * TPB + t0 + 8 * hh;
    bf16x8 vf[8], ka[2][8];
#pragma unroll
    for (int ks = 0; ks < 8; ++ks) vf[ks] = *(const bf16x8*)(VTg + ks * 16);
#pragma unroll
    for (int sub = 0; sub < 2; ++sub)
#pragma unroll
        for (int ks = 0; ks < 8; ++ks) ka[sub][ks] = *(const bf16x8*)(KTg + (size_t)(32 * sub + qc) * TPB + ks * 16);
#pragma unroll
    for (int dir = 0; dir < 2; ++dir) {
        const float lg2 = ret_lg2(p, l, dir, h);
        f32x16 U0, U1;
#pragma unroll
        for (int rr = 0; rr < 16; ++rr) { U0[rr] = 0.f; U1[rr] = 0.f; }
#pragma unroll
        for (int ks = 0; ks < 8; ++ks) {
            bf16x8 vs;
#pragma unroll
            for (int e = 0; e < 8; ++e) {
                const int j = 16 * ks + 8 * hh + e;
                const float kd = __builtin_amdgcn_exp2f(lg2 * (float)(dir == 0 ? 127 - j : j));
                vs[e] = (short)f2bf(bf2f((bf16_t)vf[ks][e]) * kd);
            }
            U0 = __builtin_amdgcn_mfma_f32_32x32x16_bf16(ka[0][ks], vs, U0, 0, 0, 0);
            U1 = __builtin_amdgcn_mfma_f32_32x32x16_bf16(ka[1][ks], vs, U1, 0, 0, 0);
        }
        bf16_t* up = DB(D_OB) + ((((size_t)(b * 4 + h) * 18 + m) * 2 + dir) * 128) * 64 + (size_t)(32 * w + qc) * 8 + 4 * hh;
#pragma unroll
        for (int g = 0; g < 4; ++g) {
            bf16x4 a, c;
#pragma unroll
            for (int e = 0; e < 4; ++e) { a[e] = (short)f2bf(U0[4 * g + e]); c[e] = (short)f2bf(U1[4 * g + e]); }
            *(bf16x4*)(up + (((g >> 1) * 2 + (g & 1)) * 128) * 8) = a;
            *(bf16x4*)(up + (((2 + (g >> 1)) * 2 + (g & 1)) * 128) * 8) = c;
        }
    }
}
DEVI void ret_out_task(const Params& p, int l, int b, int h, int m, unsigned char* smem) {
    constexpr int PLD = 136;
    bf16_t* P = (bf16_t*)smem;
    float* red = (float*)(smem + 34816);
    const int tid = TIDX, lane = tid & 63, w = tid >> 6, qc = lane & 31, hh = lane >> 5;
    const int t0 = m * 128, iq = 32 * w + qc;
    const float lgf = ret_lg2(p, l, 0, h), lgb = ret_lg2(p, l, 1, h);
    const float cdf = exp2f(lgf * 128.f), cdb = exp2f(lgb * 128.f);
    bf16x8 sff[4], sfb[4];
    {
        float Sf[4][8], Sb[4][8];
#pragma unroll
        for (int ks = 0; ks < 4; ++ks)
#pragma unroll
            for (int e = 0; e < 8; ++e) { Sf[ks][e] = 0.f; Sb[ks][e] = 0.f; }
        const bf16_t* Ub = DB(D_OB) + (size_t)(b * 4 + h) * 18 * 2 * 128 * 64 + (size_t)(hh * 128 + 32 * w + qc) * 8;
        const int pos = m < 2 ? 1 - m : 19 - m;
        const int nf4 = (m + 3) & ~3, nb4 = (pos + 3) & ~3;
        for (int c0 = 0; c0 < nf4; c0 += 4) {
            bf16x8 u[4][4]; float wg[4];
#pragma unroll
            for (int q = 0; q < 4; ++q) {
                const int c = c0 + q, cl = c < m ? c : 0;
                wg[q] = c < m ? __builtin_amdgcn_exp2f(lgf * 128.f * (float)(m - 1 - c)) : 0.f;
                const bf16_t* up = Ub + (size_t)(cl * 2 + 0) * 128 * 64;
#pragma unroll
                for (int ks = 0; ks < 4; ++ks) u[q][ks] = *(const bf16x8*)(up + ks * 2048);
            }
#pragma unroll
            for (int q = 0; q < 4; ++q)
#pragma unroll
                for (int ks = 0; ks < 4; ++ks)
#pragma unroll
                    for (int e = 0; e < 8; ++e) Sf[ks][e] += wg[q] * bf2f((bf16_t)u[q][ks][e]);
        }
        for (int c0 = 0; c0 < nb4; c0 += 4) {
            bf16x8 u[4][4]; float wg[4];
#pragma unroll
            for (int q = 0; q < 4; ++q) {
                const int cc = c0 + q, ccl = cc < pos ? cc : 0;
                const int c = ccl < 2 ? 1 - ccl : 19 - ccl;
                wg[q] = cc < pos ? __builtin_amdgcn_exp2f(lgb * 128.f * (float)(pos - 1 - cc)) : 0.f;
                const bf16_t* up = Ub + (size_t)(c * 2 + 1) * 128 * 64;
#pragma unroll
                for (int ks = 0; ks < 4; ++ks) u[q][ks] = *(const bf16x8*)(up + ks * 2048);
            }
#pragma unroll
            for (int q = 0; q < 4; ++q)
#pragma unroll
                for (int ks = 0; ks < 4; ++ks)
#pragma unroll
                    for (int e = 0; e < 8; ++e) Sb[ks][e] += wg[q] * bf2f((bf16_t)u[q][ks][e]);
        }
#pragma unroll
        for (int ks = 0; ks < 4; ++ks)
#pragma unroll
            for (int e = 0; e < 8; ++e) { sff[ks][e] = (short)f2bf(Sf[ks][e]); sfb[ks][e] = (short)f2bf(Sb[ks][e]); }
    }
    const bf16_t* Kg = CB(C_RK) + ((size_t)b * TPB + t0) * 256 + h * 64 + 8 * hh;
    const bf16_t* Qg = CB(C_RQ) + ((size_t)b * TPB + t0) * 256 + h * 64 + 8 * hh;
    const bf16_t* VTg = CB(C_RVT) + (((size_t)b * 4 + h) * 128 + w * 32 + qc) * TPB + t0 + 8 * hh;
    bf16x8 vf[8];
#pragma unroll
    for (int ks = 0; ks < 8; ++ks) vf[ks] = *(const bf16x8*)(VTg + ks * 16);
    {
        bf16x8 qf[4], ka[4][4];
#pragma unroll
        for (int ks = 0; ks < 4; ++ks) qf[ks] = *(const bf16x8*)(Qg + (size_t)iq * 256 + ks * 16);
#pragma unroll
        for (int js = 0; js < 4; ++js)
#pragma unroll
            for (int ks = 0; ks < 4; ++ks) ka[js][ks] = *(const bf16x8*)(Kg + (size_t)(32 * js + qc) * 256 + ks * 16);
        __syncthreads();
#pragma unroll
        for (int js = 0; js < 4; ++js) {
            f32x16 sc;
#pragma unroll
            for (int r = 0; r < 16; ++r) sc[r] = 0.f;
#pragma unroll
            for (int ks = 0; ks < 4; ++ks) sc = __builtin_amdgcn_mfma_f32_32x32x16_bf16(ka[js][ks], qf[ks], sc, 0, 0, 0);
#pragma unroll
            for (int g = 0; g < 4; ++g) {
                bf16x4 pk;
#pragma unroll
                for (int e = 0; e < 4; ++e) {
                    const int d = iq - (32 * js + 8 * g + 4 * hh + e);
                    const float wgt = d >= 0 ? __builtin_amdgcn_exp2f(lgf * (float)d) : __builtin_amdgcn_exp2f(lgb * (float)(-d));
                    pk[e] = (short)f2bf(sc[4 * g + e] * wgt);
                }
                *(bf16x4*)(P + iq * PLD + 32 * js + 8 * g + 4 * hh) = pk;
            }
        }
    }
    bf16x8 qa[4];
#pragma unroll
    for (int ks = 0; ks < 4; ++ks) qa[ks] = *(const bf16x8*)(Qg + (size_t)qc * 256 + ks * 16);
    __syncthreads();
    f32x16 o[4];
#pragma unroll
    for (int isub = 0; isub < 4; ++isub) {
        const int ii = 32 * isub + qc;
        bf16x8 qn[4];
        if (isub < 3) {
#pragma unroll
            for (int ks = 0; ks < 4; ++ks) qn[ks] = *(const bf16x8*)(Qg + (size_t)(ii + 32) * 256 + ks * 16);
        }
#pragma unroll
        for (int r = 0; r < 16; ++r) o[isub][r] = 0.f;
#pragma unroll
        for (int ks = 0; ks < 4; ++ks) o[isub] = __builtin_amdgcn_mfma_f32_32x32x16_bf16(sff[ks], qa[ks], o[isub], 0, 0, 0);
        const float qdf = __builtin_amdgcn_exp2f(lgf * (float)(ii + 1)), qdb = __builtin_amdgcn_exp2f(lgb * (float)(128 - ii));
        const float rat = qdf / qdb;
#pragma unroll
        for (int r = 0; r < 16; ++r) o[isub][r] *= rat;
#pragma unroll
        for (int ks = 0; ks < 4; ++ks) o[isub] = __builtin_amdgcn_mfma_f32_32x32x16_bf16(sfb[ks], qa[ks], o[isub], 0, 0, 0);
#pragma unroll
        for (int r = 0; r < 16; ++r) o[isub][r] *= qdb;
#pragma unroll
        for (int ks = 0; ks < 8; ++ks) {
            bf16x8 pf = *(const bf16x8*)(P + ii * PLD + 16 * ks + 8 * hh);
            o[isub] = __builtin_amdgcn_mfma_f32_32x32x16_bf16(vf[ks], pf, o[isub], 0, 0, 0);
        }
        float s1 = 0.f, s2 = 0.f;
#pragma unroll
        for (int r = 0; r < 16; ++r) { s1 += o[isub][r]; s2 += o[isub][r] * o[isub][r]; }
        s1 += __shfl_xor(s1, 32); s2 += __shfl_xor(s2, 32);
        if (hh == 0) { red[(w * 128 + ii) * 2] = s1; red[(w * 128 + ii) * 2 + 1] = s2; }
        if (isub < 3) {
#pragma unroll
            for (int ks = 0; ks < 4; ++ks) qa[ks] = qn[ks];
        }
    }
    __syncthreads();
    const float* gn = p.in[I_RNORM] + l * 512 + h * 128 + 32 * w + 4 * hh;
    float gnv[16];
#pragma unroll
    for (int g = 0; g < 4; ++g)
#pragma unroll
        for (int e = 0; e < 4; ++e) gnv[4 * g + e] = gn[8 * g + e];
#pragma unroll
    for (int isub = 0; isub < 4; ++isub) {
        const int ii = 32 * isub + qc;
        float t1 = 0.f, t2 = 0.f;
#pragma unroll
        for (int ww = 0; ww < 4; ++ww) { t1 += red[(ww * 128 + ii) * 2]; t2 += red[(ww * 128 + ii) * 2 + 1]; }
        const float mu = t1 * (1.f / 128.f);
        const float rs = rsqrtf(fmaxf(t2 * (1.f / 128.f) - mu * mu, 0.f) + EPSV);
#pragma unroll
        for (int g = 0; g < 4; ++g) {
            bf16x4 ov;
#pragma unroll
            for (int e = 0; e < 4; ++e) ov[e] = (short)f2bf((o[isub][4 * g + e] - mu) * rs * gnv[4 * g + e]);
            *(bf16x4*)(P + ii * PLD + 32 * w + 8 * g + 4 * hh) = ov;
        }
    }
    __syncthreads();
#pragma unroll
    for (int k = 0; k < 8; ++k) {
        const int c = tid + 256 * k, row = c >> 4, ch = c & 15;
        const size_t ro = ((size_t)b * TPB + t0 + row) * 512 + h * 128 + ch * 8;
        const bf16x8 nv = *(const bf16x8*)(P + row * PLD + ch * 8);
        const bf16x8 gt = *(const bf16x8*)(CB(C_RG) + ro);
        bf16x8 ov;
#pragma unroll
        for (int e = 0; e < 8; ++e) ov[e] = (short)f2bf(siluf_(bf2f((bf16_t)gt[e])) * bf2f((bf16_t)nv[e]));
        *(bf16x8*)(DB(D_OF) + ro) = ov;
    }
}

DEVI void h_to_fp8(const Params& p, int mt) {
    const int lane = TIDX & 63, w = TIDX >> 6;
    for (int i = 0; i < 32; ++i) {
        const size_t row = (size_t)mt * 128 + w * 32 + i;
        const bf16x8 a = *(const bf16x8*)(HB + row * 1024 + lane * 16), b = *(const bf16x8*)(HB + row * 1024 + lane * 16 + 8);
        i32x4 o;
        o[0] = pk4_fp8(bf2f((bf16_t)a[0]), bf2f((bf16_t)a[1]), bf2f((bf16_t)a[2]), bf2f((bf16_t)a[3]));
        o[1] = pk4_fp8(bf2f((bf16_t)a[4]), bf2f((bf16_t)a[5]), bf2f((bf16_t)a[6]), bf2f((bf16_t)a[7]));
        o[2] = pk4_fp8(bf2f((bf16_t)b[0]), bf2f((bf16_t)b[1]), bf2f((bf16_t)b[2]), bf2f((bf16_t)b[3]));
        o[3] = pk4_fp8(bf2f((bf16_t)b[4]), bf2f((bf16_t)b[5]), bf2f((bf16_t)b[6]), bf2f((bf16_t)b[7]));
        asm volatile("s_waitcnt vmcnt(0)" ::: "memory");
        *(i32x4*)((unsigned char*)HB + row * 2048 + lane * 16) = o;
    }
}
DEVI void phase_mla_up(const Params& p, int l, unsigned char* smem) {
    bf16_t* ct = (bf16_t*)smem;
    float* rstd = (float*)(smem + AUX_OFF);
    const float* cs32 = WSF(OFF_R32);
    const float qscale = 0.10206207261596575f * LOG2E;
    const int nq = (l == 0 ? 144 : 128) * 6;
    const int nkv = 144 * 8;
    for (int tile = BIDX; tile < nq + nkv + 576 + 144; tile += gridDim.x) {
        if (tile >= nq + nkv + 576) { h_to_fp8(p, tile - nq - nkv - 576); continue; }
        if (tile >= nq + nkv) { ret_chunk_U(p, l, tile - nq - nkv); continue; }
        if (tile < nq) {
            const int mt = mt_of(tile / 6, l != 0), nt = tile % 6;
            const int row0 = mt * 128, t0 = (mt % 18) * 128;
            const bool lat = (mt % 18) >= 2;
            f32x4 acc[4][4];
            acc_zero<128>(acc);
            AOp A{CB(C_CQ), 256, row0, nullptr};
            gemm_core<128>(acc, A, WB(W_UQ + (size_t)l * 768 * 256 + (size_t)nt * 128 * 256), 256, 256, smem);
            __syncthreads();
            acc_to_ct<128>(acc, ct);
            ep_rstd(CB(C_CQ), 256, row0, 256, rstd);
            __syncthreads();
            if (nt < 4) {
                ep_scale_rows(ct, 0, 128, rstd, qscale); __syncthreads();
                ep_store_rows<64>(ct, 0, CB(C_MQ) + (nt * 2) * 96, 768, row0);
                ep_store_rows<64>(ct, 64, CB(C_MQ) + (nt * 2 + 1) * 96, 768, row0);
            } else {
                ep_rope32(ct, 4, rstd, qscale, lat, t0 - CTXL, cs32); __syncthreads();
#pragma unroll
                for (int g = 0; g < 4; ++g) ep_store_rows<32>(ct, g * 32, CB(C_MQ) + ((nt - 4) * 4 + g) * 96 + 64, 768, row0);
            }
            __syncthreads();
        } else {
            const int tk = tile - nq;
            const int mt = tk / 8, nt = tk % 8;
            const int row0 = mt * 128, b = mt / 18, t0 = (mt % 18) * 128;
            f32x4 acc[4][4];
            acc_zero<128>(acc);
            AOp A{CB(C_CKV), 128, row0, nullptr};
            gemm_core<128>(acc, A, WB(W_UKV + (size_t)l * 1024 * 128 + (size_t)nt * 128 * 128), 128, 128, smem);
            __syncthreads();
            acc_to_ct<128>(acc, ct);
            ep_rstd(CB(C_CKV), 128, row0, 128, rstd);
            __syncthreads();
            ep_scale_rows(ct, 0, 128, rstd, 1.f); __syncthreads();
            ep_store_rows<64>(ct, 0, CB(C_KN) + nt * 64, 512, row0);
            ep_store_T(ct, 64, 64, CB(C_VMT) + ((size_t)b * 8 + nt) * 64 * TPB, TPB, t0);
            __syncthreads();
        }
    }
}

template <int DK, bool MLA>
DEVI void attn_naive_wave(const Params& p, int b, int t0, int hq) {
    const int lane = TIDX & 63;
    const int t = t0 + lane, row = b * TPB + t;
    const int nkeys = (t0 < CTXL) ? CTXL : TPB;
    float q[DK];
    const bf16_t* qp = MLA ? CB(C_MQ) + (size_t)row * 768 + hq * 96 : CB(C_GQ) + (size_t)row * 512 + hq * 64;
#pragma unroll
    for (int c = 0; c < DK / 8; ++c) {
        bf16x8 tq = *(const bf16x8*)(qp + c * 8);
#pragma unroll
        for (int e = 0; e < 8; ++e) q[c * 8 + e] = bf2f((bf16_t)tq[e]);
    }
    float acc[64];
#pragma unroll
    for (int d = 0; d < 64; ++d) acc[d] = 0.f;
    float m = -1e30f, lsum = 0.f;
    const int hk = MLA ? hq : (hq >> 2);
    const bf16_t* vT = MLA ? CB(C_VMT) + ((size_t)b * 8 + hk) * 64 * TPB : CB(C_GVT) + ((size_t)b * 2 + hk) * 64 * TPB;
    for (int kt = 0; kt < nkeys; ++kt) {
        const size_t krow = (size_t)b * TPB + kt;
        float s = 0.f;
        const bf16_t* kp = MLA ? CB(C_KN) + krow * 512 + hk * 64 : CB(C_GK) + krow * 128 + hk * 64;
#pragma unroll
        for (int c = 0; c < 8; ++c) {
            bf16x8 tk = *(const bf16x8*)(kp + c * 8);
#pragma unroll
            for (int e = 0; e < 8; ++e) s += q[c * 8 + e] * bf2f((bf16_t)tk[e]);
        }
        if (MLA) {
            const bf16_t* rp = CB(C_KR) + krow * 32;
#pragma unroll
            for (int c = 0; c < 4; ++c) {
                bf16x8 tk = *(const bf16x8*)(rp + c * 8);
#pragma unroll
                for (int e = 0; e < 8; ++e) s += q[(DK - 32) + c * 8 + e] * bf2f((bf16_t)tk[e]);
            }
        }
        const float mn = fmaxf(m, s);
        const float alpha = exp2f(m - mn), pp = exp2f(s - mn);
        lsum = lsum * alpha + pp;
#pragma unroll
        for (int d = 0; d < 64; ++d) acc[d] = acc[d] * alpha + pp * bf2f(vT[(size_t)d * TPB + kt]);
        m = mn;
    }
    const float inv = 1.f / lsum;
    bf16_t* op = (MLA ? DB(D_YA) : DB(D_YD)) + (size_t)row * 512 + hq * 64;
#pragma unroll
    for (int c = 0; c < 8; ++c) {
        bf16x8 o;
#pragma unroll
        for (int e = 0; e < 8; ++e) o[e] = (short)f2bf(acc[c * 8 + e] * inv);
        *(bf16x8*)(op + c * 8) = o;
    }
}


template <int DK, bool MLA>
DEVI void attn_task(const Params& p, int b, int hsel, int tq0, int nkeys, unsigned char* smem) {
    constexpr int KLD = DK + 8;
    constexpr int CK = DK / 8;
    constexpr int NKC = 64 * CK / 256;
    constexpr int VLD = 68;
    constexpr int KBYTES = 64 * KLD * 2, VBYTES = 64 * VLD * 2;
    constexpr int VOFF = 2 * KBYTES;
    static_assert(2 * (KBYTES + VBYTES) <= 60000, "attn lds");
    const int tid = TIDX, lane = tid & 63, w = tid >> 6, qc = lane & 31, hh = lane >> 5;
    const int tq = MLA ? tq0 + w * 32 + qc : tq0 + qc;
    const int hq = MLA ? hsel : hsel * 4 + w;
    const size_t qrow = (size_t)b * TPB + tq;
    const bf16_t* qp = MLA ? CB(C_MQ) + qrow * 768 + hq * 96 : CB(C_GQ) + qrow * 512 + hq * 64;
    bf16x8 qf[DK / 16];
#pragma unroll
    for (int ks = 0; ks < DK / 16; ++ks) qf[ks] = *(const bf16x8*)(qp + ks * 16 + hh * 8);
    const bf16_t* ksrc[NKC]; int kstep[NKC], kdst[NKC];
#pragma unroll
    for (int i = 0; i < NKC; ++i) {
        const int q = tid + 256 * i, key = q / CK, ch = q % CK;
        if (MLA) {
            if (ch < 8) { ksrc[i] = CB(C_KN) + ((size_t)b * TPB + key) * 512 + hsel * 64 + ch * 8; kstep[i] = 64 * 512; }
            else { ksrc[i] = CB(C_KR) + ((size_t)b * TPB + key) * 32 + (ch - 8) * 8; kstep[i] = 64 * 32; }
        } else { ksrc[i] = CB(C_GK) + ((size_t)b * TPB + key) * 128 + hsel * 64 + ch * 8; kstep[i] = 64 * 128; }
        kdst[i] = (key * KLD + ch * 8) * 2;
    }
    const bf16_t* vT = MLA ? CB(C_VMT) + ((size_t)b * 8 + hsel) * 64 * TPB : CB(C_GVT) + ((size_t)b * 2 + hsel) * 64 * TPB;
    const bf16_t* vsrc[2]; int vdst[2];
#pragma unroll
    for (int i = 0; i < 2; ++i) {
        const int q = tid + 256 * i, dv = q >> 3, ch = q & 7;
        vsrc[i] = vT + (size_t)dv * TPB + ch * 8;
        vdst[i] = VOFF + (dv * VLD + ch * 8) * 2;
    }
    const int nt = nkeys >> 6;
    bf16x8 kr[NKC], vr[2];
#pragma unroll
    for (int i = 0; i < NKC; ++i) kr[i] = *(const bf16x8*)(ksrc[i]);
#pragma unroll
    for (int i = 0; i < 2; ++i) vr[i] = *(const bf16x8*)(vsrc[i]);
    __syncthreads();
#pragma unroll
    for (int i = 0; i < NKC; ++i) *(bf16x8*)(smem + kdst[i]) = kr[i];
#pragma unroll
    for (int i = 0; i < 2; ++i) {
        *(bf16x4*)(smem + vdst[i]) = bf16x4{vr[i][0], vr[i][1], vr[i][2], vr[i][3]};
        *(bf16x4*)(smem + vdst[i] + 8) = bf16x4{vr[i][4], vr[i][5], vr[i][6], vr[i][7]};
    }
#pragma unroll
    for (int i = 0; i < NKC; ++i) kr[i] = *(const bf16x8*)(ksrc[i] + (size_t)kstep[i]);
    __syncthreads();
    f32x16 s0, s1;
#pragma unroll
    for (int r = 0; r < 16; ++r) { s0[r] = 0.f; s1[r] = 0.f; }
#pragma unroll
    for (int ks = 0; ks < DK / 16; ++ks) {
        bf16x8 a0 = *(const bf16x8*)(smem + (qc * KLD + ks * 16 + hh * 8) * 2);
        bf16x8 a1 = *(const bf16x8*)(smem + ((32 + qc) * KLD + ks * 16 + hh * 8) * 2);
        s0 = __builtin_amdgcn_mfma_f32_32x32x16_bf16(a0, qf[ks], s0, 0, 0, 0);
        s1 = __builtin_amdgcn_mfma_f32_32x32x16_bf16(a1, qf[ks], s1, 0, 0, 0);
    }
#pragma unroll
    for (int i = 0; i < NKC; ++i) *(bf16x8*)(smem + KBYTES + kdst[i]) = kr[i];
    f32x16 o0, o1;
#pragma unroll
    for (int r = 0; r < 16; ++r) { o0[r] = 0.f; o1[r] = 0.f; }
    float m = -1e30f, lsum = 0.f;
    for (int it = 0; it < nt; ++it) {
        __syncthreads();
        if (it + 2 < nt) {
#pragma unroll
            for (int i = 0; i < NKC; ++i) kr[i] = *(const bf16x8*)(ksrc[i] + (size_t)(it + 2) * kstep[i]);
        }
        if (it + 1 < nt) {
#pragma unroll
            for (int i = 0; i < 2; ++i) vr[i] = *(const bf16x8*)(vsrc[i] + (it + 1) * 64);
        }
        f32x16 n0, n1;
#pragma unroll
        for (int r = 0; r < 16; ++r) { n0[r] = 0.f; n1[r] = 0.f; }
        if (it + 1 < nt) {
            const unsigned char* ck = smem + ((it + 1) & 1) * KBYTES;
#pragma unroll
            for (int ks = 0; ks < DK / 16; ++ks) {
                bf16x8 a0 = *(const bf16x8*)(ck + (qc * KLD + ks * 16 + hh * 8) * 2);
                bf16x8 a1 = *(const bf16x8*)(ck + ((32 + qc) * KLD + ks * 16 + hh * 8) * 2);
                n0 = __builtin_amdgcn_mfma_f32_32x32x16_bf16(a0, qf[ks], n0, 0, 0, 0);
                n1 = __builtin_amdgcn_mfma_f32_32x32x16_bf16(a1, qf[ks], n1, 0, 0, 0);
            }
        }
        float mx = s0[0];
#pragma unroll
        for (int r = 1; r < 16; ++r) mx = fmaxf(mx, s0[r]);
#pragma unroll
        for (int r = 0; r < 16; ++r) mx = fmaxf(mx, s1[r]);
        mx = fmaxf(mx, __shfl_xor(mx, 32));
        if (!__all(mx <= m + 6.f)) {
            const float mn = fmaxf(m, mx);
            const float alpha = __builtin_amdgcn_exp2f(m - mn);
            m = mn;
            lsum *= alpha;
#pragma unroll
            for (int r = 0; r < 16; ++r) { o0[r] *= alpha; o1[r] *= alpha; }
        }
        float ps = 0.f;
#pragma unroll
        for (int r = 0; r < 16; ++r) { s0[r] = __builtin_amdgcn_exp2f(s0[r] - m); ps += s0[r]; }
#pragma unroll
        for (int r = 0; r < 16; ++r) { s1[r] = __builtin_amdgcn_exp2f(s1[r] - m); ps += s1[r]; }
        lsum += ps;
        bf16x8 pf[2][2];
#pragma unroll
        for (int s = 0; s < 2; ++s)
#pragma unroll
            for (int j = 0; j < 8; ++j) { pf[0][s][j] = (short)f2bf(s0[8 * s + j]); pf[1][s][j] = (short)f2bf(s1[8 * s + j]); }
        const unsigned char* cv = smem + VOFF + (it & 1) * VBYTES;
#pragma unroll
        for (int a = 0; a < 2; ++a)
#pragma unroll
            for (int s = 0; s < 2; ++s) {
                const int keyoff = a * 32 + 16 * s + 4 * hh;
                bf16x4 l0 = *(const bf16x4*)(cv + (qc * VLD + keyoff) * 2);
                bf16x4 h0 = *(const bf16x4*)(cv + (qc * VLD + keyoff + 8) * 2);
                bf16x4 l1 = *(const bf16x4*)(cv + ((32 + qc) * VLD + keyoff) * 2);
                bf16x4 h1 = *(const bf16x4*)(cv + ((32 + qc) * VLD + keyoff + 8) * 2);
                bf16x8 v0 = bf16x8{l0[0], l0[1], l0[2], l0[3], h0[0], h0[1], h0[2], h0[3]};
                bf16x8 v1 = bf16x8{l1[0], l1[1], l1[2], l1[3], h1[0], h1[1], h1[2], h1[3]};
                o0 = __builtin_amdgcn_mfma_f32_32x32x16_bf16(v0, pf[a][s], o0, 0, 0, 0);
                o1 = __builtin_amdgcn_mfma_f32_32x32x16_bf16(v1, pf[a][s], o1, 0, 0, 0);
            }
        if (it + 2 < nt) {
            unsigned char* nk = smem + (it & 1) * KBYTES;
#pragma unroll
            for (int i = 0; i < NKC; ++i) *(bf16x8*)(nk + kdst[i]) = kr[i];
        }
        if (it + 1 < nt) {
            unsigned char* nv = smem + ((it + 1) & 1) * VBYTES;
#pragma unroll
            for (int i = 0; i < 2; ++i) {
                *(bf16x4*)(nv + vdst[i]) = bf16x4{vr[i][0], vr[i][1], vr[i][2], vr[i][3]};
                *(bf16x4*)(nv + vdst[i] + 8) = bf16x4{vr[i][4], vr[i][5], vr[i][6], vr[i][7]};
            }
        }
        s0 = n0; s1 = n1;
    }
    lsum += __shfl_xor(lsum, 32);
    const float inv = 1.f / lsum;
    bf16_t* op = (MLA ? DB(D_YA) : DB(D_YD)) + qrow * 512 + hq * 64;
#pragma unroll
    for (int g = 0; g < 4; ++g) {
        bf16x4 a, c;
#pragma unroll
        for (int e = 0; e < 4; ++e) { a[e] = (short)f2bf(o0[g * 4 + e] * inv); c[e] = (short)f2bf(o1[g * 4 + e] * inv); }
        *(bf16x4*)(op + 8 * g + 4 * hh) = a;
        *(bf16x4*)(op + 32 + 8 * g + 4 * hh) = c;
    }
}

DEVI int proc_tok(int dir, int pidx) { return dir == 0 ? pidx : (pidx < CTXL ? CTXL - 1 - pidx : (CTXL + TPB - 1) - pidx); }

DEVI void retention_naive(const Params& p, int l, int task) {
    const int b = task >> 2, h = task & 3;
    const int dir = TIDX >> 7, dv = TIDX & 127;
    const float dec = p.in[I_RDEC][l * 8 + dir * 4 + h];
    const float lg = -log1pf(expf(-dec));
    const float g = expf(lg);
    float S[64];
#pragma unroll
    for (int d = 0; d < 64; ++d) S[d] = 0.f;
    const bf16_t* vT = CB(C_RVT) + (((size_t)b * 4 + h) * 128 + dv) * TPB;
    bf16_t* outp = (dir == 0 ? DB(D_OF) : DB(D_OB));
    for (int pi = 0; pi < TPB; ++pi) {
        const int u = proc_tok(dir, pi);
        const size_t row = (size_t)b * TPB + u;
        const bf16_t* qp = CB(C_RQ) + row * 256 + h * 64;
        const bf16_t* kp = CB(C_RK) + row * 256 + h * 64;
        const float v = bf2f(vT[u]);
        float o = 0.f;
#pragma unroll
        for (int c = 0; c < 8; ++c) {
            bf16x8 tq = *(const bf16x8*)(qp + c * 8);
            bf16x8 tk = *(const bf16x8*)(kp + c * 8);
#pragma unroll
            for (int e = 0; e < 8; ++e) {
                const int d = c * 8 + e;
                const float qd = bf2f((bf16_t)tq[e]), kd = bf2f((bf16_t)tk[e]);
                if (dir == 0) { S[d] = g * S[d] + kd * v; o += qd * S[d]; }
                else { S[d] = g * S[d]; o += qd * S[d]; S[d] += kd * v; }
            }
        }
        outp[row * 512 + h * 128 + dv] = f2bf(o);
    }
}

DEVI void lru_naive_wave(const Params& p, int l, int task) {
    const int lane = TIDX & 63;
    const int b = task >> 4, d = (task >> 3) & 1, blk = task & 7;
    const int ch = blk * 64 + lane;
    float cw[4];
#pragma unroll
    for (int j = 0; j < 4; ++j) cw[j] = p.in[I_LCW][(l * 4 + j) * 512 + ch];
    const float cb = p.in[I_LCB][l * 512 + ch];
    const float ba = p.in[I_LBA][(l * 2 + d) * 512 + ch], bx = p.in[I_LBX][(l * 2 + d) * 512 + ch];
    const float lam = p.in[I_LLAM][(l * 2 + d) * 512 + ch];
    const float sp = log1pf(expf(-lam));
    const float* Wa = p.in[I_LWA] + ((size_t)(l * 2 + d) * 8 + blk) * 4096;
    const float* Wx = p.in[I_LWX] + ((size_t)(l * 2 + d) * 8 + blk) * 4096;
    float h = 0.f;
    bf16_t* outp = (d == 0 ? DB(D_LH0) : DB(D_LH1));
    for (int pi = 0; pi < TPB; ++pi) {
        const int u = proc_tok(d, pi);
        const int lo = u < CTXL ? 0 : CTXL, hi = u < CTXL ? CTXL : TPB;
        const size_t row = (size_t)b * TPB + u;
        float uval = cb;
#pragma unroll
        for (int j = 0; j < 4; ++j) {
            const int tt = u - 2 + j;
            if (tt >= lo && tt < hi) uval += cw[j] * bf2f(CB(C_LX)[((size_t)b * TPB + tt) * 512 + ch]);
        }
        float rp = 0.f, ip = 0.f;
        for (int c = 0; c < 64; ++c) {
            const float uc = __shfl(uval, c);
            rp += uc * Wa[c * 64 + lane];
            ip += uc * Wx[c * 64 + lane];
        }
        const float r = sigmoidf_(rp + ba), ig = sigmoidf_(ip + bx);
        const float la = -8.f * r * sp;
        const float a = expf(la);
        const float bb = sqrtf(-expm1f(2.f * la)) * (ig * uval);
        h = a * h + bb;
        outp[row * 512 + ch] = f2bf(h);
    }
}


DEVI void retention_walk(const Params& p, int l, int task, unsigned char* smem) {
    constexpr int PLD = 136;
    const int b = task >> 3, h = (task >> 1) & 3, dir = task & 1;
    const int tid = TIDX, lane = tid & 63, w = tid >> 6, qc = lane & 31, hh = lane >> 5;
    const float dec = p.in[I_RDEC][l * 8 + dir * 4 + h];
    const float lg2 = -log1pf(expf(-dec)) * LOG2E;
    const float cdec = exp2f(lg2 * 128.f);
    bf16_t* P = (bf16_t*)smem;
    f32x16 S0, S1;
#pragma unroll
    for (int r = 0; r < 16; ++r) { S0[r] = 0.f; S1[r] = 0.f; }
    const bf16_t* Kg = CB(C_RK) + (size_t)b * TPB * 256 + h * 64;
    const bf16_t* Qg = CB(C_RQ) + (size_t)b * TPB * 256 + h * 64;
    const bf16_t* KTg = CB(C_RKT) + ((size_t)b * 4 + h) * 64 * TPB;
    const bf16_t* VTg = CB(C_RVT) + (((size_t)b * 4 + h) * 128 + w * 32 + qc) * TPB;
    bf16_t* outp = (dir == 0 ? DB(D_OF) : DB(D_OB)) + (size_t)b * TPB * 512 + h * 128 + w * 32;
    const int iq = 32 * w + qc;
    for (int cc = 0; cc < 18; ++cc) {
        const int mch = dir == 0 ? cc : (cc < 2 ? 1 - cc : 19 - cc);
        const int t0 = mch * 128;
        bf16x8 vf[8];
#pragma unroll
        for (int ks = 0; ks < 8; ++ks) vf[ks] = *(const bf16x8*)(VTg + t0 + ks * 16 + hh * 8);
        bf16x8 qf[4];
        {
            const bf16_t* qrow = Qg + (size_t)(t0 + iq) * 256;
#pragma unroll
            for (int ks = 0; ks < 4; ++ks) qf[ks] = *(const bf16x8*)(qrow + ks * 16 + hh * 8);
        }
        __syncthreads();
#pragma unroll 1
        for (int js = 0; js < 4; ++js) {
            f32x16 sc;
#pragma unroll
            for (int r = 0; r < 16; ++r) sc[r] = 0.f;
            const bf16_t* krow = Kg + (size_t)(t0 + 32 * js + qc) * 256;
#pragma unroll
            for (int ks = 0; ks < 4; ++ks) {
                bf16x8 a = *(const bf16x8*)(krow + ks * 16 + hh * 8);
                sc = __builtin_amdgcn_mfma_f32_32x32x16_bf16(a, qf[ks], sc, 0, 0, 0);
            }
#pragma unroll
            for (int g = 0; g < 4; ++g) {
                bf16x4 pk;
#pragma unroll
                for (int e = 0; e < 4; ++e) {
                    const int j = 32 * js + 8 * g + 4 * hh + e;
                    const int d = iq - j;
                    float wgt;
                    if (dir == 0) wgt = d >= 0 ? __builtin_amdgcn_exp2f(lg2 * (float)d) : 0.f;
                    else wgt = d < 0 ? __builtin_amdgcn_exp2f(lg2 * (float)(-d)) : 0.f;
                    pk[e] = (short)f2bf(sc[4 * g + e] * wgt);
                }
                *(bf16x4*)(P + iq * PLD + 32 * js + 8 * g + 4 * hh) = pk;
            }
        }
        __syncthreads();
        bf16x8 sf[2][2];
#pragma unroll
        for (int s = 0; s < 2; ++s)
#pragma unroll
            for (int j = 0; j < 8; ++j) { sf[0][s][j] = (short)f2bf(S0[8 * s + j]); sf[1][s][j] = (short)f2bf(S1[8 * s + j]); }
#pragma unroll 1
        for (int isub = 0; isub < 4; ++isub) {
            const int ii = 32 * isub + qc;
            const bf16_t* qr = Qg + (size_t)(t0 + ii) * 256;
            f32x16 o;
#pragma unroll
            for (int r = 0; r < 16; ++r) o[r] = 0.f;
#pragma unroll
            for (int sub = 0; sub < 2; ++sub)
#pragma unroll
                for (int s = 0; s < 2; ++s) {
                    const int dk0 = 32 * sub + 16 * s + 4 * hh;
                    bf16x4 lo = *(const bf16x4*)(qr + dk0), hi = *(const bf16x4*)(qr + dk0 + 8);
                    bf16x8 bq = bf16x8{lo[0], lo[1], lo[2], lo[3], hi[0], hi[1], hi[2], hi[3]};
                    o = __builtin_amdgcn_mfma_f32_32x32x16_bf16(sf[sub][s], bq, o, 0, 0, 0);
                }
            const float qd = dir == 0 ? __builtin_amdgcn_exp2f(lg2 * (float)(ii + 1)) : __builtin_amdgcn_exp2f(lg2 * (float)(128 - ii));
#pragma unroll
            for (int r = 0; r < 16; ++r) o[r] *= qd;
#pragma unroll
            for (int ks = 0; ks < 8; ++ks) {
                bf16x8 pf = *(const bf16x8*)(P + ii * PLD + 16 * ks + 8 * hh);
                o = __builtin_amdgcn_mfma_f32_32x32x16_bf16(vf[ks], pf, o, 0, 0, 0);
            }
            bf16_t* orow = outp + (size_t)(t0 + ii) * 512;
#pragma unroll
            for (int g = 0; g < 4; ++g) {
                bf16x4 pk;
#pragma unroll
                for (int e = 0; e < 4; ++e) pk[e] = (short)f2bf(o[4 * g + e]);
                *(bf16x4*)(orow + 8 * g + 4 * hh) = pk;
            }
        }
#pragma unroll
        for (int r = 0; r < 16; ++r) { S0[r] *= cdec; S1[r] *= cdec; }
#pragma unroll
        for (int ks = 0; ks < 8; ++ks) {
            bf16x8 vs;
#pragma unroll
            for (int e = 0; e < 8; ++e) {
                const int j = 16 * ks + 8 * hh + e;
                const float kd = dir == 0 ? __builtin_amdgcn_exp2f(lg2 * (float)(127 - j)) : __builtin_amdgcn_exp2f(lg2 * (float)j);
                vs[e] = (short)f2bf(bf2f((bf16_t)vf[ks][e]) * kd);
            }
            bf16x8 a0 = *(const bf16x8*)(KTg + (size_t)qc * TPB + t0 + 16 * ks + 8 * hh);
            bf16x8 a1 = *(const bf16x8*)(KTg + (size_t)(32 + qc) * TPB + t0 + 16 * ks + 8 * hh);
            S0 = __builtin_amdgcn_mfma_f32_32x32x16_bf16(a0, vs, S0, 0, 0, 0);
            S1 = __builtin_amdgcn_mfma_f32_32x32x16_bf16(a1, vs, S1, 0, 0, 0);
        }
    }
    __syncthreads();
}

DEVI float fsig(float x) { return __builtin_amdgcn_rcpf(1.f + __expf(-x)); }
DEVI void lru_walk(const Params& p, int l, int task, unsigned char* smem) {
    const int b = task >> 4, d = (task >> 3) & 1, blk = task & 7;
    const int tid = TIDX, lane = tid & 63, w = tid >> 6, ln = lane & 15, g = lane >> 4;
    bf16_t* Wt = (bf16_t*)smem;
    float* uw = (float*)(smem + 18432 + w * 4224);
    float* cpar = (float*)(smem + 35328);
    float* agg = (float*)(smem + 36608);
    __syncthreads();
    {
        const bf16_t* wsrc = WB(W_LRU + ((size_t)(l * 2 + d) * 8 + blk) * 8192);
        for (int c = tid; c < 128 * 8; c += 256) {
            const int n = c >> 3, kc = c & 7;
            *(bf16x8*)(Wt + n * 72 + kc * 8) = *(const bf16x8*)(wsrc + n * 64 + kc * 8);
        }
        if (tid < 64) {
            const int ch = blk * 64 + tid;
#pragma unroll
            for (int j = 0; j < 4; ++j) cpar[j * 64 + tid] = p.in[I_LCW][(l * 4 + j) * 512 + ch];
            cpar[256 + tid] = p.in[I_LCB][l * 512 + ch];
        }
    }
    __syncthreads();
    float ba[4], bx[4], sp[4], hc[4];
#pragma unroll
    for (int ct = 0; ct < 4; ++ct) {
        const int ch = blk * 64 + 16 * ct + ln;
        ba[ct] = p.in[I_LBA][(l * 2 + d) * 512 + ch];
        bx[ct] = p.in[I_LBX][(l * 2 + d) * 512 + ch];
        sp[ct] = log1pf(expf(-p.in[I_LLAM][(l * 2 + d) * 512 + ch]));
        hc[ct] = 0.f;
    }
    const bf16_t* X = CB(C_LX) + (size_t)b * TPB * 512 + blk * 64;
    bf16_t* outp = (d == 0 ? DB(D_LH0) : DB(D_LH1)) + (size_t)b * TPB * 512 + blk * 64;
    bf16x8 xr[2][4];
    float xm[4];
    {
        const int tok = proc_tok(d, 16 * w + ln);
        const int lo = tok < CTXL ? 0 : CTXL, hi = tok < CTXL ? CTXL : TPB;
#pragma unroll
        for (int ks = 0; ks < 2; ++ks)
#pragma unroll
            for (int j = 0; j < 4; ++j) {
                const int tt = tok - 2 + j;
                const int tc = tt < lo ? lo : (tt >= hi ? hi - 1 : tt);
                xr[ks][j] = *(const bf16x8*)(X + (size_t)tc * 512 + 32 * ks + 8 * g);
                xm[j] = (tt >= lo && tt < hi) ? 1.f : 0.f;
            }
    }
    for (int c = 0; c < 36; ++c) {
        bf16x8 af[2];
#pragma unroll
        for (int ks = 0; ks < 2; ++ks) {
            const int c0 = 32 * ks + 8 * g;
            float u8[8];
#pragma unroll
            for (int e = 0; e < 8; ++e) u8[e] = cpar[256 + c0 + e];
#pragma unroll
            for (int j = 0; j < 4; ++j)
#pragma unroll
                for (int e = 0; e < 8; ++e) u8[e] += (cpar[j * 64 + c0 + e] * xm[j]) * bf2f((bf16_t)xr[ks][j][e]);
#pragma unroll
            for (int e = 0; e < 8; ++e) { uw[ln * 65 + c0 + e] = u8[e]; af[ks][e] = (short)f2bf(u8[e]); }
        }
        if (c + 1 < 36) {
            const int tok = proc_tok(d, 64 * (c + 1) + 16 * w + ln);
            const int lo = tok < CTXL ? 0 : CTXL, hi = tok < CTXL ? CTXL : TPB;
#pragma unroll
            for (int ks = 0; ks < 2; ++ks)
#pragma unroll
                for (int j = 0; j < 4; ++j) {
                    const int tt = tok - 2 + j;
                    const int tc = tt < lo ? lo : (tt >= hi ? hi - 1 : tt);
                    xr[ks][j] = *(const bf16x8*)(X + (size_t)tc * 512 + 32 * ks + 8 * g);
                    xm[j] = (tt >= lo && tt < hi) ? 1.f : 0.f;
                }
        }
        __builtin_amdgcn_wave_barrier();
        f32x4 acc[8];
#pragma unroll
        for (int nt = 0; nt < 8; ++nt) acc[nt] = f32x4{0.f, 0.f, 0.f, 0.f};
#pragma unroll
        for (int ks = 0; ks < 2; ++ks)
#pragma unroll
            for (int nt = 0; nt < 8; ++nt) {
                bf16x8 bfr = *(const bf16x8*)(Wt + (16 * nt + ln) * 72 + 32 * ks + 8 * g);
                acc[nt] = __builtin_amdgcn_mfma_f32_16x16x32_bf16(af[ks], bfr, acc[nt], 0, 0, 0);
            }
        float A[4][4], B[4][4];
#pragma unroll
        for (int ct = 0; ct < 4; ++ct) {
            float pa = 1.f, pb = 0.f;
#pragma unroll
            for (int j = 0; j < 4; ++j) {
                const float r = fsig(acc[ct][j] + ba[ct]);
                const float ig = fsig(acc[4 + ct][j] + bx[ct]);
                const float la = -8.f * r * sp[ct];
                const float a = __expf(la);
                const float uu = uw[(4 * g + j) * 65 + 16 * ct + ln];
                const float bb = __builtin_amdgcn_sqrtf(fmaxf(1.f - a * a, 0.f)) * ig * uu;
                pb = a * pb + bb; pa = a * pa;
                A[ct][j] = pa; B[ct][j] = pb;
            }
            float ia = pa, ib = pb;
#pragma unroll
            for (int dd = 1; dd <= 2; dd <<= 1) {
                const float qa = __shfl_up(ia, 16 * dd), qb = __shfl_up(ib, 16 * dd);
                if (g >= dd) { ib = ia * qb + ib; ia = ia * qa; }
            }
            float ea = __shfl_up(ia, 16), eb = __shfl_up(ib, 16);
            if (g == 0) { ea = 1.f; eb = 0.f; }
#pragma unroll
            for (int j = 0; j < 4; ++j) { B[ct][j] = A[ct][j] * eb + B[ct][j]; A[ct][j] = A[ct][j] * ea; }
            if (g == 3) {
                float* ag = agg + (((c & 1) * 4 + w) * 64 + 16 * ct + ln) * 2;
                ag[0] = ia; ag[1] = ib;
            }
        }
        __syncthreads();
#pragma unroll
        for (int ct = 0; ct < 4; ++ct) {
            float hrun = hc[ct], hin = 0.f;
#pragma unroll
            for (int w2 = 0; w2 < 4; ++w2) {
                const float* ag = agg + (((c & 1) * 4 + w2) * 64 + 16 * ct + ln) * 2;
                if (w2 == w) hin = hrun;
                hrun = ag[0] * hrun + ag[1];
            }
            hc[ct] = hrun;
#pragma unroll
            for (int j = 0; j < 4; ++j) {
                const int tok2 = proc_tok(d, 64 * c + 16 * w + 4 * g + j);
                outp[(size_t)tok2 * 512 + 16 * ct + ln] = f2bf(A[ct][j] * hin + B[ct][j]);
            }
        }
    }
    __syncthreads();
}

DEVI void phase_mix(const Params& p, int l, unsigned char* smem) {
    const int NLRU = 128, NRET = (l == 0 ? 576 : 512);
    const int NLAT = 1024, NCTX = (l == 0 ? 128 : 0);
    const int ntask = NLRU + NRET + 2 * NLAT + 2 * NCTX;
    const int ncvt = 3072;
    int cv = BIDX;
    int* ctr = WSI(OFF_CNT) + 128 + l;
    volatile int* nxt = (volatile int*)(smem + 65520);
    for (;;) {
        __syncthreads();
        if (TIDX == 0) *nxt = atomicAdd(ctr, 1);
        __syncthreads();
        const int task = *nxt;
        if (task >= ntask) break;
        if (cv < ncvt) { CvtJob j = get_moe_job(p, l, cv >> 10); cvt_tile256(j, cv & 1023, smem); cv += gridDim.x; }
        if (task < NLRU) lru_walk(p, l, task, smem);
        else if (task >= NLRU + 2 * NLAT && task < NLRU + 2 * NLAT + NRET) {
            const int a = task - NLRU - 2 * NLAT;
            int b, h, m;
            if (l == 0) { b = a / 72; const int r = a % 72; h = r / 18; m = r % 18; }
            else { b = a >> 6; const int r = a & 63; h = r >> 4; m = 2 + (r & 15); }
            ret_out_task(p, l, b, h, m, smem);
        } else {
            int a = task < NLRU + 2 * NLAT ? task - NLRU : task - NLRU - NRET;
            int kind, b, hsel, tq0, nkeys;
            if (a < NLAT) { kind = 0; b = a >> 7; const int r = a & 127; hsel = r >> 4; tq0 = CTXL + (r & 15) * 128; nkeys = TPB; }
            else if (a < 2 * NLAT) { a -= NLAT; kind = 1; b = a >> 7; const int r = a & 127; hsel = r >> 6; tq0 = CTXL + (r & 63) * 32; nkeys = TPB; }
            else if (a < 2 * NLAT + NCTX) { a -= 2 * NLAT; kind = 0; b = a >> 4; const int r = a & 15; hsel = r >> 1; tq0 = (r & 1) * 128; nkeys = CTXL; }
            else { a -= 2 * NLAT + NCTX; kind = 1; b = a >> 4; const int r = a & 15; hsel = r >> 3; tq0 = (r & 7) * 32; nkeys = CTXL; }
            if (kind == 0) attn_task<96, true>(p, b, hsel, tq0, nkeys, smem);
            else attn_task<64, false>(p, b, hsel, tq0, nkeys, smem);
        }
    }
    for (; cv < ncvt; cv += gridDim.x) { CvtJob j = get_moe_job(p, l, cv >> 10); cvt_tile256(j, cv & 1023, smem); }
}

DEVI void phase_fin(const Params& p, int l) {
    const int lane = TIDX & 63, w = TIDX >> 6;
    for (int row = BIDX * 4 + w; row < TT; row += gridDim.x * 4) {
        if (l == 1 && (row % TPB) < CTXL) continue;
        const size_t o = (size_t)row * 512 + lane * 8;
        bf16x8 h0 = *(const bf16x8*)(DB(D_LH0) + o), h1 = *(const bf16x8*)(DB(D_LH1) + o), lg = *(const bf16x8*)(CB(C_LG) + o);
        bf16x8 oc;
#pragma unroll
        for (int e = 0; e < 8; ++e) oc[e] = (short)f2bf((bf2f((bf16_t)h0[e]) + bf2f((bf16_t)h1[e])) * gelu_tanh(bf2f((bf16_t)lg[e])));
        *(bf16x8*)(DB(D_LH0) + o) = oc;
    }
}

DEVI void merge_tile(const Params& p, int l, int mq, int nt, unsigned char* smem) {
    bf16_t* ct = (bf16_t*)smem;
    const int lane = TIDX & 63, wc = (TIDX >> 6) & 1;
    const int mt = mt_of(mq, l != 0);
    const int row0 = mt * 128;
    unsigned mp[4][4][2];
#pragma unroll
    for (int mi = 0; mi < 4; ++mi)
#pragma unroll
        for (int ni = 0; ni < 4; ++ni) { mp[mi][ni][0] = 0u; mp[mi][ni][1] = 0u; }
#pragma unroll 1
    for (int n = 0; n < 4; ++n) {
        unsigned gp[4][4][2];
        {
            f32x4 ag[4][4];
            acc_zero<128>(ag);
            gemm_core_fp8(ag, (const unsigned char*)HB, 2048, row0, (const unsigned char*)WB(W_MG + (size_t)l * 4096 * 1024) + (size_t)(n * 1024 + nt * 128) * 1024, 1024, 1024, smem);
            const float* bm = p.in[I_BMG] + l * 4096 + n * 1024 + nt * 128 + wc * 64 + (lane & 15);
#pragma unroll
            for (int ni = 0; ni < 4; ++ni) {
                const float bias = bm[ni * 16];
#pragma unroll
                for (int mi = 0; mi < 4; ++mi) {
                    gp[mi][ni][0] = (unsigned)f2bf(sigmoidf_(ag[mi][ni][0] + bias)) | ((unsigned)f2bf(sigmoidf_(ag[mi][ni][1] + bias)) << 16);
                    gp[mi][ni][1] = (unsigned)f2bf(sigmoidf_(ag[mi][ni][2] + bias)) | ((unsigned)f2bf(sigmoidf_(ag[mi][ni][3] + bias)) << 16);
                }
            }
        }
        f32x4 ap[4][4];
        acc_zero<128>(ap);
        const bf16_t* yb = n == 0 ? DB(D_YA) : (n == 1 ? DB(D_OF) : (n == 2 ? DB(D_LH0) : DB(D_YD)));
        AOp A2{yb, 512, row0, nullptr};
        gemm_core<128>(ap, A2, WB(W_BR + ((size_t)l * 4 + n) * 1024 * 512 + (size_t)(nt * 128) * 512), 512, 512, smem);
#pragma unroll
        for (int mi = 0; mi < 4; ++mi)
#pragma unroll
            for (int ni = 0; ni < 4; ++ni) {
                const float m0 = __uint_as_float(mp[mi][ni][0] << 16) + __uint_as_float(gp[mi][ni][0] << 16) * ap[mi][ni][0];
                const float m1 = __uint_as_float(mp[mi][ni][0] & 0xffff0000u) + __uint_as_float(gp[mi][ni][0] & 0xffff0000u) * ap[mi][ni][1];
                const float m2 = __uint_as_float(mp[mi][ni][1] << 16) + __uint_as_float(gp[mi][ni][1] << 16) * ap[mi][ni][2];
                const float m3 = __uint_as_float(mp[mi][ni][1] & 0xffff0000u) + __uint_as_float(gp[mi][ni][1] & 0xffff0000u) * ap[mi][ni][3];
                mp[mi][ni][0] = (unsigned)f2bf(m0) | ((unsigned)f2bf(m1) << 16);
                mp[mi][ni][1] = (unsigned)f2bf(m2) | ((unsigned)f2bf(m3) << 16);
            }
    }
    __syncthreads();
    {
        const int wid = TIDX >> 6, wr = wid >> 1;
#pragma unroll
        for (int mi = 0; mi < 4; ++mi)
#pragma unroll
            for (int ni = 0; ni < 4; ++ni) {
                bf16_t* cp = ct + (wr * 64 + mi * 16 + (lane >> 4) * 4) * CT_LD + wc * 64 + ni * 16 + (lane & 15);
                cp[0] = (bf16_t)(mp[mi][ni][0] & 0xffffu); cp[CT_LD] = (bf16_t)(mp[mi][ni][0] >> 16);
                cp[2 * CT_LD] = (bf16_t)(mp[mi][ni][1] & 0xffffu); cp[3 * CT_LD] = (bf16_t)(mp[mi][ni][1] >> 16);
            }
    }
    __syncthreads();
    ep_store_rows<128>(ct, 0, CB(C_M) + nt * 128, 1024, row0);
}

DEVI void wout_tile(const Params& p, int l, int mq, int nt, unsigned char* smem) {
    bf16_t* ct = (bf16_t*)smem;
    const int mt = mt_of(mq, l != 0);
    const int row0 = mt * 128, b = mt / 18, t0 = (mt % 18) * 128;
    const bool isctx = (mt % 18) < 2;
    const int bi = isctx ? 8 : b;
    f32x4 acc[4][4];
    acc_zero<128>(acc);
    AOp A{CB(C_M), 1024, row0, nullptr};
    gemm_core<128>(acc, A, WB(W_OUT + (size_t)l * 1024 * 1024 + (size_t)nt * 128 * 1024), 1024, 1024, smem);
    __syncthreads();
    acc_to_ct<128>(acc, ct);
    __syncthreads();
    const float* gate = WSF(OFF_MOD) + (size_t)(l * 9 + bi) * 6144 + 2 * 1024 + nt * 128;
    for (int c = TIDX; c < 128 * 32; c += 256) {
        const int i = c >> 5, jc = c & 31;
        const int t = t0 + i;
        const float* xs;
        if (l == 0) xs = isctx ? p.in[I_CTX] + ((size_t)b * CTXL + t) * DM : p.in[I_X] + ((size_t)b * SEQL + (t - CTXL)) * DM;
        else xs = XCUR + (size_t)(row0 + i) * DM;
        float4 x4 = *(const float4*)(xs + nt * 128 + jc * 4);
        float4 g4 = *(const float4*)(gate + jc * 4);
        uint2 y = *(const uint2*)(ct + i * CT_LD + jc * 4);
        x4.x += g4.x * __uint_as_float(y.x << 16);
        x4.y += g4.y * __uint_as_float(y.x & 0xffff0000u);
        x4.z += g4.z * __uint_as_float(y.y << 16);
        x4.w += g4.w * __uint_as_float(y.y & 0xffff0000u);
        *(float4*)(XCUR + (size_t)(row0 + i) * DM + nt * 128 + jc * 4) = x4;
    }
}

DEVI void phase_merge_wout(const Params& p, int l, unsigned char* smem) {
    const int nmt = (l == 0 ? 144 : 128);
    const int N5 = nmt * 8;
    int* ctr = WSI(OFF_CNT) + 132 + l;
    int* dep = WSI(OFF_CNT) + 256 + l * 160;
    for (;;) {
        const int task = fetch_task(ctr, smem);
        if (task >= 2 * N5) break;
        if (task < N5) {
            merge_tile(p, l, task >> 3, task & 7, smem);
            dep_signal(dep + (task >> 3));
        } else {
            const int t6 = task - N5;
            dep_wait(dep + (t6 >> 3), 8);
            wout_tile(p, l, t6 >> 3, t6 & 7, smem);
        }
    }
}

DEVI void phase_route(const Params& p, int l, unsigned char* smem) {
    const int tid = TIDX, lane = tid & 63, w = tid >> 6, wr = w >> 1, wc = w & 1;
    float* lgt = (float*)smem;
    const float rbias = p.in[I_RB][lane];
    int* cnt = WSI(OFF_CNT) + l * 64;
    int* list = WSI(OFF_LIST);
    const int ntile = l == 0 ? 144 : 128;
    for (int q = BIDX; q < ntile; q += gridDim.x) {
        const int mt = mt_of(q, l != 0);
        const int row0 = mt * 128;
        f32x4 acc[4][2];
        acc_zero<64>(acc);
        AOp A{HB, 1024, row0, nullptr};
        gemm_core<64>(acc, A, WB(W_RT), 1024, 1024, smem);
        __syncthreads();
#pragma unroll
        for (int mi = 0; mi < 4; ++mi)
#pragma unroll
            for (int ni = 0; ni < 2; ++ni)
#pragma unroll
                for (int j = 0; j < 4; ++j)
                    lgt[(wr * 64 + mi * 16 + (lane >> 4) * 4 + j) * 68 + wc * 32 + ni * 16 + (lane & 15)] = acc[mi][ni][j];
        __syncthreads();
        for (int i = 0; i < 32; ++i) {
            const int row = row0 + w * 32 + i;
            const float lg = lgt[(w * 32 + i) * 68 + lane];
            const float score = sigmoidf_(lg);
            const float biased = score + rbias;
            float v1 = biased; int i1 = lane;
#pragma unroll
            for (int off = 1; off < 8; off <<= 1) {
                float ov = __shfl_xor(v1, off); int oi = __shfl_xor(i1, off);
                if (ov > v1 || (ov == v1 && oi < i1)) { v1 = ov; i1 = oi; }
            }
            float v2 = (lane == i1) ? -3.0e38f : biased; int i2 = lane;
#pragma unroll
            for (int off = 1; off < 8; off <<= 1) {
                float ov = __shfl_xor(v2, off); int oi = __shfl_xor(i2, off);
                if (ov > v2 || (ov == v2 && oi < i2)) { v2 = ov; i2 = oi; }
            }
            float gv = v1 + v2; int gi = lane >> 3;
#pragma unroll
            for (int off = 8; off < 64; off <<= 1) {
                float ov = __shfl_xor(gv, off); int oi = __shfl_xor(gi, off);
                if (ov > gv || (ov == gv && oi < gi)) { gv = ov; gi = oi; }
            }
            const int e0 = __shfl(i1, gi * 8), e1 = __shfl(i2, gi * 8);
            const float s0 = __shfl(score, e0), s1 = __shfl(score, e1);
            if (lane == 0) {
                Rec rc;
                rc.e0 = e0; rc.e1 = e1;
                rc.p0 = atomicAdd(&cnt[e0], 1);
                rc.p1 = atomicAdd(&cnt[e1], 1);
                const float inv = 1.f / (s0 + s1);
                rc.w0 = s0 * inv; rc.w1 = s1 * inv; rc.pad0 = 0; rc.pad1 = 0;
                list[(size_t)e0 * TT + rc.p0] = row;
                list[(size_t)e1 * TT + rc.p1] = row;
                ((Rec*)(p.ws + OFF_REC))[row] = rc;
            }
        }
        __syncthreads();
    }
}

struct MoeGrp { int ne[8], sg[8], cn[8]; };
DEVI MoeGrp moe_grp(const MoeTab& mt, const GrpInfo& gi) {
    MoeGrp g;
#pragma unroll
    for (int q = 0; q < 8; ++q) {
        const int ee = gi.ngrp == 8 ? gi.xcd * 8 + q : 0;
        g.cn[q] = mt.cnt(ee); g.sg[q] = mt.seg(ee); g.ne[q] = (g.cn[q] + 127) >> 7;
    }
    return g;
}
DEVI bool moe_tile(const MoeTab& mt, const MoeGrp& mg, const GrpInfo& gi, int it, int NT, int& e, int& jt, int& nt, int& cn, int& sg) {
    int rem = gi.j + gi.per * it;
    if (gi.ngrp == 8) {
#pragma unroll
        for (int q = 0; q < 8; ++q) {
            const int ne = mg.ne[q] * NT;
            if (rem < ne) { e = gi.xcd * 8 + q; jt = rem / NT; nt = rem % NT; cn = mg.cn[q]; sg = mg.sg[q]; return true; }
            rem -= ne;
        }
        return false;
    }
    for (int ee = 0; ee < 64; ++ee) {
        const int c = mt.cnt(ee);
        const int ne = ((c + 127) >> 7) * NT;
        if (rem < ne) { e = ee; jt = rem / NT; nt = rem % NT; cn = c; sg = mt.seg(ee); return true; }
        rem -= ne;
    }
    return false;
}
DEVI void moe_find(const MoeTab& mt, int rt, int& e, int& jt) {
    int lo = 0, hi = 64;
    while (hi - lo > 1) { const int mid = (lo + hi) >> 1; if (mt.tp(mid) <= rt) lo = mid; else hi = mid; }
    e = lo; jt = rt - mt.tp(lo);
}
DEVI void phase_moe(const Params& p, int l, unsigned char* smem) {
    bf16_t* ct = (bf16_t*)smem;
    int* ridx = (int*)(smem + AUX_OFF);
    MoeTab mt = moe_tables(p, l, smem);
    const int* list = WSI(OFF_LIST);
    const int nrt = mt.tp(64);
    int* ctr = WSI(OFF_CNT) + 136 + l;
    int* dep = WSI(OFF_CNT) + 1024 + l * 384;
    for (;;) {
        const int task = fetch_task(ctr, smem);
        if (task >= nrt * 12) break;
        if (task < nrt * 4) {
            const int rt = task >> 2, nt = task & 3;
            int e, jt;
            moe_find(mt, rt, e, jt);
            const int cn = mt.cnt(e), sg = mt.seg(e);
            if (TIDX < 128) {
                const int idx = jt * 128 + TIDX;
                ridx[TIDX] = list[(size_t)e * TT + (idx < cn ? idx : 0)];
            }
            __syncthreads();
            f32x4 acc[4][4];
            acc_zero<128>(acc);
            AOp A{HB, 1024, 0, ridx};
            gemm_core<128, true>(acc, A, MWB(MW_13) + ((size_t)e * 512 + nt * 128) * 1024, 1024, 1024, smem);
            __syncthreads();
            acc_to_ct<128>(acc, ct);
            __syncthreads();
            const int slot0 = sg + jt * 128;
            for (int c = TIDX; c < 128 * 8; c += 256) {
                const int i = c >> 3, jc = c & 7;
                bf16x8 a = *(const bf16x8*)(ct + i * CT_LD + jc * 8), g = *(const bf16x8*)(ct + i * CT_LD + 64 + jc * 8), o;
#pragma unroll
                for (int q = 0; q < 8; ++q) o[q] = (short)f2bf(siluf_(bf2f((bf16_t)a[q])) * bf2f((bf16_t)g[q]));
                *(bf16x8*)(DB(D_ACT) + (size_t)(slot0 + i) * 256 + nt * 64 + jc * 8) = o;
            }
            dep_signal(dep + rt);
        } else {
            const int t2 = task - nrt * 4;
            const int rt = t2 >> 3, nt = t2 & 7;
            int e, jt;
            moe_find(mt, rt, e, jt);
            const int slot0 = mt.seg(e) + jt * 128;
            dep_wait(dep + rt, 4);
            f32x4 acc[4][4];
            acc_zero<128>(acc);
            AOp A{DB(D_ACT), 256, slot0, nullptr};
            gemm_core<128>(acc, A, MWB(MW_2) + ((size_t)e * 1024 + nt * 128) * 256, 256, 256, smem);
            __syncthreads();
            acc_to_ct<128>(acc, ct);
            __syncthreads();
            ep_store_rows<128>(ct, 0, DB(D_YS) + nt * 128, 1024, slot0);
        }
    }
}

#define XB_TMO      128
#define XB_XCNT(j)  (256  + 64 * (j))
#define XB_XSUB(j)  (1280 + 64 * (j))
#define XB_XGEN(j)  (2304 + 64 * (j))
#define XB_TOP      3328
#define XB_TOPGEN   3392
#define XB_SPIN_CAP (1u << 22)
DEVI unsigned xb_ld(unsigned* p) { return __hip_atomic_load(p, __ATOMIC_RELAXED, __HIP_MEMORY_SCOPE_AGENT); }
DEVI unsigned xb_add(unsigned* p, unsigned v) { return __hip_atomic_fetch_add(p, v, __ATOMIC_RELAXED, __HIP_MEMORY_SCOPE_AGENT); }
DEVI unsigned xb_xcc_id() { return (unsigned)__builtin_amdgcn_s_getreg((3 << 11) | 20) & 0xFu; }
#define XB_SPIN(cond, bar) do { unsigned _sp = 0; while (cond) { __builtin_amdgcn_s_sleep(1); \
    if ((++_sp & 255u) == 0u) { if (xb_ld(&(bar)[XB_TMO])) break; if (_sp > XB_SPIN_CAP) { atomicAdd(&(bar)[XB_TMO], 1u); break; } } } } while (0)
struct XcdBarrier { unsigned* bar; unsigned x; unsigned* st; };
DEVI XcdBarrier xcd_barrier_post(unsigned* bar, unsigned* st) {
    XcdBarrier b; b.bar = bar; b.x = xb_xcc_id(); b.st = st;
    if (__builtin_amdgcn_workitem_id_x() == 0) (void)xb_add(&bar[XB_XCNT(b.x)], 1u);
    return b;
}
DEVI void xcd_barrier_complete(unsigned* bar, unsigned x, unsigned& nloc, unsigned& nx) {
    const unsigned G = gridDim.x * gridDim.y * gridDim.z;
    unsigned sum, cnt, mine, sp = 0u;
    for (;;) {
        sum = 0u; cnt = 0u; mine = 0u;
#pragma unroll
        for (unsigned j = 0; j < 16; ++j) { const unsigned c = xb_ld(&bar[XB_XCNT(j)]); sum += c; cnt += (c > 0u) ? 1u : 0u; mine = (j == x) ? c : mine; }
        if (sum == G) break;
        __builtin_amdgcn_s_sleep(1);
        if ((++sp & 255u) == 0u) { if (xb_ld(&bar[XB_TMO])) break; if (sp > XB_SPIN_CAP) { atomicAdd(&bar[XB_TMO], 1u); break; } }
    }
    nloc = mine > 0u ? mine : 1u; nx = cnt > 0u ? cnt : 1u;
}
DEVI void xcd_barrier(const XcdBarrier& b) {
    asm volatile("s_waitcnt vmcnt(0)" ::: "memory");
    __syncthreads();
    if (__builtin_amdgcn_workitem_id_x() == 0) {
        unsigned* bar = b.bar;
        __builtin_amdgcn_s_waitcnt(0);
        unsigned nloc = xb_ld(&b.st[0]), nx = xb_ld(&b.st[1]);
        if (nloc == 0u) { xcd_barrier_complete(bar, b.x, nloc, nx); __hip_atomic_store(&b.st[0], nloc, __ATOMIC_RELAXED, __HIP_MEMORY_SCOPE_AGENT); __hip_atomic_store(&b.st[1], nx, __ATOMIC_RELAXED, __HIP_MEMORY_SCOPE_AGENT); }
        const unsigned old = xb_add(&bar[XB_XSUB(b.x)], 1u);
        const unsigned gen = old / nloc;
        if (old + 1u == (gen + 1u) * nloc) {
            __builtin_amdgcn_fence(__ATOMIC_RELEASE, "agent");
            asm volatile("s_waitcnt vmcnt(0)" ::: "memory");
            const unsigned og = xb_add(&bar[XB_TOP], 1u);
            const unsigned tg = og / nx;
            if (og + 1u == (tg + 1u) * nx) xb_add(&bar[XB_TOPGEN], 1u);
            else XB_SPIN(xb_ld(&bar[XB_TOPGEN]) == tg, bar);
            __builtin_amdgcn_fence(__ATOMIC_ACQUIRE, "agent");
            xb_add(&bar[XB_XGEN(b.x)], 1u);
            asm volatile("s_waitcnt vmcnt(0)" ::: "memory");
        } else {
            XB_SPIN(xb_ld(&bar[XB_XGEN(b.x)]) == gen, bar);
            __builtin_amdgcn_fence(__ATOMIC_ACQUIRE, "agent");
            asm volatile("s_waitcnt vmcnt(0)" ::: "memory");
        }
    }
    __syncthreads();
}

constexpr int NPHASE = 24;
DEVI void run_phase(const Params& p, int ph, unsigned char* smem) {
#ifndef ONLYK
    if (ph == 0) { phase0(p, smem); return; }
    if (ph == 23) { phase_norm1(p, 1, 1, smem); return; }
#endif
    const int l = (ph - 1) / 11, k = (ph - 1) % 11;
#ifdef ONLYK
    if (k != ONLYK) return;
#endif
    switch (k) {
    case 0: phase_norm1(p, l, 0, smem); break;
    case 1: phase_win(p, l, smem); break;
    case 2: phase_mla_up(p, l, smem); break;
    case 3: phase_mix(p, l, smem); break;
    case 4: phase_fin(p, l); break;
    case 5: phase_merge_wout(p, l, smem); break;
    case 6: break;
    case 7: phase_norm1(p, l, 2, smem); break;
    case 8: phase_route(p, l, smem); break;
    case 9: phase_moe(p, l, smem); break;
    default: break;
    }
}

__global__ void __launch_bounds__(256, 2) k_main(Params p, int ph_lo, int ph_hi) {
    __shared__ __attribute__((aligned(16))) unsigned char smem[SMEM_BYTES];
    unsigned* xb_priv = (unsigned*)(p.ws + OFF_PRIV + (size_t)__builtin_amdgcn_workgroup_id_x() * 1024 + 896);
    if (__builtin_amdgcn_workitem_id_x() == 0) { __hip_atomic_store(xb_priv, 0u, __ATOMIC_RELAXED, __HIP_MEMORY_SCOPE_AGENT); __hip_atomic_store(xb_priv + 1, 0u, __ATOMIC_RELAXED, __HIP_MEMORY_SCOPE_AGENT); }
    XcdBarrier xb = xcd_barrier_post((unsigned*)(p.ws + OFF_BAR), xb_priv);
    if (__builtin_amdgcn_workitem_id_x() == 0) {
        const unsigned rk = xb_add((unsigned*)(p.ws + OFF_BAR) + 3456 + xb.x, 1u);
        __hip_atomic_store(xb_priv + 2, xb.x, __ATOMIC_RELAXED, __HIP_MEMORY_SCOPE_AGENT);
        __hip_atomic_store(xb_priv + 3, rk, __ATOMIC_RELAXED, __HIP_MEMORY_SCOPE_AGENT);
    }
    for (int ph = ph_lo; ph < ph_hi; ++ph) {
        if (ph >= 1 && ph <= 22 && (((ph - 1) % 11) == 6 || ((ph - 1) % 11) == 10)) continue;
        run_phase(p, ph, smem);
#ifdef DUPK
        if (ph >= 1 && ph <= 22 && ((ph - 1) % 11) == DUPK) run_phase(p, ph, smem);
        if (DUPK == 10 && ph == 0) run_phase(p, ph, smem);
#endif
        if (ph + 1 < ph_hi) {
            if (ph == ph_lo) cg::this_grid().sync();
            else xcd_barrier(xb);
        }
    }
#ifdef TPROBE
    if (__builtin_amdgcn_workgroup_id_x() == 0 && __builtin_amdgcn_workitem_id_x() == 0) {
        const unsigned long long dt = __hip_atomic_load(T_SLOT(TPROBE), __ATOMIC_RELAXED, __HIP_MEMORY_SCOPE_AGENT) * TMULT;
        const unsigned long long t0 = __builtin_amdgcn_s_memrealtime();
        while (__builtin_amdgcn_s_memrealtime() - t0 < dt) __builtin_amdgcn_s_sleep(8);
    }
#endif
}

extern "C" void kernel_launch(void* const* d_in, const int* in_sizes, int n_in, void* d_out, int out_size, void* d_ws, size_t ws_size,
                              hipStream_t stream) {
    if (ws_size < WS_NEED || n_in < N_IN) { fprintf(stderr, "workspace too small: %zu < %zu\n", ws_size, (size_t)WS_NEED); return; }
    Params p{};
    for (int i = 0; i < N_IN; ++i) p.in[i] = (const float*)d_in[i];
    p.out = (float*)d_out;
    p.ws = (unsigned char*)d_ws;
    static int grid_blocks = 0;
    if (!grid_blocks) {
        int dev = 0, cus = 0, per_cu = 0;
        hipGetDevice(&dev);
        hipDeviceGetAttribute(&cus, hipDeviceAttributeMultiprocessorCount, dev);
        hipOccupancyMaxActiveBlocksPerMultiprocessor(&per_cu, k_main, 256, DYN_LDS);
        if (per_cu > 2) per_cu = 2;
        if (per_cu < 1) per_cu = 1;
        grid_blocks = cus * per_cu;
    }
    hipMemsetAsync(p.ws + OFF_BAR, 0, 16384, stream);
#if ONE_LAUNCH
    int lo = 0, hi = NPHASE;
    void* args[] = {&p, &lo, &hi};
    hipError_t e = hipLaunchCooperativeKernel((void*)k_main, dim3(grid_blocks), dim3(256), args, DYN_LDS, stream);
    if (e != hipSuccess) fprintf(stderr, "cooperative launch failed: %s (grid %d)\n", hipGetErrorString(e), grid_blocks);
#else
    for (int ph = 0; ph < NPHASE; ++ph) hipLaunchKernelGGL(k_main, dim3(grid_blocks), dim3(256), DYN_LDS, stream, p, ph, ph + 1);
#endif
}
```

```cpp
#include <hip/hip_runtime.h>
#include <hip/hip_cooperative_groups.h>
#include <stdint.h>
#include <stdio.h>
namespace cg = cooperative_groups;

#define DEVI __device__ __forceinline__
#define LAS __attribute__((address_space(3)))
typedef unsigned short bf16_t;
typedef __attribute__((ext_vector_type(8))) short bf16x8;
typedef __attribute__((ext_vector_type(4))) float f32x4;
typedef __attribute__((ext_vector_type(16))) float f32x16;
typedef __attribute__((ext_vector_type(4))) short bf16x4;

#ifndef NAIVE_GEMM
#define NAIVE_GEMM 0
#endif
#ifndef ONE_LAUNCH
#define ONE_LAUNCH 1
#endif

constexpr int DM = 1024, NBT = 8, SEQL = 2048, CTXL = 256, TPB = 2304, TT = 18432;
constexpr int DINP = 3840;
constexpr float LOG2E = 1.4426950408889634f;
constexpr float EPSV = 1e-6f;
constexpr int NSLOT = 2 * TT + 64 * 128;

enum { I_X = 0, I_C, I_CTX, I_CCTX, I_ADAW, I_ADAB, I_N1G, I_N2G, I_WIN, I_MQN, I_MKVN, I_WUQ, I_WUKV, I_RDEC, I_RNORM,
       I_LCW, I_LCB, I_LWA, I_LBA, I_LWX, I_LBX, I_LLAM, I_GQN, I_GKN, I_WBR, I_WMG, I_BMG, I_WOUT, I_RW, I_RB,
       I_W1, I_W3, I_W2, I_FN, N_IN };

constexpr size_t AL(size_t x) { return (x + 255) & ~(size_t)255; }
constexpr size_t OFF_BAR = 0;
constexpr size_t OFF_CNT = 16384;
constexpr size_t OFF_MOD = OFF_CNT + 16384;
constexpr size_t OFF_R64 = AL(OFF_MOD + (size_t)2 * 9 * 6144 * 4);
constexpr size_t OFF_R32 = OFF_R64 + (size_t)2048 * 64 * 4;
constexpr size_t OFF_REC = OFF_R32 + (size_t)2048 * 32 * 4;
constexpr size_t OFF_LIST = OFF_REC + (size_t)TT * 32;
constexpr size_t OFF_PRIV = AL(OFF_LIST + (size_t)64 * TT * 4);
constexpr size_t OFF_W = OFF_PRIV + (size_t)2048 * 1024;
constexpr size_t W_IN = 0;
constexpr size_t W_UQ = W_IN + (size_t)2 * 3840 * 1024;
constexpr size_t W_UKV = W_UQ + (size_t)2 * 768 * 256;
constexpr size_t W_BR = W_UKV + (size_t)2 * 1024 * 128;
constexpr size_t W_MG = W_BR + (size_t)2 * 4 * 1024 * 512;
constexpr size_t W_OUT = W_MG + (size_t)2 * 4096 * 1024;
constexpr size_t W_LRU = W_OUT + (size_t)2 * 1024 * 1024;
constexpr size_t W_RT = W_LRU + (size_t)2 * 2 * 8 * 2 * 64 * 64;
constexpr size_t W_END = W_RT + (size_t)64 * 1024;
constexpr size_t OFF_XCUR = AL(OFF_W + W_END * 2);
constexpr size_t OFF_H = OFF_XCUR + (size_t)TT * 1024 * 4;
constexpr size_t OFF_C = OFF_H + (size_t)TT * 1024 * 2;
constexpr size_t C_CQ = 0;
constexpr size_t C_CKV = C_CQ + (size_t)TT * 256;
constexpr size_t C_KR = C_CKV + (size_t)TT * 128;
constexpr size_t C_MQ = C_KR + (size_t)TT * 32;
constexpr size_t C_KN = C_MQ + (size_t)TT * 768;
constexpr size_t C_VMT = C_KN + (size_t)TT * 512;
constexpr size_t C_RQ = C_VMT + (size_t)TT * 512;
constexpr size_t C_RK = C_RQ + (size_t)TT * 256;
constexpr size_t C_RKT = C_RK + (size_t)TT * 256;
constexpr size_t C_RVT = C_RKT + (size_t)TT * 256;
constexpr size_t C_RG = C_RVT + (size_t)TT * 512;
constexpr size_t C_LX = C_RG + (size_t)TT * 512;
constexpr size_t C_LG = C_LX + (size_t)TT * 512;
constexpr size_t C_GQ = C_LG + (size_t)TT * 512;
constexpr size_t C_GK = C_GQ + (size_t)TT * 512;
constexpr size_t C_GVT = C_GK + (size_t)TT * 128;
constexpr size_t C_END = C_GVT + (size_t)TT * 128;
constexpr size_t C_M = 0;
constexpr size_t C_W13 = (size_t)24 * 1024 * 1024;
constexpr size_t C_W2 = C_W13 + (size_t)64 * 512 * 1024;
static_assert(C_W2 + (size_t)64 * 1024 * 256 <= C_END, "moe alias");
static_assert((size_t)TT * 1024 <= C_W13, "m alias");
constexpr size_t OFF_D = OFF_C + C_END * 2;
constexpr size_t D_YA = 0;
constexpr size_t D_YD = (size_t)TT * 512;
constexpr size_t D_OF = (size_t)2 * TT * 512;
constexpr size_t D_OB = (size_t)3 * TT * 512;
constexpr size_t D_LH0 = (size_t)4 * TT * 512;
constexpr size_t D_LH1 = (size_t)5 * TT * 512;
constexpr size_t D_ACT = 0;
constexpr size_t D_YS = (size_t)12 * 1024 * 1024;
constexpr size_t D_END = D_YS + (size_t)NSLOT * 1024;
static_assert((size_t)NSLOT * 256 <= D_YS, "act alias");
static_assert((size_t)6 * TT * 512 <= D_END, "d size");
constexpr size_t OFF_MOEW = AL(OFF_D + D_END * 2);
constexpr size_t MW_13 = 0, MW_2 = (size_t)64 * 512 * 1024, MW_END = MW_2 + (size_t)64 * 1024 * 256;
constexpr size_t WS_NEED = OFF_MOEW + MW_END * 2;

struct Params {
    const float* in[N_IN];
    float* out;
    unsigned char* ws;
};

#define WSF(off) ((float*)(p.ws + (off)))
#define WSI(off) ((int*)(p.ws + (off)))
#define WB(el) ((bf16_t*)(p.ws + OFF_W) + (el))
#define CB(el) ((bf16_t*)(p.ws + OFF_C) + (el))
#define DB(el) ((bf16_t*)(p.ws + OFF_D) + (el))
#define MWB(el) ((bf16_t*)(p.ws + OFF_MOEW) + (el))
#define HB ((bf16_t*)(p.ws + OFF_H))
#define XCUR ((float*)(p.ws + OFF_XCUR))

constexpr int SMEM_BYTES = 65536;
constexpr int DYN_LDS = 0;
constexpr int CT_LD = 136;
constexpr int AUX_OFF = 36864;

#ifdef TPROBE
#define T_SLOT(id) ((unsigned long long*)(p.ws + OFF_BAR + 14400) + (id))
#define T_BEGIN(id) const unsigned long long _tb##id = __builtin_amdgcn_s_memrealtime()
#define T_END(id, cond) do { if ((cond) && __builtin_amdgcn_workitem_id_x() == 0) atomicAdd(T_SLOT(id), __builtin_amdgcn_s_memrealtime() - _tb##id); } while (0)
#else
#define T_BEGIN(id)
#define T_END(id, cond)
#endif
DEVI int launder_tid() { int t = __builtin_amdgcn_workitem_id_x(); asm volatile("" : "+v"(t)); return t; }
DEVI int launder_bid() { int t = __builtin_amdgcn_workgroup_id_x(); asm volatile("" : "+s"(t)); return t; }
#define TIDX launder_tid()
#define BIDX launder_bid()
DEVI float bf2f(bf16_t v) { return __uint_as_float(((unsigned)v) << 16); }
DEVI bf16_t f2bf(float f) {
    __bf16 h = (__bf16)f;
    return __builtin_bit_cast(unsigned short, h);
}
typedef __attribute__((ext_vector_type(8))) int i32x8;
typedef __attribute__((ext_vector_type(4))) int i32x4;
DEVI int pk4_fp8(float a, float b, float c, float d) {
    int r = __builtin_amdgcn_cvt_pk_fp8_f32(a, b, 0, false);
    return __builtin_amdgcn_cvt_pk_fp8_f32(c, d, r, true);
}
DEVI float sigmoidf_(float x) { return 1.f / (1.f + __expf(-x)); }
DEVI float siluf_(float x) { return x / (1.f + __expf(-x)); }
DEVI float gelu_tanh(float x) {
    float u = 0.7978845608028654f * (x + 0.044715f * x * x * x);
    return 0.5f * x * (1.f + tanhf(u));
}
DEVI float wave_sum(float v) {
#pragma unroll
    for (int o = 32; o > 0; o >>= 1) v += __shfl_xor(v, o);
    return v;
}
DEVI int mt_of(int q, bool latonly) { return latonly ? (q >> 4) * 18 + 2 + (q & 15) : q; }

struct CvtJob { const float* src; bf16_t* dst; const float* ks; int K, N, ldd, batch; size_t sbs, dbs; int mode; int lds, n0, wide; };
DEVI int cvt_rowmap(int mode, int n) {
    if (mode == 1) return n < 384 ? n : (n < 416 ? n - 384 + 3712 : n - 32);
    if (mode == 2) { int h = n / 96, j = n % 96; return j < 64 ? h * 64 + j : 512 + h * 32 + (j - 64); }
    if (mode == 3) return (n >> 6) * 128 + (n & 63);
    return n;
}
DEVI void cvt_tile(const CvtJob& j, int tile, float* lds) {
    const int tn = j.N / 32, tk = j.K / 64, per = tn * tk;
    const int bb = tile / per, r = tile % per, kt = r / tn, nt = r % tn;
    const float* s = j.src + (size_t)bb * j.sbs + (size_t)(kt * 64) * j.lds + j.n0 + nt * 32;
    const int tx = TIDX & 31, ty = TIDX >> 5;
#pragma unroll
    for (int i = 0; i < 8; ++i) {
        int k = ty + 8 * i;
        float v = s[(size_t)k * j.lds + tx];
        if (j.ks) v *= j.ks[kt * 64 + k];
        lds[k * 33 + tx] = v;
    }
    __syncthreads();
    bf16_t* d = j.dst + (size_t)bb * j.dbs;
#pragma unroll
    for (int i = 0; i < 4; ++i) {
        int n = ty + 8 * i, kk = tx * 2;
        unsigned lo = f2bf(lds[kk * 33 + n]), hi = f2bf(lds[(kk + 1) * 33 + n]);
        int row = cvt_rowmap(j.mode, j.n0 + nt * 32 + n);
        *(unsigned*)(d + (size_t)row * j.ldd + kt * 64 + kk) = lo | (hi << 16);
    }
    __syncthreads();
}

DEVI void cvt_tile256(const CvtJob& j, int tile, unsigned char* smem) {
    constexpr int NS = 68;
    bf16_t* T = (bf16_t*)smem;
    const int tn = j.N / 256, tk = j.K / 64, per = tn * tk;
    const int bb = tile / per, r = tile % per, kt = r / tn, nt = r % tn;
    const float* s = j.src + (size_t)bb * j.sbs + (size_t)(kt * 64) * j.lds + j.n0 + nt * 256;
    const int tid = TIDX, lane = tid & 63, w = tid >> 6;
    float4 v[16];
#pragma unroll
    for (int i = 0; i < 16; ++i) v[i] = *(const float4*)(s + (size_t)(w * 16 + i) * j.lds + lane * 4);
    if (j.ks) {
#pragma unroll
        for (int i = 0; i < 16; ++i) { const float sc = j.ks[kt * 64 + w * 16 + i]; v[i].x *= sc; v[i].y *= sc; v[i].z *= sc; v[i].w *= sc; }
    }
    __syncthreads();
#pragma unroll
    for (int h = 0; h < 2; ++h) {
        bf16x4 q0a, q0b, q1a, q1b, q2a, q2b, q3a, q3b;
#pragma unroll
        for (int e = 0; e < 4; ++e) {
            q0a[e] = (short)f2bf(v[h * 8 + e].x); q0b[e] = (short)f2bf(v[h * 8 + 4 + e].x);
            q1a[e] = (short)f2bf(v[h * 8 + e].y); q1b[e] = (short)f2bf(v[h * 8 + 4 + e].y);
            q2a[e] = (short)f2bf(v[h * 8 + e].z); q2b[e] = (short)f2bf(v[h * 8 + 4 + e].z);
            q3a[e] = (short)f2bf(v[h * 8 + e].w); q3b[e] = (short)f2bf(v[h * 8 + 4 + e].w);
        }
        bf16_t* tp = T + (lane * 4) * NS + w * 16 + h * 8;
        *(bf16x4*)(tp) = q0a; *(bf16x4*)(tp + 4) = q0b;
        *(bf16x4*)(tp + NS) = q1a; *(bf16x4*)(tp + NS + 4) = q1b;
        *(bf16x4*)(tp + 2 * NS) = q2a; *(bf16x4*)(tp + 2 * NS + 4) = q2b;
        *(bf16x4*)(tp + 3 * NS) = q3a; *(bf16x4*)(tp + 3 * NS + 4) = q3b;
    }
    __syncthreads();
    bf16_t* d = j.dst + (size_t)bb * j.dbs;
#pragma unroll
    for (int i = 0; i < 8; ++i) {
        const int c = tid + 256 * i, n = c >> 3, kc = c & 7;
        const bf16x4 lo = *(const bf16x4*)(T + n * NS + kc * 8), hi = *(const bf16x4*)(T + n * NS + kc * 8 + 4);
        const int row = cvt_rowmap(j.mode, j.n0 + nt * 256 + n);
        *(bf16x8*)(d + (size_t)row * j.ldd + kt * 64 + kc * 8) = bf16x8{lo[0], lo[1], lo[2], lo[3], hi[0], hi[1], hi[2], hi[3]};
    }
}
constexpr float W8_SCALE = 32.f;
DEVI void cvt_tile256_fp8(const CvtJob& j, int tile, unsigned char* smem) {
    constexpr int RS = 80;
    const int tn = j.N / 256, tk = j.K / 64, per = tn * tk;
    const int bb = tile / per, r = tile % per, kt = r / tn, nt = r % tn;
    const float* s = j.src + (size_t)bb * j.sbs + (size_t)(kt * 64) * j.lds + nt * 256;
    const int tid = TIDX, lane = tid & 63, w = tid >> 6;
    float4 v[16];
#pragma unroll
    for (int i = 0; i < 16; ++i) v[i] = *(const float4*)(s + (size_t)(w * 16 + i) * j.lds + lane * 4);
    __syncthreads();
    i32x4 q0, q1, q2, q3;
#pragma unroll
    for (int c = 0; c < 4; ++c) {
        q0[c] = pk4_fp8(v[4 * c].x * W8_SCALE, v[4 * c + 1].x * W8_SCALE, v[4 * c + 2].x * W8_SCALE, v[4 * c + 3].x * W8_SCALE);
        q1[c] = pk4_fp8(v[4 * c].y * W8_SCALE, v[4 * c + 1].y * W8_SCALE, v[4 * c + 2].y * W8_SCALE, v[4 * c + 3].y * W8_SCALE);
        q2[c] = pk4_fp8(v[4 * c].z * W8_SCALE, v[4 * c + 1].z * W8_SCALE, v[4 * c + 2].z * W8_SCALE, v[4 * c + 3].z * W8_SCALE);
        q3[c] = pk4_fp8(v[4 * c].w * W8_SCALE, v[4 * c + 1].w * W8_SCALE, v[4 * c + 2].w * W8_SCALE, v[4 * c + 3].w * W8_SCALE);
    }
    unsigned char* tp = smem + (lane * 4) * RS + w * 16;
    *(i32x4*)(tp) = q0; *(i32x4*)(tp + RS) = q1; *(i32x4*)(tp + 2 * RS) = q2; *(i32x4*)(tp + 3 * RS) = q3;
    __syncthreads();
    unsigned char* d = (unsigned char*)j.dst + (size_t)bb * j.dbs;
#pragma unroll
    for (int i = 0; i < 4; ++i) {
        const int c = tid + 256 * i, n = c >> 2, kc = c & 3;
        *(i32x4*)(d + (size_t)cvt_rowmap(j.mode, nt * 256 + n) * j.ldd + kt * 64 + kc * 16) = *(const i32x4*)(smem + n * RS + kc * 16);
    }
}
__constant__ const int CVT_TILES[10] = {224, 80, 12, 8, 128, 256, 64, 32, 32, 32};
constexpr int CVT_PER_LAYER = 224 + 80 + 12 + 8 + 128 + 256 + 64 + 32 + 32 + 32;
DEVI CvtJob get_job(const Params& p, int l, int k) {
    CvtJob j; j.ks = nullptr; j.batch = 1; j.sbs = 0; j.dbs = 0; j.mode = 0; j.n0 = 0; j.wide = 1;
    switch (k) {
    case 0: j.src = p.in[I_WIN] + (size_t)l * 1024 * 3744; j.dst = WB(W_IN + (size_t)l * 3840 * 1024); j.K = 1024; j.N = 3584; j.lds = 3744; j.ldd = 1024; j.mode = 1; break;
    case 1: j.src = p.in[I_WIN] + (size_t)l * 1024 * 3744; j.dst = WB(W_IN + (size_t)l * 3840 * 1024); j.K = 1024; j.N = 160; j.lds = 3744; j.n0 = 3584; j.ldd = 1024; j.mode = 1; j.wide = 0; break;
    case 2: j.src = p.in[I_WUQ] + (size_t)l * 256 * 768; j.dst = WB(W_UQ + (size_t)l * 768 * 256); j.K = 256; j.N = 768; j.lds = 768; j.ldd = 256; j.ks = p.in[I_MQN] + l * 256; j.mode = 2; break;
    case 3: j.src = p.in[I_WUKV] + (size_t)l * 128 * 1024; j.dst = WB(W_UKV + (size_t)l * 1024 * 128); j.K = 128; j.N = 1024; j.lds = 1024; j.ldd = 128; j.ks = p.in[I_MKVN] + l * 128; break;
    case 4: j.src = p.in[I_WBR] + (size_t)l * 4 * 512 * 1024; j.dst = WB(W_BR + (size_t)l * 4 * 1024 * 512); j.K = 512; j.N = 1024; j.lds = 1024; j.ldd = 512; j.batch = 4; j.sbs = 512 * 1024; j.dbs = 1024 * 512; break;
    case 5: j.src = p.in[I_WMG] + (size_t)l * 1024 * 4096; j.dst = WB(W_MG + (size_t)l * 4096 * 1024); j.K = 1024; j.N = 4096; j.lds = 4096; j.ldd = 1024; break;
    case 6: j.src = p.in[I_WOUT] + (size_t)l * 1024 * 1024; j.dst = WB(W_OUT + (size_t)l * 1024 * 1024); j.K = 1024; j.N = 1024; j.lds = 1024; j.ldd = 1024; break;
    case 7: j.src = p.in[I_LWA] + (size_t)l * 16 * 4096; j.dst = WB(W_LRU + (size_t)l * 16 * 8192); j.K = 64; j.N = 64; j.lds = 64; j.ldd = 64; j.batch = 16; j.sbs = 4096; j.dbs = 8192; j.wide = 0; break;
    case 8: j.src = p.in[I_LWX] + (size_t)l * 16 * 4096; j.dst = WB(W_LRU + (size_t)l * 16 * 8192 + 4096); j.K = 64; j.N = 64; j.lds = 64; j.ldd = 64; j.batch = 16; j.sbs = 4096; j.dbs = 8192; j.wide = 0; break;
    default: j.src = p.in[I_RW]; j.dst = WB(W_RT); j.K = 1024; j.N = 64; j.lds = 64; j.ldd = 1024; j.wide = 0; break;
    }
    return j;
}
DEVI CvtJob get_moe_job(const Params& p, int l, int k) {
    CvtJob j; j.ks = nullptr; j.batch = 64; j.sbs = 262144; j.n0 = 0; j.wide = 1;
    if (k == 0) { j.src = p.in[I_W1] + (size_t)l * 64 * 262144; j.dst = MWB(MW_13);     j.K = 1024; j.N = 256; j.lds = 256; j.ldd = 1024; j.dbs = 512 * 1024; j.mode = 3; }
    else if (k == 1) { j.src = p.in[I_W3] + (size_t)l * 64 * 262144; j.dst = (bf16_t*)((unsigned char*)MWB(MW_13) + 64 * 1024); j.K = 1024; j.N = 256; j.lds = 256; j.ldd = 1024; j.dbs = 512 * 1024; j.mode = 3; }
    else { j.src = p.in[I_W2] + (size_t)l * 64 * 262144; j.dst = MWB(MW_2); j.K = 256; j.N = 1024; j.lds = 1024; j.ldd = 256; j.dbs = 262144; j.mode = 0; }
    return j;
}

struct AOp { const bf16_t* base; int ld; int row0; const int* ridx; };
DEVI const bf16_t* arow(const AOp& a, int i) {
    int r = a.ridx ? a.ridx[i] : a.row0 + i;
    return a.base + (size_t)r * a.ld;
}

#if NAIVE_GEMM
template <int BN>
DEVI void gemm_core(f32x4 (&acc)[4][BN / 32], const AOp& A, const bf16_t* B, int ldb, int K, unsigned char* smem) {
    constexpr int NI = BN / 32;
    const int tid = TIDX, lane = tid & 63, wid = tid >> 6, wr = wid >> 1, wc = wid & 1;
    for (int k0 = 0; k0 < K; k0 += 8) {
        bf16x8 bv[NI];
#pragma unroll
        for (int ni = 0; ni < NI; ++ni) bv[ni] = *(const bf16x8*)(B + (size_t)(wc * (BN / 2) + ni * 16 + (lane & 15)) * ldb + k0);
#pragma unroll
        for (int mi = 0; mi < 4; ++mi)
#pragma unroll
            for (int j = 0; j < 4; ++j) {
                bf16x8 av = *(const bf16x8*)(arow(A, wr * 64 + mi * 16 + (lane >> 4) * 4 + j) + k0);
#pragma unroll
                for (int ni = 0; ni < NI; ++ni) {
                    float s = 0.f;
#pragma unroll
                    for (int e = 0; e < 8; ++e) s += bf2f((bf16_t)av[e]) * bf2f((bf16_t)bv[ni][e]);
                    acc[mi][ni][j] += s;
                }
            }
    }
}
#else
#define GAS __attribute__((address_space(1)))
template <int BN, bool GATHER = false>
DEVI void gemm_core(f32x4 (&acc)[4][BN / 32], const AOp& A, const bf16_t* B, int ldb, int K, unsigned char* smem) {
    constexpr int NI = BN / 32;
    constexpr int NBL = BN / 32;
    constexpr int STG = 32768;
    const int tid = TIDX, lane = tid & 63, wid = tid >> 6, wr = wid >> 1, wc = wid & 1;
    const int lr = tid >> 3;
    const int kc = (tid & 7) ^ (lr & 7);
    const bf16_t* ap[GATHER ? 4 : 1];
    if (GATHER) {
#pragma unroll
        for (int i = 0; i < (GATHER ? 4 : 1); ++i) ap[i] = arow(A, lr + 32 * i) + kc * 8;
    } else ap[0] = A.base + (size_t)(A.row0 + lr) * A.ld + kc * 8;
    const size_t astep = (size_t)32 * A.ld;
    const bf16_t* bp = B + (size_t)lr * ldb + kc * 8;
    const size_t bstep = (size_t)32 * ldb;
    LAS unsigned char* lA = (LAS unsigned char*)smem + tid * 16;
    LAS unsigned char* lB = lA + 16384;
    const int nk = K >> 6;
    const int arow_off = (wr * 64 + (lane & 15)) * 128;
    const int brow_off = 16384 + (wc * (BN / 2) + (lane & 15)) * 128;
    __syncthreads();
#pragma unroll
    for (int i = 0; i < 4; ++i) __builtin_amdgcn_global_load_lds((const GAS unsigned*)(GATHER ? ap[GATHER ? i : 0] : ap[0] + i * astep), (LAS unsigned*)(lA + i * 4096), 16, 0, 0);
#pragma unroll
    for (int i = 0; i < NBL; ++i) __builtin_amdgcn_global_load_lds((const GAS unsigned*)(bp + i * bstep), (LAS unsigned*)(lB + i * 4096), 16, 0, 0);
    for (int kt = 0; kt < nk; ++kt) {
        __syncthreads();
        if (kt + 1 < nk) {
            const int ko = (kt + 1) * 64;
            const int so = ((kt + 1) & 1) * STG;
#pragma unroll
            for (int i = 0; i < 4; ++i) __builtin_amdgcn_global_load_lds((const GAS unsigned*)((GATHER ? ap[GATHER ? i : 0] : ap[0] + i * astep) + ko), (LAS unsigned*)(lA + so + i * 4096), 16, 0, 0);
#pragma unroll
            for (int i = 0; i < NBL; ++i) __builtin_amdgcn_global_load_lds((const GAS unsigned*)(bp + i * bstep + ko), (LAS unsigned*)(lB + so + i * 4096), 16, 0, 0);
        }
        const unsigned char* cs = smem + (kt & 1) * STG;
#pragma unroll
        for (int ks = 0; ks < 2; ++ks) {
            const int pch = ((ks * 4 + (lane >> 4)) ^ (lane & 7)) << 4;
            bf16x8 bfr[NI];
#pragma unroll
            for (int ni = 0; ni < NI; ++ni) bfr[ni] = *(const bf16x8*)(cs + brow_off + ni * 2048 + pch);
#pragma unroll
            for (int mi = 0; mi < 4; mi += 2) {
                const bf16x8 a0 = *(const bf16x8*)(cs + arow_off + mi * 2048 + pch);
                const bf16x8 a1 = *(const bf16x8*)(cs + arow_off + (mi + 1) * 2048 + pch);
#pragma unroll
                for (int ni = 0; ni < NI; ++ni) acc[mi][ni] = __builtin_amdgcn_mfma_f32_16x16x32_bf16(a0, bfr[ni], acc[mi][ni], 0, 0, 0);
#pragma unroll
                for (int ni = 0; ni < NI; ++ni) acc[mi + 1][ni] = __builtin_amdgcn_mfma_f32_16x16x32_bf16(a1, bfr[ni], acc[mi + 1][ni], 0, 0, 0);
            }
        }
    }
}
#endif

template <bool GATHER = false>
DEVI void gemm_core_fp8(f32x4 (&acc)[4][4], const unsigned char* Ab, size_t lda, int row0, const unsigned char* Bb, size_t ldb, int K, unsigned char* smem, const int* ridx = nullptr) {
    constexpr int STG = 32768;
    const int tid = TIDX, lane = tid & 63, wid = tid >> 6, wr = wid >> 1, wc = wid & 1;
    const int lr = tid >> 3;
    const int kc = (tid & 7) ^ (lr & 7);
    const unsigned char* ap[GATHER ? 4 : 1];
    if (GATHER) {
#pragma unroll
        for (int i = 0; i < (GATHER ? 4 : 1); ++i) ap[i] = Ab + (size_t)ridx[lr + 32 * i] * lda + kc * 16;
    } else ap[0] = Ab + (size_t)(row0 + lr) * lda + kc * 16;
    const size_t astep = GATHER ? 0 : 32 * lda;
    const unsigned char* bp = Bb + (size_t)lr * ldb + kc * 16;
    const size_t bstep = 32 * ldb;
    LAS unsigned char* lA = (LAS unsigned char*)smem + tid * 16;
    LAS unsigned char* lB = lA + 16384;
    const int nk = K >> 7;
    const int arow_off = (wr * 64 + (lane & 15)) * 128;
    const int brow_off = 16384 + (wc * 64 + (lane & 15)) * 128;
    const int c0 = ((2 * (lane >> 4)) ^ (lane & 7)) << 4, c1 = ((2 * (lane >> 4) + 1) ^ (lane & 7)) << 4;
    __syncthreads();
#pragma unroll
    for (int i = 0; i < 4; ++i) __builtin_amdgcn_global_load_lds((const GAS unsigned*)(ap[GATHER ? i : 0] + i * astep), (LAS unsigned*)(lA + i * 4096), 16, 0, 0);
#pragma unroll
    for (int i = 0; i < 4; ++i) __builtin_amdgcn_global_load_lds((const GAS unsigned*)(bp + i * bstep), (LAS unsigned*)(lB + i * 4096), 16, 0, 0);
#pragma unroll 1
    for (int kt = 0; kt < nk; ++kt) {
        __syncthreads();
        if (kt + 1 < nk) {
            const int ko = (kt + 1) * 128;
            const int so = ((kt + 1) & 1) * STG;
#pragma unroll
            for (int i = 0; i < 4; ++i) __builtin_amdgcn_global_load_lds((const GAS unsigned*)(ap[GATHER ? i : 0] + i * astep + ko), (LAS unsigned*)(lA + so + i * 4096), 16, 0, 0);
#pragma unroll
            for (int i = 0; i < 4; ++i) __builtin_amdgcn_global_load_lds((const GAS unsigned*)(bp + i * bstep + ko), (LAS unsigned*)(lB + so + i * 4096), 16, 0, 0);
        }
        const unsigned char* cs = smem + (kt & 1) * STG;
        i32x8 bfr[4];
#pragma unroll
        for (int ni = 0; ni < 4; ++ni) {
            const i32x4 lo = *(const i32x4*)(cs + brow_off + ni * 2048 + c0), hi = *(const i32x4*)(cs + brow_off + ni * 2048 + c1);
            bfr[ni] = i32x8{lo[0], lo[1], lo[2], lo[3], hi[0], hi[1], hi[2], hi[3]};
        }
#pragma unroll
        for (int mi = 0; mi < 4; ++mi) {
            const i32x4 lo = *(const i32x4*)(cs + arow_off + mi * 2048 + c0), hi = *(const i32x4*)(cs + arow_off + mi * 2048 + c1);
            const i32x8 af = i32x8{lo[0], lo[1], lo[2], lo[3], hi[0], hi[1], hi[2], hi[3]};
#pragma unroll
            for (int ni = 0; ni < 4; ++ni)
                acc[mi][ni] = __builtin_amdgcn_mfma_scale_f32_16x16x128_f8f6f4(af, bfr[ni], acc[mi][ni], 0, 0, 0, 0x7f7f7f7f, 0, 0x7a7a7a7a);
        }
    }
}

template <int BN>
DEVI void acc_zero(f32x4 (&acc)[4][BN / 32]) {
#pragma unroll
    for (int mi = 0; mi < 4; ++mi)
#pragma unroll
        for (int ni = 0; ni < BN / 32; ++ni) acc[mi][ni] = f32x4{0.f, 0.f, 0.f, 0.f};
}
template <int BN>
DEVI void acc_to_ct(const f32x4 (&acc)[4][BN / 32], bf16_t* ct) {
    const int tid = TIDX, lane = tid & 63, wid = tid >> 6, wr = wid >> 1, wc = wid & 1;
#pragma unroll
    for (int mi = 0; mi < 4; ++mi)
#pragma unroll
        for (int ni = 0; ni < BN / 32; ++ni)
#pragma unroll
            for (int j = 0; j < 4; ++j)
                ct[(wr * 64 + mi * 16 + (lane >> 4) * 4 + j) * CT_LD + wc * (BN / 2) + ni * 16 + (lane & 15)] = f2bf(acc[mi][ni][j]);
}

template <int NC>
DEVI void ep_store_rows(const bf16_t* ct, int c0, bf16_t* dst, int ldd, int row0) {
    constexpr int CPR = NC / 8;
    for (int c = TIDX; c < 128 * CPR; c += 256) {
        int i = c / CPR, jc = c % CPR;
        *(bf16x8*)(dst + (size_t)(row0 + i) * ldd + jc * 8) = *(const bf16x8*)(ct + i * CT_LD + c0 + jc * 8);
    }
}
DEVI void ep_store_T(const bf16_t* ct, int c0, int nc, bf16_t* dstT, int ldT, int t0) {
    for (int c = TIDX; c < nc * 16; c += 256) {
        int j = c >> 4, ic = c & 15;
        bf16x8 v;
#pragma unroll
        for (int e = 0; e < 8; ++e) v[e] = (short)ct[(ic * 8 + e) * CT_LD + c0 + j];
        *(bf16x8*)(dstT + (size_t)j * ldT + t0 + ic * 8) = v;
    }
}
DEVI void ep_rope64(bf16_t* ct, const float* gain, float scale, bool lat, int pos0, const float* cs64) {
    const int row = TIDX >> 1, half = TIDX & 1;
    bf16_t* pr = ct + row * CT_LD + half * 64;
    float v[64];
#pragma unroll
    for (int c = 0; c < 8; ++c) {
        bf16x8 t = *(const bf16x8*)(pr + c * 8);
#pragma unroll
        for (int e = 0; e < 8; ++e) v[c * 8 + e] = bf2f((bf16_t)t[e]);
    }
    if (gain) {
        float ss = 0.f;
#pragma unroll
        for (int d = 0; d < 64; ++d) ss += v[d] * v[d];
        float rstd = rsqrtf(ss * (1.f / 64.f) + EPSV);
#pragma unroll
        for (int d = 0; d < 64; ++d) v[d] = v[d] * rstd * gain[d];
    }
    if (lat) {
        const float* cs = cs64 + (size_t)(pos0 + row) * 64;
#pragma unroll
        for (int i = 0; i < 16; ++i) {
            float a = v[i], b = v[i + 16], c = cs[i], s = cs[32 + i];
            v[i] = a * c - b * s; v[i + 16] = b * c + a * s;
            a = v[32 + i]; b = v[48 + i]; c = cs[16 + i]; s = cs[48 + i];
            v[32 + i] = a * c - b * s; v[48 + i] = b * c + a * s;
        }
    }
#pragma unroll
    for (int c = 0; c < 8; ++c) {
        bf16x8 t;
#pragma unroll
        for (int e = 0; e < 8; ++e) t[e] = (short)f2bf(v[c * 8 + e] * scale);
        *(bf16x8*)(pr + c * 8) = t;
    }
}
DEVI void ep_rope32(bf16_t* ct, int ngroups, const float* rstd, float scale, bool lat, int pos0, const float* cs32) {
    const int row = TIDX >> 1, half = TIDX & 1;
    const float rs = (rstd ? rstd[row] : 1.f) * scale;
#pragma unroll
    for (int gg = 0; gg < 2; ++gg) {
        const int g = half * 2 + gg;
        if (g < ngroups) {
            bf16_t* pr = ct + row * CT_LD + g * 32;
            float v[32];
#pragma unroll
            for (int c = 0; c < 4; ++c) {
                bf16x8 t = *(const bf16x8*)(pr + c * 8);
#pragma unroll
                for (int e = 0; e < 8; ++e) v[c * 8 + e] = bf2f((bf16_t)t[e]);
            }
            if (lat) {
                const float* cs = cs32 + (size_t)(pos0 + row) * 32;
#pragma unroll
                for (int i = 0; i < 8; ++i) {
                    float a = v[i], b = v[i + 8], c = cs[i], s = cs[16 + i];
                    v[i] = a * c - b * s; v[i + 8] = b * c + a * s;
                    a = v[16 + i]; b = v[24 + i]; c = cs[8 + i]; s = cs[24 + i];
                    v[16 + i] = a * c - b * s; v[24 + i] = b * c + a * s;
                }
            }
#pragma unroll
            for (int c = 0; c < 4; ++c) {
                bf16x8 t;
#pragma unroll
                for (int e = 0; e < 8; ++e) t[e] = (short)f2bf(v[c * 8 + e] * rs);
                *(bf16x8*)(pr + c * 8) = t;
            }
        }
    }
}
DEVI void ep_scale_rows(bf16_t* ct, int c0, int nc, const float* rstd, float scale) {
    const int cpr = nc / 8;
    for (int c = TIDX; c < 128 * cpr; c += 256) {
        int i = c / cpr, jc = c % cpr;
        bf16_t* pr = ct + i * CT_LD + c0 + jc * 8;
        bf16x8 t = *(const bf16x8*)pr;
        float rs = rstd[i] * scale;
#pragma unroll
        for (int e = 0; e < 8; ++e) t[e] = (short)f2bf(bf2f((bf16_t)t[e]) * rs);
        *(bf16x8*)pr = t;
    }
}
DEVI void ep_rstd(const bf16_t* A, int ld, int row0, int K, float* rstd) {
    const int row = TIDX >> 1, half = TIDX & 1;
    const bf16_t* pr = A + (size_t)(row0 + row) * ld + half * (K / 2);
    float ss = 0.f;
    for (int c = 0; c < K / 16; ++c) {
        bf16x8 t = *(const bf16x8*)(pr + c * 8);
#pragma unroll
        for (int e = 0; e < 8; ++e) { float f = bf2f((bf16_t)t[e]); ss += f * f; }
    }
    ss += __shfl_xor(ss, 1);
    if (half == 0) rstd[row] = rsqrtf(ss / (float)K + EPSV);
}


struct GrpInfo { int xcd, j, per, ngrp; };
DEVI GrpInfo grp_info(const Params& p) {
    const unsigned* pv = (const unsigned*)(p.ws + OFF_PRIV + (size_t)BIDX * 1024 + 896);
    GrpInfo g;
    g.xcd = (int)__hip_atomic_load(pv + 2, __ATOMIC_RELAXED, __HIP_MEMORY_SCOPE_AGENT);
    g.j = (int)__hip_atomic_load(pv + 3, __ATOMIC_RELAXED, __HIP_MEMORY_SCOPE_AGENT);
    g.per = (int)__hip_atomic_load((const unsigned*)(p.ws + OFF_BAR) + 256 + 64 * g.xcd, __ATOMIC_RELAXED, __HIP_MEMORY_SCOPE_AGENT);
    g.ngrp = 8;
    if (g.xcd >= 8 || g.per <= 0) { g.xcd = 0; g.j = BIDX; g.per = gridDim.x; g.ngrp = 1; }
    return g;
}
DEVI bool super_tile(const GrpInfo& gi, int it, int NMT, int NNT, int SM, int SN, int& mt, int& nt) {
    const int ST = SM * SN, passes = (ST + gi.per - 1) / gi.per;
    const int nsn = (NNT + SN - 1) / SN, nsm = (NMT + SM - 1) / SM;
    const int s = (it / passes) * gi.ngrp + gi.xcd;
    if (s >= nsm * nsn) return false;
    const int idx = (it % passes) * gi.per + gi.j;
    mt = -1; nt = 0;
    if (idx < ST) {
        const int m = (s / nsn) * SM + idx / SN, n = (s % nsn) * SN + idx % SN;
        if (m < NMT && n < NNT) { mt = m; nt = n; }
    }
    return true;
}

DEVI void phase0(const Params& p, unsigned char* smem) {
    const int tid = TIDX, lane = tid & 63, w = tid >> 6;
    const int NG = 192, NCV = 2 * CVT_PER_LAYER, NR = 192;
    const int ntask = NG + NCV + NR + 1;
    for (int task = BIDX; task < ntask; task += gridDim.x) {
        if (task < NG) {
            const int l = task / 96, n0 = (task % 96) * 64;
            float* sv = (float*)smem;
            float* red = (float*)smem;
            for (int idx = lane; idx < 9 * 256; idx += 64) {
                int bi = idx >> 8, kk = idx & 255, k = 256 * w + kk;
                float c = bi < 8 ? p.in[I_C][bi * 1024 + k] : p.in[I_CCTX][k];
                sv[(w * 9 + bi) * 256 + kk] = siluf_(c);
            }
            __syncthreads();
            const int ksub = lane >> 4, c4 = (lane & 15) * 4;
            float acc[9][4];
#pragma unroll
            for (int bi = 0; bi < 9; ++bi) { acc[bi][0] = 0.f; acc[bi][1] = 0.f; acc[bi][2] = 0.f; acc[bi][3] = 0.f; }
            const float* wp = p.in[I_ADAW] + (size_t)l * 1024 * 6144 + (size_t)(256 * w + ksub) * 6144 + n0 + c4;
#pragma unroll 8
            for (int i = 0; i < 64; ++i) {
                const float4 wv = *(const float4*)(wp + (size_t)(4 * i) * 6144);
#pragma unroll
                for (int bi = 0; bi < 9; ++bi) {
                    const float sx = sv[(w * 9 + bi) * 256 + 4 * i + ksub];
                    acc[bi][0] += sx * wv.x; acc[bi][1] += sx * wv.y; acc[bi][2] += sx * wv.z; acc[bi][3] += sx * wv.w;
                }
            }
            __syncthreads();
#pragma unroll
            for (int bi = 0; bi < 9; ++bi)
                *(float4*)(red + (((w * 4 + ksub) * 9 + bi) * 64) + c4) = make_float4(acc[bi][0], acc[bi][1], acc[bi][2], acc[bi][3]);
            __syncthreads();
            for (int idx = tid; idx < 9 * 64; idx += 256) {
                int bi = idx >> 6, c = idx & 63;
                float sacc = p.in[I_ADAB][l * 6144 + n0 + c];
#pragma unroll
                for (int q = 0; q < 16; ++q) sacc += red[((q * 9 + bi) * 64) + c];
                WSF(OFF_MOD)[(size_t)(l * 9 + bi) * 6144 + n0 + c] = sacc;
            }
            __syncthreads();
        } else if (task < NG + NCV) {
            int t = task - NG;
            int l = t / CVT_PER_LAYER; t %= CVT_PER_LAYER;
            int k = 0;
            while (t >= CVT_TILES[k]) { t -= CVT_TILES[k]; ++k; }
            CvtJob j = get_job(p, l, k);
            if (k == 5) cvt_tile256_fp8(j, t, smem); else if (j.wide) cvt_tile256(j, t, smem); else cvt_tile(j, t, (float*)smem);
        } else if (task < NG + NCV + NR) {
            const int idx = (task - NG - NCV) * 256 + tid;
            const int pos = idx / 24, f = idx % 24;
            const float rp = (float)(pos >> 6), cp = (float)(pos & 63);
            if (f < 16) {
                const float inv = powf(10000.f, -(float)(2 * f) / 32.f);
                const float ar = rp * inv, ac = cp * inv;
                float* t64 = WSF(OFF_R64) + (size_t)pos * 64;
                t64[f] = cosf(ar); t64[16 + f] = cosf(ac); t64[32 + f] = sinf(ar); t64[48 + f] = sinf(ac);
            } else {
                const int i = f - 16;
                const float inv = powf(10000.f, -(float)(2 * i) / 16.f);
                const float ar = rp * inv, ac = cp * inv;
                float* t32 = WSF(OFF_R32) + (size_t)pos * 32;
                t32[i] = cosf(ar); t32[8 + i] = cosf(ac); t32[16 + i] = sinf(ar); t32[24 + i] = sinf(ac);
            }
        } else {
            for (int i = tid; i < 4096; i += 256) WSI(OFF_CNT)[i] = 0;
            for (int l = 0; l < 2; ++l) {
                unsigned* z = (unsigned*)WB(W_IN + (size_t)l * 3840 * 1024 + (size_t)3744 * 1024);
                for (int i = tid; i < 96 * 1024 / 2; i += 256) z[i] = 0u;
            }
        }
    }
}

struct MoeTab {
    int* base;
    DEVI int cnt(int e) const { return __hip_atomic_load(base + e, __ATOMIC_RELAXED, __HIP_MEMORY_SCOPE_AGENT); }
    DEVI int tp(int e) const { return __hip_atomic_load(base + 64 + e, __ATOMIC_RELAXED, __HIP_MEMORY_SCOPE_AGENT); }
    DEVI int seg(int e) const { return __hip_atomic_load(base + 136 + e, __ATOMIC_RELAXED, __HIP_MEMORY_SCOPE_AGENT); }
};
DEVI MoeTab moe_tables(const Params& p, int l, unsigned char* smem) {
    MoeTab t; t.base = (int*)(p.ws + OFF_PRIV + (size_t)BIDX * 1024);
    __syncthreads();
    if (TIDX == 0) {
        int a = 0, sg = 0;
        for (int e = 0; e < 64; ++e) {
            const int c = WSI(OFF_CNT)[l * 64 + e];
            __hip_atomic_store(t.base + e, c, __ATOMIC_RELAXED, __HIP_MEMORY_SCOPE_AGENT);
            __hip_atomic_store(t.base + 64 + e, a, __ATOMIC_RELAXED, __HIP_MEMORY_SCOPE_AGENT);
            __hip_atomic_store(t.base + 136 + e, sg, __ATOMIC_RELAXED, __HIP_MEMORY_SCOPE_AGENT);
            const int nt = (c + 127) >> 7;
            a += nt; sg += nt * 128;
        }
        __hip_atomic_store(t.base + 64 + 64, a, __ATOMIC_RELAXED, __HIP_MEMORY_SCOPE_AGENT);
        __hip_atomic_store(t.base + 136 + 64, sg, __ATOMIC_RELAXED, __HIP_MEMORY_SCOPE_AGENT);
    }
    asm volatile("s_waitcnt vmcnt(0)" ::: "memory");
    __syncthreads();
    return t;
}
struct Rec { int e0, p0, e1, p1; float w0, w1; int pad0, pad1; };

DEVI void phase_norm1(const Params& p, int l, int mode, unsigned char* smem) {
    const int lane = TIDX & 63, w = TIDX >> 6;
    MoeTab mt;
    const bool comb = (mode == 0 && l > 0) || mode == 1;
    const int lp = mode == 1 ? 1 : l - 1;
    if (comb) mt = moe_tables(p, lp, smem);
    const float* g1 = mode == 1 ? p.in[I_FN] : (mode == 2 ? p.in[I_N2G] + l * 1024 : p.in[I_N1G] + l * 1024);
    const bool latonly = (mode == 1) || (mode == 2 && l == 1);
    const int nrows = latonly ? NBT * SEQL : TT;
    const int stride = gridDim.x * 4;
    int ri = BIDX * 4 + w;
    float4 xn[4];
    auto rowof = [&](int r) { return latonly ? (r >> 11) * TPB + CTXL + (r & 2047) : r; };
    auto srcof = [&](int row) -> const float* {
        if (mode == 0 && l == 0) {
            const int b = row / TPB, t = row % TPB;
            return t < CTXL ? p.in[I_CTX] + ((size_t)b * CTXL + t) * DM : p.in[I_X] + ((size_t)b * SEQL + (t - CTXL)) * DM;
        }
        return XCUR + (size_t)row * DM;
    };
    if (ri < nrows) {
        const float* src = srcof(rowof(ri));
#pragma unroll
        for (int i = 0; i < 4; ++i) xn[i] = *(const float4*)(src + i * 256 + lane * 4);
    }
    for (; ri < nrows; ri += stride) {
        const int row = rowof(ri);
        const int b = row / TPB, t = row % TPB;
        const bool isctx = t < CTXL;
        const int bi = isctx ? 8 : b;
        float v[16];
#pragma unroll
        for (int i = 0; i < 4; ++i) { v[i * 4] = xn[i].x; v[i * 4 + 1] = xn[i].y; v[i * 4 + 2] = xn[i].z; v[i * 4 + 3] = xn[i].w; }
        if (ri + stride < nrows) {
            const float* src = srcof(rowof(ri + stride));
#pragma unroll
            for (int i = 0; i < 4; ++i) xn[i] = *(const float4*)(src + i * 256 + lane * 4);
        }
        if (comb) {
            float* xr = XCUR + (size_t)row * DM;
            const Rec rc = ((const Rec*)(p.ws + OFF_REC))[row];
            const bf16_t* y0 = DB(D_YS) + (size_t)(mt.seg(rc.e0) + rc.p0) * 1024;
            const bf16_t* y1 = DB(D_YS) + (size_t)(mt.seg(rc.e1) + rc.p1) * 1024;
            const float* gate = WSF(OFF_MOD) + (size_t)(lp * 9 + bi) * 6144 + 5 * 1024;
#pragma unroll
            for (int i = 0; i < 4; ++i) {
                const int c = i * 256 + lane * 4;
                float4 g4 = *(const float4*)(gate + c);
                uint2 a = *(const uint2*)(y0 + c), bb = *(const uint2*)(y1 + c);
                float f0 = rc.w0 * __uint_as_float(a.x << 16) + rc.w1 * __uint_as_float(bb.x << 16);
                float f1 = rc.w0 * __uint_as_float(a.x & 0xffff0000u) + rc.w1 * __uint_as_float(bb.x & 0xffff0000u);
                float f2 = rc.w0 * __uint_as_float(a.y << 16) + rc.w1 * __uint_as_float(bb.y << 16);
                float f3 = rc.w0 * __uint_as_float(a.y & 0xffff0000u) + rc.w1 * __uint_as_float(bb.y & 0xffff0000u);
                v[i * 4] += g4.x * f0; v[i * 4 + 1] += g4.y * f1; v[i * 4 + 2] += g4.z * f2; v[i * 4 + 3] += g4.w * f3;
                if (mode == 0) *(float4*)(xr + c) = make_float4(v[i * 4], v[i * 4 + 1], v[i * 4 + 2], v[i * 4 + 3]);
            }
        }
        float ss = 0.f;
#pragma unroll
        for (int i = 0; i < 16; ++i) ss += v[i] * v[i];
        ss = wave_sum(ss);
        const float rstd = rsqrtf(ss * (1.f / 1024.f) + EPSV);
        if (mode == 1) {
            float* o = p.out + ((size_t)b * SEQL + (t - CTXL)) * DM;
#pragma unroll
            for (int i = 0; i < 4; ++i) {
                const int c = i * 256 + lane * 4;
                float4 g4 = *(const float4*)(g1 + c);
                float4 r4;
                r4.x = v[i * 4] * rstd * g4.x; r4.y = v[i * 4 + 1] * rstd * g4.y; r4.z = v[i * 4 + 2] * rstd * g4.z; r4.w = v[i * 4 + 3] * rstd * g4.w;
                *(float4*)(o + c) = r4;
            }
        } else {
            const float* md = WSF(OFF_MOD) + (size_t)(l * 9 + bi) * 6144 + (mode == 2 ? 3 * 1024 : 0);
            bf16_t* ho = HB + (size_t)row * DM;
#pragma unroll
            for (int i = 0; i < 4; ++i) {
                const int c = i * 256 + lane * 4;
                float4 g4 = *(const float4*)(g1 + c);
                float4 sh = *(const float4*)(md + c);
                float4 sc = *(const float4*)(md + 1024 + c);
                float h0 = v[i * 4] * rstd * g4.x * (1.f + sc.x) + sh.x;
                float h1 = v[i * 4 + 1] * rstd * g4.y * (1.f + sc.y) + sh.y;
                float h2 = v[i * 4 + 2] * rstd * g4.z * (1.f + sc.z) + sh.z;
                float h3 = v[i * 4 + 3] * rstd * g4.w * (1.f + sc.w) + sh.w;
                uint2 o2;
                o2.x = (unsigned)f2bf(h0) | ((unsigned)f2bf(h1) << 16);
                o2.y = (unsigned)f2bf(h2) | ((unsigned)f2bf(h3) << 16);
                *(uint2*)(ho + c) = o2;
                if (mode == 2) *(int*)((unsigned char*)CB(0) + (size_t)row * 1024 + c) = pk4_fp8(h0, h1, h2, h3);
            }
        }
    }
}

DEVI int fetch_task(int* ctr, unsigned char* smem) {
    __syncthreads();
    if (TIDX == 0) *(volatile int*)smem = atomicAdd(ctr, 1);
    __syncthreads();
    return *(volatile int*)smem;
}
DEVI void dep_signal(int* cnt) {
    asm volatile("s_waitcnt vmcnt(0)" ::: "memory");
    __syncthreads();
    if (TIDX == 0) {
        __builtin_amdgcn_fence(__ATOMIC_RELEASE, "agent");
        asm volatile("s_waitcnt vmcnt(0)" ::: "memory");
        __hip_atomic_fetch_add(cnt, 1, __ATOMIC_RELAXED, __HIP_MEMORY_SCOPE_AGENT);
    }
}
DEVI void dep_wait(int* cnt, int need) {
    if (TIDX == 0) {
        while (__hip_atomic_load(cnt, __ATOMIC_RELAXED, __HIP_MEMORY_SCOPE_AGENT) < need) __builtin_amdgcn_s_sleep(2);
        __builtin_amdgcn_fence(__ATOMIC_ACQUIRE, "agent");
        asm volatile("s_waitcnt vmcnt(0)" ::: "memory");
    }
    __syncthreads();
}

DEVI void phase_win(const Params& p, int l, unsigned char* smem) {
    bf16_t* ct = (bf16_t*)smem;
    const float* cs64 = WSF(OFF_R64);
    const float* cs32 = WSF(OFF_R32);
    int* ctr = WSI(OFF_CNT) + 134 + l;
    for (;;) {
        const int task = fetch_task(ctr, smem);
        if (task >= 144 * 30) break;
        const int mt = task / 30, nt = task % 30;
        const int row0 = mt * 128, b = mt / 18, t0 = (mt % 18) * 128;
        const bool lat = (mt % 18) >= 2;
        const int pos0 = t0 - CTXL;
        f32x4 acc[4][4];
        acc_zero<128>(acc);
        AOp A{HB, 1024, row0, nullptr};
        T_BEGIN(3);
        gemm_core<128>(acc, A, WB(W_IN + (size_t)l * 3840 * 1024 + (size_t)nt * 128 * 1024), 1024, 1024, smem);
        __syncthreads();
        T_END(3, l == 0 && BIDX == 8);
        T_BEGIN(4);
        acc_to_ct<128>(acc, ct);
        __syncthreads();
        if (nt < 2) ep_store_rows<128>(ct, 0, CB(C_CQ) + nt * 128, 256, row0);
        else if (nt == 2) ep_store_rows<128>(ct, 0, CB(C_CKV), 128, row0);
        else if (nt < 5) { ep_rope64(ct, nullptr, 1.f, lat, pos0, cs64); __syncthreads(); ep_store_rows<128>(ct, 0, CB(C_RQ) + (nt - 3) * 128, 256, row0); }
        else if (nt < 7) {
            ep_rope64(ct, nullptr, 0.125f, lat, pos0, cs64); __syncthreads();
            ep_store_rows<128>(ct, 0, CB(C_RK) + (nt - 5) * 128, 256, row0);
            ep_store_T(ct, 0, 128, CB(C_RKT) + ((size_t)b * 256 + (nt - 5) * 128) * TPB, TPB, t0);
        }
        else if (nt < 11) ep_store_T(ct, 0, 128, CB(C_RVT) + ((size_t)b * 4 + (nt - 7)) * 128 * TPB, TPB, t0);
        else if (nt < 15) ep_store_rows<128>(ct, 0, CB(C_RG) + (nt - 11) * 128, 512, row0);
        else if (nt < 19) ep_store_rows<128>(ct, 0, CB(C_LX) + (nt - 15) * 128, 512, row0);
        else if (nt < 23) ep_store_rows<128>(ct, 0, CB(C_LG) + (nt - 19) * 128, 512, row0);
        else if (nt < 27) { ep_rope64(ct, p.in[I_GQN] + l * 64, 0.125f * LOG2E, lat, pos0, cs64); __syncthreads(); ep_store_rows<128>(ct, 0, CB(C_GQ) + (nt - 23) * 128, 512, row0); }
        else if (nt == 27) { ep_rope64(ct, p.in[I_GKN] + l * 64, 1.f, lat, pos0, cs64); __syncthreads(); ep_store_rows<128>(ct, 0, CB(C_GK), 128, row0); }
        else if (nt == 28) ep_store_T(ct, 0, 128, CB(C_GVT) + (size_t)b * 128 * TPB, TPB, t0);
        else { ep_rope32(ct, 1, nullptr, 1.f, lat, pos0, cs32); __syncthreads(); ep_store_rows<32>(ct, 0, CB(C_KR), 32, row0); }
        __syncthreads();
        T_END(4, l == 0 && BIDX == 8);
    }
}

DEVI float ret_lg2(const Params& p, int l, int dir, int h) { return -log1pf(expf(-p.in[I_RDEC][l * 8 + dir * 4 + h])) * LOG2E; }
DEVI void ret_chunk_U(const Params& p, int l, int task) {
    const int b = task / 72, r = task % 72, h = r / 18, m = r % 18;
    const int tid = TIDX, lane = tid & 63, w = tid >> 6, qc = lane & 31, hh = lane >> 5;
    const int t0 = m * 128;
    const bf16_t* KTg = CB(C_RKT) + ((size_t)b * 4 + h) * 64 * TPB + t0 + 8 * hh;
    const bf16_t* VTg = CB(C_RVT) + (((size_t)b * 4 + h) * 128 + w * 32 + qc) * TPB + t0 + 8 * hh;
    bf16x8 vf[8], ka[2][8];
#pragma unroll
    for (int ks = 0; ks < 8; ++ks) vf[ks] = *(const bf16x8*)(VTg + ks * 16);
#pragma unroll
    for (int sub = 0; sub < 2; ++sub)
#pragma unroll
        for (int ks = 0; ks < 8; ++ks) ka[sub][ks] = *(const bf16x8*)(KTg + (size_t)(32 * sub + qc) * TPB + ks * 16);
#pragma unroll
    for (int dir = 0; dir < 2; ++dir) {
        const float lg2 = ret_lg2(p, l, dir, h);
        f32x16 U0, U1;
#pragma unroll
        for (int rr = 0; rr < 16; ++rr) { U0[rr] = 0.f; U1[rr] = 0.f; }
#pragma unroll
        for (int ks = 0; ks < 8; ++ks) {
            bf16x8 vs;
#pragma unroll
            for (int e = 0; e < 8; ++e) {
                const int j = 16 * ks + 8 * hh + e;
                const float kd = __builtin_amdgcn_exp2f(lg2 * (float)(dir == 0 ? 127 - j : j));
                vs[e] = (short)f2bf(bf2f((bf16_t)vf[ks][e]) * kd);
            }
            U0 = __builtin_amdgcn_mfma_f32_32x32x16_bf16(ka[0][ks], vs, U0, 0, 0, 0);
            U1 = __builtin_amdgcn_mfma_f32_32x32x16_bf16(ka[1][ks], vs, U1, 0, 0, 0);
        }
        bf16_t* up = DB(D_OB) + ((((size_t)(b * 4 + h) * 18 + m) * 2 + dir) * 128) * 64 + (size_t)(32 * w + qc) * 8 + 4 * hh;
#pragma unroll
        for (int g = 0; g < 4; ++g) {
            bf16x4 a, c;
#pragma unroll
            for (int e = 0; e < 4; ++e) { a[e] = (short)f2bf(U0[4 * g + e]); c[e] = (short)f2bf(U1[4 * g + e]); }
            *(bf16x4*)(up + (((g >> 1) * 2 + (g & 1)) * 128) * 8) = a;
            *(bf16x4*)(up + (((2 + (g >> 1)) * 2 + (g & 1)) * 128) * 8) = c;
        }
    }
}
DEVI void ret_out_task(const Params& p, int l, int b, int h, int m, unsigned char* smem) {
    constexpr int PLD = 136;
    bf16_t* P = (bf16_t*)smem;
    float* red = (float*)(smem + 34816);
    const int tid = TIDX, lane = tid & 63, w = tid >> 6, qc = lane & 31, hh = lane >> 5;
    const int t0 = m * 128, iq = 32 * w + qc;
    const float lgf = ret_lg2(p, l, 0, h), lgb = ret_lg2(p, l, 1, h);
    const float cdf = exp2f(lgf * 128.f), cdb = exp2f(lgb * 128.f);
    bf16x8 sff[4], sfb[4];
    {
        float Sf[4][8], Sb[4][8];
#pragma unroll
        for (int ks = 0; ks < 4; ++ks)
#pragma unroll
            for (int e = 0; e < 8; ++e) { Sf[ks][e] = 0.f; Sb[ks][e] = 0.f; }
        const bf16_t* Ub = DB(D_OB) + (size_t)(b * 4 + h) * 18 * 2 * 128 * 64 + (size_t)(hh * 128 + 32 * w + qc) * 8;
        const int pos = m < 2 ? 1 - m : 19 - m;
        const int nf4 = (m + 3) & ~3, nb4 = (pos + 3) & ~3;
        for (int c0 = 0; c0 < nf4; c0 += 4) {
            bf16x8 u[4][4]; float wg[4];
#pragma unroll
            for (int q = 0; q < 4; ++q) {
                const int c = c0 + q, cl = c < m ? c : 0;
                wg[q] = c < m ? __builtin_amdgcn_exp2f(lgf * 128.f * (float)(m - 1 - c)) : 0.f;
                const bf16_t* up = Ub + (size_t)(cl * 2 + 0) * 128 * 64;
#pragma unroll
                for (int ks = 0; ks < 4; ++ks) u[q][ks] = *(const bf16x8*)(up + ks * 2048);
            }
#pragma unroll
            for (int q = 0; q < 4; ++q)
#pragma unroll
                for (int ks = 0; ks < 4; ++ks)
#pragma unroll
                    for (int e = 0; e < 8; ++e) Sf[ks][e] += wg[q] * bf2f((bf16_t)u[q][ks][e]);
        }
        for (int c0 = 0; c0 < nb4; c0 += 4) {
            bf16x8 u[4][4]; float wg[4];
#pragma unroll
            for (int q = 0; q < 4; ++q) {
                const int cc = c0 + q, ccl = cc < pos ? cc : 0;
                const int c = ccl < 2 ? 1 - ccl : 19 - ccl;
                wg[q] = cc < pos ? __builtin_amdgcn_exp2f(lgb * 128.f * (float)(pos - 1 - cc)) : 0.f;
                const bf16_t* up = Ub + (size_t)(c * 2 + 1) * 128 * 64;
#pragma unroll
                for (int ks = 0; ks < 4; ++ks) u[q][ks] = *(const bf16x8*)(up + ks * 2048);
            }
#pragma unroll
            for (int q = 0; q < 4; ++q)
#pragma unroll
                for (int ks = 0; ks < 4; ++ks)
#pragma unroll
                    for (int e = 0; e < 8; ++e) Sb[ks][e] += wg[q] * bf2f((bf16_t)u[q][ks][e]);
        }
#pragma unroll
        for (int ks = 0; ks < 4; ++ks)
#pragma unroll
            for (int e = 0; e < 8; ++e) { sff[ks][e] = (short)f2bf(Sf[ks][e]); sfb[ks][e] = (short)f2bf(Sb[ks][e]); }
    }
    const bf16_t* Kg = CB(C_RK) + ((size_t)b * TPB + t0) * 256 + h * 64 + 8 * hh;
    const bf16_t* Qg = CB(C_RQ) + ((size_t)b * TPB + t0) * 256 + h * 64 + 8 * hh;
    const bf16_t* VTg = CB(C_RVT) + (((size_t)b * 4 + h) * 128 + w * 32 + qc) * TPB + t0 + 8 * hh;
    bf16x8 vf[8];
#pragma unroll
    for (int ks = 0; ks < 8; ++ks) vf[ks] = *(const bf16x8*)(VTg + ks * 16);
    {
        bf16x8 qf[4], ka[4][4];
#pragma unroll
        for (int ks = 0; ks < 4; ++ks) qf[ks] = *(const bf16x8*)(Qg + (size_t)iq * 256 + ks * 16);
#pragma unroll
        for (int js = 0; js < 4; ++js)
#pragma unroll
            for (int ks = 0; ks < 4; ++ks) ka[js][ks] = *(const bf16x8*)(Kg + (size_t)(32 * js + qc) * 256 + ks * 16);
        __syncthreads();
#pragma unroll
        for (int js = 0; js < 4; ++js) {
            f32x16 sc;
#pragma unroll
            for (int r = 0; r < 16; ++r) sc[r] = 0.f;
#pragma unroll
            for (int ks = 0; ks < 4; ++ks) sc = __builtin_amdgcn_mfma_f32_32x32x16_bf16(ka[js][ks], qf[ks], sc, 0, 0, 0);
#pragma unroll
            for (int g = 0; g < 4; ++g) {
                bf16x4 pk;
#pragma unroll
                for (int e = 0; e < 4; ++e) {
                    const int d = iq - (32 * js + 8 * g + 4 * hh + e);
                    const float wgt = d >= 0 ? __builtin_amdgcn_exp2f(lgf * (float)d) : __builtin_amdgcn_exp2f(lgb * (float)(-d));
                    pk[e] = (short)f2bf(sc[4 * g + e] * wgt);
                }
                *(bf16x4*)(P + iq * PLD + 32 * js + 8 * g + 4 * hh) = pk;
            }
        }
    }
    bf16x8 qa[4];
#pragma unroll
    for (int ks = 0; ks < 4; ++ks) qa[ks] = *(const bf16x8*)(Qg + (size_t)qc * 256 + ks * 16);
    __syncthreads();
    f32x16 o[4];
#pragma unroll
    for (int isub = 0; isub < 4; ++isub) {
        const int ii = 32 * isub + qc;
        bf16x8 qn[4];
        if (isub < 3) {
#pragma unroll
            for (int ks = 0; ks < 4; ++ks) qn[ks] = *(const bf16x8*)(Qg + (size_t)(ii + 32) * 256 + ks * 16);
        }
#pragma unroll
        for (int r = 0; r < 16; ++r) o[isub][r] = 0.f;
#pragma unroll
        for (int ks = 0; ks < 4; ++ks) o[isub] = __builtin_amdgcn_mfma_f32_32x32x16_bf16(sff[ks], qa[ks], o[isub], 0, 0, 0);
        const float qdf = __builtin_amdgcn_exp2f(lgf * (float)(ii + 1)), qdb = __builtin_amdgcn_exp2f(lgb * (float)(128 - ii));
        const float rat = qdf / qdb;
#pragma unroll
        for (int r = 0; r < 16; ++r) o[isub][r] *= rat;
#pragma unroll
        for (int ks = 0; ks < 4; ++ks) o[isub] = __builtin_amdgcn_mfma_f32_32x32x16_bf16(sfb[ks], qa[ks], o[isub], 0, 0, 0);
#pragma unroll
        for (int r = 0; r < 16; ++r) o[isub][r] *= qdb;
#pragma unroll
        for (int ks = 0; ks < 8; ++ks) {
            bf16x8 pf = *(const bf16x8*)(P + ii * PLD + 16 * ks + 8 * hh);
            o[isub] = __builtin_amdgcn_mfma_f32_32x32x16_bf16(vf[ks], pf, o[isub], 0, 0, 0);
        }
        float s1 = 0.f, s2 = 0.f;
#pragma unroll
        for (int r = 0; r < 16; ++r) { s1 += o[isub][r]; s2 += o[isub][r] * o[isub][r]; }
        s1 += __shfl_xor(s1, 32); s2 += __shfl_xor(s2, 32);
        if (hh == 0) { red[(w * 128 + ii) * 2] = s1; red[(w * 128 + ii) * 2 + 1] = s2; }
        if (isub < 3) {
#pragma unroll
            for (int ks = 0; ks < 4; ++ks) qa[ks] = qn[ks];
        }
    }
    __syncthreads();
    const float* gn = p.in[I_RNORM] + l * 512 + h * 128 + 32 * w + 4 * hh;
    float gnv[16];
#pragma unroll
    for (int g = 0; g < 4; ++g)
#pragma unroll
        for (int e = 0; e < 4; ++e) gnv[4 * g + e] = gn[8 * g + e];
#pragma unroll
    for (int isub = 0; isub < 4; ++isub) {
        const int ii = 32 * isub + qc;
        float t1 = 0.f, t2 = 0.f;
#pragma unroll
        for (int ww = 0; ww < 4; ++ww) { t1 += red[(ww * 128 + ii) * 2]; t2 += red[(ww * 128 + ii) * 2 + 1]; }
        const float mu = t1 * (1.f / 128.f);
        const float rs = rsqrtf(fmaxf(t2 * (1.f / 128.f) - mu * mu, 0.f) + EPSV);
#pragma unroll
        for (int g = 0; g < 4; ++g) {
            bf16x4 ov;
#pragma unroll
            for (int e = 0; e < 4; ++e) ov[e] = (short)f2bf((o[isub][4 * g + e] - mu) * rs * gnv[4 * g + e]);
            *(bf16x4*)(P + ii * PLD + 32 * w + 8 * g + 4 * hh) = ov;
        }
    }
    __syncthreads();
#pragma unroll
    for (int k = 0; k < 8; ++k) {
        const int c = tid + 256 * k, row = c >> 4, ch = c & 15;
        const size_t ro = ((size_t)b * TPB + t0 + row) * 512 + h * 128 + ch * 8;
        const bf16x8 nv = *(const bf16x8*)(P + row * PLD + ch * 8);
        const bf16x8 gt = *(const bf16x8*)(CB(C_RG) + ro);
        bf16x8 ov;
#pragma unroll
        for (int e = 0; e < 8; ++e) ov[e] = (short)f2bf(siluf_(bf2f((bf16_t)gt[e])) * bf2f((bf16_t)nv[e]));
        *(bf16x8*)(DB(D_OF) + ro) = ov;
    }
}

DEVI void h_to_fp8(const Params& p, int mt) {
    const int lane = TIDX & 63, w = TIDX >> 6;
    for (int i = 0; i < 32; ++i) {
        const size_t row = (size_t)mt * 128 + w * 32 + i;
        const bf16x8 a = *(const bf16x8*)(HB + row * 1024 + lane * 16), b = *(const bf16x8*)(HB + row * 1024 + lane * 16 + 8);
        i32x4 o;
        o[0] = pk4_fp8(bf2f((bf16_t)a[0]), bf2f((bf16_t)a[1]), bf2f((bf16_t)a[2]), bf2f((bf16_t)a[3]));
        o[1] = pk4_fp8(bf2f((bf16_t)a[4]), bf2f((bf16_t)a[5]), bf2f((bf16_t)a[6]), bf2f((bf16_t)a[7]));
        o[2] = pk4_fp8(bf2f((bf16_t)b[0]), bf2f((bf16_t)b[1]), bf2f((bf16_t)b[2]), bf2f((bf16_t)b[3]));
        o[3] = pk4_fp8(bf2f((bf16_t)b[4]), bf2f((bf16_t)b[5]), bf2f((bf16_t)b[6]), bf2f((bf16_t)b[7]));
        asm volatile("s_waitcnt vmcnt(0)" ::: "memory");
        *(i32x4*)((unsigned char*)HB + row * 2048 + lane * 16) = o;
    }
}
DEVI void phase_mla_up(const Params& p, int l, unsigned char* smem) {
    bf16_t* ct = (bf16_t*)smem;
    float* rstd = (float*)(smem + AUX_OFF);
    const float* cs32 = WSF(OFF_R32);
    const float qscale = 0.10206207261596575f * LOG2E;
    const int nq = (l == 0 ? 144 : 128) * 6;
    const int nkv = 144 * 8;
    for (int tile = BIDX; tile < nq + nkv + 576 + 144; tile += gridDim.x) {
        if (tile >= nq + nkv + 576) { h_to_fp8(p, tile - nq - nkv - 576); continue; }
        if (tile >= nq + nkv) { ret_chunk_U(p, l, tile - nq - nkv); continue; }
        if (tile < nq) {
            const int mt = mt_of(tile / 6, l != 0), nt = tile % 6;
            const int row0 = mt * 128, t0 = (mt % 18) * 128;
            const bool lat = (mt % 18) >= 2;
            f32x4 acc[4][4];
            acc_zero<128>(acc);
            AOp A{CB(C_CQ), 256, row0, nullptr};
            gemm_core<128>(acc, A, WB(W_UQ + (size_t)l * 768 * 256 + (size_t)nt * 128 * 256), 256, 256, smem);
            __syncthreads();
            acc_to_ct<128>(acc, ct);
            ep_rstd(CB(C_CQ), 256, row0, 256, rstd);
            __syncthreads();
            if (nt < 4) {
                ep_scale_rows(ct, 0, 128, rstd, qscale); __syncthreads();
                ep_store_rows<64>(ct, 0, CB(C_MQ) + (nt * 2) * 96, 768, row0);
                ep_store_rows<64>(ct, 64, CB(C_MQ) + (nt * 2 + 1) * 96, 768, row0);
            } else {
                ep_rope32(ct, 4, rstd, qscale, lat, t0 - CTXL, cs32); __syncthreads();
#pragma unroll
                for (int g = 0; g < 4; ++g) ep_store_rows<32>(ct, g * 32, CB(C_MQ) + ((nt - 4) * 4 + g) * 96 + 64, 768, row0);
            }
            __syncthreads();
        } else {
            const int tk = tile - nq;
            const int mt = tk / 8, nt = tk % 8;
            const int row0 = mt * 128, b = mt / 18, t0 = (mt % 18) * 128;
            f32x4 acc[4][4];
            acc_zero<128>(acc);
            AOp A{CB(C_CKV), 128, row0, nullptr};
            gemm_core<128>(acc, A, WB(W_UKV + (size_t)l * 1024 * 128 + (size_t)nt * 128 * 128), 128, 128, smem);
            __syncthreads();
            acc_to_ct<128>(acc, ct);
            ep_rstd(CB(C_CKV), 128, row0, 128, rstd);
            __syncthreads();
            ep_scale_rows(ct, 0, 128, rstd, 1.f); __syncthreads();
            ep_store_rows<64>(ct, 0, CB(C_KN) + nt * 64, 512, row0);
            ep_store_T(ct, 64, 64, CB(C_VMT) + ((size_t)b * 8 + nt) * 64 * TPB, TPB, t0);
            __syncthreads();
        }
    }
}

template <int DK, bool MLA>
DEVI void attn_naive_wave(const Params& p, int b, int t0, int hq) {
    const int lane = TIDX & 63;
    const int t = t0 + lane, row = b * TPB + t;
    const int nkeys = (t0 < CTXL) ? CTXL : TPB;
    float q[DK];
    const bf16_t* qp = MLA ? CB(C_MQ) + (size_t)row * 768 + hq * 96 : CB(C_GQ) + (size_t)row * 512 + hq * 64;
#pragma unroll
    for (int c = 0; c < DK / 8; ++c) {
        bf16x8 tq = *(const bf16x8*)(qp + c * 8);
#pragma unroll
        for (int e = 0; e < 8; ++e) q[c * 8 + e] = bf2f((bf16_t)tq[e]);
    }
    float acc[64];
#pragma unroll
    for (int d = 0; d < 64; ++d) acc[d] = 0.f;
    float m = -1e30f, lsum = 0.f;
    const int hk = MLA ? hq : (hq >> 2);
    const bf16_t* vT = MLA ? CB(C_VMT) + ((size_t)b * 8 + hk) * 64 * TPB : CB(C_GVT) + ((size_t)b * 2 + hk) * 64 * TPB;
    for (int kt = 0; kt < nkeys; ++kt) {
        const size_t krow = (size_t)b * TPB + kt;
        float s = 0.f;
        const bf16_t* kp = MLA ? CB(C_KN) + krow * 512 + hk * 64 : CB(C_GK) + krow * 128 + hk * 64;
#pragma unroll
        for (int c = 0; c < 8; ++c) {
            bf16x8 tk = *(const bf16x8*)(kp + c * 8);
#pragma unroll
            for (int e = 0; e < 8; ++e) s += q[c * 8 + e] * bf2f((bf16_t)tk[e]);
        }
        if (MLA) {
            const bf16_t* rp = CB(C_KR) + krow * 32;
#pragma unroll
            for (int c = 0; c < 4; ++c) {
                bf16x8 tk = *(const bf16x8*)(rp + c * 8);
#pragma unroll
                for (int e = 0; e < 8; ++e) s += q[(DK - 32) + c * 8 + e] * bf2f((bf16_t)tk[e]);
            }
        }
        const float mn = fmaxf(m, s);
        const float alpha = exp2f(m - mn), pp = exp2f(s - mn);
        lsum = lsum * alpha + pp;
#pragma unroll
        for (int d = 0; d < 64; ++d) acc[d] = acc[d] * alpha + pp * bf2f(vT[(size_t)d * TPB + kt]);
        m = mn;
    }
    const float inv = 1.f / lsum;
    bf16_t* op = (MLA ? DB(D_YA) : DB(D_YD)) + (size_t)row * 512 + hq * 64;
#pragma unroll
    for (int c = 0; c < 8; ++c) {
        bf16x8 o;
#pragma unroll
        for (int e = 0; e < 8; ++e) o[e] = (short)f2bf(acc[c * 8 + e] * inv);
        *(bf16x8*)(op + c * 8) = o;
    }
}


template <int DK, bool MLA>
DEVI void attn_task(const Params& p, int b, int hsel, int tq0, int nkeys, unsigned char* smem) {
    constexpr int KLD = DK + 8;
    constexpr int CK = DK / 8;
    constexpr int NKC = 64 * CK / 256;
    constexpr int VLD = 68;
    constexpr int KBYTES = 64 * KLD * 2, VBYTES = 64 * VLD * 2;
    constexpr int VOFF = 2 * KBYTES;
    static_assert(2 * (KBYTES + VBYTES) <= 60000, "attn lds");
    const int tid = TIDX, lane = tid & 63, w = tid >> 6, qc = lane & 31, hh = lane >> 5;
    const int tq = MLA ? tq0 + w * 32 + qc : tq0 + qc;
    const int hq = MLA ? hsel : hsel * 4 + w;
    const size_t qrow = (size_t)b * TPB + tq;
    const bf16_t* qp = MLA ? CB(C_MQ) + qrow * 768 + hq * 96 : CB(C_GQ) + qrow * 512 + hq * 64;
    bf16x8 qf[DK / 16];
#pragma unroll
    for (int ks = 0; ks < DK / 16; ++ks) qf[ks] = *(const bf16x8*)(qp + ks * 16 + hh * 8);
    const bf16_t* ksrc[NKC]; int kstep[NKC], kdst[NKC];
#pragma unroll
    for (int i = 0; i < NKC; ++i) {
        const int q = tid + 256 * i, key = q / CK, ch = q % CK;
        if (MLA) {
            if (ch < 8) { ksrc[i] = CB(C_KN) + ((size_t)b * TPB + key) * 512 + hsel * 64 + ch * 8; kstep[i] = 64 * 512; }
            else { ksrc[i] = CB(C_KR) + ((size_t)b * TPB + key) * 32 + (ch - 8) * 8; kstep[i] = 64 * 32; }
        } else { ksrc[i] = CB(C_GK) + ((size_t)b * TPB + key) * 128 + hsel * 64 + ch * 8; kstep[i] = 64 * 128; }
        kdst[i] = (key * KLD + ch * 8) * 2;
    }
    const bf16_t* vT = MLA ? CB(C_VMT) + ((size_t)b * 8 + hsel) * 64 * TPB : CB(C_GVT) + ((size_t)b * 2 + hsel) * 64 * TPB;
    const bf16_t* vsrc[2]; int vdst[2];
#pragma unroll
    for (int i = 0; i < 2; ++i) {
        const int q = tid + 256 * i, dv = q >> 3, ch = q & 7;
        vsrc[i] = vT + (size_t)dv * TPB + ch * 8;
        vdst[i] = VOFF + (dv * VLD + ch * 8) * 2;
    }
    const int nt = nkeys >> 6;
    bf16x8 kr[NKC], vr[2];
#pragma unroll
    for (int i = 0; i < NKC; ++i) kr[i] = *(const bf16x8*)(ksrc[i]);
#pragma unroll
    for (int i = 0; i < 2; ++i) vr[i] = *(const bf16x8*)(vsrc[i]);
    __syncthreads();
#pragma unroll
    for (int i = 0; i < NKC; ++i) *(bf16x8*)(smem + kdst[i]) = kr[i];
#pragma unroll
    for (int i = 0; i < 2; ++i) {
        *(bf16x4*)(smem + vdst[i]) = bf16x4{vr[i][0], vr[i][1], vr[i][2], vr[i][3]};
        *(bf16x4*)(smem + vdst[i] + 8) = bf16x4{vr[i][4], vr[i][5], vr[i][6], vr[i][7]};
    }
#pragma unroll
    for (int i = 0; i < NKC; ++i) kr[i] = *(const bf16x8*)(ksrc[i] + (size_t)kstep[i]);
    __syncthreads();
    f32x16 s0, s1;
#pragma unroll
    for (int r = 0; r < 16; ++r) { s0[r] = 0.f; s1[r] = 0.f; }
#pragma unroll
    for (int ks = 0; ks < DK / 16; ++ks) {
        bf16x8 a0 = *(const bf16x8*)(smem + (qc * KLD + ks * 16 + hh * 8) * 2);
        bf16x8 a1 = *(const bf16x8*)(smem + ((32 + qc) * KLD + ks * 16 + hh * 8) * 2);
        s0 = __builtin_amdgcn_mfma_f32_32x32x16_bf16(a0, qf[ks], s0, 0, 0, 0);
        s1 = __builtin_amdgcn_mfma_f32_32x32x16_bf16(a1, qf[ks], s1, 0, 0, 0);
    }
#pragma unroll
    for (int i = 0; i < NKC; ++i) *(bf16x8*)(smem + KBYTES + kdst[i]) = kr[i];
    f32x16 o0, o1;
#pragma unroll
    for (int r = 0; r < 16; ++r) { o0[r] = 0.f; o1[r] = 0.f; }
    float m = -1e30f, lsum = 0.f;
    for (int it = 0; it < nt; ++it) {
        __syncthreads();
        if (it + 2 < nt) {
#pragma unroll
            for (int i = 0; i < NKC; ++i) kr[i] = *(const bf16x8*)(ksrc[i] + (size_t)(it + 2) * kstep[i]);
        }
        if (it + 1 < nt) {
#pragma unroll
            for (int i = 0; i < 2; ++i) vr[i] = *(const bf16x8*)(vsrc[i] + (it + 1) * 64);
        }
        f32x16 n0, n1;
#pragma unroll
        for (int r = 0; r < 16; ++r) { n0[r] = 0.f; n1[r] = 0.f; }
        if (it + 1 < nt) {
            const unsigned char* ck = smem + ((it + 1) & 1) * KBYTES;
#pragma unroll
            for (int ks = 0; ks < DK / 16; ++ks) {
                bf16x8 a0 = *(const bf16x8*)(ck + (qc * KLD + ks * 16 + hh * 8) * 2);
                bf16x8 a1 = *(const bf16x8*)(ck + ((32 + qc) * KLD + ks * 16 + hh * 8) * 2);
                n0 = __builtin_amdgcn_mfma_f32_32x32x16_bf16(a0, qf[ks], n0, 0, 0, 0);
                n1 = __builtin_amdgcn_mfma_f32_32x32x16_bf16(a1, qf[ks], n1, 0, 0, 0);
            }
        }
        float mx = s0[0];
#pragma unroll
        for (int r = 1; r < 16; ++r) mx = fmaxf(mx, s0[r]);
#pragma unroll
        for (int r = 0; r < 16; ++r) mx = fmaxf(mx, s1[r]);
        mx = fmaxf(mx, __shfl_xor(mx, 32));
        if (!__all(mx <= m + 6.f)) {
            const float mn = fmaxf(m, mx);
            const float alpha = __builtin_amdgcn_exp2f(m - mn);
            m = mn;
            lsum *= alpha;
#pragma unroll
            for (int r = 0; r < 16; ++r) { o0[r] *= alpha; o1[r] *= alpha; }
        }
        float ps = 0.f;
#pragma unroll
        for (int r = 0; r < 16; ++r) { s0[r] = __builtin_amdgcn_exp2f(s0[r] - m); ps += s0[r]; }
#pragma unroll
        for (int r = 0; r < 16; ++r) { s1[r] = __builtin_amdgcn_exp2f(s1[r] - m); ps += s1[r]; }
        lsum += ps;
        bf16x8 pf[2][2];
#pragma unroll
        for (int s = 0; s < 2; ++s)
#pragma unroll
            for (int j = 0; j < 8; ++j) { pf[0][s][j] = (short)f2bf(s0[8 * s + j]); pf[1][s][j] = (short)f2bf(s1[8 * s + j]); }
        const unsigned char* cv = smem + VOFF + (it & 1) * VBYTES;
#pragma unroll
        for (int a = 0; a < 2; ++a)
#pragma unroll
            for (int s = 0; s < 2; ++s) {
                const int keyoff = a * 32 + 16 * s + 4 * hh;
                bf16x4 l0 = *(const bf16x4*)(cv + (qc * VLD + keyoff) * 2);
                bf16x4 h0 = *(const bf16x4*)(cv + (qc * VLD + keyoff + 8) * 2);
                bf16x4 l1 = *(const bf16x4*)(cv + ((32 + qc) * VLD + keyoff) * 2);
                bf16x4 h1 = *(const bf16x4*)(cv + ((32 + qc) * VLD + keyoff + 8) * 2);
                bf16x8 v0 = bf16x8{l0[0], l0[1], l0[2], l0[3], h0[0], h0[1], h0[2], h0[3]};
                bf16x8 v1 = bf16x8{l1[0], l1[1], l1[2], l1[3], h1[0], h1[1], h1[2], h1[3]};
                o0 = __builtin_amdgcn_mfma_f32_32x32x16_bf16(v0, pf[a][s], o0, 0, 0, 0);
                o1 = __builtin_amdgcn_mfma_f32_32x32x16_bf16(v1, pf[a][s], o1, 0, 0, 0);
            }
        if (it + 2 < nt) {
            unsigned char* nk = smem + (it & 1) * KBYTES;
#pragma unroll
            for (int i = 0; i < NKC; ++i) *(bf16x8*)(nk + kdst[i]) = kr[i];
        }
        if (it + 1 < nt) {
            unsigned char* nv = smem + ((it + 1) & 1) * VBYTES;
#pragma unroll
            for (int i = 0; i < 2; ++i) {
                *(bf16x4*)(nv + vdst[i]) = bf16x4{vr[i][0], vr[i][1], vr[i][2], vr[i][3]};
                *(bf16x4*)(nv + vdst[i] + 8) = bf16x4{vr[i][4], vr[i][5], vr[i][6], vr[i][7]};
            }
        }
        s0 = n0; s1 = n1;
    }
    lsum += __shfl_xor(lsum, 32);
    const float inv = 1.f / lsum;
    bf16_t* op = (MLA ? DB(D_YA) : DB(D_YD)) + qrow * 512 + hq * 64;
#pragma unroll
    for (int g = 0; g < 4; ++g) {
        bf16x4 a, c;
#pragma unroll
        for (int e = 0; e < 4; ++e) { a[e] = (short)f2bf(o0[g * 4 + e] * inv); c[e] = (short)f2bf(o1[g * 4 + e] * inv); }
        *(bf16x4*)(op + 8 * g + 4 * hh) = a;
        *(bf16x4*)(op + 32 + 8 * g + 4 * hh) = c;
    }
}

DEVI int proc_tok(int dir, int pidx) { return dir == 0 ? pidx : (pidx < CTXL ? CTXL - 1 - pidx : (CTXL + TPB - 1) - pidx); }

DEVI void retention_naive(const Params& p, int l, int task) {
    const int b = task >> 2, h = task & 3;
    const int dir = TIDX >> 7, dv = TIDX & 127;
    const float dec = p.in[I_RDEC][l * 8 + dir * 4 + h];
    const float lg = -log1pf(expf(-dec));
    const float g = expf(lg);
    float S[64];
#pragma unroll
    for (int d = 0; d < 64; ++d) S[d] = 0.f;
    const bf16_t* vT = CB(C_RVT) + (((size_t)b * 4 + h) * 128 + dv) * TPB;
    bf16_t* outp = (dir == 0 ? DB(D_OF) : DB(D_OB));
    for (int pi = 0; pi < TPB; ++pi) {
        const int u = proc_tok(dir, pi);
        const size_t row = (size_t)b * TPB + u;
        const bf16_t* qp = CB(C_RQ) + row * 256 + h * 64;
        const bf16_t* kp = CB(C_RK) + row * 256 + h * 64;
        const float v = bf2f(vT[u]);
        float o = 0.f;
#pragma unroll
        for (int c = 0; c < 8; ++c) {
            bf16x8 tq = *(const bf16x8*)(qp + c * 8);
            bf16x8 tk = *(const bf16x8*)(kp + c * 8);
#pragma unroll
            for (int e = 0; e < 8; ++e) {
                const int d = c * 8 + e;
                const float qd = bf2f((bf16_t)tq[e]), kd = bf2f((bf16_t)tk[e]);
                if (dir == 0) { S[d] = g * S[d] + kd * v; o += qd * S[d]; }
                else { S[d] = g * S[d]; o += qd * S[d]; S[d] += kd * v; }
            }
        }
        outp[row * 512 + h * 128 + dv] = f2bf(o);
    }
}

DEVI void lru_naive_wave(const Params& p, int l, int task) {
    const int lane = TIDX & 63;
    const int b = task >> 4, d = (task >> 3) & 1, blk = task & 7;
    const int ch = blk * 64 + lane;
    float cw[4];
#pragma unroll
    for (int j = 0; j < 4; ++j) cw[j] = p.in[I_LCW][(l * 4 + j) * 512 + ch];
    const float cb = p.in[I_LCB][l * 512 + ch];
    const float ba = p.in[I_LBA][(l * 2 + d) * 512 + ch], bx = p.in[I_LBX][(l * 2 + d) * 512 + ch];
    const float lam = p.in[I_LLAM][(l * 2 + d) * 512 + ch];
    const float sp = log1pf(expf(-lam));
    const float* Wa = p.in[I_LWA] + ((size_t)(l * 2 + d) * 8 + blk) * 4096;
    const float* Wx = p.in[I_LWX] + ((size_t)(l * 2 + d) * 8 + blk) * 4096;
    float h = 0.f;
    bf16_t* outp = (d == 0 ? DB(D_LH0) : DB(D_LH1));
    for (int pi = 0; pi < TPB; ++pi) {
        const int u = proc_tok(d, pi);
        const int lo = u < CTXL ? 0 : CTXL, hi = u < CTXL ? CTXL : TPB;
        const size_t row = (size_t)b * TPB + u;
        float uval = cb;
#pragma unroll
        for (int j = 0; j < 4; ++j) {
            const int tt = u - 2 + j;
            if (tt >= lo && tt < hi) uval += cw[j] * bf2f(CB(C_LX)[((size_t)b * TPB + tt) * 512 + ch]);
        }
        float rp = 0.f, ip = 0.f;
        for (int c = 0; c < 64; ++c) {
            const float uc = __shfl(uval, c);
            rp += uc * Wa[c * 64 + lane];
            ip += uc * Wx[c * 64 + lane];
        }
        const float r = sigmoidf_(rp + ba), ig = sigmoidf_(ip + bx);
        const float la = -8.f * r * sp;
        const float a = expf(la);
        const float bb = sqrtf(-expm1f(2.f * la)) * (ig * uval);
        h = a * h + bb;
        outp[row * 512 + ch] = f2bf(h);
    }
}


DEVI void retention_walk(const Params& p, int l, int task, unsigned char* smem) {
    constexpr int PLD = 136;
    const int b = task >> 3, h = (task >> 1) & 3, dir = task & 1;
    const int tid = TIDX, lane = tid & 63, w = tid >> 6, qc = lane & 31, hh = lane >> 5;
    const float dec = p.in[I_RDEC][l * 8 + dir * 4 + h];
    const float lg2 = -log1pf(expf(-dec)) * LOG2E;
    const float cdec = exp2f(lg2 * 128.f);
    bf16_t* P = (bf16_t*)smem;
    f32x16 S0, S1;
#pragma unroll
    for (int r = 0; r < 16; ++r) { S0[r] = 0.f; S1[r] = 0.f; }
    const bf16_t* Kg = CB(C_RK) + (size_t)b * TPB * 256 + h * 64;
    const bf16_t* Qg = CB(C_RQ) + (size_t)b * TPB * 256 + h * 64;
    const bf16_t* KTg = CB(C_RKT) + ((size_t)b * 4 + h) * 64 * TPB;
    const bf16_t* VTg = CB(C_RVT) + (((size_t)b * 4 + h) * 128 + w * 32 + qc) * TPB;
    bf16_t* outp = (dir == 0 ? DB(D_OF) : DB(D_OB)) + (size_t)b * TPB * 512 + h * 128 + w * 32;
    const int iq = 32 * w + qc;
    for (int cc = 0; cc < 18; ++cc) {
        const int mch = dir == 0 ? cc : (cc < 2 ? 1 - cc : 19 - cc);
        const int t0 = mch * 128;
        bf16x8 vf[8];
#pragma unroll
        for (int ks = 0; ks < 8; ++ks) vf[ks] = *(const bf16x8*)(VTg + t0 + ks * 16 + hh * 8);
        bf16x8 qf[4];
        {
            const bf16_t* qrow = Qg + (size_t)(t0 + iq) * 256;
#pragma unroll
            for (int ks = 0; ks < 4; ++ks) qf[ks] = *(const bf16x8*)(qrow + ks * 16 + hh * 8);
        }
        __syncthreads();
#pragma unroll 1
        for (int js = 0; js < 4; ++js) {
            f32x16 sc;
#pragma unroll
            for (int r = 0; r < 16; ++r) sc[r] = 0.f;
            const bf16_t* krow = Kg + (size_t)(t0 + 32 * js + qc) * 256;
#pragma unroll
            for (int ks = 0; ks < 4; ++ks) {
                bf16x8 a = *(const bf16x8*)(krow + ks * 16 + hh * 8);
                sc = __builtin_amdgcn_mfma_f32_32x32x16_bf16(a, qf[ks], sc, 0, 0, 0);
            }
#pragma unroll
            for (int g = 0; g < 4; ++g) {
                bf16x4 pk;
#pragma unroll
                for (int e = 0; e < 4; ++e) {
                    const int j = 32 * js + 8 * g + 4 * hh + e;
                    const int d = iq - j;
                    float wgt;
                    if (dir == 0) wgt = d >= 0 ? __builtin_amdgcn_exp2f(lg2 * (float)d) : 0.f;
                    else wgt = d < 0 ? __builtin_amdgcn_exp2f(lg2 * (float)(-d)) : 0.f;
                    pk[e] = (short)f2bf(sc[4 * g + e] * wgt);
                }
                *(bf16x4*)(P + iq * PLD + 32 * js + 8 * g + 4 * hh) = pk;
            }
        }
        __syncthreads();
        bf16x8 sf[2][2];
#pragma unroll
        for (int s = 0; s < 2; ++s)
#pragma unroll
            for (int j = 0; j < 8; ++j) { sf[0][s][j] = (short)f2bf(S0[8 * s + j]); sf[1][s][j] = (short)f2bf(S1[8 * s + j]); }
#pragma unroll 1
        for (int isub = 0; isub < 4; ++isub) {
            const int ii = 32 * isub + qc;
            const bf16_t* qr = Qg + (size_t)(t0 + ii) * 256;
            f32x16 o;
#pragma unroll
            for (int r = 0; r < 16; ++r) o[r] = 0.f;
#pragma unroll
            for (int sub = 0; sub < 2; ++sub)
#pragma unroll
                for (int s = 0; s < 2; ++s) {
                    const int dk0 = 32 * sub + 16 * s + 4 * hh;
                    bf16x4 lo = *(const bf16x4*)(qr + dk0), hi = *(const bf16x4*)(qr + dk0 + 8);
                    bf16x8 bq = bf16x8{lo[0], lo[1], lo[2], lo[3], hi[0], hi[1], hi[2], hi[3]};
                    o = __builtin_amdgcn_mfma_f32_32x32x16_bf16(sf[sub][s], bq, o, 0, 0, 0);
                }
            const float qd = dir == 0 ? __builtin_amdgcn_exp2f(lg2 * (float)(ii + 1)) : __builtin_amdgcn_exp2f(lg2 * (float)(128 - ii));
#pragma unroll
            for (int r = 0; r < 16; ++r) o[r] *= qd;
#pragma unroll
            for (int ks = 0; ks < 8; ++ks) {
                bf16x8 pf = *(const bf16x8*)(P + ii * PLD + 16 * ks + 8 * hh);
                o = __builtin_amdgcn_mfma_f32_32x32x16_bf16(vf[ks], pf, o, 0, 0, 0);
            }
            bf16_t* orow = outp + (size_t)(t0 + ii) * 512;
#pragma unroll
            for (int g = 0; g < 4; ++g) {
                bf16x4 pk;
#pragma unroll
                for (int e = 0; e < 4; ++e) pk[e] = (short)f2bf(o[4 * g + e]);
                *(bf16x4*)(orow + 8 * g + 4 * hh) = pk;
            }
        }
#pragma unroll
        for (int r = 0; r < 16; ++r) { S0[r] *= cdec; S1[r] *= cdec; }
#pragma unroll
        for (int ks = 0; ks < 8; ++ks) {
            bf16x8 vs;
#pragma unroll
            for (int e = 0; e < 8; ++e) {
                const int j = 16 * ks + 8 * hh + e;
                const float kd = dir == 0 ? __builtin_amdgcn_exp2f(lg2 * (float)(127 - j)) : __builtin_amdgcn_exp2f(lg2 * (float)j);
                vs[e] = (short)f2bf(bf2f((bf16_t)vf[ks][e]) * kd);
            }
            bf16x8 a0 = *(const bf16x8*)(KTg + (size_t)qc * TPB + t0 + 16 * ks + 8 * hh);
            bf16x8 a1 = *(const bf16x8*)(KTg + (size_t)(32 + qc) * TPB + t0 + 16 * ks + 8 * hh);
            S0 = __builtin_amdgcn_mfma_f32_32x32x16_bf16(a0, vs, S0, 0, 0, 0);
            S1 = __builtin_amdgcn_mfma_f32_32x32x16_bf16(a1, vs, S1, 0, 0, 0);
        }
    }
    __syncthreads();
}

DEVI float fsig(float x) { return __builtin_amdgcn_rcpf(1.f + __expf(-x)); }
DEVI void lru_walk(const Params& p, int l, int task, unsigned char* smem) {
    const int b = task >> 4, d = (task >> 3) & 1, blk = task & 7;
    const int tid = TIDX, lane = tid & 63, w = tid >> 6, ln = lane & 15, g = lane >> 4;
    bf16_t* Wt = (bf16_t*)smem;
    float* uw = (float*)(smem + 18432 + w * 4224);
    float* cpar = (float*)(smem + 35328);
    float* agg = (float*)(smem + 36608);
    __syncthreads();
    {
        const bf16_t* wsrc = WB(W_LRU + ((size_t)(l * 2 + d) * 8 + blk) * 8192);
        for (int c = tid; c < 128 * 8; c += 256) {
            const int n = c >> 3, kc = c & 7;
            *(bf16x8*)(Wt + n * 72 + kc * 8) = *(const bf16x8*)(wsrc + n * 64 + kc * 8);
        }
        if (tid < 64) {
            const int ch = blk * 64 + tid;
#pragma unroll
            for (int j = 0; j < 4; ++j) cpar[j * 64 + tid] = p.in[I_LCW][(l * 4 + j) * 512 + ch];
            cpar[256 + tid] = p.in[I_LCB][l * 512 + ch];
        }
    }
    __syncthreads();
    float ba[4], bx[4], sp[4], hc[4];
#pragma unroll
    for (int ct = 0; ct < 4; ++ct) {
        const int ch = blk * 64 + 16 * ct + ln;
        ba[ct] = p.in[I_LBA][(l * 2 + d) * 512 + ch];
        bx[ct] = p.in[I_LBX][(l * 2 + d) * 512 + ch];
        sp[ct] = log1pf(expf(-p.in[I_LLAM][(l * 2 + d) * 512 + ch]));
        hc[ct] = 0.f;
    }
    const bf16_t* X = CB(C_LX) + (size_t)b * TPB * 512 + blk * 64;
    bf16_t* outp = (d == 0 ? DB(D_LH0) : DB(D_LH1)) + (size_t)b * TPB * 512 + blk * 64;
    bf16x8 xr[2][4];
    float xm[4];
    {
        const int tok = proc_tok(d, 16 * w + ln);
        const int lo = tok < CTXL ? 0 : CTXL, hi = tok < CTXL ? CTXL : TPB;
#pragma unroll
        for (int ks = 0; ks < 2; ++ks)
#pragma unroll
            for (int j = 0; j < 4; ++j) {
                const int tt = tok - 2 + j;
                const int tc = tt < lo ? lo : (tt >= hi ? hi - 1 : tt);
                xr[ks][j] = *(const bf16x8*)(X + (size_t)tc * 512 + 32 * ks + 8 * g);
                xm[j] = (tt >= lo && tt < hi) ? 1.f : 0.f;
            }
    }
    for (int c = 0; c < 36; ++c) {
        bf16x8 af[2];
#pragma unroll
        for (int ks = 0; ks < 2; ++ks) {
            const int c0 = 32 * ks + 8 * g;
            float u8[8];
#pragma unroll
            for (int e = 0; e < 8; ++e) u8[e] = cpar[256 + c0 + e];
#pragma unroll
            for (int j = 0; j < 4; ++j)
#pragma unroll
                for (int e = 0; e < 8; ++e) u8[e] += (cpar[j * 64 + c0 + e] * xm[j]) * bf2f((bf16_t)xr[ks][j][e]);
#pragma unroll
            for (int e = 0; e < 8; ++e) { uw[ln * 65 + c0 + e] = u8[e]; af[ks][e] = (short)f2bf(u8[e]); }
        }
        if (c + 1 < 36) {
            const int tok = proc_tok(d, 64 * (c + 1) + 16 * w + ln);
            const int lo = tok < CTXL ? 0 : CTXL, hi = tok < CTXL ? CTXL : TPB;
#pragma unroll
            for (int ks = 0; ks < 2; ++ks)
#pragma unroll
                for (int j = 0; j < 4; ++j) {
                    const int tt = tok - 2 + j;
                    const int tc = tt < lo ? lo : (tt >= hi ? hi - 1 : tt);
                    xr[ks][j] = *(const bf16x8*)(X + (size_t)tc * 512 + 32 * ks + 8 * g);
                    xm[j] = (tt >= lo && tt < hi) ? 1.f : 0.f;
                }
        }
        __builtin_amdgcn_wave_barrier();
        f32x4 acc[8];
#pragma unroll
        for (int nt = 0; nt < 8; ++nt) acc[nt] = f32x4{0.f, 0.f, 0.f, 0.f};
#pragma unroll
        for (int ks = 0; ks < 2; ++ks)
#pragma unroll
            for (int nt = 0; nt < 8; ++nt) {
                bf16x8 bfr = *(const bf16x8*)(Wt + (16 * nt + ln) * 72 + 32 * ks + 8 * g);
                acc[nt] = __builtin_amdgcn_mfma_f32_16x16x32_bf16(af[ks], bfr, acc[nt], 0, 0, 0);
            }
        float A[4][4], B[4][4];
#pragma unroll
        for (int ct = 0; ct < 4; ++ct) {
            float pa = 1.f, pb = 0.f;
#pragma unroll
            for (int j = 0; j < 4; ++j) {
                const float r = fsig(acc[ct][j] + ba[ct]);
                const float ig = fsig(acc[4 + ct][j] + bx[ct]);
                const float la = -8.f * r * sp[ct];
                const float a = __expf(la);
                const float uu = uw[(4 * g + j) * 65 + 16 * ct + ln];
                const float bb = __builtin_amdgcn_sqrtf(fmaxf(1.f - a * a, 0.f)) * ig * uu;
                pb = a * pb + bb; pa = a * pa;
                A[ct][j] = pa; B[ct][j] = pb;
            }
            float ia = pa, ib = pb;
#pragma unroll
            for (int dd = 1; dd <= 2; dd <<= 1) {
                const float qa = __shfl_up(ia, 16 * dd), qb = __shfl_up(ib, 16 * dd);
                if (g >= dd) { ib = ia * qb + ib; ia = ia * qa; }
            }
            float ea = __shfl_up(ia, 16), eb = __shfl_up(ib, 16);
            if (g == 0) { ea = 1.f; eb = 0.f; }
#pragma unroll
            for (int j = 0; j < 4; ++j) { B[ct][j] = A[ct][j] * eb + B[ct][j]; A[ct][j] = A[ct][j] * ea; }
            if (g == 3) {
                float* ag = agg + (((c & 1) * 4 + w) * 64 + 16 * ct + ln) * 2;
                ag[0] = ia; ag[1] = ib;
            }
        }
        __syncthreads();
#pragma unroll
        for (int ct = 0; ct < 4; ++ct) {
            float hrun = hc[ct], hin = 0.f;
#pragma unroll
            for (int w2 = 0; w2 < 4; ++w2) {
                const float* ag = agg + (((c & 1) * 4 + w2) * 64 + 16 * ct + ln) * 2;
                if (w2 == w) hin = hrun;
                hrun = ag[0] * hrun + ag[1];
            }
            hc[ct] = hrun;
#pragma unroll
            for (int j = 0; j < 4; ++j) {
                const int tok2 = proc_tok(d, 64 * c + 16 * w + 4 * g + j);
                outp[(size_t)tok2 * 512 + 16 * ct + ln] = f2bf(A[ct][j] * hin + B[ct][j]);
            }
        }
    }
    __syncthreads();
}

DEVI void phase_mix(const Params& p, int l, unsigned char* smem) {
    const int NLRU = 128, NRET = (l == 0 ? 576 : 512);
    const int NLAT = 1024, NCTX = (l == 0 ? 128 : 0);
    const int ntask = NLRU + NRET + 2 * NLAT + 2 * NCTX;
    const int ncvt = 3072;
    int cv = BIDX;
    int* ctr = WSI(OFF_CNT) + 128 + l;
    volatile int* nxt = (volatile int*)(smem + 65520);
    for (;;) {
        __syncthreads();
        if (TIDX == 0) *nxt = atomicAdd(ctr, 1);
        __syncthreads();
        const int task = *nxt;
        if (task >= ntask) break;
        if (cv < ncvt) { CvtJob j = get_moe_job(p, l, cv >> 10); if ((cv >> 10) < 2) cvt_tile256_fp8(j, cv & 1023, smem); else cvt_tile256(j, cv & 1023, smem); cv += gridDim.x; }
        if (task < NLRU) lru_walk(p, l, task, smem);
        else if (task >= NLRU + 2 * NLAT && task < NLRU + 2 * NLAT + NRET) {
            const int a = task - NLRU - 2 * NLAT;
            int b, h, m;
            if (l == 0) { b = a / 72; const int r = a % 72; h = r / 18; m = r % 18; }
            else { b = a >> 6; const int r = a & 63; h = r >> 4; m = 2 + (r & 15); }
            ret_out_task(p, l, b, h, m, smem);
        } else {
            int a = task < NLRU + 2 * NLAT ? task - NLRU : task - NLRU - NRET;
            int kind, b, hsel, tq0, nkeys;
            if (a < NLAT) { kind = 0; b = a >> 7; const int r = a & 127; hsel = r >> 4; tq0 = CTXL + (r & 15) * 128; nkeys = TPB; }
            else if (a < 2 * NLAT) { a -= NLAT; kind = 1; b = a >> 7; const int r = a & 127; hsel = r >> 6; tq0 = CTXL + (r & 63) * 32; nkeys = TPB; }
            else if (a < 2 * NLAT + NCTX) { a -= 2 * NLAT; kind = 0; b = a >> 4; const int r = a & 15; hsel = r >> 1; tq0 = (r & 1) * 128; nkeys = CTXL; }
            else { a -= 2 * NLAT + NCTX; kind = 1; b = a >> 4; const int r = a & 15; hsel = r >> 3; tq0 = (r & 7) * 32; nkeys = CTXL; }
            if (kind == 0) attn_task<96, true>(p, b, hsel, tq0, nkeys, smem);
            else attn_task<64, false>(p, b, hsel, tq0, nkeys, smem);
        }
    }
    for (; cv < ncvt; cv += gridDim.x) { CvtJob j = get_moe_job(p, l, cv >> 10); if ((cv >> 10) < 2) cvt_tile256_fp8(j, cv & 1023, smem); else cvt_tile256(j, cv & 1023, smem); }
}

DEVI void phase_fin(const Params& p, int l) {
    const int lane = TIDX & 63, w = TIDX >> 6;
    for (int row = BIDX * 4 + w; row < TT; row += gridDim.x * 4) {
        if (l == 1 && (row % TPB) < CTXL) continue;
        const size_t o = (size_t)row * 512 + lane * 8;
        bf16x8 h0 = *(const bf16x8*)(DB(D_LH0) + o), h1 = *(const bf16x8*)(DB(D_LH1) + o), lg = *(const bf16x8*)(CB(C_LG) + o);
        bf16x8 oc;
#pragma unroll
        for (int e = 0; e < 8; ++e) oc[e] = (short)f2bf((bf2f((bf16_t)h0[e]) + bf2f((bf16_t)h1[e])) * gelu_tanh(bf2f((bf16_t)lg[e])));
        *(bf16x8*)(DB(D_LH0) + o) = oc;
    }
}

DEVI void merge_tile(const Params& p, int l, int mq, int nt, unsigned char* smem) {
    bf16_t* ct = (bf16_t*)smem;
    const int lane = TIDX & 63, wc = (TIDX >> 6) & 1;
    const int mt = mt_of(mq, l != 0);
    const int row0 = mt * 128;
    unsigned mp[4][4][2];
#pragma unroll
    for (int mi = 0; mi < 4; ++mi)
#pragma unroll
        for (int ni = 0; ni < 4; ++ni) { mp[mi][ni][0] = 0u; mp[mi][ni][1] = 0u; }
#pragma unroll 1
    for (int n = 0; n < 4; ++n) {
        unsigned gp[4][4][2];
        {
            f32x4 ag[4][4];
            acc_zero<128>(ag);
            gemm_core_fp8<false>(ag, (const unsigned char*)HB, 2048, row0, (const unsigned char*)WB(W_MG + (size_t)l * 4096 * 1024) + (size_t)(n * 1024 + nt * 128) * 1024, 1024, 1024, smem);
            const float* bm = p.in[I_BMG] + l * 4096 + n * 1024 + nt * 128 + wc * 64 + (lane & 15);
#pragma unroll
            for (int ni = 0; ni < 4; ++ni) {
                const float bias = bm[ni * 16];
#pragma unroll
                for (int mi = 0; mi < 4; ++mi) {
                    gp[mi][ni][0] = (unsigned)f2bf(sigmoidf_(ag[mi][ni][0] + bias)) | ((unsigned)f2bf(sigmoidf_(ag[mi][ni][1] + bias)) << 16);
                    gp[mi][ni][1] = (unsigned)f2bf(sigmoidf_(ag[mi][ni][2] + bias)) | ((unsigned)f2bf(sigmoidf_(ag[mi][ni][3] + bias)) << 16);
                }
            }
        }
        f32x4 ap[4][4];
        acc_zero<128>(ap);
        const bf16_t* yb = n == 0 ? DB(D_YA) : (n == 1 ? DB(D_OF) : (n == 2 ? DB(D_LH0) : DB(D_YD)));
        AOp A2{yb, 512, row0, nullptr};
        gemm_core<128>(ap, A2, WB(W_BR + ((size_t)l * 4 + n) * 1024 * 512 + (size_t)(nt * 128) * 512), 512, 512, smem);
#pragma unroll
        for (int mi = 0; mi < 4; ++mi)
#pragma unroll
            for (int ni = 0; ni < 4; ++ni) {
                const float m0 = __uint_as_float(mp[mi][ni][0] << 16) + __uint_as_float(gp[mi][ni][0] << 16) * ap[mi][ni][0];
                const float m1 = __uint_as_float(mp[mi][ni][0] & 0xffff0000u) + __uint_as_float(gp[mi][ni][0] & 0xffff0000u) * ap[mi][ni][1];
                const float m2 = __uint_as_float(mp[mi][ni][1] << 16) + __uint_as_float(gp[mi][ni][1] << 16) * ap[mi][ni][2];
                const float m3 = __uint_as_float(mp[mi][ni][1] & 0xffff0000u) + __uint_as_float(gp[mi][ni][1] & 0xffff0000u) * ap[mi][ni][3];
                mp[mi][ni][0] = (unsigned)f2bf(m0) | ((unsigned)f2bf(m1) << 16);
                mp[mi][ni][1] = (unsigned)f2bf(m2) | ((unsigned)f2bf(m3) << 16);
            }
    }
    __syncthreads();
    {
        const int wid = TIDX >> 6, wr = wid >> 1;
#pragma unroll
        for (int mi = 0; mi < 4; ++mi)
#pragma unroll
            for (int ni = 0; ni < 4; ++ni) {
                bf16_t* cp = ct + (wr * 64 + mi * 16 + (lane >> 4) * 4) * CT_LD + wc * 64 + ni * 16 + (lane & 15);
                cp[0] = (bf16_t)(mp[mi][ni][0] & 0xffffu); cp[CT_LD] = (bf16_t)(mp[mi][ni][0] >> 16);
                cp[2 * CT_LD] = (bf16_t)(mp[mi][ni][1] & 0xffffu); cp[3 * CT_LD] = (bf16_t)(mp[mi][ni][1] >> 16);
            }
    }
    __syncthreads();
    ep_store_rows<128>(ct, 0, CB(C_M) + nt * 128, 1024, row0);
}

DEVI void wout_tile(const Params& p, int l, int mq, int nt, unsigned char* smem) {
    bf16_t* ct = (bf16_t*)smem;
    const int mt = mt_of(mq, l != 0);
    const int row0 = mt * 128, b = mt / 18, t0 = (mt % 18) * 128;
    const bool isctx = (mt % 18) < 2;
    const int bi = isctx ? 8 : b;
    f32x4 acc[4][4];
    acc_zero<128>(acc);
    AOp A{CB(C_M), 1024, row0, nullptr};
    gemm_core<128>(acc, A, WB(W_OUT + (size_t)l * 1024 * 1024 + (size_t)nt * 128 * 1024), 1024, 1024, smem);
    __syncthreads();
    acc_to_ct<128>(acc, ct);
    __syncthreads();
    const float* gate = WSF(OFF_MOD) + (size_t)(l * 9 + bi) * 6144 + 2 * 1024 + nt * 128;
    for (int c = TIDX; c < 128 * 32; c += 256) {
        const int i = c >> 5, jc = c & 31;
        const int t = t0 + i;
        const float* xs;
        if (l == 0) xs = isctx ? p.in[I_CTX] + ((size_t)b * CTXL + t) * DM : p.in[I_X] + ((size_t)b * SEQL + (t - CTXL)) * DM;
        else xs = XCUR + (size_t)(row0 + i) * DM;
        float4 x4 = *(const float4*)(xs + nt * 128 + jc * 4);
        float4 g4 = *(const float4*)(gate + jc * 4);
        uint2 y = *(const uint2*)(ct + i * CT_LD + jc * 4);
        x4.x += g4.x * __uint_as_float(y.x << 16);
        x4.y += g4.y * __uint_as_float(y.x & 0xffff0000u);
        x4.z += g4.z * __uint_as_float(y.y << 16);
        x4.w += g4.w * __uint_as_float(y.y & 0xffff0000u);
        *(float4*)(XCUR + (size_t)(row0 + i) * DM + nt * 128 + jc * 4) = x4;
    }
}

DEVI void phase_merge_wout(const Params& p, int l, unsigned char* smem) {
    const int nmt = (l == 0 ? 144 : 128);
    const int N5 = nmt * 8;
    int* ctr = WSI(OFF_CNT) + 132 + l;
    int* dep = WSI(OFF_CNT) + 256 + l * 160;
    for (;;) {
        const int task = fetch_task(ctr, smem);
        if (task >= 2 * N5) break;
        if (task < N5) {
            merge_tile(p, l, task >> 3, task & 7, smem);
            dep_signal(dep + (task >> 3));
        } else {
            const int t6 = task - N5;
            dep_wait(dep + (t6 >> 3), 8);
            wout_tile(p, l, t6 >> 3, t6 & 7, smem);
        }
    }
}

DEVI void phase_route(const Params& p, int l, unsigned char* smem) {
    const int tid = TIDX, lane = tid & 63, w = tid >> 6, wr = w >> 1, wc = w & 1;
    float* lgt = (float*)smem;
    const float rbias = p.in[I_RB][lane];
    int* cnt = WSI(OFF_CNT) + l * 64;
    int* list = WSI(OFF_LIST);
    const int ntile = l == 0 ? 144 : 128;
    for (int q = BIDX; q < ntile; q += gridDim.x) {
        const int mt = mt_of(q, l != 0);
        const int row0 = mt * 128;
        f32x4 acc[4][2];
        acc_zero<64>(acc);
        AOp A{HB, 1024, row0, nullptr};
        gemm_core<64>(acc, A, WB(W_RT), 1024, 1024, smem);
        __syncthreads();
#pragma unroll
        for (int mi = 0; mi < 4; ++mi)
#pragma unroll
            for (int ni = 0; ni < 2; ++ni)
#pragma unroll
                for (int j = 0; j < 4; ++j)
                    lgt[(wr * 64 + mi * 16 + (lane >> 4) * 4 + j) * 68 + wc * 32 + ni * 16 + (lane & 15)] = acc[mi][ni][j];
        __syncthreads();
        int me0 = 0, me1 = 0; float ms0 = 0.f, ms1 = 0.f;
#pragma unroll 2
        for (int i = 0; i < 32; ++i) {
            const float lg = lgt[(w * 32 + i) * 68 + lane];
            const float score = sigmoidf_(lg);
            const float biased = score + rbias;
            float v1 = biased; int i1 = lane;
#pragma unroll
            for (int off = 1; off < 8; off <<= 1) {
                float ov = __shfl_xor(v1, off); int oi = __shfl_xor(i1, off);
                if (ov > v1 || (ov == v1 && oi < i1)) { v1 = ov; i1 = oi; }
            }
            float v2 = (lane == i1) ? -3.0e38f : biased; int i2 = lane;
#pragma unroll
            for (int off = 1; off < 8; off <<= 1) {
                float ov = __shfl_xor(v2, off); int oi = __shfl_xor(i2, off);
                if (ov > v2 || (ov == v2 && oi < i2)) { v2 = ov; i2 = oi; }
            }
            float gv = v1 + v2; int gi = lane >> 3;
#pragma unroll
            for (int off = 8; off < 64; off <<= 1) {
                float ov = __shfl_xor(gv, off); int oi = __shfl_xor(gi, off);
                if (ov > gv || (ov == gv && oi < gi)) { gv = ov; gi = oi; }
            }
            const int e0 = __shfl(i1, gi * 8), e1 = __shfl(i2, gi * 8);
            const float s0 = __shfl(score, e0), s1 = __shfl(score, e1);
            if (lane == i) { me0 = e0; me1 = e1; ms0 = s0; ms1 = s1; }
        }
        if (lane < 32) {
            const int row = row0 + w * 32 + lane;
            Rec rc;
            rc.e0 = me0; rc.e1 = me1;
            rc.p0 = atomicAdd(&cnt[me0], 1);
            rc.p1 = atomicAdd(&cnt[me1], 1);
            const float inv = 1.f / (ms0 + ms1);
            rc.w0 = ms0 * inv; rc.w1 = ms1 * inv; rc.pad0 = 0; rc.pad1 = 0;
            list[(size_t)me0 * TT + rc.p0] = row;
            list[(size_t)me1 * TT + rc.p1] = row;
            ((Rec*)(p.ws + OFF_REC))[row] = rc;
        }
        __syncthreads();
    }
}

struct MoeGrp { int ne[8], sg[8], cn[8]; };
DEVI MoeGrp moe_grp(const MoeTab& mt, const GrpInfo& gi) {
    MoeGrp g;
#pragma unroll
    for (int q = 0; q < 8; ++q) {
        const int ee = gi.ngrp == 8 ? gi.xcd * 8 + q : 0;
        g.cn[q] = mt.cnt(ee); g.sg[q] = mt.seg(ee); g.ne[q] = (g.cn[q] + 127) >> 7;
    }
    return g;
}
DEVI bool moe_tile(const MoeTab& mt, const MoeGrp& mg, const GrpInfo& gi, int it, int NT, int& e, int& jt, int& nt, int& cn, int& sg) {
    int rem = gi.j + gi.per * it;
    if (gi.ngrp == 8) {
#pragma unroll
        for (int q = 0; q < 8; ++q) {
            const int ne = mg.ne[q] * NT;
            if (rem < ne) { e = gi.xcd * 8 + q; jt = rem / NT; nt = rem % NT; cn = mg.cn[q]; sg = mg.sg[q]; return true; }
            rem -= ne;
        }
        return false;
    }
    for (int ee = 0; ee < 64; ++ee) {
        const int c = mt.cnt(ee);
        const int ne = ((c + 127) >> 7) * NT;
        if (rem < ne) { e = ee; jt = rem / NT; nt = rem % NT; cn = c; sg = mt.seg(ee); return true; }
        rem -= ne;
    }
    return false;
}
DEVI void moe_find(const MoeTab& mt, int rt, int& e, int& jt) {
    int lo = 0, hi = 64;
    while (hi - lo > 1) { const int mid = (lo + hi) >> 1; if (mt.tp(mid) <= rt) lo = mid; else hi = mid; }
    e = lo; jt = rt - mt.tp(lo);
}
DEVI void phase_moe(const Params& p, int l, unsigned char* smem) {
    bf16_t* ct = (bf16_t*)smem;
    int* ridx = (int*)(smem + AUX_OFF);
    MoeTab mt = moe_tables(p, l, smem);
    const int* list = WSI(OFF_LIST);
    const int nrt = mt.tp(64);
    int* ctr = WSI(OFF_CNT) + 136 + l;
    int* dep = WSI(OFF_CNT) + 1024 + l * 384;
    for (;;) {
        const int task = fetch_task(ctr, smem);
        if (task >= nrt * 12) break;
        if (task < nrt * 4) {
            const int rt = task >> 2, nt = task & 3;
            int e, jt;
            moe_find(mt, rt, e, jt);
            const int cn = mt.cnt(e), sg = mt.seg(e);
            if (TIDX < 128) {
                const int idx = jt * 128 + TIDX;
                ridx[TIDX] = list[(size_t)e * TT + (idx < cn ? idx : 0)];
            }
            __syncthreads();
            f32x4 acc[4][4];
            acc_zero<128>(acc);
            gemm_core_fp8<true>(acc, (const unsigned char*)CB(0), 1024, 0, (const unsigned char*)MWB(MW_13) + ((size_t)e * 512 + nt * 128) * 1024, 1024, 1024, smem, ridx);
            __syncthreads();
            acc_to_ct<128>(acc, ct);
            __syncthreads();
            const int slot0 = sg + jt * 128;
            for (int c = TIDX; c < 128 * 8; c += 256) {
                const int i = c >> 3, jc = c & 7;
                bf16x8 a = *(const bf16x8*)(ct + i * CT_LD + jc * 8), g = *(const bf16x8*)(ct + i * CT_LD + 64 + jc * 8), o;
#pragma unroll
                for (int q = 0; q < 8; ++q) o[q] = (short)f2bf(siluf_(bf2f((bf16_t)a[q])) * bf2f((bf16_t)g[q]));
                *(bf16x8*)(DB(D_ACT) + (size_t)(slot0 + i) * 256 + nt * 64 + jc * 8) = o;
            }
            dep_signal(dep + rt);
        } else {
            const int t2 = task - nrt * 4;
            const int rt = t2 >> 3, nt = t2 & 7;
            int e, jt;
            moe_find(mt, rt, e, jt);
            const int slot0 = mt.seg(e) + jt * 128;
            dep_wait(dep + rt, 4);
            f32x4 acc[4][4];
            acc_zero<128>(acc);
            AOp A{DB(D_ACT), 256, slot0, nullptr};
            gemm_core<128>(acc, A, MWB(MW_2) + ((size_t)e * 1024 + nt * 128) * 256, 256, 256, smem);
            __syncthreads();
            acc_to_ct<128>(acc, ct);
            __syncthreads();
            ep_store_rows<128>(ct, 0, DB(D_YS) + nt * 128, 1024, slot0);
        }
    }
}

#define XB_TMO      128
#define XB_XCNT(j)  (256  + 64 * (j))
#define XB_XSUB(j)  (1280 + 64 * (j))
#define XB_XGEN(j)  (2304 + 64 * (j))
#define XB_TOP      3328
#define XB_TOPGEN   3392
#define XB_SPIN_CAP (1u << 22)
DEVI unsigned xb_ld(unsigned* p) { return __hip_atomic_load(p, __ATOMIC_RELAXED, __HIP_MEMORY_SCOPE_AGENT); }
DEVI unsigned xb_add(unsigned* p, unsigned v) { return __hip_atomic_fetch_add(p, v, __ATOMIC_RELAXED, __HIP_MEMORY_SCOPE_AGENT); }
DEVI unsigned xb_xcc_id() { return (unsigned)__builtin_amdgcn_s_getreg((3 << 11) | 20) & 0xFu; }
#define XB_SPIN(cond, bar) do { unsigned _sp = 0; while (cond) { __builtin_amdgcn_s_sleep(1); \
    if ((++_sp & 255u) == 0u) { if (xb_ld(&(bar)[XB_TMO])) break; if (_sp > XB_SPIN_CAP) { atomicAdd(&(bar)[XB_TMO], 1u); break; } } } } while (0)
struct XcdBarrier { unsigned* bar; unsigned x; unsigned* st; };
DEVI XcdBarrier xcd_barrier_post(unsigned* bar, unsigned* st) {
    XcdBarrier b; b.bar = bar; b.x = xb_xcc_id(); b.st = st;
    if (__builtin_amdgcn_workitem_id_x() == 0) (void)xb_add(&bar[XB_XCNT(b.x)], 1u);
    return b;
}
DEVI void xcd_barrier_complete(unsigned* bar, unsigned x, unsigned& nloc, unsigned& nx) {
    const unsigned G = gridDim.x * gridDim.y * gridDim.z;
    unsigned sum, cnt, mine, sp = 0u;
    for (;;) {
        sum = 0u; cnt = 0u; mine = 0u;
#pragma unroll
        for (unsigned j = 0; j < 16; ++j) { const unsigned c = xb_ld(&bar[XB_XCNT(j)]); sum += c; cnt += (c > 0u) ? 1u : 0u; mine = (j == x) ? c : mine; }
        if (sum == G) break;
        __builtin_amdgcn_s_sleep(1);
        if ((++sp & 255u) == 0u) { if (xb_ld(&bar[XB_TMO])) break; if (sp > XB_SPIN_CAP) { atomicAdd(&bar[XB_TMO], 1u); break; } }
    }
    nloc = mine > 0u ? mine : 1u; nx = cnt > 0u ? cnt : 1u;
}
DEVI void xcd_barrier(const XcdBarrier& b) {
    asm volatile("s_waitcnt vmcnt(0)" ::: "memory");
    __syncthreads();
    if (__builtin_amdgcn_workitem_id_x() == 0) {
        unsigned* bar = b.bar;
        __builtin_amdgcn_s_waitcnt(0);
        unsigned nloc = xb_ld(&b.st[0]), nx = xb_ld(&b.st[1]);
        if (nloc == 0u) { xcd_barrier_complete(bar, b.x, nloc, nx); __hip_atomic_store(&b.st[0], nloc, __ATOMIC_RELAXED, __HIP_MEMORY_SCOPE_AGENT); __hip_atomic_store(&b.st[1], nx, __ATOMIC_RELAXED, __HIP_MEMORY_SCOPE_AGENT); }
        const unsigned old = xb_add(&bar[XB_XSUB(b.x)], 1u);
        const unsigned gen = old / nloc;
        if (old + 1u == (gen + 1u) * nloc) {
            __builtin_amdgcn_fence(__ATOMIC_RELEASE, "agent");
            asm volatile("s_waitcnt vmcnt(0)" ::: "memory");
            const unsigned og = xb_add(&bar[XB_TOP], 1u);
            const unsigned tg = og / nx;
            if (og + 1u == (tg + 1u) * nx) xb_add(&bar[XB_TOPGEN], 1u);
            else XB_SPIN(xb_ld(&bar[XB_TOPGEN]) == tg, bar);
            __builtin_amdgcn_fence(__ATOMIC_ACQUIRE, "agent");
            xb_add(&bar[XB_XGEN(b.x)], 1u);
            asm volatile("s_waitcnt vmcnt(0)" ::: "memory");
        } else {
            XB_SPIN(xb_ld(&bar[XB_XGEN(b.x)]) == gen, bar);
            __builtin_amdgcn_fence(__ATOMIC_ACQUIRE, "agent");
            asm volatile("s_waitcnt vmcnt(0)" ::: "memory");
        }
    }
    __syncthreads();
}

constexpr int NPHASE = 24;
DEVI void run_phase(const Params& p, int ph, unsigned char* smem) {
#ifndef ONLYK
    if (ph == 0) { phase0(p, smem); return; }
    if (ph == 23) { phase_norm1(p, 1, 1, smem); return; }
#endif
    const int l = (ph - 1) / 11, k = (ph - 1) % 11;
#ifdef ONLYK
    if (k != ONLYK) return;
#endif
    switch (k) {
    case 0: phase_norm1(p, l, 0, smem); break;
    case 1: phase_win(p, l, smem); break;
    case 2: phase_mla_up(p, l, smem); break;
    case 3: phase_mix(p, l, smem); break;
    case 4: phase_fin(p, l); break;
    case 5: phase_merge_wout(p, l, smem); break;
    case 6: break;
    case 7: phase_norm1(p, l, 2, smem); break;
    case 8: phase_route(p, l, smem); break;
    case 9: phase_moe(p, l, smem); break;
    default: break;
    }
}

__global__ void __launch_bounds__(256, 2) k_main(Params p, int ph_lo, int ph_hi) {
    __shared__ __attribute__((aligned(16))) unsigned char smem[SMEM_BYTES];
    unsigned* xb_priv = (unsigned*)(p.ws + OFF_PRIV + (size_t)__builtin_amdgcn_workgroup_id_x() * 1024 + 896);
    if (__builtin_amdgcn_workitem_id_x() == 0) { __hip_atomic_store(xb_priv, 0u, __ATOMIC_RELAXED, __HIP_MEMORY_SCOPE_AGENT); __hip_atomic_store(xb_priv + 1, 0u, __ATOMIC_RELAXED, __HIP_MEMORY_SCOPE_AGENT); }
    XcdBarrier xb = xcd_barrier_post((unsigned*)(p.ws + OFF_BAR), xb_priv);
    if (__builtin_amdgcn_workitem_id_x() == 0) {
        const unsigned rk = xb_add((unsigned*)(p.ws + OFF_BAR) + 3456 + xb.x, 1u);
        __hip_atomic_store(xb_priv + 2, xb.x, __ATOMIC_RELAXED, __HIP_MEMORY_SCOPE_AGENT);
        __hip_atomic_store(xb_priv + 3, rk, __ATOMIC_RELAXED, __HIP_MEMORY_SCOPE_AGENT);
    }
    for (int ph = ph_lo; ph < ph_hi; ++ph) {
        if (ph >= 1 && ph <= 22 && (((ph - 1) % 11) == 6 || ((ph - 1) % 11) == 10)) continue;
        run_phase(p, ph, smem);
#ifdef DUPK
        if (ph >= 1 && ph <= 22 && ((ph - 1) % 11) == DUPK) run_phase(p, ph, smem);
        if (DUPK == 10 && ph == 0) run_phase(p, ph, smem);
#endif
        if (ph + 1 < ph_hi) {
            if (ph == ph_lo) cg::this_grid().sync();
            else xcd_barrier(xb);
        }
    }
#ifdef TPROBE
    if (__builtin_amdgcn_workgroup_id_x() == 0 && __builtin_amdgcn_workitem_id_x() == 0) {
        const unsigned long long dt = __hip_atomic_load(T_SLOT(TPROBE), __ATOMIC_RELAXED, __HIP_MEMORY_SCOPE_AGENT) * TMULT;
        const unsigned long long t0 = __builtin_amdgcn_s_memrealtime();
        while (__builtin_amdgcn_s_memrealtime() - t0 < dt) __builtin_amdgcn_s_sleep(8);
    }
#endif
}

extern "C" void kernel_launch(void* const* d_in, const int* in_sizes, int n_in, void* d_out, int out_size, void* d_ws, size_t ws_size,
                              hipStream_t stream) {
    if (ws_size < WS_NEED || n_in < N_IN) { fprintf(stderr, "workspace too small: %zu < %zu\n", ws_size, (size_t)WS_NEED); return; }
    Params p{};
    for (int i = 0; i < N_IN; ++i) p.in[i] = (const float*)d_in[i];
    p.out = (float*)d_out;
    p.ws = (unsigned char*)d_ws;
    static int grid_blocks = 0;
    if (!grid_blocks) {
        int dev = 0, cus = 0, per_cu = 0;
        hipGetDevice(&dev);
        hipDeviceGetAttribute(&cus, hipDeviceAttributeMultiprocessorCount, dev);
        hipOccupancyMaxActiveBlocksPerMultiprocessor(&per_cu, k_main, 256, DYN_LDS);
        if (per_cu > 2) per_cu = 2;
        if (per_cu < 1) per_cu = 1;
        grid_blocks = cus * per_cu;
    }
    hipMemsetAsync(p.ws + OFF_BAR, 0, 16384, stream);
#if ONE_LAUNCH
    int lo = 0, hi = NPHASE;
    void* args[] = {&p, &lo, &hi};
    hipError_t e = hipLaunchCooperativeKernel((void*)k_main, dim3(grid_blocks), dim3(256), args, DYN_LDS, stream);
    if (e != hipSuccess) fprintf(stderr, "cooperative launch failed: %s (grid %d)\n", hipGetErrorString(e), grid_blocks);
#else
    for (int ph = 0; ph < NPHASE; ++ph) hipLaunchKernelGGL(k_main, dim3(grid_blocks), dim3(256), DYN_LDS, stream, p, ph, ph + 1);
#endif
}
```

```cpp
#include <hip/hip_runtime.h>
#include <hip/hip_cooperative_groups.h>
#include <stdint.h>
#include <stdio.h>
namespace cg = cooperative_groups;

#define DEVI __device__ __forceinline__
#define LAS __attribute__((address_space(3)))
typedef unsigned short bf16_t;
typedef __attribute__((ext_vector_type(8))) short bf16x8;
typedef __attribute__((ext_vector_type(4))) float f32x4;
typedef __attribute__((ext_vector_type(16))) float f32x16;
typedef __attribute__((ext_vector_type(4))) short bf16x4;

#ifndef NAIVE_GEMM
#define NAIVE_GEMM 0
#endif
#ifndef ONE_LAUNCH
#define ONE_LAUNCH 1
#endif

constexpr int DM = 1024, NBT = 8, SEQL = 2048, CTXL = 256, TPB = 2304, TT = 18432;
constexpr int DINP = 3840;
constexpr float LOG2E = 1.4426950408889634f;
constexpr float EPSV = 1e-6f;
constexpr int NSLOT = 2 * TT + 64 * 128;

enum { I_X = 0, I_C, I_CTX, I_CCTX, I_ADAW, I_ADAB, I_N1G, I_N2G, I_WIN, I_MQN, I_MKVN, I_WUQ, I_WUKV, I_RDEC, I_RNORM,
       I_LCW, I_LCB, I_LWA, I_LBA, I_LWX, I_LBX, I_LLAM, I_GQN, I_GKN, I_WBR, I_WMG, I_BMG, I_WOUT, I_RW, I_RB,
       I_W1, I_W3, I_W2, I_FN, N_IN };

constexpr size_t AL(size_t x) { return (x + 255) & ~(size_t)255; }
constexpr size_t OFF_BAR = 0;
constexpr size_t OFF_CNT = 16384;
constexpr size_t OFF_MOD = OFF_CNT + 16384;
constexpr size_t OFF_R64 = AL(OFF_MOD + (size_t)2 * 9 * 6144 * 4);
constexpr size_t OFF_R32 = OFF_R64 + (size_t)2048 * 64 * 4;
constexpr size_t OFF_REC = OFF_R32 + (size_t)2048 * 32 * 4;
constexpr size_t OFF_LIST = OFF_REC + (size_t)TT * 32;
constexpr size_t OFF_PRIV = AL(OFF_LIST + (size_t)64 * TT * 4);
constexpr size_t OFF_W = OFF_PRIV + (size_t)2048 * 1024;
constexpr size_t W_IN = 0;
constexpr size_t W_UQ = W_IN + (size_t)2 * 3840 * 1024;
constexpr size_t W_UKV = W_UQ + (size_t)2 * 768 * 256;
constexpr size_t W_BR = W_UKV + (size_t)2 * 1024 * 128;
constexpr size_t W_MG = W_BR + (size_t)2 * 4 * 1024 * 512;
constexpr size_t W_OUT = W_MG + (size_t)2 * 4096 * 1024;
constexpr size_t W_LRU = W_OUT + (size_t)2 * 1024 * 1024;
constexpr size_t W_RT = W_LRU + (size_t)2 * 2 * 8 * 2 * 64 * 64;
constexpr size_t W_END = W_RT + (size_t)64 * 1024;
constexpr size_t OFF_XCUR = AL(OFF_W + W_END * 2);
constexpr size_t OFF_H = OFF_XCUR + (size_t)TT * 1024 * 4;
constexpr size_t OFF_C = OFF_H + (size_t)TT * 1024 * 2;
constexpr size_t C_CQ = 0;
constexpr size_t C_CKV = C_CQ + (size_t)TT * 256;
constexpr size_t C_KR = C_CKV + (size_t)TT * 128;
constexpr size_t C_MQ = C_KR + (size_t)TT * 32;
constexpr size_t C_KN = C_MQ + (size_t)TT * 768;
constexpr size_t C_VMT = C_KN + (size_t)TT * 512;
constexpr size_t C_RQ = C_VMT + (size_t)TT * 512;
constexpr size_t C_RK = C_RQ + (size_t)TT * 256;
constexpr size_t C_RKT = C_RK + (size_t)TT * 256;
constexpr size_t C_RVT = C_RKT + (size_t)TT * 256;
constexpr size_t C_RG = C_RVT + (size_t)TT * 512;
constexpr size_t C_LX = C_RG + (size_t)TT * 512;
constexpr size_t C_LG = C_LX + (size_t)TT * 512;
constexpr size_t C_GQ = C_LG + (size_t)TT * 512;
constexpr size_t C_GK = C_GQ + (size_t)TT * 512;
constexpr size_t C_GVT = C_GK + (size_t)TT * 128;
constexpr size_t C_END = C_GVT + (size_t)TT * 128;
constexpr size_t C_M = 0;
constexpr size_t C_W13 = (size_t)24 * 1024 * 1024;
constexpr size_t C_W2 = C_W13 + (size_t)64 * 512 * 1024;
static_assert(C_W2 + (size_t)64 * 1024 * 256 <= C_END, "moe alias");
static_assert((size_t)TT * 1024 <= C_W13, "m alias");
constexpr size_t OFF_D = OFF_C + C_END * 2;
constexpr size_t D_YA = 0;
constexpr size_t D_YD = (size_t)TT * 512;
constexpr size_t D_OF = (size_t)2 * TT * 512;
constexpr size_t D_OB = (size_t)3 * TT * 512;
constexpr size_t D_LH0 = (size_t)4 * TT * 512;
constexpr size_t D_LH1 = (size_t)5 * TT * 512;
constexpr size_t D_ACT = 0;
constexpr size_t D_YS = (size_t)12 * 1024 * 1024;
constexpr size_t D_END = D_YS + (size_t)NSLOT * 1024;
static_assert((size_t)NSLOT * 256 <= D_YS, "act alias");
static_assert((size_t)6 * TT * 512 <= D_END, "d size");
constexpr size_t OFF_MOEW = AL(OFF_D + D_END * 2);
constexpr size_t MW_13 = 0, MW_2 = (size_t)64 * 512 * 1024, MW_END = MW_2 + (size_t)64 * 1024 * 256;
constexpr size_t WS_NEED = OFF_MOEW + MW_END * 2;

struct Params {
    const float* in[N_IN];
    float* out;
    unsigned char* ws;
};

#define WSF(off) ((float*)(p.ws + (off)))
#define WSI(off) ((int*)(p.ws + (off)))
#define WB(el) ((bf16_t*)(p.ws + OFF_W) + (el))
#define CB(el) ((bf16_t*)(p.ws + OFF_C) + (el))
#define DB(el) ((bf16_t*)(p.ws + OFF_D) + (el))
#define MWB(el) ((bf16_t*)(p.ws + OFF_MOEW) + (el))
#define HB ((bf16_t*)(p.ws + OFF_H))
#define XCUR ((float*)(p.ws + OFF_XCUR))

constexpr int SMEM_BYTES = 65536;
constexpr int DYN_LDS = 0;
constexpr int CT_LD = 136;
constexpr int AUX_OFF = 36864;

#ifdef TPROBE
#define T_SLOT(id) ((unsigned long long*)(p.ws + OFF_BAR + 14400) + (id))
#define T_BEGIN(id) const unsigned long long _tb##id = __builtin_amdgcn_s_memrealtime()
#define T_END(id, cond) do { if ((cond) && __builtin_amdgcn_workitem_id_x() == 0) atomicAdd(T_SLOT(id), __builtin_amdgcn_s_memrealtime() - _tb##id); } while (0)
#else
#define T_BEGIN(id)
#define T_END(id, cond)
#endif
DEVI int launder_tid() { int t = __builtin_amdgcn_workitem_id_x(); asm volatile("" : "+v"(t)); return t; }
DEVI int launder_bid() { int t = __builtin_amdgcn_workgroup_id_x(); asm volatile("" : "+s"(t)); return t; }
#define TIDX launder_tid()
#define BIDX launder_bid()
DEVI float bf2f(bf16_t v) { return __uint_as_float(((unsigned)v) << 16); }
DEVI bf16_t f2bf(float f) {
    __bf16 h = (__bf16)f;
    return __builtin_bit_cast(unsigned short, h);
}
typedef __attribute__((ext_vector_type(8))) int i32x8;
typedef __attribute__((ext_vector_type(4))) int i32x4;
DEVI float clamp8(float x) { return __builtin_amdgcn_fmed3f(x, -448.f, 448.f); }
DEVI int pk4_fp8(float a, float b, float c, float d) {
    int r = __builtin_amdgcn_cvt_pk_fp8_f32(clamp8(a), clamp8(b), 0, false);
    return __builtin_amdgcn_cvt_pk_fp8_f32(clamp8(c), clamp8(d), r, true);
}
DEVI float fsig(float x) { return __builtin_amdgcn_rcpf(1.f + __expf(-x)); }
DEVI float sigmoidf_(float x) { return 1.f / (1.f + __expf(-x)); }
DEVI float siluf_(float x) { return x / (1.f + __expf(-x)); }
DEVI float gelu_tanh(float x) {
    float u = 0.7978845608028654f * (x + 0.044715f * x * x * x);
    return 0.5f * x * (1.f + tanhf(u));
}
DEVI float wave_sum(float v) {
#pragma unroll
    for (int o = 32; o > 0; o >>= 1) v += __shfl_xor(v, o);
    return v;
}
DEVI int mt_of(int q, bool latonly) { return latonly ? (q >> 4) * 18 + 2 + (q & 15) : q; }

struct CvtJob { const float* src; bf16_t* dst; const float* ks; int K, N, ldd, batch; size_t sbs, dbs; int mode; int lds, n0, wide; };
DEVI int cvt_rowmap(int mode, int n) {
    if (mode == 1) return n < 384 ? n : (n < 416 ? n - 384 + 3712 : n - 32);
    if (mode == 2) { int h = n / 96, j = n % 96; return j < 64 ? h * 64 + j : 512 + h * 32 + (j - 64); }
    if (mode == 3) return (n >> 6) * 128 + (n & 63);
    return n;
}
DEVI void cvt_tile(const CvtJob& j, int tile, float* lds) {
    const int tn = j.N / 32, tk = j.K / 64, per = tn * tk;
    const int bb = tile / per, r = tile % per, kt = r / tn, nt = r % tn;
    const float* s = j.src + (size_t)bb * j.sbs + (size_t)(kt * 64) * j.lds + j.n0 + nt * 32;
    const int tx = TIDX & 31, ty = TIDX >> 5;
#pragma unroll
    for (int i = 0; i < 8; ++i) {
        int k = ty + 8 * i;
        float v = s[(size_t)k * j.lds + tx];
        if (j.ks) v *= j.ks[kt * 64 + k];
        lds[k * 33 + tx] = v;
    }
    __syncthreads();
    bf16_t* d = j.dst + (size_t)bb * j.dbs;
#pragma unroll
    for (int i = 0; i < 4; ++i) {
        int n = ty + 8 * i, kk = tx * 2;
        unsigned lo = f2bf(lds[kk * 33 + n]), hi = f2bf(lds[(kk + 1) * 33 + n]);
        int row = cvt_rowmap(j.mode, j.n0 + nt * 32 + n);
        *(unsigned*)(d + (size_t)row * j.ldd + kt * 64 + kk) = lo | (hi << 16);
    }
    __syncthreads();
}

DEVI void cvt_tile256(const CvtJob& j, int tile, unsigned char* smem) {
    constexpr int NS = 68;
    bf16_t* T = (bf16_t*)smem;
    const int tn = j.N / 256, tk = j.K / 64, per = tn * tk;
    const int bb = tile / per, r = tile % per, kt = r / tn, nt = r % tn;
    const float* s = j.src + (size_t)bb * j.sbs + (size_t)(kt * 64) * j.lds + j.n0 + nt * 256;
    const int tid = TIDX, lane = tid & 63, w = tid >> 6;
    float4 v[16];
#pragma unroll
    for (int i = 0; i < 16; ++i) v[i] = *(const float4*)(s + (size_t)(w * 16 + i) * j.lds + lane * 4);
    if (j.ks) {
#pragma unroll
        for (int i = 0; i < 16; ++i) { const float sc = j.ks[kt * 64 + w * 16 + i]; v[i].x *= sc; v[i].y *= sc; v[i].z *= sc; v[i].w *= sc; }
    }
    __syncthreads();
#pragma unroll
    for (int h = 0; h < 2; ++h) {
        bf16x4 q0a, q0b, q1a, q1b, q2a, q2b, q3a, q3b;
#pragma unroll
        for (int e = 0; e < 4; ++e) {
            q0a[e] = (short)f2bf(v[h * 8 + e].x); q0b[e] = (short)f2bf(v[h * 8 + 4 + e].x);
            q1a[e] = (short)f2bf(v[h * 8 + e].y); q1b[e] = (short)f2bf(v[h * 8 + 4 + e].y);
            q2a[e] = (short)f2bf(v[h * 8 + e].z); q2b[e] = (short)f2bf(v[h * 8 + 4 + e].z);
            q3a[e] = (short)f2bf(v[h * 8 + e].w); q3b[e] = (short)f2bf(v[h * 8 + 4 + e].w);
        }
        bf16_t* tp = T + (lane * 4) * NS + w * 16 + h * 8;
        *(bf16x4*)(tp) = q0a; *(bf16x4*)(tp + 4) = q0b;
        *(bf16x4*)(tp + NS) = q1a; *(bf16x4*)(tp + NS + 4) = q1b;
        *(bf16x4*)(tp + 2 * NS) = q2a; *(bf16x4*)(tp + 2 * NS + 4) = q2b;
        *(bf16x4*)(tp + 3 * NS) = q3a; *(bf16x4*)(tp + 3 * NS + 4) = q3b;
    }
    __syncthreads();
    bf16_t* d = j.dst + (size_t)bb * j.dbs;
#pragma unroll
    for (int i = 0; i < 8; ++i) {
        const int c = tid + 256 * i, n = c >> 3, kc = c & 7;
        const bf16x4 lo = *(const bf16x4*)(T + n * NS + kc * 8), hi = *(const bf16x4*)(T + n * NS + kc * 8 + 4);
        const int row = cvt_rowmap(j.mode, j.n0 + nt * 256 + n);
        *(bf16x8*)(d + (size_t)row * j.ldd + kt * 64 + kc * 8) = bf16x8{lo[0], lo[1], lo[2], lo[3], hi[0], hi[1], hi[2], hi[3]};
    }
}
constexpr float W8_SCALE = 32.f;
DEVI void cvt_tile256_fp8(const CvtJob& j, int tile, unsigned char* smem) {
    constexpr int RS = 80;
    const int tn = j.N / 256, tk = j.K / 64, per = tn * tk;
    const int bb = tile / per, r = tile % per, kt = r / tn, nt = r % tn;
    const float* s = j.src + (size_t)bb * j.sbs + (size_t)(kt * 64) * j.lds + nt * 256;
    const int tid = TIDX, lane = tid & 63, w = tid >> 6;
    float4 v[16];
#pragma unroll
    for (int i = 0; i < 16; ++i) v[i] = *(const float4*)(s + (size_t)(w * 16 + i) * j.lds + lane * 4);
    __syncthreads();
    i32x4 q0, q1, q2, q3;
#pragma unroll
    for (int c = 0; c < 4; ++c) {
        q0[c] = pk4_fp8(v[4 * c].x * W8_SCALE, v[4 * c + 1].x * W8_SCALE, v[4 * c + 2].x * W8_SCALE, v[4 * c + 3].x * W8_SCALE);
        q1[c] = pk4_fp8(v[4 * c].y * W8_SCALE, v[4 * c + 1].y * W8_SCALE, v[4 * c + 2].y * W8_SCALE, v[4 * c + 3].y * W8_SCALE);
        q2[c] = pk4_fp8(v[4 * c].z * W8_SCALE, v[4 * c + 1].z * W8_SCALE, v[4 * c + 2].z * W8_SCALE, v[4 * c + 3].z * W8_SCALE);
        q3[c] = pk4_fp8(v[4 * c].w * W8_SCALE, v[4 * c + 1].w * W8_SCALE, v[4 * c + 2].w * W8_SCALE, v[4 * c + 3].w * W8_SCALE);
    }
    unsigned char* tp = smem + (lane * 4) * RS + w * 16;
    *(i32x4*)(tp) = q0; *(i32x4*)(tp + RS) = q1; *(i32x4*)(tp + 2 * RS) = q2; *(i32x4*)(tp + 3 * RS) = q3;
    __syncthreads();
    unsigned char* d = (unsigned char*)j.dst + (size_t)bb * j.dbs;
#pragma unroll
    for (int i = 0; i < 4; ++i) {
        const int c = tid + 256 * i, n = c >> 2, kc = c & 3;
        *(i32x4*)(d + (size_t)cvt_rowmap(j.mode, nt * 256 + n) * j.ldd + kt * 64 + kc * 16) = *(const i32x4*)(smem + n * RS + kc * 16);
    }
}
__constant__ const int CVT_TILES[10] = {224, 80, 12, 8, 128, 256, 64, 32, 32, 32};
constexpr int CVT_PER_LAYER = 224 + 80 + 12 + 8 + 128 + 256 + 64 + 32 + 32 + 32;
DEVI CvtJob get_job(const Params& p, int l, int k) {
    CvtJob j; j.ks = nullptr; j.batch = 1; j.sbs = 0; j.dbs = 0; j.mode = 0; j.n0 = 0; j.wide = 1;
    switch (k) {
    case 0: j.src = p.in[I_WIN] + (size_t)l * 1024 * 3744; j.dst = WB(W_IN + (size_t)l * 3840 * 1024); j.K = 1024; j.N = 3584; j.lds = 3744; j.ldd = 1024; j.mode = 1; break;
    case 1: j.src = p.in[I_WIN] + (size_t)l * 1024 * 3744; j.dst = WB(W_IN + (size_t)l * 3840 * 1024); j.K = 1024; j.N = 160; j.lds = 3744; j.n0 = 3584; j.ldd = 1024; j.mode = 1; j.wide = 0; break;
    case 2: j.src = p.in[I_WUQ] + (size_t)l * 256 * 768; j.dst = WB(W_UQ + (size_t)l * 768 * 256); j.K = 256; j.N = 768; j.lds = 768; j.ldd = 256; j.ks = p.in[I_MQN] + l * 256; j.mode = 2; break;
    case 3: j.src = p.in[I_WUKV] + (size_t)l * 128 * 1024; j.dst = WB(W_UKV + (size_t)l * 1024 * 128); j.K = 128; j.N = 1024; j.lds = 1024; j.ldd = 128; j.ks = p.in[I_MKVN] + l * 128; break;
    case 4: j.src = p.in[I_WBR] + (size_t)l * 4 * 512 * 1024; j.dst = WB(W_BR + (size_t)l * 4 * 1024 * 512); j.K = 512; j.N = 1024; j.lds = 1024; j.ldd = 512; j.batch = 4; j.sbs = 512 * 1024; j.dbs = 1024 * 512; break;
    case 5: j.src = p.in[I_WMG] + (size_t)l * 1024 * 4096; j.dst = WB(W_MG + (size_t)l * 4096 * 1024); j.K = 1024; j.N = 4096; j.lds = 4096; j.ldd = 1024; break;
    case 6: j.src = p.in[I_WOUT] + (size_t)l * 1024 * 1024; j.dst = WB(W_OUT + (size_t)l * 1024 * 1024); j.K = 1024; j.N = 1024; j.lds = 1024; j.ldd = 1024; break;
    case 7: j.src = p.in[I_LWA] + (size_t)l * 16 * 4096; j.dst = WB(W_LRU + (size_t)l * 16 * 8192); j.K = 64; j.N = 64; j.lds = 64; j.ldd = 64; j.batch = 16; j.sbs = 4096; j.dbs = 8192; j.wide = 0; break;
    case 8: j.src = p.in[I_LWX] + (size_t)l * 16 * 4096; j.dst = WB(W_LRU + (size_t)l * 16 * 8192 + 4096); j.K = 64; j.N = 64; j.lds = 64; j.ldd = 64; j.batch = 16; j.sbs = 4096; j.dbs = 8192; j.wide = 0; break;
    default: j.src = p.in[I_RW]; j.dst = WB(W_RT); j.K = 1024; j.N = 64; j.lds = 64; j.ldd = 1024; j.wide = 0; break;
    }
    return j;
}
DEVI CvtJob get_moe_job(const Params& p, int l, int k) {
    CvtJob j; j.ks = nullptr; j.batch = 64; j.sbs = 262144; j.n0 = 0; j.wide = 1;
    if (k == 0) { j.src = p.in[I_W1] + (size_t)l * 64 * 262144; j.dst = MWB(MW_13);     j.K = 1024; j.N = 256; j.lds = 256; j.ldd = 1024; j.dbs = 512 * 1024; j.mode = 3; }
    else if (k == 1) { j.src = p.in[I_W3] + (size_t)l * 64 * 262144; j.dst = (bf16_t*)((unsigned char*)MWB(MW_13) + 64 * 1024); j.K = 1024; j.N = 256; j.lds = 256; j.ldd = 1024; j.dbs = 512 * 1024; j.mode = 3; }
    else { j.src = p.in[I_W2] + (size_t)l * 64 * 262144; j.dst = MWB(MW_2); j.K = 256; j.N = 1024; j.lds = 1024; j.ldd = 256; j.dbs = 262144; j.mode = 0; }
    return j;
}

struct AOp { const bf16_t* base; int ld; int row0; const int* ridx; };
DEVI const bf16_t* arow(const AOp& a, int i) {
    int r = a.ridx ? a.ridx[i] : a.row0 + i;
    return a.base + (size_t)r * a.ld;
}

#if NAIVE_GEMM
template <int BN>
DEVI void gemm_core(f32x4 (&acc)[4][BN / 32], const AOp& A, const bf16_t* B, int ldb, int K, unsigned char* smem) {
    constexpr int NI = BN / 32;
    const int tid = TIDX, lane = tid & 63, wid = tid >> 6, wr = wid >> 1, wc = wid & 1;
    for (int k0 = 0; k0 < K; k0 += 8) {
        bf16x8 bv[NI];
#pragma unroll
        for (int ni = 0; ni < NI; ++ni) bv[ni] = *(const bf16x8*)(B + (size_t)(wc * (BN / 2) + ni * 16 + (lane & 15)) * ldb + k0);
#pragma unroll
        for (int mi = 0; mi < 4; ++mi)
#pragma unroll
            for (int j = 0; j < 4; ++j) {
                bf16x8 av = *(const bf16x8*)(arow(A, wr * 64 + mi * 16 + (lane >> 4) * 4 + j) + k0);
#pragma unroll
                for (int ni = 0; ni < NI; ++ni) {
                    float s = 0.f;
#pragma unroll
                    for (int e = 0; e < 8; ++e) s += bf2f((bf16_t)av[e]) * bf2f((bf16_t)bv[ni][e]);
                    acc[mi][ni][j] += s;
                }
            }
    }
}
#else
#define GAS __attribute__((address_space(1)))
template <int BN, bool GATHER = false>
DEVI void gemm_core(f32x4 (&acc)[4][BN / 32], const AOp& A, const bf16_t* B, int ldb, int K, unsigned char* smem) {
    constexpr int NI = BN / 32;
    constexpr int NBL = BN / 32;
    constexpr int STG = 32768;
    const int tid = TIDX, lane = tid & 63, wid = tid >> 6, wr = wid >> 1, wc = wid & 1;
    const int lr = tid >> 3;
    const int kc = (tid & 7) ^ (lr & 7);
    const bf16_t* ap[GATHER ? 4 : 1];
    if (GATHER) {
#pragma unroll
        for (int i = 0; i < (GATHER ? 4 : 1); ++i) ap[i] = arow(A, lr + 32 * i) + kc * 8;
    } else ap[0] = A.base + (size_t)(A.row0 + lr) * A.ld + kc * 8;
    const size_t astep = (size_t)32 * A.ld;
    const bf16_t* bp = B + (size_t)lr * ldb + kc * 8;
    const size_t bstep = (size_t)32 * ldb;
    LAS unsigned char* lA = (LAS unsigned char*)smem + tid * 16;
    LAS unsigned char* lB = lA + 16384;
    const int nk = K >> 6;
    const int arow_off = (wr * 64 + (lane & 15)) * 128;
    const int brow_off = 16384 + (wc * (BN / 2) + (lane & 15)) * 128;
    __syncthreads();
#pragma unroll
    for (int i = 0; i < 4; ++i) __builtin_amdgcn_global_load_lds((const GAS unsigned*)(GATHER ? ap[GATHER ? i : 0] : ap[0] + i * astep), (LAS unsigned*)(lA + i * 4096), 16, 0, 0);
#pragma unroll
    for (int i = 0; i < NBL; ++i) __builtin_amdgcn_global_load_lds((const GAS unsigned*)(bp + i * bstep), (LAS unsigned*)(lB + i * 4096), 16, 0, 0);
    for (int kt = 0; kt < nk; ++kt) {
        __syncthreads();
        if (kt + 1 < nk) {
            const int ko = (kt + 1) * 64;
            const int so = ((kt + 1) & 1) * STG;
#pragma unroll
            for (int i = 0; i < 4; ++i) __builtin_amdgcn_global_load_lds((const GAS unsigned*)((GATHER ? ap[GATHER ? i : 0] : ap[0] + i * astep) + ko), (LAS unsigned*)(lA + so + i * 4096), 16, 0, 0);
#pragma unroll
            for (int i = 0; i < NBL; ++i) __builtin_amdgcn_global_load_lds((const GAS unsigned*)(bp + i * bstep + ko), (LAS unsigned*)(lB + so + i * 4096), 16, 0, 0);
        }
        const unsigned char* cs = smem + (kt & 1) * STG;
#pragma unroll
        for (int ks = 0; ks < 2; ++ks) {
            const int pch = ((ks * 4 + (lane >> 4)) ^ (lane & 7)) << 4;
            bf16x8 bfr[NI];
#pragma unroll
            for (int ni = 0; ni < NI; ++ni) bfr[ni] = *(const bf16x8*)(cs + brow_off + ni * 2048 + pch);
#pragma unroll
            for (int mi = 0; mi < 4; mi += 2) {
                const bf16x8 a0 = *(const bf16x8*)(cs + arow_off + mi * 2048 + pch);
                const bf16x8 a1 = *(const bf16x8*)(cs + arow_off + (mi + 1) * 2048 + pch);
#pragma unroll
                for (int ni = 0; ni < NI; ++ni) acc[mi][ni] = __builtin_amdgcn_mfma_f32_16x16x32_bf16(a0, bfr[ni], acc[mi][ni], 0, 0, 0);
#pragma unroll
                for (int ni = 0; ni < NI; ++ni) acc[mi + 1][ni] = __builtin_amdgcn_mfma_f32_16x16x32_bf16(a1, bfr[ni], acc[mi + 1][ni], 0, 0, 0);
            }
        }
    }
}
#endif

template <bool GATHER = false>
DEVI void gemm_core_fp8(f32x4 (&acc)[4][4], const unsigned char* Ab, size_t lda, int row0, const unsigned char* Bb, size_t ldb, int K, unsigned char* smem, const int* ridx = nullptr) {
    constexpr int STG = 32768;
    const int tid = TIDX, lane = tid & 63, wid = tid >> 6, wr = wid >> 1, wc = wid & 1;
    const int lr = tid >> 3;
    const int kc = (tid & 7) ^ (lr & 7);
    const unsigned char* ap[GATHER ? 4 : 1];
    if (GATHER) {
#pragma unroll
        for (int i = 0; i < (GATHER ? 4 : 1); ++i) ap[i] = Ab + (size_t)ridx[lr + 32 * i] * lda + kc * 16;
    } else ap[0] = Ab + (size_t)(row0 + lr) * lda + kc * 16;
    const size_t astep = GATHER ? 0 : 32 * lda;
    const unsigned char* bp = Bb + (size_t)lr * ldb + kc * 16;
    const size_t bstep = 32 * ldb;
    LAS unsigned char* lA = (LAS unsigned char*)smem + tid * 16;
    LAS unsigned char* lB = lA + 16384;
    const int nk = K >> 7;
    const int arow_off = (wr * 64 + (lane & 15)) * 128;
    const int brow_off = 16384 + (wc * 64 + (lane & 15)) * 128;
    const int c0 = ((2 * (lane >> 4)) ^ (lane & 7)) << 4, c1 = ((2 * (lane >> 4) + 1) ^ (lane & 7)) << 4;
    __syncthreads();
#pragma unroll
    for (int i = 0; i < 4; ++i) __builtin_amdgcn_global_load_lds((const GAS unsigned*)(ap[GATHER ? i : 0] + i * astep), (LAS unsigned*)(lA + i * 4096), 16, 0, 0);
#pragma unroll
    for (int i = 0; i < 4; ++i) __builtin_amdgcn_global_load_lds((const GAS unsigned*)(bp + i * bstep), (LAS unsigned*)(lB + i * 4096), 16, 0, 0);
#pragma unroll 1
    for (int kt = 0; kt < nk; ++kt) {
        __syncthreads();
        if (kt + 1 < nk) {
            const int ko = (kt + 1) * 128;
            const int so = ((kt + 1) & 1) * STG;
#pragma unroll
            for (int i = 0; i < 4; ++i) __builtin_amdgcn_global_load_lds((const GAS unsigned*)(ap[GATHER ? i : 0] + i * astep + ko), (LAS unsigned*)(lA + so + i * 4096), 16, 0, 0);
#pragma unroll
            for (int i = 0; i < 4; ++i) __builtin_amdgcn_global_load_lds((const GAS unsigned*)(bp + i * bstep + ko), (LAS unsigned*)(lB + so + i * 4096), 16, 0, 0);
        }
        const unsigned char* cs = smem + (kt & 1) * STG;
        i32x8 bfr[4];
#pragma unroll
        for (int ni = 0; ni < 4; ++ni) {
            const i32x4 lo = *(const i32x4*)(cs + brow_off + ni * 2048 + c0), hi = *(const i32x4*)(cs + brow_off + ni * 2048 + c1);
            bfr[ni] = i32x8{lo[0], lo[1], lo[2], lo[3], hi[0], hi[1], hi[2], hi[3]};
        }
#pragma unroll
        for (int mi = 0; mi < 4; ++mi) {
            const i32x4 lo = *(const i32x4*)(cs + arow_off + mi * 2048 + c0), hi = *(const i32x4*)(cs + arow_off + mi * 2048 + c1);
            const i32x8 af = i32x8{lo[0], lo[1], lo[2], lo[3], hi[0], hi[1], hi[2], hi[3]};
#pragma unroll
            for (int ni = 0; ni < 4; ++ni)
                acc[mi][ni] = __builtin_amdgcn_mfma_scale_f32_16x16x128_f8f6f4(af, bfr[ni], acc[mi][ni], 0, 0, 0, 0x7f7f7f7f, 0, 0x7a7a7a7a);
        }
    }
}

template <int BN>
DEVI void acc_zero(f32x4 (&acc)[4][BN / 32]) {
#pragma unroll
    for (int mi = 0; mi < 4; ++mi)
#pragma unroll
        for (int ni = 0; ni < BN / 32; ++ni) acc[mi][ni] = f32x4{0.f, 0.f, 0.f, 0.f};
}
template <int BN>
DEVI void acc_to_ct(const f32x4 (&acc)[4][BN / 32], bf16_t* ct) {
    const int tid = TIDX, lane = tid & 63, wid = tid >> 6, wr = wid >> 1, wc = wid & 1;
#pragma unroll
    for (int mi = 0; mi < 4; ++mi)
#pragma unroll
        for (int ni = 0; ni < BN / 32; ++ni)
#pragma unroll
            for (int j = 0; j < 4; ++j)
                ct[(wr * 64 + mi * 16 + (lane >> 4) * 4 + j) * CT_LD + wc * (BN / 2) + ni * 16 + (lane & 15)] = f2bf(acc[mi][ni][j]);
}

template <int NC>
DEVI void ep_store_rows(const bf16_t* ct, int c0, bf16_t* dst, int ldd, int row0) {
    constexpr int CPR = NC / 8;
    for (int c = TIDX; c < 128 * CPR; c += 256) {
        int i = c / CPR, jc = c % CPR;
        *(bf16x8*)(dst + (size_t)(row0 + i) * ldd + jc * 8) = *(const bf16x8*)(ct + i * CT_LD + c0 + jc * 8);
    }
}
DEVI void ep_store_T(const bf16_t* ct, int c0, int nc, bf16_t* dstT, int ldT, int t0) {
    for (int c = TIDX; c < nc * 16; c += 256) {
        int j = c >> 4, ic = c & 15;
        bf16x8 v;
#pragma unroll
        for (int e = 0; e < 8; ++e) v[e] = (short)ct[(ic * 8 + e) * CT_LD + c0 + j];
        *(bf16x8*)(dstT + (size_t)j * ldT + t0 + ic * 8) = v;
    }
}
DEVI void ep_rope64(bf16_t* ct, const float* gain, float scale, bool lat, int pos0, const float* cs64) {
    const int row = TIDX >> 1, half = TIDX & 1;
    bf16_t* pr = ct + row * CT_LD + half * 64;
    float v[64];
#pragma unroll
    for (int c = 0; c < 8; ++c) {
        bf16x8 t = *(const bf16x8*)(pr + c * 8);
#pragma unroll
        for (int e = 0; e < 8; ++e) v[c * 8 + e] = bf2f((bf16_t)t[e]);
    }
    if (gain) {
        float ss = 0.f;
#pragma unroll
        for (int d = 0; d < 64; ++d) ss += v[d] * v[d];
        float rstd = rsqrtf(ss * (1.f / 64.f) + EPSV);
#pragma unroll
        for (int d = 0; d < 64; ++d) v[d] = v[d] * rstd * gain[d];
    }
    if (lat) {
        const float* cs = cs64 + (size_t)(pos0 + row) * 64;
#pragma unroll
        for (int i = 0; i < 16; ++i) {
            float a = v[i], b = v[i + 16], c = cs[i], s = cs[32 + i];
            v[i] = a * c - b * s; v[i + 16] = b * c + a * s;
            a = v[32 + i]; b = v[48 + i]; c = cs[16 + i]; s = cs[48 + i];
            v[32 + i] = a * c - b * s; v[48 + i] = b * c + a * s;
        }
    }
#pragma unroll
    for (int c = 0; c < 8; ++c) {
        bf16x8 t;
#pragma unroll
        for (int e = 0; e < 8; ++e) t[e] = (short)f2bf(v[c * 8 + e] * scale);
        *(bf16x8*)(pr + c * 8) = t;
    }
}
DEVI void ep_rope32(bf16_t* ct, int ngroups, const float* rstd, float scale, bool lat, int pos0, const float* cs32) {
    const int row = TIDX >> 1, half = TIDX & 1;
    const float rs = (rstd ? rstd[row] : 1.f) * scale;
#pragma unroll
    for (int gg = 0; gg < 2; ++gg) {
        const int g = half * 2 + gg;
        if (g < ngroups) {
            bf16_t* pr = ct + row * CT_LD + g * 32;
            float v[32];
#pragma unroll
            for (int c = 0; c < 4; ++c) {
                bf16x8 t = *(const bf16x8*)(pr + c * 8);
#pragma unroll
                for (int e = 0; e < 8; ++e) v[c * 8 + e] = bf2f((bf16_t)t[e]);
            }
            if (lat) {
                const float* cs = cs32 + (size_t)(pos0 + row) * 32;
#pragma unroll
                for (int i = 0; i < 8; ++i) {
                    float a = v[i], b = v[i + 8], c = cs[i], s = cs[16 + i];
                    v[i] = a * c - b * s; v[i + 8] = b * c + a * s;
                    a = v[16 + i]; b = v[24 + i]; c = cs[8 + i]; s = cs[24 + i];
                    v[16 + i] = a * c - b * s; v[24 + i] = b * c + a * s;
                }
            }
#pragma unroll
            for (int c = 0; c < 4; ++c) {
                bf16x8 t;
#pragma unroll
                for (int e = 0; e < 8; ++e) t[e] = (short)f2bf(v[c * 8 + e] * rs);
                *(bf16x8*)(pr + c * 8) = t;
            }
        }
    }
}
DEVI void ep_scale_rows(bf16_t* ct, int c0, int nc, const float* rstd, float scale) {
    const int cpr = nc / 8;
    for (int c = TIDX; c < 128 * cpr; c += 256) {
        int i = c / cpr, jc = c % cpr;
        bf16_t* pr = ct + i * CT_LD + c0 + jc * 8;
        bf16x8 t = *(const bf16x8*)pr;
        float rs = rstd[i] * scale;
#pragma unroll
        for (int e = 0; e < 8; ++e) t[e] = (short)f2bf(bf2f((bf16_t)t[e]) * rs);
        *(bf16x8*)pr = t;
    }
}
DEVI void ep_rstd(const bf16_t* A, int ld, int row0, int K, float* rstd) {
    const int row = TIDX >> 1, half = TIDX & 1;
    const bf16_t* pr = A + (size_t)(row0 + row) * ld + half * (K / 2);
    float ss = 0.f;
    for (int c = 0; c < K / 16; ++c) {
        bf16x8 t = *(const bf16x8*)(pr + c * 8);
#pragma unroll
        for (int e = 0; e < 8; ++e) { float f = bf2f((bf16_t)t[e]); ss += f * f; }
    }
    ss += __shfl_xor(ss, 1);
    if (half == 0) rstd[row] = rsqrtf(ss / (float)K + EPSV);
}


struct GrpInfo { int xcd, j, per, ngrp; };
DEVI GrpInfo grp_info(const Params& p) {
    const unsigned* pv = (const unsigned*)(p.ws + OFF_PRIV + (size_t)BIDX * 1024 + 896);
    GrpInfo g;
    g.xcd = (int)__hip_atomic_load(pv + 2, __ATOMIC_RELAXED, __HIP_MEMORY_SCOPE_AGENT);
    g.j = (int)__hip_atomic_load(pv + 3, __ATOMIC_RELAXED, __HIP_MEMORY_SCOPE_AGENT);
    g.per = (int)__hip_atomic_load((const unsigned*)(p.ws + OFF_BAR) + 256 + 64 * g.xcd, __ATOMIC_RELAXED, __HIP_MEMORY_SCOPE_AGENT);
    g.ngrp = 8;
    if (g.xcd >= 8 || g.per <= 0) { g.xcd = 0; g.j = BIDX; g.per = gridDim.x; g.ngrp = 1; }
    return g;
}
DEVI bool super_tile(const GrpInfo& gi, int it, int NMT, int NNT, int SM, int SN, int& mt, int& nt) {
    const int ST = SM * SN, passes = (ST + gi.per - 1) / gi.per;
    const int nsn = (NNT + SN - 1) / SN, nsm = (NMT + SM - 1) / SM;
    const int s = (it / passes) * gi.ngrp + gi.xcd;
    if (s >= nsm * nsn) return false;
    const int idx = (it % passes) * gi.per + gi.j;
    mt = -1; nt = 0;
    if (idx < ST) {
        const int m = (s / nsn) * SM + idx / SN, n = (s % nsn) * SN + idx % SN;
        if (m < NMT && n < NNT) { mt = m; nt = n; }
    }
    return true;
}

DEVI void phase0(const Params& p, unsigned char* smem) {
    const int tid = TIDX, lane = tid & 63, w = tid >> 6;
    const int NG = 192, NCV = 2 * CVT_PER_LAYER, NR = 192;
    const int ntask = NG + NCV + NR + 1;
    for (int task = BIDX; task < ntask; task += gridDim.x) {
        if (task < NG) {
            const int l = task / 96, n0 = (task % 96) * 64;
            float* sv = (float*)smem;
            float* red = (float*)smem;
            for (int idx = lane; idx < 9 * 256; idx += 64) {
                int bi = idx >> 8, kk = idx & 255, k = 256 * w + kk;
                float c = bi < 8 ? p.in[I_C][bi * 1024 + k] : p.in[I_CCTX][k];
                sv[(w * 9 + bi) * 256 + kk] = siluf_(c);
            }
            __syncthreads();
            const int ksub = lane >> 4, c4 = (lane & 15) * 4;
            float acc[9][4];
#pragma unroll
            for (int bi = 0; bi < 9; ++bi) { acc[bi][0] = 0.f; acc[bi][1] = 0.f; acc[bi][2] = 0.f; acc[bi][3] = 0.f; }
            const float* wp = p.in[I_ADAW] + (size_t)l * 1024 * 6144 + (size_t)(256 * w + ksub) * 6144 + n0 + c4;
#pragma unroll 8
            for (int i = 0; i < 64; ++i) {
                const float4 wv = *(const float4*)(wp + (size_t)(4 * i) * 6144);
#pragma unroll
                for (int bi = 0; bi < 9; ++bi) {
                    const float sx = sv[(w * 9 + bi) * 256 + 4 * i + ksub];
                    acc[bi][0] += sx * wv.x; acc[bi][1] += sx * wv.y; acc[bi][2] += sx * wv.z; acc[bi][3] += sx * wv.w;
                }
            }
            __syncthreads();
#pragma unroll
            for (int bi = 0; bi < 9; ++bi)
                *(float4*)(red + (((w * 4 + ksub) * 9 + bi) * 64) + c4) = make_float4(acc[bi][0], acc[bi][1], acc[bi][2], acc[bi][3]);
            __syncthreads();
            for (int idx = tid; idx < 9 * 64; idx += 256) {
                int bi = idx >> 6, c = idx & 63;
                float sacc = p.in[I_ADAB][l * 6144 + n0 + c];
#pragma unroll
                for (int q = 0; q < 16; ++q) sacc += red[((q * 9 + bi) * 64) + c];
                WSF(OFF_MOD)[(size_t)(l * 9 + bi) * 6144 + n0 + c] = sacc;
            }
            __syncthreads();
        } else if (task < NG + NCV) {
            int t = task - NG;
            int l = t / CVT_PER_LAYER; t %= CVT_PER_LAYER;
            int k = 0;
            while (t >= CVT_TILES[k]) { t -= CVT_TILES[k]; ++k; }
            CvtJob j = get_job(p, l, k);
            if (k == 5) cvt_tile256_fp8(j, t, smem); else if (j.wide) cvt_tile256(j, t, smem); else cvt_tile(j, t, (float*)smem);
        } else if (task < NG + NCV + NR) {
            const int idx = (task - NG - NCV) * 256 + tid;
            const int pos = idx / 24, f = idx % 24;
            const float rp = (float)(pos >> 6), cp = (float)(pos & 63);
            if (f < 16) {
                const float inv = powf(10000.f, -(float)(2 * f) / 32.f);
                const float ar = rp * inv, ac = cp * inv;
                float* t64 = WSF(OFF_R64) + (size_t)pos * 64;
                t64[f] = cosf(ar); t64[16 + f] = cosf(ac); t64[32 + f] = sinf(ar); t64[48 + f] = sinf(ac);
            } else {
                const int i = f - 16;
                const float inv = powf(10000.f, -(float)(2 * i) / 16.f);
                const float ar = rp * inv, ac = cp * inv;
                float* t32 = WSF(OFF_R32) + (size_t)pos * 32;
                t32[i] = cosf(ar); t32[8 + i] = cosf(ac); t32[16 + i] = sinf(ar); t32[24 + i] = sinf(ac);
            }
        } else {
            for (int i = tid; i < 4096; i += 256) WSI(OFF_CNT)[i] = 0;
            for (int l = 0; l < 2; ++l) {
                unsigned* z = (unsigned*)WB(W_IN + (size_t)l * 3840 * 1024 + (size_t)3744 * 1024);
                for (int i = tid; i < 96 * 1024 / 2; i += 256) z[i] = 0u;
            }
        }
    }
}

struct MoeTab {
    int* base;
    DEVI int cnt(int e) const { return __hip_atomic_load(base + e, __ATOMIC_RELAXED, __HIP_MEMORY_SCOPE_AGENT); }
    DEVI int tp(int e) const { return __hip_atomic_load(base + 64 + e, __ATOMIC_RELAXED, __HIP_MEMORY_SCOPE_AGENT); }
    DEVI int seg(int e) const { return __hip_atomic_load(base + 136 + e, __ATOMIC_RELAXED, __HIP_MEMORY_SCOPE_AGENT); }
};
DEVI MoeTab moe_tables(const Params& p, int l, unsigned char* smem) {
    MoeTab t; t.base = (int*)(p.ws + OFF_PRIV + (size_t)BIDX * 1024);
    __syncthreads();
    if (TIDX == 0) {
        int a = 0, sg = 0;
        for (int e = 0; e < 64; ++e) {
            const int c = WSI(OFF_CNT)[l * 64 + e];
            __hip_atomic_store(t.base + e, c, __ATOMIC_RELAXED, __HIP_MEMORY_SCOPE_AGENT);
            __hip_atomic_store(t.base + 64 + e, a, __ATOMIC_RELAXED, __HIP_MEMORY_SCOPE_AGENT);
            __hip_atomic_store(t.base + 136 + e, sg, __ATOMIC_RELAXED, __HIP_MEMORY_SCOPE_AGENT);
            const int nt = (c + 127) >> 7;
            a += nt; sg += nt * 128;
        }
        __hip_atomic_store(t.base + 64 + 64, a, __ATOMIC_RELAXED, __HIP_MEMORY_SCOPE_AGENT);
        __hip_atomic_store(t.base + 136 + 64, sg, __ATOMIC_RELAXED, __HIP_MEMORY_SCOPE_AGENT);
    }
    asm volatile("s_waitcnt vmcnt(0)" ::: "memory");
    __syncthreads();
    return t;
}
struct Rec { int e0, p0, e1, p1; float w0, w1; int pad0, pad1; };

DEVI void phase_norm1(const Params& p, int l, int mode, unsigned char* smem) {
    const int lane = TIDX & 63, w = TIDX >> 6;
    MoeTab mt;
    const bool comb = (mode == 0 && l > 0) || mode == 1;
    const int lp = mode == 1 ? 1 : l - 1;
    int segv = 0;
    if (comb) { mt = moe_tables(p, lp, smem); segv = mt.seg(lane); }
    const float* g1 = mode == 1 ? p.in[I_FN] : (mode == 2 ? p.in[I_N2G] + l * 1024 : p.in[I_N1G] + l * 1024);
    const bool latonly = (mode == 1) || (mode == 2 && l == 1);
    const int nrows = latonly ? NBT * SEQL : TT;
    const int stride = gridDim.x * 4;
    int ri = BIDX * 4 + w;
    float4 xn[4];
    Rec rcn; rcn.e0 = 0; rcn.e1 = 0; rcn.p0 = 0; rcn.p1 = 0; rcn.w0 = 0.f; rcn.w1 = 0.f;
    auto rowof = [&](int r) { return latonly ? (r >> 11) * TPB + CTXL + (r & 2047) : r; };
    auto srcof = [&](int row) -> const float* {
        if (mode == 0 && l == 0) {
            const int b = row / TPB, t = row % TPB;
            return t < CTXL ? p.in[I_CTX] + ((size_t)b * CTXL + t) * DM : p.in[I_X] + ((size_t)b * SEQL + (t - CTXL)) * DM;
        }
        return XCUR + (size_t)row * DM;
    };
    if (ri < nrows) {
        const float* src = srcof(rowof(ri));
#pragma unroll
        for (int i = 0; i < 4; ++i) xn[i] = *(const float4*)(src + i * 256 + lane * 4);
        if (comb) rcn = ((const Rec*)(p.ws + OFF_REC))[rowof(ri)];
    }
    for (; ri < nrows; ri += stride) {
        const int row = rowof(ri);
        const int b = row / TPB, t = row % TPB;
        const bool isctx = t < CTXL;
        const int bi = isctx ? 8 : b;
        float v[16];
#pragma unroll
        for (int i = 0; i < 4; ++i) { v[i * 4] = xn[i].x; v[i * 4 + 1] = xn[i].y; v[i * 4 + 2] = xn[i].z; v[i * 4 + 3] = xn[i].w; }
        const Rec rc = rcn;
        if (ri + stride < nrows) {
            if (comb) rcn = ((const Rec*)(p.ws + OFF_REC))[rowof(ri + stride)];
            const float* src = srcof(rowof(ri + stride));
#pragma unroll
            for (int i = 0; i < 4; ++i) xn[i] = *(const float4*)(src + i * 256 + lane * 4);
        }
        if (comb) {
            float* xr = XCUR + (size_t)row * DM;
            const bf16_t* y0 = DB(D_YS) + (size_t)(__shfl(segv, rc.e0) + rc.p0) * 1024;
            const bf16_t* y1 = DB(D_YS) + (size_t)(__shfl(segv, rc.e1) + rc.p1) * 1024;
            const float* gate = WSF(OFF_MOD) + (size_t)(lp * 9 + bi) * 6144 + 5 * 1024;
#pragma unroll
            for (int i = 0; i < 4; ++i) {
                const int c = i * 256 + lane * 4;
                float4 g4 = *(const float4*)(gate + c);
                uint2 a = *(const uint2*)(y0 + c), bb = *(const uint2*)(y1 + c);
                float f0 = rc.w0 * __uint_as_float(a.x << 16) + rc.w1 * __uint_as_float(bb.x << 16);
                float f1 = rc.w0 * __uint_as_float(a.x & 0xffff0000u) + rc.w1 * __uint_as_float(bb.x & 0xffff0000u);
                float f2 = rc.w0 * __uint_as_float(a.y << 16) + rc.w1 * __uint_as_float(bb.y << 16);
                float f3 = rc.w0 * __uint_as_float(a.y & 0xffff0000u) + rc.w1 * __uint_as_float(bb.y & 0xffff0000u);
                v[i * 4] += g4.x * f0; v[i * 4 + 1] += g4.y * f1; v[i * 4 + 2] += g4.z * f2; v[i * 4 + 3] += g4.w * f3;
                if (mode == 0) *(float4*)(xr + c) = make_float4(v[i * 4], v[i * 4 + 1], v[i * 4 + 2], v[i * 4 + 3]);
            }
        }
        float ss = 0.f;
#pragma unroll
        for (int i = 0; i < 16; ++i) ss += v[i] * v[i];
        ss = wave_sum(ss);
        const float rstd = rsqrtf(ss * (1.f / 1024.f) + EPSV);
        if (mode == 1) {
            float* o = p.out + ((size_t)b * SEQL + (t - CTXL)) * DM;
#pragma unroll
            for (int i = 0; i < 4; ++i) {
                const int c = i * 256 + lane * 4;
                float4 g4 = *(const float4*)(g1 + c);
                float4 r4;
                r4.x = v[i * 4] * rstd * g4.x; r4.y = v[i * 4 + 1] * rstd * g4.y; r4.z = v[i * 4 + 2] * rstd * g4.z; r4.w = v[i * 4 + 3] * rstd * g4.w;
                *(float4*)(o + c) = r4;
            }
        } else {
            const float* md = WSF(OFF_MOD) + (size_t)(l * 9 + bi) * 6144 + (mode == 2 ? 3 * 1024 : 0);
            bf16_t* ho = HB + (size_t)row * DM;
#pragma unroll
            for (int i = 0; i < 4; ++i) {
                const int c = i * 256 + lane * 4;
                float4 g4 = *(const float4*)(g1 + c);
                float4 sh = *(const float4*)(md + c);
                float4 sc = *(const float4*)(md + 1024 + c);
                float h0 = v[i * 4] * rstd * g4.x * (1.f + sc.x) + sh.x;
                float h1 = v[i * 4 + 1] * rstd * g4.y * (1.f + sc.y) + sh.y;
                float h2 = v[i * 4 + 2] * rstd * g4.z * (1.f + sc.z) + sh.z;
                float h3 = v[i * 4 + 3] * rstd * g4.w * (1.f + sc.w) + sh.w;
                uint2 o2;
                o2.x = (unsigned)f2bf(h0) | ((unsigned)f2bf(h1) << 16);
                o2.y = (unsigned)f2bf(h2) | ((unsigned)f2bf(h3) << 16);
                *(uint2*)(ho + c) = o2;
                if (mode == 2) *(int*)((unsigned char*)CB(0) + (size_t)row * 1024 + c) = pk4_fp8(h0, h1, h2, h3);
            }
        }
    }
}

DEVI int fetch_task(int* ctr, unsigned char* smem) {
    __syncthreads();
    if (TIDX == 0) *(volatile int*)smem = atomicAdd(ctr, 1);
    __syncthreads();
    return *(volatile int*)smem;
}
DEVI void dep_signal(int* cnt) {
    asm volatile("s_waitcnt vmcnt(0)" ::: "memory");
    __syncthreads();
    if (TIDX == 0) {
        __builtin_amdgcn_fence(__ATOMIC_RELEASE, "agent");
        asm volatile("s_waitcnt vmcnt(0)" ::: "memory");
        __hip_atomic_fetch_add(cnt, 1, __ATOMIC_RELAXED, __HIP_MEMORY_SCOPE_AGENT);
    }
}
DEVI void dep_wait(int* cnt, int need) {
    if (TIDX == 0) {
        while (__hip_atomic_load(cnt, __ATOMIC_RELAXED, __HIP_MEMORY_SCOPE_AGENT) < need) __builtin_amdgcn_s_sleep(2);
        __builtin_amdgcn_fence(__ATOMIC_ACQUIRE, "agent");
        asm volatile("s_waitcnt vmcnt(0)" ::: "memory");
    }
    __syncthreads();
}

DEVI void phase_win(const Params& p, int l, unsigned char* smem) {
    bf16_t* ct = (bf16_t*)smem;
    const float* cs64 = WSF(OFF_R64);
    const float* cs32 = WSF(OFF_R32);
    int* ctr = WSI(OFF_CNT) + 134 + l;
    for (;;) {
        const int task = fetch_task(ctr, smem);
        if (task >= 144 * 30) break;
        const int mt = task / 30, nt = task % 30;
        const int row0 = mt * 128, b = mt / 18, t0 = (mt % 18) * 128;
        const bool lat = (mt % 18) >= 2;
        const int pos0 = t0 - CTXL;
        f32x4 acc[4][4];
        acc_zero<128>(acc);
        AOp A{HB, 1024, row0, nullptr};
        T_BEGIN(3);
        gemm_core<128>(acc, A, WB(W_IN + (size_t)l * 3840 * 1024 + (size_t)nt * 128 * 1024), 1024, 1024, smem);
        __syncthreads();
        T_END(3, l == 0 && BIDX == 8);
        T_BEGIN(4);
        acc_to_ct<128>(acc, ct);
        __syncthreads();
        if (nt < 2) ep_store_rows<128>(ct, 0, CB(C_CQ) + nt * 128, 256, row0);
        else if (nt == 2) ep_store_rows<128>(ct, 0, CB(C_CKV), 128, row0);
        else if (nt < 5) { ep_rope64(ct, nullptr, 1.f, lat, pos0, cs64); __syncthreads(); ep_store_rows<128>(ct, 0, CB(C_RQ) + (nt - 3) * 128, 256, row0); }
        else if (nt < 7) {
            ep_rope64(ct, nullptr, 0.125f, lat, pos0, cs64); __syncthreads();
            ep_store_rows<128>(ct, 0, CB(C_RK) + (nt - 5) * 128, 256, row0);
            ep_store_T(ct, 0, 128, CB(C_RKT) + ((size_t)b * 256 + (nt - 5) * 128) * TPB, TPB, t0);
        }
        else if (nt < 11) ep_store_T(ct, 0, 128, CB(C_RVT) + ((size_t)b * 4 + (nt - 7)) * 128 * TPB, TPB, t0);
        else if (nt < 15) ep_store_rows<128>(ct, 0, CB(C_RG) + (nt - 11) * 128, 512, row0);
        else if (nt < 19) ep_store_rows<128>(ct, 0, CB(C_LX) + (nt - 15) * 128, 512, row0);
        else if (nt < 23) ep_store_rows<128>(ct, 0, CB(C_LG) + (nt - 19) * 128, 512, row0);
        else if (nt < 27) { ep_rope64(ct, p.in[I_GQN] + l * 64, 0.125f * LOG2E, lat, pos0, cs64); __syncthreads(); ep_store_rows<128>(ct, 0, CB(C_GQ) + (nt - 23) * 128, 512, row0); }
        else if (nt == 27) { ep_rope64(ct, p.in[I_GKN] + l * 64, 1.f, lat, pos0, cs64); __syncthreads(); ep_store_rows<128>(ct, 0, CB(C_GK), 128, row0); }
        else if (nt == 28) ep_store_T(ct, 0, 128, CB(C_GVT) + (size_t)b * 128 * TPB, TPB, t0);
        else { ep_rope32(ct, 1, nullptr, 1.f, lat, pos0, cs32); __syncthreads(); ep_store_rows<32>(ct, 0, CB(C_KR), 32, row0); }
        __syncthreads();
        T_END(4, l == 0 && BIDX == 8);
    }
}

DEVI float ret_lg2(const Params& p, int l, int dir, int h) { return -log1pf(expf(-p.in[I_RDEC][l * 8 + dir * 4 + h])) * LOG2E; }
DEVI void ret_chunk_U(const Params& p, int l, int task) {
    const int b = task / 72, r = task % 72, h = r / 18, m = r % 18;
    const int tid = TIDX, lane = tid & 63, w = tid >> 6, qc = lane & 31, hh = lane >> 5;
    const int t0 = m * 128;
    const bf16_t* KTg = CB(C_RKT) + ((size_t)b * 4 + h) * 64 * TPB + t0 + 8 * hh;
    const bf16_t* VTg = CB(C_RVT) + (((size_t)b * 4 + h) * 128 + w * 32 + qc) * TPB + t0 + 8 * hh;
    bf16x8 vf[8], ka[2][8];
#pragma unroll
    for (int ks = 0; ks < 8; ++ks) vf[ks] = *(const bf16x8*)(VTg + ks * 16);
#pragma unroll
    for (int sub = 0; sub < 2; ++sub)
#pragma unroll
        for (int ks = 0; ks < 8; ++ks) ka[sub][ks] = *(const bf16x8*)(KTg + (size_t)(32 * sub + qc) * TPB + ks * 16);
#pragma unroll
    for (int dir = 0; dir < 2; ++dir) {
        const float lg2 = ret_lg2(p, l, dir, h);
        f32x16 U0, U1;
#pragma unroll
        for (int rr = 0; rr < 16; ++rr) { U0[rr] = 0.f; U1[rr] = 0.f; }
#pragma unroll
        for (int ks = 0; ks < 8; ++ks) {
            bf16x8 vs;
#pragma unroll
            for (int e = 0; e < 8; ++e) {
                const int j = 16 * ks + 8 * hh + e;
                const float kd = __builtin_amdgcn_exp2f(lg2 * (float)(dir == 0 ? 127 - j : j));
                vs[e] = (short)f2bf(bf2f((bf16_t)vf[ks][e]) * kd);
            }
            U0 = __builtin_amdgcn_mfma_f32_32x32x16_bf16(ka[0][ks], vs, U0, 0, 0, 0);
            U1 = __builtin_amdgcn_mfma_f32_32x32x16_bf16(ka[1][ks], vs, U1, 0, 0, 0);
        }
        bf16_t* up = DB(D_OB) + ((((size_t)(b * 4 + h) * 18 + m) * 2 + dir) * 128) * 64 + (size_t)(32 * w + qc) * 8 + 4 * hh;
#pragma unroll
        for (int g = 0; g < 4; ++g) {
            bf16x4 a, c;
#pragma unroll
            for (int e = 0; e < 4; ++e) { a[e] = (short)f2bf(U0[4 * g + e]); c[e] = (short)f2bf(U1[4 * g + e]); }
            *(bf16x4*)(up + (((g >> 1) * 2 + (g & 1)) * 128) * 8) = a;
            *(bf16x4*)(up + (((2 + (g >> 1)) * 2 + (g & 1)) * 128) * 8) = c;
        }
    }
}
DEVI void ret_out_task(const Params& p, int l, int b, int h, int m, unsigned char* smem) {
    constexpr int PLD = 136;
    bf16_t* P = (bf16_t*)smem;
    float* red = (float*)(smem + 34816);
    const int tid = TIDX, lane = tid & 63, w = tid >> 6, qc = lane & 31, hh = lane >> 5;
    const int t0 = m * 128, iq = 32 * w + qc;
    const float lgf = ret_lg2(p, l, 0, h), lgb = ret_lg2(p, l, 1, h);
    const float cdf = exp2f(lgf * 128.f), cdb = exp2f(lgb * 128.f);
    bf16x8 sff[4], sfb[4];
    {
        float Sf[4][8], Sb[4][8];
#pragma unroll
        for (int ks = 0; ks < 4; ++ks)
#pragma unroll
            for (int e = 0; e < 8; ++e) { Sf[ks][e] = 0.f; Sb[ks][e] = 0.f; }
        const bf16_t* Ub = DB(D_OB) + (size_t)(b * 4 + h) * 18 * 2 * 128 * 64 + (size_t)(hh * 128 + 32 * w + qc) * 8;
        const int pos = m < 2 ? 1 - m : 19 - m;
        const int nf4 = (m + 3) & ~3, nb4 = (pos + 3) & ~3;
        for (int c0 = 0; c0 < nf4; c0 += 4) {
            bf16x8 u[4][4]; float wg[4];
#pragma unroll
            for (int q = 0; q < 4; ++q) {
                const int c = c0 + q, cl = c < m ? c : 0;
                wg[q] = c < m ? __builtin_amdgcn_exp2f(lgf * 128.f * (float)(m - 1 - c)) : 0.f;
                const bf16_t* up = Ub + (size_t)(cl * 2 + 0) * 128 * 64;
#pragma unroll
                for (int ks = 0; ks < 4; ++ks) u[q][ks] = *(const bf16x8*)(up + ks * 2048);
            }
#pragma unroll
            for (int q = 0; q < 4; ++q)
#pragma unroll
                for (int ks = 0; ks < 4; ++ks)
#pragma unroll
                    for (int e = 0; e < 8; ++e) Sf[ks][e] += wg[q] * bf2f((bf16_t)u[q][ks][e]);
        }
        for (int c0 = 0; c0 < nb4; c0 += 4) {
            bf16x8 u[4][4]; float wg[4];
#pragma unroll
            for (int q = 0; q < 4; ++q) {
                const int cc = c0 + q, ccl = cc < pos ? cc : 0;
                const int c = ccl < 2 ? 1 - ccl : 19 - ccl;
                wg[q] = cc < pos ? __builtin_amdgcn_exp2f(lgb * 128.f * (float)(pos - 1 - cc)) : 0.f;
                const bf16_t* up = Ub + (size_t)(c * 2 + 1) * 128 * 64;
#pragma unroll
                for (int ks = 0; ks < 4; ++ks) u[q][ks] = *(const bf16x8*)(up + ks * 2048);
            }
#pragma unroll
            for (int q = 0; q < 4; ++q)
#pragma unroll
                for (int ks = 0; ks < 4; ++ks)
#pragma unroll
                    for (int e = 0; e < 8; ++e) Sb[ks][e] += wg[q] * bf2f((bf16_t)u[q][ks][e]);
        }
#pragma unroll
        for (int ks = 0; ks < 4; ++ks)
#pragma unroll
            for (int e = 0; e < 8; ++e) { sff[ks][e] = (short)f2bf(Sf[ks][e]); sfb[ks][e] = (short)f2bf(Sb[ks][e]); }
    }
    const bf16_t* Kg = CB(C_RK) + ((size_t)b * TPB + t0) * 256 + h * 64 + 8 * hh;
    const bf16_t* Qg = CB(C_RQ) + ((size_t)b * TPB + t0) * 256 + h * 64 + 8 * hh;
    const bf16_t* VTg = CB(C_RVT) + (((size_t)b * 4 + h) * 128 + w * 32 + qc) * TPB + t0 + 8 * hh;
    bf16x8 vf[8];
#pragma unroll
    for (int ks = 0; ks < 8; ++ks) vf[ks] = *(const bf16x8*)(VTg + ks * 16);
    {
        bf16x8 qf[4], ka[4][4];
#pragma unroll
        for (int ks = 0; ks < 4; ++ks) qf[ks] = *(const bf16x8*)(Qg + (size_t)iq * 256 + ks * 16);
#pragma unroll
        for (int js = 0; js < 4; ++js)
#pragma unroll
            for (int ks = 0; ks < 4; ++ks) ka[js][ks] = *(const bf16x8*)(Kg + (size_t)(32 * js + qc) * 256 + ks * 16);
        __syncthreads();
#pragma unroll
        for (int js = 0; js < 4; ++js) {
            f32x16 sc;
#pragma unroll
            for (int r = 0; r < 16; ++r) sc[r] = 0.f;
#pragma unroll
            for (int ks = 0; ks < 4; ++ks) sc = __builtin_amdgcn_mfma_f32_32x32x16_bf16(ka[js][ks], qf[ks], sc, 0, 0, 0);
#pragma unroll
            for (int g = 0; g < 4; ++g) {
                bf16x4 pk;
#pragma unroll
                for (int e = 0; e < 4; ++e) {
                    const int d = iq - (32 * js + 8 * g + 4 * hh + e);
                    const float wgt = d >= 0 ? __builtin_amdgcn_exp2f(lgf * (float)d) : __builtin_amdgcn_exp2f(lgb * (float)(-d));
                    pk[e] = (short)f2bf(sc[4 * g + e] * wgt);
                }
                *(bf16x4*)(P + iq * PLD + 32 * js + 8 * g + 4 * hh) = pk;
            }
        }
    }
    bf16x8 qa[4];
#pragma unroll
    for (int ks = 0; ks < 4; ++ks) qa[ks] = *(const bf16x8*)(Qg + (size_t)qc * 256 + ks * 16);
    __syncthreads();
    f32x16 o[4];
#pragma unroll
    for (int isub = 0; isub < 4; ++isub) {
        const int ii = 32 * isub + qc;
        bf16x8 qn[4];
        if (isub < 3) {
#pragma unroll
            for (int ks = 0; ks < 4; ++ks) qn[ks] = *(const bf16x8*)(Qg + (size_t)(ii + 32) * 256 + ks * 16);
        }
#pragma unroll
        for (int r = 0; r < 16; ++r) o[isub][r] = 0.f;
#pragma unroll
        for (int ks = 0; ks < 4; ++ks) o[isub] = __builtin_amdgcn_mfma_f32_32x32x16_bf16(sff[ks], qa[ks], o[isub], 0, 0, 0);
        const float qdf = __builtin_amdgcn_exp2f(lgf * (float)(ii + 1)), qdb = __builtin_amdgcn_exp2f(lgb * (float)(128 - ii));
        const float rat = qdf / qdb;
#pragma unroll
        for (int r = 0; r < 16; ++r) o[isub][r] *= rat;
#pragma unroll
        for (int ks = 0; ks < 4; ++ks) o[isub] = __builtin_amdgcn_mfma_f32_32x32x16_bf16(sfb[ks], qa[ks], o[isub], 0, 0, 0);
#pragma unroll
        for (int r = 0; r < 16; ++r) o[isub][r] *= qdb;
#pragma unroll
        for (int ks = 0; ks < 8; ++ks) {
            bf16x8 pf = *(const bf16x8*)(P + ii * PLD + 16 * ks + 8 * hh);
            o[isub] = __builtin_amdgcn_mfma_f32_32x32x16_bf16(vf[ks], pf, o[isub], 0, 0, 0);
        }
        float s1 = 0.f, s2 = 0.f;
#pragma unroll
        for (int r = 0; r < 16; ++r) { s1 += o[isub][r]; s2 += o[isub][r] * o[isub][r]; }
        s1 += __shfl_xor(s1, 32); s2 += __shfl_xor(s2, 32);
        if (hh == 0) { red[(w * 128 + ii) * 2] = s1; red[(w * 128 + ii) * 2 + 1] = s2; }
        if (isub < 3) {
#pragma unroll
            for (int ks = 0; ks < 4; ++ks) qa[ks] = qn[ks];
        }
    }
    __syncthreads();
    const float* gn = p.in[I_RNORM] + l * 512 + h * 128 + 32 * w + 4 * hh;
    float gnv[16];
#pragma unroll
    for (int g = 0; g < 4; ++g)
#pragma unroll
        for (int e = 0; e < 4; ++e) gnv[4 * g + e] = gn[8 * g + e];
#pragma unroll
    for (int isub = 0; isub < 4; ++isub) {
        const int ii = 32 * isub + qc;
        float t1 = 0.f, t2 = 0.f;
#pragma unroll
        for (int ww = 0; ww < 4; ++ww) { t1 += red[(ww * 128 + ii) * 2]; t2 += red[(ww * 128 + ii) * 2 + 1]; }
        const float mu = t1 * (1.f / 128.f);
        const float rs = rsqrtf(fmaxf(t2 * (1.f / 128.f) - mu * mu, 0.f) + EPSV);
#pragma unroll
        for (int g = 0; g < 4; ++g) {
            bf16x4 ov;
#pragma unroll
            for (int e = 0; e < 4; ++e) ov[e] = (short)f2bf((o[isub][4 * g + e] - mu) * rs * gnv[4 * g + e]);
            *(bf16x4*)(P + ii * PLD + 32 * w + 8 * g + 4 * hh) = ov;
        }
    }
    __syncthreads();
#pragma unroll
    for (int k = 0; k < 8; ++k) {
        const int c = tid + 256 * k, row = c >> 4, ch = c & 15;
        const size_t ro = ((size_t)b * TPB + t0 + row) * 512 + h * 128 + ch * 8;
        const bf16x8 nv = *(const bf16x8*)(P + row * PLD + ch * 8);
        const bf16x8 gt = *(const bf16x8*)(CB(C_RG) + ro);
        bf16x8 ov;
#pragma unroll
        for (int e = 0; e < 8; ++e) ov[e] = (short)f2bf(siluf_(bf2f((bf16_t)gt[e])) * bf2f((bf16_t)nv[e]));
        *(bf16x8*)(DB(D_OF) + ro) = ov;
    }
}

DEVI void h_to_fp8(const Params& p, int t32) {
    const int lane = TIDX & 63, w = TIDX >> 6;
    const size_t row0 = (size_t)t32 * 32 + w * 8;
    bf16x8 a[8], b[8];
#pragma unroll
    for (int i = 0; i < 8; ++i) {
        a[i] = *(const bf16x8*)(HB + (row0 + i) * 1024 + lane * 16);
        b[i] = *(const bf16x8*)(HB + (row0 + i) * 1024 + lane * 16 + 8);
    }
    asm volatile("s_waitcnt vmcnt(0)" ::: "memory");
#pragma unroll
    for (int i = 0; i < 8; ++i) {
        i32x4 o;
        o[0] = pk4_fp8(bf2f((bf16_t)a[i][0]), bf2f((bf16_t)a[i][1]), bf2f((bf16_t)a[i][2]), bf2f((bf16_t)a[i][3]));
        o[1] = pk4_fp8(bf2f((bf16_t)a[i][4]), bf2f((bf16_t)a[i][5]), bf2f((bf16_t)a[i][6]), bf2f((bf16_t)a[i][7]));
        o[2] = pk4_fp8(bf2f((bf16_t)b[i][0]), bf2f((bf16_t)b[i][1]), bf2f((bf16_t)b[i][2]), bf2f((bf16_t)b[i][3]));
        o[3] = pk4_fp8(bf2f((bf16_t)b[i][4]), bf2f((bf16_t)b[i][5]), bf2f((bf16_t)b[i][6]), bf2f((bf16_t)b[i][7]));
        *(i32x4*)((unsigned char*)HB + (row0 + i) * 2048 + lane * 16) = o;
    }
}
DEVI void phase_mla_up(const Params& p, int l, unsigned char* smem) {
    bf16_t* ct = (bf16_t*)smem;
    float* rstd = (float*)(smem + AUX_OFF);
    const float* cs32 = WSF(OFF_R32);
    const float qscale = 0.10206207261596575f * LOG2E;
    const int nq = (l == 0 ? 144 : 128) * 6;
    const int nkv = 144 * 8;
    for (int tile = BIDX; tile < nq + nkv + 576 + 576; tile += gridDim.x) {
        if (tile >= nq + nkv + 576) { h_to_fp8(p, tile - nq - nkv - 576); continue; }
        if (tile >= nq + nkv) { ret_chunk_U(p, l, tile - nq - nkv); continue; }
        if (tile < nq) {
            const int mt = mt_of(tile / 6, l != 0), nt = tile % 6;
            const int row0 = mt * 128, t0 = (mt % 18) * 128;
            const bool lat = (mt % 18) >= 2;
            f32x4 acc[4][4];
            acc_zero<128>(acc);
            AOp A{CB(C_CQ), 256, row0, nullptr};
            gemm_core<128>(acc, A, WB(W_UQ + (size_t)l * 768 * 256 + (size_t)nt * 128 * 256), 256, 256, smem);
            __syncthreads();
            acc_to_ct<128>(acc, ct);
            ep_rstd(CB(C_CQ), 256, row0, 256, rstd);
            __syncthreads();
            if (nt < 4) {
                ep_scale_rows(ct, 0, 128, rstd, qscale); __syncthreads();
                ep_store_rows<64>(ct, 0, CB(C_MQ) + (nt * 2) * 96, 768, row0);
                ep_store_rows<64>(ct, 64, CB(C_MQ) + (nt * 2 + 1) * 96, 768, row0);
            } else {
                ep_rope32(ct, 4, rstd, qscale, lat, t0 - CTXL, cs32); __syncthreads();
#pragma unroll
                for (int g = 0; g < 4; ++g) ep_store_rows<32>(ct, g * 32, CB(C_MQ) + ((nt - 4) * 4 + g) * 96 + 64, 768, row0);
            }
            __syncthreads();
        } else {
            const int tk = tile - nq;
            const int mt = tk / 8, nt = tk % 8;
            const int row0 = mt * 128, b = mt / 18, t0 = (mt % 18) * 128;
            f32x4 acc[4][4];
            acc_zero<128>(acc);
            AOp A{CB(C_CKV), 128, row0, nullptr};
            gemm_core<128>(acc, A, WB(W_UKV + (size_t)l * 1024 * 128 + (size_t)nt * 128 * 128), 128, 128, smem);
            __syncthreads();
            acc_to_ct<128>(acc, ct);
            ep_rstd(CB(C_CKV), 128, row0, 128, rstd);
            __syncthreads();
            ep_scale_rows(ct, 0, 128, rstd, 1.f); __syncthreads();
            ep_store_rows<64>(ct, 0, CB(C_KN) + nt * 64, 512, row0);
            ep_store_T(ct, 64, 64, CB(C_VMT) + ((size_t)b * 8 + nt) * 64 * TPB, TPB, t0);
            __syncthreads();
        }
    }
}

template <int DK, bool MLA>
DEVI void attn_naive_wave(const Params& p, int b, int t0, int hq) {
    const int lane = TIDX & 63;
    const int t = t0 + lane, row = b * TPB + t;
    const int nkeys = (t0 < CTXL) ? CTXL : TPB;
    float q[DK];
    const bf16_t* qp = MLA ? CB(C_MQ) + (size_t)row * 768 + hq * 96 : CB(C_GQ) + (size_t)row * 512 + hq * 64;
#pragma unroll
    for (int c = 0; c < DK / 8; ++c) {
        bf16x8 tq = *(const bf16x8*)(qp + c * 8);
#pragma unroll
        for (int e = 0; e < 8; ++e) q[c * 8 + e] = bf2f((bf16_t)tq[e]);
    }
    float acc[64];
#pragma unroll
    for (int d = 0; d < 64; ++d) acc[d] = 0.f;
    float m = -1e30f, lsum = 0.f;
    const int hk = MLA ? hq : (hq >> 2);
    const bf16_t* vT = MLA ? CB(C_VMT) + ((size_t)b * 8 + hk) * 64 * TPB : CB(C_GVT) + ((size_t)b * 2 + hk) * 64 * TPB;
    for (int kt = 0; kt < nkeys; ++kt) {
        const size_t krow = (size_t)b * TPB + kt;
        float s = 0.f;
        const bf16_t* kp = MLA ? CB(C_KN) + krow * 512 + hk * 64 : CB(C_GK) + krow * 128 + hk * 64;
#pragma unroll
        for (int c = 0; c < 8; ++c) {
            bf16x8 tk = *(const bf16x8*)(kp + c * 8);
#pragma unroll
            for (int e = 0; e < 8; ++e) s += q[c * 8 + e] * bf2f((bf16_t)tk[e]);
        }
        if (MLA) {
            const bf16_t* rp = CB(C_KR) + krow * 32;
#pragma unroll
            for (int c = 0; c < 4; ++c) {
                bf16x8 tk = *(const bf16x8*)(rp + c * 8);
#pragma unroll
                for (int e = 0; e < 8; ++e) s += q[(DK - 32) + c * 8 + e] * bf2f((bf16_t)tk[e]);
            }
        }
        const float mn = fmaxf(m, s);
        const float alpha = exp2f(m - mn), pp = exp2f(s - mn);
        lsum = lsum * alpha + pp;
#pragma unroll
        for (int d = 0; d < 64; ++d) acc[d] = acc[d] * alpha + pp * bf2f(vT[(size_t)d * TPB + kt]);
        m = mn;
    }
    const float inv = 1.f / lsum;
    bf16_t* op = (MLA ? DB(D_YA) : DB(D_YD)) + (size_t)row * 512 + hq * 64;
#pragma unroll
    for (int c = 0; c < 8; ++c) {
        bf16x8 o;
#pragma unroll
        for (int e = 0; e < 8; ++e) o[e] = (short)f2bf(acc[c * 8 + e] * inv);
        *(bf16x8*)(op + c * 8) = o;
    }
}


template <int DK, bool MLA>
DEVI void attn_task(const Params& p, int b, int hsel, int tq0, int nkeys, unsigned char* smem) {
    constexpr int KLD = DK + 8;
    constexpr int CK = DK / 8;
    constexpr int NKC = 64 * CK / 256;
    constexpr int VLD = 68;
    constexpr int KBYTES = 64 * KLD * 2, VBYTES = 64 * VLD * 2;
    constexpr int VOFF = 2 * KBYTES;
    static_assert(2 * (KBYTES + VBYTES) <= 60000, "attn lds");
    const int tid = TIDX, lane = tid & 63, w = tid >> 6, qc = lane & 31, hh = lane >> 5;
    const int tq = MLA ? tq0 + w * 32 + qc : tq0 + qc;
    const int hq = MLA ? hsel : hsel * 4 + w;
    const size_t qrow = (size_t)b * TPB + tq;
    const bf16_t* qp = MLA ? CB(C_MQ) + qrow * 768 + hq * 96 : CB(C_GQ) + qrow * 512 + hq * 64;
    bf16x8 qf[DK / 16];
#pragma unroll
    for (int ks = 0; ks < DK / 16; ++ks) qf[ks] = *(const bf16x8*)(qp + ks * 16 + hh * 8);
    const bf16_t* ksrc[NKC]; int kstep[NKC], kdst[NKC];
#pragma unroll
    for (int i = 0; i < NKC; ++i) {
        const int q = tid + 256 * i, key = q / CK, ch = q % CK;
        if (MLA) {
            if (ch < 8) { ksrc[i] = CB(C_KN) + ((size_t)b * TPB + key) * 512 + hsel * 64 + ch * 8; kstep[i] = 64 * 512; }
            else { ksrc[i] = CB(C_KR) + ((size_t)b * TPB + key) * 32 + (ch - 8) * 8; kstep[i] = 64 * 32; }
        } else { ksrc[i] = CB(C_GK) + ((size_t)b * TPB + key) * 128 + hsel * 64 + ch * 8; kstep[i] = 64 * 128; }
        kdst[i] = (key * KLD + ch * 8) * 2;
    }
    const bf16_t* vT = MLA ? CB(C_VMT) + ((size_t)b * 8 + hsel) * 64 * TPB : CB(C_GVT) + ((size_t)b * 2 + hsel) * 64 * TPB;
    const bf16_t* vsrc[2]; int vdst[2];
#pragma unroll
    for (int i = 0; i < 2; ++i) {
        const int q = tid + 256 * i, dv = q >> 3, ch = q & 7;
        vsrc[i] = vT + (size_t)dv * TPB + ch * 8;
        vdst[i] = VOFF + (dv * VLD + ch * 8) * 2;
    }
    const int nt = nkeys >> 6;
    bf16x8 kr[NKC], vr[2];
#pragma unroll
    for (int i = 0; i < NKC; ++i) kr[i] = *(const bf16x8*)(ksrc[i]);
#pragma unroll
    for (int i = 0; i < 2; ++i) vr[i] = *(const bf16x8*)(vsrc[i]);
    __syncthreads();
#pragma unroll
    for (int i = 0; i < NKC; ++i) *(bf16x8*)(smem + kdst[i]) = kr[i];
#pragma unroll
    for (int i = 0; i < 2; ++i) {
        *(bf16x4*)(smem + vdst[i]) = bf16x4{vr[i][0], vr[i][1], vr[i][2], vr[i][3]};
        *(bf16x4*)(smem + vdst[i] + 8) = bf16x4{vr[i][4], vr[i][5], vr[i][6], vr[i][7]};
    }
#pragma unroll
    for (int i = 0; i < NKC; ++i) kr[i] = *(const bf16x8*)(ksrc[i] + (size_t)kstep[i]);
    __syncthreads();
    f32x16 s0, s1;
#pragma unroll
    for (int r = 0; r < 16; ++r) { s0[r] = 0.f; s1[r] = 0.f; }
#pragma unroll
    for (int ks = 0; ks < DK / 16; ++ks) {
        bf16x8 a0 = *(const bf16x8*)(smem + (qc * KLD + ks * 16 + hh * 8) * 2);
        bf16x8 a1 = *(const bf16x8*)(smem + ((32 + qc) * KLD + ks * 16 + hh * 8) * 2);
        s0 = __builtin_amdgcn_mfma_f32_32x32x16_bf16(a0, qf[ks], s0, 0, 0, 0);
        s1 = __builtin_amdgcn_mfma_f32_32x32x16_bf16(a1, qf[ks], s1, 0, 0, 0);
    }
#pragma unroll
    for (int i = 0; i < NKC; ++i) *(bf16x8*)(smem + KBYTES + kdst[i]) = kr[i];
    f32x16 o0, o1;
#pragma unroll
    for (int r = 0; r < 16; ++r) { o0[r] = 0.f; o1[r] = 0.f; }
    float m = -1e30f, lsum = 0.f;
    for (int it = 0; it < nt; ++it) {
        __syncthreads();
        if (it + 2 < nt) {
#pragma unroll
            for (int i = 0; i < NKC; ++i) kr[i] = *(const bf16x8*)(ksrc[i] + (size_t)(it + 2) * kstep[i]);
        }
        if (it + 1 < nt) {
#pragma unroll
            for (int i = 0; i < 2; ++i) vr[i] = *(const bf16x8*)(vsrc[i] + (it + 1) * 64);
        }
        f32x16 n0, n1;
#pragma unroll
        for (int r = 0; r < 16; ++r) { n0[r] = 0.f; n1[r] = 0.f; }
        if (it + 1 < nt) {
            const unsigned char* ck = smem + ((it + 1) & 1) * KBYTES;
#pragma unroll
            for (int ks = 0; ks < DK / 16; ++ks) {
                bf16x8 a0 = *(const bf16x8*)(ck + (qc * KLD + ks * 16 + hh * 8) * 2);
                bf16x8 a1 = *(const bf16x8*)(ck + ((32 + qc) * KLD + ks * 16 + hh * 8) * 2);
                n0 = __builtin_amdgcn_mfma_f32_32x32x16_bf16(a0, qf[ks], n0, 0, 0, 0);
                n1 = __builtin_amdgcn_mfma_f32_32x32x16_bf16(a1, qf[ks], n1, 0, 0, 0);
            }
        }
        float mx = s0[0];
#pragma unroll
        for (int r = 1; r < 16; ++r) mx = fmaxf(mx, s0[r]);
#pragma unroll
        for (int r = 0; r < 16; ++r) mx = fmaxf(mx, s1[r]);
        mx = fmaxf(mx, __shfl_xor(mx, 32));
        if (!__all(mx <= m + 6.f)) {
            const float mn = fmaxf(m, mx);
            const float alpha = __builtin_amdgcn_exp2f(m - mn);
            m = mn;
            lsum *= alpha;
#pragma unroll
            for (int r = 0; r < 16; ++r) { o0[r] *= alpha; o1[r] *= alpha; }
        }
        float ps = 0.f;
#pragma unroll
        for (int r = 0; r < 16; ++r) { s0[r] = __builtin_amdgcn_exp2f(s0[r] - m); ps += s0[r]; }
#pragma unroll
        for (int r = 0; r < 16; ++r) { s1[r] = __builtin_amdgcn_exp2f(s1[r] - m); ps += s1[r]; }
        lsum += ps;
        bf16x8 pf[2][2];
#pragma unroll
        for (int s = 0; s < 2; ++s)
#pragma unroll
            for (int j = 0; j < 8; ++j) { pf[0][s][j] = (short)f2bf(s0[8 * s + j]); pf[1][s][j] = (short)f2bf(s1[8 * s + j]); }
        const unsigned char* cv = smem + VOFF + (it & 1) * VBYTES;
#pragma unroll
        for (int a = 0; a < 2; ++a)
#pragma unroll
            for (int s = 0; s < 2; ++s) {
                const int keyoff = a * 32 + 16 * s + 4 * hh;
                bf16x4 l0 = *(const bf16x4*)(cv + (qc * VLD + keyoff) * 2);
                bf16x4 h0 = *(const bf16x4*)(cv + (qc * VLD + keyoff + 8) * 2);
                bf16x4 l1 = *(const bf16x4*)(cv + ((32 + qc) * VLD + keyoff) * 2);
                bf16x4 h1 = *(const bf16x4*)(cv + ((32 + qc) * VLD + keyoff + 8) * 2);
                bf16x8 v0 = bf16x8{l0[0], l0[1], l0[2], l0[3], h0[0], h0[1], h0[2], h0[3]};
                bf16x8 v1 = bf16x8{l1[0], l1[1], l1[2], l1[3], h1[0], h1[1], h1[2], h1[3]};
                o0 = __builtin_amdgcn_mfma_f32_32x32x16_bf16(v0, pf[a][s], o0, 0, 0, 0);
                o1 = __builtin_amdgcn_mfma_f32_32x32x16_bf16(v1, pf[a][s], o1, 0, 0, 0);
            }
        if (it + 2 < nt) {
            unsigned char* nk = smem + (it & 1) * KBYTES;
#pragma unroll
            for (int i = 0; i < NKC; ++i) *(bf16x8*)(nk + kdst[i]) = kr[i];
        }
        if (it + 1 < nt) {
            unsigned char* nv = smem + ((it + 1) & 1) * VBYTES;
#pragma unroll
            for (int i = 0; i < 2; ++i) {
                *(bf16x4*)(nv + vdst[i]) = bf16x4{vr[i][0], vr[i][1], vr[i][2], vr[i][3]};
                *(bf16x4*)(nv + vdst[i] + 8) = bf16x4{vr[i][4], vr[i][5], vr[i][6], vr[i][7]};
            }
        }
        s0 = n0; s1 = n1;
    }
    lsum += __shfl_xor(lsum, 32);
    const float inv = 1.f / lsum;
    bf16_t* op = (MLA ? DB(D_YA) : DB(D_YD)) + qrow * 512 + hq * 64;
#pragma unroll
    for (int g = 0; g < 4; ++g) {
        bf16x4 a, c;
#pragma unroll
        for (int e = 0; e < 4; ++e) { a[e] = (short)f2bf(o0[g * 4 + e] * inv); c[e] = (short)f2bf(o1[g * 4 + e] * inv); }
        *(bf16x4*)(op + 8 * g + 4 * hh) = a;
        *(bf16x4*)(op + 32 + 8 * g + 4 * hh) = c;
    }
}

DEVI int proc_tok(int dir, int pidx) { return dir == 0 ? pidx : (pidx < CTXL ? CTXL - 1 - pidx : (CTXL + TPB - 1) - pidx); }

DEVI void retention_naive(const Params& p, int l, int task) {
    const int b = task >> 2, h = task & 3;
    const int dir = TIDX >> 7, dv = TIDX & 127;
    const float dec = p.in[I_RDEC][l * 8 + dir * 4 + h];
    const float lg = -log1pf(expf(-dec));
    const float g = expf(lg);
    float S[64];
#pragma unroll
    for (int d = 0; d < 64; ++d) S[d] = 0.f;
    const bf16_t* vT = CB(C_RVT) + (((size_t)b * 4 + h) * 128 + dv) * TPB;
    bf16_t* outp = (dir == 0 ? DB(D_OF) : DB(D_OB));
    for (int pi = 0; pi < TPB; ++pi) {
        const int u = proc_tok(dir, pi);
        const size_t row = (size_t)b * TPB + u;
        const bf16_t* qp = CB(C_RQ) + row * 256 + h * 64;
        const bf16_t* kp = CB(C_RK) + row * 256 + h * 64;
        const float v = bf2f(vT[u]);
        float o = 0.f;
#pragma unroll
        for (int c = 0; c < 8; ++c) {
            bf16x8 tq = *(const bf16x8*)(qp + c * 8);
            bf16x8 tk = *(const bf16x8*)(kp + c * 8);
#pragma unroll
            for (int e = 0; e < 8; ++e) {
                const int d = c * 8 + e;
                const float qd = bf2f((bf16_t)tq[e]), kd = bf2f((bf16_t)tk[e]);
                if (dir == 0) { S[d] = g * S[d] + kd * v; o += qd * S[d]; }
                else { S[d] = g * S[d]; o += qd * S[d]; S[d] += kd * v; }
            }
        }
        outp[row * 512 + h * 128 + dv] = f2bf(o);
    }
}

DEVI void lru_naive_wave(const Params& p, int l, int task) {
    const int lane = TIDX & 63;
    const int b = task >> 4, d = (task >> 3) & 1, blk = task & 7;
    const int ch = blk * 64 + lane;
    float cw[4];
#pragma unroll
    for (int j = 0; j < 4; ++j) cw[j] = p.in[I_LCW][(l * 4 + j) * 512 + ch];
    const float cb = p.in[I_LCB][l * 512 + ch];
    const float ba = p.in[I_LBA][(l * 2 + d) * 512 + ch], bx = p.in[I_LBX][(l * 2 + d) * 512 + ch];
    const float lam = p.in[I_LLAM][(l * 2 + d) * 512 + ch];
    const float sp = log1pf(expf(-lam));
    const float* Wa = p.in[I_LWA] + ((size_t)(l * 2 + d) * 8 + blk) * 4096;
    const float* Wx = p.in[I_LWX] + ((size_t)(l * 2 + d) * 8 + blk) * 4096;
    float h = 0.f;
    bf16_t* outp = (d == 0 ? DB(D_LH0) : DB(D_LH1));
    for (int pi = 0; pi < TPB; ++pi) {
        const int u = proc_tok(d, pi);
        const int lo = u < CTXL ? 0 : CTXL, hi = u < CTXL ? CTXL : TPB;
        const size_t row = (size_t)b * TPB + u;
        float uval = cb;
#pragma unroll
        for (int j = 0; j < 4; ++j) {
            const int tt = u - 2 + j;
            if (tt >= lo && tt < hi) uval += cw[j] * bf2f(CB(C_LX)[((size_t)b * TPB + tt) * 512 + ch]);
        }
        float rp = 0.f, ip = 0.f;
        for (int c = 0; c < 64; ++c) {
            const float uc = __shfl(uval, c);
            rp += uc * Wa[c * 64 + lane];
            ip += uc * Wx[c * 64 + lane];
        }
        const float r = sigmoidf_(rp + ba), ig = sigmoidf_(ip + bx);
        const float la = -8.f * r * sp;
        const float a = expf(la);
        const float bb = sqrtf(-expm1f(2.f * la)) * (ig * uval);
        h = a * h + bb;
        outp[row * 512 + ch] = f2bf(h);
    }
}


DEVI void retention_walk(const Params& p, int l, int task, unsigned char* smem) {
    constexpr int PLD = 136;
    const int b = task >> 3, h = (task >> 1) & 3, dir = task & 1;
    const int tid = TIDX, lane = tid & 63, w = tid >> 6, qc = lane & 31, hh = lane >> 5;
    const float dec = p.in[I_RDEC][l * 8 + dir * 4 + h];
    const float lg2 = -log1pf(expf(-dec)) * LOG2E;
    const float cdec = exp2f(lg2 * 128.f);
    bf16_t* P = (bf16_t*)smem;
    f32x16 S0, S1;
#pragma unroll
    for (int r = 0; r < 16; ++r) { S0[r] = 0.f; S1[r] = 0.f; }
    const bf16_t* Kg = CB(C_RK) + (size_t)b * TPB * 256 + h * 64;
    const bf16_t* Qg = CB(C_RQ) + (size_t)b * TPB * 256 + h * 64;
    const bf16_t* KTg = CB(C_RKT) + ((size_t)b * 4 + h) * 64 * TPB;
    const bf16_t* VTg = CB(C_RVT) + (((size_t)b * 4 + h) * 128 + w * 32 + qc) * TPB;
    bf16_t* outp = (dir == 0 ? DB(D_OF) : DB(D_OB)) + (size_t)b * TPB * 512 + h * 128 + w * 32;
    const int iq = 32 * w + qc;
    for (int cc = 0; cc < 18; ++cc) {
        const int mch = dir == 0 ? cc : (cc < 2 ? 1 - cc : 19 - cc);
        const int t0 = mch * 128;
        bf16x8 vf[8];
#pragma unroll
        for (int ks = 0; ks < 8; ++ks) vf[ks] = *(const bf16x8*)(VTg + t0 + ks * 16 + hh * 8);
        bf16x8 qf[4];
        {
            const bf16_t* qrow = Qg + (size_t)(t0 + iq) * 256;
#pragma unroll
            for (int ks = 0; ks < 4; ++ks) qf[ks] = *(const bf16x8*)(qrow + ks * 16 + hh * 8);
        }
        __syncthreads();
#pragma unroll 1
        for (int js = 0; js < 4; ++js) {
            f32x16 sc;
#pragma unroll
            for (int r = 0; r < 16; ++r) sc[r] = 0.f;
            const bf16_t* krow = Kg + (size_t)(t0 + 32 * js + qc) * 256;
#pragma unroll
            for (int ks = 0; ks < 4; ++ks) {
                bf16x8 a = *(const bf16x8*)(krow + ks * 16 + hh * 8);
                sc = __builtin_amdgcn_mfma_f32_32x32x16_bf16(a, qf[ks], sc, 0, 0, 0);
            }
#pragma unroll
            for (int g = 0; g < 4; ++g) {
                bf16x4 pk;
#pragma unroll
                for (int e = 0; e < 4; ++e) {
                    const int j = 32 * js + 8 * g + 4 * hh + e;
                    const int d = iq - j;
                    float wgt;
                    if (dir == 0) wgt = d >= 0 ? __builtin_amdgcn_exp2f(lg2 * (float)d) : 0.f;
                    else wgt = d < 0 ? __builtin_amdgcn_exp2f(lg2 * (float)(-d)) : 0.f;
                    pk[e] = (short)f2bf(sc[4 * g + e] * wgt);
                }
                *(bf16x4*)(P + iq * PLD + 32 * js + 8 * g + 4 * hh) = pk;
            }
        }
        __syncthreads();
        bf16x8 sf[2][2];
#pragma unroll
        for (int s = 0; s < 2; ++s)
#pragma unroll
            for (int j = 0; j < 8; ++j) { sf[0][s][j] = (short)f2bf(S0[8 * s + j]); sf[1][s][j] = (short)f2bf(S1[8 * s + j]); }
#pragma unroll 1
        for (int isub = 0; isub < 4; ++isub) {
            const int ii = 32 * isub + qc;
            const bf16_t* qr = Qg + (size_t)(t0 + ii) * 256;
            f32x16 o;
#pragma unroll
            for (int r = 0; r < 16; ++r) o[r] = 0.f;
#pragma unroll
            for (int sub = 0; sub < 2; ++sub)
#pragma unroll
                for (int s = 0; s < 2; ++s) {
                    const int dk0 = 32 * sub + 16 * s + 4 * hh;
                    bf16x4 lo = *(const bf16x4*)(qr + dk0), hi = *(const bf16x4*)(qr + dk0 + 8);
                    bf16x8 bq = bf16x8{lo[0], lo[1], lo[2], lo[3], hi[0], hi[1], hi[2], hi[3]};
                    o = __builtin_amdgcn_mfma_f32_32x32x16_bf16(sf[sub][s], bq, o, 0, 0, 0);
                }
            const float qd = dir == 0 ? __builtin_amdgcn_exp2f(lg2 * (float)(ii + 1)) : __builtin_amdgcn_exp2f(lg2 * (float)(128 - ii));
#pragma unroll
            for (int r = 0; r < 16; ++r) o[r] *= qd;
#pragma unroll
            for (int ks = 0; ks < 8; ++ks) {
                bf16x8 pf = *(const bf16x8*)(P + ii * PLD + 16 * ks + 8 * hh);
                o = __builtin_amdgcn_mfma_f32_32x32x16_bf16(vf[ks], pf, o, 0, 0, 0);
            }
            bf16_t* orow = outp + (size_t)(t0 + ii) * 512;
#pragma unroll
            for (int g = 0; g < 4; ++g) {
                bf16x4 pk;
#pragma unroll
                for (int e = 0; e < 4; ++e) pk[e] = (short)f2bf(o[4 * g + e]);
                *(bf16x4*)(orow + 8 * g + 4 * hh) = pk;
            }
        }
#pragma unroll
        for (int r = 0; r < 16; ++r) { S0[r] *= cdec; S1[r] *= cdec; }
#pragma unroll
        for (int ks = 0; ks < 8; ++ks) {
            bf16x8 vs;
#pragma unroll
            for (int e = 0; e < 8; ++e) {
                const int j = 16 * ks + 8 * hh + e;
                const float kd = dir == 0 ? __builtin_amdgcn_exp2f(lg2 * (float)(127 - j)) : __builtin_amdgcn_exp2f(lg2 * (float)j);
                vs[e] = (short)f2bf(bf2f((bf16_t)vf[ks][e]) * kd);
            }
            bf16x8 a0 = *(const bf16x8*)(KTg + (size_t)qc * TPB + t0 + 16 * ks + 8 * hh);
            bf16x8 a1 = *(const bf16x8*)(KTg + (size_t)(32 + qc) * TPB + t0 + 16 * ks + 8 * hh);
            S0 = __builtin_amdgcn_mfma_f32_32x32x16_bf16(a0, vs, S0, 0, 0, 0);
            S1 = __builtin_amdgcn_mfma_f32_32x32x16_bf16(a1, vs, S1, 0, 0, 0);
        }
    }
    __syncthreads();
}

DEVI void lru_walk(const Params& p, int l, int task, unsigned char* smem) {
    const int b = task >> 4, d = (task >> 3) & 1, blk = task & 7;
    const int tid = TIDX, lane = tid & 63, w = tid >> 6, ln = lane & 15, g = lane >> 4;
    bf16_t* Wt = (bf16_t*)smem;
    float* uw = (float*)(smem + 18432 + w * 4224);
    float* cpar = (float*)(smem + 35328);
    float* agg = (float*)(smem + 36608);
    __syncthreads();
    {
        const bf16_t* wsrc = WB(W_LRU + ((size_t)(l * 2 + d) * 8 + blk) * 8192);
        for (int c = tid; c < 128 * 8; c += 256) {
            const int n = c >> 3, kc = c & 7;
            *(bf16x8*)(Wt + n * 72 + kc * 8) = *(const bf16x8*)(wsrc + n * 64 + kc * 8);
        }
        if (tid < 64) {
            const int ch = blk * 64 + tid;
#pragma unroll
            for (int j = 0; j < 4; ++j) cpar[j * 64 + tid] = p.in[I_LCW][(l * 4 + j) * 512 + ch];
            cpar[256 + tid] = p.in[I_LCB][l * 512 + ch];
        }
    }
    __syncthreads();
    float ba[4], bx[4], sp[4], hc[4];
#pragma unroll
    for (int ct = 0; ct < 4; ++ct) {
        const int ch = blk * 64 + 16 * ct + ln;
        ba[ct] = p.in[I_LBA][(l * 2 + d) * 512 + ch];
        bx[ct] = p.in[I_LBX][(l * 2 + d) * 512 + ch];
        sp[ct] = log1pf(expf(-p.in[I_LLAM][(l * 2 + d) * 512 + ch]));
        hc[ct] = 0.f;
    }
    const bf16_t* X = CB(C_LX) + (size_t)b * TPB * 512 + blk * 64;
    bf16_t* outp = (d == 0 ? DB(D_LH0) : DB(D_LH1)) + (size_t)b * TPB * 512 + blk * 64;
    bf16x8 xr[2][4];
    float xm[4];
    {
        const int tok = proc_tok(d, 16 * w + ln);
        const int lo = tok < CTXL ? 0 : CTXL, hi = tok < CTXL ? CTXL : TPB;
#pragma unroll
        for (int ks = 0; ks < 2; ++ks)
#pragma unroll
            for (int j = 0; j < 4; ++j) {
                const int tt = tok - 2 + j;
                const int tc = tt < lo ? lo : (tt >= hi ? hi - 1 : tt);
                xr[ks][j] = *(const bf16x8*)(X + (size_t)tc * 512 + 32 * ks + 8 * g);
                xm[j] = (tt >= lo && tt < hi) ? 1.f : 0.f;
            }
    }
    for (int c = 0; c < 36; ++c) {
        bf16x8 af[2];
#pragma unroll
        for (int ks = 0; ks < 2; ++ks) {
            const int c0 = 32 * ks + 8 * g;
            float u8[8];
#pragma unroll
            for (int e = 0; e < 8; ++e) u8[e] = cpar[256 + c0 + e];
#pragma unroll
            for (int j = 0; j < 4; ++j)
#pragma unroll
                for (int e = 0; e < 8; ++e) u8[e] += (cpar[j * 64 + c0 + e] * xm[j]) * bf2f((bf16_t)xr[ks][j][e]);
#pragma unroll
            for (int e = 0; e < 8; ++e) { uw[ln * 65 + c0 + e] = u8[e]; af[ks][e] = (short)f2bf(u8[e]); }
        }
        if (c + 1 < 36) {
            const int tok = proc_tok(d, 64 * (c + 1) + 16 * w + ln);
            const int lo = tok < CTXL ? 0 : CTXL, hi = tok < CTXL ? CTXL : TPB;
#pragma unroll
            for (int ks = 0; ks < 2; ++ks)
#pragma unroll
                for (int j = 0; j < 4; ++j) {
                    const int tt = tok - 2 + j;
                    const int tc = tt < lo ? lo : (tt >= hi ? hi - 1 : tt);
                    xr[ks][j] = *(const bf16x8*)(X + (size_t)tc * 512 + 32 * ks + 8 * g);
                    xm[j] = (tt >= lo && tt < hi) ? 1.f : 0.f;
                }
        }
        __builtin_amdgcn_wave_barrier();
        f32x4 acc[8];
#pragma unroll
        for (int nt = 0; nt < 8; ++nt) acc[nt] = f32x4{0.f, 0.f, 0.f, 0.f};
#pragma unroll
        for (int ks = 0; ks < 2; ++ks)
#pragma unroll
            for (int nt = 0; nt < 8; ++nt) {
                bf16x8 bfr = *(const bf16x8*)(Wt + (16 * nt + ln) * 72 + 32 * ks + 8 * g);
                acc[nt] = __builtin_amdgcn_mfma_f32_16x16x32_bf16(af[ks], bfr, acc[nt], 0, 0, 0);
            }
        float A[4][4], B[4][4];
#pragma unroll
        for (int ct = 0; ct < 4; ++ct) {
            float pa = 1.f, pb = 0.f;
#pragma unroll
            for (int j = 0; j < 4; ++j) {
                const float r = fsig(acc[ct][j] + ba[ct]);
                const float ig = fsig(acc[4 + ct][j] + bx[ct]);
                const float la = -8.f * r * sp[ct];
                const float a = __expf(la);
                const float uu = uw[(4 * g + j) * 65 + 16 * ct + ln];
                const float bb = __builtin_amdgcn_sqrtf(fmaxf(1.f - a * a, 0.f)) * ig * uu;
                pb = a * pb + bb; pa = a * pa;
                A[ct][j] = pa; B[ct][j] = pb;
            }
            float ia = pa, ib = pb;
#pragma unroll
            for (int dd = 1; dd <= 2; dd <<= 1) {
                const float qa = __shfl_up(ia, 16 * dd), qb = __shfl_up(ib, 16 * dd);
                if (g >= dd) { ib = ia * qb + ib; ia = ia * qa; }
            }
            float ea = __shfl_up(ia, 16), eb = __shfl_up(ib, 16);
            if (g == 0) { ea = 1.f; eb = 0.f; }
#pragma unroll
            for (int j = 0; j < 4; ++j) { B[ct][j] = A[ct][j] * eb + B[ct][j]; A[ct][j] = A[ct][j] * ea; }
            if (g == 3) {
                float* ag = agg + (((c & 1) * 4 + w) * 64 + 16 * ct + ln) * 2;
                ag[0] = ia; ag[1] = ib;
            }
        }
        __syncthreads();
#pragma unroll
        for (int ct = 0; ct < 4; ++ct) {
            float hrun = hc[ct], hin = 0.f;
#pragma unroll
            for (int w2 = 0; w2 < 4; ++w2) {
                const float* ag = agg + (((c & 1) * 4 + w2) * 64 + 16 * ct + ln) * 2;
                if (w2 == w) hin = hrun;
                hrun = ag[0] * hrun + ag[1];
            }
            hc[ct] = hrun;
#pragma unroll
            for (int j = 0; j < 4; ++j) {
                const int tok2 = proc_tok(d, 64 * c + 16 * w + 4 * g + j);
                outp[(size_t)tok2 * 512 + 16 * ct + ln] = f2bf(A[ct][j] * hin + B[ct][j]);
            }
        }
    }
    __syncthreads();
}

DEVI void phase_mix(const Params& p, int l, unsigned char* smem) {
    const int NLRU = 128, NRET = (l == 0 ? 576 : 512);
    const int NLAT = 1024, NCTX = (l == 0 ? 128 : 0);
    const int ntask = NLRU + NRET + 2 * NLAT + 2 * NCTX;
    const int ncvt = 3072;
    int cv = BIDX;
    int* ctr = WSI(OFF_CNT) + 128 + l;
    volatile int* nxt = (volatile int*)(smem + 65520);
    for (;;) {
        __syncthreads();
        if (TIDX == 0) *nxt = atomicAdd(ctr, 1);
        __syncthreads();
        const int task = *nxt;
        if (task >= ntask) break;
        if (cv < ncvt) { CvtJob j = get_moe_job(p, l, cv >> 10); if ((cv >> 10) < 2) cvt_tile256_fp8(j, cv & 1023, smem); else cvt_tile256(j, cv & 1023, smem); cv += gridDim.x; }
        if (task < NLRU) lru_walk(p, l, task, smem);
        else if (task >= NLRU + 2 * NLAT && task < NLRU + 2 * NLAT + NRET) {
            const int a = task - NLRU - 2 * NLAT;
            int b, h, m;
            if (l == 0) { b = a / 72; const int r = a % 72; h = r / 18; m = r % 18; }
            else { b = a >> 6; const int r = a & 63; h = r >> 4; m = 2 + (r & 15); }
            ret_out_task(p, l, b, h, m, smem);
        } else {
            int a = task < NLRU + 2 * NLAT ? task - NLRU : task - NLRU - NRET;
            int kind, b, hsel, tq0, nkeys;
            if (a < NLAT) { kind = 0; b = a >> 7; const int r = a & 127; hsel = r >> 4; tq0 = CTXL + (r & 15) * 128; nkeys = TPB; }
            else if (a < 2 * NLAT) { a -= NLAT; kind = 1; b = a >> 7; const int r = a & 127; hsel = r >> 6; tq0 = CTXL + (r & 63) * 32; nkeys = TPB; }
            else if (a < 2 * NLAT + NCTX) { a -= 2 * NLAT; kind = 0; b = a >> 4; const int r = a & 15; hsel = r >> 1; tq0 = (r & 1) * 128; nkeys = CTXL; }
            else { a -= 2 * NLAT + NCTX; kind = 1; b = a >> 4; const int r = a & 15; hsel = r >> 3; tq0 = (r & 7) * 32; nkeys = CTXL; }
            if (kind == 0) attn_task<96, true>(p, b, hsel, tq0, nkeys, smem);
            else attn_task<64, false>(p, b, hsel, tq0, nkeys, smem);
        }
    }
    for (; cv < ncvt; cv += gridDim.x) { CvtJob j = get_moe_job(p, l, cv >> 10); if ((cv >> 10) < 2) cvt_tile256_fp8(j, cv & 1023, smem); else cvt_tile256(j, cv & 1023, smem); }
}

DEVI void phase_fin(const Params& p, int l) {
    const int lane = TIDX & 63, w = TIDX >> 6;
    for (int row = BIDX * 4 + w; row < TT; row += gridDim.x * 4) {
        if (l == 1 && (row % TPB) < CTXL) continue;
        const size_t o = (size_t)row * 512 + lane * 8;
        bf16x8 h0 = *(const bf16x8*)(DB(D_LH0) + o), h1 = *(const bf16x8*)(DB(D_LH1) + o), lg = *(const bf16x8*)(CB(C_LG) + o);
        bf16x8 oc;
#pragma unroll
        for (int e = 0; e < 8; ++e) oc[e] = (short)f2bf((bf2f((bf16_t)h0[e]) + bf2f((bf16_t)h1[e])) * gelu_tanh(bf2f((bf16_t)lg[e])));
        *(bf16x8*)(DB(D_LH0) + o) = oc;
    }
}

DEVI void merge_tile(const Params& p, int l, int mq, int nt, unsigned char* smem) {
    bf16_t* ct = (bf16_t*)smem;
    const int lane = TIDX & 63, wc = (TIDX >> 6) & 1;
    const int mt = mt_of(mq, l != 0);
    const int row0 = mt * 128;
    unsigned mp[4][4][2];
#pragma unroll
    for (int mi = 0; mi < 4; ++mi)
#pragma unroll
        for (int ni = 0; ni < 4; ++ni) { mp[mi][ni][0] = 0u; mp[mi][ni][1] = 0u; }
#pragma unroll 1
    for (int n = 0; n < 4; ++n) {
        unsigned gp[4][4][2];
        {
            f32x4 ag[4][4];
            acc_zero<128>(ag);
            gemm_core_fp8<false>(ag, (const unsigned char*)HB, 2048, row0, (const unsigned char*)WB(W_MG + (size_t)l * 4096 * 1024) + (size_t)(n * 1024 + nt * 128) * 1024, 1024, 1024, smem);
            const float* bm = p.in[I_BMG] + l * 4096 + n * 1024 + nt * 128 + wc * 64 + (lane & 15);
#pragma unroll
            for (int ni = 0; ni < 4; ++ni) {
                const float bias = bm[ni * 16];
#pragma unroll
                for (int mi = 0; mi < 4; ++mi) {
                    gp[mi][ni][0] = (unsigned)f2bf(fsig(ag[mi][ni][0] + bias)) | ((unsigned)f2bf(fsig(ag[mi][ni][1] + bias)) << 16);
                    gp[mi][ni][1] = (unsigned)f2bf(fsig(ag[mi][ni][2] + bias)) | ((unsigned)f2bf(fsig(ag[mi][ni][3] + bias)) << 16);
                }
            }
        }
        f32x4 ap[4][4];
        acc_zero<128>(ap);
        const bf16_t* yb = n == 0 ? DB(D_YA) : (n == 1 ? DB(D_OF) : (n == 2 ? DB(D_LH0) : DB(D_YD)));
        AOp A2{yb, 512, row0, nullptr};
        gemm_core<128>(ap, A2, WB(W_BR + ((size_t)l * 4 + n) * 1024 * 512 + (size_t)(nt * 128) * 512), 512, 512, smem);
#pragma unroll
        for (int mi = 0; mi < 4; ++mi)
#pragma unroll
            for (int ni = 0; ni < 4; ++ni) {
                const float m0 = __uint_as_float(mp[mi][ni][0] << 16) + __uint_as_float(gp[mi][ni][0] << 16) * ap[mi][ni][0];
                const float m1 = __uint_as_float(mp[mi][ni][0] & 0xffff0000u) + __uint_as_float(gp[mi][ni][0] & 0xffff0000u) * ap[mi][ni][1];
                const float m2 = __uint_as_float(mp[mi][ni][1] << 16) + __uint_as_float(gp[mi][ni][1] << 16) * ap[mi][ni][2];
                const float m3 = __uint_as_float(mp[mi][ni][1] & 0xffff0000u) + __uint_as_float(gp[mi][ni][1] & 0xffff0000u) * ap[mi][ni][3];
                mp[mi][ni][0] = (unsigned)f2bf(m0) | ((unsigned)f2bf(m1) << 16);
                mp[mi][ni][1] = (unsigned)f2bf(m2) | ((unsigned)f2bf(m3) << 16);
            }
    }
    __syncthreads();
    {
        const int wid = TIDX >> 6, wr = wid >> 1;
#pragma unroll
        for (int mi = 0; mi < 4; ++mi)
#pragma unroll
            for (int ni = 0; ni < 4; ++ni) {
                bf16_t* cp = ct + (wr * 64 + mi * 16 + (lane >> 4) * 4) * CT_LD + wc * 64 + ni * 16 + (lane & 15);
                cp[0] = (bf16_t)(mp[mi][ni][0] & 0xffffu); cp[CT_LD] = (bf16_t)(mp[mi][ni][0] >> 16);
                cp[2 * CT_LD] = (bf16_t)(mp[mi][ni][1] & 0xffffu); cp[3 * CT_LD] = (bf16_t)(mp[mi][ni][1] >> 16);
            }
    }
    __syncthreads();
    ep_store_rows<128>(ct, 0, CB(C_M) + nt * 128, 1024, row0);
}

DEVI void wout_tile(const Params& p, int l, int mq, int nt, unsigned char* smem) {
    bf16_t* ct = (bf16_t*)smem;
    const int mt = mt_of(mq, l != 0);
    const int row0 = mt * 128, b = mt / 18, t0 = (mt % 18) * 128;
    const bool isctx = (mt % 18) < 2;
    const int bi = isctx ? 8 : b;
    f32x4 acc[4][4];
    acc_zero<128>(acc);
    AOp A{CB(C_M), 1024, row0, nullptr};
    gemm_core<128>(acc, A, WB(W_OUT + (size_t)l * 1024 * 1024 + (size_t)nt * 128 * 1024), 1024, 1024, smem);
    __syncthreads();
    acc_to_ct<128>(acc, ct);
    __syncthreads();
    const float* gate = WSF(OFF_MOD) + (size_t)(l * 9 + bi) * 6144 + 2 * 1024 + nt * 128;
    for (int c = TIDX; c < 128 * 32; c += 256) {
        const int i = c >> 5, jc = c & 31;
        const int t = t0 + i;
        const float* xs;
        if (l == 0) xs = isctx ? p.in[I_CTX] + ((size_t)b * CTXL + t) * DM : p.in[I_X] + ((size_t)b * SEQL + (t - CTXL)) * DM;
        else xs = XCUR + (size_t)(row0 + i) * DM;
        float4 x4 = *(const float4*)(xs + nt * 128 + jc * 4);
        float4 g4 = *(const float4*)(gate + jc * 4);
        uint2 y = *(const uint2*)(ct + i * CT_LD + jc * 4);
        x4.x += g4.x * __uint_as_float(y.x << 16);
        x4.y += g4.y * __uint_as_float(y.x & 0xffff0000u);
        x4.z += g4.z * __uint_as_float(y.y << 16);
        x4.w += g4.w * __uint_as_float(y.y & 0xffff0000u);
        *(float4*)(XCUR + (size_t)(row0 + i) * DM + nt * 128 + jc * 4) = x4;
    }
}

DEVI void phase_merge_wout(const Params& p, int l, unsigned char* smem) {
    const int nmt = (l == 0 ? 144 : 128);
    const int N5 = nmt * 8;
    int* ctr = WSI(OFF_CNT) + 132 + l;
    int* dep = WSI(OFF_CNT) + 256 + l * 160;
    for (;;) {
        const int task = fetch_task(ctr, smem);
        if (task >= 2 * N5) break;
        if (task < N5) {
            merge_tile(p, l, task >> 3, task & 7, smem);
            dep_signal(dep + (task >> 3));
        } else {
            const int t6 = task - N5;
            dep_wait(dep + (t6 >> 3), 8);
            wout_tile(p, l, t6 >> 3, t6 & 7, smem);
        }
    }
}

DEVI void phase_route(const Params& p, int l, unsigned char* smem) {
    const int tid = TIDX, lane = tid & 63, w = tid >> 6, wr = w >> 1, wc = w & 1;
    float* lgt = (float*)smem;
    const float rbias = p.in[I_RB][lane];
    int* cnt = WSI(OFF_CNT) + l * 64;
    int* list = WSI(OFF_LIST);
    const int ntile = l == 0 ? 144 : 128;
    for (int q = BIDX; q < ntile; q += gridDim.x) {
        const int mt = mt_of(q, l != 0);
        const int row0 = mt * 128;
        f32x4 acc[4][2];
        acc_zero<64>(acc);
        AOp A{HB, 1024, row0, nullptr};
        gemm_core<64>(acc, A, WB(W_RT), 1024, 1024, smem);
        __syncthreads();
#pragma unroll
        for (int mi = 0; mi < 4; ++mi)
#pragma unroll
            for (int ni = 0; ni < 2; ++ni)
#pragma unroll
                for (int j = 0; j < 4; ++j)
                    lgt[(wr * 64 + mi * 16 + (lane >> 4) * 4 + j) * 68 + wc * 32 + ni * 16 + (lane & 15)] = acc[mi][ni][j];
        __syncthreads();
        int me0 = 0, me1 = 0; float ms0 = 0.f, ms1 = 0.f;
#pragma unroll 2
        for (int i = 0; i < 32; ++i) {
            const float lg = lgt[(w * 32 + i) * 68 + lane];
            const float score = sigmoidf_(lg);
            const float biased = score + rbias;
            float v1 = biased; int i1 = lane;
#pragma unroll
            for (int off = 1; off < 8; off <<= 1) {
                float ov = __shfl_xor(v1, off); int oi = __shfl_xor(i1, off);
                if (ov > v1 || (ov == v1 && oi < i1)) { v1 = ov; i1 = oi; }
            }
            float v2 = (lane == i1) ? -3.0e38f : biased; int i2 = lane;
#pragma unroll
            for (int off = 1; off < 8; off <<= 1) {
                float ov = __shfl_xor(v2, off); int oi = __shfl_xor(i2, off);
                if (ov > v2 || (ov == v2 && oi < i2)) { v2 = ov; i2 = oi; }
            }
            float gv = v1 + v2; int gi = lane >> 3;
#pragma unroll
            for (int off = 8; off < 64; off <<= 1) {
                float ov = __shfl_xor(gv, off); int oi = __shfl_xor(gi, off);
                if (ov > gv || (ov == gv && oi < gi)) { gv = ov; gi = oi; }
            }
            const int e0 = __shfl(i1, gi * 8), e1 = __shfl(i2, gi * 8);
            const float s0 = __shfl(score, e0), s1 = __shfl(score, e1);
            if (lane == i) { me0 = e0; me1 = e1; ms0 = s0; ms1 = s1; }
        }
        int* hist = (int*)(smem + 36864);
        int* base = hist + 64;
        if (tid < 64) hist[tid] = 0;
        __syncthreads();
        int r0 = 0, r1 = 0;
        if (lane < 32) { r0 = atomicAdd(&hist[me0], 1); r1 = atomicAdd(&hist[me1], 1); }
        __syncthreads();
        if (tid < 64) { const int hc = hist[tid]; base[tid] = hc ? atomicAdd(&cnt[tid], hc) : 0; }
        __syncthreads();
        if (lane < 32) {
            const int row = row0 + w * 32 + lane;
            Rec rc;
            rc.e0 = me0; rc.e1 = me1;
            rc.p0 = base[me0] + r0;
            rc.p1 = base[me1] + r1;
            const float inv = 1.f / (ms0 + ms1);
            rc.w0 = ms0 * inv; rc.w1 = ms1 * inv; rc.pad0 = 0; rc.pad1 = 0;
            list[(size_t)me0 * TT + rc.p0] = row;
            list[(size_t)me1 * TT + rc.p1] = row;
            ((Rec*)(p.ws + OFF_REC))[row] = rc;
        }
        __syncthreads();
    }
}

struct MoeGrp { int ne[8], sg[8], cn[8]; };
DEVI MoeGrp moe_grp(const MoeTab& mt, const GrpInfo& gi) {
    MoeGrp g;
#pragma unroll
    for (int q = 0; q < 8; ++q) {
        const int ee = gi.ngrp == 8 ? gi.xcd * 8 + q : 0;
        g.cn[q] = mt.cnt(ee); g.sg[q] = mt.seg(ee); g.ne[q] = (g.cn[q] + 127) >> 7;
    }
    return g;
}
DEVI bool moe_tile(const MoeTab& mt, const MoeGrp& mg, const GrpInfo& gi, int it, int NT, int& e, int& jt, int& nt, int& cn, int& sg) {
    int rem = gi.j + gi.per * it;
    if (gi.ngrp == 8) {
#pragma unroll
        for (int q = 0; q < 8; ++q) {
            const int ne = mg.ne[q] * NT;
            if (rem < ne) { e = gi.xcd * 8 + q; jt = rem / NT; nt = rem % NT; cn = mg.cn[q]; sg = mg.sg[q]; return true; }
            rem -= ne;
        }
        return false;
    }
    for (int ee = 0; ee < 64; ++ee) {
        const int c = mt.cnt(ee);
        const int ne = ((c + 127) >> 7) * NT;
        if (rem < ne) { e = ee; jt = rem / NT; nt = rem % NT; cn = c; sg = mt.seg(ee); return true; }
        rem -= ne;
    }
    return false;
}
struct MoeRegs { int tp, cnt, seg; };
DEVI void moe_find(const MoeRegs& mr, int rt, int& e, int& jt, int& cn, int& sg) {
    const unsigned long long m = __ballot(mr.tp <= rt);
    e = __popcll(m) - 1;
    jt = rt - __shfl(mr.tp, e); cn = __shfl(mr.cnt, e); sg = __shfl(mr.seg, e);
}
DEVI void phase_moe(const Params& p, int l, unsigned char* smem) {
    bf16_t* ct = (bf16_t*)smem;
    int* ridx = (int*)(smem + AUX_OFF);
    MoeTab mt = moe_tables(p, l, smem);
    const int* list = WSI(OFF_LIST);
    const int nrt = mt.tp(64);
    MoeRegs mr; mr.tp = mt.tp(TIDX & 63); mr.cnt = mt.cnt(TIDX & 63); mr.seg = mt.seg(TIDX & 63);
    int* ctr = WSI(OFF_CNT) + 136 + l;
    int* dep = WSI(OFF_CNT) + 1024 + l * 384;
    for (;;) {
        const int task = fetch_task(ctr, smem);
        if (task >= nrt * 12) break;
        if (task < nrt * 4) {
            const int rt = task >> 2, nt = task & 3;
            int e, jt, cn, sg;
            moe_find(mr, rt, e, jt, cn, sg);
            if (TIDX < 128) {
                const int idx = jt * 128 + TIDX;
                ridx[TIDX] = list[(size_t)e * TT + (idx < cn ? idx : 0)];
            }
            __syncthreads();
            f32x4 acc[4][4];
            acc_zero<128>(acc);
            gemm_core_fp8<true>(acc, (const unsigned char*)CB(0), 1024, 0, (const unsigned char*)MWB(MW_13) + ((size_t)e * 512 + nt * 128) * 1024, 1024, 1024, smem, ridx);
            __syncthreads();
            acc_to_ct<128>(acc, ct);
            __syncthreads();
            const int slot0 = sg + jt * 128;
            for (int c = TIDX; c < 128 * 8; c += 256) {
                const int i = c >> 3, jc = c & 7;
                bf16x8 a = *(const bf16x8*)(ct + i * CT_LD + jc * 8), g = *(const bf16x8*)(ct + i * CT_LD + 64 + jc * 8), o;
#pragma unroll
                for (int q = 0; q < 8; ++q) o[q] = (short)f2bf(siluf_(bf2f((bf16_t)a[q])) * bf2f((bf16_t)g[q]));
                *(bf16x8*)(DB(D_ACT) + (size_t)(slot0 + i) * 256 + nt * 64 + jc * 8) = o;
            }
            dep_signal(dep + rt);
        } else {
            const int t2 = task - nrt * 4;
            const int rt = t2 >> 3, nt = t2 & 7;
            int e, jt, cn, sg;
            moe_find(mr, rt, e, jt, cn, sg);
            const int slot0 = sg + jt * 128;
            dep_wait(dep + rt, 4);
            f32x4 acc[4][4];
            acc_zero<128>(acc);
            AOp A{DB(D_ACT), 256, slot0, nullptr};
            gemm_core<128>(acc, A, MWB(MW_2) + ((size_t)e * 1024 + nt * 128) * 256, 256, 256, smem);
            __syncthreads();
            acc_to_ct<128>(acc, ct);
            __syncthreads();
            ep_store_rows<128>(ct, 0, DB(D_YS) + nt * 128, 1024, slot0);
        }
    }
}

#define XB_TMO      128
#define XB_XCNT(j)  (256  + 64 * (j))
#define XB_XSUB(j)  (1280 + 64 * (j))
#define XB_XGEN(j)  (2304 + 64 * (j))
#define XB_TOP      3328
#define XB_TOPGEN   3392
#define XB_SPIN_CAP (1u << 22)
DEVI unsigned xb_ld(unsigned* p) { return __hip_atomic_load(p, __ATOMIC_RELAXED, __HIP_MEMORY_SCOPE_AGENT); }
DEVI unsigned xb_add(unsigned* p, unsigned v) { return __hip_atomic_fetch_add(p, v, __ATOMIC_RELAXED, __HIP_MEMORY_SCOPE_AGENT); }
DEVI unsigned xb_xcc_id() { return (unsigned)__builtin_amdgcn_s_getreg((3 << 11) | 20) & 0xFu; }
#define XB_SPIN(cond, bar) do { unsigned _sp = 0; while (cond) { __builtin_amdgcn_s_sleep(1); \
    if ((++_sp & 255u) == 0u) { if (xb_ld(&(bar)[XB_TMO])) break; if (_sp > XB_SPIN_CAP) { atomicAdd(&(bar)[XB_TMO], 1u); break; } } } } while (0)
struct XcdBarrier { unsigned* bar; unsigned x; unsigned* st; };
DEVI XcdBarrier xcd_barrier_post(unsigned* bar, unsigned* st) {
    XcdBarrier b; b.bar = bar; b.x = xb_xcc_id(); b.st = st;
    if (__builtin_amdgcn_workitem_id_x() == 0) (void)xb_add(&bar[XB_XCNT(b.x)], 1u);
    return b;
}
DEVI void xcd_barrier_complete(unsigned* bar, unsigned x, unsigned& nloc, unsigned& nx) {
    const unsigned G = gridDim.x * gridDim.y * gridDim.z;
    unsigned sum, cnt, mine, sp = 0u;
    for (;;) {
        sum = 0u; cnt = 0u; mine = 0u;
#pragma unroll
        for (unsigned j = 0; j < 16; ++j) { const unsigned c = xb_ld(&bar[XB_XCNT(j)]); sum += c; cnt += (c > 0u) ? 1u : 0u; mine = (j == x) ? c : mine; }
        if (sum == G) break;
        __builtin_amdgcn_s_sleep(1);
        if ((++sp & 255u) == 0u) { if (xb_ld(&bar[XB_TMO])) break; if (sp > XB_SPIN_CAP) { atomicAdd(&bar[XB_TMO], 1u); break; } }
    }
    nloc = mine > 0u ? mine : 1u; nx = cnt > 0u ? cnt : 1u;
}
DEVI void xcd_barrier(const XcdBarrier& b) {
    asm volatile("s_waitcnt vmcnt(0)" ::: "memory");
    __syncthreads();
    if (__builtin_amdgcn_workitem_id_x() == 0) {
        unsigned* bar = b.bar;
        __builtin_amdgcn_s_waitcnt(0);
        unsigned nloc = xb_ld(&b.st[0]), nx = xb_ld(&b.st[1]);
        if (nloc == 0u) { xcd_barrier_complete(bar, b.x, nloc, nx); __hip_atomic_store(&b.st[0], nloc, __ATOMIC_RELAXED, __HIP_MEMORY_SCOPE_AGENT); __hip_atomic_store(&b.st[1], nx, __ATOMIC_RELAXED, __HIP_MEMORY_SCOPE_AGENT); }
        const unsigned old = xb_add(&bar[XB_XSUB(b.x)], 1u);
        const unsigned gen = old / nloc;
        if (old + 1u == (gen + 1u) * nloc) {
            __builtin_amdgcn_fence(__ATOMIC_RELEASE, "agent");
            asm volatile("s_waitcnt vmcnt(0)" ::: "memory");
            const unsigned og = xb_add(&bar[XB_TOP], 1u);
            const unsigned tg = og / nx;
            if (og + 1u == (tg + 1u) * nx) xb_add(&bar[XB_TOPGEN], 1u);
            else XB_SPIN(xb_ld(&bar[XB_TOPGEN]) == tg, bar);
            __builtin_amdgcn_fence(__ATOMIC_ACQUIRE, "agent");
            xb_add(&bar[XB_XGEN(b.x)], 1u);
            asm volatile("s_waitcnt vmcnt(0)" ::: "memory");
        } else {
            XB_SPIN(xb_ld(&bar[XB_XGEN(b.x)]) == gen, bar);
            __builtin_amdgcn_fence(__ATOMIC_ACQUIRE, "agent");
            asm volatile("s_waitcnt vmcnt(0)" ::: "memory");
        }
    }
    __syncthreads();
}

constexpr int NPHASE = 24;
DEVI void run_phase(const Params& p, int ph, unsigned char* smem) {
#ifndef ONLYK
    if (ph == 0) { phase0(p, smem); return; }
    if (ph == 23) { phase_norm1(p, 1, 1, smem); return; }
#endif
    const int l = (ph - 1) / 11, k = (ph - 1) % 11;
#ifdef ONLYK
    if (k != ONLYK) return;
#endif
    switch (k) {
    case 0: phase_norm1(p, l, 0, smem); break;
    case 1: phase_win(p, l, smem); break;
    case 2: phase_mla_up(p, l, smem); break;
    case 3: phase_mix(p, l, smem); break;
    case 4: phase_fin(p, l); break;
    case 5: phase_merge_wout(p, l, smem); break;
    case 6: break;
    case 7: phase_norm1(p, l, 2, smem); break;
    case 8: phase_route(p, l, smem); break;
    case 9: phase_moe(p, l, smem); break;
    default: break;
    }
}

__global__ void __launch_bounds__(256, 2) k_main(Params p, int ph_lo, int ph_hi) {
    __shared__ __attribute__((aligned(16))) unsigned char smem[SMEM_BYTES];
    unsigned* xb_priv = (unsigned*)(p.ws + OFF_PRIV + (size_t)__builtin_amdgcn_workgroup_id_x() * 1024 + 896);
    if (__builtin_amdgcn_workitem_id_x() == 0) { __hip_atomic_store(xb_priv, 0u, __ATOMIC_RELAXED, __HIP_MEMORY_SCOPE_AGENT); __hip_atomic_store(xb_priv + 1, 0u, __ATOMIC_RELAXED, __HIP_MEMORY_SCOPE_AGENT); }
    XcdBarrier xb = xcd_barrier_post((unsigned*)(p.ws + OFF_BAR), xb_priv);
    if (__builtin_amdgcn_workitem_id_x() == 0) {
        const unsigned rk = xb_add((unsigned*)(p.ws + OFF_BAR) + 3456 + xb.x, 1u);
        __hip_atomic_store(xb_priv + 2, xb.x, __ATOMIC_RELAXED, __HIP_MEMORY_SCOPE_AGENT);
        __hip_atomic_store(xb_priv + 3, rk, __ATOMIC_RELAXED, __HIP_MEMORY_SCOPE_AGENT);
    }
    for (int ph = ph_lo; ph < ph_hi; ++ph) {
        if (ph >= 1 && ph <= 22 && (((ph - 1) % 11) == 6 || ((ph - 1) % 11) == 10)) continue;
        run_phase(p, ph, smem);
#ifdef DUPK
        if (ph >= 1 && ph <= 22 && ((ph - 1) % 11) == DUPK) run_phase(p, ph, smem);
        if (DUPK == 10 && ph == 0) run_phase(p, ph, smem);
#endif
        if (ph + 1 < ph_hi) {
            if (ph == ph_lo) cg::this_grid().sync();
            else xcd_barrier(xb);
        }
    }
#ifdef TPROBE
    if (__builtin_amdgcn_workgroup_id_x() == 0 && __builtin_amdgcn_workitem_id_x() == 0) {
        const unsigned long long dt = __hip_atomic_load(T_SLOT(TPROBE), __ATOMIC_RELAXED, __HIP_MEMORY_SCOPE_AGENT) * TMULT;
        const unsigned long long t0 = __builtin_amdgcn_s_memrealtime();
        while (__builtin_amdgcn_s_memrealtime() - t0 < dt) __builtin_amdgcn_s_sleep(8);
    }
#endif
}

extern "C" void kernel_launch(void* const* d_in, const int* in_sizes, int n_in, void* d_out, int out_size, void* d_ws, size_t ws_size,
                              hipStream_t stream) {
    if (ws_size < WS_NEED || n_in < N_IN) { fprintf(stderr, "workspace too small: %zu < %zu\n", ws_size, (size_t)WS_NEED); return; }
    Params p{};
    for (int i = 0; i < N_IN; ++i) p.in[i] = (const float*)d_in[i];
    p.out = (float*)d_out;
    p.ws = (unsigned char*)d_ws;
    static int grid_blocks = 0;
    if (!grid_blocks) {
        int dev = 0, cus = 0, per_cu = 0;
        hipGetDevice(&dev);
        hipDeviceGetAttribute(&cus, hipDeviceAttributeMultiprocessorCount, dev);
        hipOccupancyMaxActiveBlocksPerMultiprocessor(&per_cu, k_main, 256, DYN_LDS);
        if (per_cu > 2) per_cu = 2;
        if (per_cu < 1) per_cu = 1;
        grid_blocks = cus * per_cu;
    }
    hipMemsetAsync(p.ws + OFF_BAR, 0, 16384, stream);
#if ONE_LAUNCH
    int lo = 0, hi = NPHASE;
    void* args[] = {&p, &lo, &hi};
    hipError_t e = hipLaunchCooperativeKernel((void*)k_main, dim3(grid_blocks), dim3(256), args, DYN_LDS, stream);
    if (e != hipSuccess) fprintf(stderr, "cooperative launch failed: %s (grid %d)\n", hipGetErrorString(e), grid_blocks);
#else
    for (int ph = 0; ph < NPHASE; ++ph) hipLaunchKernelGGL(k_main, dim3(grid_blocks), dim3(256), DYN_LDS, stream, p, ph, ph + 1);
#endif
}
```

```cpp
#include <hip/hip_runtime.h>
#include <hip/hip_cooperative_groups.h>
#include <stdint.h>
#include <stdio.h>
namespace cg = cooperative_groups;

#define DEVI __device__ __forceinline__
#define LAS __attribute__((address_space(3)))
typedef unsigned short bf16_t;
typedef __attribute__((ext_vector_type(8))) short bf16x8;
typedef __attribute__((ext_vector_type(4))) float f32x4;
typedef __attribute__((ext_vector_type(16))) float f32x16;
typedef __attribute__((ext_vector_type(4))) short bf16x4;

#ifndef NAIVE_GEMM
#define NAIVE_GEMM 0
#endif
#ifndef ONE_LAUNCH
#define ONE_LAUNCH 1
#endif

constexpr int DM = 1024, NBT = 8, SEQL = 2048, CTXL = 256, TPB = 2304, TT = 18432;
constexpr int DINP = 3840;
constexpr float LOG2E = 1.4426950408889634f;
constexpr float EPSV = 1e-6f;
constexpr int NSLOT = 2 * TT + 64 * 128;

enum { I_X = 0, I_C, I_CTX, I_CCTX, I_ADAW, I_ADAB, I_N1G, I_N2G, I_WIN, I_MQN, I_MKVN, I_WUQ, I_WUKV, I_RDEC, I_RNORM,
       I_LCW, I_LCB, I_LWA, I_LBA, I_LWX, I_LBX, I_LLAM, I_GQN, I_GKN, I_WBR, I_WMG, I_BMG, I_WOUT, I_RW, I_RB,
       I_W1, I_W3, I_W2, I_FN, N_IN };

constexpr size_t AL(size_t x) { return (x + 255) & ~(size_t)255; }
constexpr size_t OFF_BAR = 0;
constexpr size_t OFF_CNT = 16384;
constexpr size_t OFF_MOD = OFF_CNT + 16384;
constexpr size_t OFF_R64 = AL(OFF_MOD + (size_t)2 * 9 * 6144 * 4);
constexpr size_t OFF_R32 = OFF_R64 + (size_t)2048 * 64 * 4;
constexpr size_t OFF_REC = OFF_R32 + (size_t)2048 * 32 * 4;
constexpr size_t OFF_LIST = OFF_REC + (size_t)TT * 32;
constexpr size_t OFF_PRIV = AL(OFF_LIST + (size_t)64 * TT * 4);
constexpr size_t OFF_W = OFF_PRIV + (size_t)2048 * 1024;
constexpr size_t W_IN = 0;
constexpr size_t W_UQ = W_IN + (size_t)2 * 3840 * 1024;
constexpr size_t W_UKV = W_UQ + (size_t)2 * 768 * 256;
constexpr size_t W_BR = W_UKV + (size_t)2 * 1024 * 128;
constexpr size_t W_MG = W_BR + (size_t)2 * 4 * 1024 * 512;
constexpr size_t W_OUT = W_MG + (size_t)2 * 4096 * 1024;
constexpr size_t W_LRU = W_OUT + (size_t)2 * 1024 * 1024;
constexpr size_t W_RT = W_LRU + (size_t)2 * 2 * 8 * 2 * 64 * 64;
constexpr size_t W_END = W_RT + (size_t)64 * 1024;
constexpr size_t OFF_XCUR = AL(OFF_W + W_END * 2);
constexpr size_t OFF_H = OFF_XCUR + (size_t)TT * 1024 * 4;
constexpr size_t OFF_C = OFF_H + (size_t)TT * 1024 * 2;
constexpr size_t C_CQ = 0;
constexpr size_t C_CKV = C_CQ + (size_t)TT * 256;
constexpr size_t C_KR = C_CKV + (size_t)TT * 128;
constexpr size_t C_MQ = C_KR + (size_t)TT * 32;
constexpr size_t C_KN = C_MQ + (size_t)TT * 768;
constexpr size_t C_VMT = C_KN + (size_t)TT * 512;
constexpr size_t C_RQ = C_VMT + (size_t)TT * 512;
constexpr size_t C_RK = C_RQ + (size_t)TT * 256;
constexpr size_t C_RKT = C_RK + (size_t)TT * 256;
constexpr size_t C_RVT = C_RKT + (size_t)TT * 256;
constexpr size_t C_RG = C_RVT + (size_t)TT * 512;
constexpr size_t C_LX = C_RG + (size_t)TT * 512;
constexpr size_t C_LG = C_LX + (size_t)TT * 512;
constexpr size_t C_GQ = C_LG + (size_t)TT * 512;
constexpr size_t C_GK = C_GQ + (size_t)TT * 512;
constexpr size_t C_GVT = C_GK + (size_t)TT * 128;
constexpr size_t C_END = C_GVT + (size_t)TT * 128;
constexpr size_t C_M = 0;
constexpr size_t C_W13 = (size_t)24 * 1024 * 1024;
constexpr size_t C_W2 = C_W13 + (size_t)64 * 512 * 1024;
static_assert(C_W2 + (size_t)64 * 1024 * 256 <= C_END, "moe alias");
static_assert((size_t)TT * 1024 <= C_W13, "m alias");
constexpr size_t OFF_D = OFF_C + C_END * 2;
constexpr size_t D_YA = 0;
constexpr size_t D_YD = (size_t)TT * 512;
constexpr size_t D_OF = (size_t)2 * TT * 512;
constexpr size_t D_OB = (size_t)3 * TT * 512;
constexpr size_t D_LH0 = (size_t)4 * TT * 512;
constexpr size_t D_LH1 = (size_t)5 * TT * 512;
constexpr size_t D_ACT = 0;
constexpr size_t D_YS = (size_t)12 * 1024 * 1024;
constexpr size_t D_END = D_YS + (size_t)NSLOT * 1024;
static_assert((size_t)NSLOT * 256 <= D_YS, "act alias");
static_assert((size_t)6 * TT * 512 <= D_END, "d size");
constexpr size_t OFF_MOEW = AL(OFF_D + D_END * 2);
constexpr size_t MW_13 = 0, MW_2 = (size_t)64 * 512 * 1024, MW_END = MW_2 + (size_t)64 * 1024 * 256;
constexpr size_t WS_NEED = OFF_MOEW + MW_END * 2;

struct Params {
    const float* in[N_IN];
    float* out;
    unsigned char* ws;
};

#define WSF(off) ((float*)(p.ws + (off)))
#define WSI(off) ((int*)(p.ws + (off)))
#define WB(el) ((bf16_t*)(p.ws + OFF_W) + (el))
#define CB(el) ((bf16_t*)(p.ws + OFF_C) + (el))
#define DB(el) ((bf16_t*)(p.ws + OFF_D) + (el))
#define MWB(el) ((bf16_t*)(p.ws + OFF_MOEW) + (el))
#define HB ((bf16_t*)(p.ws + OFF_H))
#define XCUR ((float*)(p.ws + OFF_XCUR))

constexpr int SMEM_BYTES = 65536;
constexpr int DYN_LDS = 0;
constexpr int CT_LD = 136;
constexpr int AUX_OFF = 36864;

#ifdef TPROBE
#define T_SLOT(id) ((unsigned long long*)(p.ws + OFF_BAR + 14400) + (id))
#define T_BEGIN(id) const unsigned long long _tb##id = __builtin_amdgcn_s_memrealtime()
#define T_END(id, cond) do { if ((cond) && __builtin_amdgcn_workitem_id_x() == 0) atomicAdd(T_SLOT(id), __builtin_amdgcn_s_memrealtime() - _tb##id); } while (0)
#else
#define T_BEGIN(id)
#define T_END(id, cond)
#endif
DEVI int launder_tid() { int t = __builtin_amdgcn_workitem_id_x(); asm volatile("" : "+v"(t)); return t; }
DEVI int launder_bid() { int t = __builtin_amdgcn_workgroup_id_x(); asm volatile("" : "+s"(t)); return t; }
#define TIDX launder_tid()
#define BIDX launder_bid()
DEVI float bf2f(bf16_t v) { return __uint_as_float(((unsigned)v) << 16); }
DEVI bf16_t f2bf(float f) {
    __bf16 h = (__bf16)f;
    return __builtin_bit_cast(unsigned short, h);
}
typedef __attribute__((ext_vector_type(8))) int i32x8;
typedef __attribute__((ext_vector_type(4))) int i32x4;
DEVI float clamp8(float x) { return __builtin_amdgcn_fmed3f(x, -448.f, 448.f); }
DEVI int pk4_fp8(float a, float b, float c, float d) {
    int r = __builtin_amdgcn_cvt_pk_fp8_f32(clamp8(a), clamp8(b), 0, false);
    return __builtin_amdgcn_cvt_pk_fp8_f32(clamp8(c), clamp8(d), r, true);
}
DEVI float fsig(float x) { return __builtin_amdgcn_rcpf(1.f + __expf(-x)); }
DEVI float sigmoidf_(float x) { return 1.f / (1.f + __expf(-x)); }
DEVI float siluf_(float x) { return x / (1.f + __expf(-x)); }
DEVI float gelu_tanh(float x) {
    float u = 0.7978845608028654f * (x + 0.044715f * x * x * x);
    return 0.5f * x * (1.f + tanhf(u));
}
DEVI float wave_sum(float v) {
#pragma unroll
    for (int o = 32; o > 0; o >>= 1) v += __shfl_xor(v, o);
    return v;
}
DEVI int mt_of(int q, bool latonly) { return latonly ? (q >> 4) * 18 + 2 + (q & 15) : q; }

struct CvtJob { const float* src; bf16_t* dst; const float* ks; int K, N, ldd, batch; size_t sbs, dbs; int mode; int lds, n0, wide; };
DEVI int cvt_rowmap(int mode, int n) {
    if (mode == 1) return n < 384 ? n : (n < 416 ? n - 384 + 3712 : n - 32);
    if (mode == 2) { int h = n / 96, j = n % 96; return j < 64 ? h * 64 + j : 512 + h * 32 + (j - 64); }
    if (mode == 3) return (n >> 6) * 128 + (n & 63);
    return n;
}
DEVI void cvt_tile(const CvtJob& j, int tile, float* lds) {
    const int tn = j.N / 32, tk = j.K / 64, per = tn * tk;
    const int bb = tile / per, r = tile % per, kt = r / tn, nt = r % tn;
    const float* s = j.src + (size_t)bb * j.sbs + (size_t)(kt * 64) * j.lds + j.n0 + nt * 32;
    const int tx = TIDX & 31, ty = TIDX >> 5;
#pragma unroll
    for (int i = 0; i < 8; ++i) {
        int k = ty + 8 * i;
        float v = s[(size_t)k * j.lds + tx];
        if (j.ks) v *= j.ks[kt * 64 + k];
        lds[k * 33 + tx] = v;
    }
    __syncthreads();
    bf16_t* d = j.dst + (size_t)bb * j.dbs;
#pragma unroll
    for (int i = 0; i < 4; ++i) {
        int n = ty + 8 * i, kk = tx * 2;
        unsigned lo = f2bf(lds[kk * 33 + n]), hi = f2bf(lds[(kk + 1) * 33 + n]);
        int row = cvt_rowmap(j.mode, j.n0 + nt * 32 + n);
        *(unsigned*)(d + (size_t)row * j.ldd + kt * 64 + kk) = lo | (hi << 16);
    }
    __syncthreads();
}

DEVI void cvt_tile256(const CvtJob& j, int tile, unsigned char* smem) {
    constexpr int NS = 68;
    bf16_t* T = (bf16_t*)smem;
    const int tn = j.N / 256, tk = j.K / 64, per = tn * tk;
    const int bb = tile / per, r = tile % per, kt = r / tn, nt = r % tn;
    const float* s = j.src + (size_t)bb * j.sbs + (size_t)(kt * 64) * j.lds + j.n0 + nt * 256;
    const int tid = TIDX, lane = tid & 63, w = tid >> 6;
    float4 v[16];
#pragma unroll
    for (int i = 0; i < 16; ++i) v[i] = *(const float4*)(s + (size_t)(w * 16 + i) * j.lds + lane * 4);
    if (j.ks) {
#pragma unroll
        for (int i = 0; i < 16; ++i) { const float sc = j.ks[kt * 64 + w * 16 + i]; v[i].x *= sc; v[i].y *= sc; v[i].z *= sc; v[i].w *= sc; }
    }
    __syncthreads();
#pragma unroll
    for (int h = 0; h < 2; ++h) {
        bf16x4 q0a, q0b, q1a, q1b, q2a, q2b, q3a, q3b;
#pragma unroll
        for (int e = 0; e < 4; ++e) {
            q0a[e] = (short)f2bf(v[h * 8 + e].x); q0b[e] = (short)f2bf(v[h * 8 + 4 + e].x);
            q1a[e] = (short)f2bf(v[h * 8 + e].y); q1b[e] = (short)f2bf(v[h * 8 + 4 + e].y);
            q2a[e] = (short)f2bf(v[h * 8 + e].z); q2b[e] = (short)f2bf(v[h * 8 + 4 + e].z);
            q3a[e] = (short)f2bf(v[h * 8 + e].w); q3b[e] = (short)f2bf(v[h * 8 + 4 + e].w);
        }
        bf16_t* tp = T + (lane * 4) * NS + w * 16 + h * 8;
        *(bf16x4*)(tp) = q0a; *(bf16x4*)(tp + 4) = q0b;
        *(bf16x4*)(tp + NS) = q1a; *(bf16x4*)(tp + NS + 4) = q1b;
        *(bf16x4*)(tp + 2 * NS) = q2a; *(bf16x4*)(tp + 2 * NS + 4) = q2b;
        *(bf16x4*)(tp + 3 * NS) = q3a; *(bf16x4*)(tp + 3 * NS + 4) = q3b;
    }
    __syncthreads();
    bf16_t* d = j.dst + (size_t)bb * j.dbs;
#pragma unroll
    for (int i = 0; i < 8; ++i) {
        const int c = tid + 256 * i, n = c >> 3, kc = c & 7;
        const bf16x4 lo = *(const bf16x4*)(T + n * NS + kc * 8), hi = *(const bf16x4*)(T + n * NS + kc * 8 + 4);
        const int row = cvt_rowmap(j.mode, j.n0 + nt * 256 + n);
        *(bf16x8*)(d + (size_t)row * j.ldd + kt * 64 + kc * 8) = bf16x8{lo[0], lo[1], lo[2], lo[3], hi[0], hi[1], hi[2], hi[3]};
    }
}
constexpr float W8_SCALE = 32.f;
DEVI void cvt_tile256_fp8(const CvtJob& j, int tile, unsigned char* smem) {
    constexpr int RS = 80;
    const int tn = j.N / 256, tk = j.K / 64, per = tn * tk;
    const int bb = tile / per, r = tile % per, kt = r / tn, nt = r % tn;
    const float* s = j.src + (size_t)bb * j.sbs + (size_t)(kt * 64) * j.lds + nt * 256;
    const int tid = TIDX, lane = tid & 63, w = tid >> 6;
    float4 v[16];
#pragma unroll
    for (int i = 0; i < 16; ++i) v[i] = *(const float4*)(s + (size_t)(w * 16 + i) * j.lds + lane * 4);
    __syncthreads();
    i32x4 q0, q1, q2, q3;
#pragma unroll
    for (int c = 0; c < 4; ++c) {
        q0[c] = pk4_fp8(v[4 * c].x * W8_SCALE, v[4 * c + 1].x * W8_SCALE, v[4 * c + 2].x * W8_SCALE, v[4 * c + 3].x * W8_SCALE);
        q1[c] = pk4_fp8(v[4 * c].y * W8_SCALE, v[4 * c + 1].y * W8_SCALE, v[4 * c + 2].y * W8_SCALE, v[4 * c + 3].y * W8_SCALE);
        q2[c] = pk4_fp8(v[4 * c].z * W8_SCALE, v[4 * c + 1].z * W8_SCALE, v[4 * c + 2].z * W8_SCALE, v[4 * c + 3].z * W8_SCALE);
        q3[c] = pk4_fp8(v[4 * c].w * W8_SCALE, v[4 * c + 1].w * W8_SCALE, v[4 * c + 2].w * W8_SCALE, v[4 * c + 3].w * W8_SCALE);
    }
    unsigned char* tp = smem + (lane * 4) * RS + w * 16;
    *(i32x4*)(tp) = q0; *(i32x4*)(tp + RS) = q1; *(i32x4*)(tp + 2 * RS) = q2; *(i32x4*)(tp + 3 * RS) = q3;
    __syncthreads();
    unsigned char* d = (unsigned char*)j.dst + (size_t)bb * j.dbs;
#pragma unroll
    for (int i = 0; i < 4; ++i) {
        const int c = tid + 256 * i, n = c >> 2, kc = c & 3;
        *(i32x4*)(d + (size_t)cvt_rowmap(j.mode, nt * 256 + n) * j.ldd + kt * 64 + kc * 16) = *(const i32x4*)(smem + n * RS + kc * 16);
    }
}
__constant__ const int CVT_TILES[10] = {224, 80, 12, 8, 128, 256, 64, 32, 32, 32};
constexpr int CVT_PER_LAYER = 224 + 80 + 12 + 8 + 128 + 256 + 64 + 32 + 32 + 32;
DEVI CvtJob get_job(const Params& p, int l, int k) {
    CvtJob j; j.ks = nullptr; j.batch = 1; j.sbs = 0; j.dbs = 0; j.mode = 0; j.n0 = 0; j.wide = 1;
    switch (k) {
    case 0: j.src = p.in[I_WIN] + (size_t)l * 1024 * 3744; j.dst = WB(W_IN + (size_t)l * 3840 * 1024); j.K = 1024; j.N = 3584; j.lds = 3744; j.ldd = 1024; j.mode = 1; break;
    case 1: j.src = p.in[I_WIN] + (size_t)l * 1024 * 3744; j.dst = WB(W_IN + (size_t)l * 3840 * 1024); j.K = 1024; j.N = 160; j.lds = 3744; j.n0 = 3584; j.ldd = 1024; j.mode = 1; j.wide = 0; break;
    case 2: j.src = p.in[I_WUQ] + (size_t)l * 256 * 768; j.dst = WB(W_UQ + (size_t)l * 768 * 256); j.K = 256; j.N = 768; j.lds = 768; j.ldd = 256; j.ks = p.in[I_MQN] + l * 256; j.mode = 2; break;
    case 3: j.src = p.in[I_WUKV] + (size_t)l * 128 * 1024; j.dst = WB(W_UKV + (size_t)l * 1024 * 128); j.K = 128; j.N = 1024; j.lds = 1024; j.ldd = 128; j.ks = p.in[I_MKVN] + l * 128; break;
    case 4: j.src = p.in[I_WBR] + (size_t)l * 4 * 512 * 1024; j.dst = WB(W_BR + (size_t)l * 4 * 1024 * 512); j.K = 512; j.N = 1024; j.lds = 1024; j.ldd = 512; j.batch = 4; j.sbs = 512 * 1024; j.dbs = 1024 * 512; break;
    case 5: j.src = p.in[I_WMG] + (size_t)l * 1024 * 4096; j.dst = WB(W_MG + (size_t)l * 4096 * 1024); j.K = 1024; j.N = 4096; j.lds = 4096; j.ldd = 1024; break;
    case 6: j.src = p.in[I_WOUT] + (size_t)l * 1024 * 1024; j.dst = WB(W_OUT + (size_t)l * 1024 * 1024); j.K = 1024; j.N = 1024; j.lds = 1024; j.ldd = 1024; break;
    case 7: j.src = p.in[I_LWA] + (size_t)l * 16 * 4096; j.dst = WB(W_LRU + (size_t)l * 16 * 8192); j.K = 64; j.N = 64; j.lds = 64; j.ldd = 64; j.batch = 16; j.sbs = 4096; j.dbs = 8192; j.wide = 0; break;
    case 8: j.src = p.in[I_LWX] + (size_t)l * 16 * 4096; j.dst = WB(W_LRU + (size_t)l * 16 * 8192 + 4096); j.K = 64; j.N = 64; j.lds = 64; j.ldd = 64; j.batch = 16; j.sbs = 4096; j.dbs = 8192; j.wide = 0; break;
    default: j.src = p.in[I_RW]; j.dst = WB(W_RT); j.K = 1024; j.N = 64; j.lds = 64; j.ldd = 1024; j.wide = 0; break;
    }
    return j;
}
DEVI CvtJob get_moe_job(const Params& p, int l, int k) {
    CvtJob j; j.ks = nullptr; j.batch = 64; j.sbs = 262144; j.n0 = 0; j.wide = 1;
    if (k == 0) { j.src = p.in[I_W1] + (size_t)l * 64 * 262144; j.dst = MWB(MW_13);     j.K = 1024; j.N = 256; j.lds = 256; j.ldd = 1024; j.dbs = 512 * 1024; j.mode = 3; }
    else if (k == 1) { j.src = p.in[I_W3] + (size_t)l * 64 * 262144; j.dst = (bf16_t*)((unsigned char*)MWB(MW_13) + 64 * 1024); j.K = 1024; j.N = 256; j.lds = 256; j.ldd = 1024; j.dbs = 512 * 1024; j.mode = 3; }
    else { j.src = p.in[I_W2] + (size_t)l * 64 * 262144; j.dst = MWB(MW_2); j.K = 256; j.N = 1024; j.lds = 1024; j.ldd = 256; j.dbs = 262144; j.mode = 0; }
    return j;
}

struct AOp { const bf16_t* base; int ld; int row0; const int* ridx; };
DEVI const bf16_t* arow(const AOp& a, int i) {
    int r = a.ridx ? a.ridx[i] : a.row0 + i;
    return a.base + (size_t)r * a.ld;
}

#if NAIVE_GEMM
template <int BN>
DEVI void gemm_core(f32x4 (&acc)[4][BN / 32], const AOp& A, const bf16_t* B, int ldb, int K, unsigned char* smem) {
    constexpr int NI = BN / 32;
    const int tid = TIDX, lane = tid & 63, wid = tid >> 6, wr = wid >> 1, wc = wid & 1;
    for (int k0 = 0; k0 < K; k0 += 8) {
        bf16x8 bv[NI];
#pragma unroll
        for (int ni = 0; ni < NI; ++ni) bv[ni] = *(const bf16x8*)(B + (size_t)(wc * (BN / 2) + ni * 16 + (lane & 15)) * ldb + k0);
#pragma unroll
        for (int mi = 0; mi < 4; ++mi)
#pragma unroll
            for (int j = 0; j < 4; ++j) {
                bf16x8 av = *(const bf16x8*)(arow(A, wr * 64 + mi * 16 + (lane >> 4) * 4 + j) + k0);
#pragma unroll
                for (int ni = 0; ni < NI; ++ni) {
                    float s = 0.f;
#pragma unroll
                    for (int e = 0; e < 8; ++e) s += bf2f((bf16_t)av[e]) * bf2f((bf16_t)bv[ni][e]);
                    acc[mi][ni][j] += s;
                }
            }
    }
}
#else
#define GAS __attribute__((address_space(1)))
template <int BN, bool GATHER = false>
DEVI void gemm_core(f32x4 (&acc)[4][BN / 32], const AOp& A, const bf16_t* B, int ldb, int K, unsigned char* smem) {
    constexpr int NI = BN / 32;
    constexpr int NBL = BN / 32;
    constexpr int STG = 32768;
    const int tid = TIDX, lane = tid & 63, wid = tid >> 6, wr = wid >> 1, wc = wid & 1;
    const int lr = tid >> 3;
    const int kc = (tid & 7) ^ (lr & 7);
    const bf16_t* ap[GATHER ? 4 : 1];
    if (GATHER) {
#pragma unroll
        for (int i = 0; i < (GATHER ? 4 : 1); ++i) ap[i] = arow(A, lr + 32 * i) + kc * 8;
    } else ap[0] = A.base + (size_t)(A.row0 + lr) * A.ld + kc * 8;
    const size_t astep = (size_t)32 * A.ld;
    const bf16_t* bp = B + (size_t)lr * ldb + kc * 8;
    const size_t bstep = (size_t)32 * ldb;
    LAS unsigned char* lA = (LAS unsigned char*)smem + tid * 16;
    LAS unsigned char* lB = lA + 16384;
    const int nk = K >> 6;
    const int arow_off = (wr * 64 + (lane & 15)) * 128;
    const int brow_off = 16384 + (wc * (BN / 2) + (lane & 15)) * 128;
    __syncthreads();
#pragma unroll
    for (int i = 0; i < 4; ++i) __builtin_amdgcn_global_load_lds((const GAS unsigned*)(GATHER ? ap[GATHER ? i : 0] : ap[0] + i * astep), (LAS unsigned*)(lA + i * 4096), 16, 0, 0);
#pragma unroll
    for (int i = 0; i < NBL; ++i) __builtin_amdgcn_global_load_lds((const GAS unsigned*)(bp + i * bstep), (LAS unsigned*)(lB + i * 4096), 16, 0, 0);
    for (int kt = 0; kt < nk; ++kt) {
        __syncthreads();
        if (kt + 1 < nk) {
            const int ko = (kt + 1) * 64;
            const int so = ((kt + 1) & 1) * STG;
#pragma unroll
            for (int i = 0; i < 4; ++i) __builtin_amdgcn_global_load_lds((const GAS unsigned*)((GATHER ? ap[GATHER ? i : 0] : ap[0] + i * astep) + ko), (LAS unsigned*)(lA + so + i * 4096), 16, 0, 0);
#pragma unroll
            for (int i = 0; i < NBL; ++i) __builtin_amdgcn_global_load_lds((const GAS unsigned*)(bp + i * bstep + ko), (LAS unsigned*)(lB + so + i * 4096), 16, 0, 0);
        }
        const unsigned char* cs = smem + (kt & 1) * STG;
#pragma unroll
        for (int ks = 0; ks < 2; ++ks) {
            const int pch = ((ks * 4 + (lane >> 4)) ^ (lane & 7)) << 4;
            bf16x8 bfr[NI];
#pragma unroll
            for (int ni = 0; ni < NI; ++ni) bfr[ni] = *(const bf16x8*)(cs + brow_off + ni * 2048 + pch);
#pragma unroll
            for (int mi = 0; mi < 4; mi += 2) {
                const bf16x8 a0 = *(const bf16x8*)(cs + arow_off + mi * 2048 + pch);
                const bf16x8 a1 = *(const bf16x8*)(cs + arow_off + (mi + 1) * 2048 + pch);
#pragma unroll
                for (int ni = 0; ni < NI; ++ni) acc[mi][ni] = __builtin_amdgcn_mfma_f32_16x16x32_bf16(a0, bfr[ni], acc[mi][ni], 0, 0, 0);
#pragma unroll
                for (int ni = 0; ni < NI; ++ni) acc[mi + 1][ni] = __builtin_amdgcn_mfma_f32_16x16x32_bf16(a1, bfr[ni], acc[mi + 1][ni], 0, 0, 0);
            }
        }
    }
}
#endif

template <bool GATHER = false>
DEVI void gemm_core_fp8(f32x4 (&acc)[4][4], const unsigned char* Ab, size_t lda, int row0, const unsigned char* Bb, size_t ldb, int K, unsigned char* smem, const int* ridx = nullptr) {
    constexpr int STG = 32768;
    const int tid = TIDX, lane = tid & 63, wid = tid >> 6, wr = wid >> 1, wc = wid & 1;
    const int lr = tid >> 3;
    const int kc = (tid & 7) ^ (lr & 7);
    const unsigned char* ap[GATHER ? 4 : 1];
    if (GATHER) {
#pragma unroll
        for (int i = 0; i < (GATHER ? 4 : 1); ++i) ap[i] = Ab + (size_t)ridx[lr + 32 * i] * lda + kc * 16;
    } else ap[0] = Ab + (size_t)(row0 + lr) * lda + kc * 16;
    const size_t astep = GATHER ? 0 : 32 * lda;
    const unsigned char* bp = Bb + (size_t)lr * ldb + kc * 16;
    const size_t bstep = 32 * ldb;
    LAS unsigned char* lA = (LAS unsigned char*)smem + tid * 16;
    LAS unsigned char* lB = lA + 16384;
    const int nk = K >> 7;
    const int arow_off = (wr * 64 + (lane & 15)) * 128;
    const int brow_off = 16384 + (wc * 64 + (lane & 15)) * 128;
    const int c0 = ((2 * (lane >> 4)) ^ (lane & 7)) << 4, c1 = ((2 * (lane >> 4) + 1) ^ (lane & 7)) << 4;
    __syncthreads();
#pragma unroll
    for (int i = 0; i < 4; ++i) __builtin_amdgcn_global_load_lds((const GAS unsigned*)(ap[GATHER ? i : 0] + i * astep), (LAS unsigned*)(lA + i * 4096), 16, 0, 0);
#pragma unroll
    for (int i = 0; i < 4; ++i) __builtin_amdgcn_global_load_lds((const GAS unsigned*)(bp + i * bstep), (LAS unsigned*)(lB + i * 4096), 16, 0, 0);
#pragma unroll 1
    for (int kt = 0; kt < nk; ++kt) {
        __syncthreads();
        if (kt + 1 < nk) {
            const int ko = (kt + 1) * 128;
            const int so = ((kt + 1) & 1) * STG;
#pragma unroll
            for (int i = 0; i < 4; ++i) __builtin_amdgcn_global_load_lds((const GAS unsigned*)(ap[GATHER ? i : 0] + i * astep + ko), (LAS unsigned*)(lA + so + i * 4096), 16, 0, 0);
#pragma unroll
            for (int i = 0; i < 4; ++i) __builtin_amdgcn_global_load_lds((const GAS unsigned*)(bp + i * bstep + ko), (LAS unsigned*)(lB + so + i * 4096), 16, 0, 0);
        }
        const unsigned char* cs = smem + (kt & 1) * STG;
        i32x8 bfr[4];
#pragma unroll
        for (int ni = 0; ni < 4; ++ni) {
            const i32x4 lo = *(const i32x4*)(cs + brow_off + ni * 2048 + c0), hi = *(const i32x4*)(cs + brow_off + ni * 2048 + c1);
            bfr[ni] = i32x8{lo[0], lo[1], lo[2], lo[3], hi[0], hi[1], hi[2], hi[3]};
        }
#pragma unroll
        for (int mi = 0; mi < 4; ++mi) {
            const i32x4 lo = *(const i32x4*)(cs + arow_off + mi * 2048 + c0), hi = *(const i32x4*)(cs + arow_off + mi * 2048 + c1);
            const i32x8 af = i32x8{lo[0], lo[1], lo[2], lo[3], hi[0], hi[1], hi[2], hi[3]};
#pragma unroll
            for (int ni = 0; ni < 4; ++ni)
                acc[mi][ni] = __builtin_amdgcn_mfma_scale_f32_16x16x128_f8f6f4(af, bfr[ni], acc[mi][ni], 0, 0, 0, 0x7f7f7f7f, 0, 0x7a7a7a7a);
        }
    }
}

template <int BN>
DEVI void acc_zero(f32x4 (&acc)[4][BN / 32]) {
#pragma unroll
    for (int mi = 0; mi < 4; ++mi)
#pragma unroll
        for (int ni = 0; ni < BN / 32; ++ni) acc[mi][ni] = f32x4{0.f, 0.f, 0.f, 0.f};
}
template <int BN>
DEVI void acc_to_ct(const f32x4 (&acc)[4][BN / 32], bf16_t* ct) {
    const int tid = TIDX, lane = tid & 63, wid = tid >> 6, wr = wid >> 1, wc = wid & 1;
#pragma unroll
    for (int mi = 0; mi < 4; ++mi)
#pragma unroll
        for (int ni = 0; ni < BN / 32; ++ni)
#pragma unroll
            for (int j = 0; j < 4; ++j)
                ct[(wr * 64 + mi * 16 + (lane >> 4) * 4 + j) * CT_LD + wc * (BN / 2) + ni * 16 + (lane & 15)] = f2bf(acc[mi][ni][j]);
}

template <int NC>
DEVI void ep_store_rows(const bf16_t* ct, int c0, bf16_t* dst, int ldd, int row0) {
    constexpr int CPR = NC / 8;
    for (int c = TIDX; c < 128 * CPR; c += 256) {
        int i = c / CPR, jc = c % CPR;
        *(bf16x8*)(dst + (size_t)(row0 + i) * ldd + jc * 8) = *(const bf16x8*)(ct + i * CT_LD + c0 + jc * 8);
    }
}
DEVI void ep_store_T(const bf16_t* ct, int c0, int nc, bf16_t* dstT, int ldT, int t0) {
    for (int c = TIDX; c < nc * 16; c += 256) {
        int j = c >> 4, ic = c & 15;
        bf16x8 v;
#pragma unroll
        for (int e = 0; e < 8; ++e) v[e] = (short)ct[(ic * 8 + e) * CT_LD + c0 + j];
        *(bf16x8*)(dstT + (size_t)j * ldT + t0 + ic * 8) = v;
    }
}
DEVI void ep_rope64(bf16_t* ct, const float* gain, float scale, bool lat, int pos0, const float* cs64) {
    const int row = TIDX >> 1, half = TIDX & 1;
    bf16_t* pr = ct + row * CT_LD + half * 64;
    float v[64];
#pragma unroll
    for (int c = 0; c < 8; ++c) {
        bf16x8 t = *(const bf16x8*)(pr + c * 8);
#pragma unroll
        for (int e = 0; e < 8; ++e) v[c * 8 + e] = bf2f((bf16_t)t[e]);
    }
    if (gain) {
        float ss = 0.f;
#pragma unroll
        for (int d = 0; d < 64; ++d) ss += v[d] * v[d];
        float rstd = rsqrtf(ss * (1.f / 64.f) + EPSV);
#pragma unroll
        for (int d = 0; d < 64; ++d) v[d] = v[d] * rstd * gain[d];
    }
    if (lat) {
        const float* cs = cs64 + (size_t)(pos0 + row) * 64;
#pragma unroll
        for (int i = 0; i < 16; ++i) {
            float a = v[i], b = v[i + 16], c = cs[i], s = cs[32 + i];
            v[i] = a * c - b * s; v[i + 16] = b * c + a * s;
            a = v[32 + i]; b = v[48 + i]; c = cs[16 + i]; s = cs[48 + i];
            v[32 + i] = a * c - b * s; v[48 + i] = b * c + a * s;
        }
    }
#pragma unroll
    for (int c = 0; c < 8; ++c) {
        bf16x8 t;
#pragma unroll
        for (int e = 0; e < 8; ++e) t[e] = (short)f2bf(v[c * 8 + e] * scale);
        *(bf16x8*)(pr + c * 8) = t;
    }
}
DEVI void ep_rope32(bf16_t* ct, int ngroups, const float* rstd, float scale, bool lat, int pos0, const float* cs32) {
    const int row = TIDX >> 1, half = TIDX & 1;
    const float rs = (rstd ? rstd[row] : 1.f) * scale;
#pragma unroll
    for (int gg = 0; gg < 2; ++gg) {
        const int g = half * 2 + gg;
        if (g < ngroups) {
            bf16_t* pr = ct + row * CT_LD + g * 32;
            float v[32];
#pragma unroll
            for (int c = 0; c < 4; ++c) {
                bf16x8 t = *(const bf16x8*)(pr + c * 8);
#pragma unroll
                for (int e = 0; e < 8; ++e) v[c * 8 + e] = bf2f((bf16_t)t[e]);
            }
            if (lat) {
                const float* cs = cs32 + (size_t)(pos0 + row) * 32;
#pragma unroll
                for (int i = 0; i < 8; ++i) {
                    float a = v[i], b = v[i + 8], c = cs[i], s = cs[16 + i];
                    v[i] = a * c - b * s; v[i + 8] = b * c + a * s;
                    a = v[16 + i]; b = v[24 + i]; c = cs[8 + i]; s = cs[24 + i];
                    v[16 + i] = a * c - b * s; v[24 + i] = b * c + a * s;
                }
            }
#pragma unroll
            for (int c = 0; c < 4; ++c) {
                bf16x8 t;
#pragma unroll
                for (int e = 0; e < 8; ++e) t[e] = (short)f2bf(v[c * 8 + e] * rs);
                *(bf16x8*)(pr + c * 8) = t;
            }
        }
    }
}
DEVI void ep_scale_rows(bf16_t* ct, int c0, int nc, const float* rstd, float scale) {
    const int cpr = nc / 8;
    for (int c = TIDX; c < 128 * cpr; c += 256) {
        int i = c / cpr, jc = c % cpr;
        bf16_t* pr = ct + i * CT_LD + c0 + jc * 8;
        bf16x8 t = *(const bf16x8*)pr;
        float rs = rstd[i] * scale;
#pragma unroll
        for (int e = 0; e < 8; ++e) t[e] = (short)f2bf(bf2f((bf16_t)t[e]) * rs);
        *(bf16x8*)pr = t;
    }
}
DEVI void ep_rstd(const bf16_t* A, int ld, int row0, int K, float* rstd) {
    const int row = TIDX >> 1, half = TIDX & 1;
    const bf16_t* pr = A + (size_t)(row0 + row) * ld + half * (K / 2);
    float ss = 0.f;
    for (int c = 0; c < K / 16; ++c) {
        bf16x8 t = *(const bf16x8*)(pr + c * 8);
#pragma unroll
        for (int e = 0; e < 8; ++e) { float f = bf2f((bf16_t)t[e]); ss += f * f; }
    }
    ss += __shfl_xor(ss, 1);
    if (half == 0) rstd[row] = rsqrtf(ss / (float)K + EPSV);
}


struct GrpInfo { int xcd, j, per, ngrp; };
DEVI GrpInfo grp_info(const Params& p) {
    const unsigned* pv = (const unsigned*)(p.ws + OFF_PRIV + (size_t)BIDX * 1024 + 896);
    GrpInfo g;
    g.xcd = (int)__hip_atomic_load(pv + 2, __ATOMIC_RELAXED, __HIP_MEMORY_SCOPE_AGENT);
    g.j = (int)__hip_atomic_load(pv + 3, __ATOMIC_RELAXED, __HIP_MEMORY_SCOPE_AGENT);
    g.per = (int)__hip_atomic_load((const unsigned*)(p.ws + OFF_BAR) + 256 + 64 * g.xcd, __ATOMIC_RELAXED, __HIP_MEMORY_SCOPE_AGENT);
    g.ngrp = 8;
    if (g.xcd >= 8 || g.per <= 0) { g.xcd = 0; g.j = BIDX; g.per = gridDim.x; g.ngrp = 1; }
    return g;
}
DEVI bool super_tile(const GrpInfo& gi, int it, int NMT, int NNT, int SM, int SN, int& mt, int& nt) {
    const int ST = SM * SN, passes = (ST + gi.per - 1) / gi.per;
    const int nsn = (NNT + SN - 1) / SN, nsm = (NMT + SM - 1) / SM;
    const int s = (it / passes) * gi.ngrp + gi.xcd;
    if (s >= nsm * nsn) return false;
    const int idx = (it % passes) * gi.per + gi.j;
    mt = -1; nt = 0;
    if (idx < ST) {
        const int m = (s / nsn) * SM + idx / SN, n = (s % nsn) * SN + idx % SN;
        if (m < NMT && n < NNT) { mt = m; nt = n; }
    }
    return true;
}

DEVI void phase0(const Params& p, unsigned char* smem) {
    const int tid = TIDX, lane = tid & 63, w = tid >> 6;
    const int NG = 192, NCV = 2 * CVT_PER_LAYER, NR = 192;
    const int ntask = NG + NCV + NR + 1;
    for (int task = BIDX; task < ntask; task += gridDim.x) {
        if (task < NG) {
            const int l = task / 96, n0 = (task % 96) * 64;
            float* sv = (float*)smem;
            float* red = (float*)smem;
            for (int idx = lane; idx < 9 * 256; idx += 64) {
                int bi = idx >> 8, kk = idx & 255, k = 256 * w + kk;
                float c = bi < 8 ? p.in[I_C][bi * 1024 + k] : p.in[I_CCTX][k];
                sv[(w * 9 + bi) * 256 + kk] = siluf_(c);
            }
            __syncthreads();
            const int ksub = lane >> 4, c4 = (lane & 15) * 4;
            float acc[9][4];
#pragma unroll
            for (int bi = 0; bi < 9; ++bi) { acc[bi][0] = 0.f; acc[bi][1] = 0.f; acc[bi][2] = 0.f; acc[bi][3] = 0.f; }
            const float* wp = p.in[I_ADAW] + (size_t)l * 1024 * 6144 + (size_t)(256 * w + ksub) * 6144 + n0 + c4;
#pragma unroll 8
            for (int i = 0; i < 64; ++i) {
                const float4 wv = *(const float4*)(wp + (size_t)(4 * i) * 6144);
#pragma unroll
                for (int bi = 0; bi < 9; ++bi) {
                    const float sx = sv[(w * 9 + bi) * 256 + 4 * i + ksub];
                    acc[bi][0] += sx * wv.x; acc[bi][1] += sx * wv.y; acc[bi][2] += sx * wv.z; acc[bi][3] += sx * wv.w;
                }
            }
            __syncthreads();
#pragma unroll
            for (int bi = 0; bi < 9; ++bi)
                *(float4*)(red + (((w * 4 + ksub) * 9 + bi) * 64) + c4) = make_float4(acc[bi][0], acc[bi][1], acc[bi][2], acc[bi][3]);
            __syncthreads();
            for (int idx = tid; idx < 9 * 64; idx += 256) {
                int bi = idx >> 6, c = idx & 63;
                float sacc = p.in[I_ADAB][l * 6144 + n0 + c];
#pragma unroll
                for (int q = 0; q < 16; ++q) sacc += red[((q * 9 + bi) * 64) + c];
                WSF(OFF_MOD)[(size_t)(l * 9 + bi) * 6144 + n0 + c] = sacc;
            }
            __syncthreads();
        } else if (task < NG + NCV) {
            int t = task - NG;
            int l = t / CVT_PER_LAYER; t %= CVT_PER_LAYER;
            int k = 0;
            while (t >= CVT_TILES[k]) { t -= CVT_TILES[k]; ++k; }
            CvtJob j = get_job(p, l, k);
            if (k == 5) cvt_tile256_fp8(j, t, smem); else if (j.wide) cvt_tile256(j, t, smem); else cvt_tile(j, t, (float*)smem);
        } else if (task < NG + NCV + NR) {
            const int idx = (task - NG - NCV) * 256 + tid;
            const int pos = idx / 24, f = idx % 24;
            const float rp = (float)(pos >> 6), cp = (float)(pos & 63);
            if (f < 16) {
                const float inv = powf(10000.f, -(float)(2 * f) / 32.f);
                const float ar = rp * inv, ac = cp * inv;
                float* t64 = WSF(OFF_R64) + (size_t)pos * 64;
                t64[f] = cosf(ar); t64[16 + f] = cosf(ac); t64[32 + f] = sinf(ar); t64[48 + f] = sinf(ac);
            } else {
                const int i = f - 16;
                const float inv = powf(10000.f, -(float)(2 * i) / 16.f);
                const float ar = rp * inv, ac = cp * inv;
                float* t32 = WSF(OFF_R32) + (size_t)pos * 32;
                t32[i] = cosf(ar); t32[8 + i] = cosf(ac); t32[16 + i] = sinf(ar); t32[24 + i] = sinf(ac);
            }
        } else {
            for (int i = tid; i < 4096; i += 256) WSI(OFF_CNT)[i] = 0;
            for (int l = 0; l < 2; ++l) {
                unsigned* z = (unsigned*)WB(W_IN + (size_t)l * 3840 * 1024 + (size_t)3744 * 1024);
                for (int i = tid; i < 96 * 1024 / 2; i += 256) z[i] = 0u;
            }
        }
    }
}

struct MoeTab {
    int* base;
    DEVI int cnt(int e) const { return __hip_atomic_load(base + e, __ATOMIC_RELAXED, __HIP_MEMORY_SCOPE_AGENT); }
    DEVI int tp(int e) const { return __hip_atomic_load(base + 64 + e, __ATOMIC_RELAXED, __HIP_MEMORY_SCOPE_AGENT); }
    DEVI int seg(int e) const { return __hip_atomic_load(base + 136 + e, __ATOMIC_RELAXED, __HIP_MEMORY_SCOPE_AGENT); }
};
DEVI MoeTab moe_tables(const Params& p, int l, unsigned char* smem) {
    MoeTab t; t.base = (int*)(p.ws + OFF_PRIV + (size_t)BIDX * 1024);
    __syncthreads();
    if (TIDX == 0) {
        int a = 0, sg = 0;
        for (int e = 0; e < 64; ++e) {
            const int c = WSI(OFF_CNT)[l * 64 + e];
            __hip_atomic_store(t.base + e, c, __ATOMIC_RELAXED, __HIP_MEMORY_SCOPE_AGENT);
            __hip_atomic_store(t.base + 64 + e, a, __ATOMIC_RELAXED, __HIP_MEMORY_SCOPE_AGENT);
            __hip_atomic_store(t.base + 136 + e, sg, __ATOMIC_RELAXED, __HIP_MEMORY_SCOPE_AGENT);
            const int nt = (c + 127) >> 7;
            a += nt; sg += nt * 128;
        }
        __hip_atomic_store(t.base + 64 + 64, a, __ATOMIC_RELAXED, __HIP_MEMORY_SCOPE_AGENT);
        __hip_atomic_store(t.base + 136 + 64, sg, __ATOMIC_RELAXED, __HIP_MEMORY_SCOPE_AGENT);
    }
    asm volatile("s_waitcnt vmcnt(0)" ::: "memory");
    __syncthreads();
    return t;
}
struct Rec { int e0, p0, e1, p1; float w0, w1; int pad0, pad1; };

DEVI void phase_norm1(const Params& p, int l, int mode, unsigned char* smem) {
    const int lane = TIDX & 63, w = TIDX >> 6;
    MoeTab mt;
    const bool comb = (mode == 0 && l > 0) || mode == 1;
    const int lp = mode == 1 ? 1 : l - 1;
    int segv = 0;
    if (comb) { mt = moe_tables(p, lp, smem); segv = mt.seg(lane); }
    const float* g1 = mode == 1 ? p.in[I_FN] : (mode == 2 ? p.in[I_N2G] + l * 1024 : p.in[I_N1G] + l * 1024);
    const bool latonly = (mode == 1) || (mode == 2 && l == 1);
    const int nrows = latonly ? NBT * SEQL : TT;
    const int stride = gridDim.x * 4;
    int ri = BIDX * 4 + w;
    float4 xn[4];
    Rec rcn; rcn.e0 = 0; rcn.e1 = 0; rcn.p0 = 0; rcn.p1 = 0; rcn.w0 = 0.f; rcn.w1 = 0.f;
    auto rowof = [&](int r) { return latonly ? (r >> 11) * TPB + CTXL + (r & 2047) : r; };
    auto srcof = [&](int row) -> const float* {
        if (mode == 0 && l == 0) {
            const int b = row / TPB, t = row % TPB;
            return t < CTXL ? p.in[I_CTX] + ((size_t)b * CTXL + t) * DM : p.in[I_X] + ((size_t)b * SEQL + (t - CTXL)) * DM;
        }
        return XCUR + (size_t)row * DM;
    };
    if (ri < nrows) {
        const float* src = srcof(rowof(ri));
#pragma unroll
        for (int i = 0; i < 4; ++i) xn[i] = *(const float4*)(src + i * 256 + lane * 4);
        if (comb) rcn = ((const Rec*)(p.ws + OFF_REC))[rowof(ri)];
    }
    for (; ri < nrows; ri += stride) {
        const int row = rowof(ri);
        const int b = row / TPB, t = row % TPB;
        const bool isctx = t < CTXL;
        const int bi = isctx ? 8 : b;
        float v[16];
#pragma unroll
        for (int i = 0; i < 4; ++i) { v[i * 4] = xn[i].x; v[i * 4 + 1] = xn[i].y; v[i * 4 + 2] = xn[i].z; v[i * 4 + 3] = xn[i].w; }
        const Rec rc = rcn;
        if (ri + stride < nrows) {
            if (comb) rcn = ((const Rec*)(p.ws + OFF_REC))[rowof(ri + stride)];
            const float* src = srcof(rowof(ri + stride));
#pragma unroll
            for (int i = 0; i < 4; ++i) xn[i] = *(const float4*)(src + i * 256 + lane * 4);
        }
        if (comb) {
            float* xr = XCUR + (size_t)row * DM;
            const bf16_t* y0 = DB(D_YS) + (size_t)(__shfl(segv, rc.e0) + rc.p0) * 1024;
            const bf16_t* y1 = DB(D_YS) + (size_t)(__shfl(segv, rc.e1) + rc.p1) * 1024;
            const float* gate = WSF(OFF_MOD) + (size_t)(lp * 9 + bi) * 6144 + 5 * 1024;
#pragma unroll
            for (int i = 0; i < 4; ++i) {
                const int c = i * 256 + lane * 4;
                float4 g4 = *(const float4*)(gate + c);
                uint2 a = *(const uint2*)(y0 + c), bb = *(const uint2*)(y1 + c);
                float f0 = rc.w0 * __uint_as_float(a.x << 16) + rc.w1 * __uint_as_float(bb.x << 16);
                float f1 = rc.w0 * __uint_as_float(a.x & 0xffff0000u) + rc.w1 * __uint_as_float(bb.x & 0xffff0000u);
                float f2 = rc.w0 * __uint_as_float(a.y << 16) + rc.w1 * __uint_as_float(bb.y << 16);
                float f3 = rc.w0 * __uint_as_float(a.y & 0xffff0000u) + rc.w1 * __uint_as_float(bb.y & 0xffff0000u);
                v[i * 4] += g4.x * f0; v[i * 4 + 1] += g4.y * f1; v[i * 4 + 2] += g4.z * f2; v[i * 4 + 3] += g4.w * f3;
                if (mode == 0) *(float4*)(xr + c) = make_float4(v[i * 4], v[i * 4 + 1], v[i * 4 + 2], v[i * 4 + 3]);
            }
        }
        float ss = 0.f;
#pragma unroll
        for (int i = 0; i < 16; ++i) ss += v[i] * v[i];
        ss = wave_sum(ss);
        const float rstd = rsqrtf(ss * (1.f / 1024.f) + EPSV);
        if (mode == 1) {
            float* o = p.out + ((size_t)b * SEQL + (t - CTXL)) * DM;
#pragma unroll
            for (int i = 0; i < 4; ++i) {
                const int c = i * 256 + lane * 4;
                float4 g4 = *(const float4*)(g1 + c);
                float4 r4;
                r4.x = v[i * 4] * rstd * g4.x; r4.y = v[i * 4 + 1] * rstd * g4.y; r4.z = v[i * 4 + 2] * rstd * g4.z; r4.w = v[i * 4 + 3] * rstd * g4.w;
                *(float4*)(o + c) = r4;
            }
        } else {
            const float* md = WSF(OFF_MOD) + (size_t)(l * 9 + bi) * 6144 + (mode == 2 ? 3 * 1024 : 0);
            bf16_t* ho = HB + (size_t)row * DM;
#pragma unroll
            for (int i = 0; i < 4; ++i) {
                const int c = i * 256 + lane * 4;
                float4 g4 = *(const float4*)(g1 + c);
                float4 sh = *(const float4*)(md + c);
                float4 sc = *(const float4*)(md + 1024 + c);
                float h0 = v[i * 4] * rstd * g4.x * (1.f + sc.x) + sh.x;
                float h1 = v[i * 4 + 1] * rstd * g4.y * (1.f + sc.y) + sh.y;
                float h2 = v[i * 4 + 2] * rstd * g4.z * (1.f + sc.z) + sh.z;
                float h3 = v[i * 4 + 3] * rstd * g4.w * (1.f + sc.w) + sh.w;
                uint2 o2;
                o2.x = (unsigned)f2bf(h0) | ((unsigned)f2bf(h1) << 16);
                o2.y = (unsigned)f2bf(h2) | ((unsigned)f2bf(h3) << 16);
                *(uint2*)(ho + c) = o2;
                if (mode == 2) *(int*)((unsigned char*)CB(0) + (size_t)row * 1024 + c) = pk4_fp8(h0, h1, h2, h3);
            }
        }
    }
}

DEVI int fetch_task(int* ctr, unsigned char* smem) {
    __syncthreads();
    if (TIDX == 0) *(volatile int*)smem = atomicAdd(ctr, 1);
    __syncthreads();
    return *(volatile int*)smem;
}
DEVI void dep_signal(int* cnt) {
    asm volatile("s_waitcnt vmcnt(0)" ::: "memory");
    __syncthreads();
    if (TIDX == 0) {
        __builtin_amdgcn_fence(__ATOMIC_RELEASE, "agent");
        asm volatile("s_waitcnt vmcnt(0)" ::: "memory");
        __hip_atomic_fetch_add(cnt, 1, __ATOMIC_RELAXED, __HIP_MEMORY_SCOPE_AGENT);
    }
}
DEVI void dep_wait(int* cnt, int need) {
    if (TIDX == 0) {
        while (__hip_atomic_load(cnt, __ATOMIC_RELAXED, __HIP_MEMORY_SCOPE_AGENT) < need) __builtin_amdgcn_s_sleep(2);
        __builtin_amdgcn_fence(__ATOMIC_ACQUIRE, "agent");
        asm volatile("s_waitcnt vmcnt(0)" ::: "memory");
    }
    __syncthreads();
}

DEVI void phase_win(const Params& p, int l, unsigned char* smem) {
    bf16_t* ct = (bf16_t*)smem;
    const float* cs64 = WSF(OFF_R64);
    const float* cs32 = WSF(OFF_R32);
    int* ctr = WSI(OFF_CNT) + 134 + l;
    for (;;) {
        const int task = fetch_task(ctr, smem);
        if (task >= 144 * 30) break;
        const int mt = task / 30, nt = task % 30;
        const int row0 = mt * 128, b = mt / 18, t0 = (mt % 18) * 128;
        const bool lat = (mt % 18) >= 2;
        const int pos0 = t0 - CTXL;
        f32x4 acc[4][4];
        acc_zero<128>(acc);
        AOp A{HB, 1024, row0, nullptr};
        T_BEGIN(3);
        gemm_core<128>(acc, A, WB(W_IN + (size_t)l * 3840 * 1024 + (size_t)nt * 128 * 1024), 1024, 1024, smem);
        __syncthreads();
        T_END(3, l == 0 && BIDX == 8);
        T_BEGIN(4);
        acc_to_ct<128>(acc, ct);
        __syncthreads();
        if (nt < 2) ep_store_rows<128>(ct, 0, CB(C_CQ) + nt * 128, 256, row0);
        else if (nt == 2) ep_store_rows<128>(ct, 0, CB(C_CKV), 128, row0);
        else if (nt < 5) { ep_rope64(ct, nullptr, 1.f, lat, pos0, cs64); __syncthreads(); ep_store_rows<128>(ct, 0, CB(C_RQ) + (nt - 3) * 128, 256, row0); }
        else if (nt < 7) {
            ep_rope64(ct, nullptr, 0.125f, lat, pos0, cs64); __syncthreads();
            ep_store_rows<128>(ct, 0, CB(C_RK) + (nt - 5) * 128, 256, row0);
            ep_store_T(ct, 0, 128, CB(C_RKT) + ((size_t)b * 256 + (nt - 5) * 128) * TPB, TPB, t0);
        }
        else if (nt < 11) ep_store_T(ct, 0, 128, CB(C_RVT) + ((size_t)b * 4 + (nt - 7)) * 128 * TPB, TPB, t0);
        else if (nt < 15) ep_store_rows<128>(ct, 0, CB(C_RG) + (nt - 11) * 128, 512, row0);
        else if (nt < 19) ep_store_rows<128>(ct, 0, CB(C_LX) + (nt - 15) * 128, 512, row0);
        else if (nt < 23) ep_store_rows<128>(ct, 0, CB(C_LG) + (nt - 19) * 128, 512, row0);
        else if (nt < 27) { ep_rope64(ct, p.in[I_GQN] + l * 64, 0.125f * LOG2E, lat, pos0, cs64); __syncthreads(); ep_store_rows<128>(ct, 0, CB(C_GQ) + (nt - 23) * 128, 512, row0); }
        else if (nt == 27) { ep_rope64(ct, p.in[I_GKN] + l * 64, 1.f, lat, pos0, cs64); __syncthreads(); ep_store_rows<128>(ct, 0, CB(C_GK), 128, row0); }
        else if (nt == 28) ep_store_T(ct, 0, 128, CB(C_GVT) + (size_t)b * 128 * TPB, TPB, t0);
        else { ep_rope32(ct, 1, nullptr, 1.f, lat, pos0, cs32); __syncthreads(); ep_store_rows<32>(ct, 0, CB(C_KR), 32, row0); }
        __syncthreads();
        T_END(4, l == 0 && BIDX == 8);
    }
}

DEVI float ret_lg2(const Params& p, int l, int dir, int h) { return -log1pf(expf(-p.in[I_RDEC][l * 8 + dir * 4 + h])) * LOG2E; }
DEVI void ret_chunk_U(const Params& p, int l, int task) {
    const int b = task / 72, r = task % 72, h = r / 18, m = r % 18;
    const int tid = TIDX, lane = tid & 63, w = tid >> 6, qc = lane & 31, hh = lane >> 5;
    const int t0 = m * 128;
    const bf16_t* KTg = CB(C_RKT) + ((size_t)b * 4 + h) * 64 * TPB + t0 + 8 * hh;
    const bf16_t* VTg = CB(C_RVT) + (((size_t)b * 4 + h) * 128 + w * 32 + qc) * TPB + t0 + 8 * hh;
    bf16x8 vf[8], ka[2][8];
#pragma unroll
    for (int ks = 0; ks < 8; ++ks) vf[ks] = *(const bf16x8*)(VTg + ks * 16);
#pragma unroll
    for (int sub = 0; sub < 2; ++sub)
#pragma unroll
        for (int ks = 0; ks < 8; ++ks) ka[sub][ks] = *(const bf16x8*)(KTg + (size_t)(32 * sub + qc) * TPB + ks * 16);
#pragma unroll
    for (int dir = 0; dir < 2; ++dir) {
        const float lg2 = ret_lg2(p, l, dir, h);
        f32x16 U0, U1;
#pragma unroll
        for (int rr = 0; rr < 16; ++rr) { U0[rr] = 0.f; U1[rr] = 0.f; }
#pragma unroll
        for (int ks = 0; ks < 8; ++ks) {
            bf16x8 vs;
#pragma unroll
            for (int e = 0; e < 8; ++e) {
                const int j = 16 * ks + 8 * hh + e;
                const float kd = __builtin_amdgcn_exp2f(lg2 * (float)(dir == 0 ? 127 - j : j));
                vs[e] = (short)f2bf(bf2f((bf16_t)vf[ks][e]) * kd);
            }
            U0 = __builtin_amdgcn_mfma_f32_32x32x16_bf16(ka[0][ks], vs, U0, 0, 0, 0);
            U1 = __builtin_amdgcn_mfma_f32_32x32x16_bf16(ka[1][ks], vs, U1, 0, 0, 0);
        }
        bf16_t* up = DB(D_OB) + ((((size_t)(b * 4 + h) * 18 + m) * 2 + dir) * 128) * 64 + (size_t)(32 * w + qc) * 8 + 4 * hh;
#pragma unroll
        for (int g = 0; g < 4; ++g) {
            bf16x4 a, c;
#pragma unroll
            for (int e = 0; e < 4; ++e) { a[e] = (short)f2bf(U0[4 * g + e]); c[e] = (short)f2bf(U1[4 * g + e]); }
            *(bf16x4*)(up + (((g >> 1) * 2 + (g & 1)) * 128) * 8) = a;
            *(bf16x4*)(up + (((2 + (g >> 1)) * 2 + (g & 1)) * 128) * 8) = c;
        }
    }
}
DEVI void ret_out_task(const Params& p, int l, int b, int h, int m, unsigned char* smem) {
    constexpr int PLD = 136;
    bf16_t* P = (bf16_t*)smem;
    float* red = (float*)(smem + 34816);
    const int tid = TIDX, lane = tid & 63, w = tid >> 6, qc = lane & 31, hh = lane >> 5;
    const int t0 = m * 128, iq = 32 * w + qc;
    const float lgf = ret_lg2(p, l, 0, h), lgb = ret_lg2(p, l, 1, h);
    const float cdf = exp2f(lgf * 128.f), cdb = exp2f(lgb * 128.f);
    bf16x8 sff[4], sfb[4];
    {
        float Sf[4][8], Sb[4][8];
#pragma unroll
        for (int ks = 0; ks < 4; ++ks)
#pragma unroll
            for (int e = 0; e < 8; ++e) { Sf[ks][e] = 0.f; Sb[ks][e] = 0.f; }
        const bf16_t* Ub = DB(D_OB) + (size_t)(b * 4 + h) * 18 * 2 * 128 * 64 + (size_t)(hh * 128 + 32 * w + qc) * 8;
        const int pos = m < 2 ? 1 - m : 19 - m;
        const int nf4 = (m + 3) & ~3, nb4 = (pos + 3) & ~3;
        for (int c0 = 0; c0 < nf4; c0 += 4) {
            bf16x8 u[4][4]; float wg[4];
#pragma unroll
            for (int q = 0; q < 4; ++q) {
                const int c = c0 + q, cl = c < m ? c : 0;
                wg[q] = c < m ? __builtin_amdgcn_exp2f(lgf * 128.f * (float)(m - 1 - c)) : 0.f;
                const bf16_t* up = Ub + (size_t)(cl * 2 + 0) * 128 * 64;
#pragma unroll
                for (int ks = 0; ks < 4; ++ks) u[q][ks] = *(const bf16x8*)(up + ks * 2048);
            }
#pragma unroll
            for (int q = 0; q < 4; ++q)
#pragma unroll
                for (int ks = 0; ks < 4; ++ks)
#pragma unroll
                    for (int e = 0; e < 8; ++e) Sf[ks][e] += wg[q] * bf2f((bf16_t)u[q][ks][e]);
        }
        for (int c0 = 0; c0 < nb4; c0 += 4) {
            bf16x8 u[4][4]; float wg[4];
#pragma unroll
            for (int q = 0; q < 4; ++q) {
                const int cc = c0 + q, ccl = cc < pos ? cc : 0;
                const int c = ccl < 2 ? 1 - ccl : 19 - ccl;
                wg[q] = cc < pos ? __builtin_amdgcn_exp2f(lgb * 128.f * (float)(pos - 1 - cc)) : 0.f;
                const bf16_t* up = Ub + (size_t)(c * 2 + 1) * 128 * 64;
#pragma unroll
                for (int ks = 0; ks < 4; ++ks) u[q][ks] = *(const bf16x8*)(up + ks * 2048);
            }
#pragma unroll
            for (int q = 0; q < 4; ++q)
#pragma unroll
                for (int ks = 0; ks < 4; ++ks)
#pragma unroll
                    for (int e = 0; e < 8; ++e) Sb[ks][e] += wg[q] * bf2f((bf16_t)u[q][ks][e]);
        }
#pragma unroll
        for (int ks = 0; ks < 4; ++ks)
#pragma unroll
            for (int e = 0; e < 8; ++e) { sff[ks][e] = (short)f2bf(Sf[ks][e]); sfb[ks][e] = (short)f2bf(Sb[ks][e]); }
    }
    const bf16_t* Kg = CB(C_RK) + ((size_t)b * TPB + t0) * 256 + h * 64 + 8 * hh;
    const bf16_t* Qg = CB(C_RQ) + ((size_t)b * TPB + t0) * 256 + h * 64 + 8 * hh;
    const bf16_t* VTg = CB(C_RVT) + (((size_t)b * 4 + h) * 128 + w * 32 + qc) * TPB + t0 + 8 * hh;
    bf16x8 vf[8];
#pragma unroll
    for (int ks = 0; ks < 8; ++ks) vf[ks] = *(const bf16x8*)(VTg + ks * 16);
    {
        bf16x8 qf[4], ka[4][4];
#pragma unroll
        for (int ks = 0; ks < 4; ++ks) qf[ks] = *(const bf16x8*)(Qg + (size_t)iq * 256 + ks * 16);
#pragma unroll
        for (int js = 0; js < 4; ++js)
#pragma unroll
            for (int ks = 0; ks < 4; ++ks) ka[js][ks] = *(const bf16x8*)(Kg + (size_t)(32 * js + qc) * 256 + ks * 16);
        __syncthreads();
#pragma unroll
        for (int js = 0; js < 4; ++js) {
            f32x16 sc;
#pragma unroll
            for (int r = 0; r < 16; ++r) sc[r] = 0.f;
#pragma unroll
            for (int ks = 0; ks < 4; ++ks) sc = __builtin_amdgcn_mfma_f32_32x32x16_bf16(ka[js][ks], qf[ks], sc, 0, 0, 0);
#pragma unroll
            for (int g = 0; g < 4; ++g) {
                bf16x4 pk;
#pragma unroll
                for (int e = 0; e < 4; ++e) {
                    const int d = iq - (32 * js + 8 * g + 4 * hh + e);
                    const float wgt = d >= 0 ? __builtin_amdgcn_exp2f(lgf * (float)d) : __builtin_amdgcn_exp2f(lgb * (float)(-d));
                    pk[e] = (short)f2bf(sc[4 * g + e] * wgt);
                }
                *(bf16x4*)(P + iq * PLD + 32 * js + 8 * g + 4 * hh) = pk;
            }
        }
    }
    bf16x8 qa[4];
#pragma unroll
    for (int ks = 0; ks < 4; ++ks) qa[ks] = *(const bf16x8*)(Qg + (size_t)qc * 256 + ks * 16);
    __syncthreads();
    f32x16 o[4];
#pragma unroll
    for (int isub = 0; isub < 4; ++isub) {
        const int ii = 32 * isub + qc;
        bf16x8 qn[4];
        if (isub < 3) {
#pragma unroll
            for (int ks = 0; ks < 4; ++ks) qn[ks] = *(const bf16x8*)(Qg + (size_t)(ii + 32) * 256 + ks * 16);
        }
#pragma unroll
        for (int r = 0; r < 16; ++r) o[isub][r] = 0.f;
#pragma unroll
        for (int ks = 0; ks < 4; ++ks) o[isub] = __builtin_amdgcn_mfma_f32_32x32x16_bf16(sff[ks], qa[ks], o[isub], 0, 0, 0);
        const float qdf = __builtin_amdgcn_exp2f(lgf * (float)(ii + 1)), qdb = __builtin_amdgcn_exp2f(lgb * (float)(128 - ii));
        const float rat = qdf / qdb;
#pragma unroll
        for (int r = 0; r < 16; ++r) o[isub][r] *= rat;
#pragma unroll
        for (int ks = 0; ks < 4; ++ks) o[isub] = __builtin_amdgcn_mfma_f32_32x32x16_bf16(sfb[ks], qa[ks], o[isub], 0, 0, 0);
#pragma unroll
        for (int r = 0; r < 16; ++r) o[isub][r] *= qdb;
#pragma unroll
        for (int ks = 0; ks < 8; ++ks) {
            bf16x8 pf = *(const bf16x8*)(P + ii * PLD + 16 * ks + 8 * hh);
            o[isub] = __builtin_amdgcn_mfma_f32_32x32x16_bf16(vf[ks], pf, o[isub], 0, 0, 0);
        }
        float s1 = 0.f, s2 = 0.f;
#pragma unroll
        for (int r = 0; r < 16; ++r) { s1 += o[isub][r]; s2 += o[isub][r] * o[isub][r]; }
        s1 += __shfl_xor(s1, 32); s2 += __shfl_xor(s2, 32);
        if (hh == 0) { red[(w * 128 + ii) * 2] = s1; red[(w * 128 + ii) * 2 + 1] = s2; }
        if (isub < 3) {
#pragma unroll
            for (int ks = 0; ks < 4; ++ks) qa[ks] = qn[ks];
        }
    }
    __syncthreads();
    const float* gn = p.in[I_RNORM] + l * 512 + h * 128 + 32 * w + 4 * hh;
    float gnv[16];
#pragma unroll
    for (int g = 0; g < 4; ++g)
#pragma unroll
        for (int e = 0; e < 4; ++e) gnv[4 * g + e] = gn[8 * g + e];
#pragma unroll
    for (int isub = 0; isub < 4; ++isub) {
        const int ii = 32 * isub + qc;
        float t1 = 0.f, t2 = 0.f;
#pragma unroll
        for (int ww = 0; ww < 4; ++ww) { t1 += red[(ww * 128 + ii) * 2]; t2 += red[(ww * 128 + ii) * 2 + 1]; }
        const float mu = t1 * (1.f / 128.f);
        const float rs = rsqrtf(fmaxf(t2 * (1.f / 128.f) - mu * mu, 0.f) + EPSV);
#pragma unroll
        for (int g = 0; g < 4; ++g) {
            bf16x4 ov;
#pragma unroll
            for (int e = 0; e < 4; ++e) ov[e] = (short)f2bf((o[isub][4 * g + e] - mu) * rs * gnv[4 * g + e]);
            *(bf16x4*)(P + ii * PLD + 32 * w + 8 * g + 4 * hh) = ov;
        }
    }
    __syncthreads();
#pragma unroll
    for (int k = 0; k < 8; ++k) {
        const int c = tid + 256 * k, row = c >> 4, ch = c & 15;
        const size_t ro = ((size_t)b * TPB + t0 + row) * 512 + h * 128 + ch * 8;
        const bf16x8 nv = *(const bf16x8*)(P + row * PLD + ch * 8);
        const bf16x8 gt = *(const bf16x8*)(CB(C_RG) + ro);
        bf16x8 ov;
#pragma unroll
        for (int e = 0; e < 8; ++e) ov[e] = (short)f2bf(siluf_(bf2f((bf16_t)gt[e])) * bf2f((bf16_t)nv[e]));
        *(bf16x8*)(DB(D_OF) + ro) = ov;
    }
}

DEVI void h_to_fp8(const Params& p, int t32) {
    const int lane = TIDX & 63, w = TIDX >> 6;
    const size_t row0 = (size_t)t32 * 32 + w * 8;
    bf16x8 a[8], b[8];
#pragma unroll
    for (int i = 0; i < 8; ++i) {
        a[i] = *(const bf16x8*)(HB + (row0 + i) * 1024 + lane * 16);
        b[i] = *(const bf16x8*)(HB + (row0 + i) * 1024 + lane * 16 + 8);
    }
    asm volatile("s_waitcnt vmcnt(0)" ::: "memory");
#pragma unroll
    for (int i = 0; i < 8; ++i) {
        i32x4 o;
        o[0] = pk4_fp8(bf2f((bf16_t)a[i][0]), bf2f((bf16_t)a[i][1]), bf2f((bf16_t)a[i][2]), bf2f((bf16_t)a[i][3]));
        o[1] = pk4_fp8(bf2f((bf16_t)a[i][4]), bf2f((bf16_t)a[i][5]), bf2f((bf16_t)a[i][6]), bf2f((bf16_t)a[i][7]));
        o[2] = pk4_fp8(bf2f((bf16_t)b[i][0]), bf2f((bf16_t)b[i][1]), bf2f((bf16_t)b[i][2]), bf2f((bf16_t)b[i][3]));
        o[3] = pk4_fp8(bf2f((bf16_t)b[i][4]), bf2f((bf16_t)b[i][5]), bf2f((bf16_t)b[i][6]), bf2f((bf16_t)b[i][7]));
        *(i32x4*)((unsigned char*)HB + (row0 + i) * 2048 + lane * 16) = o;
    }
}
DEVI void phase_mla_up(const Params& p, int l, unsigned char* smem) {
    bf16_t* ct = (bf16_t*)smem;
    float* rstd = (float*)(smem + AUX_OFF);
    const float* cs32 = WSF(OFF_R32);
    const float qscale = 0.10206207261596575f * LOG2E;
    const int nq = (l == 0 ? 144 : 128) * 6;
    const int nkv = 144 * 8;
    for (int tile = BIDX; tile < nq + nkv + 576 + 576; tile += gridDim.x) {
        if (tile >= nq + nkv + 576) { h_to_fp8(p, tile - nq - nkv - 576); continue; }
        if (tile >= nq + nkv) { ret_chunk_U(p, l, tile - nq - nkv); continue; }
        if (tile < nq) {
            const int mt = mt_of(tile / 6, l != 0), nt = tile % 6;
            const int row0 = mt * 128, t0 = (mt % 18) * 128;
            const bool lat = (mt % 18) >= 2;
            f32x4 acc[4][4];
            acc_zero<128>(acc);
            AOp A{CB(C_CQ), 256, row0, nullptr};
            gemm_core<128>(acc, A, WB(W_UQ + (size_t)l * 768 * 256 + (size_t)nt * 128 * 256), 256, 256, smem);
            __syncthreads();
            acc_to_ct<128>(acc, ct);
            ep_rstd(CB(C_CQ), 256, row0, 256, rstd);
            __syncthreads();
            if (nt < 4) {
                ep_scale_rows(ct, 0, 128, rstd, qscale); __syncthreads();
                ep_store_rows<64>(ct, 0, CB(C_MQ) + (nt * 2) * 96, 768, row0);
                ep_store_rows<64>(ct, 64, CB(C_MQ) + (nt * 2 + 1) * 96, 768, row0);
            } else {
                ep_rope32(ct, 4, rstd, qscale, lat, t0 - CTXL, cs32); __syncthreads();
#pragma unroll
                for (int g = 0; g < 4; ++g) ep_store_rows<32>(ct, g * 32, CB(C_MQ) + ((nt - 4) * 4 + g) * 96 + 64, 768, row0);
            }
            __syncthreads();
        } else {
            const int tk = tile - nq;
            const int mt = tk / 8, nt = tk % 8;
            const int row0 = mt * 128, b = mt / 18, t0 = (mt % 18) * 128;
            f32x4 acc[4][4];
            acc_zero<128>(acc);
            AOp A{CB(C_CKV), 128, row0, nullptr};
            gemm_core<128>(acc, A, WB(W_UKV + (size_t)l * 1024 * 128 + (size_t)nt * 128 * 128), 128, 128, smem);
            __syncthreads();
            acc_to_ct<128>(acc, ct);
            ep_rstd(CB(C_CKV), 128, row0, 128, rstd);
            __syncthreads();
            ep_scale_rows(ct, 0, 128, rstd, 1.f); __syncthreads();
            ep_store_rows<64>(ct, 0, CB(C_KN) + nt * 64, 512, row0);
            ep_store_T(ct, 64, 64, CB(C_VMT) + ((size_t)b * 8 + nt) * 64 * TPB, TPB, t0);
            __syncthreads();
        }
    }
}

template <int DK, bool MLA>
DEVI void attn_naive_wave(const Params& p, int b, int t0, int hq) {
    const int lane = TIDX & 63;
    const int t = t0 + lane, row = b * TPB + t;
    const int nkeys = (t0 < CTXL) ? CTXL : TPB;
    float q[DK];
    const bf16_t* qp = MLA ? CB(C_MQ) + (size_t)row * 768 + hq * 96 : CB(C_GQ) + (size_t)row * 512 + hq * 64;
#pragma unroll
    for (int c = 0; c < DK / 8; ++c) {
        bf16x8 tq = *(const bf16x8*)(qp + c * 8);
#pragma unroll
        for (int e = 0; e < 8; ++e) q[c * 8 + e] = bf2f((bf16_t)tq[e]);
    }
    float acc[64];
#pragma unroll
    for (int d = 0; d < 64; ++d) acc[d] = 0.f;
    float m = -1e30f, lsum = 0.f;
    const int hk = MLA ? hq : (hq >> 2);
    const bf16_t* vT = MLA ? CB(C_VMT) + ((size_t)b * 8 + hk) * 64 * TPB : CB(C_GVT) + ((size_t)b * 2 + hk) * 64 * TPB;
    for (int kt = 0; kt < nkeys; ++kt) {
        const size_t krow = (size_t)b * TPB + kt;
        float s = 0.f;
        const bf16_t* kp = MLA ? CB(C_KN) + krow * 512 + hk * 64 : CB(C_GK) + krow * 128 + hk * 64;
#pragma unroll
        for (int c = 0; c < 8; ++c) {
            bf16x8 tk = *(const bf16x8*)(kp + c * 8);
#pragma unroll
            for (int e = 0; e < 8; ++e) s += q[c * 8 + e] * bf2f((bf16_t)tk[e]);
        }
        if (MLA) {
            const bf16_t* rp = CB(C_KR) + krow * 32;
#pragma unroll
            for (int c = 0; c < 4; ++c) {
                bf16x8 tk = *(const bf16x8*)(rp + c * 8);
#pragma unroll
                for (int e = 0; e < 8; ++e) s += q[(DK - 32) + c * 8 + e] * bf2f((bf16_t)tk[e]);
            }
        }
        const float mn = fmaxf(m, s);
        const float alpha = exp2f(m - mn), pp = exp2f(s - mn);
        lsum = lsum * alpha + pp;
#pragma unroll
        for (int d = 0; d < 64; ++d) acc[d] = acc[d] * alpha + pp * bf2f(vT[(size_t)d * TPB + kt]);
        m = mn;
    }
    const float inv = 1.f / lsum;
    bf16_t* op = (MLA ? DB(D_YA) : DB(D_YD)) + (size_t)row * 512 + hq * 64;
#pragma unroll
    for (int c = 0; c < 8; ++c) {
        bf16x8 o;
#pragma unroll
        for (int e = 0; e < 8; ++e) o[e] = (short)f2bf(acc[c * 8 + e] * inv);
        *(bf16x8*)(op + c * 8) = o;
    }
}


template <int DK, bool MLA>
DEVI void attn_task(const Params& p, int b, int hsel, int tq0, int nkeys, unsigned char* smem) {
    constexpr int KLD = DK + 8;
    constexpr int CK = DK / 8;
    constexpr int NKC = 64 * CK / 256;
    constexpr int VLD = 68;
    constexpr int KBYTES = 64 * KLD * 2, VBYTES = 64 * VLD * 2;
    constexpr int VOFF = 2 * KBYTES;
    static_assert(2 * (KBYTES + VBYTES) <= 60000, "attn lds");
    const int tid = TIDX, lane = tid & 63, w = tid >> 6, qc = lane & 31, hh = lane >> 5;
    const int tq = MLA ? tq0 + w * 32 + qc : tq0 + qc;
    const int hq = MLA ? hsel : hsel * 4 + w;
    const size_t qrow = (size_t)b * TPB + tq;
    const bf16_t* qp = MLA ? CB(C_MQ) + qrow * 768 + hq * 96 : CB(C_GQ) + qrow * 512 + hq * 64;
    bf16x8 qf[DK / 16];
#pragma unroll
    for (int ks = 0; ks < DK / 16; ++ks) qf[ks] = *(const bf16x8*)(qp + ks * 16 + hh * 8);
    const bf16_t* ksrc[NKC]; int kstep[NKC], kdst[NKC];
#pragma unroll
    for (int i = 0; i < NKC; ++i) {
        const int q = tid + 256 * i, key = q / CK, ch = q % CK;
        if (MLA) {
            if (ch < 8) { ksrc[i] = CB(C_KN) + ((size_t)b * TPB + key) * 512 + hsel * 64 + ch * 8; kstep[i] = 64 * 512; }
            else { ksrc[i] = CB(C_KR) + ((size_t)b * TPB + key) * 32 + (ch - 8) * 8; kstep[i] = 64 * 32; }
        } else { ksrc[i] = CB(C_GK) + ((size_t)b * TPB + key) * 128 + hsel * 64 + ch * 8; kstep[i] = 64 * 128; }
        kdst[i] = (key * KLD + ch * 8) * 2;
    }
    const bf16_t* vT = MLA ? CB(C_VMT) + ((size_t)b * 8 + hsel) * 64 * TPB : CB(C_GVT) + ((size_t)b * 2 + hsel) * 64 * TPB;
    const bf16_t* vsrc[2]; int vdst[2];
#pragma unroll
    for (int i = 0; i < 2; ++i) {
        const int q = tid + 256 * i, dv = q >> 3, ch = q & 7;
        vsrc[i] = vT + (size_t)dv * TPB + ch * 8;
        vdst[i] = VOFF + (dv * VLD + ch * 8) * 2;
    }
    const int nt = nkeys >> 6;
    bf16x8 kr[NKC], vr[2];
#pragma unroll
    for (int i = 0; i < NKC; ++i) kr[i] = *(const bf16x8*)(ksrc[i]);
#pragma unroll
    for (int i = 0; i < 2; ++i) vr[i] = *(const bf16x8*)(vsrc[i]);
    __syncthreads();
#pragma unroll
    for (int i = 0; i < NKC; ++i) *(bf16x8*)(smem + kdst[i]) = kr[i];
#pragma unroll
    for (int i = 0; i < 2; ++i) {
        *(bf16x4*)(smem + vdst[i]) = bf16x4{vr[i][0], vr[i][1], vr[i][2], vr[i][3]};
        *(bf16x4*)(smem + vdst[i] + 8) = bf16x4{vr[i][4], vr[i][5], vr[i][6], vr[i][7]};
    }
#pragma unroll
    for (int i = 0; i < NKC; ++i) kr[i] = *(const bf16x8*)(ksrc[i] + (size_t)kstep[i]);
    __syncthreads();
    f32x16 s0, s1;
#pragma unroll
    for (int r = 0; r < 16; ++r) { s0[r] = 0.f; s1[r] = 0.f; }
#pragma unroll
    for (int ks = 0; ks < DK / 16; ++ks) {
        bf16x8 a0 = *(const bf16x8*)(smem + (qc * KLD + ks * 16 + hh * 8) * 2);
        bf16x8 a1 = *(const bf16x8*)(smem + ((32 + qc) * KLD + ks * 16 + hh * 8) * 2);
        s0 = __builtin_amdgcn_mfma_f32_32x32x16_bf16(a0, qf[ks], s0, 0, 0, 0);
        s1 = __builtin_amdgcn_mfma_f32_32x32x16_bf16(a1, qf[ks], s1, 0, 0, 0);
    }
#pragma unroll
    for (int i = 0; i < NKC; ++i) *(bf16x8*)(smem + KBYTES + kdst[i]) = kr[i];
    f32x16 o0, o1;
#pragma unroll
    for (int r = 0; r < 16; ++r) { o0[r] = 0.f; o1[r] = 0.f; }
    float m = -1e30f, lsum = 0.f;
    for (int it = 0; it < nt; ++it) {
        __syncthreads();
        if (it + 2 < nt) {
#pragma unroll
            for (int i = 0; i < NKC; ++i) kr[i] = *(const bf16x8*)(ksrc[i] + (size_t)(it + 2) * kstep[i]);
        }
        if (it + 1 < nt) {
#pragma unroll
            for (int i = 0; i < 2; ++i) vr[i] = *(const bf16x8*)(vsrc[i] + (it + 1) * 64);
        }
        f32x16 n0, n1;
#pragma unroll
        for (int r = 0; r < 16; ++r) { n0[r] = 0.f; n1[r] = 0.f; }
        if (it + 1 < nt) {
            const unsigned char* ck = smem + ((it + 1) & 1) * KBYTES;
#pragma unroll
            for (int ks = 0; ks < DK / 16; ++ks) {
                bf16x8 a0 = *(const bf16x8*)(ck + (qc * KLD + ks * 16 + hh * 8) * 2);
                bf16x8 a1 = *(const bf16x8*)(ck + ((32 + qc) * KLD + ks * 16 + hh * 8) * 2);
                n0 = __builtin_amdgcn_mfma_f32_32x32x16_bf16(a0, qf[ks], n0, 0, 0, 0);
                n1 = __builtin_amdgcn_mfma_f32_32x32x16_bf16(a1, qf[ks], n1, 0, 0, 0);
            }
        }
        float mx = s0[0];
#pragma unroll
        for (int r = 1; r < 16; ++r) mx = fmaxf(mx, s0[r]);
#pragma unroll
        for (int r = 0; r < 16; ++r) mx = fmaxf(mx, s1[r]);
        mx = fmaxf(mx, __shfl_xor(mx, 32));
        if (!__all(mx <= m + 6.f)) {
            const float mn = fmaxf(m, mx);
            const float alpha = __builtin_amdgcn_exp2f(m - mn);
            m = mn;
            lsum *= alpha;
#pragma unroll
            for (int r = 0; r < 16; ++r) { o0[r] *= alpha; o1[r] *= alpha; }
        }
        float ps = 0.f;
#pragma unroll
        for (int r = 0; r < 16; ++r) { s0[r] = __builtin_amdgcn_exp2f(s0[r] - m); ps += s0[r]; }
#pragma unroll
        for (int r = 0; r < 16; ++r) { s1[r] = __builtin_amdgcn_exp2f(s1[r] - m); ps += s1[r]; }
        lsum += ps;
        bf16x8 pf[2][2];
#pragma unroll
        for (int s = 0; s < 2; ++s)
#pragma unroll
            for (int j = 0; j < 8; ++j) { pf[0][s][j] = (short)f2bf(s0[8 * s + j]); pf[1][s][j] = (short)f2bf(s1[8 * s + j]); }
        const unsigned char* cv = smem + VOFF + (it & 1) * VBYTES;
#pragma unroll
        for (int a = 0; a < 2; ++a)
#pragma unroll
            for (int s = 0; s < 2; ++s) {
                const int keyoff = a * 32 + 16 * s + 4 * hh;
                bf16x4 l0 = *(const bf16x4*)(cv + (qc * VLD + keyoff) * 2);
                bf16x4 h0 = *(const bf16x4*)(cv + (qc * VLD + keyoff + 8) * 2);
                bf16x4 l1 = *(const bf16x4*)(cv + ((32 + qc) * VLD + keyoff) * 2);
                bf16x4 h1 = *(const bf16x4*)(cv + ((32 + qc) * VLD + keyoff + 8) * 2);
                bf16x8 v0 = bf16x8{l0[0], l0[1], l0[2], l0[3], h0[0], h0[1], h0[2], h0[3]};
                bf16x8 v1 = bf16x8{l1[0], l1[1], l1[2], l1[3], h1[0], h1[1], h1[2], h1[3]};
                o0 = __builtin_amdgcn_mfma_f32_32x32x16_bf16(v0, pf[a][s], o0, 0, 0, 0);
                o1 = __builtin_amdgcn_mfma_f32_32x32x16_bf16(v1, pf[a][s], o1, 0, 0, 0);
            }
        if (it + 2 < nt) {
            unsigned char* nk = smem + (it & 1) * KBYTES;
#pragma unroll
            for (int i = 0; i < NKC; ++i) *(bf16x8*)(nk + kdst[i]) = kr[i];
        }
        if (it + 1 < nt) {
            unsigned char* nv = smem + ((it + 1) & 1) * VBYTES;
#pragma unroll
            for (int i = 0; i < 2; ++i) {
                *(bf16x4*)(nv + vdst[i]) = bf16x4{vr[i][0], vr[i][1], vr[i][2], vr[i][3]};
                *(bf16x4*)(nv + vdst[i] + 8) = bf16x4{vr[i][4], vr[i][5], vr[i][6], vr[i][7]};
            }
        }
        s0 = n0; s1 = n1;
    }
    lsum += __shfl_xor(lsum, 32);
    const float inv = 1.f / lsum;
    bf16_t* op = (MLA ? DB(D_YA) : DB(D_YD)) + qrow * 512 + hq * 64;
#pragma unroll
    for (int g = 0; g < 4; ++g) {
        bf16x4 a, c;
#pragma unroll
        for (int e = 0; e < 4; ++e) { a[e] = (short)f2bf(o0[g * 4 + e] * inv); c[e] = (short)f2bf(o1[g * 4 + e] * inv); }
        *(bf16x4*)(op + 8 * g + 4 * hh) = a;
        *(bf16x4*)(op + 32 + 8 * g + 4 * hh) = c;
    }
}

DEVI int proc_tok(int dir, int pidx) { return dir == 0 ? pidx : (pidx < CTXL ? CTXL - 1 - pidx : (CTXL + TPB - 1) - pidx); }

DEVI void retention_naive(const Params& p, int l, int task) {
    const int b = task >> 2, h = task & 3;
    const int dir = TIDX >> 7, dv = TIDX & 127;
    const float dec = p.in[I_RDEC][l * 8 + dir * 4 + h];
    const float lg = -log1pf(expf(-dec));
    const float g = expf(lg);
    float S[64];
#pragma unroll
    for (int d = 0; d < 64; ++d) S[d] = 0.f;
    const bf16_t* vT = CB(C_RVT) + (((size_t)b * 4 + h) * 128 + dv) * TPB;
    bf16_t* outp = (dir == 0 ? DB(D_OF) : DB(D_OB));
    for (int pi = 0; pi < TPB; ++pi) {
        const int u = proc_tok(dir, pi);
        const size_t row = (size_t)b * TPB + u;
        const bf16_t* qp = CB(C_RQ) + row * 256 + h * 64;
        const bf16_t* kp = CB(C_RK) + row * 256 + h * 64;
        const float v = bf2f(vT[u]);
        float o = 0.f;
#pragma unroll
        for (int c = 0; c < 8; ++c) {
            bf16x8 tq = *(const bf16x8*)(qp + c * 8);
            bf16x8 tk = *(const bf16x8*)(kp + c * 8);
#pragma unroll
            for (int e = 0; e < 8; ++e) {
                const int d = c * 8 + e;
                const float qd = bf2f((bf16_t)tq[e]), kd = bf2f((bf16_t)tk[e]);
                if (dir == 0) { S[d] = g * S[d] + kd * v; o += qd * S[d]; }
                else { S[d] = g * S[d]; o += qd * S[d]; S[d] += kd * v; }
            }
        }
        outp[row * 512 + h * 128 + dv] = f2bf(o);
    }
}

DEVI void lru_naive_wave(const Params& p, int l, int task) {
    const int lane = TIDX & 63;
    const int b = task >> 4, d = (task >> 3) & 1, blk = task & 7;
    const int ch = blk * 64 + lane;
    float cw[4];
#pragma unroll
    for (int j = 0; j < 4; ++j) cw[j] = p.in[I_LCW][(l * 4 + j) * 512 + ch];
    const float cb = p.in[I_LCB][l * 512 + ch];
    const float ba = p.in[I_LBA][(l * 2 + d) * 512 + ch], bx = p.in[I_LBX][(l * 2 + d) * 512 + ch];
    const float lam = p.in[I_LLAM][(l * 2 + d) * 512 + ch];
    const float sp = log1pf(expf(-lam));
    const float* Wa = p.in[I_LWA] + ((size_t)(l * 2 + d) * 8 + blk) * 4096;
    const float* Wx = p.in[I_LWX] + ((size_t)(l * 2 + d) * 8 + blk) * 4096;
    float h = 0.f;
    bf16_t* outp = (d == 0 ? DB(D_LH0) : DB(D_LH1));
    for (int pi = 0; pi < TPB; ++pi) {
        const int u = proc_tok(d, pi);
        const int lo = u < CTXL ? 0 : CTXL, hi = u < CTXL ? CTXL : TPB;
        const size_t row = (size_t)b * TPB + u;
        float uval = cb;
#pragma unroll
        for (int j = 0; j < 4; ++j) {
            const int tt = u - 2 + j;
            if (tt >= lo && tt < hi) uval += cw[j] * bf2f(CB(C_LX)[((size_t)b * TPB + tt) * 512 + ch]);
        }
        float rp = 0.f, ip = 0.f;
        for (int c = 0; c < 64; ++c) {
            const float uc = __shfl(uval, c);
            rp += uc * Wa[c * 64 + lane];
            ip += uc * Wx[c * 64 + lane];
        }
        const float r = sigmoidf_(rp + ba), ig = sigmoidf_(ip + bx);
        const float la = -8.f * r * sp;
        const float a = expf(la);
        const float bb = sqrtf(-expm1f(2.f * la)) * (ig * uval);
        h = a * h + bb;
        outp[row * 512 + ch] = f2bf(h);
    }
}


DEVI void retention_walk(const Params& p, int l, int task, unsigned char* smem) {
    constexpr int PLD = 136;
    const int b = task >> 3, h = (task >> 1) & 3, dir = task & 1;
    const int tid = TIDX, lane = tid & 63, w = tid >> 6, qc = lane & 31, hh = lane >> 5;
    const float dec = p.in[I_RDEC][l * 8 + dir * 4 + h];
    const float lg2 = -log1pf(expf(-dec)) * LOG2E;
    const float cdec = exp2f(lg2 * 128.f);
    bf16_t* P = (bf16_t*)smem;
    f32x16 S0, S1;
#pragma unroll
    for (int r = 0; r < 16; ++r) { S0[r] = 0.f; S1[r] = 0.f; }
    const bf16_t* Kg = CB(C_RK) + (size_t)b * TPB * 256 + h * 64;
    const bf16_t* Qg = CB(C_RQ) + (size_t)b * TPB * 256 + h * 64;
    const bf16_t* KTg = CB(C_RKT) + ((size_t)b * 4 + h) * 64 * TPB;
    const bf16_t* VTg = CB(C_RVT) + (((size_t)b * 4 + h) * 128 + w * 32 + qc) * TPB;
    bf16_t* outp = (dir == 0 ? DB(D_OF) : DB(D_OB)) + (size_t)b * TPB * 512 + h * 128 + w * 32;
    const int iq = 32 * w + qc;
    for (int cc = 0; cc < 18; ++cc) {
        const int mch = dir == 0 ? cc : (cc < 2 ? 1 - cc : 19 - cc);
        const int t0 = mch * 128;
        bf16x8 vf[8];
#pragma unroll
        for (int ks = 0; ks < 8; ++ks) vf[ks] = *(const bf16x8*)(VTg + t0 + ks * 16 + hh * 8);
        bf16x8 qf[4];
        {
            const bf16_t* qrow = Qg + (size_t)(t0 + iq) * 256;
#pragma unroll
            for (int ks = 0; ks < 4; ++ks) qf[ks] = *(const bf16x8*)(qrow + ks * 16 + hh * 8);
        }
        __syncthreads();
#pragma unroll 1
        for (int js = 0; js < 4; ++js) {
            f32x16 sc;
#pragma unroll
            for (int r = 0; r < 16; ++r) sc[r] = 0.f;
            const bf16_t* krow = Kg + (size_t)(t0 + 32 * js + qc) * 256;
#pragma unroll
            for (int ks = 0; ks < 4; ++ks) {
                bf16x8 a = *(const bf16x8*)(krow + ks * 16 + hh * 8);
                sc = __builtin_amdgcn_mfma_f32_32x32x16_bf16(a, qf[ks], sc, 0, 0, 0);
            }
#pragma unroll
            for (int g = 0; g < 4; ++g) {
                bf16x4 pk;
#pragma unroll
                for (int e = 0; e < 4; ++e) {
                    const int j = 32 * js + 8 * g + 4 * hh + e;
                    const int d = iq - j;
                    float wgt;
                    if (dir == 0) wgt = d >= 0 ? __builtin_amdgcn_exp2f(lg2 * (float)d) : 0.f;
                    else wgt = d < 0 ? __builtin_amdgcn_exp2f(lg2 * (float)(-d)) : 0.f;
                    pk[e] = (short)f2bf(sc[4 * g + e] * wgt);
                }
                *(bf16x4*)(P + iq * PLD + 32 * js + 8 * g + 4 * hh) = pk;
            }
        }
        __syncthreads();
        bf16x8 sf[2][2];
#pragma unroll
        for (int s = 0; s < 2; ++s)
#pragma unroll
            for (int j = 0; j < 8; ++j) { sf[0][s][j] = (short)f2bf(S0[8 * s + j]); sf[1][s][j] = (short)f2bf(S1[8 * s + j]); }
#pragma unroll 1
        for (int isub = 0; isub < 4; ++isub) {
            const int ii = 32 * isub + qc;
            const bf16_t* qr = Qg + (size_t)(t0 + ii) * 256;
            f32x16 o;
#pragma unroll
            for (int r = 0; r < 16; ++r) o[r] = 0.f;
#pragma unroll
            for (int sub = 0; sub < 2; ++sub)
#pragma unroll
                for (int s = 0; s < 2; ++s) {
                    const int dk0 = 32 * sub + 16 * s + 4 * hh;
                    bf16x4 lo = *(const bf16x4*)(qr + dk0), hi = *(const bf16x4*)(qr + dk0 + 8);
                    bf16x8 bq = bf16x8{lo[0], lo[1], lo[2], lo[3], hi[0], hi[1], hi[2], hi[3]};
                    o = __builtin_amdgcn_mfma_f32_32x32x16_bf16(sf[sub][s], bq, o, 0, 0, 0);
                }
            const float qd = dir == 0 ? __builtin_amdgcn_exp2f(lg2 * (float)(ii + 1)) : __builtin_amdgcn_exp2f(lg2 * (float)(128 - ii));
#pragma unroll
            for (int r = 0; r < 16; ++r) o[r] *= qd;
#pragma unroll
            for (int ks = 0; ks < 8; ++ks) {
                bf16x8 pf = *(const bf16x8*)(P + ii * PLD + 16 * ks + 8 * hh);
                o = __builtin_amdgcn_mfma_f32_32x32x16_bf16(vf[ks], pf, o, 0, 0, 0);
            }
            bf16_t* orow = outp + (size_t)(t0 + ii) * 512;
#pragma unroll
            for (int g = 0; g < 4; ++g) {
                bf16x4 pk;
#pragma unroll
                for (int e = 0; e < 4; ++e) pk[e] = (short)f2bf(o[4 * g + e]);
                *(bf16x4*)(orow + 8 * g + 4 * hh) = pk;
            }
        }
#pragma unroll
        for (int r = 0; r < 16; ++r) { S0[r] *= cdec; S1[r] *= cdec; }
#pragma unroll
        for (int ks = 0; ks < 8; ++ks) {
            bf16x8 vs;
#pragma unroll
            for (int e = 0; e < 8; ++e) {
                const int j = 16 * ks + 8 * hh + e;
                const float kd = dir == 0 ? __builtin_amdgcn_exp2f(lg2 * (float)(127 - j)) : __builtin_amdgcn_exp2f(lg2 * (float)j);
                vs[e] = (short)f2bf(bf2f((bf16_t)vf[ks][e]) * kd);
            }
            bf16x8 a0 = *(const bf16x8*)(KTg + (size_t)qc * TPB + t0 + 16 * ks + 8 * hh);
            bf16x8 a1 = *(const bf16x8*)(KTg + (size_t)(32 + qc) * TPB + t0 + 16 * ks + 8 * hh);
            S0 = __builtin_amdgcn_mfma_f32_32x32x16_bf16(a0, vs, S0, 0, 0, 0);
            S1 = __builtin_amdgcn_mfma_f32_32x32x16_bf16(a1, vs, S1, 0, 0, 0);
        }
    }
    __syncthreads();
}

DEVI void lru_walk(const Params& p, int l, int task, unsigned char* smem) {
    const int b = task >> 4, d = (task >> 3) & 1, blk = task & 7;
    const int tid = TIDX, lane = tid & 63, w = tid >> 6, ln = lane & 15, g = lane >> 4;
    bf16_t* Wt = (bf16_t*)smem;
    float* uw = (float*)(smem + 18432 + w * 4224);
    float* cpar = (float*)(smem + 35328);
    float* agg = (float*)(smem + 36608);
    __syncthreads();
    {
        const bf16_t* wsrc = WB(W_LRU + ((size_t)(l * 2 + d) * 8 + blk) * 8192);
        for (int c = tid; c < 128 * 8; c += 256) {
            const int n = c >> 3, kc = c & 7;
            *(bf16x8*)(Wt + n * 72 + kc * 8) = *(const bf16x8*)(wsrc + n * 64 + kc * 8);
        }
        if (tid < 64) {
            const int ch = blk * 64 + tid;
#pragma unroll
            for (int j = 0; j < 4; ++j) cpar[j * 64 + tid] = p.in[I_LCW][(l * 4 + j) * 512 + ch];
            cpar[256 + tid] = p.in[I_LCB][l * 512 + ch];
        }
    }
    __syncthreads();
    float ba[4], bx[4], sp[4], hc[4];
#pragma unroll
    for (int ct = 0; ct < 4; ++ct) {
        const int ch = blk * 64 + 16 * ct + ln;
        ba[ct] = p.in[I_LBA][(l * 2 + d) * 512 + ch];
        bx[ct] = p.in[I_LBX][(l * 2 + d) * 512 + ch];
        sp[ct] = log1pf(expf(-p.in[I_LLAM][(l * 2 + d) * 512 + ch]));
        hc[ct] = 0.f;
    }
    const bf16_t* X = CB(C_LX) + (size_t)b * TPB * 512 + blk * 64;
    bf16_t* outp = (d == 0 ? DB(D_LH0) : DB(D_LH1)) + (size_t)b * TPB * 512 + blk * 64;
    bf16x8 xr[2][4];
    float xm[4];
    {
        const int tok = proc_tok(d, 16 * w + ln);
        const int lo = tok < CTXL ? 0 : CTXL, hi = tok < CTXL ? CTXL : TPB;
#pragma unroll
        for (int ks = 0; ks < 2; ++ks)
#pragma unroll
            for (int j = 0; j < 4; ++j) {
                const int tt = tok - 2 + j;
                const int tc = tt < lo ? lo : (tt >= hi ? hi - 1 : tt);
                xr[ks][j] = *(const bf16x8*)(X + (size_t)tc * 512 + 32 * ks + 8 * g);
                xm[j] = (tt >= lo && tt < hi) ? 1.f : 0.f;
            }
    }
    for (int c = 0; c < 36; ++c) {
        bf16x8 af[2];
#pragma unroll
        for (int ks = 0; ks < 2; ++ks) {
            const int c0 = 32 * ks + 8 * g;
            float u8[8];
#pragma unroll
            for (int e = 0; e < 8; ++e) u8[e] = cpar[256 + c0 + e];
#pragma unroll
            for (int j = 0; j < 4; ++j)
#pragma unroll
                for (int e = 0; e < 8; ++e) u8[e] += (cpar[j * 64 + c0 + e] * xm[j]) * bf2f((bf16_t)xr[ks][j][e]);
#pragma unroll
            for (int e = 0; e < 8; ++e) { uw[ln * 65 + c0 + e] = u8[e]; af[ks][e] = (short)f2bf(u8[e]); }
        }
        if (c + 1 < 36) {
            const int tok = proc_tok(d, 64 * (c + 1) + 16 * w + ln);
            const int lo = tok < CTXL ? 0 : CTXL, hi = tok < CTXL ? CTXL : TPB;
#pragma unroll
            for (int ks = 0; ks < 2; ++ks)
#pragma unroll
                for (int j = 0; j < 4; ++j) {
                    const int tt = tok - 2 + j;
                    const int tc = tt < lo ? lo : (tt >= hi ? hi - 1 : tt);
                    xr[ks][j] = *(const bf16x8*)(X + (size_t)tc * 512 + 32 * ks + 8 * g);
                    xm[j] = (tt >= lo && tt < hi) ? 1.f : 0.f;
                }
        }
        __builtin_amdgcn_wave_barrier();
        f32x4 acc[8];
#pragma unroll
        for (int nt = 0; nt < 8; ++nt) acc[nt] = f32x4{0.f, 0.f, 0.f, 0.f};
#pragma unroll
        for (int ks = 0; ks < 2; ++ks)
#pragma unroll
            for (int nt = 0; nt < 8; ++nt) {
                bf16x8 bfr = *(const bf16x8*)(Wt + (16 * nt + ln) * 72 + 32 * ks + 8 * g);
                acc[nt] = __builtin_amdgcn_mfma_f32_16x16x32_bf16(af[ks], bfr, acc[nt], 0, 0, 0);
            }
        float A[4][4], B[4][4];
#pragma unroll
        for (int ct = 0; ct < 4; ++ct) {
            float pa = 1.f, pb = 0.f;
#pragma unroll
            for (int j = 0; j < 4; ++j) {
                const float r = fsig(acc[ct][j] + ba[ct]);
                const float ig = fsig(acc[4 + ct][j] + bx[ct]);
                const float la = -8.f * r * sp[ct];
                const float a = __expf(la);
                const float uu = uw[(4 * g + j) * 65 + 16 * ct + ln];
                const float bb = __builtin_amdgcn_sqrtf(fmaxf(1.f - a * a, 0.f)) * ig * uu;
                pb = a * pb + bb; pa = a * pa;
                A[ct][j] = pa; B[ct][j] = pb;
            }
            float ia = pa, ib = pb;
#pragma unroll
            for (int dd = 1; dd <= 2; dd <<= 1) {
                const float qa = __shfl_up(ia, 16 * dd), qb = __shfl_up(ib, 16 * dd);
                if (g >= dd) { ib = ia * qb + ib; ia = ia * qa; }
            }
            float ea = __shfl_up(ia, 16), eb = __shfl_up(ib, 16);
            if (g == 0) { ea = 1.f; eb = 0.f; }
#pragma unroll
            for (int j = 0; j < 4; ++j) { B[ct][j] = A[ct][j] * eb + B[ct][j]; A[ct][j] = A[ct][j] * ea; }
            if (g == 3) {
                float* ag = agg + (((c & 1) * 4 + w) * 64 + 16 * ct + ln) * 2;
                ag[0] = ia; ag[1] = ib;
            }
        }
        __syncthreads();
#pragma unroll
        for (int ct = 0; ct < 4; ++ct) {
            float hrun = hc[ct], hin = 0.f;
#pragma unroll
            for (int w2 = 0; w2 < 4; ++w2) {
                const float* ag = agg + (((c & 1) * 4 + w2) * 64 + 16 * ct + ln) * 2;
                if (w2 == w) hin = hrun;
                hrun = ag[0] * hrun + ag[1];
            }
            hc[ct] = hrun;
#pragma unroll
            for (int j = 0; j < 4; ++j) {
                const int tok2 = proc_tok(d, 64 * c + 16 * w + 4 * g + j);
                outp[(size_t)tok2 * 512 + 16 * ct + ln] = f2bf(A[ct][j] * hin + B[ct][j]);
            }
        }
    }
    __syncthreads();
}

DEVI void phase_mix(const Params& p, int l, unsigned char* smem) {
    const int NLRU = 128, NRET = (l == 0 ? 576 : 512);
    const int NLAT = 1024, NCTX = (l == 0 ? 128 : 0);
    const int ntask = NLRU + NRET + 2 * NLAT + 2 * NCTX;
    const int ncvt = 3072;
    int cv = BIDX;
    int* ctr = WSI(OFF_CNT) + 128 + l;
    volatile int* nxt = (volatile int*)(smem + 65520);
    for (;;) {
        __syncthreads();
        if (TIDX == 0) *nxt = atomicAdd(ctr, 1);
        __syncthreads();
        const int task = *nxt;
        if (task >= ntask) break;
        if (cv < ncvt) { CvtJob j = get_moe_job(p, l, cv >> 10); if ((cv >> 10) < 2) cvt_tile256_fp8(j, cv & 1023, smem); else cvt_tile256(j, cv & 1023, smem); cv += gridDim.x; }
        if (task < NLRU) lru_walk(p, l, task, smem);
        else if (task >= NLRU + 2 * NLAT && task < NLRU + 2 * NLAT + NRET) {
            const int a = task - NLRU - 2 * NLAT;
            int b, h, m;
            if (l == 0) { b = a / 72; const int r = a % 72; h = r / 18; m = r % 18; }
            else { b = a >> 6; const int r = a & 63; h = r >> 4; m = 2 + (r & 15); }
            ret_out_task(p, l, b, h, m, smem);
        } else {
            int a = task < NLRU + 2 * NLAT ? task - NLRU : task - NLRU - NRET;
            int kind, b, hsel, tq0, nkeys;
            if (a < NLAT) { kind = 0; b = a >> 7; const int r = a & 127; hsel = r >> 4; tq0 = CTXL + (r & 15) * 128; nkeys = TPB; }
            else if (a < 2 * NLAT) { a -= NLAT; kind = 1; b = a >> 7; const int r = a & 127; hsel = r >> 6; tq0 = CTXL + (r & 63) * 32; nkeys = TPB; }
            else if (a < 2 * NLAT + NCTX) { a -= 2 * NLAT; kind = 0; b = a >> 4; const int r = a & 15; hsel = r >> 1; tq0 = (r & 1) * 128; nkeys = CTXL; }
            else { a -= 2 * NLAT + NCTX; kind = 1; b = a >> 4; const int r = a & 15; hsel = r >> 3; tq0 = (r & 7) * 32; nkeys = CTXL; }
            if (kind == 0) attn_task<96, true>(p, b, hsel, tq0, nkeys, smem);
            else attn_task<64, false>(p, b, hsel, tq0, nkeys, smem);
        }
    }
    for (; cv < ncvt; cv += gridDim.x) { CvtJob j = get_moe_job(p, l, cv >> 10); if ((cv >> 10) < 2) cvt_tile256_fp8(j, cv & 1023, smem); else cvt_tile256(j, cv & 1023, smem); }
}

DEVI void phase_fin(const Params& p, int l) {
    const int lane = TIDX & 63, w = TIDX >> 6;
    for (int row = BIDX * 4 + w; row < TT; row += gridDim.x * 4) {
        if (l == 1 && (row % TPB) < CTXL) continue;
        const size_t o = (size_t)row * 512 + lane * 8;
        bf16x8 h0 = *(const bf16x8*)(DB(D_LH0) + o), h1 = *(const bf16x8*)(DB(D_LH1) + o), lg = *(const bf16x8*)(CB(C_LG) + o);
        bf16x8 oc;
#pragma unroll
        for (int e = 0; e < 8; ++e) oc[e] = (short)f2bf((bf2f((bf16_t)h0[e]) + bf2f((bf16_t)h1[e])) * gelu_tanh(bf2f((bf16_t)lg[e])));
        *(bf16x8*)(DB(D_LH0) + o) = oc;
    }
}

DEVI void merge_tile(const Params& p, int l, int mq, int nt, unsigned char* smem) {
    bf16_t* ct = (bf16_t*)smem;
    const int lane = TIDX & 63, wc = (TIDX >> 6) & 1;
    const int mt = mt_of(mq, l != 0);
    const int row0 = mt * 128;
    unsigned mp[4][4][2];
#pragma unroll
    for (int mi = 0; mi < 4; ++mi)
#pragma unroll
        for (int ni = 0; ni < 4; ++ni) { mp[mi][ni][0] = 0u; mp[mi][ni][1] = 0u; }
#pragma unroll 1
    for (int n = 0; n < 4; ++n) {
        unsigned gp[4][4][2];
        {
            f32x4 ag[4][4];
            acc_zero<128>(ag);
            gemm_core_fp8<false>(ag, (const unsigned char*)HB, 2048, row0, (const unsigned char*)WB(W_MG + (size_t)l * 4096 * 1024) + (size_t)(n * 1024 + nt * 128) * 1024, 1024, 1024, smem);
            const float* bm = p.in[I_BMG] + l * 4096 + n * 1024 + nt * 128 + wc * 64 + (lane & 15);
#pragma unroll
            for (int ni = 0; ni < 4; ++ni) {
                const float bias = bm[ni * 16];
#pragma unroll
                for (int mi = 0; mi < 4; ++mi) {
                    gp[mi][ni][0] = (unsigned)f2bf(fsig(ag[mi][ni][0] + bias)) | ((unsigned)f2bf(fsig(ag[mi][ni][1] + bias)) << 16);
                    gp[mi][ni][1] = (unsigned)f2bf(fsig(ag[mi][ni][2] + bias)) | ((unsigned)f2bf(fsig(ag[mi][ni][3] + bias)) << 16);
                }
            }
        }
        f32x4 ap[4][4];
        acc_zero<128>(ap);
        const bf16_t* yb = n == 0 ? DB(D_YA) : (n == 1 ? DB(D_OF) : (n == 2 ? DB(D_LH0) : DB(D_YD)));
        AOp A2{yb, 512, row0, nullptr};
        gemm_core<128>(ap, A2, WB(W_BR + ((size_t)l * 4 + n) * 1024 * 512 + (size_t)(nt * 128) * 512), 512, 512, smem);
#pragma unroll
        for (int mi = 0; mi < 4; ++mi)
#pragma unroll
            for (int ni = 0; ni < 4; ++ni) {
                const float m0 = __uint_as_float(mp[mi][ni][0] << 16) + __uint_as_float(gp[mi][ni][0] << 16) * ap[mi][ni][0];
                const float m1 = __uint_as_float(mp[mi][ni][0] & 0xffff0000u) + __uint_as_float(gp[mi][ni][0] & 0xffff0000u) * ap[mi][ni][1];
                const float m2 = __uint_as_float(mp[mi][ni][1] << 16) + __uint_as_float(gp[mi][ni][1] << 16) * ap[mi][ni][2];
                const float m3 = __uint_as_float(mp[mi][ni][1] & 0xffff0000u) + __uint_as_float(gp[mi][ni][1] & 0xffff0000u) * ap[mi][ni][3];
                mp[mi][ni][0] = (unsigned)f2bf(m0) | ((unsigned)f2bf(m1) << 16);
                mp[mi][ni][1] = (unsigned)f2bf(m2) | ((unsigned)f2bf(m3) << 16);
            }
    }
    __syncthreads();
    {
        const int wid = TIDX >> 6, wr = wid >> 1;
#pragma unroll
        for (int mi = 0; mi < 4; ++mi)
#pragma unroll
            for (int ni = 0; ni < 4; ++ni) {
                bf16_t* cp = ct + (wr * 64 + mi * 16 + (lane >> 4) * 4) * CT_LD + wc * 64 + ni * 16 + (lane & 15);
                cp[0] = (bf16_t)(mp[mi][ni][0] & 0xffffu); cp[CT_LD] = (bf16_t)(mp[mi][ni][0] >> 16);
                cp[2 * CT_LD] = (bf16_t)(mp[mi][ni][1] & 0xffffu); cp[3 * CT_LD] = (bf16_t)(mp[mi][ni][1] >> 16);
            }
    }
    __syncthreads();
    ep_store_rows<128>(ct, 0, CB(C_M) + nt * 128, 1024, row0);
}

DEVI void wout_tile(const Params& p, int l, int mq, int nt, unsigned char* smem) {
    bf16_t* ct = (bf16_t*)smem;
    const int mt = mt_of(mq, l != 0);
    const int row0 = mt * 128, b = mt / 18, t0 = (mt % 18) * 128;
    const bool isctx = (mt % 18) < 2;
    const int bi = isctx ? 8 : b;
    f32x4 acc[4][4];
    acc_zero<128>(acc);
    AOp A{CB(C_M), 1024, row0, nullptr};
    gemm_core<128>(acc, A, WB(W_OUT + (size_t)l * 1024 * 1024 + (size_t)nt * 128 * 1024), 1024, 1024, smem);
    __syncthreads();
    acc_to_ct<128>(acc, ct);
    __syncthreads();
    const float* gate = WSF(OFF_MOD) + (size_t)(l * 9 + bi) * 6144 + 2 * 1024 + nt * 128;
    for (int c = TIDX; c < 128 * 32; c += 256) {
        const int i = c >> 5, jc = c & 31;
        const int t = t0 + i;
        const float* xs;
        if (l == 0) xs = isctx ? p.in[I_CTX] + ((size_t)b * CTXL + t) * DM : p.in[I_X] + ((size_t)b * SEQL + (t - CTXL)) * DM;
        else xs = XCUR + (size_t)(row0 + i) * DM;
        float4 x4 = *(const float4*)(xs + nt * 128 + jc * 4);
        float4 g4 = *(const float4*)(gate + jc * 4);
        uint2 y = *(const uint2*)(ct + i * CT_LD + jc * 4);
        x4.x += g4.x * __uint_as_float(y.x << 16);
        x4.y += g4.y * __uint_as_float(y.x & 0xffff0000u);
        x4.z += g4.z * __uint_as_float(y.y << 16);
        x4.w += g4.w * __uint_as_float(y.y & 0xffff0000u);
        *(float4*)(XCUR + (size_t)(row0 + i) * DM + nt * 128 + jc * 4) = x4;
    }
}

DEVI void phase_merge_wout(const Params& p, int l, unsigned char* smem) {
    const int nmt = (l == 0 ? 144 : 128);
    const int N5 = nmt * 8;
    int* ctr = WSI(OFF_CNT) + 132 + l;
    int* dep = WSI(OFF_CNT) + 256 + l * 160;
    for (;;) {
        const int task = fetch_task(ctr, smem);
        if (task >= 2 * N5) break;
        if (task < N5) {
            merge_tile(p, l, task >> 3, task & 7, smem);
            dep_signal(dep + (task >> 3));
        } else {
            const int t6 = task - N5;
            dep_wait(dep + (t6 >> 3), 8);
            wout_tile(p, l, t6 >> 3, t6 & 7, smem);
        }
    }
}

DEVI void phase_route(const Params& p, int l, unsigned char* smem) {
    const int tid = TIDX, lane = tid & 63, w = tid >> 6, wr = w >> 1, wc = w & 1;
    float* lgt = (float*)smem;
    const float rbias = p.in[I_RB][lane];
    int* cnt = WSI(OFF_CNT) + l * 64;
    int* list = WSI(OFF_LIST);
    const int ntile = l == 0 ? 144 : 128;
    for (int q = BIDX; q < ntile; q += gridDim.x) {
        const int mt = mt_of(q, l != 0);
        const int row0 = mt * 128;
        f32x4 acc[4][2];
        acc_zero<64>(acc);
        AOp A{HB, 1024, row0, nullptr};
        gemm_core<64>(acc, A, WB(W_RT), 1024, 1024, smem);
        __syncthreads();
#pragma unroll
        for (int mi = 0; mi < 4; ++mi)
#pragma unroll
            for (int ni = 0; ni < 2; ++ni)
#pragma unroll
                for (int j = 0; j < 4; ++j)
                    lgt[(wr * 64 + mi * 16 + (lane >> 4) * 4 + j) * 68 + wc * 32 + ni * 16 + (lane & 15)] = acc[mi][ni][j];
        __syncthreads();
        int me0 = 0, me1 = 0; float ms0 = 0.f, ms1 = 0.f;
#pragma unroll 2
        for (int i = 0; i < 32; ++i) {
            const float lg = lgt[(w * 32 + i) * 68 + lane];
            const float score = sigmoidf_(lg);
            const float biased = score + rbias;
            float v1 = biased; int i1 = lane;
#pragma unroll
            for (int off = 1; off < 8; off <<= 1) {
                float ov = __shfl_xor(v1, off); int oi = __shfl_xor(i1, off);
                if (ov > v1 || (ov == v1 && oi < i1)) { v1 = ov; i1 = oi; }
            }
            float v2 = (lane == i1) ? -3.0e38f : biased; int i2 = lane;
#pragma unroll
            for (int off = 1; off < 8; off <<= 1) {
                float ov = __shfl_xor(v2, off); int oi = __shfl_xor(i2, off);
                if (ov > v2 || (ov == v2 && oi < i2)) { v2 = ov; i2 = oi; }
            }
            float gv = v1 + v2; int gi = lane >> 3;
#pragma unroll
            for (int off = 8; off < 64; off <<= 1) {
                float ov = __shfl_xor(gv, off); int oi = __shfl_xor(gi, off);
                if (ov > gv || (ov == gv && oi < gi)) { gv = ov; gi = oi; }
            }
            const int e0 = __shfl(i1, gi * 8), e1 = __shfl(i2, gi * 8);
            const float s0 = __shfl(score, e0), s1 = __shfl(score, e1);
            if (lane == i) { me0 = e0; me1 = e1; ms0 = s0; ms1 = s1; }
        }
        int* hist = (int*)(smem + 36864);
        int* base = hist + 64;
        if (tid < 64) hist[tid] = 0;
        __syncthreads();
        int r0 = 0, r1 = 0;
        if (lane < 32) { r0 = atomicAdd(&hist[me0], 1); r1 = atomicAdd(&hist[me1], 1); }
        __syncthreads();
        if (tid < 64) { const int hc = hist[tid]; base[tid] = hc ? atomicAdd(&cnt[tid], hc) : 0; }
        __syncthreads();
        if (lane < 32) {
            const int row = row0 + w * 32 + lane;
            Rec rc;
            rc.e0 = me0; rc.e1 = me1;
            rc.p0 = base[me0] + r0;
            rc.p1 = base[me1] + r1;
            const float inv = 1.f / (ms0 + ms1);
            rc.w0 = ms0 * inv; rc.w1 = ms1 * inv; rc.pad0 = 0; rc.pad1 = 0;
            list[(size_t)me0 * TT + rc.p0] = row;
            list[(size_t)me1 * TT + rc.p1] = row;
            ((Rec*)(p.ws + OFF_REC))[row] = rc;
        }
        __syncthreads();
    }
}

struct MoeGrp { int ne[8], sg[8], cn[8]; };
DEVI MoeGrp moe_grp(const MoeTab& mt, const GrpInfo& gi) {
    MoeGrp g;
#pragma unroll
    for (int q = 0; q < 8; ++q) {
        const int ee = gi.ngrp == 8 ? gi.xcd * 8 + q : 0;
        g.cn[q] = mt.cnt(ee); g.sg[q] = mt.seg(ee); g.ne[q] = (g.cn[q] + 127) >> 7;
    }
    return g;
}
DEVI bool moe_tile(const MoeTab& mt, const MoeGrp& mg, const GrpInfo& gi, int it, int NT, int& e, int& jt, int& nt, int& cn, int& sg) {
    int rem = gi.j + gi.per * it;
    if (gi.ngrp == 8) {
#pragma unroll
        for (int q = 0; q < 8; ++q) {
            const int ne = mg.ne[q] * NT;
            if (rem < ne) { e = gi.xcd * 8 + q; jt = rem / NT; nt = rem % NT; cn = mg.cn[q]; sg = mg.sg[q]; return true; }
            rem -= ne;
        }
        return false;
    }
    for (int ee = 0; ee < 64; ++ee) {
        const int c = mt.cnt(ee);
        const int ne = ((c + 127) >> 7) * NT;
        if (rem < ne) { e = ee; jt = rem / NT; nt = rem % NT; cn = c; sg = mt.seg(ee); return true; }
        rem -= ne;
    }
    return false;
}
struct MoeRegs { int tp, cnt, seg; };
DEVI void moe_find(const MoeRegs& mr, int rt, int& e, int& jt, int& cn, int& sg) {
    const unsigned long long m = __ballot(mr.tp <= rt);
    e = __popcll(m) - 1;
    jt = rt - __shfl(mr.tp, e); cn = __shfl(mr.cnt, e); sg = __shfl(mr.seg, e);
}
DEVI void phase_moe(const Params& p, int l, unsigned char* smem) {
    bf16_t* ct = (bf16_t*)smem;
    int* ridx = (int*)(smem + AUX_OFF);
    MoeTab mt = moe_tables(p, l, smem);
    const int* list = WSI(OFF_LIST);
    const int nrt = mt.tp(64);
    MoeRegs mr; mr.tp = mt.tp(TIDX & 63); mr.cnt = mt.cnt(TIDX & 63); mr.seg = mt.seg(TIDX & 63);
    int* ctr = WSI(OFF_CNT) + 136 + l;
    int* dep = WSI(OFF_CNT) + 1024 + l * 384;
    for (;;) {
        const int task = fetch_task(ctr, smem);
        if (task >= nrt * 12) break;
        if (task < nrt * 4) {
            const int rt = task >> 2, nt = task & 3;
            int e, jt, cn, sg;
            moe_find(mr, rt, e, jt, cn, sg);
            if (TIDX < 128) {
                const int idx = jt * 128 + TIDX;
                ridx[TIDX] = list[(size_t)e * TT + (idx < cn ? idx : 0)];
            }
            __syncthreads();
            f32x4 acc[4][4];
            acc_zero<128>(acc);
            gemm_core_fp8<true>(acc, (const unsigned char*)CB(0), 1024, 0, (const unsigned char*)MWB(MW_13) + ((size_t)e * 512 + nt * 128) * 1024, 1024, 1024, smem, ridx);
            __syncthreads();
            acc_to_ct<128>(acc, ct);
            __syncthreads();
            const int slot0 = sg + jt * 128;
            for (int c = TIDX; c < 128 * 8; c += 256) {
                const int i = c >> 3, jc = c & 7;
                bf16x8 a = *(const bf16x8*)(ct + i * CT_LD + jc * 8), g = *(const bf16x8*)(ct + i * CT_LD + 64 + jc * 8), o;
#pragma unroll
                for (int q = 0; q < 8; ++q) o[q] = (short)f2bf(siluf_(bf2f((bf16_t)a[q])) * bf2f((bf16_t)g[q]));
                *(bf16x8*)(DB(D_ACT) + (size_t)(slot0 + i) * 256 + nt * 64 + jc * 8) = o;
            }
            dep_signal(dep + rt);
        } else {
            const int t2 = task - nrt * 4;
            const int rt = t2 >> 3, nt = t2 & 7;
            int e, jt, cn, sg;
            moe_find(mr, rt, e, jt, cn, sg);
            const int slot0 = sg + jt * 128;
            dep_wait(dep + rt, 4);
            f32x4 acc[4][4];
            acc_zero<128>(acc);
            AOp A{DB(D_ACT), 256, slot0, nullptr};
            gemm_core<128>(acc, A, MWB(MW_2) + ((size_t)e * 1024 + nt * 128) * 256, 256, 256, smem);
            __syncthreads();
            acc_to_ct<128>(acc, ct);
            __syncthreads();
            ep_store_rows<128>(ct, 0, DB(D_YS) + nt * 128, 1024, slot0);
        }
    }
}

#define XB_TMO      128
#define XB_XCNT(j)  (256  + 64 * (j))
#define XB_XSUB(j)  (1280 + 64 * (j))
#define XB_XGEN(j)  (2304 + 64 * (j))
#define XB_TOP      3328
#define XB_TOPGEN   3392
#define XB_SPIN_CAP (1u << 22)
DEVI unsigned xb_ld(unsigned* p) { return __hip_atomic_load(p, __ATOMIC_RELAXED, __HIP_MEMORY_SCOPE_AGENT); }
DEVI unsigned xb_add(unsigned* p, unsigned v) { return __hip_atomic_fetch_add(p, v, __ATOMIC_RELAXED, __HIP_MEMORY_SCOPE_AGENT); }
DEVI unsigned xb_xcc_id() { return (unsigned)__builtin_amdgcn_s_getreg((3 << 11) | 20) & 0xFu; }
#define XB_SPIN(cond, bar) do { unsigned _sp = 0; while (cond) { __builtin_amdgcn_s_sleep(1); \
    if ((++_sp & 255u) == 0u) { if (xb_ld(&(bar)[XB_TMO])) break; if (_sp > XB_SPIN_CAP) { atomicAdd(&(bar)[XB_TMO], 1u); break; } } } } while (0)
struct XcdBarrier { unsigned* bar; unsigned x; unsigned* st; };
DEVI XcdBarrier xcd_barrier_post(unsigned* bar, unsigned* st) {
    XcdBarrier b; b.bar = bar; b.x = xb_xcc_id(); b.st = st;
    if (__builtin_amdgcn_workitem_id_x() == 0) (void)xb_add(&bar[XB_XCNT(b.x)], 1u);
    return b;
}
DEVI void xcd_barrier_complete(unsigned* bar, unsigned x, unsigned& nloc, unsigned& nx) {
    const unsigned G = gridDim.x * gridDim.y * gridDim.z;
    unsigned sum, cnt, mine, sp = 0u;
    for (;;) {
        sum = 0u; cnt = 0u; mine = 0u;
#pragma unroll
        for (unsigned j = 0; j < 16; ++j) { const unsigned c = xb_ld(&bar[XB_XCNT(j)]); sum += c; cnt += (c > 0u) ? 1u : 0u; mine = (j == x) ? c : mine; }
        if (sum == G) break;
        __builtin_amdgcn_s_sleep(1);
        if ((++sp & 255u) == 0u) { if (xb_ld(&bar[XB_TMO])) break; if (sp > XB_SPIN_CAP) { atomicAdd(&bar[XB_TMO], 1u); break; } }
    }
    nloc = mine > 0u ? mine : 1u; nx = cnt > 0u ? cnt : 1u;
}
DEVI void xcd_barrier(const XcdBarrier& b) {
    asm volatile("s_waitcnt vmcnt(0)" ::: "memory");
    __syncthreads();
    if (__builtin_amdgcn_workitem_id_x() == 0) {
        unsigned* bar = b.bar;
        __builtin_amdgcn_s_waitcnt(0);
        unsigned nloc = xb_ld(&b.st[0]), nx = xb_ld(&b.st[1]);
        if (nloc == 0u) { xcd_barrier_complete(bar, b.x, nloc, nx); __hip_atomic_store(&b.st[0], nloc, __ATOMIC_RELAXED, __HIP_MEMORY_SCOPE_AGENT); __hip_atomic_store(&b.st[1], nx, __ATOMIC_RELAXED, __HIP_MEMORY_SCOPE_AGENT); }
        const unsigned old = xb_add(&bar[XB_XSUB(b.x)], 1u);
        const unsigned gen = old / nloc;
        if (old + 1u == (gen + 1u) * nloc) {
            __builtin_amdgcn_fence(__ATOMIC_RELEASE, "agent");
            asm volatile("s_waitcnt vmcnt(0)" ::: "memory");
            const unsigned og = xb_add(&bar[XB_TOP], 1u);
            const unsigned tg = og / nx;
            if (og + 1u == (tg + 1u) * nx) xb_add(&bar[XB_TOPGEN], 1u);
            else XB_SPIN(xb_ld(&bar[XB_TOPGEN]) == tg, bar);
            __builtin_amdgcn_fence(__ATOMIC_ACQUIRE, "agent");
            xb_add(&bar[XB_XGEN(b.x)], 1u);
            asm volatile("s_waitcnt vmcnt(0)" ::: "memory");
        } else {
            XB_SPIN(xb_ld(&bar[XB_XGEN(b.x)]) == gen, bar);
            __builtin_amdgcn_fence(__ATOMIC_ACQUIRE, "agent");
            asm volatile("s_waitcnt vmcnt(0)" ::: "memory");
        }
    }
    __syncthreads();
}

constexpr int NPHASE = 24;
DEVI void run_phase(const Params& p, int ph, unsigned char* smem) {
#ifndef ONLYK
    if (ph == 0) { phase0(p, smem); return; }
    if (ph == 23) { phase_norm1(p, 1, 1, smem); return; }
#endif
    const int l = (ph - 1) / 11, k = (ph - 1) % 11;
#ifdef ONLYK
    if (k != ONLYK) return;
#endif
    switch (k) {
    case 0: phase_norm1(p, l, 0, smem); break;
    case 1: phase_win(p, l, smem); break;
    case 2: phase_mla_up(p, l, smem); break;
    case 3: phase_mix(p, l, smem); break;
    case 4: phase_fin(p, l); break;
    case 5: phase_merge_wout(p, l, smem); break;
    case 6: break;
    case 7: phase_norm1(p, l, 2, smem); break;
    case 8: phase_route(p, l, smem); break;
    case 9: phase_moe(p, l, smem); break;
    default: break;
    }
}

__global__ void __launch_bounds__(256, 2) k_main(Params p, int ph_lo, int ph_hi) {
    __shared__ __attribute__((aligned(16))) unsigned char smem[SMEM_BYTES];
    unsigned* xb_priv = (unsigned*)(p.ws + OFF_PRIV + (size_t)__builtin_amdgcn_workgroup_id_x() * 1024 + 896);
    if (__builtin_amdgcn_workitem_id_x() == 0) { __hip_atomic_store(xb_priv, 0u, __ATOMIC_RELAXED, __HIP_MEMORY_SCOPE_AGENT); __hip_atomic_store(xb_priv + 1, 0u, __ATOMIC_RELAXED, __HIP_MEMORY_SCOPE_AGENT); }
    XcdBarrier xb = xcd_barrier_post((unsigned*)(p.ws + OFF_BAR), xb_priv);
    if (__builtin_amdgcn_workitem_id_x() == 0) {
        const unsigned rk = xb_add((unsigned*)(p.ws + OFF_BAR) + 3456 + xb.x, 1u);
        __hip_atomic_store(xb_priv + 2, xb.x, __ATOMIC_RELAXED, __HIP_MEMORY_SCOPE_AGENT);
        __hip_atomic_store(xb_priv + 3, rk, __ATOMIC_RELAXED, __HIP_MEMORY_SCOPE_AGENT);
    }
    for (int ph = ph_lo; ph < ph_hi; ++ph) {
        if (ph >= 1 && ph <= 22 && (((ph - 1) % 11) == 6 || ((ph - 1) % 11) == 10)) continue;
        run_phase(p, ph, smem);
#ifdef DUPK
        if (ph >= 1 && ph <= 22 && ((ph - 1) % 11) == DUPK) run_phase(p, ph, smem);
        if (DUPK == 10 && ph == 0) run_phase(p, ph, smem);
#endif
        if (ph + 1 < ph_hi) {
            if (ph_hi < 0) cg::this_grid().sync();
            xcd_barrier(xb);
        }
    }
#ifdef TPROBE
    if (__builtin_amdgcn_workgroup_id_x() == 0 && __builtin_amdgcn_workitem_id_x() == 0) {
        const unsigned long long dt = __hip_atomic_load(T_SLOT(TPROBE), __ATOMIC_RELAXED, __HIP_MEMORY_SCOPE_AGENT) * TMULT;
        const unsigned long long t0 = __builtin_amdgcn_s_memrealtime();
        while (__builtin_amdgcn_s_memrealtime() - t0 < dt) __builtin_amdgcn_s_sleep(8);
    }
#endif
}

extern "C" void kernel_launch(void* const* d_in, const int* in_sizes, int n_in, void* d_out, int out_size, void* d_ws, size_t ws_size,
                              hipStream_t stream) {
    if (ws_size < WS_NEED || n_in < N_IN) { fprintf(stderr, "workspace too small: %zu < %zu\n", ws_size, (size_t)WS_NEED); return; }
    Params p{};
    for (int i = 0; i < N_IN; ++i) p.in[i] = (const float*)d_in[i];
    p.out = (float*)d_out;
    p.ws = (unsigned char*)d_ws;
    static int grid_blocks = 0;
    if (!grid_blocks) {
        int dev = 0, cus = 0, per_cu = 0;
        hipGetDevice(&dev);
        hipDeviceGetAttribute(&cus, hipDeviceAttributeMultiprocessorCount, dev);
        hipOccupancyMaxActiveBlocksPerMultiprocessor(&per_cu, k_main, 256, DYN_LDS);
        if (per_cu > 2) per_cu = 2;
        if (per_cu < 1) per_cu = 1;
        grid_blocks = cus * per_cu;
    }
    hipMemsetAsync(p.ws + OFF_BAR, 0, 16384, stream);
#if ONE_LAUNCH
    int lo = 0, hi = NPHASE;
    void* args[] = {&p, &lo, &hi};
    hipError_t e = hipLaunchCooperativeKernel((void*)k_main, dim3(grid_blocks), dim3(256), args, DYN_LDS, stream);
    if (e != hipSuccess) fprintf(stderr, "cooperative launch failed: %s (grid %d)\n", hipGetErrorString(e), grid_blocks);
#else
    for (int ph = 0; ph < NPHASE; ++ph) hipLaunchKernelGGL(k_main, dim3(grid_blocks), dim3(256), DYN_LDS, stream, p, ph, ph + 1);
#endif
}
```

```cpp
#include <hip/hip_runtime.h>
#include <hip/hip_cooperative_groups.h>
#include <stdint.h>
#include <stdio.h>
namespace cg = cooperative_groups;

#define DEVI __device__ __forceinline__
#define LAS __attribute__((address_space(3)))
typedef unsigned short bf16_t;
typedef __attribute__((ext_vector_type(8))) short bf16x8;
typedef __attribute__((ext_vector_type(4))) float f32x4;
typedef __attribute__((ext_vector_type(16))) float f32x16;
typedef __attribute__((ext_vector_type(4))) short bf16x4;

#ifndef NAIVE_GEMM
#define NAIVE_GEMM 0
#endif
#ifndef ONE_LAUNCH
#define ONE_LAUNCH 1
#endif

constexpr int DM = 1024, NBT = 8, SEQL = 2048, CTXL = 256, TPB = 2304, TT = 18432;
constexpr int DINP = 3840;
constexpr float LOG2E = 1.4426950408889634f;
constexpr float EPSV = 1e-6f;
constexpr int NSLOT = 2 * TT + 64 * 128;

enum { I_X = 0, I_C, I_CTX, I_CCTX, I_ADAW, I_ADAB, I_N1G, I_N2G, I_WIN, I_MQN, I_MKVN, I_WUQ, I_WUKV, I_RDEC, I_RNORM,
       I_LCW, I_LCB, I_LWA, I_LBA, I_LWX, I_LBX, I_LLAM, I_GQN, I_GKN, I_WBR, I_WMG, I_BMG, I_WOUT, I_RW, I_RB,
       I_W1, I_W3, I_W2, I_FN, N_IN };

constexpr size_t AL(size_t x) { return (x + 255) & ~(size_t)255; }
constexpr size_t OFF_BAR = 0;
constexpr size_t OFF_CNT = 16384;
constexpr size_t OFF_MOD = OFF_CNT + 16384;
constexpr size_t OFF_R64 = AL(OFF_MOD + (size_t)2 * 9 * 6144 * 4);
constexpr size_t OFF_R32 = OFF_R64 + (size_t)2048 * 64 * 4;
constexpr size_t OFF_REC = OFF_R32 + (size_t)2048 * 32 * 4;
constexpr size_t OFF_LIST = OFF_REC + (size_t)TT * 32;
constexpr size_t OFF_PRIV = AL(OFF_LIST + (size_t)64 * TT * 4);
constexpr size_t OFF_W = OFF_PRIV + (size_t)2048 * 1024;
constexpr size_t W_IN = 0;
constexpr size_t W_UQ = W_IN + (size_t)2 * 3840 * 1024;
constexpr size_t W_UKV = W_UQ + (size_t)2 * 768 * 256;
constexpr size_t W_BR = W_UKV + (size_t)2 * 1024 * 128;
constexpr size_t W_MG = W_BR + (size_t)2 * 4 * 1024 * 512;
constexpr size_t W_OUT = W_MG + (size_t)2 * 4096 * 1024;
constexpr size_t W_LRU = W_OUT + (size_t)2 * 1024 * 1024;
constexpr size_t W_RT = W_LRU + (size_t)2 * 2 * 8 * 2 * 64 * 64;
constexpr size_t W_END = W_RT + (size_t)64 * 1024;
constexpr size_t OFF_XCUR = AL(OFF_W + W_END * 2);
constexpr size_t OFF_H = OFF_XCUR + (size_t)TT * 1024 * 4;
constexpr size_t OFF_C = OFF_H + (size_t)TT * 1024 * 2;
constexpr size_t C_CQ = 0;
constexpr size_t C_CKV = C_CQ + (size_t)TT * 256;
constexpr size_t C_KR = C_CKV + (size_t)TT * 128;
constexpr size_t C_MQ = C_KR + (size_t)TT * 32;
constexpr size_t C_KN = C_MQ + (size_t)TT * 768;
constexpr size_t C_VMT = C_KN + (size_t)TT * 512;
constexpr size_t C_RQ = C_VMT + (size_t)TT * 512;
constexpr size_t C_RK = C_RQ + (size_t)TT * 256;
constexpr size_t C_RKT = C_RK + (size_t)TT * 256;
constexpr size_t C_RVT = C_RKT + (size_t)TT * 256;
constexpr size_t C_RG = C_RVT + (size_t)TT * 512;
constexpr size_t C_LX = C_RG + (size_t)TT * 512;
constexpr size_t C_LG = C_LX + (size_t)TT * 512;
constexpr size_t C_GQ = C_LG + (size_t)TT * 512;
constexpr size_t C_GK = C_GQ + (size_t)TT * 512;
constexpr size_t C_GVT = C_GK + (size_t)TT * 128;
constexpr size_t C_END = C_GVT + (size_t)TT * 128;
constexpr size_t C_M = 0;
constexpr size_t C_W13 = (size_t)24 * 1024 * 1024;
constexpr size_t C_W2 = C_W13 + (size_t)64 * 512 * 1024;
static_assert(C_W2 + (size_t)64 * 1024 * 256 <= C_END, "moe alias");
static_assert((size_t)TT * 1024 <= C_W13, "m alias");
constexpr size_t OFF_D = OFF_C + C_END * 2;
constexpr size_t D_YA = 0;
constexpr size_t D_YD = (size_t)TT * 512;
constexpr size_t D_OF = (size_t)2 * TT * 512;
constexpr size_t D_OB = (size_t)3 * TT * 512;
constexpr size_t D_LH0 = (size_t)4 * TT * 512;
constexpr size_t D_LH1 = (size_t)5 * TT * 512;
constexpr size_t D_ACT = 0;
constexpr size_t D_YS = (size_t)12 * 1024 * 1024;
constexpr size_t D_END = D_YS + (size_t)NSLOT * 1024;
static_assert((size_t)NSLOT * 256 <= D_YS, "act alias");
static_assert((size_t)6 * TT * 512 <= D_END, "d size");
constexpr size_t OFF_MOEW = AL(OFF_D + D_END * 2);
constexpr size_t MW_13 = 0, MW_2 = (size_t)64 * 512 * 1024, MW_END = MW_2 + (size_t)64 * 1024 * 256;
constexpr size_t WS_NEED = OFF_MOEW + MW_END * 2;

struct Params {
    const float* in[N_IN];
    float* out;
    unsigned char* ws;
};

#define WSF(off) ((float*)(p.ws + (off)))
#define WSI(off) ((int*)(p.ws + (off)))
#define WB(el) ((bf16_t*)(p.ws + OFF_W) + (el))
#define CB(el) ((bf16_t*)(p.ws + OFF_C) + (el))
#define DB(el) ((bf16_t*)(p.ws + OFF_D) + (el))
#define MWB(el) ((bf16_t*)(p.ws + OFF_MOEW) + (el))
#define HB ((bf16_t*)(p.ws + OFF_H))
#define XCUR ((float*)(p.ws + OFF_XCUR))

constexpr int SMEM_BYTES = 65536;
constexpr int DYN_LDS = 0;
constexpr int CT_LD = 136;
constexpr int AUX_OFF = 36864;

#ifdef TPROBE
#define T_SLOT(id) ((unsigned long long*)(p.ws + OFF_BAR + 14400) + (id))
#define T_BEGIN(id) const unsigned long long _tb##id = __builtin_amdgcn_s_memrealtime()
#define T_END(id, cond) do { if ((cond) && __builtin_amdgcn_workitem_id_x() == 0) atomicAdd(T_SLOT(id), __builtin_amdgcn_s_memrealtime() - _tb##id); } while (0)
#else
#define T_BEGIN(id)
#define T_END(id, cond)
#endif
DEVI int launder_tid() { int t = __builtin_amdgcn_workitem_id_x(); asm volatile("" : "+v"(t)); return t; }
DEVI int launder_bid() { int t = __builtin_amdgcn_workgroup_id_x(); asm volatile("" : "+s"(t)); return t; }
#define TIDX launder_tid()
#define BIDX launder_bid()
DEVI float bf2f(bf16_t v) { return __uint_as_float(((unsigned)v) << 16); }
DEVI bf16_t f2bf(float f) {
    __bf16 h = (__bf16)f;
    return __builtin_bit_cast(unsigned short, h);
}
typedef __attribute__((ext_vector_type(8))) int i32x8;
typedef __attribute__((ext_vector_type(4))) int i32x4;
DEVI float clamp8(float x) { return __builtin_amdgcn_fmed3f(x, -448.f, 448.f); }
DEVI int pk4_fp8(float a, float b, float c, float d) {
    int r = __builtin_amdgcn_cvt_pk_fp8_f32(clamp8(a), clamp8(b), 0, false);
    return __builtin_amdgcn_cvt_pk_fp8_f32(clamp8(c), clamp8(d), r, true);
}
DEVI float fsig(float x) { return __builtin_amdgcn_rcpf(1.f + __expf(-x)); }
DEVI float sigmoidf_(float x) { return 1.f / (1.f + __expf(-x)); }
DEVI float siluf_(float x) { return x / (1.f + __expf(-x)); }
DEVI float gelu_tanh(float x) {
    float u = 0.7978845608028654f * (x + 0.044715f * x * x * x);
    return 0.5f * x * (1.f + tanhf(u));
}
DEVI float wave_sum(float v) {
#pragma unroll
    for (int o = 32; o > 0; o >>= 1) v += __shfl_xor(v, o);
    return v;
}
DEVI int mt_of(int q, bool latonly) { return latonly ? (q >> 4) * 18 + 2 + (q & 15) : q; }

struct CvtJob { const float* src; bf16_t* dst; const float* ks; int K, N, ldd, batch; size_t sbs, dbs; int mode; int lds, n0, wide; };
DEVI int cvt_rowmap(int mode, int n) {
    if (mode == 1) return n < 384 ? n : (n < 416 ? n - 384 + 3712 : n - 32);
    if (mode == 2) { int h = n / 96, j = n % 96; return j < 64 ? h * 64 + j : 512 + h * 32 + (j - 64); }
    if (mode == 3) return (n >> 6) * 128 + (n & 63);
    return n;
}
DEVI void cvt_tile(const CvtJob& j, int tile, float* lds) {
    const int tn = j.N / 32, tk = j.K / 64, per = tn * tk;
    const int bb = tile / per, r = tile % per, kt = r / tn, nt = r % tn;
    const float* s = j.src + (size_t)bb * j.sbs + (size_t)(kt * 64) * j.lds + j.n0 + nt * 32;
    const int tx = TIDX & 31, ty = TIDX >> 5;
#pragma unroll
    for (int i = 0; i < 8; ++i) {
        int k = ty + 8 * i;
        float v = s[(size_t)k * j.lds + tx];
        if (j.ks) v *= j.ks[kt * 64 + k];
        lds[k * 33 + tx] = v;
    }
    __syncthreads();
    bf16_t* d = j.dst + (size_t)bb * j.dbs;
#pragma unroll
    for (int i = 0; i < 4; ++i) {
        int n = ty + 8 * i, kk = tx * 2;
        unsigned lo = f2bf(lds[kk * 33 + n]), hi = f2bf(lds[(kk + 1) * 33 + n]);
        int row = cvt_rowmap(j.mode, j.n0 + nt * 32 + n);
        *(unsigned*)(d + (size_t)row * j.ldd + kt * 64 + kk) = lo | (hi << 16);
    }
    __syncthreads();
}

DEVI void cvt_tile256(const CvtJob& j, int tile, unsigned char* smem) {
    constexpr int NS = 68;
    bf16_t* T = (bf16_t*)smem;
    const int tn = j.N / 256, tk = j.K / 64, per = tn * tk;
    const int bb = tile / per, r = tile % per, kt = r / tn, nt = r % tn;
    const float* s = j.src + (size_t)bb * j.sbs + (size_t)(kt * 64) * j.lds + j.n0 + nt * 256;
    const int tid = TIDX, lane = tid & 63, w = tid >> 6;
    float4 v[16];
#pragma unroll
    for (int i = 0; i < 16; ++i) v[i] = *(const float4*)(s + (size_t)(w * 16 + i) * j.lds + lane * 4);
    if (j.ks) {
#pragma unroll
        for (int i = 0; i < 16; ++i) { const float sc = j.ks[kt * 64 + w * 16 + i]; v[i].x *= sc; v[i].y *= sc; v[i].z *= sc; v[i].w *= sc; }
    }
    __syncthreads();
#pragma unroll
    for (int h = 0; h < 2; ++h) {
        bf16x4 q0a, q0b, q1a, q1b, q2a, q2b, q3a, q3b;
#pragma unroll
        for (int e = 0; e < 4; ++e) {
            q0a[e] = (short)f2bf(v[h * 8 + e].x); q0b[e] = (short)f2bf(v[h * 8 + 4 + e].x);
            q1a[e] = (short)f2bf(v[h * 8 + e].y); q1b[e] = (short)f2bf(v[h * 8 + 4 + e].y);
            q2a[e] = (short)f2bf(v[h * 8 + e].z); q2b[e] = (short)f2bf(v[h * 8 + 4 + e].z);
            q3a[e] = (short)f2bf(v[h * 8 + e].w); q3b[e] = (short)f2bf(v[h * 8 + 4 + e].w);
        }
        bf16_t* tp = T + (lane * 4) * NS + w * 16 + h * 8;
        *(bf16x4*)(tp) = q0a; *(bf16x4*)(tp + 4) = q0b;
        *(bf16x4*)(tp + NS) = q1a; *(bf16x4*)(tp + NS + 4) = q1b;
        *(bf16x4*)(tp + 2 * NS) = q2a; *(bf16x4*)(tp + 2 * NS + 4) = q2b;
        *(bf16x4*)(tp + 3 * NS) = q3a; *(bf16x4*)(tp + 3 * NS + 4) = q3b;
    }
    __syncthreads();
    bf16_t* d = j.dst + (size_t)bb * j.dbs;
#pragma unroll
    for (int i = 0; i < 8; ++i) {
        const int c = tid + 256 * i, n = c >> 3, kc = c & 7;
        const bf16x4 lo = *(const bf16x4*)(T + n * NS + kc * 8), hi = *(const bf16x4*)(T + n * NS + kc * 8 + 4);
        const int row = cvt_rowmap(j.mode, j.n0 + nt * 256 + n);
        *(bf16x8*)(d + (size_t)row * j.ldd + kt * 64 + kc * 8) = bf16x8{lo[0], lo[1], lo[2], lo[3], hi[0], hi[1], hi[2], hi[3]};
    }
}
constexpr float W8_SCALE = 32.f;
DEVI void cvt_tile256_fp8(const CvtJob& j, int tile, unsigned char* smem) {
    constexpr int RS = 80;
    const int tn = j.N / 256, tk = j.K / 64, per = tn * tk;
    const int bb = tile / per, r = tile % per, kt = r / tn, nt = r % tn;
    const float* s = j.src + (size_t)bb * j.sbs + (size_t)(kt * 64) * j.lds + nt * 256;
    const int tid = TIDX, lane = tid & 63, w = tid >> 6;
    float4 v[16];
#pragma unroll
    for (int i = 0; i < 16; ++i) v[i] = *(const float4*)(s + (size_t)(w * 16 + i) * j.lds + lane * 4);
    __syncthreads();
    i32x4 q0, q1, q2, q3;
#pragma unroll
    for (int c = 0; c < 4; ++c) {
        q0[c] = pk4_fp8(v[4 * c].x * W8_SCALE, v[4 * c + 1].x * W8_SCALE, v[4 * c + 2].x * W8_SCALE, v[4 * c + 3].x * W8_SCALE);
        q1[c] = pk4_fp8(v[4 * c].y * W8_SCALE, v[4 * c + 1].y * W8_SCALE, v[4 * c + 2].y * W8_SCALE, v[4 * c + 3].y * W8_SCALE);
        q2[c] = pk4_fp8(v[4 * c].z * W8_SCALE, v[4 * c + 1].z * W8_SCALE, v[4 * c + 2].z * W8_SCALE, v[4 * c + 3].z * W8_SCALE);
        q3[c] = pk4_fp8(v[4 * c].w * W8_SCALE, v[4 * c + 1].w * W8_SCALE, v[4 * c + 2].w * W8_SCALE, v[4 * c + 3].w * W8_SCALE);
    }
    unsigned char* tp = smem + (lane * 4) * RS + w * 16;
    *(i32x4*)(tp) = q0; *(i32x4*)(tp + RS) = q1; *(i32x4*)(tp + 2 * RS) = q2; *(i32x4*)(tp + 3 * RS) = q3;
    __syncthreads();
    unsigned char* d = (unsigned char*)j.dst + (size_t)bb * j.dbs;
#pragma unroll
    for (int i = 0; i < 4; ++i) {
        const int c = tid + 256 * i, n = c >> 2, kc = c & 3;
        *(i32x4*)(d + (size_t)cvt_rowmap(j.mode, nt * 256 + n) * j.ldd + kt * 64 + kc * 16) = *(const i32x4*)(smem + n * RS + kc * 16);
    }
}
__constant__ const int CVT_TILES[10] = {224, 80, 12, 8, 128, 256, 64, 32, 32, 32};
constexpr int CVT_PER_LAYER = 224 + 80 + 12 + 8 + 128 + 256 + 64 + 32 + 32 + 32;
DEVI CvtJob get_job(const Params& p, int l, int k) {
    CvtJob j; j.ks = nullptr; j.batch = 1; j.sbs = 0; j.dbs = 0; j.mode = 0; j.n0 = 0; j.wide = 1;
    switch (k) {
    case 0: j.src = p.in[I_WIN] + (size_t)l * 1024 * 3744; j.dst = WB(W_IN + (size_t)l * 3840 * 1024); j.K = 1024; j.N = 3584; j.lds = 3744; j.ldd = 1024; j.mode = 1; break;
    case 1: j.src = p.in[I_WIN] + (size_t)l * 1024 * 3744; j.dst = WB(W_IN + (size_t)l * 3840 * 1024); j.K = 1024; j.N = 160; j.lds = 3744; j.n0 = 3584; j.ldd = 1024; j.mode = 1; j.wide = 0; break;
    case 2: j.src = p.in[I_WUQ] + (size_t)l * 256 * 768; j.dst = WB(W_UQ + (size_t)l * 768 * 256); j.K = 256; j.N = 768; j.lds = 768; j.ldd = 256; j.ks = p.in[I_MQN] + l * 256; j.mode = 2; break;
    case 3: j.src = p.in[I_WUKV] + (size_t)l * 128 * 1024; j.dst = WB(W_UKV + (size_t)l * 1024 * 128); j.K = 128; j.N = 1024; j.lds = 1024; j.ldd = 128; j.ks = p.in[I_MKVN] + l * 128; break;
    case 4: j.src = p.in[I_WBR] + (size_t)l * 4 * 512 * 1024; j.dst = WB(W_BR + (size_t)l * 4 * 1024 * 512); j.K = 512; j.N = 1024; j.lds = 1024; j.ldd = 512; j.batch = 4; j.sbs = 512 * 1024; j.dbs = 1024 * 512; break;
    case 5: j.src = p.in[I_WMG] + (size_t)l * 1024 * 4096; j.dst = WB(W_MG + (size_t)l * 4096 * 1024); j.K = 1024; j.N = 4096; j.lds = 4096; j.ldd = 1024; break;
    case 6: j.src = p.in[I_WOUT] + (size_t)l * 1024 * 1024; j.dst = WB(W_OUT + (size_t)l * 1024 * 1024); j.K = 1024; j.N = 1024; j.lds = 1024; j.ldd = 1024; break;
    case 7: j.src = p.in[I_LWA] + (size_t)l * 16 * 4096; j.dst = WB(W_LRU + (size_t)l * 16 * 8192); j.K = 64; j.N = 64; j.lds = 64; j.ldd = 64; j.batch = 16; j.sbs = 4096; j.dbs = 8192; j.wide = 0; break;
    case 8: j.src = p.in[I_LWX] + (size_t)l * 16 * 4096; j.dst = WB(W_LRU + (size_t)l * 16 * 8192 + 4096); j.K = 64; j.N = 64; j.lds = 64; j.ldd = 64; j.batch = 16; j.sbs = 4096; j.dbs = 8192; j.wide = 0; break;
    default: j.src = p.in[I_RW]; j.dst = WB(W_RT); j.K = 1024; j.N = 64; j.lds = 64; j.ldd = 1024; j.wide = 0; break;
    }
    return j;
}
DEVI CvtJob get_moe_job(const Params& p, int l, int k) {
    CvtJob j; j.ks = nullptr; j.batch = 64; j.sbs = 262144; j.n0 = 0; j.wide = 1;
    if (k == 0) { j.src = p.in[I_W1] + (size_t)l * 64 * 262144; j.dst = MWB(MW_13);     j.K = 1024; j.N = 256; j.lds = 256; j.ldd = 1024; j.dbs = 512 * 1024; j.mode = 3; }
    else if (k == 1) { j.src = p.in[I_W3] + (size_t)l * 64 * 262144; j.dst = (bf16_t*)((unsigned char*)MWB(MW_13) + 64 * 1024); j.K = 1024; j.N = 256; j.lds = 256; j.ldd = 1024; j.dbs = 512 * 1024; j.mode = 3; }
    else { j.src = p.in[I_W2] + (size_t)l * 64 * 262144; j.dst = MWB(MW_2); j.K = 256; j.N = 1024; j.lds = 1024; j.ldd = 256; j.dbs = 262144; j.mode = 0; }
    return j;
}

struct AOp { const bf16_t* base; int ld; int row0; const int* ridx; };
DEVI const bf16_t* arow(const AOp& a, int i) {
    int r = a.ridx ? a.ridx[i] : a.row0 + i;
    return a.base + (size_t)r * a.ld;
}

#if NAIVE_GEMM
template <int BN>
DEVI void gemm_core(f32x4 (&acc)[4][BN / 32], const AOp& A, const bf16_t* B, int ldb, int K, unsigned char* smem) {
    constexpr int NI = BN / 32;
    const int tid = TIDX, lane = tid & 63, wid = tid >> 6, wr = wid >> 1, wc = wid & 1;
    for (int k0 = 0; k0 < K; k0 += 8) {
        bf16x8 bv[NI];
#pragma unroll
        for (int ni = 0; ni < NI; ++ni) bv[ni] = *(const bf16x8*)(B + (size_t)(wc * (BN / 2) + ni * 16 + (lane & 15)) * ldb + k0);
#pragma unroll
        for (int mi = 0; mi < 4; ++mi)
#pragma unroll
            for (int j = 0; j < 4; ++j) {
                bf16x8 av = *(const bf16x8*)(arow(A, wr * 64 + mi * 16 + (lane >> 4) * 4 + j) + k0);
#pragma unroll
                for (int ni = 0; ni < NI; ++ni) {
                    float s = 0.f;
#pragma unroll
                    for (int e = 0; e < 8; ++e) s += bf2f((bf16_t)av[e]) * bf2f((bf16_t)bv[ni][e]);
                    acc[mi][ni][j] += s;
                }
            }
    }
}
#else
#define GAS __attribute__((address_space(1)))
template <int BN, bool GATHER = false>
DEVI void gemm_core(f32x4 (&acc)[4][BN / 32], const AOp& A, const bf16_t* B, int ldb, int K, unsigned char* smem) {
    constexpr int NI = BN / 32;
    constexpr int NBL = BN / 32;
    constexpr int STG = 32768;
    const int tid = TIDX, lane = tid & 63, wid = tid >> 6, wr = wid >> 1, wc = wid & 1;
    const int lr = tid >> 3;
    const int kc = (tid & 7) ^ (lr & 7);
    const bf16_t* ap[GATHER ? 4 : 1];
    if (GATHER) {
#pragma unroll
        for (int i = 0; i < (GATHER ? 4 : 1); ++i) ap[i] = arow(A, lr + 32 * i) + kc * 8;
    } else ap[0] = A.base + (size_t)(A.row0 + lr) * A.ld + kc * 8;
    const size_t astep = (size_t)32 * A.ld;
    const bf16_t* bp = B + (size_t)lr * ldb + kc * 8;
    const size_t bstep = (size_t)32 * ldb;
    LAS unsigned char* lA = (LAS unsigned char*)smem + tid * 16;
    LAS unsigned char* lB = lA + 16384;
    const int nk = K >> 6;
    const int arow_off = (wr * 64 + (lane & 15)) * 128;
    const int brow_off = 16384 + (wc * (BN / 2) + (lane & 15)) * 128;
    __syncthreads();
#pragma unroll
    for (int i = 0; i < 4; ++i) __builtin_amdgcn_global_load_lds((const GAS unsigned*)(GATHER ? ap[GATHER ? i : 0] : ap[0] + i * astep), (LAS unsigned*)(lA + i * 4096), 16, 0, 0);
#pragma unroll
    for (int i = 0; i < NBL; ++i) __builtin_amdgcn_global_load_lds((const GAS unsigned*)(bp + i * bstep), (LAS unsigned*)(lB + i * 4096), 16, 0, 0);
    for (int kt = 0; kt < nk; ++kt) {
        __syncthreads();
        if (kt + 1 < nk) {
            const int ko = (kt + 1) * 64;
            const int so = ((kt + 1) & 1) * STG;
#pragma unroll
            for (int i = 0; i < 4; ++i) __builtin_amdgcn_global_load_lds((const GAS unsigned*)((GATHER ? ap[GATHER ? i : 0] : ap[0] + i * astep) + ko), (LAS unsigned*)(lA + so + i * 4096), 16, 0, 0);
#pragma unroll
            for (int i = 0; i < NBL; ++i) __builtin_amdgcn_global_load_lds((const GAS unsigned*)(bp + i * bstep + ko), (LAS unsigned*)(lB + so + i * 4096), 16, 0, 0);
        }
        const unsigned char* cs = smem + (kt & 1) * STG;
#pragma unroll
        for (int ks = 0; ks < 2; ++ks) {
            const int pch = ((ks * 4 + (lane >> 4)) ^ (lane & 7)) << 4;
            bf16x8 bfr[NI];
#pragma unroll
            for (int ni = 0; ni < NI; ++ni) bfr[ni] = *(const bf16x8*)(cs + brow_off + ni * 2048 + pch);
#pragma unroll
            for (int mi = 0; mi < 4; mi += 2) {
                const bf16x8 a0 = *(const bf16x8*)(cs + arow_off + mi * 2048 + pch);
                const bf16x8 a1 = *(const bf16x8*)(cs + arow_off + (mi + 1) * 2048 + pch);
#pragma unroll
                for (int ni = 0; ni < NI; ++ni) acc[mi][ni] = __builtin_amdgcn_mfma_f32_16x16x32_bf16(a0, bfr[ni], acc[mi][ni], 0, 0, 0);
#pragma unroll
                for (int ni = 0; ni < NI; ++ni) acc[mi + 1][ni] = __builtin_amdgcn_mfma_f32_16x16x32_bf16(a1, bfr[ni], acc[mi + 1][ni], 0, 0, 0);
            }
        }
    }
}
#endif

template <bool GATHER = false>
DEVI void gemm_core_fp8(f32x4 (&acc)[4][4], const unsigned char* Ab, size_t lda, int row0, const unsigned char* Bb, size_t ldb, int K, unsigned char* smem, const int* ridx = nullptr) {
    constexpr int STG = 32768;
    const int tid = TIDX, lane = tid & 63, wid = tid >> 6, wr = wid >> 1, wc = wid & 1;
    const int lr = tid >> 3;
    const int kc = (tid & 7) ^ (lr & 7);
    const unsigned char* ap[GATHER ? 4 : 1];
    if (GATHER) {
#pragma unroll
        for (int i = 0; i < (GATHER ? 4 : 1); ++i) ap[i] = Ab + (size_t)ridx[lr + 32 * i] * lda + kc * 16;
    } else ap[0] = Ab + (size_t)(row0 + lr) * lda + kc * 16;
    const size_t astep = GATHER ? 0 : 32 * lda;
    const unsigned char* bp = Bb + (size_t)lr * ldb + kc * 16;
    const size_t bstep = 32 * ldb;
    LAS unsigned char* lA = (LAS unsigned char*)smem + tid * 16;
    LAS unsigned char* lB = lA + 16384;
    const int nk = K >> 7;
    const int arow_off = (wr * 64 + (lane & 15)) * 128;
    const int brow_off = 16384 + (wc * 64 + (lane & 15)) * 128;
    const int c0 = ((2 * (lane >> 4)) ^ (lane & 7)) << 4, c1 = ((2 * (lane >> 4) + 1) ^ (lane & 7)) << 4;
    __syncthreads();
#pragma unroll
    for (int i = 0; i < 4; ++i) __builtin_amdgcn_global_load_lds((const GAS unsigned*)(ap[GATHER ? i : 0] + i * astep), (LAS unsigned*)(lA + i * 4096), 16, 0, 0);
#pragma unroll
    for (int i = 0; i < 4; ++i) __builtin_amdgcn_global_load_lds((const GAS unsigned*)(bp + i * bstep), (LAS unsigned*)(lB + i * 4096), 16, 0, 0);
#pragma unroll 1
    for (int kt = 0; kt < nk; ++kt) {
        __syncthreads();
        if (kt + 1 < nk) {
            const int ko = (kt + 1) * 128;
            const int so = ((kt + 1) & 1) * STG;
#pragma unroll
            for (int i = 0; i < 4; ++i) __builtin_amdgcn_global_load_lds((const GAS unsigned*)(ap[GATHER ? i : 0] + i * astep + ko), (LAS unsigned*)(lA + so + i * 4096), 16, 0, 0);
#pragma unroll
            for (int i = 0; i < 4; ++i) __builtin_amdgcn_global_load_lds((const GAS unsigned*)(bp + i * bstep + ko), (LAS unsigned*)(lB + so + i * 4096), 16, 0, 0);
        }
        const unsigned char* cs = smem + (kt & 1) * STG;
        i32x8 bfr[4];
#pragma unroll
        for (int ni = 0; ni < 4; ++ni) {
            const i32x4 lo = *(const i32x4*)(cs + brow_off + ni * 2048 + c0), hi = *(const i32x4*)(cs + brow_off + ni * 2048 + c1);
            bfr[ni] = i32x8{lo[0], lo[1], lo[2], lo[3], hi[0], hi[1], hi[2], hi[3]};
        }
#pragma unroll
        for (int mi = 0; mi < 4; ++mi) {
            const i32x4 lo = *(const i32x4*)(cs + arow_off + mi * 2048 + c0), hi = *(const i32x4*)(cs + arow_off + mi * 2048 + c1);
            const i32x8 af = i32x8{lo[0], lo[1], lo[2], lo[3], hi[0], hi[1], hi[2], hi[3]};
#pragma unroll
            for (int ni = 0; ni < 4; ++ni)
                acc[mi][ni] = __builtin_amdgcn_mfma_scale_f32_16x16x128_f8f6f4(af, bfr[ni], acc[mi][ni], 0, 0, 0, 0x7f7f7f7f, 0, 0x7a7a7a7a);
        }
    }
}

template <int BN>
DEVI void acc_zero(f32x4 (&acc)[4][BN / 32]) {
#pragma unroll
    for (int mi = 0; mi < 4; ++mi)
#pragma unroll
        for (int ni = 0; ni < BN / 32; ++ni) acc[mi][ni] = f32x4{0.f, 0.f, 0.f, 0.f};
}
template <int BN>
DEVI void acc_to_ct(const f32x4 (&acc)[4][BN / 32], bf16_t* ct) {
    const int tid = TIDX, lane = tid & 63, wid = tid >> 6, wr = wid >> 1, wc = wid & 1;
#pragma unroll
    for (int mi = 0; mi < 4; ++mi)
#pragma unroll
        for (int ni = 0; ni < BN / 32; ++ni)
#pragma unroll
            for (int j = 0; j < 4; ++j)
                ct[(wr * 64 + mi * 16 + (lane >> 4) * 4 + j) * CT_LD + wc * (BN / 2) + ni * 16 + (lane & 15)] = f2bf(acc[mi][ni][j]);
}

DEVI void acc_to_ctT(const f32x4 (&acc)[4][4], bf16_t* ct) {
    const int tid = TIDX, lane = tid & 63, wid = tid >> 6, wr = wid >> 1, wc = wid & 1;
#pragma unroll
    for (int mi = 0; mi < 4; ++mi)
#pragma unroll
        for (int ni = 0; ni < 4; ++ni) {
            bf16x4 v;
#pragma unroll
            for (int j = 0; j < 4; ++j) v[j] = (short)f2bf(acc[mi][ni][j]);
            *(bf16x4*)(ct + (wc * 64 + ni * 16 + (lane & 15)) * CT_LD + wr * 64 + mi * 16 + (lane >> 4) * 4) = v;
        }
}
template <int NC>
DEVI void ep_store_rows(const bf16_t* ct, int c0, bf16_t* dst, int ldd, int row0) {
    constexpr int CPR = NC / 8;
    for (int c = TIDX; c < 128 * CPR; c += 256) {
        int i = c / CPR, jc = c % CPR;
        *(bf16x8*)(dst + (size_t)(row0 + i) * ldd + jc * 8) = *(const bf16x8*)(ct + i * CT_LD + c0 + jc * 8);
    }
}
DEVI void ep_store_T(const bf16_t* ct, int c0, int nc, bf16_t* dstT, int ldT, int t0) {
    for (int c = TIDX; c < nc * 16; c += 256) {
        int j = c >> 4, ic = c & 15;
        bf16x8 v;
#pragma unroll
        for (int e = 0; e < 8; ++e) v[e] = (short)ct[(ic * 8 + e) * CT_LD + c0 + j];
        *(bf16x8*)(dstT + (size_t)j * ldT + t0 + ic * 8) = v;
    }
}
DEVI void ep_rope64(bf16_t* ct, const float* gain, float scale, bool lat, int pos0, const float* cs64) {
    const int row = TIDX >> 1, half = TIDX & 1;
    bf16_t* pr = ct + row * CT_LD + half * 64;
    float v[64];
#pragma unroll
    for (int c = 0; c < 8; ++c) {
        bf16x8 t = *(const bf16x8*)(pr + c * 8);
#pragma unroll
        for (int e = 0; e < 8; ++e) v[c * 8 + e] = bf2f((bf16_t)t[e]);
    }
    if (gain) {
        float ss = 0.f;
#pragma unroll
        for (int d = 0; d < 64; ++d) ss += v[d] * v[d];
        float rstd = rsqrtf(ss * (1.f / 64.f) + EPSV);
#pragma unroll
        for (int d = 0; d < 64; ++d) v[d] = v[d] * rstd * gain[d];
    }
    if (lat) {
        const float* cs = cs64 + (size_t)(pos0 + row) * 64;
#pragma unroll
        for (int i = 0; i < 16; ++i) {
            float a = v[i], b = v[i + 16], c = cs[i], s = cs[32 + i];
            v[i] = a * c - b * s; v[i + 16] = b * c + a * s;
            a = v[32 + i]; b = v[48 + i]; c = cs[16 + i]; s = cs[48 + i];
            v[32 + i] = a * c - b * s; v[48 + i] = b * c + a * s;
        }
    }
#pragma unroll
    for (int c = 0; c < 8; ++c) {
        bf16x8 t;
#pragma unroll
        for (int e = 0; e < 8; ++e) t[e] = (short)f2bf(v[c * 8 + e] * scale);
        *(bf16x8*)(pr + c * 8) = t;
    }
}
DEVI void ep_rope32(bf16_t* ct, int ngroups, const float* rstd, float scale, bool lat, int pos0, const float* cs32) {
    const int row = TIDX >> 1, half = TIDX & 1;
    const float rs = (rstd ? rstd[row] : 1.f) * scale;
#pragma unroll
    for (int gg = 0; gg < 2; ++gg) {
        const int g = half * 2 + gg;
        if (g < ngroups) {
            bf16_t* pr = ct + row * CT_LD + g * 32;
            float v[32];
#pragma unroll
            for (int c = 0; c < 4; ++c) {
                bf16x8 t = *(const bf16x8*)(pr + c * 8);
#pragma unroll
                for (int e = 0; e < 8; ++e) v[c * 8 + e] = bf2f((bf16_t)t[e]);
            }
            if (lat) {
                const float* cs = cs32 + (size_t)(pos0 + row) * 32;
#pragma unroll
                for (int i = 0; i < 8; ++i) {
                    float a = v[i], b = v[i + 8], c = cs[i], s = cs[16 + i];
                    v[i] = a * c - b * s; v[i + 8] = b * c + a * s;
                    a = v[16 + i]; b = v[24 + i]; c = cs[8 + i]; s = cs[24 + i];
                    v[16 + i] = a * c - b * s; v[24 + i] = b * c + a * s;
                }
            }
#pragma unroll
            for (int c = 0; c < 4; ++c) {
                bf16x8 t;
#pragma unroll
                for (int e = 0; e < 8; ++e) t[e] = (short)f2bf(v[c * 8 + e] * rs);
                *(bf16x8*)(pr + c * 8) = t;
            }
        }
    }
}
DEVI void ep_scale_rows(bf16_t* ct, int c0, int nc, const float* rstd, float scale) {
    const int cpr = nc / 8;
    for (int c = TIDX; c < 128 * cpr; c += 256) {
        int i = c / cpr, jc = c % cpr;
        bf16_t* pr = ct + i * CT_LD + c0 + jc * 8;
        bf16x8 t = *(const bf16x8*)pr;
        float rs = rstd[i] * scale;
#pragma unroll
        for (int e = 0; e < 8; ++e) t[e] = (short)f2bf(bf2f((bf16_t)t[e]) * rs);
        *(bf16x8*)pr = t;
    }
}
DEVI void ep_rstd(const bf16_t* A, int ld, int row0, int K, float* rstd) {
    const int row = TIDX >> 1, half = TIDX & 1;
    const bf16_t* pr = A + (size_t)(row0 + row) * ld + half * (K / 2);
    float ss = 0.f;
    for (int c = 0; c < K / 16; ++c) {
        bf16x8 t = *(const bf16x8*)(pr + c * 8);
#pragma unroll
        for (int e = 0; e < 8; ++e) { float f = bf2f((bf16_t)t[e]); ss += f * f; }
    }
    ss += __shfl_xor(ss, 1);
    if (half == 0) rstd[row] = rsqrtf(ss / (float)K + EPSV);
}


struct GrpInfo { int xcd, j, per, ngrp; };
DEVI GrpInfo grp_info(const Params& p) {
    const unsigned* pv = (const unsigned*)(p.ws + OFF_PRIV + (size_t)BIDX * 1024 + 896);
    GrpInfo g;
    g.xcd = (int)__hip_atomic_load(pv + 2, __ATOMIC_RELAXED, __HIP_MEMORY_SCOPE_AGENT);
    g.j = (int)__hip_atomic_load(pv + 3, __ATOMIC_RELAXED, __HIP_MEMORY_SCOPE_AGENT);
    g.per = (int)__hip_atomic_load((const unsigned*)(p.ws + OFF_BAR) + 256 + 64 * g.xcd, __ATOMIC_RELAXED, __HIP_MEMORY_SCOPE_AGENT);
    g.ngrp = 8;
    if (g.xcd >= 8 || g.per <= 0) { g.xcd = 0; g.j = BIDX; g.per = gridDim.x; g.ngrp = 1; }
    return g;
}
DEVI bool super_tile(const GrpInfo& gi, int it, int NMT, int NNT, int SM, int SN, int& mt, int& nt) {
    const int ST = SM * SN, passes = (ST + gi.per - 1) / gi.per;
    const int nsn = (NNT + SN - 1) / SN, nsm = (NMT + SM - 1) / SM;
    const int s = (it / passes) * gi.ngrp + gi.xcd;
    if (s >= nsm * nsn) return false;
    const int idx = (it % passes) * gi.per + gi.j;
    mt = -1; nt = 0;
    if (idx < ST) {
        const int m = (s / nsn) * SM + idx / SN, n = (s % nsn) * SN + idx % SN;
        if (m < NMT && n < NNT) { mt = m; nt = n; }
    }
    return true;
}

DEVI void phase0(const Params& p, unsigned char* smem) {
    const int tid = TIDX, lane = tid & 63, w = tid >> 6;
    const int NG = 192, NCV = 2 * CVT_PER_LAYER, NR = 192;
    const int ntask = NG + NCV + NR + 1;
    for (int task = BIDX; task < ntask; task += gridDim.x) {
        if (task < NG) {
            const int l = task / 96, n0 = (task % 96) * 64;
            float* sv = (float*)smem;
            float* red = (float*)smem;
            for (int idx = lane; idx < 9 * 256; idx += 64) {
                int bi = idx >> 8, kk = idx & 255, k = 256 * w + kk;
                float c = bi < 8 ? p.in[I_C][bi * 1024 + k] : p.in[I_CCTX][k];
                sv[(w * 9 + bi) * 256 + kk] = siluf_(c);
            }
            __syncthreads();
            const int ksub = lane >> 4, c4 = (lane & 15) * 4;
            float acc[9][4];
#pragma unroll
            for (int bi = 0; bi < 9; ++bi) { acc[bi][0] = 0.f; acc[bi][1] = 0.f; acc[bi][2] = 0.f; acc[bi][3] = 0.f; }
            const float* wp = p.in[I_ADAW] + (size_t)l * 1024 * 6144 + (size_t)(256 * w + ksub) * 6144 + n0 + c4;
#pragma unroll 8
            for (int i = 0; i < 64; ++i) {
                const float4 wv = *(const float4*)(wp + (size_t)(4 * i) * 6144);
#pragma unroll
                for (int bi = 0; bi < 9; ++bi) {
                    const float sx = sv[(w * 9 + bi) * 256 + 4 * i + ksub];
                    acc[bi][0] += sx * wv.x; acc[bi][1] += sx * wv.y; acc[bi][2] += sx * wv.z; acc[bi][3] += sx * wv.w;
                }
            }
            __syncthreads();
#pragma unroll
            for (int bi = 0; bi < 9; ++bi)
                *(float4*)(red + (((w * 4 + ksub) * 9 + bi) * 64) + c4) = make_float4(acc[bi][0], acc[bi][1], acc[bi][2], acc[bi][3]);
            __syncthreads();
            for (int idx = tid; idx < 9 * 64; idx += 256) {
                int bi = idx >> 6, c = idx & 63;
                float sacc = p.in[I_ADAB][l * 6144 + n0 + c];
#pragma unroll
                for (int q = 0; q < 16; ++q) sacc += red[((q * 9 + bi) * 64) + c];
                WSF(OFF_MOD)[(size_t)(l * 9 + bi) * 6144 + n0 + c] = sacc;
            }
            __syncthreads();
        } else if (task < NG + NCV) {
            int t = task - NG;
            int l = t / CVT_PER_LAYER; t %= CVT_PER_LAYER;
            int k = 0;
            while (t >= CVT_TILES[k]) { t -= CVT_TILES[k]; ++k; }
            CvtJob j = get_job(p, l, k);
            if (k == 5) cvt_tile256_fp8(j, t, smem); else if (j.wide) cvt_tile256(j, t, smem); else cvt_tile(j, t, (float*)smem);
        } else if (task < NG + NCV + NR) {
            const int idx = (task - NG - NCV) * 256 + tid;
            const int pos = idx / 24, f = idx % 24;
            const float rp = (float)(pos >> 6), cp = (float)(pos & 63);
            if (f < 16) {
                const float inv = powf(10000.f, -(float)(2 * f) / 32.f);
                const float ar = rp * inv, ac = cp * inv;
                float* t64 = WSF(OFF_R64) + (size_t)pos * 64;
                t64[f] = cosf(ar); t64[16 + f] = cosf(ac); t64[32 + f] = sinf(ar); t64[48 + f] = sinf(ac);
            } else {
                const int i = f - 16;
                const float inv = powf(10000.f, -(float)(2 * i) / 16.f);
                const float ar = rp * inv, ac = cp * inv;
                float* t32 = WSF(OFF_R32) + (size_t)pos * 32;
                t32[i] = cosf(ar); t32[8 + i] = cosf(ac); t32[16 + i] = sinf(ar); t32[24 + i] = sinf(ac);
            }
        } else {
            for (int i = tid; i < 4096; i += 256) WSI(OFF_CNT)[i] = 0;
            for (int l = 0; l < 2; ++l) {
                unsigned* z = (unsigned*)WB(W_IN + (size_t)l * 3840 * 1024 + (size_t)3744 * 1024);
                for (int i = tid; i < 96 * 1024 / 2; i += 256) z[i] = 0u;
            }
        }
    }
}

struct MoeTab {
    int* base;
    DEVI int cnt(int e) const { return __hip_atomic_load(base + e, __ATOMIC_RELAXED, __HIP_MEMORY_SCOPE_AGENT); }
    DEVI int tp(int e) const { return __hip_atomic_load(base + 64 + e, __ATOMIC_RELAXED, __HIP_MEMORY_SCOPE_AGENT); }
    DEVI int seg(int e) const { return __hip_atomic_load(base + 136 + e, __ATOMIC_RELAXED, __HIP_MEMORY_SCOPE_AGENT); }
};
DEVI MoeTab moe_tables(const Params& p, int l, unsigned char* smem) {
    MoeTab t; t.base = (int*)(p.ws + OFF_PRIV + (size_t)BIDX * 1024);
    __syncthreads();
    if (TIDX == 0) {
        int a = 0, sg = 0;
        for (int e = 0; e < 64; ++e) {
            const int c = WSI(OFF_CNT)[l * 64 + e];
            __hip_atomic_store(t.base + e, c, __ATOMIC_RELAXED, __HIP_MEMORY_SCOPE_AGENT);
            __hip_atomic_store(t.base + 64 + e, a, __ATOMIC_RELAXED, __HIP_MEMORY_SCOPE_AGENT);
            __hip_atomic_store(t.base + 136 + e, sg, __ATOMIC_RELAXED, __HIP_MEMORY_SCOPE_AGENT);
            const int nt = (c + 127) >> 7;
            a += nt; sg += nt * 128;
        }
        __hip_atomic_store(t.base + 64 + 64, a, __ATOMIC_RELAXED, __HIP_MEMORY_SCOPE_AGENT);
        __hip_atomic_store(t.base + 136 + 64, sg, __ATOMIC_RELAXED, __HIP_MEMORY_SCOPE_AGENT);
    }
    asm volatile("s_waitcnt vmcnt(0)" ::: "memory");
    __syncthreads();
    return t;
}
struct Rec { int e0, p0, e1, p1; float w0, w1; int pad0, pad1; };

DEVI void phase_norm1(const Params& p, int l, int mode, unsigned char* smem) {
    const int lane = TIDX & 63, w = TIDX >> 6;
    MoeTab mt;
    const bool comb = (mode == 0 && l > 0) || mode == 1;
    const int lp = mode == 1 ? 1 : l - 1;
    int segv = 0;
    if (comb) { mt = moe_tables(p, lp, smem); segv = mt.seg(lane); }
    const float* g1 = mode == 1 ? p.in[I_FN] : (mode == 2 ? p.in[I_N2G] + l * 1024 : p.in[I_N1G] + l * 1024);
    const bool latonly = (mode == 1) || (mode == 2 && l == 1);
    const int nrows = latonly ? NBT * SEQL : TT;
    const int stride = gridDim.x * 4;
    int ri = BIDX * 4 + w;
    float4 xn[4];
    Rec rcn; rcn.e0 = 0; rcn.e1 = 0; rcn.p0 = 0; rcn.p1 = 0; rcn.w0 = 0.f; rcn.w1 = 0.f;
    auto rowof = [&](int r) { return latonly ? (r >> 11) * TPB + CTXL + (r & 2047) : r; };
    auto srcof = [&](int row) -> const float* {
        if (mode == 0 && l == 0) {
            const int b = row / TPB, t = row % TPB;
            return t < CTXL ? p.in[I_CTX] + ((size_t)b * CTXL + t) * DM : p.in[I_X] + ((size_t)b * SEQL + (t - CTXL)) * DM;
        }
        return XCUR + (size_t)row * DM;
    };
    if (ri < nrows) {
        const float* src = srcof(rowof(ri));
#pragma unroll
        for (int i = 0; i < 4; ++i) xn[i] = *(const float4*)(src + i * 256 + lane * 4);
        if (comb) rcn = ((const Rec*)(p.ws + OFF_REC))[rowof(ri)];
    }
    for (; ri < nrows; ri += stride) {
        const int row = rowof(ri);
        const int b = row / TPB, t = row % TPB;
        const bool isctx = t < CTXL;
        const int bi = isctx ? 8 : b;
        float v[16];
#pragma unroll
        for (int i = 0; i < 4; ++i) { v[i * 4] = xn[i].x; v[i * 4 + 1] = xn[i].y; v[i * 4 + 2] = xn[i].z; v[i * 4 + 3] = xn[i].w; }
        const Rec rc = rcn;
        if (ri + stride < nrows) {
            if (comb) rcn = ((const Rec*)(p.ws + OFF_REC))[rowof(ri + stride)];
            const float* src = srcof(rowof(ri + stride));
#pragma unroll
            for (int i = 0; i < 4; ++i) xn[i] = *(const float4*)(src + i * 256 + lane * 4);
        }
        if (comb) {
            float* xr = XCUR + (size_t)row * DM;
            const bf16_t* y0 = DB(D_YS) + (size_t)(__shfl(segv, rc.e0) + rc.p0) * 1024;
            const bf16_t* y1 = DB(D_YS) + (size_t)(__shfl(segv, rc.e1) + rc.p1) * 1024;
            const float* gate = WSF(OFF_MOD) + (size_t)(lp * 9 + bi) * 6144 + 5 * 1024;
#pragma unroll
            for (int i = 0; i < 4; ++i) {
                const int c = i * 256 + lane * 4;
                float4 g4 = *(const float4*)(gate + c);
                uint2 a = *(const uint2*)(y0 + c), bb = *(const uint2*)(y1 + c);
                float f0 = rc.w0 * __uint_as_float(a.x << 16) + rc.w1 * __uint_as_float(bb.x << 16);
                float f1 = rc.w0 * __uint_as_float(a.x & 0xffff0000u) + rc.w1 * __uint_as_float(bb.x & 0xffff0000u);
                float f2 = rc.w0 * __uint_as_float(a.y << 16) + rc.w1 * __uint_as_float(bb.y << 16);
                float f3 = rc.w0 * __uint_as_float(a.y & 0xffff0000u) + rc.w1 * __uint_as_float(bb.y & 0xffff0000u);
                v[i * 4] += g4.x * f0; v[i * 4 + 1] += g4.y * f1; v[i * 4 + 2] += g4.z * f2; v[i * 4 + 3] += g4.w * f3;
                if (mode == 0) *(float4*)(xr + c) = make_float4(v[i * 4], v[i * 4 + 1], v[i * 4 + 2], v[i * 4 + 3]);
            }
        }
        float ss = 0.f;
#pragma unroll
        for (int i = 0; i < 16; ++i) ss += v[i] * v[i];
        ss = wave_sum(ss);
        const float rstd = rsqrtf(ss * (1.f / 1024.f) + EPSV);
        if (mode == 1) {
            float* o = p.out + ((size_t)b * SEQL + (t - CTXL)) * DM;
#pragma unroll
            for (int i = 0; i < 4; ++i) {
                const int c = i * 256 + lane * 4;
                float4 g4 = *(const float4*)(g1 + c);
                float4 r4;
                r4.x = v[i * 4] * rstd * g4.x; r4.y = v[i * 4 + 1] * rstd * g4.y; r4.z = v[i * 4 + 2] * rstd * g4.z; r4.w = v[i * 4 + 3] * rstd * g4.w;
                *(float4*)(o + c) = r4;
            }
        } else {
            const float* md = WSF(OFF_MOD) + (size_t)(l * 9 + bi) * 6144 + (mode == 2 ? 3 * 1024 : 0);
            bf16_t* ho = HB + (size_t)row * DM;
#pragma unroll
            for (int i = 0; i < 4; ++i) {
                const int c = i * 256 + lane * 4;
                float4 g4 = *(const float4*)(g1 + c);
                float4 sh = *(const float4*)(md + c);
                float4 sc = *(const float4*)(md + 1024 + c);
                float h0 = v[i * 4] * rstd * g4.x * (1.f + sc.x) + sh.x;
                float h1 = v[i * 4 + 1] * rstd * g4.y * (1.f + sc.y) + sh.y;
                float h2 = v[i * 4 + 2] * rstd * g4.z * (1.f + sc.z) + sh.z;
                float h3 = v[i * 4 + 3] * rstd * g4.w * (1.f + sc.w) + sh.w;
                uint2 o2;
                o2.x = (unsigned)f2bf(h0) | ((unsigned)f2bf(h1) << 16);
                o2.y = (unsigned)f2bf(h2) | ((unsigned)f2bf(h3) << 16);
                *(uint2*)(ho + c) = o2;
                if (mode == 2) *(int*)((unsigned char*)CB(0) + (size_t)row * 1024 + c) = pk4_fp8(h0, h1, h2, h3);
            }
        }
    }
}

DEVI int fetch_task(int* ctr, unsigned char* smem) {
    __syncthreads();
    if (TIDX == 0) *(volatile int*)smem = atomicAdd(ctr, 1);
    __syncthreads();
    return *(volatile int*)smem;
}
DEVI void dep_signal(int* cnt) {
    asm volatile("s_waitcnt vmcnt(0)" ::: "memory");
    __syncthreads();
    if (TIDX == 0) {
        __builtin_amdgcn_fence(__ATOMIC_RELEASE, "agent");
        asm volatile("s_waitcnt vmcnt(0)" ::: "memory");
        __hip_atomic_fetch_add(cnt, 1, __ATOMIC_RELAXED, __HIP_MEMORY_SCOPE_AGENT);
    }
}
DEVI void dep_wait(int* cnt, int need) {
    if (TIDX == 0) {
        while (__hip_atomic_load(cnt, __ATOMIC_RELAXED, __HIP_MEMORY_SCOPE_AGENT) < need) __builtin_amdgcn_s_sleep(2);
        __builtin_amdgcn_fence(__ATOMIC_ACQUIRE, "agent");
        asm volatile("s_waitcnt vmcnt(0)" ::: "memory");
    }
    __syncthreads();
}

DEVI void phase_win(const Params& p, int l, unsigned char* smem) {
    bf16_t* ct = (bf16_t*)smem;
    const float* cs64 = WSF(OFF_R64);
    const float* cs32 = WSF(OFF_R32);
    int* ctr = WSI(OFF_CNT) + 134 + l;
    for (;;) {
        const int task = fetch_task(ctr, smem);
        if (task >= 144 * 30) break;
        const int mt = task / 30, nt = task % 30;
        const int row0 = mt * 128, b = mt / 18, t0 = (mt % 18) * 128;
        const bool lat = (mt % 18) >= 2;
        const int pos0 = t0 - CTXL;
        f32x4 acc[4][4];
        acc_zero<128>(acc);
        AOp A{HB, 1024, row0, nullptr};
        T_BEGIN(3);
        gemm_core<128>(acc, A, WB(W_IN + (size_t)l * 3840 * 1024 + (size_t)nt * 128 * 1024), 1024, 1024, smem);
        __syncthreads();
        T_END(3, l == 0 && BIDX == 8);
        T_BEGIN(4);
        const bool tonly = (nt >= 7 && nt < 11) || nt == 28;
        if (tonly) acc_to_ctT(acc, ct); else acc_to_ct<128>(acc, ct);
        __syncthreads();
        if (nt < 2) ep_store_rows<128>(ct, 0, CB(C_CQ) + nt * 128, 256, row0);
        else if (nt == 2) ep_store_rows<128>(ct, 0, CB(C_CKV), 128, row0);
        else if (nt < 5) { ep_rope64(ct, nullptr, 1.f, lat, pos0, cs64); __syncthreads(); ep_store_rows<128>(ct, 0, CB(C_RQ) + (nt - 3) * 128, 256, row0); }
        else if (nt < 7) {
            ep_rope64(ct, nullptr, 0.125f, lat, pos0, cs64); __syncthreads();
            ep_store_rows<128>(ct, 0, CB(C_RK) + (nt - 5) * 128, 256, row0);
            ep_store_T(ct, 0, 128, CB(C_RKT) + ((size_t)b * 256 + (nt - 5) * 128) * TPB, TPB, t0);
        }
        else if (nt < 11) ep_store_rows<128>(ct, 0, CB(C_RVT) + ((size_t)b * 4 + (nt - 7)) * 128 * TPB + t0, TPB, 0);
        else if (nt < 15) ep_store_rows<128>(ct, 0, CB(C_RG) + (nt - 11) * 128, 512, row0);
        else if (nt < 19) ep_store_rows<128>(ct, 0, CB(C_LX) + (nt - 15) * 128, 512, row0);
        else if (nt < 23) ep_store_rows<128>(ct, 0, CB(C_LG) + (nt - 19) * 128, 512, row0);
        else if (nt < 27) { ep_rope64(ct, p.in[I_GQN] + l * 64, 0.125f * LOG2E, lat, pos0, cs64); __syncthreads(); ep_store_rows<128>(ct, 0, CB(C_GQ) + (nt - 23) * 128, 512, row0); }
        else if (nt == 27) { ep_rope64(ct, p.in[I_GKN] + l * 64, 1.f, lat, pos0, cs64); __syncthreads(); ep_store_rows<128>(ct, 0, CB(C_GK), 128, row0); }
        else if (nt == 28) ep_store_rows<128>(ct, 0, CB(C_GVT) + (size_t)b * 128 * TPB + t0, TPB, 0);
        else { ep_rope32(ct, 1, nullptr, 1.f, lat, pos0, cs32); __syncthreads(); ep_store_rows<32>(ct, 0, CB(C_KR), 32, row0); }
        __syncthreads();
        T_END(4, l == 0 && BIDX == 8);
    }
}

DEVI float ret_lg2(const Params& p, int l, int dir, int h) { return -log1pf(expf(-p.in[I_RDEC][l * 8 + dir * 4 + h])) * LOG2E; }
DEVI void ret_chunk_U(const Params& p, int l, int task) {
    const int b = task / 72, r = task % 72, h = r / 18, m = r % 18;
    const int tid = TIDX, lane = tid & 63, w = tid >> 6, qc = lane & 31, hh = lane >> 5;
    const int t0 = m * 128;
    const bf16_t* KTg = CB(C_RKT) + ((size_t)b * 4 + h) * 64 * TPB + t0 + 8 * hh;
    const bf16_t* VTg = CB(C_RVT) + (((size_t)b * 4 + h) * 128 + w * 32 + qc) * TPB + t0 + 8 * hh;
    bf16x8 vf[8], ka[2][8];
#pragma unroll
    for (int ks = 0; ks < 8; ++ks) vf[ks] = *(const bf16x8*)(VTg + ks * 16);
#pragma unroll
    for (int sub = 0; sub < 2; ++sub)
#pragma unroll
        for (int ks = 0; ks < 8; ++ks) ka[sub][ks] = *(const bf16x8*)(KTg + (size_t)(32 * sub + qc) * TPB + ks * 16);
#pragma unroll
    for (int dir = 0; dir < 2; ++dir) {
        const float lg2 = ret_lg2(p, l, dir, h);
        f32x16 U0, U1;
#pragma unroll
        for (int rr = 0; rr < 16; ++rr) { U0[rr] = 0.f; U1[rr] = 0.f; }
#pragma unroll
        for (int ks = 0; ks < 8; ++ks) {
            bf16x8 vs;
#pragma unroll
            for (int e = 0; e < 8; ++e) {
                const int j = 16 * ks + 8 * hh + e;
                const float kd = __builtin_amdgcn_exp2f(lg2 * (float)(dir == 0 ? 127 - j : j));
                vs[e] = (short)f2bf(bf2f((bf16_t)vf[ks][e]) * kd);
            }
            U0 = __builtin_amdgcn_mfma_f32_32x32x16_bf16(ka[0][ks], vs, U0, 0, 0, 0);
            U1 = __builtin_amdgcn_mfma_f32_32x32x16_bf16(ka[1][ks], vs, U1, 0, 0, 0);
        }
        bf16_t* up = DB(D_OB) + ((((size_t)(b * 4 + h) * 18 + m) * 2 + dir) * 128) * 64 + (size_t)(32 * w + qc) * 8 + 4 * hh;
#pragma unroll
        for (int g = 0; g < 4; ++g) {
            bf16x4 a, c;
#pragma unroll
            for (int e = 0; e < 4; ++e) { a[e] = (short)f2bf(U0[4 * g + e]); c[e] = (short)f2bf(U1[4 * g + e]); }
            *(bf16x4*)(up + (((g >> 1) * 2 + (g & 1)) * 128) * 8) = a;
            *(bf16x4*)(up + (((2 + (g >> 1)) * 2 + (g & 1)) * 128) * 8) = c;
        }
    }
}
DEVI void ret_out_task(const Params& p, int l, int b, int h, int m, unsigned char* smem) {
    constexpr int PLD = 136;
    bf16_t* P = (bf16_t*)smem;
    float* red = (float*)(smem + 34816);
    const int tid = TIDX, lane = tid & 63, w = tid >> 6, qc = lane & 31, hh = lane >> 5;
    const int t0 = m * 128, iq = 32 * w + qc;
    const float lgf = ret_lg2(p, l, 0, h), lgb = ret_lg2(p, l, 1, h);
    const float cdf = exp2f(lgf * 128.f), cdb = exp2f(lgb * 128.f);
    bf16x8 sff[4], sfb[4];
    {
        float Sf[4][8], Sb[4][8];
#pragma unroll
        for (int ks = 0; ks < 4; ++ks)
#pragma unroll
            for (int e = 0; e < 8; ++e) { Sf[ks][e] = 0.f; Sb[ks][e] = 0.f; }
        const bf16_t* Ub = DB(D_OB) + (size_t)(b * 4 + h) * 18 * 2 * 128 * 64 + (size_t)(hh * 128 + 32 * w + qc) * 8;
        const int pos = m < 2 ? 1 - m : 19 - m;
        const int nf4 = (m + 3) & ~3, nb4 = (pos + 3) & ~3;
        for (int c0 = 0; c0 < nf4; c0 += 4) {
            bf16x8 u[4][4]; float wg[4];
#pragma unroll
            for (int q = 0; q < 4; ++q) {
                const int c = c0 + q, cl = c < m ? c : 0;
                wg[q] = c < m ? __builtin_amdgcn_exp2f(lgf * 128.f * (float)(m - 1 - c)) : 0.f;
                const bf16_t* up = Ub + (size_t)(cl * 2 + 0) * 128 * 64;
#pragma unroll
                for (int ks = 0; ks < 4; ++ks) u[q][ks] = *(const bf16x8*)(up + ks * 2048);
            }
#pragma unroll
            for (int q = 0; q < 4; ++q)
#pragma unroll
                for (int ks = 0; ks < 4; ++ks)
#pragma unroll
                    for (int e = 0; e < 8; ++e) Sf[ks][e] += wg[q] * bf2f((bf16_t)u[q][ks][e]);
        }
        for (int c0 = 0; c0 < nb4; c0 += 4) {
            bf16x8 u[4][4]; float wg[4];
#pragma unroll
            for (int q = 0; q < 4; ++q) {
                const int cc = c0 + q, ccl = cc < pos ? cc : 0;
                const int c = ccl < 2 ? 1 - ccl : 19 - ccl;
                wg[q] = cc < pos ? __builtin_amdgcn_exp2f(lgb * 128.f * (float)(pos - 1 - cc)) : 0.f;
                const bf16_t* up = Ub + (size_t)(c * 2 + 1) * 128 * 64;
#pragma unroll
                for (int ks = 0; ks < 4; ++ks) u[q][ks] = *(const bf16x8*)(up + ks * 2048);
            }
#pragma unroll
            for (int q = 0; q < 4; ++q)
#pragma unroll
                for (int ks = 0; ks < 4; ++ks)
#pragma unroll
                    for (int e = 0; e < 8; ++e) Sb[ks][e] += wg[q] * bf2f((bf16_t)u[q][ks][e]);
        }
#pragma unroll
        for (int ks = 0; ks < 4; ++ks)
#pragma unroll
            for (int e = 0; e < 8; ++e) { sff[ks][e] = (short)f2bf(Sf[ks][e]); sfb[ks][e] = (short)f2bf(Sb[ks][e]); }
    }
    const bf16_t* Kg = CB(C_RK) + ((size_t)b * TPB + t0) * 256 + h * 64 + 8 * hh;
    const bf16_t* Qg = CB(C_RQ) + ((size_t)b * TPB + t0) * 256 + h * 64 + 8 * hh;
    const bf16_t* VTg = CB(C_RVT) + (((size_t)b * 4 + h) * 128 + w * 32 + qc) * TPB + t0 + 8 * hh;
    bf16x8 vf[8];
#pragma unroll
    for (int ks = 0; ks < 8; ++ks) vf[ks] = *(const bf16x8*)(VTg + ks * 16);
    {
        bf16x8 qf[4], ka[4][4];
#pragma unroll
        for (int ks = 0; ks < 4; ++ks) qf[ks] = *(const bf16x8*)(Qg + (size_t)iq * 256 + ks * 16);
#pragma unroll
        for (int js = 0; js < 4; ++js)
#pragma unroll
            for (int ks = 0; ks < 4; ++ks) ka[js][ks] = *(const bf16x8*)(Kg + (size_t)(32 * js + qc) * 256 + ks * 16);
        __syncthreads();
#pragma unroll
        for (int js = 0; js < 4; ++js) {
            f32x16 sc;
#pragma unroll
            for (int r = 0; r < 16; ++r) sc[r] = 0.f;
#pragma unroll
            for (int ks = 0; ks < 4; ++ks) sc = __builtin_amdgcn_mfma_f32_32x32x16_bf16(ka[js][ks], qf[ks], sc, 0, 0, 0);
#pragma unroll
            for (int g = 0; g < 4; ++g) {
                bf16x4 pk;
#pragma unroll
                for (int e = 0; e < 4; ++e) {
                    const int d = iq - (32 * js + 8 * g + 4 * hh + e);
                    const float wgt = d >= 0 ? __builtin_amdgcn_exp2f(lgf * (float)d) : __builtin_amdgcn_exp2f(lgb * (float)(-d));
                    pk[e] = (short)f2bf(sc[4 * g + e] * wgt);
                }
                *(bf16x4*)(P + iq * PLD + 32 * js + 8 * g + 4 * hh) = pk;
            }
        }
    }
    bf16x8 qa[4];
#pragma unroll
    for (int ks = 0; ks < 4; ++ks) qa[ks] = *(const bf16x8*)(Qg + (size_t)qc * 256 + ks * 16);
    __syncthreads();
    f32x16 o[4];
#pragma unroll
    for (int isub = 0; isub < 4; ++isub) {
        const int ii = 32 * isub + qc;
        bf16x8 qn[4];
        if (isub < 3) {
#pragma unroll
            for (int ks = 0; ks < 4; ++ks) qn[ks] = *(const bf16x8*)(Qg + (size_t)(ii + 32) * 256 + ks * 16);
        }
#pragma unroll
        for (int r = 0; r < 16; ++r) o[isub][r] = 0.f;
#pragma unroll
        for (int ks = 0; ks < 4; ++ks) o[isub] = __builtin_amdgcn_mfma_f32_32x32x16_bf16(sff[ks], qa[ks], o[isub], 0, 0, 0);
        const float qdf = __builtin_amdgcn_exp2f(lgf * (float)(ii + 1)), qdb = __builtin_amdgcn_exp2f(lgb * (float)(128 - ii));
        const float rat = qdf / qdb;
#pragma unroll
        for (int r = 0; r < 16; ++r) o[isub][r] *= rat;
#pragma unroll
        for (int ks = 0; ks < 4; ++ks) o[isub] = __builtin_amdgcn_mfma_f32_32x32x16_bf16(sfb[ks], qa[ks], o[isub], 0, 0, 0);
#pragma unroll
        for (int r = 0; r < 16; ++r) o[isub][r] *= qdb;
#pragma unroll
        for (int ks = 0; ks < 8; ++ks) {
            bf16x8 pf = *(const bf16x8*)(P + ii * PLD + 16 * ks + 8 * hh);
            o[isub] = __builtin_amdgcn_mfma_f32_32x32x16_bf16(vf[ks], pf, o[isub], 0, 0, 0);
        }
        float s1 = 0.f, s2 = 0.f;
#pragma unroll
        for (int r = 0; r < 16; ++r) { s1 += o[isub][r]; s2 += o[isub][r] * o[isub][r]; }
        s1 += __shfl_xor(s1, 32); s2 += __shfl_xor(s2, 32);
        if (hh == 0) { red[(w * 128 + ii) * 2] = s1; red[(w * 128 + ii) * 2 + 1] = s2; }
        if (isub < 3) {
#pragma unroll
            for (int ks = 0; ks < 4; ++ks) qa[ks] = qn[ks];
        }
    }
    __syncthreads();
    const float* gn = p.in[I_RNORM] + l * 512 + h * 128 + 32 * w + 4 * hh;
    float gnv[16];
#pragma unroll
    for (int g = 0; g < 4; ++g)
#pragma unroll
        for (int e = 0; e < 4; ++e) gnv[4 * g + e] = gn[8 * g + e];
#pragma unroll
    for (int isub = 0; isub < 4; ++isub) {
        const int ii = 32 * isub + qc;
        float t1 = 0.f, t2 = 0.f;
#pragma unroll
        for (int ww = 0; ww < 4; ++ww) { t1 += red[(ww * 128 + ii) * 2]; t2 += red[(ww * 128 + ii) * 2 + 1]; }
        const float mu = t1 * (1.f / 128.f);
        const float rs = rsqrtf(fmaxf(t2 * (1.f / 128.f) - mu * mu, 0.f) + EPSV);
#pragma unroll
        for (int g = 0; g < 4; ++g) {
            bf16x4 ov;
#pragma unroll
            for (int e = 0; e < 4; ++e) ov[e] = (short)f2bf((o[isub][4 * g + e] - mu) * rs * gnv[4 * g + e]);
            *(bf16x4*)(P + ii * PLD + 32 * w + 8 * g + 4 * hh) = ov;
        }
    }
    __syncthreads();
#pragma unroll
    for (int k = 0; k < 8; ++k) {
        const int c = tid + 256 * k, row = c >> 4, ch = c & 15;
        const size_t ro = ((size_t)b * TPB + t0 + row) * 512 + h * 128 + ch * 8;
        const bf16x8 nv = *(const bf16x8*)(P + row * PLD + ch * 8);
        const bf16x8 gt = *(const bf16x8*)(CB(C_RG) + ro);
        bf16x8 ov;
#pragma unroll
        for (int e = 0; e < 8; ++e) ov[e] = (short)f2bf(siluf_(bf2f((bf16_t)gt[e])) * bf2f((bf16_t)nv[e]));
        *(bf16x8*)(DB(D_OF) + ro) = ov;
    }
}

DEVI void h_to_fp8(const Params& p, int t32) {
    const int lane = TIDX & 63, w = TIDX >> 6;
    const size_t row0 = (size_t)t32 * 32 + w * 8;
    bf16x8 a[8], b[8];
#pragma unroll
    for (int i = 0; i < 8; ++i) {
        a[i] = *(const bf16x8*)(HB + (row0 + i) * 1024 + lane * 16);
        b[i] = *(const bf16x8*)(HB + (row0 + i) * 1024 + lane * 16 + 8);
    }
    asm volatile("s_waitcnt vmcnt(0)" ::: "memory");
#pragma unroll
    for (int i = 0; i < 8; ++i) {
        i32x4 o;
        o[0] = pk4_fp8(bf2f((bf16_t)a[i][0]), bf2f((bf16_t)a[i][1]), bf2f((bf16_t)a[i][2]), bf2f((bf16_t)a[i][3]));
        o[1] = pk4_fp8(bf2f((bf16_t)a[i][4]), bf2f((bf16_t)a[i][5]), bf2f((bf16_t)a[i][6]), bf2f((bf16_t)a[i][7]));
        o[2] = pk4_fp8(bf2f((bf16_t)b[i][0]), bf2f((bf16_t)b[i][1]), bf2f((bf16_t)b[i][2]), bf2f((bf16_t)b[i][3]));
        o[3] = pk4_fp8(bf2f((bf16_t)b[i][4]), bf2f((bf16_t)b[i][5]), bf2f((bf16_t)b[i][6]), bf2f((bf16_t)b[i][7]));
        *(i32x4*)((unsigned char*)HB + (row0 + i) * 2048 + lane * 16) = o;
    }
}
DEVI void phase_mla_up(const Params& p, int l, unsigned char* smem) {
    bf16_t* ct = (bf16_t*)smem;
    float* rstd = (float*)(smem + AUX_OFF);
    const float* cs32 = WSF(OFF_R32);
    const float qscale = 0.10206207261596575f * LOG2E;
    const int nq = (l == 0 ? 144 : 128) * 6;
    const int nkv = 144 * 8;
    for (int tile = BIDX; tile < nq + nkv + 576 + 576; tile += gridDim.x) {
        if (tile >= nq + nkv + 576) { h_to_fp8(p, tile - nq - nkv - 576); continue; }
        if (tile >= nq + nkv) { ret_chunk_U(p, l, tile - nq - nkv); continue; }
        if (tile < nq) {
            const int mt = mt_of(tile / 6, l != 0), nt = tile % 6;
            const int row0 = mt * 128, t0 = (mt % 18) * 128;
            const bool lat = (mt % 18) >= 2;
            f32x4 acc[4][4];
            acc_zero<128>(acc);
            AOp A{CB(C_CQ), 256, row0, nullptr};
            gemm_core<128>(acc, A, WB(W_UQ + (size_t)l * 768 * 256 + (size_t)nt * 128 * 256), 256, 256, smem);
            __syncthreads();
            acc_to_ct<128>(acc, ct);
            ep_rstd(CB(C_CQ), 256, row0, 256, rstd);
            __syncthreads();
            if (nt < 4) {
                ep_scale_rows(ct, 0, 128, rstd, qscale); __syncthreads();
                ep_store_rows<64>(ct, 0, CB(C_MQ) + (nt * 2) * 96, 768, row0);
                ep_store_rows<64>(ct, 64, CB(C_MQ) + (nt * 2 + 1) * 96, 768, row0);
            } else {
                ep_rope32(ct, 4, rstd, qscale, lat, t0 - CTXL, cs32); __syncthreads();
#pragma unroll
                for (int g = 0; g < 4; ++g) ep_store_rows<32>(ct, g * 32, CB(C_MQ) + ((nt - 4) * 4 + g) * 96 + 64, 768, row0);
            }
            __syncthreads();
        } else {
            const int tk = tile - nq;
            const int mt = tk / 8, nt = tk % 8;
            const int row0 = mt * 128, b = mt / 18, t0 = (mt % 18) * 128;
            f32x4 acc[4][4];
            acc_zero<128>(acc);
            AOp A{CB(C_CKV), 128, row0, nullptr};
            gemm_core<128>(acc, A, WB(W_UKV + (size_t)l * 1024 * 128 + (size_t)nt * 128 * 128), 128, 128, smem);
            __syncthreads();
            acc_to_ct<128>(acc, ct);
            ep_rstd(CB(C_CKV), 128, row0, 128, rstd);
            __syncthreads();
            ep_scale_rows(ct, 0, 128, rstd, 1.f); __syncthreads();
            ep_store_rows<64>(ct, 0, CB(C_KN) + nt * 64, 512, row0);
            ep_store_T(ct, 64, 64, CB(C_VMT) + ((size_t)b * 8 + nt) * 64 * TPB, TPB, t0);
            __syncthreads();
        }
    }
}

template <int DK, bool MLA>
DEVI void attn_naive_wave(const Params& p, int b, int t0, int hq) {
    const int lane = TIDX & 63;
    const int t = t0 + lane, row = b * TPB + t;
    const int nkeys = (t0 < CTXL) ? CTXL : TPB;
    float q[DK];
    const bf16_t* qp = MLA ? CB(C_MQ) + (size_t)row * 768 + hq * 96 : CB(C_GQ) + (size_t)row * 512 + hq * 64;
#pragma unroll
    for (int c = 0; c < DK / 8; ++c) {
        bf16x8 tq = *(const bf16x8*)(qp + c * 8);
#pragma unroll
        for (int e = 0; e < 8; ++e) q[c * 8 + e] = bf2f((bf16_t)tq[e]);
    }
    float acc[64];
#pragma unroll
    for (int d = 0; d < 64; ++d) acc[d] = 0.f;
    float m = -1e30f, lsum = 0.f;
    const int hk = MLA ? hq : (hq >> 2);
    const bf16_t* vT = MLA ? CB(C_VMT) + ((size_t)b * 8 + hk) * 64 * TPB : CB(C_GVT) + ((size_t)b * 2 + hk) * 64 * TPB;
    for (int kt = 0; kt < nkeys; ++kt) {
        const size_t krow = (size_t)b * TPB + kt;
        float s = 0.f;
        const bf16_t* kp = MLA ? CB(C_KN) + krow * 512 + hk * 64 : CB(C_GK) + krow * 128 + hk * 64;
#pragma unroll
        for (int c = 0; c < 8; ++c) {
            bf16x8 tk = *(const bf16x8*)(kp + c * 8);
#pragma unroll
            for (int e = 0; e < 8; ++e) s += q[c * 8 + e] * bf2f((bf16_t)tk[e]);
        }
        if (MLA) {
            const bf16_t* rp = CB(C_KR) + krow * 32;
#pragma unroll
            for (int c = 0; c < 4; ++c) {
                bf16x8 tk = *(const bf16x8*)(rp + c * 8);
#pragma unroll
                for (int e = 0; e < 8; ++e) s += q[(DK - 32) + c * 8 + e] * bf2f((bf16_t)tk[e]);
            }
        }
        const float mn = fmaxf(m, s);
        const float alpha = exp2f(m - mn), pp = exp2f(s - mn);
        lsum = lsum * alpha + pp;
#pragma unroll
        for (int d = 0; d < 64; ++d) acc[d] = acc[d] * alpha + pp * bf2f(vT[(size_t)d * TPB + kt]);
        m = mn;
    }
    const float inv = 1.f / lsum;
    bf16_t* op = (MLA ? DB(D_YA) : DB(D_YD)) + (size_t)row * 512 + hq * 64;
#pragma unroll
    for (int c = 0; c < 8; ++c) {
        bf16x8 o;
#pragma unroll
        for (int e = 0; e < 8; ++e) o[e] = (short)f2bf(acc[c * 8 + e] * inv);
        *(bf16x8*)(op + c * 8) = o;
    }
}


template <int DK, bool MLA>
DEVI void attn_task(const Params& p, int b, int hsel, int tq0, int nkeys, unsigned char* smem) {
    constexpr int KLD = DK + 8;
    constexpr int CK = DK / 8;
    constexpr int NKC = 64 * CK / 256;
    constexpr int VLD = 68;
    constexpr int KBYTES = 64 * KLD * 2, VBYTES = 64 * VLD * 2;
    constexpr int VOFF = 2 * KBYTES;
    static_assert(2 * (KBYTES + VBYTES) <= 60000, "attn lds");
    const int tid = TIDX, lane = tid & 63, w = tid >> 6, qc = lane & 31, hh = lane >> 5;
    const int tq = MLA ? tq0 + w * 32 + qc : tq0 + qc;
    const int hq = MLA ? hsel : hsel * 4 + w;
    const size_t qrow = (size_t)b * TPB + tq;
    const bf16_t* qp = MLA ? CB(C_MQ) + qrow * 768 + hq * 96 : CB(C_GQ) + qrow * 512 + hq * 64;
    bf16x8 qf[DK / 16];
#pragma unroll
    for (int ks = 0; ks < DK / 16; ++ks) qf[ks] = *(const bf16x8*)(qp + ks * 16 + hh * 8);
    const bf16_t* ksrc[NKC]; int kstep[NKC], kdst[NKC];
#pragma unroll
    for (int i = 0; i < NKC; ++i) {
        const int q = tid + 256 * i, key = q / CK, ch = q % CK;
        if (MLA) {
            if (ch < 8) { ksrc[i] = CB(C_KN) + ((size_t)b * TPB + key) * 512 + hsel * 64 + ch * 8; kstep[i] = 64 * 512; }
            else { ksrc[i] = CB(C_KR) + ((size_t)b * TPB + key) * 32 + (ch - 8) * 8; kstep[i] = 64 * 32; }
        } else { ksrc[i] = CB(C_GK) + ((size_t)b * TPB + key) * 128 + hsel * 64 + ch * 8; kstep[i] = 64 * 128; }
        kdst[i] = (key * KLD + ch * 8) * 2;
    }
    const bf16_t* vT = MLA ? CB(C_VMT) + ((size_t)b * 8 + hsel) * 64 * TPB : CB(C_GVT) + ((size_t)b * 2 + hsel) * 64 * TPB;
    const bf16_t* vsrc[2]; int vdst[2];
#pragma unroll
    for (int i = 0; i < 2; ++i) {
        const int q = tid + 256 * i, dv = q >> 3, ch = q & 7;
        vsrc[i] = vT + (size_t)dv * TPB + ch * 8;
        vdst[i] = VOFF + (dv * VLD + ch * 8) * 2;
    }
    const int nt = nkeys >> 6;
    bf16x8 kr[NKC], vr[2];
#pragma unroll
    for (int i = 0; i < NKC; ++i) kr[i] = *(const bf16x8*)(ksrc[i]);
#pragma unroll
    for (int i = 0; i < 2; ++i) vr[i] = *(const bf16x8*)(vsrc[i]);
    __syncthreads();
#pragma unroll
    for (int i = 0; i < NKC; ++i) *(bf16x8*)(smem + kdst[i]) = kr[i];
#pragma unroll
    for (int i = 0; i < 2; ++i) {
        *(bf16x4*)(smem + vdst[i]) = bf16x4{vr[i][0], vr[i][1], vr[i][2], vr[i][3]};
        *(bf16x4*)(smem + vdst[i] + 8) = bf16x4{vr[i][4], vr[i][5], vr[i][6], vr[i][7]};
    }
#pragma unroll
    for (int i = 0; i < NKC; ++i) kr[i] = *(const bf16x8*)(ksrc[i] + (size_t)kstep[i]);
    __syncthreads();
    f32x16 s0, s1;
#pragma unroll
    for (int r = 0; r < 16; ++r) { s0[r] = 0.f; s1[r] = 0.f; }
#pragma unroll
    for (int ks = 0; ks < DK / 16; ++ks) {
        bf16x8 a0 = *(const bf16x8*)(smem + (qc * KLD + ks * 16 + hh * 8) * 2);
        bf16x8 a1 = *(const bf16x8*)(smem + ((32 + qc) * KLD + ks * 16 + hh * 8) * 2);
        s0 = __builtin_amdgcn_mfma_f32_32x32x16_bf16(a0, qf[ks], s0, 0, 0, 0);
        s1 = __builtin_amdgcn_mfma_f32_32x32x16_bf16(a1, qf[ks], s1, 0, 0, 0);
    }
#pragma unroll
    for (int i = 0; i < NKC; ++i) *(bf16x8*)(smem + KBYTES + kdst[i]) = kr[i];
    f32x16 o0, o1;
#pragma unroll
    for (int r = 0; r < 16; ++r) { o0[r] = 0.f; o1[r] = 0.f; }
    float m = -1e30f, lsum = 0.f;
    for (int it = 0; it < nt; ++it) {
        __syncthreads();
        if (it + 2 < nt) {
#pragma unroll
            for (int i = 0; i < NKC; ++i) kr[i] = *(const bf16x8*)(ksrc[i] + (size_t)(it + 2) * kstep[i]);
        }
        if (it + 1 < nt) {
#pragma unroll
            for (int i = 0; i < 2; ++i) vr[i] = *(const bf16x8*)(vsrc[i] + (it + 1) * 64);
        }
        f32x16 n0, n1;
#pragma unroll
        for (int r = 0; r < 16; ++r) { n0[r] = 0.f; n1[r] = 0.f; }
        if (it + 1 < nt) {
            const unsigned char* ck = smem + ((it + 1) & 1) * KBYTES;
#pragma unroll
            for (int ks = 0; ks < DK / 16; ++ks) {
                bf16x8 a0 = *(const bf16x8*)(ck + (qc * KLD + ks * 16 + hh * 8) * 2);
                bf16x8 a1 = *(const bf16x8*)(ck + ((32 + qc) * KLD + ks * 16 + hh * 8) * 2);
                n0 = __builtin_amdgcn_mfma_f32_32x32x16_bf16(a0, qf[ks], n0, 0, 0, 0);
                n1 = __builtin_amdgcn_mfma_f32_32x32x16_bf16(a1, qf[ks], n1, 0, 0, 0);
            }
        }
        float mx = s0[0];
#pragma unroll
        for (int r = 1; r < 16; ++r) mx = fmaxf(mx, s0[r]);
#pragma unroll
        for (int r = 0; r < 16; ++r) mx = fmaxf(mx, s1[r]);
        mx = fmaxf(mx, __shfl_xor(mx, 32));
        if (!__all(mx <= m + 6.f)) {
            const float mn = fmaxf(m, mx);
            const float alpha = __builtin_amdgcn_exp2f(m - mn);
            m = mn;
            lsum *= alpha;
#pragma unroll
            for (int r = 0; r < 16; ++r) { o0[r] *= alpha; o1[r] *= alpha; }
        }
        float ps = 0.f;
#pragma unroll
        for (int r = 0; r < 16; ++r) { s0[r] = __builtin_amdgcn_exp2f(s0[r] - m); ps += s0[r]; }
#pragma unroll
        for (int r = 0; r < 16; ++r) { s1[r] = __builtin_amdgcn_exp2f(s1[r] - m); ps += s1[r]; }
        lsum += ps;
        bf16x8 pf[2][2];
#pragma unroll
        for (int s = 0; s < 2; ++s)
#pragma unroll
            for (int j = 0; j < 8; ++j) { pf[0][s][j] = (short)f2bf(s0[8 * s + j]); pf[1][s][j] = (short)f2bf(s1[8 * s + j]); }
        const unsigned char* cv = smem + VOFF + (it & 1) * VBYTES;
#pragma unroll
        for (int a = 0; a < 2; ++a)
#pragma unroll
            for (int s = 0; s < 2; ++s) {
                const int keyoff = a * 32 + 16 * s + 4 * hh;
                bf16x4 l0 = *(const bf16x4*)(cv + (qc * VLD + keyoff) * 2);
                bf16x4 h0 = *(const bf16x4*)(cv + (qc * VLD + keyoff + 8) * 2);
                bf16x4 l1 = *(const bf16x4*)(cv + ((32 + qc) * VLD + keyoff) * 2);
                bf16x4 h1 = *(const bf16x4*)(cv + ((32 + qc) * VLD + keyoff + 8) * 2);
                bf16x8 v0 = bf16x8{l0[0], l0[1], l0[2], l0[3], h0[0], h0[1], h0[2], h0[3]};
                bf16x8 v1 = bf16x8{l1[0], l1[1], l1[2], l1[3], h1[0], h1[1], h1[2], h1[3]};
                o0 = __builtin_amdgcn_mfma_f32_32x32x16_bf16(v0, pf[a][s], o0, 0, 0, 0);
                o1 = __builtin_amdgcn_mfma_f32_32x32x16_bf16(v1, pf[a][s], o1, 0, 0, 0);
            }
        if (it + 2 < nt) {
            unsigned char* nk = smem + (it & 1) * KBYTES;
#pragma unroll
            for (int i = 0; i < NKC; ++i) *(bf16x8*)(nk + kdst[i]) = kr[i];
        }
        if (it + 1 < nt) {
            unsigned char* nv = smem + ((it + 1) & 1) * VBYTES;
#pragma unroll
            for (int i = 0; i < 2; ++i) {
                *(bf16x4*)(nv + vdst[i]) = bf16x4{vr[i][0], vr[i][1], vr[i][2], vr[i][3]};
                *(bf16x4*)(nv + vdst[i] + 8) = bf16x4{vr[i][4], vr[i][5], vr[i][6], vr[i][7]};
            }
        }
        s0 = n0; s1 = n1;
    }
    lsum += __shfl_xor(lsum, 32);
    const float inv = 1.f / lsum;
    bf16_t* op = (MLA ? DB(D_YA) : DB(D_YD)) + qrow * 512 + hq * 64;
#pragma unroll
    for (int g = 0; g < 4; ++g) {
        bf16x4 a, c;
#pragma unroll
        for (int e = 0; e < 4; ++e) { a[e] = (short)f2bf(o0[g * 4 + e] * inv); c[e] = (short)f2bf(o1[g * 4 + e] * inv); }
        *(bf16x4*)(op + 8 * g + 4 * hh) = a;
        *(bf16x4*)(op + 32 + 8 * g + 4 * hh) = c;
    }
}

DEVI int proc_tok(int dir, int pidx) { return dir == 0 ? pidx : (pidx < CTXL ? CTXL - 1 - pidx : (CTXL + TPB - 1) - pidx); }

DEVI void retention_naive(const Params& p, int l, int task) {
    const int b = task >> 2, h = task & 3;
    const int dir = TIDX >> 7, dv = TIDX & 127;
    const float dec = p.in[I_RDEC][l * 8 + dir * 4 + h];
    const float lg = -log1pf(expf(-dec));
    const float g = expf(lg);
    float S[64];
#pragma unroll
    for (int d = 0; d < 64; ++d) S[d] = 0.f;
    const bf16_t* vT = CB(C_RVT) + (((size_t)b * 4 + h) * 128 + dv) * TPB;
    bf16_t* outp = (dir == 0 ? DB(D_OF) : DB(D_OB));
    for (int pi = 0; pi < TPB; ++pi) {
        const int u = proc_tok(dir, pi);
        const size_t row = (size_t)b * TPB + u;
        const bf16_t* qp = CB(C_RQ) + row * 256 + h * 64;
        const bf16_t* kp = CB(C_RK) + row * 256 + h * 64;
        const float v = bf2f(vT[u]);
        float o = 0.f;
#pragma unroll
        for (int c = 0; c < 8; ++c) {
            bf16x8 tq = *(const bf16x8*)(qp + c * 8);
            bf16x8 tk = *(const bf16x8*)(kp + c * 8);
#pragma unroll
            for (int e = 0; e < 8; ++e) {
                const int d = c * 8 + e;
                const float qd = bf2f((bf16_t)tq[e]), kd = bf2f((bf16_t)tk[e]);
                if (dir == 0) { S[d] = g * S[d] + kd * v; o += qd * S[d]; }
                else { S[d] = g * S[d]; o += qd * S[d]; S[d] += kd * v; }
            }
        }
        outp[row * 512 + h * 128 + dv] = f2bf(o);
    }
}

DEVI void lru_naive_wave(const Params& p, int l, int task) {
    const int lane = TIDX & 63;
    const int b = task >> 4, d = (task >> 3) & 1, blk = task & 7;
    const int ch = blk * 64 + lane;
    float cw[4];
#pragma unroll
    for (int j = 0; j < 4; ++j) cw[j] = p.in[I_LCW][(l * 4 + j) * 512 + ch];
    const float cb = p.in[I_LCB][l * 512 + ch];
    const float ba = p.in[I_LBA][(l * 2 + d) * 512 + ch], bx = p.in[I_LBX][(l * 2 + d) * 512 + ch];
    const float lam = p.in[I_LLAM][(l * 2 + d) * 512 + ch];
    const float sp = log1pf(expf(-lam));
    const float* Wa = p.in[I_LWA] + ((size_t)(l * 2 + d) * 8 + blk) * 4096;
    const float* Wx = p.in[I_LWX] + ((size_t)(l * 2 + d) * 8 + blk) * 4096;
    float h = 0.f;
    bf16_t* outp = (d == 0 ? DB(D_LH0) : DB(D_LH1));
    for (int pi = 0; pi < TPB; ++pi) {
        const int u = proc_tok(d, pi);
        const int lo = u < CTXL ? 0 : CTXL, hi = u < CTXL ? CTXL : TPB;
        const size_t row = (size_t)b * TPB + u;
        float uval = cb;
#pragma unroll
        for (int j = 0; j < 4; ++j) {
            const int tt = u - 2 + j;
            if (tt >= lo && tt < hi) uval += cw[j] * bf2f(CB(C_LX)[((size_t)b * TPB + tt) * 512 + ch]);
        }
        float rp = 0.f, ip = 0.f;
        for (int c = 0; c < 64; ++c) {
            const float uc = __shfl(uval, c);
            rp += uc * Wa[c * 64 + lane];
            ip += uc * Wx[c * 64 + lane];
        }
        const float r = sigmoidf_(rp + ba), ig = sigmoidf_(ip + bx);
        const float la = -8.f * r * sp;
        const float a = expf(la);
        const float bb = sqrtf(-expm1f(2.f * la)) * (ig * uval);
        h = a * h + bb;
        outp[row * 512 + ch] = f2bf(h);
    }
}


DEVI void retention_walk(const Params& p, int l, int task, unsigned char* smem) {
    constexpr int PLD = 136;
    const int b = task >> 3, h = (task >> 1) & 3, dir = task & 1;
    const int tid = TIDX, lane = tid & 63, w = tid >> 6, qc = lane & 31, hh = lane >> 5;
    const float dec = p.in[I_RDEC][l * 8 + dir * 4 + h];
    const float lg2 = -log1pf(expf(-dec)) * LOG2E;
    const float cdec = exp2f(lg2 * 128.f);
    bf16_t* P = (bf16_t*)smem;
    f32x16 S0, S1;
#pragma unroll
    for (int r = 0; r < 16; ++r) { S0[r] = 0.f; S1[r] = 0.f; }
    const bf16_t* Kg = CB(C_RK) + (size_t)b * TPB * 256 + h * 64;
    const bf16_t* Qg = CB(C_RQ) + (size_t)b * TPB * 256 + h * 64;
    const bf16_t* KTg = CB(C_RKT) + ((size_t)b * 4 + h) * 64 * TPB;
    const bf16_t* VTg = CB(C_RVT) + (((size_t)b * 4 + h) * 128 + w * 32 + qc) * TPB;
    bf16_t* outp = (dir == 0 ? DB(D_OF) : DB(D_OB)) + (size_t)b * TPB * 512 + h * 128 + w * 32;
    const int iq = 32 * w + qc;
    for (int cc = 0; cc < 18; ++cc) {
        const int mch = dir == 0 ? cc : (cc < 2 ? 1 - cc : 19 - cc);
        const int t0 = mch * 128;
        bf16x8 vf[8];
#pragma unroll
        for (int ks = 0; ks < 8; ++ks) vf[ks] = *(const bf16x8*)(VTg + t0 + ks * 16 + hh * 8);
        bf16x8 qf[4];
        {
            const bf16_t* qrow = Qg + (size_t)(t0 + iq) * 256;
#pragma unroll
            for (int ks = 0; ks < 4; ++ks) qf[ks] = *(const bf16x8*)(qrow + ks * 16 + hh * 8);
        }
        __syncthreads();
#pragma unroll 1
        for (int js = 0; js < 4; ++js) {
            f32x16 sc;
#pragma unroll
            for (int r = 0; r < 16; ++r) sc[r] = 0.f;
            const bf16_t* krow = Kg + (size_t)(t0 + 32 * js + qc) * 256;
#pragma unroll
            for (int ks = 0; ks < 4; ++ks) {
                bf16x8 a = *(const bf16x8*)(krow + ks * 16 + hh * 8);
                sc = __builtin_amdgcn_mfma_f32_32x32x16_bf16(a, qf[ks], sc, 0, 0, 0);
            }
#pragma unroll
            for (int g = 0; g < 4; ++g) {
                bf16x4 pk;
#pragma unroll
                for (int e = 0; e < 4; ++e) {
                    const int j = 32 * js + 8 * g + 4 * hh + e;
                    const int d = iq - j;
                    float wgt;
                    if (dir == 0) wgt = d >= 0 ? __builtin_amdgcn_exp2f(lg2 * (float)d) : 0.f;
                    else wgt = d < 0 ? __builtin_amdgcn_exp2f(lg2 * (float)(-d)) : 0.f;
                    pk[e] = (short)f2bf(sc[4 * g + e] * wgt);
                }
                *(bf16x4*)(P + iq * PLD + 32 * js + 8 * g + 4 * hh) = pk;
            }
        }
        __syncthreads();
        bf16x8 sf[2][2];
#pragma unroll
        for (int s = 0; s < 2; ++s)
#pragma unroll
            for (int j = 0; j < 8; ++j) { sf[0][s][j] = (short)f2bf(S0[8 * s + j]); sf[1][s][j] = (short)f2bf(S1[8 * s + j]); }
#pragma unroll 1
        for (int isub = 0; isub < 4; ++isub) {
            const int ii = 32 * isub + qc;
            const bf16_t* qr = Qg + (size_t)(t0 + ii) * 256;
            f32x16 o;
#pragma unroll
            for (int r = 0; r < 16; ++r) o[r] = 0.f;
#pragma unroll
            for (int sub = 0; sub < 2; ++sub)
#pragma unroll
                for (int s = 0; s < 2; ++s) {
                    const int dk0 = 32 * sub + 16 * s + 4 * hh;
                    bf16x4 lo = *(const bf16x4*)(qr + dk0), hi = *(const bf16x4*)(qr + dk0 + 8);
                    bf16x8 bq = bf16x8{lo[0], lo[1], lo[2], lo[3], hi[0], hi[1], hi[2], hi[3]};
                    o = __builtin_amdgcn_mfma_f32_32x32x16_bf16(sf[sub][s], bq, o, 0, 0, 0);
                }
            const float qd = dir == 0 ? __builtin_amdgcn_exp2f(lg2 * (float)(ii + 1)) : __builtin_amdgcn_exp2f(lg2 * (float)(128 - ii));
#pragma unroll
            for (int r = 0; r < 16; ++r) o[r] *= qd;
#pragma unroll
            for (int ks = 0; ks < 8; ++ks) {
                bf16x8 pf = *(const bf16x8*)(P + ii * PLD + 16 * ks + 8 * hh);
                o = __builtin_amdgcn_mfma_f32_32x32x16_bf16(vf[ks], pf, o, 0, 0, 0);
            }
            bf16_t* orow = outp + (size_t)(t0 + ii) * 512;
#pragma unroll
            for (int g = 0; g < 4; ++g) {
                bf16x4 pk;
#pragma unroll
                for (int e = 0; e < 4; ++e) pk[e] = (short)f2bf(o[4 * g + e]);
                *(bf16x4*)(orow + 8 * g + 4 * hh) = pk;
            }
        }
#pragma unroll
        for (int r = 0; r < 16; ++r) { S0[r] *= cdec; S1[r] *= cdec; }
#pragma unroll
        for (int ks = 0; ks < 8; ++ks) {
            bf16x8 vs;
#pragma unroll
            for (int e = 0; e < 8; ++e) {
                const int j = 16 * ks + 8 * hh + e;
                const float kd = dir == 0 ? __builtin_amdgcn_exp2f(lg2 * (float)(127 - j)) : __builtin_amdgcn_exp2f(lg2 * (float)j);
                vs[e] = (short)f2bf(bf2f((bf16_t)vf[ks][e]) * kd);
            }
            bf16x8 a0 = *(const bf16x8*)(KTg + (size_t)qc * TPB + t0 + 16 * ks + 8 * hh);
            bf16x8 a1 = *(const bf16x8*)(KTg + (size_t)(32 + qc) * TPB + t0 + 16 * ks + 8 * hh);
            S0 = __builtin_amdgcn_mfma_f32_32x32x16_bf16(a0, vs, S0, 0, 0, 0);
            S1 = __builtin_amdgcn_mfma_f32_32x32x16_bf16(a1, vs, S1, 0, 0, 0);
        }
    }
    __syncthreads();
}

DEVI void lru_walk(const Params& p, int l, int task, unsigned char* smem) {
    const int b = task >> 4, d = (task >> 3) & 1, blk = task & 7;
    const int tid = TIDX, lane = tid & 63, w = tid >> 6, ln = lane & 15, g = lane >> 4;
    bf16_t* Wt = (bf16_t*)smem;
    float* uw = (float*)(smem + 18432 + w * 4224);
    float* cpar = (float*)(smem + 35328);
    float* agg = (float*)(smem + 36608);
    __syncthreads();
    {
        const bf16_t* wsrc = WB(W_LRU + ((size_t)(l * 2 + d) * 8 + blk) * 8192);
        for (int c = tid; c < 128 * 8; c += 256) {
            const int n = c >> 3, kc = c & 7;
            *(bf16x8*)(Wt + n * 72 + kc * 8) = *(const bf16x8*)(wsrc + n * 64 + kc * 8);
        }
        if (tid < 64) {
            const int ch = blk * 64 + tid;
#pragma unroll
            for (int j = 0; j < 4; ++j) cpar[j * 64 + tid] = p.in[I_LCW][(l * 4 + j) * 512 + ch];
            cpar[256 + tid] = p.in[I_LCB][l * 512 + ch];
        }
    }
    __syncthreads();
    float ba[4], bx[4], sp[4], hc[4];
#pragma unroll
    for (int ct = 0; ct < 4; ++ct) {
        const int ch = blk * 64 + 16 * ct + ln;
        ba[ct] = p.in[I_LBA][(l * 2 + d) * 512 + ch];
        bx[ct] = p.in[I_LBX][(l * 2 + d) * 512 + ch];
        sp[ct] = log1pf(expf(-p.in[I_LLAM][(l * 2 + d) * 512 + ch]));
        hc[ct] = 0.f;
    }
    const bf16_t* X = CB(C_LX) + (size_t)b * TPB * 512 + blk * 64;
    bf16_t* outp = (d == 0 ? DB(D_LH0) : DB(D_LH1)) + (size_t)b * TPB * 512 + blk * 64;
    bf16x8 xr[2][4];
    float xm[4];
    {
        const int tok = proc_tok(d, 16 * w + ln);
        const int lo = tok < CTXL ? 0 : CTXL, hi = tok < CTXL ? CTXL : TPB;
#pragma unroll
        for (int ks = 0; ks < 2; ++ks)
#pragma unroll
            for (int j = 0; j < 4; ++j) {
                const int tt = tok - 2 + j;
                const int tc = tt < lo ? lo : (tt >= hi ? hi - 1 : tt);
                xr[ks][j] = *(const bf16x8*)(X + (size_t)tc * 512 + 32 * ks + 8 * g);
                xm[j] = (tt >= lo && tt < hi) ? 1.f : 0.f;
            }
    }
    for (int c = 0; c < 36; ++c) {
        bf16x8 af[2];
#pragma unroll
        for (int ks = 0; ks < 2; ++ks) {
            const int c0 = 32 * ks + 8 * g;
            float u8[8];
#pragma unroll
            for (int e = 0; e < 8; ++e) u8[e] = cpar[256 + c0 + e];
#pragma unroll
            for (int j = 0; j < 4; ++j)
#pragma unroll
                for (int e = 0; e < 8; ++e) u8[e] += (cpar[j * 64 + c0 + e] * xm[j]) * bf2f((bf16_t)xr[ks][j][e]);
#pragma unroll
            for (int e = 0; e < 8; ++e) { uw[ln * 65 + c0 + e] = u8[e]; af[ks][e] = (short)f2bf(u8[e]); }
        }
        if (c + 1 < 36) {
            const int tok = proc_tok(d, 64 * (c + 1) + 16 * w + ln);
            const int lo = tok < CTXL ? 0 : CTXL, hi = tok < CTXL ? CTXL : TPB;
#pragma unroll
            for (int ks = 0; ks < 2; ++ks)
#pragma unroll
                for (int j = 0; j < 4; ++j) {
                    const int tt = tok - 2 + j;
                    const int tc = tt < lo ? lo : (tt >= hi ? hi - 1 : tt);
                    xr[ks][j] = *(const bf16x8*)(X + (size_t)tc * 512 + 32 * ks + 8 * g);
                    xm[j] = (tt >= lo && tt < hi) ? 1.f : 0.f;
                }
        }
        __builtin_amdgcn_wave_barrier();
        f32x4 acc[8];
#pragma unroll
        for (int nt = 0; nt < 8; ++nt) acc[nt] = f32x4{0.f, 0.f, 0.f, 0.f};
#pragma unroll
        for (int ks = 0; ks < 2; ++ks)
#pragma unroll
            for (int nt = 0; nt < 8; ++nt) {
                bf16x8 bfr = *(const bf16x8*)(Wt + (16 * nt + ln) * 72 + 32 * ks + 8 * g);
                acc[nt] = __builtin_amdgcn_mfma_f32_16x16x32_bf16(af[ks], bfr, acc[nt], 0, 0, 0);
            }
        float A[4][4], B[4][4];
#pragma unroll
        for (int ct = 0; ct < 4; ++ct) {
            float pa = 1.f, pb = 0.f;
#pragma unroll
            for (int j = 0; j < 4; ++j) {
                const float r = fsig(acc[ct][j] + ba[ct]);
                const float ig = fsig(acc[4 + ct][j] + bx[ct]);
                const float la = -8.f * r * sp[ct];
                const float a = __expf(la);
                const float uu = uw[(4 * g + j) * 65 + 16 * ct + ln];
                const float bb = __builtin_amdgcn_sqrtf(fmaxf(1.f - a * a, 0.f)) * ig * uu;
                pb = a * pb + bb; pa = a * pa;
                A[ct][j] = pa; B[ct][j] = pb;
            }
            float ia = pa, ib = pb;
#pragma unroll
            for (int dd = 1; dd <= 2; dd <<= 1) {
                const float qa = __shfl_up(ia, 16 * dd), qb = __shfl_up(ib, 16 * dd);
                if (g >= dd) { ib = ia * qb + ib; ia = ia * qa; }
            }
            float ea = __shfl_up(ia, 16), eb = __shfl_up(ib, 16);
            if (g == 0) { ea = 1.f; eb = 0.f; }
#pragma unroll
            for (int j = 0; j < 4; ++j) { B[ct][j] = A[ct][j] * eb + B[ct][j]; A[ct][j] = A[ct][j] * ea; }
            if (g == 3) {
                float* ag = agg + (((c & 1) * 4 + w) * 64 + 16 * ct + ln) * 2;
                ag[0] = ia; ag[1] = ib;
            }
        }
        __syncthreads();
#pragma unroll
        for (int ct = 0; ct < 4; ++ct) {
            float hrun = hc[ct], hin = 0.f;
#pragma unroll
            for (int w2 = 0; w2 < 4; ++w2) {
                const float* ag = agg + (((c & 1) * 4 + w2) * 64 + 16 * ct + ln) * 2;
                if (w2 == w) hin = hrun;
                hrun = ag[0] * hrun + ag[1];
            }
            hc[ct] = hrun;
#pragma unroll
            for (int j = 0; j < 4; ++j) {
                const int tok2 = proc_tok(d, 64 * c + 16 * w + 4 * g + j);
                outp[(size_t)tok2 * 512 + 16 * ct + ln] = f2bf(A[ct][j] * hin + B[ct][j]);
            }
        }
    }
    __syncthreads();
}

DEVI void phase_mix(const Params& p, int l, unsigned char* smem) {
    const int NLRU = 128, NRET = (l == 0 ? 576 : 512);
    const int NLAT = 1024, NCTX = (l == 0 ? 128 : 0);
    const int ntask = NLRU + NRET + 2 * NLAT + 2 * NCTX;
    const int ncvt = 3072;
    int cv = BIDX;
    int* ctr = WSI(OFF_CNT) + 128 + l;
    volatile int* nxt = (volatile int*)(smem + 65520);
    for (;;) {
        __syncthreads();
        if (TIDX == 0) *nxt = atomicAdd(ctr, 1);
        __syncthreads();
        const int task = *nxt;
        if (task >= ntask) break;
        if (cv < ncvt) { CvtJob j = get_moe_job(p, l, cv >> 10); if ((cv >> 10) < 2) cvt_tile256_fp8(j, cv & 1023, smem); else cvt_tile256(j, cv & 1023, smem); cv += gridDim.x; }
        if (task < NLRU) lru_walk(p, l, task, smem);
        else if (task >= NLRU + 2 * NLAT && task < NLRU + 2 * NLAT + NRET) {
            const int a = task - NLRU - 2 * NLAT;
            int b, h, m;
            if (l == 0) { b = a / 72; const int r = a % 72; h = r / 18; m = r % 18; }
            else { b = a >> 6; const int r = a & 63; h = r >> 4; m = 2 + (r & 15); }
            ret_out_task(p, l, b, h, m, smem);
        } else {
            int a = task < NLRU + 2 * NLAT ? task - NLRU : task - NLRU - NRET;
            int kind, b, hsel, tq0, nkeys;
            if (a < NLAT) { kind = 0; b = a >> 7; const int r = a & 127; hsel = r >> 4; tq0 = CTXL + (r & 15) * 128; nkeys = TPB; }
            else if (a < 2 * NLAT) { a -= NLAT; kind = 1; b = a >> 7; const int r = a & 127; hsel = r >> 6; tq0 = CTXL + (r & 63) * 32; nkeys = TPB; }
            else if (a < 2 * NLAT + NCTX) { a -= 2 * NLAT; kind = 0; b = a >> 4; const int r = a & 15; hsel = r >> 1; tq0 = (r & 1) * 128; nkeys = CTXL; }
            else { a -= 2 * NLAT + NCTX; kind = 1; b = a >> 4; const int r = a & 15; hsel = r >> 3; tq0 = (r & 7) * 32; nkeys = CTXL; }
            if (kind == 0) attn_task<96, true>(p, b, hsel, tq0, nkeys, smem);
            else attn_task<64, false>(p, b, hsel, tq0, nkeys, smem);
        }
    }
    for (; cv < ncvt; cv += gridDim.x) { CvtJob j = get_moe_job(p, l, cv >> 10); if ((cv >> 10) < 2) cvt_tile256_fp8(j, cv & 1023, smem); else cvt_tile256(j, cv & 1023, smem); }
}

DEVI void phase_fin(const Params& p, int l) {
    const int lane = TIDX & 63, w = TIDX >> 6;
    for (int row = BIDX * 4 + w; row < TT; row += gridDim.x * 4) {
        if (l == 1 && (row % TPB) < CTXL) continue;
        const size_t o = (size_t)row * 512 + lane * 8;
        bf16x8 h0 = *(const bf16x8*)(DB(D_LH0) + o), h1 = *(const bf16x8*)(DB(D_LH1) + o), lg = *(const bf16x8*)(CB(C_LG) + o);
        bf16x8 oc;
#pragma unroll
        for (int e = 0; e < 8; ++e) oc[e] = (short)f2bf((bf2f((bf16_t)h0[e]) + bf2f((bf16_t)h1[e])) * gelu_tanh(bf2f((bf16_t)lg[e])));
        *(bf16x8*)(DB(D_LH0) + o) = oc;
    }
}

DEVI void merge_tile(const Params& p, int l, int mq, int nt, unsigned char* smem) {
    bf16_t* ct = (bf16_t*)smem;
    const int lane = TIDX & 63, wc = (TIDX >> 6) & 1;
    const int mt = mt_of(mq, l != 0);
    const int row0 = mt * 128;
    unsigned mp[4][4][2];
#pragma unroll
    for (int mi = 0; mi < 4; ++mi)
#pragma unroll
        for (int ni = 0; ni < 4; ++ni) { mp[mi][ni][0] = 0u; mp[mi][ni][1] = 0u; }
#pragma unroll 1
    for (int n = 0; n < 4; ++n) {
        unsigned gp[4][4][2];
        {
            f32x4 ag[4][4];
            acc_zero<128>(ag);
            gemm_core_fp8<false>(ag, (const unsigned char*)HB, 2048, row0, (const unsigned char*)WB(W_MG + (size_t)l * 4096 * 1024) + (size_t)(n * 1024 + nt * 128) * 1024, 1024, 1024, smem);
            const float* bm = p.in[I_BMG] + l * 4096 + n * 1024 + nt * 128 + wc * 64 + (lane & 15);
#pragma unroll
            for (int ni = 0; ni < 4; ++ni) {
                const float bias = bm[ni * 16];
#pragma unroll
                for (int mi = 0; mi < 4; ++mi) {
                    gp[mi][ni][0] = (unsigned)f2bf(fsig(ag[mi][ni][0] + bias)) | ((unsigned)f2bf(fsig(ag[mi][ni][1] + bias)) << 16);
                    gp[mi][ni][1] = (unsigned)f2bf(fsig(ag[mi][ni][2] + bias)) | ((unsigned)f2bf(fsig(ag[mi][ni][3] + bias)) << 16);
                }
            }
        }
        f32x4 ap[4][4];
        acc_zero<128>(ap);
        const bf16_t* yb = n == 0 ? DB(D_YA) : (n == 1 ? DB(D_OF) : (n == 2 ? DB(D_LH0) : DB(D_YD)));
        AOp A2{yb, 512, row0, nullptr};
        gemm_core<128>(ap, A2, WB(W_BR + ((size_t)l * 4 + n) * 1024 * 512 + (size_t)(nt * 128) * 512), 512, 512, smem);
#pragma unroll
        for (int mi = 0; mi < 4; ++mi)
#pragma unroll
            for (int ni = 0; ni < 4; ++ni) {
                const float m0 = __uint_as_float(mp[mi][ni][0] << 16) + __uint_as_float(gp[mi][ni][0] << 16) * ap[mi][ni][0];
                const float m1 = __uint_as_float(mp[mi][ni][0] & 0xffff0000u) + __uint_as_float(gp[mi][ni][0] & 0xffff0000u) * ap[mi][ni][1];
                const float m2 = __uint_as_float(mp[mi][ni][1] << 16) + __uint_as_float(gp[mi][ni][1] << 16) * ap[mi][ni][2];
                const float m3 = __uint_as_float(mp[mi][ni][1] & 0xffff0000u) + __uint_as_float(gp[mi][ni][1] & 0xffff0000u) * ap[mi][ni][3];
                mp[mi][ni][0] = (unsigned)f2bf(m0) | ((unsigned)f2bf(m1) << 16);
                mp[mi][ni][1] = (unsigned)f2bf(m2) | ((unsigned)f2bf(m3) << 16);
            }
    }
    __syncthreads();
    {
        const int wid = TIDX >> 6, wr = wid >> 1;
#pragma unroll
        for (int mi = 0; mi < 4; ++mi)
#pragma unroll
            for (int ni = 0; ni < 4; ++ni) {
                bf16_t* cp = ct + (wr * 64 + mi * 16 + (lane >> 4) * 4) * CT_LD + wc * 64 + ni * 16 + (lane & 15);
                cp[0] = (bf16_t)(mp[mi][ni][0] & 0xffffu); cp[CT_LD] = (bf16_t)(mp[mi][ni][0] >> 16);
                cp[2 * CT_LD] = (bf16_t)(mp[mi][ni][1] & 0xffffu); cp[3 * CT_LD] = (bf16_t)(mp[mi][ni][1] >> 16);
            }
    }
    __syncthreads();
    ep_store_rows<128>(ct, 0, CB(C_M) + nt * 128, 1024, row0);
}

DEVI void wout_tile(const Params& p, int l, int mq, int nt, unsigned char* smem) {
    bf16_t* ct = (bf16_t*)smem;
    const int mt = mt_of(mq, l != 0);
    const int row0 = mt * 128, b = mt / 18, t0 = (mt % 18) * 128;
    const bool isctx = (mt % 18) < 2;
    const int bi = isctx ? 8 : b;
    f32x4 acc[4][4];
    acc_zero<128>(acc);
    AOp A{CB(C_M), 1024, row0, nullptr};
    gemm_core<128>(acc, A, WB(W_OUT + (size_t)l * 1024 * 1024 + (size_t)nt * 128 * 1024), 1024, 1024, smem);
    __syncthreads();
    acc_to_ct<128>(acc, ct);
    __syncthreads();
    const float* gate = WSF(OFF_MOD) + (size_t)(l * 9 + bi) * 6144 + 2 * 1024 + nt * 128;
    for (int c = TIDX; c < 128 * 32; c += 256) {
        const int i = c >> 5, jc = c & 31;
        const int t = t0 + i;
        const float* xs;
        if (l == 0) xs = isctx ? p.in[I_CTX] + ((size_t)b * CTXL + t) * DM : p.in[I_X] + ((size_t)b * SEQL + (t - CTXL)) * DM;
        else xs = XCUR + (size_t)(row0 + i) * DM;
        float4 x4 = *(const float4*)(xs + nt * 128 + jc * 4);
        float4 g4 = *(const float4*)(gate + jc * 4);
        uint2 y = *(const uint2*)(ct + i * CT_LD + jc * 4);
        x4.x += g4.x * __uint_as_float(y.x << 16);
        x4.y += g4.y * __uint_as_float(y.x & 0xffff0000u);
        x4.z += g4.z * __uint_as_float(y.y << 16);
        x4.w += g4.w * __uint_as_float(y.y & 0xffff0000u);
        *(float4*)(XCUR + (size_t)(row0 + i) * DM + nt * 128 + jc * 4) = x4;
    }
}

DEVI void phase_merge_wout(const Params& p, int l, unsigned char* smem) {
    const int nmt = (l == 0 ? 144 : 128);
    const int N5 = nmt * 8;
    int* ctr = WSI(OFF_CNT) + 132 + l;
    int* dep = WSI(OFF_CNT) + 256 + l * 160;
    for (;;) {
        const int task = fetch_task(ctr, smem);
        if (task >= 2 * N5) break;
        if (task < N5) {
            merge_tile(p, l, task >> 3, task & 7, smem);
            dep_signal(dep + (task >> 3));
        } else {
            const int t6 = task - N5;
            dep_wait(dep + (t6 >> 3), 8);
            wout_tile(p, l, t6 >> 3, t6 & 7, smem);
        }
    }
}

DEVI void phase_route(const Params& p, int l, unsigned char* smem) {
    const int tid = TIDX, lane = tid & 63, w = tid >> 6, wr = w >> 1, wc = w & 1;
    float* lgt = (float*)smem;
    const float rbias = p.in[I_RB][lane];
    int* cnt = WSI(OFF_CNT) + l * 64;
    int* list = WSI(OFF_LIST);
    const int ntile = l == 0 ? 144 : 128;
    for (int q = BIDX; q < ntile; q += gridDim.x) {
        const int mt = mt_of(q, l != 0);
        const int row0 = mt * 128;
        f32x4 acc[4][2];
        acc_zero<64>(acc);
        AOp A{HB, 1024, row0, nullptr};
        gemm_core<64>(acc, A, WB(W_RT), 1024, 1024, smem);
        __syncthreads();
#pragma unroll
        for (int mi = 0; mi < 4; ++mi)
#pragma unroll
            for (int ni = 0; ni < 2; ++ni)
#pragma unroll
                for (int j = 0; j < 4; ++j)
                    lgt[(wr * 64 + mi * 16 + (lane >> 4) * 4 + j) * 68 + wc * 32 + ni * 16 + (lane & 15)] = acc[mi][ni][j];
        __syncthreads();
        int me0 = 0, me1 = 0; float ms0 = 0.f, ms1 = 0.f;
#pragma unroll 2
        for (int i = 0; i < 32; ++i) {
            const float lg = lgt[(w * 32 + i) * 68 + lane];
            const float score = sigmoidf_(lg);
            const float biased = score + rbias;
            float v1 = biased; int i1 = lane;
#pragma unroll
            for (int off = 1; off < 8; off <<= 1) {
                float ov = __shfl_xor(v1, off); int oi = __shfl_xor(i1, off);
                if (ov > v1 || (ov == v1 && oi < i1)) { v1 = ov; i1 = oi; }
            }
            float v2 = (lane == i1) ? -3.0e38f : biased; int i2 = lane;
#pragma unroll
            for (int off = 1; off < 8; off <<= 1) {
                float ov = __shfl_xor(v2, off); int oi = __shfl_xor(i2, off);
                if (ov > v2 || (ov == v2 && oi < i2)) { v2 = ov; i2 = oi; }
            }
            float gv = v1 + v2; int gi = lane >> 3;
#pragma unroll
            for (int off = 8; off < 64; off <<= 1) {
                float ov = __shfl_xor(gv, off); int oi = __shfl_xor(gi, off);
                if (ov > gv || (ov == gv && oi < gi)) { gv = ov; gi = oi; }
            }
            const int e0 = __shfl(i1, gi * 8), e1 = __shfl(i2, gi * 8);
            const float s0 = __shfl(score, e0), s1 = __shfl(score, e1);
            if (lane == i) { me0 = e0; me1 = e1; ms0 = s0; ms1 = s1; }
        }
        int* hist = (int*)(smem + 36864);
        int* base = hist + 64;
        if (tid < 64) hist[tid] = 0;
        __syncthreads();
        int r0 = 0, r1 = 0;
        if (lane < 32) { r0 = atomicAdd(&hist[me0], 1); r1 = atomicAdd(&hist[me1], 1); }
        __syncthreads();
        if (tid < 64) { const int hc = hist[tid]; base[tid] = hc ? atomicAdd(&cnt[tid], hc) : 0; }
        __syncthreads();
        if (lane < 32) {
            const int row = row0 + w * 32 + lane;
            Rec rc;
            rc.e0 = me0; rc.e1 = me1;
            rc.p0 = base[me0] + r0;
            rc.p1 = base[me1] + r1;
            const float inv = 1.f / (ms0 + ms1);
            rc.w0 = ms0 * inv; rc.w1 = ms1 * inv; rc.pad0 = 0; rc.pad1 = 0;
            list[(size_t)me0 * TT + rc.p0] = row;
            list[(size_t)me1 * TT + rc.p1] = row;
            ((Rec*)(p.ws + OFF_REC))[row] = rc;
        }
        __syncthreads();
    }
}

struct MoeGrp { int ne[8], sg[8], cn[8]; };
DEVI MoeGrp moe_grp(const MoeTab& mt, const GrpInfo& gi) {
    MoeGrp g;
#pragma unroll
    for (int q = 0; q < 8; ++q) {
        const int ee = gi.ngrp == 8 ? gi.xcd * 8 + q : 0;
        g.cn[q] = mt.cnt(ee); g.sg[q] = mt.seg(ee); g.ne[q] = (g.cn[q] + 127) >> 7;
    }
    return g;
}
DEVI bool moe_tile(const MoeTab& mt, const MoeGrp& mg, const GrpInfo& gi, int it, int NT, int& e, int& jt, int& nt, int& cn, int& sg) {
    int rem = gi.j + gi.per * it;
    if (gi.ngrp == 8) {
#pragma unroll
        for (int q = 0; q < 8; ++q) {
            const int ne = mg.ne[q] * NT;
            if (rem < ne) { e = gi.xcd * 8 + q; jt = rem / NT; nt = rem % NT; cn = mg.cn[q]; sg = mg.sg[q]; return true; }
            rem -= ne;
        }
        return false;
    }
    for (int ee = 0; ee < 64; ++ee) {
        const int c = mt.cnt(ee);
        const int ne = ((c + 127) >> 7) * NT;
        if (rem < ne) { e = ee; jt = rem / NT; nt = rem % NT; cn = c; sg = mt.seg(ee); return true; }
        rem -= ne;
    }
    return false;
}
struct MoeRegs { int tp, cnt, seg; };
DEVI void moe_find(const MoeRegs& mr, int rt, int& e, int& jt, int& cn, int& sg) {
    const unsigned long long m = __ballot(mr.tp <= rt);
    e = __popcll(m) - 1;
    jt = rt - __shfl(mr.tp, e); cn = __shfl(mr.cnt, e); sg = __shfl(mr.seg, e);
}
DEVI void phase_moe(const Params& p, int l, unsigned char* smem) {
    bf16_t* ct = (bf16_t*)smem;
    int* ridx = (int*)(smem + AUX_OFF);
    MoeTab mt = moe_tables(p, l, smem);
    const int* list = WSI(OFF_LIST);
    const int nrt = mt.tp(64);
    MoeRegs mr; mr.tp = mt.tp(TIDX & 63); mr.cnt = mt.cnt(TIDX & 63); mr.seg = mt.seg(TIDX & 63);
    int* ctr = WSI(OFF_CNT) + 136 + l;
    int* dep = WSI(OFF_CNT) + 1024 + l * 384;
    for (;;) {
        const int task = fetch_task(ctr, smem);
        if (task >= nrt * 12) break;
        if (task < nrt * 4) {
            const int rt = task >> 2, nt = task & 3;
            int e, jt, cn, sg;
            moe_find(mr, rt, e, jt, cn, sg);
            if (TIDX < 128) {
                const int idx = jt * 128 + TIDX;
                ridx[TIDX] = list[(size_t)e * TT + (idx < cn ? idx : 0)];
            }
            __syncthreads();
            f32x4 acc[4][4];
            acc_zero<128>(acc);
            gemm_core_fp8<true>(acc, (const unsigned char*)CB(0), 1024, 0, (const unsigned char*)MWB(MW_13) + ((size_t)e * 512 + nt * 128) * 1024, 1024, 1024, smem, ridx);
            __syncthreads();
            acc_to_ct<128>(acc, ct);
            __syncthreads();
            const int slot0 = sg + jt * 128;
            for (int c = TIDX; c < 128 * 8; c += 256) {
                const int i = c >> 3, jc = c & 7;
                bf16x8 a = *(const bf16x8*)(ct + i * CT_LD + jc * 8), g = *(const bf16x8*)(ct + i * CT_LD + 64 + jc * 8), o;
#pragma unroll
                for (int q = 0; q < 8; ++q) o[q] = (short)f2bf(siluf_(bf2f((bf16_t)a[q])) * bf2f((bf16_t)g[q]));
                *(bf16x8*)(DB(D_ACT) + (size_t)(slot0 + i) * 256 + nt * 64 + jc * 8) = o;
            }
            dep_signal(dep + rt);
        } else {
            const int t2 = task - nrt * 4;
            const int rt = t2 >> 3, nt = t2 & 7;
            int e, jt, cn, sg;
            moe_find(mr, rt, e, jt, cn, sg);
            const int slot0 = sg + jt * 128;
            dep_wait(dep + rt, 4);
            f32x4 acc[4][4];
            acc_zero<128>(acc);
            AOp A{DB(D_ACT), 256, slot0, nullptr};
            gemm_core<128>(acc, A, MWB(MW_2) + ((size_t)e * 1024 + nt * 128) * 256, 256, 256, smem);
            __syncthreads();
            acc_to_ct<128>(acc, ct);
            __syncthreads();
            ep_store_rows<128>(ct, 0, DB(D_YS) + nt * 128, 1024, slot0);
        }
    }
}

#define XB_TMO      128
#define XB_XCNT(j)  (256  + 64 * (j))
#define XB_XSUB(j)  (1280 + 64 * (j))
#define XB_XGEN(j)  (2304 + 64 * (j))
#define XB_TOP      3328
#define XB_TOPGEN   3392
#define XB_SPIN_CAP (1u << 22)
DEVI unsigned xb_ld(unsigned* p) { return __hip_atomic_load(p, __ATOMIC_RELAXED, __HIP_MEMORY_SCOPE_AGENT); }
DEVI unsigned xb_add(unsigned* p, unsigned v) { return __hip_atomic_fetch_add(p, v, __ATOMIC_RELAXED, __HIP_MEMORY_SCOPE_AGENT); }
DEVI unsigned xb_xcc_id() { return (unsigned)__builtin_amdgcn_s_getreg((3 << 11) | 20) & 0xFu; }
#define XB_SPIN(cond, bar) do { unsigned _sp = 0; while (cond) { __builtin_amdgcn_s_sleep(1); \
    if ((++_sp & 255u) == 0u) { if (xb_ld(&(bar)[XB_TMO])) break; if (_sp > XB_SPIN_CAP) { atomicAdd(&(bar)[XB_TMO], 1u); break; } } } } while (0)
struct XcdBarrier { unsigned* bar; unsigned x; unsigned* st; };
DEVI XcdBarrier xcd_barrier_post(unsigned* bar, unsigned* st) {
    XcdBarrier b; b.bar = bar; b.x = xb_xcc_id(); b.st = st;
    if (__builtin_amdgcn_workitem_id_x() == 0) (void)xb_add(&bar[XB_XCNT(b.x)], 1u);
    return b;
}
DEVI void xcd_barrier_complete(unsigned* bar, unsigned x, unsigned& nloc, unsigned& nx) {
    const unsigned G = gridDim.x * gridDim.y * gridDim.z;
    unsigned sum, cnt, mine, sp = 0u;
    for (;;) {
        sum = 0u; cnt = 0u; mine = 0u;
#pragma unroll
        for (unsigned j = 0; j < 16; ++j) { const unsigned c = xb_ld(&bar[XB_XCNT(j)]); sum += c; cnt += (c > 0u) ? 1u : 0u; mine = (j == x) ? c : mine; }
        if (sum == G) break;
        __builtin_amdgcn_s_sleep(1);
        if ((++sp & 255u) == 0u) { if (xb_ld(&bar[XB_TMO])) break; if (sp > XB_SPIN_CAP) { atomicAdd(&bar[XB_TMO], 1u); break; } }
    }
    nloc = mine > 0u ? mine : 1u; nx = cnt > 0u ? cnt : 1u;
}
DEVI void xcd_barrier(const XcdBarrier& b) {
    asm volatile("s_waitcnt vmcnt(0)" ::: "memory");
    __syncthreads();
    if (__builtin_amdgcn_workitem_id_x() == 0) {
        unsigned* bar = b.bar;
        __builtin_amdgcn_s_waitcnt(0);
        unsigned nloc = xb_ld(&b.st[0]), nx = xb_ld(&b.st[1]);
        if (nloc == 0u) { xcd_barrier_complete(bar, b.x, nloc, nx); __hip_atomic_store(&b.st[0], nloc, __ATOMIC_RELAXED, __HIP_MEMORY_SCOPE_AGENT); __hip_atomic_store(&b.st[1], nx, __ATOMIC_RELAXED, __HIP_MEMORY_SCOPE_AGENT); }
        const unsigned old = xb_add(&bar[XB_XSUB(b.x)], 1u);
        const unsigned gen = old / nloc;
        if (old + 1u == (gen + 1u) * nloc) {
            __builtin_amdgcn_fence(__ATOMIC_RELEASE, "agent");
            asm volatile("s_waitcnt vmcnt(0)" ::: "memory");
            const unsigned og = xb_add(&bar[XB_TOP], 1u);
            const unsigned tg = og / nx;
            if (og + 1u == (tg + 1u) * nx) xb_add(&bar[XB_TOPGEN], 1u);
            else XB_SPIN(xb_ld(&bar[XB_TOPGEN]) == tg, bar);
            __builtin_amdgcn_fence(__ATOMIC_ACQUIRE, "agent");
            xb_add(&bar[XB_XGEN(b.x)], 1u);
            asm volatile("s_waitcnt vmcnt(0)" ::: "memory");
        } else {
            XB_SPIN(xb_ld(&bar[XB_XGEN(b.x)]) == gen, bar);
            __builtin_amdgcn_fence(__ATOMIC_ACQUIRE, "agent");
            asm volatile("s_waitcnt vmcnt(0)" ::: "memory");
        }
    }
    __syncthreads();
}

constexpr int NPHASE = 24;
DEVI void run_phase(const Params& p, int ph, unsigned char* smem) {
#ifndef ONLYK
    if (ph == 0) { phase0(p, smem); return; }
    if (ph == 23) { phase_norm1(p, 1, 1, smem); return; }
#endif
    const int l = (ph - 1) / 11, k = (ph - 1) % 11;
#ifdef ONLYK
    if (k != ONLYK) return;
#endif
    switch (k) {
    case 0: phase_norm1(p, l, 0, smem); break;
    case 1: phase_win(p, l, smem); break;
    case 2: phase_mla_up(p, l, smem); break;
    case 3: phase_mix(p, l, smem); break;
    case 4: phase_fin(p, l); break;
    case 5: phase_merge_wout(p, l, smem); break;
    case 6: break;
    case 7: phase_norm1(p, l, 2, smem); break;
    case 8: phase_route(p, l, smem); break;
    case 9: phase_moe(p, l, smem); break;
    default: break;
    }
}

__global__ void __launch_bounds__(256, 2) k_main(Params p, int ph_lo, int ph_hi) {
    __shared__ __attribute__((aligned(16))) unsigned char smem[SMEM_BYTES];
    unsigned* xb_priv = (unsigned*)(p.ws + OFF_PRIV + (size_t)__builtin_amdgcn_workgroup_id_x() * 1024 + 896);
    if (__builtin_amdgcn_workitem_id_x() == 0) { __hip_atomic_store(xb_priv, 0u, __ATOMIC_RELAXED, __HIP_MEMORY_SCOPE_AGENT); __hip_atomic_store(xb_priv + 1, 0u, __ATOMIC_RELAXED, __HIP_MEMORY_SCOPE_AGENT); }
    XcdBarrier xb = xcd_barrier_post((unsigned*)(p.ws + OFF_BAR), xb_priv);
    if (__builtin_amdgcn_workitem_id_x() == 0) {
        const unsigned rk = xb_add((unsigned*)(p.ws + OFF_BAR) + 3456 + xb.x, 1u);
        __hip_atomic_store(xb_priv + 2, xb.x, __ATOMIC_RELAXED, __HIP_MEMORY_SCOPE_AGENT);
        __hip_atomic_store(xb_priv + 3, rk, __ATOMIC_RELAXED, __HIP_MEMORY_SCOPE_AGENT);
    }
    for (int ph = ph_lo; ph < ph_hi; ++ph) {
        if (ph >= 1 && ph <= 22 && (((ph - 1) % 11) == 6 || ((ph - 1) % 11) == 10)) continue;
        run_phase(p, ph, smem);
#ifdef DUPK
        if (ph >= 1 && ph <= 22 && ((ph - 1) % 11) == DUPK) run_phase(p, ph, smem);
        if (DUPK == 10 && ph == 0) run_phase(p, ph, smem);
#endif
        if (ph + 1 < ph_hi) {
            if (ph_hi < 0) cg::this_grid().sync();
            xcd_barrier(xb);
        }
    }
#ifdef TPROBE
    if (__builtin_amdgcn_workgroup_id_x() == 0 && __builtin_amdgcn_workitem_id_x() == 0) {
        const unsigned long long dt = __hip_atomic_load(T_SLOT(TPROBE), __ATOMIC_RELAXED, __HIP_MEMORY_SCOPE_AGENT) * TMULT;
        const unsigned long long t0 = __builtin_amdgcn_s_memrealtime();
        while (__builtin_amdgcn_s_memrealtime() - t0 < dt) __builtin_amdgcn_s_sleep(8);
    }
#endif
}

extern "C" void kernel_launch(void* const* d_in, const int* in_sizes, int n_in, void* d_out, int out_size, void* d_ws, size_t ws_size,
                              hipStream_t stream) {
    if (ws_size < WS_NEED || n_in < N_IN) { fprintf(stderr, "workspace too small: %zu < %zu\n", ws_size, (size_t)WS_NEED); return; }
    Params p{};
    for (int i = 0; i < N_IN; ++i) p.in[i] = (const float*)d_in[i];
    p.out = (float*)d_out;
    p.ws = (unsigned char*)d_ws;
    static int grid_blocks = 0;
    if (!grid_blocks) {
        int dev = 0, cus = 0, per_cu = 0;
        hipGetDevice(&dev);
        hipDeviceGetAttribute(&cus, hipDeviceAttributeMultiprocessorCount, dev);
        hipOccupancyMaxActiveBlocksPerMultiprocessor(&per_cu, k_main, 256, DYN_LDS);
        if (per_cu > 2) per_cu = 2;
        if (per_cu < 1) per_cu = 1;
        grid_blocks = cus * per_cu;
    }
    hipMemsetAsync(p.ws + OFF_BAR, 0, 16384, stream);
#if ONE_LAUNCH
    int lo = 0, hi = NPHASE;
    void* args[] = {&p, &lo, &hi};
    hipError_t e = hipLaunchCooperativeKernel((void*)k_main, dim3(grid_blocks), dim3(256), args, DYN_LDS, stream);
    if (e != hipSuccess) fprintf(stderr, "cooperative launch failed: %s (grid %d)\n", hipGetErrorString(e), grid_blocks);
#else
    for (int ph = 0; ph < NPHASE; ++ph) hipLaunchKernelGGL(k_main, dim3(grid_blocks), dim3(256), DYN_LDS, stream, p, ph, ph + 1);
#endif
}
```

```cpp
#include <hip/hip_runtime.h>
#include <hip/hip_cooperative_groups.h>
#include <stdint.h>
#include <stdio.h>
namespace cg = cooperative_groups;

#define DEVI __device__ __forceinline__
#define LAS __attribute__((address_space(3)))
typedef unsigned short bf16_t;
typedef __attribute__((ext_vector_type(8))) short bf16x8;
typedef __attribute__((ext_vector_type(4))) float f32x4;
typedef __attribute__((ext_vector_type(16))) float f32x16;
typedef __attribute__((ext_vector_type(4))) short bf16x4;

#ifndef NAIVE_GEMM
#define NAIVE_GEMM 0
#endif
#ifndef ONE_LAUNCH
#define ONE_LAUNCH 1
#endif

constexpr int DM = 1024, NBT = 8, SEQL = 2048, CTXL = 256, TPB = 2304, TT = 18432;
constexpr int DINP = 3840;
constexpr float LOG2E = 1.4426950408889634f;
constexpr float EPSV = 1e-6f;
constexpr int NSLOT = 2 * TT + 64 * 128;

enum { I_X = 0, I_C, I_CTX, I_CCTX, I_ADAW, I_ADAB, I_N1G, I_N2G, I_WIN, I_MQN, I_MKVN, I_WUQ, I_WUKV, I_RDEC, I_RNORM,
       I_LCW, I_LCB, I_LWA, I_LBA, I_LWX, I_LBX, I_LLAM, I_GQN, I_GKN, I_WBR, I_WMG, I_BMG, I_WOUT, I_RW, I_RB,
       I_W1, I_W3, I_W2, I_FN, N_IN };

constexpr size_t AL(size_t x) { return (x + 255) & ~(size_t)255; }
constexpr size_t OFF_BAR = 0;
constexpr size_t OFF_CNT = 16384;
constexpr size_t OFF_MOD = OFF_CNT + 16384;
constexpr size_t OFF_R64 = AL(OFF_MOD + (size_t)2 * 9 * 6144 * 4);
constexpr size_t OFF_R32 = OFF_R64 + (size_t)2048 * 64 * 4;
constexpr size_t OFF_REC = OFF_R32 + (size_t)2048 * 32 * 4;
constexpr size_t OFF_LIST = OFF_REC + (size_t)TT * 32;
constexpr size_t OFF_PRIV = AL(OFF_LIST + (size_t)64 * TT * 4);
constexpr size_t OFF_W = OFF_PRIV + (size_t)2048 * 1024;
constexpr size_t W_IN = 0;
constexpr size_t W_UQ = W_IN + (size_t)2 * 3840 * 1024;
constexpr size_t W_UKV = W_UQ + (size_t)2 * 768 * 256;
constexpr size_t W_BR = W_UKV + (size_t)2 * 1024 * 128;
constexpr size_t W_MG = W_BR + (size_t)2 * 4 * 1024 * 512;
constexpr size_t W_OUT = W_MG + (size_t)2 * 4096 * 1024;
constexpr size_t W_LRU = W_OUT + (size_t)2 * 1024 * 1024;
constexpr size_t W_RT = W_LRU + (size_t)2 * 2 * 8 * 2 * 64 * 64;
constexpr size_t W_END = W_RT + (size_t)64 * 1024;
constexpr size_t OFF_XCUR = AL(OFF_W + W_END * 2);
constexpr size_t OFF_H = OFF_XCUR + (size_t)TT * 1024 * 4;
constexpr size_t OFF_C = OFF_H + (size_t)TT * 1024 * 2;
constexpr size_t C_CQ = 0;
constexpr size_t C_CKV = C_CQ + (size_t)TT * 256;
constexpr size_t C_KR = C_CKV + (size_t)TT * 128;
constexpr size_t C_MQ = C_KR + (size_t)TT * 32;
constexpr size_t C_KN = C_MQ + (size_t)TT * 768;
constexpr size_t C_VMT = C_KN + (size_t)TT * 512;
constexpr size_t C_RQ = C_VMT + (size_t)TT * 512;
constexpr size_t C_RK = C_RQ + (size_t)TT * 256;
constexpr size_t C_RKT = C_RK + (size_t)TT * 256;
constexpr size_t C_RVT = C_RKT + (size_t)TT * 256;
constexpr size_t C_RG = C_RVT + (size_t)TT * 512;
constexpr size_t C_LX = C_RG + (size_t)TT * 512;
constexpr size_t C_LG = C_LX + (size_t)TT * 512;
constexpr size_t C_GQ = C_LG + (size_t)TT * 512;
constexpr size_t C_GK = C_GQ + (size_t)TT * 512;
constexpr size_t C_GVT = C_GK + (size_t)TT * 128;
constexpr size_t C_END = C_GVT + (size_t)TT * 128;
constexpr size_t C_M = 0;
constexpr size_t C_W13 = (size_t)24 * 1024 * 1024;
constexpr size_t C_W2 = C_W13 + (size_t)64 * 512 * 1024;
static_assert(C_W2 + (size_t)64 * 1024 * 256 <= C_END, "moe alias");
static_assert((size_t)TT * 1024 <= C_W13, "m alias");
constexpr size_t OFF_D = OFF_C + C_END * 2;
constexpr size_t D_YA = 0;
constexpr size_t D_YD = (size_t)TT * 512;
constexpr size_t D_OF = (size_t)2 * TT * 512;
constexpr size_t D_OB = (size_t)3 * TT * 512;
constexpr size_t D_LH0 = (size_t)4 * TT * 512;
constexpr size_t D_LH1 = (size_t)5 * TT * 512;
constexpr size_t D_ACT = 0;
constexpr size_t D_YS = (size_t)12 * 1024 * 1024;
constexpr size_t D_END = D_YS + (size_t)NSLOT * 1024;
static_assert((size_t)NSLOT * 256 <= D_YS, "act alias");
static_assert((size_t)6 * TT * 512 <= D_END, "d size");
constexpr size_t OFF_MOEW = AL(OFF_D + D_END * 2);
constexpr size_t MW_13 = 0, MW_2 = (size_t)64 * 512 * 1024, MW_END = MW_2 + (size_t)64 * 1024 * 256;
constexpr size_t WS_NEED = OFF_MOEW + MW_END * 2;

struct Params {
    const float* in[N_IN];
    float* out;
    unsigned char* ws;
};

#define WSF(off) ((float*)(p.ws + (off)))
#define WSI(off) ((int*)(p.ws + (off)))
#define WB(el) ((bf16_t*)(p.ws + OFF_W) + (el))
#define CB(el) ((bf16_t*)(p.ws + OFF_C) + (el))
#define DB(el) ((bf16_t*)(p.ws + OFF_D) + (el))
#define MWB(el) ((bf16_t*)(p.ws + OFF_MOEW) + (el))
#define HB ((bf16_t*)(p.ws + OFF_H))
#define XCUR ((float*)(p.ws + OFF_XCUR))

constexpr int SMEM_BYTES = 65536;
constexpr int DYN_LDS = 0;
constexpr int CT_LD = 136;
constexpr int AUX_OFF = 36864;

#ifdef TPROBE
#define T_SLOT(id) ((unsigned long long*)(p.ws + OFF_BAR + 14400) + (id))
#define T_BEGIN(id) const unsigned long long _tb##id = __builtin_amdgcn_s_memrealtime()
#define T_END(id, cond) do { if ((cond) && __builtin_amdgcn_workitem_id_x() == 0) atomicAdd(T_SLOT(id), __builtin_amdgcn_s_memrealtime() - _tb##id); } while (0)
#else
#define T_BEGIN(id)
#define T_END(id, cond)
#endif
DEVI int launder_tid() { int t = __builtin_amdgcn_workitem_id_x(); asm volatile("" : "+v"(t)); return t; }
DEVI int launder_bid() { int t = __builtin_amdgcn_workgroup_id_x(); asm volatile("" : "+s"(t)); return t; }
#define TIDX launder_tid()
#define BIDX launder_bid()
DEVI float bf2f(bf16_t v) { return __uint_as_float(((unsigned)v) << 16); }
DEVI bf16_t f2bf(float f) {
    __bf16 h = (__bf16)f;
    return __builtin_bit_cast(unsigned short, h);
}
typedef __attribute__((ext_vector_type(8))) int i32x8;
typedef __attribute__((ext_vector_type(4))) int i32x4;
DEVI float clamp8(float x) { return __builtin_amdgcn_fmed3f(x, -448.f, 448.f); }
DEVI int pk4_fp8(float a, float b, float c, float d) {
    int r = __builtin_amdgcn_cvt_pk_fp8_f32(clamp8(a), clamp8(b), 0, false);
    return __builtin_amdgcn_cvt_pk_fp8_f32(clamp8(c), clamp8(d), r, true);
}
DEVI float fsig(float x) { return __builtin_amdgcn_rcpf(1.f + __expf(-x)); }
DEVI float sigmoidf_(float x) { return 1.f / (1.f + __expf(-x)); }
DEVI float siluf_(float x) { return x / (1.f + __expf(-x)); }
DEVI float gelu_tanh(float x) {
    float u = 0.7978845608028654f * (x + 0.044715f * x * x * x);
    return 0.5f * x * (1.f + tanhf(u));
}
DEVI float wave_sum(float v) {
#pragma unroll
    for (int o = 32; o > 0; o >>= 1) v += __shfl_xor(v, o);
    return v;
}
DEVI int mt_of(int q, bool latonly) { return latonly ? (q >> 4) * 18 + 2 + (q & 15) : q; }

struct CvtJob { const float* src; bf16_t* dst; const float* ks; int K, N, ldd, batch; size_t sbs, dbs; int mode; int lds, n0, wide; };
DEVI int cvt_rowmap(int mode, int n) {
    if (mode == 1) return n < 384 ? n : (n < 416 ? n - 384 + 3712 : n - 32);
    if (mode == 2) { int h = n / 96, j = n % 96; return j < 64 ? h * 64 + j : 512 + h * 32 + (j - 64); }
    if (mode == 3) return (n >> 6) * 128 + (n & 63);
    return n;
}
DEVI void cvt_tile(const CvtJob& j, int tile, float* lds) {
    const int tn = j.N / 32, tk = j.K / 64, per = tn * tk;
    const int bb = tile / per, r = tile % per, kt = r / tn, nt = r % tn;
    const float* s = j.src + (size_t)bb * j.sbs + (size_t)(kt * 64) * j.lds + j.n0 + nt * 32;
    const int tx = TIDX & 31, ty = TIDX >> 5;
#pragma unroll
    for (int i = 0; i < 8; ++i) {
        int k = ty + 8 * i;
        float v = s[(size_t)k * j.lds + tx];
        if (j.ks) v *= j.ks[kt * 64 + k];
        lds[k * 33 + tx] = v;
    }
    __syncthreads();
    bf16_t* d = j.dst + (size_t)bb * j.dbs;
#pragma unroll
    for (int i = 0; i < 4; ++i) {
        int n = ty + 8 * i, kk = tx * 2;
        unsigned lo = f2bf(lds[kk * 33 + n]), hi = f2bf(lds[(kk + 1) * 33 + n]);
        int row = cvt_rowmap(j.mode, j.n0 + nt * 32 + n);
        *(unsigned*)(d + (size_t)row * j.ldd + kt * 64 + kk) = lo | (hi << 16);
    }
    __syncthreads();
}

DEVI void cvt_tile256(const CvtJob& j, int tile, unsigned char* smem) {
    constexpr int NS = 68;
    bf16_t* T = (bf16_t*)smem;
    const int tn = j.N / 256, tk = j.K / 64, per = tn * tk;
    const int bb = tile / per, r = tile % per, kt = r / tn, nt = r % tn;
    const float* s = j.src + (size_t)bb * j.sbs + (size_t)(kt * 64) * j.lds + j.n0 + nt * 256;
    const int tid = TIDX, lane = tid & 63, w = tid >> 6;
    float4 v[16];
#pragma unroll
    for (int i = 0; i < 16; ++i) v[i] = *(const float4*)(s + (size_t)(w * 16 + i) * j.lds + lane * 4);
    if (j.ks) {
#pragma unroll
        for (int i = 0; i < 16; ++i) { const float sc = j.ks[kt * 64 + w * 16 + i]; v[i].x *= sc; v[i].y *= sc; v[i].z *= sc; v[i].w *= sc; }
    }
    __syncthreads();
#pragma unroll
    for (int h = 0; h < 2; ++h) {
        bf16x4 q0a, q0b, q1a, q1b, q2a, q2b, q3a, q3b;
#pragma unroll
        for (int e = 0; e < 4; ++e) {
            q0a[e] = (short)f2bf(v[h * 8 + e].x); q0b[e] = (short)f2bf(v[h * 8 + 4 + e].x);
            q1a[e] = (short)f2bf(v[h * 8 + e].y); q1b[e] = (short)f2bf(v[h * 8 + 4 + e].y);
            q2a[e] = (short)f2bf(v[h * 8 + e].z); q2b[e] = (short)f2bf(v[h * 8 + 4 + e].z);
            q3a[e] = (short)f2bf(v[h * 8 + e].w); q3b[e] = (short)f2bf(v[h * 8 + 4 + e].w);
        }
        bf16_t* tp = T + (lane * 4) * NS + w * 16 + h * 8;
        *(bf16x4*)(tp) = q0a; *(bf16x4*)(tp + 4) = q0b;
        *(bf16x4*)(tp + NS) = q1a; *(bf16x4*)(tp + NS + 4) = q1b;
        *(bf16x4*)(tp + 2 * NS) = q2a; *(bf16x4*)(tp + 2 * NS + 4) = q2b;
        *(bf16x4*)(tp + 3 * NS) = q3a; *(bf16x4*)(tp + 3 * NS + 4) = q3b;
    }
    __syncthreads();
    bf16_t* d = j.dst + (size_t)bb * j.dbs;
#pragma unroll
    for (int i = 0; i < 8; ++i) {
        const int c = tid + 256 * i, n = c >> 3, kc = c & 7;
        const bf16x4 lo = *(const bf16x4*)(T + n * NS + kc * 8), hi = *(const bf16x4*)(T + n * NS + kc * 8 + 4);
        const int row = cvt_rowmap(j.mode, j.n0 + nt * 256 + n);
        *(bf16x8*)(d + (size_t)row * j.ldd + kt * 64 + kc * 8) = bf16x8{lo[0], lo[1], lo[2], lo[3], hi[0], hi[1], hi[2], hi[3]};
    }
}
constexpr float W8_SCALE = 32.f;
DEVI void cvt_tile256_fp8(const CvtJob& j, int tile, unsigned char* smem) {
    constexpr int RS = 80;
    const int tn = j.N / 256, tk = j.K / 64, per = tn * tk;
    const int bb = tile / per, r = tile % per, kt = r / tn, nt = r % tn;
    const float* s = j.src + (size_t)bb * j.sbs + (size_t)(kt * 64) * j.lds + nt * 256;
    const int tid = TIDX, lane = tid & 63, w = tid >> 6;
    float4 v[16];
#pragma unroll
    for (int i = 0; i < 16; ++i) v[i] = *(const float4*)(s + (size_t)(w * 16 + i) * j.lds + lane * 4);
    __syncthreads();
    i32x4 q0, q1, q2, q3;
#pragma unroll
    for (int c = 0; c < 4; ++c) {
        q0[c] = pk4_fp8(v[4 * c].x * W8_SCALE, v[4 * c + 1].x * W8_SCALE, v[4 * c + 2].x * W8_SCALE, v[4 * c + 3].x * W8_SCALE);
        q1[c] = pk4_fp8(v[4 * c].y * W8_SCALE, v[4 * c + 1].y * W8_SCALE, v[4 * c + 2].y * W8_SCALE, v[4 * c + 3].y * W8_SCALE);
        q2[c] = pk4_fp8(v[4 * c].z * W8_SCALE, v[4 * c + 1].z * W8_SCALE, v[4 * c + 2].z * W8_SCALE, v[4 * c + 3].z * W8_SCALE);
        q3[c] = pk4_fp8(v[4 * c].w * W8_SCALE, v[4 * c + 1].w * W8_SCALE, v[4 * c + 2].w * W8_SCALE, v[4 * c + 3].w * W8_SCALE);
    }
    unsigned char* tp = smem + (lane * 4) * RS + w * 16;
    *(i32x4*)(tp) = q0; *(i32x4*)(tp + RS) = q1; *(i32x4*)(tp + 2 * RS) = q2; *(i32x4*)(tp + 3 * RS) = q3;
    __syncthreads();
    unsigned char* d = (unsigned char*)j.dst + (size_t)bb * j.dbs;
#pragma unroll
    for (int i = 0; i < 4; ++i) {
        const int c = tid + 256 * i, n = c >> 2, kc = c & 3;
        *(i32x4*)(d + (size_t)cvt_rowmap(j.mode, nt * 256 + n) * j.ldd + kt * 64 + kc * 16) = *(const i32x4*)(smem + n * RS + kc * 16);
    }
}
__constant__ const int CVT_TILES[10] = {224, 80, 12, 8, 128, 256, 64, 32, 32, 32};
constexpr int CVT_PER_LAYER = 224 + 80 + 12 + 8 + 128 + 256 + 64 + 32 + 32 + 32;
DEVI CvtJob get_job(const Params& p, int l, int k) {
    CvtJob j; j.ks = nullptr; j.batch = 1; j.sbs = 0; j.dbs = 0; j.mode = 0; j.n0 = 0; j.wide = 1;
    switch (k) {
    case 0: j.src = p.in[I_WIN] + (size_t)l * 1024 * 3744; j.dst = WB(W_IN + (size_t)l * 3840 * 1024); j.K = 1024; j.N = 3584; j.lds = 3744; j.ldd = 1024; j.mode = 1; break;
    case 1: j.src = p.in[I_WIN] + (size_t)l * 1024 * 3744; j.dst = WB(W_IN + (size_t)l * 3840 * 1024); j.K = 1024; j.N = 160; j.lds = 3744; j.n0 = 3584; j.ldd = 1024; j.mode = 1; j.wide = 0; break;
    case 2: j.src = p.in[I_WUQ] + (size_t)l * 256 * 768; j.dst = WB(W_UQ + (size_t)l * 768 * 256); j.K = 256; j.N = 768; j.lds = 768; j.ldd = 256; j.ks = p.in[I_MQN] + l * 256; j.mode = 2; break;
    case 3: j.src = p.in[I_WUKV] + (size_t)l * 128 * 1024; j.dst = WB(W_UKV + (size_t)l * 1024 * 128); j.K = 128; j.N = 1024; j.lds = 1024; j.ldd = 128; j.ks = p.in[I_MKVN] + l * 128; break;
    case 4: j.src = p.in[I_WBR] + (size_t)l * 4 * 512 * 1024; j.dst = WB(W_BR + (size_t)l * 4 * 1024 * 512); j.K = 512; j.N = 1024; j.lds = 1024; j.ldd = 512; j.batch = 4; j.sbs = 512 * 1024; j.dbs = 1024 * 512; break;
    case 5: j.src = p.in[I_WMG] + (size_t)l * 1024 * 4096; j.dst = WB(W_MG + (size_t)l * 4096 * 1024); j.K = 1024; j.N = 4096; j.lds = 4096; j.ldd = 1024; break;
    case 6: j.src = p.in[I_WOUT] + (size_t)l * 1024 * 1024; j.dst = WB(W_OUT + (size_t)l * 1024 * 1024); j.K = 1024; j.N = 1024; j.lds = 1024; j.ldd = 1024; break;
    case 7: j.src = p.in[I_LWA] + (size_t)l * 16 * 4096; j.dst = WB(W_LRU + (size_t)l * 16 * 8192); j.K = 64; j.N = 64; j.lds = 64; j.ldd = 64; j.batch = 16; j.sbs = 4096; j.dbs = 8192; j.wide = 0; break;
    case 8: j.src = p.in[I_LWX] + (size_t)l * 16 * 4096; j.dst = WB(W_LRU + (size_t)l * 16 * 8192 + 4096); j.K = 64; j.N = 64; j.lds = 64; j.ldd = 64; j.batch = 16; j.sbs = 4096; j.dbs = 8192; j.wide = 0; break;
    default: j.src = p.in[I_RW]; j.dst = WB(W_RT); j.K = 1024; j.N = 64; j.lds = 64; j.ldd = 1024; j.wide = 0; break;
    }
    return j;
}
DEVI CvtJob get_moe_job(const Params& p, int l, int k) {
    CvtJob j; j.ks = nullptr; j.batch = 64; j.sbs = 262144; j.n0 = 0; j.wide = 1;
    if (k == 0) { j.src = p.in[I_W1] + (size_t)l * 64 * 262144; j.dst = MWB(MW_13);     j.K = 1024; j.N = 256; j.lds = 256; j.ldd = 1024; j.dbs = 512 * 1024; j.mode = 3; }
    else if (k == 1) { j.src = p.in[I_W3] + (size_t)l * 64 * 262144; j.dst = (bf16_t*)((unsigned char*)MWB(MW_13) + 64 * 1024); j.K = 1024; j.N = 256; j.lds = 256; j.ldd = 1024; j.dbs = 512 * 1024; j.mode = 3; }
    else { j.src = p.in[I_W2] + (size_t)l * 64 * 262144; j.dst = MWB(MW_2); j.K = 256; j.N = 1024; j.lds = 1024; j.ldd = 256; j.dbs = 262144; j.mode = 0; }
    return j;
}

struct AOp { const bf16_t* base; int ld; int row0; const int* ridx; };
DEVI const bf16_t* arow(const AOp& a, int i) {
    int r = a.ridx ? a.ridx[i] : a.row0 + i;
    return a.base + (size_t)r * a.ld;
}

#if NAIVE_GEMM
template <int BN>
DEVI void gemm_core(f32x4 (&acc)[4][BN / 32], const AOp& A, const bf16_t* B, int ldb, int K, unsigned char* smem) {
    constexpr int NI = BN / 32;
    const int tid = TIDX, lane = tid & 63, wid = tid >> 6, wr = wid >> 1, wc = wid & 1;
    for (int k0 = 0; k0 < K; k0 += 8) {
        bf16x8 bv[NI];
#pragma unroll
        for (int ni = 0; ni < NI; ++ni) bv[ni] = *(const bf16x8*)(B + (size_t)(wc * (BN / 2) + ni * 16 + (lane & 15)) * ldb + k0);
#pragma unroll
        for (int mi = 0; mi < 4; ++mi)
#pragma unroll
            for (int j = 0; j < 4; ++j) {
                bf16x8 av = *(const bf16x8*)(arow(A, wr * 64 + mi * 16 + (lane >> 4) * 4 + j) + k0);
#pragma unroll
                for (int ni = 0; ni < NI; ++ni) {
                    float s = 0.f;
#pragma unroll
                    for (int e = 0; e < 8; ++e) s += bf2f((bf16_t)av[e]) * bf2f((bf16_t)bv[ni][e]);
                    acc[mi][ni][j] += s;
                }
            }
    }
}
#else
#define GAS __attribute__((address_space(1)))
template <int BN, bool GATHER = false>
DEVI void gemm_core(f32x4 (&acc)[4][BN / 32], const AOp& A, const bf16_t* B, int ldb, int K, unsigned char* smem) {
    constexpr int NI = BN / 32;
    constexpr int NBL = BN / 32;
    constexpr int STG = 32768;
    const int tid = TIDX, lane = tid & 63, wid = tid >> 6, wr = wid >> 1, wc = wid & 1;
    const int lr = tid >> 3;
    const int kc = (tid & 7) ^ (lr & 7);
    const bf16_t* ap[GATHER ? 4 : 1];
    if (GATHER) {
#pragma unroll
        for (int i = 0; i < (GATHER ? 4 : 1); ++i) ap[i] = arow(A, lr + 32 * i) + kc * 8;
    } else ap[0] = A.base + (size_t)(A.row0 + lr) * A.ld + kc * 8;
    const size_t astep = (size_t)32 * A.ld;
    const bf16_t* bp = B + (size_t)lr * ldb + kc * 8;
    const size_t bstep = (size_t)32 * ldb;
    LAS unsigned char* lA = (LAS unsigned char*)smem + tid * 16;
    LAS unsigned char* lB = lA + 16384;
    const int nk = K >> 6;
    const int arow_off = (wr * 64 + (lane & 15)) * 128;
    const int brow_off = 16384 + (wc * (BN / 2) + (lane & 15)) * 128;
    __syncthreads();
#pragma unroll
    for (int i = 0; i < 4; ++i) __builtin_amdgcn_global_load_lds((const GAS unsigned*)(GATHER ? ap[GATHER ? i : 0] : ap[0] + i * astep), (LAS unsigned*)(lA + i * 4096), 16, 0, 0);
#pragma unroll
    for (int i = 0; i < NBL; ++i) __builtin_amdgcn_global_load_lds((const GAS unsigned*)(bp + i * bstep), (LAS unsigned*)(lB + i * 4096), 16, 0, 0);
    for (int kt = 0; kt < nk; ++kt) {
        __syncthreads();
        if (kt + 1 < nk) {
            const int ko = (kt + 1) * 64;
            const int so = ((kt + 1) & 1) * STG;
#pragma unroll
            for (int i = 0; i < 4; ++i) __builtin_amdgcn_global_load_lds((const GAS unsigned*)((GATHER ? ap[GATHER ? i : 0] : ap[0] + i * astep) + ko), (LAS unsigned*)(lA + so + i * 4096), 16, 0, 0);
#pragma unroll
            for (int i = 0; i < NBL; ++i) __builtin_amdgcn_global_load_lds((const GAS unsigned*)(bp + i * bstep + ko), (LAS unsigned*)(lB + so + i * 4096), 16, 0, 0);
        }
        const unsigned char* cs = smem + (kt & 1) * STG;
#pragma unroll
        for (int ks = 0; ks < 2; ++ks) {
            const int pch = ((ks * 4 + (lane >> 4)) ^ (lane & 7)) << 4;
            bf16x8 bfr[NI];
#pragma unroll
            for (int ni = 0; ni < NI; ++ni) bfr[ni] = *(const bf16x8*)(cs + brow_off + ni * 2048 + pch);
#pragma unroll
            for (int mi = 0; mi < 4; mi += 2) {
                const bf16x8 a0 = *(const bf16x8*)(cs + arow_off + mi * 2048 + pch);
                const bf16x8 a1 = *(const bf16x8*)(cs + arow_off + (mi + 1) * 2048 + pch);
#pragma unroll
                for (int ni = 0; ni < NI; ++ni) acc[mi][ni] = __builtin_amdgcn_mfma_f32_16x16x32_bf16(a0, bfr[ni], acc[mi][ni], 0, 0, 0);
#pragma unroll
                for (int ni = 0; ni < NI; ++ni) acc[mi + 1][ni] = __builtin_amdgcn_mfma_f32_16x16x32_bf16(a1, bfr[ni], acc[mi + 1][ni], 0, 0, 0);
            }
        }
    }
}
#endif

template <bool GATHER = false, int BN = 128>
DEVI void gemm_core_fp8(f32x4 (&acc)[4][BN / 32], const unsigned char* Ab, size_t lda, int row0, const unsigned char* Bb, size_t ldb, int K, unsigned char* smem, const int* ridx = nullptr) {
    constexpr int STG = 32768;
    constexpr int NI = BN / 32;
    const int tid = TIDX, lane = tid & 63, wid = tid >> 6, wr = wid >> 1, wc = wid & 1;
    const int lr = tid >> 3;
    const int kc = (tid & 7) ^ (lr & 7);
    const unsigned char* ap[GATHER ? 4 : 1];
    if (GATHER) {
#pragma unroll
        for (int i = 0; i < (GATHER ? 4 : 1); ++i) ap[i] = Ab + (size_t)ridx[lr + 32 * i] * lda + kc * 16;
    } else ap[0] = Ab + (size_t)(row0 + lr) * lda + kc * 16;
    const size_t astep = GATHER ? 0 : 32 * lda;
    const unsigned char* bp = Bb + (size_t)lr * ldb + kc * 16;
    const size_t bstep = 32 * ldb;
    LAS unsigned char* lA = (LAS unsigned char*)smem + tid * 16;
    LAS unsigned char* lB = lA + 16384;
    const int nk = K >> 7;
    const int arow_off = (wr * 64 + (lane & 15)) * 128;
    const int brow_off = 16384 + (wc * (BN / 2) + (lane & 15)) * 128;
    const int c0 = ((2 * (lane >> 4)) ^ (lane & 7)) << 4, c1 = ((2 * (lane >> 4) + 1) ^ (lane & 7)) << 4;
    __syncthreads();
#pragma unroll
    for (int i = 0; i < 4; ++i) __builtin_amdgcn_global_load_lds((const GAS unsigned*)(ap[GATHER ? i : 0] + i * astep), (LAS unsigned*)(lA + i * 4096), 16, 0, 0);
#pragma unroll
    for (int i = 0; i < NI; ++i) __builtin_amdgcn_global_load_lds((const GAS unsigned*)(bp + i * bstep), (LAS unsigned*)(lB + i * 4096), 16, 0, 0);
#pragma unroll 1
    for (int kt = 0; kt < nk; ++kt) {
        __syncthreads();
        if (kt + 1 < nk) {
            const int ko = (kt + 1) * 128;
            const int so = ((kt + 1) & 1) * STG;
#pragma unroll
            for (int i = 0; i < 4; ++i) __builtin_amdgcn_global_load_lds((const GAS unsigned*)(ap[GATHER ? i : 0] + i * astep + ko), (LAS unsigned*)(lA + so + i * 4096), 16, 0, 0);
#pragma unroll
            for (int i = 0; i < NI; ++i) __builtin_amdgcn_global_load_lds((const GAS unsigned*)(bp + i * bstep + ko), (LAS unsigned*)(lB + so + i * 4096), 16, 0, 0);
        }
        const unsigned char* cs = smem + (kt & 1) * STG;
        i32x8 bfr[NI];
#pragma unroll
        for (int ni = 0; ni < NI; ++ni) {
            const i32x4 lo = *(const i32x4*)(cs + brow_off + ni * 2048 + c0), hi = *(const i32x4*)(cs + brow_off + ni * 2048 + c1);
            bfr[ni] = i32x8{lo[0], lo[1], lo[2], lo[3], hi[0], hi[1], hi[2], hi[3]};
        }
#pragma unroll
        for (int mi = 0; mi < 4; ++mi) {
            const i32x4 lo = *(const i32x4*)(cs + arow_off + mi * 2048 + c0), hi = *(const i32x4*)(cs + arow_off + mi * 2048 + c1);
            const i32x8 af = i32x8{lo[0], lo[1], lo[2], lo[3], hi[0], hi[1], hi[2], hi[3]};
#pragma unroll
            for (int ni = 0; ni < NI; ++ni)
                acc[mi][ni] = __builtin_amdgcn_mfma_scale_f32_16x16x128_f8f6f4(af, bfr[ni], acc[mi][ni], 0, 0, 0, 0x7f7f7f7f, 0, 0x7a7a7a7a);
        }
    }
}

template <int BN>
DEVI void acc_zero(f32x4 (&acc)[4][BN / 32]) {
#pragma unroll
    for (int mi = 0; mi < 4; ++mi)
#pragma unroll
        for (int ni = 0; ni < BN / 32; ++ni) acc[mi][ni] = f32x4{0.f, 0.f, 0.f, 0.f};
}
template <int BN>
DEVI void acc_to_ct(const f32x4 (&acc)[4][BN / 32], bf16_t* ct) {
    const int tid = TIDX, lane = tid & 63, wid = tid >> 6, wr = wid >> 1, wc = wid & 1;
#pragma unroll
    for (int mi = 0; mi < 4; ++mi)
#pragma unroll
        for (int ni = 0; ni < BN / 32; ++ni)
#pragma unroll
            for (int j = 0; j < 4; ++j)
                ct[(wr * 64 + mi * 16 + (lane >> 4) * 4 + j) * CT_LD + wc * (BN / 2) + ni * 16 + (lane & 15)] = f2bf(acc[mi][ni][j]);
}

DEVI void acc_to_ctT(const f32x4 (&acc)[4][4], bf16_t* ct) {
    const int tid = TIDX, lane = tid & 63, wid = tid >> 6, wr = wid >> 1, wc = wid & 1;
#pragma unroll
    for (int mi = 0; mi < 4; ++mi)
#pragma unroll
        for (int ni = 0; ni < 4; ++ni) {
            bf16x4 v;
#pragma unroll
            for (int j = 0; j < 4; ++j) v[j] = (short)f2bf(acc[mi][ni][j]);
            *(bf16x4*)(ct + (wc * 64 + ni * 16 + (lane & 15)) * CT_LD + wr * 64 + mi * 16 + (lane >> 4) * 4) = v;
        }
}
template <int NC>
DEVI void ep_store_rows(const bf16_t* ct, int c0, bf16_t* dst, int ldd, int row0) {
    constexpr int CPR = NC / 8;
    for (int c = TIDX; c < 128 * CPR; c += 256) {
        int i = c / CPR, jc = c % CPR;
        *(bf16x8*)(dst + (size_t)(row0 + i) * ldd + jc * 8) = *(const bf16x8*)(ct + i * CT_LD + c0 + jc * 8);
    }
}
DEVI void ep_store_T(const bf16_t* ct, int c0, int nc, bf16_t* dstT, int ldT, int t0) {
    for (int c = TIDX; c < nc * 16; c += 256) {
        int j = c >> 4, ic = c & 15;
        bf16x8 v;
#pragma unroll
        for (int e = 0; e < 8; ++e) v[e] = (short)ct[(ic * 8 + e) * CT_LD + c0 + j];
        *(bf16x8*)(dstT + (size_t)j * ldT + t0 + ic * 8) = v;
    }
}
DEVI void ep_rope64(bf16_t* ct, const float* gain, float scale, bool lat, int pos0, const float* cs64) {
    const int row = TIDX >> 1, half = TIDX & 1;
    bf16_t* pr = ct + row * CT_LD + half * 64;
    float v[64];
#pragma unroll
    for (int c = 0; c < 8; ++c) {
        bf16x8 t = *(const bf16x8*)(pr + c * 8);
#pragma unroll
        for (int e = 0; e < 8; ++e) v[c * 8 + e] = bf2f((bf16_t)t[e]);
    }
    if (gain) {
        float ss = 0.f;
#pragma unroll
        for (int d = 0; d < 64; ++d) ss += v[d] * v[d];
        float rstd = rsqrtf(ss * (1.f / 64.f) + EPSV);
#pragma unroll
        for (int c = 0; c < 16; ++c) {
            const float4 g4 = *(const float4*)(gain + c * 4);
            v[c * 4] *= rstd * g4.x; v[c * 4 + 1] *= rstd * g4.y; v[c * 4 + 2] *= rstd * g4.z; v[c * 4 + 3] *= rstd * g4.w;
        }
    }
    if (lat) {
        const float* cs = cs64 + (size_t)(pos0 + row) * 64;
        float cw[64];
#pragma unroll
        for (int c = 0; c < 16; ++c) { const float4 t4 = *(const float4*)(cs + c * 4); cw[c * 4] = t4.x; cw[c * 4 + 1] = t4.y; cw[c * 4 + 2] = t4.z; cw[c * 4 + 3] = t4.w; }
#pragma unroll
        for (int i = 0; i < 16; ++i) {
            float a = v[i], b = v[i + 16], c = cw[i], sn = cw[32 + i];
            v[i] = a * c - b * sn; v[i + 16] = b * c + a * sn;
            a = v[32 + i]; b = v[48 + i]; c = cw[16 + i]; sn = cw[48 + i];
            v[32 + i] = a * c - b * sn; v[48 + i] = b * c + a * sn;
        }
    }
#pragma unroll
    for (int c = 0; c < 8; ++c) {
        bf16x8 t;
#pragma unroll
        for (int e = 0; e < 8; ++e) t[e] = (short)f2bf(v[c * 8 + e] * scale);
        *(bf16x8*)(pr + c * 8) = t;
    }
}
DEVI void ep_rope32(bf16_t* ct, int ngroups, const float* rstd, float scale, bool lat, int pos0, const float* cs32) {
    const int row = TIDX >> 1, half = TIDX & 1;
    const float rs = (rstd ? rstd[row] : 1.f) * scale;
#pragma unroll
    for (int gg = 0; gg < 2; ++gg) {
        const int g = half * 2 + gg;
        if (g < ngroups) {
            bf16_t* pr = ct + row * CT_LD + g * 32;
            float v[32];
#pragma unroll
            for (int c = 0; c < 4; ++c) {
                bf16x8 t = *(const bf16x8*)(pr + c * 8);
#pragma unroll
                for (int e = 0; e < 8; ++e) v[c * 8 + e] = bf2f((bf16_t)t[e]);
            }
            if (lat) {
                const float* cs = cs32 + (size_t)(pos0 + row) * 32;
#pragma unroll
                for (int i = 0; i < 8; ++i) {
                    float a = v[i], b = v[i + 8], c = cs[i], s = cs[16 + i];
                    v[i] = a * c - b * s; v[i + 8] = b * c + a * s;
                    a = v[16 + i]; b = v[24 + i]; c = cs[8 + i]; s = cs[24 + i];
                    v[16 + i] = a * c - b * s; v[24 + i] = b * c + a * s;
                }
            }
#pragma unroll
            for (int c = 0; c < 4; ++c) {
                bf16x8 t;
#pragma unroll
                for (int e = 0; e < 8; ++e) t[e] = (short)f2bf(v[c * 8 + e] * rs);
                *(bf16x8*)(pr + c * 8) = t;
            }
        }
    }
}
DEVI void ep_scale_rows(bf16_t* ct, int c0, int nc, const float* rstd, float scale) {
    const int cpr = nc / 8;
    for (int c = TIDX; c < 128 * cpr; c += 256) {
        int i = c / cpr, jc = c % cpr;
        bf16_t* pr = ct + i * CT_LD + c0 + jc * 8;
        bf16x8 t = *(const bf16x8*)pr;
        float rs = rstd[i] * scale;
#pragma unroll
        for (int e = 0; e < 8; ++e) t[e] = (short)f2bf(bf2f((bf16_t)t[e]) * rs);
        *(bf16x8*)pr = t;
    }
}
DEVI void ep_rstd(const bf16_t* A, int ld, int row0, int K, float* rstd) {
    const int row = TIDX >> 1, half = TIDX & 1;
    const bf16_t* pr = A + (size_t)(row0 + row) * ld + half * (K / 2);
    float ss = 0.f;
    for (int c = 0; c < K / 16; ++c) {
        bf16x8 t = *(const bf16x8*)(pr + c * 8);
#pragma unroll
        for (int e = 0; e < 8; ++e) { float f = bf2f((bf16_t)t[e]); ss += f * f; }
    }
    ss += __shfl_xor(ss, 1);
    if (half == 0) rstd[row] = rsqrtf(ss / (float)K + EPSV);
}


struct GrpInfo { int xcd, j, per, ngrp; };
DEVI GrpInfo grp_info(const Params& p) {
    const unsigned* pv = (const unsigned*)(p.ws + OFF_PRIV + (size_t)BIDX * 1024 + 896);
    GrpInfo g;
    g.xcd = (int)__hip_atomic_load(pv + 2, __ATOMIC_RELAXED, __HIP_MEMORY_SCOPE_AGENT);
    g.j = (int)__hip_atomic_load(pv + 3, __ATOMIC_RELAXED, __HIP_MEMORY_SCOPE_AGENT);
    g.per = (int)__hip_atomic_load((const unsigned*)(p.ws + OFF_BAR) + 256 + 64 * g.xcd, __ATOMIC_RELAXED, __HIP_MEMORY_SCOPE_AGENT);
    g.ngrp = 8;
    if (g.xcd >= 8 || g.per <= 0) { g.xcd = 0; g.j = BIDX; g.per = gridDim.x; g.ngrp = 1; }
    return g;
}
DEVI bool super_tile(const GrpInfo& gi, int it, int NMT, int NNT, int SM, int SN, int& mt, int& nt) {
    const int ST = SM * SN, passes = (ST + gi.per - 1) / gi.per;
    const int nsn = (NNT + SN - 1) / SN, nsm = (NMT + SM - 1) / SM;
    const int s = (it / passes) * gi.ngrp + gi.xcd;
    if (s >= nsm * nsn) return false;
    const int idx = (it % passes) * gi.per + gi.j;
    mt = -1; nt = 0;
    if (idx < ST) {
        const int m = (s / nsn) * SM + idx / SN, n = (s % nsn) * SN + idx % SN;
        if (m < NMT && n < NNT) { mt = m; nt = n; }
    }
    return true;
}

DEVI void phase0(const Params& p, unsigned char* smem) {
    const int tid = TIDX, lane = tid & 63, w = tid >> 6;
    const int NG = 192, NCV = 2 * CVT_PER_LAYER, NR = 192;
    const int ntask = NG + NCV + NR + 1;
    for (int task = BIDX; task < ntask; task += gridDim.x) {
        if (task < NG) {
            const int l = task / 96, n0 = (task % 96) * 64;
            float* sv = (float*)smem;
            float* red = (float*)smem;
            for (int idx = lane; idx < 9 * 256; idx += 64) {
                int bi = idx >> 8, kk = idx & 255, k = 256 * w + kk;
                float c = bi < 8 ? p.in[I_C][bi * 1024 + k] : p.in[I_CCTX][k];
                sv[(w * 9 + bi) * 256 + kk] = siluf_(c);
            }
            __syncthreads();
            const int ksub = lane >> 4, c4 = (lane & 15) * 4;
            float acc[9][4];
#pragma unroll
            for (int bi = 0; bi < 9; ++bi) { acc[bi][0] = 0.f; acc[bi][1] = 0.f; acc[bi][2] = 0.f; acc[bi][3] = 0.f; }
            const float* wp = p.in[I_ADAW] + (size_t)l * 1024 * 6144 + (size_t)(256 * w + ksub) * 6144 + n0 + c4;
#pragma unroll 8
            for (int i = 0; i < 64; ++i) {
                const float4 wv = *(const float4*)(wp + (size_t)(4 * i) * 6144);
#pragma unroll
                for (int bi = 0; bi < 9; ++bi) {
                    const float sx = sv[(w * 9 + bi) * 256 + 4 * i + ksub];
                    acc[bi][0] += sx * wv.x; acc[bi][1] += sx * wv.y; acc[bi][2] += sx * wv.z; acc[bi][3] += sx * wv.w;
                }
            }
            __syncthreads();
#pragma unroll
            for (int bi = 0; bi < 9; ++bi)
                *(float4*)(red + (((w * 4 + ksub) * 9 + bi) * 64) + c4) = make_float4(acc[bi][0], acc[bi][1], acc[bi][2], acc[bi][3]);
            __syncthreads();
            for (int idx = tid; idx < 9 * 64; idx += 256) {
                int bi = idx >> 6, c = idx & 63;
                float sacc = p.in[I_ADAB][l * 6144 + n0 + c];
#pragma unroll
                for (int q = 0; q < 16; ++q) sacc += red[((q * 9 + bi) * 64) + c];
                WSF(OFF_MOD)[(size_t)(l * 9 + bi) * 6144 + n0 + c] = sacc;
            }
            __syncthreads();
        } else if (task < NG + NCV) {
            int t = task - NG;
            int l = t / CVT_PER_LAYER; t %= CVT_PER_LAYER;
            int k = 0;
            while (t >= CVT_TILES[k]) { t -= CVT_TILES[k]; ++k; }
            CvtJob j = get_job(p, l, k);
            if (k == 5) cvt_tile256_fp8(j, t, smem); else if (j.wide) cvt_tile256(j, t, smem); else cvt_tile(j, t, (float*)smem);
        } else if (task < NG + NCV + NR) {
            const int idx = (task - NG - NCV) * 256 + tid;
            const int pos = idx / 24, f = idx % 24;
            const float rp = (float)(pos >> 6), cp = (float)(pos & 63);
            if (f < 16) {
                const float inv = powf(10000.f, -(float)(2 * f) / 32.f);
                const float ar = rp * inv, ac = cp * inv;
                float* t64 = WSF(OFF_R64) + (size_t)pos * 64;
                t64[f] = cosf(ar); t64[16 + f] = cosf(ac); t64[32 + f] = sinf(ar); t64[48 + f] = sinf(ac);
            } else {
                const int i = f - 16;
                const float inv = powf(10000.f, -(float)(2 * i) / 16.f);
                const float ar = rp * inv, ac = cp * inv;
                float* t32 = WSF(OFF_R32) + (size_t)pos * 32;
                t32[i] = cosf(ar); t32[8 + i] = cosf(ac); t32[16 + i] = sinf(ar); t32[24 + i] = sinf(ac);
            }
        } else {
            for (int i = tid; i < 4096; i += 256) WSI(OFF_CNT)[i] = 0;
            for (int l = 0; l < 2; ++l) {
                unsigned* z = (unsigned*)WB(W_IN + (size_t)l * 3840 * 1024 + (size_t)3744 * 1024);
                for (int i = tid; i < 96 * 1024 / 2; i += 256) z[i] = 0u;
            }
        }
    }
}

struct MoeTab {
    int* base;
    DEVI int cnt(int e) const { return __hip_atomic_load(base + e, __ATOMIC_RELAXED, __HIP_MEMORY_SCOPE_AGENT); }
    DEVI int tp(int e) const { return __hip_atomic_load(base + 64 + e, __ATOMIC_RELAXED, __HIP_MEMORY_SCOPE_AGENT); }
    DEVI int seg(int e) const { return __hip_atomic_load(base + 136 + e, __ATOMIC_RELAXED, __HIP_MEMORY_SCOPE_AGENT); }
};
DEVI MoeTab moe_tables(const Params& p, int l, unsigned char* smem) {
    MoeTab t; t.base = (int*)(p.ws + OFF_PRIV + (size_t)BIDX * 1024);
    __syncthreads();
    if (TIDX == 0) {
        int a = 0, sg = 0;
        for (int e = 0; e < 64; ++e) {
            const int c = WSI(OFF_CNT)[l * 64 + e];
            __hip_atomic_store(t.base + e, c, __ATOMIC_RELAXED, __HIP_MEMORY_SCOPE_AGENT);
            __hip_atomic_store(t.base + 64 + e, a, __ATOMIC_RELAXED, __HIP_MEMORY_SCOPE_AGENT);
            __hip_atomic_store(t.base + 136 + e, sg, __ATOMIC_RELAXED, __HIP_MEMORY_SCOPE_AGENT);
            const int nt = (c + 127) >> 7;
            a += nt; sg += nt * 128;
        }
        __hip_atomic_store(t.base + 64 + 64, a, __ATOMIC_RELAXED, __HIP_MEMORY_SCOPE_AGENT);
        __hip_atomic_store(t.base + 136 + 64, sg, __ATOMIC_RELAXED, __HIP_MEMORY_SCOPE_AGENT);
    }
    asm volatile("s_waitcnt vmcnt(0)" ::: "memory");
    __syncthreads();
    return t;
}
struct Rec { int e0, p0, e1, p1; float w0, w1; int pad0, pad1; };

DEVI void phase_norm1(const Params& p, int l, int mode, unsigned char* smem) {
    const int lane = TIDX & 63, w = TIDX >> 6;
    MoeTab mt;
    const bool comb = (mode == 0 && l > 0) || mode == 1;
    const int lp = mode == 1 ? 1 : l - 1;
    int segv = 0;
    if (comb) { mt = moe_tables(p, lp, smem); segv = mt.seg(lane); }
    const float* g1 = mode == 1 ? p.in[I_FN] : (mode == 2 ? p.in[I_N2G] + l * 1024 : p.in[I_N1G] + l * 1024);
    const bool latonly = (mode == 1) || (mode == 2 && l == 1);
    const int nrows = latonly ? NBT * SEQL : TT;
    const int stride = gridDim.x * 4;
    int ri = BIDX * 4 + w;
    float4 xn[4];
    Rec rcn; rcn.e0 = 0; rcn.e1 = 0; rcn.p0 = 0; rcn.p1 = 0; rcn.w0 = 0.f; rcn.w1 = 0.f;
    auto rowof = [&](int r) { return latonly ? (r >> 11) * TPB + CTXL + (r & 2047) : r; };
    auto srcof = [&](int row) -> const float* {
        if (mode == 0 && l == 0) {
            const int b = row / TPB, t = row % TPB;
            return t < CTXL ? p.in[I_CTX] + ((size_t)b * CTXL + t) * DM : p.in[I_X] + ((size_t)b * SEQL + (t - CTXL)) * DM;
        }
        return XCUR + (size_t)row * DM;
    };
    Rec rcn2 = rcn;
    uint2 yn0[4], yn1[4];
#pragma unroll
    for (int i = 0; i < 4; ++i) { yn0[i] = make_uint2(0u, 0u); yn1[i] = make_uint2(0u, 0u); }
    auto yload = [&](const Rec& r) {
        const bf16_t* y0 = DB(D_YS) + (size_t)(__shfl(segv, r.e0) + r.p0) * 1024;
        const bf16_t* y1 = DB(D_YS) + (size_t)(__shfl(segv, r.e1) + r.p1) * 1024;
#pragma unroll
        for (int i = 0; i < 4; ++i) { yn0[i] = *(const uint2*)(y0 + i * 256 + lane * 4); yn1[i] = *(const uint2*)(y1 + i * 256 + lane * 4); }
    };
    if (ri < nrows) {
        const float* src = srcof(rowof(ri));
#pragma unroll
        for (int i = 0; i < 4; ++i) xn[i] = *(const float4*)(src + i * 256 + lane * 4);
        if (comb) {
            rcn = ((const Rec*)(p.ws + OFF_REC))[rowof(ri)];
            if (ri + stride < nrows) rcn2 = ((const Rec*)(p.ws + OFF_REC))[rowof(ri + stride)];
            yload(rcn);
        }
    }
    for (; ri < nrows; ri += stride) {
        const int row = rowof(ri);
        const int b = row / TPB, t = row % TPB;
        const bool isctx = t < CTXL;
        const int bi = isctx ? 8 : b;
        float v[16];
#pragma unroll
        for (int i = 0; i < 4; ++i) { v[i * 4] = xn[i].x; v[i * 4 + 1] = xn[i].y; v[i * 4 + 2] = xn[i].z; v[i * 4 + 3] = xn[i].w; }
        const Rec rc = rcn;
        uint2 ya[4], yb[4];
#pragma unroll
        for (int i = 0; i < 4; ++i) { ya[i] = yn0[i]; yb[i] = yn1[i]; }
        if (ri + stride < nrows) {
            if (comb) {
                rcn = rcn2;
                if (ri + 2 * stride < nrows) rcn2 = ((const Rec*)(p.ws + OFF_REC))[rowof(ri + 2 * stride)];
                yload(rcn);
            }
            const float* src = srcof(rowof(ri + stride));
#pragma unroll
            for (int i = 0; i < 4; ++i) xn[i] = *(const float4*)(src + i * 256 + lane * 4);
        }
        if (comb) {
            float* xr = XCUR + (size_t)row * DM;
            const float* gate = WSF(OFF_MOD) + (size_t)(lp * 9 + bi) * 6144 + 5 * 1024;
#pragma unroll
            for (int i = 0; i < 4; ++i) {
                const int c = i * 256 + lane * 4;
                float4 g4 = *(const float4*)(gate + c);
                uint2 a = ya[i], bb = yb[i];
                float f0 = rc.w0 * __uint_as_float(a.x << 16) + rc.w1 * __uint_as_float(bb.x << 16);
                float f1 = rc.w0 * __uint_as_float(a.x & 0xffff0000u) + rc.w1 * __uint_as_float(bb.x & 0xffff0000u);
                float f2 = rc.w0 * __uint_as_float(a.y << 16) + rc.w1 * __uint_as_float(bb.y << 16);
                float f3 = rc.w0 * __uint_as_float(a.y & 0xffff0000u) + rc.w1 * __uint_as_float(bb.y & 0xffff0000u);
                v[i * 4] += g4.x * f0; v[i * 4 + 1] += g4.y * f1; v[i * 4 + 2] += g4.z * f2; v[i * 4 + 3] += g4.w * f3;
                if (mode == 0) *(float4*)(xr + c) = make_float4(v[i * 4], v[i * 4 + 1], v[i * 4 + 2], v[i * 4 + 3]);
            }
        }
        float ss = 0.f;
#pragma unroll
        for (int i = 0; i < 16; ++i) ss += v[i] * v[i];
        ss = wave_sum(ss);
        const float rstd = rsqrtf(ss * (1.f / 1024.f) + EPSV);
        if (mode == 1) {
            float* o = p.out + ((size_t)b * SEQL + (t - CTXL)) * DM;
#pragma unroll
            for (int i = 0; i < 4; ++i) {
                const int c = i * 256 + lane * 4;
                float4 g4 = *(const float4*)(g1 + c);
                float4 r4;
                r4.x = v[i * 4] * rstd * g4.x; r4.y = v[i * 4 + 1] * rstd * g4.y; r4.z = v[i * 4 + 2] * rstd * g4.z; r4.w = v[i * 4 + 3] * rstd * g4.w;
                *(float4*)(o + c) = r4;
            }
        } else {
            const float* md = WSF(OFF_MOD) + (size_t)(l * 9 + bi) * 6144 + (mode == 2 ? 3 * 1024 : 0);
            bf16_t* ho = HB + (size_t)row * DM;
#pragma unroll
            for (int i = 0; i < 4; ++i) {
                const int c = i * 256 + lane * 4;
                float4 g4 = *(const float4*)(g1 + c);
                float4 sh = *(const float4*)(md + c);
                float4 sc = *(const float4*)(md + 1024 + c);
                float h0 = v[i * 4] * rstd * g4.x * (1.f + sc.x) + sh.x;
                float h1 = v[i * 4 + 1] * rstd * g4.y * (1.f + sc.y) + sh.y;
                float h2 = v[i * 4 + 2] * rstd * g4.z * (1.f + sc.z) + sh.z;
                float h3 = v[i * 4 + 3] * rstd * g4.w * (1.f + sc.w) + sh.w;
                uint2 o2;
                o2.x = (unsigned)f2bf(h0) | ((unsigned)f2bf(h1) << 16);
                o2.y = (unsigned)f2bf(h2) | ((unsigned)f2bf(h3) << 16);
                *(uint2*)(ho + c) = o2;
                if (mode == 2) *(int*)((unsigned char*)CB(0) + (size_t)row * 1024 + c) = pk4_fp8(h0, h1, h2, h3);
            }
        }
    }
}

DEVI int fetch_task(int* ctr, unsigned char* smem) {
    __syncthreads();
    if (TIDX == 0) *(volatile int*)smem = atomicAdd(ctr, 1);
    __syncthreads();
    return *(volatile int*)smem;
}
DEVI void dep_signal(int* cnt) {
    asm volatile("s_waitcnt vmcnt(0)" ::: "memory");
    __syncthreads();
    if (TIDX == 0) {
        __builtin_amdgcn_fence(__ATOMIC_RELEASE, "agent");
        asm volatile("s_waitcnt vmcnt(0)" ::: "memory");
        __hip_atomic_fetch_add(cnt, 1, __ATOMIC_RELAXED, __HIP_MEMORY_SCOPE_AGENT);
    }
}
DEVI void dep_wait(int* cnt, int need) {
    if (TIDX == 0) {
        while (__hip_atomic_load(cnt, __ATOMIC_RELAXED, __HIP_MEMORY_SCOPE_AGENT) < need) __builtin_amdgcn_s_sleep(2);
        __builtin_amdgcn_fence(__ATOMIC_ACQUIRE, "agent");
        asm volatile("s_waitcnt vmcnt(0)" ::: "memory");
    }
    __syncthreads();
}

DEVI void phase_win(const Params& p, int l, unsigned char* smem) {
    bf16_t* ct = (bf16_t*)smem;
    const float* cs64 = WSF(OFF_R64);
    const float* cs32 = WSF(OFF_R32);
    int* ctr = WSI(OFF_CNT) + 134 + l;
    for (;;) {
        const int task = fetch_task(ctr, smem);
        if (task >= 144 * 30) break;
        const int mt = task / 30, nt = task % 30;
        const int row0 = mt * 128, b = mt / 18, t0 = (mt % 18) * 128;
        const bool lat = (mt % 18) >= 2;
        const int pos0 = t0 - CTXL;
        f32x4 acc[4][4];
        acc_zero<128>(acc);
        AOp A{HB, 1024, row0, nullptr};
        T_BEGIN(3);
        gemm_core<128>(acc, A, WB(W_IN + (size_t)l * 3840 * 1024 + (size_t)nt * 128 * 1024), 1024, 1024, smem);
        __syncthreads();
        T_END(3, l == 0 && BIDX == 8);
        T_BEGIN(4);
        const bool tonly = (nt >= 7 && nt < 11) || nt == 28;
        if (tonly) acc_to_ctT(acc, ct); else acc_to_ct<128>(acc, ct);
        __syncthreads();
        if (nt < 2) ep_store_rows<128>(ct, 0, CB(C_CQ) + nt * 128, 256, row0);
        else if (nt == 2) ep_store_rows<128>(ct, 0, CB(C_CKV), 128, row0);
        else if (nt < 5) { ep_rope64(ct, nullptr, 1.f, lat, pos0, cs64); __syncthreads(); ep_store_rows<128>(ct, 0, CB(C_RQ) + (nt - 3) * 128, 256, row0); }
        else if (nt < 7) {
            ep_rope64(ct, nullptr, 0.125f, lat, pos0, cs64); __syncthreads();
            ep_store_rows<128>(ct, 0, CB(C_RK) + (nt - 5) * 128, 256, row0);
            ep_store_T(ct, 0, 128, CB(C_RKT) + ((size_t)b * 256 + (nt - 5) * 128) * TPB, TPB, t0);
        }
        else if (nt < 11) ep_store_rows<128>(ct, 0, CB(C_RVT) + ((size_t)b * 4 + (nt - 7)) * 128 * TPB + t0, TPB, 0);
        else if (nt < 15) ep_store_rows<128>(ct, 0, CB(C_RG) + (nt - 11) * 128, 512, row0);
        else if (nt < 19) ep_store_rows<128>(ct, 0, CB(C_LX) + (nt - 15) * 128, 512, row0);
        else if (nt < 23) ep_store_rows<128>(ct, 0, CB(C_LG) + (nt - 19) * 128, 512, row0);
        else if (nt < 27) { ep_rope64(ct, p.in[I_GQN] + l * 64, 0.125f * LOG2E, lat, pos0, cs64); __syncthreads(); ep_store_rows<128>(ct, 0, CB(C_GQ) + (nt - 23) * 128, 512, row0); }
        else if (nt == 27) { ep_rope64(ct, p.in[I_GKN] + l * 64, 1.f, lat, pos0, cs64); __syncthreads(); ep_store_rows<128>(ct, 0, CB(C_GK), 128, row0); }
        else if (nt == 28) ep_store_rows<128>(ct, 0, CB(C_GVT) + (size_t)b * 128 * TPB + t0, TPB, 0);
        else { ep_rope32(ct, 1, nullptr, 1.f, lat, pos0, cs32); __syncthreads(); ep_store_rows<32>(ct, 0, CB(C_KR), 32, row0); }
        __syncthreads();
        T_END(4, l == 0 && BIDX == 8);
    }
}

DEVI float ret_lg2(const Params& p, int l, int dir, int h) { return -log1pf(expf(-p.in[I_RDEC][l * 8 + dir * 4 + h])) * LOG2E; }
DEVI void ret_chunk_U(const Params& p, int l, int task) {
    const int b = task / 72, r = task % 72, h = r / 18, m = r % 18;
    const int tid = TIDX, lane = tid & 63, w = tid >> 6, qc = lane & 31, hh = lane >> 5;
    const int t0 = m * 128;
    const bf16_t* KTg = CB(C_RKT) + ((size_t)b * 4 + h) * 64 * TPB + t0 + 8 * hh;
    const bf16_t* VTg = CB(C_RVT) + (((size_t)b * 4 + h) * 128 + w * 32 + qc) * TPB + t0 + 8 * hh;
    bf16x8 vf[8], ka[2][8];
#pragma unroll
    for (int ks = 0; ks < 8; ++ks) vf[ks] = *(const bf16x8*)(VTg + ks * 16);
#pragma unroll
    for (int sub = 0; sub < 2; ++sub)
#pragma unroll
        for (int ks = 0; ks < 8; ++ks) ka[sub][ks] = *(const bf16x8*)(KTg + (size_t)(32 * sub + qc) * TPB + ks * 16);
#pragma unroll
    for (int dir = 0; dir < 2; ++dir) {
        const float lg2 = ret_lg2(p, l, dir, h);
        f32x16 U0, U1;
#pragma unroll
        for (int rr = 0; rr < 16; ++rr) { U0[rr] = 0.f; U1[rr] = 0.f; }
#pragma unroll
        for (int ks = 0; ks < 8; ++ks) {
            bf16x8 vs;
#pragma unroll
            for (int e = 0; e < 8; ++e) {
                const int j = 16 * ks + 8 * hh + e;
                const float kd = __builtin_amdgcn_exp2f(lg2 * (float)(dir == 0 ? 127 - j : j));
                vs[e] = (short)f2bf(bf2f((bf16_t)vf[ks][e]) * kd);
            }
            U0 = __builtin_amdgcn_mfma_f32_32x32x16_bf16(ka[0][ks], vs, U0, 0, 0, 0);
            U1 = __builtin_amdgcn_mfma_f32_32x32x16_bf16(ka[1][ks], vs, U1, 0, 0, 0);
        }
        bf16_t* up = DB(D_OB) + ((((size_t)(b * 4 + h) * 18 + m) * 2 + dir) * 128) * 64 + (size_t)(32 * w + qc) * 8 + 4 * hh;
#pragma unroll
        for (int g = 0; g < 4; ++g) {
            bf16x4 a, c;
#pragma unroll
            for (int e = 0; e < 4; ++e) { a[e] = (short)f2bf(U0[4 * g + e]); c[e] = (short)f2bf(U1[4 * g + e]); }
            *(bf16x4*)(up + (((g >> 1) * 2 + (g & 1)) * 128) * 8) = a;
            *(bf16x4*)(up + (((2 + (g >> 1)) * 2 + (g & 1)) * 128) * 8) = c;
        }
    }
}
DEVI void ret_out_task(const Params& p, int l, int b, int h, int m, unsigned char* smem) {
    constexpr int PLD = 136;
    bf16_t* P = (bf16_t*)smem;
    float* red = (float*)(smem + 34816);
    const int tid = TIDX, lane = tid & 63, w = tid >> 6, qc = lane & 31, hh = lane >> 5;
    const int t0 = m * 128, iq = 32 * w + qc;
    const float lgf = ret_lg2(p, l, 0, h), lgb = ret_lg2(p, l, 1, h);
    const float cdf = exp2f(lgf * 128.f), cdb = exp2f(lgb * 128.f);
    bf16x8 sff[4], sfb[4];
    {
        float Sf[4][8], Sb[4][8];
#pragma unroll
        for (int ks = 0; ks < 4; ++ks)
#pragma unroll
            for (int e = 0; e < 8; ++e) { Sf[ks][e] = 0.f; Sb[ks][e] = 0.f; }
        const bf16_t* Ub = DB(D_OB) + (size_t)(b * 4 + h) * 18 * 2 * 128 * 64 + (size_t)(hh * 128 + 32 * w + qc) * 8;
        const int pos = m < 2 ? 1 - m : 19 - m;
        const int nf4 = (m + 3) & ~3, nb4 = (pos + 3) & ~3;
        for (int c0 = 0; c0 < nf4; c0 += 4) {
            bf16x8 u[4][4]; float wg[4];
#pragma unroll
            for (int q = 0; q < 4; ++q) {
                const int c = c0 + q, cl = c < m ? c : 0;
                wg[q] = c < m ? __builtin_amdgcn_exp2f(lgf * 128.f * (float)(m - 1 - c)) : 0.f;
                const bf16_t* up = Ub + (size_t)(cl * 2 + 0) * 128 * 64;
#pragma unroll
                for (int ks = 0; ks < 4; ++ks) u[q][ks] = *(const bf16x8*)(up + ks * 2048);
            }
#pragma unroll
            for (int q = 0; q < 4; ++q)
#pragma unroll
                for (int ks = 0; ks < 4; ++ks)
#pragma unroll
                    for (int e = 0; e < 8; ++e) Sf[ks][e] += wg[q] * bf2f((bf16_t)u[q][ks][e]);
        }
        for (int c0 = 0; c0 < nb4; c0 += 4) {
            bf16x8 u[4][4]; float wg[4];
#pragma unroll
            for (int q = 0; q < 4; ++q) {
                const int cc = c0 + q, ccl = cc < pos ? cc : 0;
                const int c = ccl < 2 ? 1 - ccl : 19 - ccl;
                wg[q] = cc < pos ? __builtin_amdgcn_exp2f(lgb * 128.f * (float)(pos - 1 - cc)) : 0.f;
                const bf16_t* up = Ub + (size_t)(c * 2 + 1) * 128 * 64;
#pragma unroll
                for (int ks = 0; ks < 4; ++ks) u[q][ks] = *(const bf16x8*)(up + ks * 2048);
            }
#pragma unroll
            for (int q = 0; q < 4; ++q)
#pragma unroll
                for (int ks = 0; ks < 4; ++ks)
#pragma unroll
                    for (int e = 0; e < 8; ++e) Sb[ks][e] += wg[q] * bf2f((bf16_t)u[q][ks][e]);
        }
#pragma unroll
        for (int ks = 0; ks < 4; ++ks)
#pragma unroll
            for (int e = 0; e < 8; ++e) { sff[ks][e] = (short)f2bf(Sf[ks][e]); sfb[ks][e] = (short)f2bf(Sb[ks][e]); }
    }
    const bf16_t* Kg = CB(C_RK) + ((size_t)b * TPB + t0) * 256 + h * 64 + 8 * hh;
    const bf16_t* Qg = CB(C_RQ) + ((size_t)b * TPB + t0) * 256 + h * 64 + 8 * hh;
    const bf16_t* VTg = CB(C_RVT) + (((size_t)b * 4 + h) * 128 + w * 32 + qc) * TPB + t0 + 8 * hh;
    bf16x8 vf[8];
#pragma unroll
    for (int ks = 0; ks < 8; ++ks) vf[ks] = *(const bf16x8*)(VTg + ks * 16);
    {
        bf16x8 qf[4], ka[4][4];
#pragma unroll
        for (int ks = 0; ks < 4; ++ks) qf[ks] = *(const bf16x8*)(Qg + (size_t)iq * 256 + ks * 16);
#pragma unroll
        for (int js = 0; js < 4; ++js)
#pragma unroll
            for (int ks = 0; ks < 4; ++ks) ka[js][ks] = *(const bf16x8*)(Kg + (size_t)(32 * js + qc) * 256 + ks * 16);
        __syncthreads();
#pragma unroll
        for (int js = 0; js < 4; ++js) {
            f32x16 sc;
#pragma unroll
            for (int r = 0; r < 16; ++r) sc[r] = 0.f;
#pragma unroll
            for (int ks = 0; ks < 4; ++ks) sc = __builtin_amdgcn_mfma_f32_32x32x16_bf16(ka[js][ks], qf[ks], sc, 0, 0, 0);
#pragma unroll
            for (int g = 0; g < 4; ++g) {
                bf16x4 pk;
#pragma unroll
                for (int e = 0; e < 4; ++e) {
                    const int d = iq - (32 * js + 8 * g + 4 * hh + e);
                    const float wgt = d >= 0 ? __builtin_amdgcn_exp2f(lgf * (float)d) : __builtin_amdgcn_exp2f(lgb * (float)(-d));
                    pk[e] = (short)f2bf(sc[4 * g + e] * wgt);
                }
                *(bf16x4*)(P + iq * PLD + 32 * js + 8 * g + 4 * hh) = pk;
            }
        }
    }
    bf16x8 qa[4];
#pragma unroll
    for (int ks = 0; ks < 4; ++ks) qa[ks] = *(const bf16x8*)(Qg + (size_t)qc * 256 + ks * 16);
    __syncthreads();
    f32x16 o[4];
#pragma unroll
    for (int isub = 0; isub < 4; ++isub) {
        const int ii = 32 * isub + qc;
        bf16x8 qn[4];
        if (isub < 3) {
#pragma unroll
            for (int ks = 0; ks < 4; ++ks) qn[ks] = *(const bf16x8*)(Qg + (size_t)(ii + 32) * 256 + ks * 16);
        }
#pragma unroll
        for (int r = 0; r < 16; ++r) o[isub][r] = 0.f;
#pragma unroll
        for (int ks = 0; ks < 4; ++ks) o[isub] = __builtin_amdgcn_mfma_f32_32x32x16_bf16(sff[ks], qa[ks], o[isub], 0, 0, 0);
        const float qdf = __builtin_amdgcn_exp2f(lgf * (float)(ii + 1)), qdb = __builtin_amdgcn_exp2f(lgb * (float)(128 - ii));
        const float rat = qdf / qdb;
#pragma unroll
        for (int r = 0; r < 16; ++r) o[isub][r] *= rat;
#pragma unroll
        for (int ks = 0; ks < 4; ++ks) o[isub] = __builtin_amdgcn_mfma_f32_32x32x16_bf16(sfb[ks], qa[ks], o[isub], 0, 0, 0);
#pragma unroll
        for (int r = 0; r < 16; ++r) o[isub][r] *= qdb;
#pragma unroll
        for (int ks = 0; ks < 8; ++ks) {
            bf16x8 pf = *(const bf16x8*)(P + ii * PLD + 16 * ks + 8 * hh);
            o[isub] = __builtin_amdgcn_mfma_f32_32x32x16_bf16(vf[ks], pf, o[isub], 0, 0, 0);
        }
        float s1 = 0.f, s2 = 0.f;
#pragma unroll
        for (int r = 0; r < 16; ++r) { s1 += o[isub][r]; s2 += o[isub][r] * o[isub][r]; }
        s1 += __shfl_xor(s1, 32); s2 += __shfl_xor(s2, 32);
        if (hh == 0) { red[(w * 128 + ii) * 2] = s1; red[(w * 128 + ii) * 2 + 1] = s2; }
        if (isub < 3) {
#pragma unroll
            for (int ks = 0; ks < 4; ++ks) qa[ks] = qn[ks];
        }
    }
    __syncthreads();
    const float* gn = p.in[I_RNORM] + l * 512 + h * 128 + 32 * w + 4 * hh;
    float gnv[16];
#pragma unroll
    for (int g = 0; g < 4; ++g)
#pragma unroll
        for (int e = 0; e < 4; ++e) gnv[4 * g + e] = gn[8 * g + e];
#pragma unroll
    for (int isub = 0; isub < 4; ++isub) {
        const int ii = 32 * isub + qc;
        float t1 = 0.f, t2 = 0.f;
#pragma unroll
        for (int ww = 0; ww < 4; ++ww) { t1 += red[(ww * 128 + ii) * 2]; t2 += red[(ww * 128 + ii) * 2 + 1]; }
        const float mu = t1 * (1.f / 128.f);
        const float rs = rsqrtf(fmaxf(t2 * (1.f / 128.f) - mu * mu, 0.f) + EPSV);
#pragma unroll
        for (int g = 0; g < 4; ++g) {
            bf16x4 ov;
#pragma unroll
            for (int e = 0; e < 4; ++e) ov[e] = (short)f2bf((o[isub][4 * g + e] - mu) * rs * gnv[4 * g + e]);
            *(bf16x4*)(P + ii * PLD + 32 * w + 8 * g + 4 * hh) = ov;
        }
    }
    __syncthreads();
#pragma unroll
    for (int k = 0; k < 8; ++k) {
        const int c = tid + 256 * k, row = c >> 4, ch = c & 15;
        const size_t ro = ((size_t)b * TPB + t0 + row) * 512 + h * 128 + ch * 8;
        const bf16x8 nv = *(const bf16x8*)(P + row * PLD + ch * 8);
        const bf16x8 gt = *(const bf16x8*)(CB(C_RG) + ro);
        bf16x8 ov;
#pragma unroll
        for (int e = 0; e < 8; ++e) ov[e] = (short)f2bf(siluf_(bf2f((bf16_t)gt[e])) * bf2f((bf16_t)nv[e]));
        *(bf16x8*)(DB(D_OF) + ro) = ov;
    }
}

DEVI void h_to_fp8(const Params& p, int t32) {
    const int lane = TIDX & 63, w = TIDX >> 6;
    const size_t row0 = (size_t)t32 * 32 + w * 8;
    bf16x8 a[8], b[8];
#pragma unroll
    for (int i = 0; i < 8; ++i) {
        a[i] = *(const bf16x8*)(HB + (row0 + i) * 1024 + lane * 16);
        b[i] = *(const bf16x8*)(HB + (row0 + i) * 1024 + lane * 16 + 8);
    }
    asm volatile("s_waitcnt vmcnt(0)" ::: "memory");
#pragma unroll
    for (int i = 0; i < 8; ++i) {
        i32x4 o;
        o[0] = pk4_fp8(bf2f((bf16_t)a[i][0]), bf2f((bf16_t)a[i][1]), bf2f((bf16_t)a[i][2]), bf2f((bf16_t)a[i][3]));
        o[1] = pk4_fp8(bf2f((bf16_t)a[i][4]), bf2f((bf16_t)a[i][5]), bf2f((bf16_t)a[i][6]), bf2f((bf16_t)a[i][7]));
        o[2] = pk4_fp8(bf2f((bf16_t)b[i][0]), bf2f((bf16_t)b[i][1]), bf2f((bf16_t)b[i][2]), bf2f((bf16_t)b[i][3]));
        o[3] = pk4_fp8(bf2f((bf16_t)b[i][4]), bf2f((bf16_t)b[i][5]), bf2f((bf16_t)b[i][6]), bf2f((bf16_t)b[i][7]));
        *(i32x4*)((unsigned char*)HB + (row0 + i) * 2048 + lane * 16) = o;
    }
}
DEVI void phase_mla_up(const Params& p, int l, unsigned char* smem) {
    bf16_t* ct = (bf16_t*)smem;
    float* rstd = (float*)(smem + AUX_OFF);
    const float* cs32 = WSF(OFF_R32);
    const float qscale = 0.10206207261596575f * LOG2E;
    const int nq = (l == 0 ? 144 : 128) * 6;
    const int nkv = 144 * 8;
    for (int tile = BIDX; tile < nq + nkv + 576 + 576; tile += gridDim.x) {
        if (tile >= nq + nkv + 576) { h_to_fp8(p, tile - nq - nkv - 576); continue; }
        if (tile >= nq + nkv) { ret_chunk_U(p, l, tile - nq - nkv); continue; }
        if (tile < nq) {
            const int mt = mt_of(tile / 6, l != 0), nt = tile % 6;
            const int row0 = mt * 128, t0 = (mt % 18) * 128;
            const bool lat = (mt % 18) >= 2;
            f32x4 acc[4][4];
            acc_zero<128>(acc);
            AOp A{CB(C_CQ), 256, row0, nullptr};
            gemm_core<128>(acc, A, WB(W_UQ + (size_t)l * 768 * 256 + (size_t)nt * 128 * 256), 256, 256, smem);
            __syncthreads();
            acc_to_ct<128>(acc, ct);
            ep_rstd(CB(C_CQ), 256, row0, 256, rstd);
            __syncthreads();
            if (nt < 4) {
                ep_scale_rows(ct, 0, 128, rstd, qscale); __syncthreads();
                ep_store_rows<64>(ct, 0, CB(C_MQ) + (nt * 2) * 96, 768, row0);
                ep_store_rows<64>(ct, 64, CB(C_MQ) + (nt * 2 + 1) * 96, 768, row0);
            } else {
                ep_rope32(ct, 4, rstd, qscale, lat, t0 - CTXL, cs32); __syncthreads();
#pragma unroll
                for (int g = 0; g < 4; ++g) ep_store_rows<32>(ct, g * 32, CB(C_MQ) + ((nt - 4) * 4 + g) * 96 + 64, 768, row0);
            }
            __syncthreads();
        } else {
            const int tk = tile - nq;
            const int mt = tk / 8, nt = tk % 8;
            const int row0 = mt * 128, b = mt / 18, t0 = (mt % 18) * 128;
            f32x4 acc[4][4];
            acc_zero<128>(acc);
            AOp A{CB(C_CKV), 128, row0, nullptr};
            gemm_core<128>(acc, A, WB(W_UKV + (size_t)l * 1024 * 128 + (size_t)nt * 128 * 128), 128, 128, smem);
            __syncthreads();
            acc_to_ct<128>(acc, ct);
            ep_rstd(CB(C_CKV), 128, row0, 128, rstd);
            __syncthreads();
            ep_scale_rows(ct, 0, 128, rstd, 1.f); __syncthreads();
            ep_store_rows<64>(ct, 0, CB(C_KN) + nt * 64, 512, row0);
            ep_store_T(ct, 64, 64, CB(C_VMT) + ((size_t)b * 8 + nt) * 64 * TPB, TPB, t0);
            __syncthreads();
        }
    }
}

template <int DK, bool MLA>
DEVI void attn_naive_wave(const Params& p, int b, int t0, int hq) {
    const int lane = TIDX & 63;
    const int t = t0 + lane, row = b * TPB + t;
    const int nkeys = (t0 < CTXL) ? CTXL : TPB;
    float q[DK];
    const bf16_t* qp = MLA ? CB(C_MQ) + (size_t)row * 768 + hq * 96 : CB(C_GQ) + (size_t)row * 512 + hq * 64;
#pragma unroll
    for (int c = 0; c < DK / 8; ++c) {
        bf16x8 tq = *(const bf16x8*)(qp + c * 8);
#pragma unroll
        for (int e = 0; e < 8; ++e) q[c * 8 + e] = bf2f((bf16_t)tq[e]);
    }
    float acc[64];
#pragma unroll
    for (int d = 0; d < 64; ++d) acc[d] = 0.f;
    float m = -1e30f, lsum = 0.f;
    const int hk = MLA ? hq : (hq >> 2);
    const bf16_t* vT = MLA ? CB(C_VMT) + ((size_t)b * 8 + hk) * 64 * TPB : CB(C_GVT) + ((size_t)b * 2 + hk) * 64 * TPB;
    for (int kt = 0; kt < nkeys; ++kt) {
        const size_t krow = (size_t)b * TPB + kt;
        float s = 0.f;
        const bf16_t* kp = MLA ? CB(C_KN) + krow * 512 + hk * 64 : CB(C_GK) + krow * 128 + hk * 64;
#pragma unroll
        for (int c = 0; c < 8; ++c) {
            bf16x8 tk = *(const bf16x8*)(kp + c * 8);
#pragma unroll
            for (int e = 0; e < 8; ++e) s += q[c * 8 + e] * bf2f((bf16_t)tk[e]);
        }
        if (MLA) {
            const bf16_t* rp = CB(C_KR) + krow * 32;
#pragma unroll
            for (int c = 0; c < 4; ++c) {
                bf16x8 tk = *(const bf16x8*)(rp + c * 8);
#pragma unroll
                for (int e = 0; e < 8; ++e) s += q[(DK - 32) + c * 8 + e] * bf2f((bf16_t)tk[e]);
            }
        }
        const float mn = fmaxf(m, s);
        const float alpha = exp2f(m - mn), pp = exp2f(s - mn);
        lsum = lsum * alpha + pp;
#pragma unroll
        for (int d = 0; d < 64; ++d) acc[d] = acc[d] * alpha + pp * bf2f(vT[(size_t)d * TPB + kt]);
        m = mn;
    }
    const float inv = 1.f / lsum;
    bf16_t* op = (MLA ? DB(D_YA) : DB(D_YD)) + (size_t)row * 512 + hq * 64;
#pragma unroll
    for (int c = 0; c < 8; ++c) {
        bf16x8 o;
#pragma unroll
        for (int e = 0; e < 8; ++e) o[e] = (short)f2bf(acc[c * 8 + e] * inv);
        *(bf16x8*)(op + c * 8) = o;
    }
}


template <int DK, bool MLA>
DEVI void attn_task(const Params& p, int b, int hsel, int tq0, int nkeys, unsigned char* smem) {
    constexpr int KLD = DK + 8;
    constexpr int CK = DK / 8;
    constexpr int NKC = 64 * CK / 256;
    constexpr int VLD = 68;
    constexpr int KBYTES = 64 * KLD * 2, VBYTES = 64 * VLD * 2;
    constexpr int VOFF = 2 * KBYTES;
    static_assert(2 * (KBYTES + VBYTES) <= 60000, "attn lds");
    const int tid = TIDX, lane = tid & 63, w = tid >> 6, qc = lane & 31, hh = lane >> 5;
    const int tq = MLA ? tq0 + w * 32 + qc : tq0 + qc;
    const int hq = MLA ? hsel : hsel * 4 + w;
    const size_t qrow = (size_t)b * TPB + tq;
    const bf16_t* qp = MLA ? CB(C_MQ) + qrow * 768 + hq * 96 : CB(C_GQ) + qrow * 512 + hq * 64;
    bf16x8 qf[DK / 16];
#pragma unroll
    for (int ks = 0; ks < DK / 16; ++ks) qf[ks] = *(const bf16x8*)(qp + ks * 16 + hh * 8);
    const bf16_t* ksrc[NKC]; int kstep[NKC], kdst[NKC];
#pragma unroll
    for (int i = 0; i < NKC; ++i) {
        const int q = tid + 256 * i, key = q / CK, ch = q % CK;
        if (MLA) {
            if (ch < 8) { ksrc[i] = CB(C_KN) + ((size_t)b * TPB + key) * 512 + hsel * 64 + ch * 8; kstep[i] = 64 * 512; }
            else { ksrc[i] = CB(C_KR) + ((size_t)b * TPB + key) * 32 + (ch - 8) * 8; kstep[i] = 64 * 32; }
        } else { ksrc[i] = CB(C_GK) + ((size_t)b * TPB + key) * 128 + hsel * 64 + ch * 8; kstep[i] = 64 * 128; }
        kdst[i] = (key * KLD + ch * 8) * 2;
    }
    const bf16_t* vT = MLA ? CB(C_VMT) + ((size_t)b * 8 + hsel) * 64 * TPB : CB(C_GVT) + ((size_t)b * 2 + hsel) * 64 * TPB;
    const bf16_t* vsrc[2]; int vdst[2];
#pragma unroll
    for (int i = 0; i < 2; ++i) {
        const int q = tid + 256 * i, dv = q >> 3, ch = q & 7;
        vsrc[i] = vT + (size_t)dv * TPB + ch * 8;
        vdst[i] = VOFF + (dv * VLD + ch * 8) * 2;
    }
    const int nt = nkeys >> 6;
    bf16x8 kr[NKC], vr[2];
#pragma unroll
    for (int i = 0; i < NKC; ++i) kr[i] = *(const bf16x8*)(ksrc[i]);
#pragma unroll
    for (int i = 0; i < 2; ++i) vr[i] = *(const bf16x8*)(vsrc[i]);
    __syncthreads();
#pragma unroll
    for (int i = 0; i < NKC; ++i) *(bf16x8*)(smem + kdst[i]) = kr[i];
#pragma unroll
    for (int i = 0; i < 2; ++i) {
        *(bf16x4*)(smem + vdst[i]) = bf16x4{vr[i][0], vr[i][1], vr[i][2], vr[i][3]};
        *(bf16x4*)(smem + vdst[i] + 8) = bf16x4{vr[i][4], vr[i][5], vr[i][6], vr[i][7]};
    }
#pragma unroll
    for (int i = 0; i < NKC; ++i) kr[i] = *(const bf16x8*)(ksrc[i] + (size_t)kstep[i]);
    __syncthreads();
    f32x16 s0, s1;
#pragma unroll
    for (int r = 0; r < 16; ++r) { s0[r] = 0.f; s1[r] = 0.f; }
#pragma unroll
    for (int ks = 0; ks < DK / 16; ++ks) {
        bf16x8 a0 = *(const bf16x8*)(smem + (qc * KLD + ks * 16 + hh * 8) * 2);
        bf16x8 a1 = *(const bf16x8*)(smem + ((32 + qc) * KLD + ks * 16 + hh * 8) * 2);
        s0 = __builtin_amdgcn_mfma_f32_32x32x16_bf16(a0, qf[ks], s0, 0, 0, 0);
        s1 = __builtin_amdgcn_mfma_f32_32x32x16_bf16(a1, qf[ks], s1, 0, 0, 0);
    }
#pragma unroll
    for (int i = 0; i < NKC; ++i) *(bf16x8*)(smem + KBYTES + kdst[i]) = kr[i];
    f32x16 o0, o1;
#pragma unroll
    for (int r = 0; r < 16; ++r) { o0[r] = 0.f; o1[r] = 0.f; }
    float m = -1e30f, lsum = 0.f;
    for (int it = 0; it < nt; ++it) {
        __syncthreads();
        if (it + 2 < nt) {
#pragma unroll
            for (int i = 0; i < NKC; ++i) kr[i] = *(const bf16x8*)(ksrc[i] + (size_t)(it + 2) * kstep[i]);
        }
        if (it + 1 < nt) {
#pragma unroll
            for (int i = 0; i < 2; ++i) vr[i] = *(const bf16x8*)(vsrc[i] + (it + 1) * 64);
        }
        f32x16 n0, n1;
#pragma unroll
        for (int r = 0; r < 16; ++r) { n0[r] = 0.f; n1[r] = 0.f; }
        if (it + 1 < nt) {
            const unsigned char* ck = smem + ((it + 1) & 1) * KBYTES;
#pragma unroll
            for (int ks = 0; ks < DK / 16; ++ks) {
                bf16x8 a0 = *(const bf16x8*)(ck + (qc * KLD + ks * 16 + hh * 8) * 2);
                bf16x8 a1 = *(const bf16x8*)(ck + ((32 + qc) * KLD + ks * 16 + hh * 8) * 2);
                n0 = __builtin_amdgcn_mfma_f32_32x32x16_bf16(a0, qf[ks], n0, 0, 0, 0);
                n1 = __builtin_amdgcn_mfma_f32_32x32x16_bf16(a1, qf[ks], n1, 0, 0, 0);
            }
        }
        float mx = s0[0];
#pragma unroll
        for (int r = 1; r < 16; ++r) mx = fmaxf(mx, s0[r]);
#pragma unroll
        for (int r = 0; r < 16; ++r) mx = fmaxf(mx, s1[r]);
        mx = fmaxf(mx, __shfl_xor(mx, 32));
        if (!__all(mx <= m + 6.f)) {
            const float mn = fmaxf(m, mx);
            const float alpha = __builtin_amdgcn_exp2f(m - mn);
            m = mn;
            lsum *= alpha;
#pragma unroll
            for (int r = 0; r < 16; ++r) { o0[r] *= alpha; o1[r] *= alpha; }
        }
        float ps = 0.f;
#pragma unroll
        for (int r = 0; r < 16; ++r) { s0[r] = __builtin_amdgcn_exp2f(s0[r] - m); ps += s0[r]; }
#pragma unroll
        for (int r = 0; r < 16; ++r) { s1[r] = __builtin_amdgcn_exp2f(s1[r] - m); ps += s1[r]; }
        lsum += ps;
        bf16x8 pf[2][2];
#pragma unroll
        for (int s = 0; s < 2; ++s)
#pragma unroll
            for (int j = 0; j < 8; ++j) { pf[0][s][j] = (short)f2bf(s0[8 * s + j]); pf[1][s][j] = (short)f2bf(s1[8 * s + j]); }
        const unsigned char* cv = smem + VOFF + (it & 1) * VBYTES;
#pragma unroll
        for (int a = 0; a < 2; ++a)
#pragma unroll
            for (int s = 0; s < 2; ++s) {
                const int keyoff = a * 32 + 16 * s + 4 * hh;
                bf16x4 l0 = *(const bf16x4*)(cv + (qc * VLD + keyoff) * 2);
                bf16x4 h0 = *(const bf16x4*)(cv + (qc * VLD + keyoff + 8) * 2);
                bf16x4 l1 = *(const bf16x4*)(cv + ((32 + qc) * VLD + keyoff) * 2);
                bf16x4 h1 = *(const bf16x4*)(cv + ((32 + qc) * VLD + keyoff + 8) * 2);
                bf16x8 v0 = bf16x8{l0[0], l0[1], l0[2], l0[3], h0[0], h0[1], h0[2], h0[3]};
                bf16x8 v1 = bf16x8{l1[0], l1[1], l1[2], l1[3], h1[0], h1[1], h1[2], h1[3]};
                o0 = __builtin_amdgcn_mfma_f32_32x32x16_bf16(v0, pf[a][s], o0, 0, 0, 0);
                o1 = __builtin_amdgcn_mfma_f32_32x32x16_bf16(v1, pf[a][s], o1, 0, 0, 0);
            }
        if (it + 2 < nt) {
            unsigned char* nk = smem + (it & 1) * KBYTES;
#pragma unroll
            for (int i = 0; i < NKC; ++i) *(bf16x8*)(nk + kdst[i]) = kr[i];
        }
        if (it + 1 < nt) {
            unsigned char* nv = smem + ((it + 1) & 1) * VBYTES;
#pragma unroll
            for (int i = 0; i < 2; ++i) {
                *(bf16x4*)(nv + vdst[i]) = bf16x4{vr[i][0], vr[i][1], vr[i][2], vr[i][3]};
                *(bf16x4*)(nv + vdst[i] + 8) = bf16x4{vr[i][4], vr[i][5], vr[i][6], vr[i][7]};
            }
        }
        s0 = n0; s1 = n1;
    }
    lsum += __shfl_xor(lsum, 32);
    const float inv = 1.f / lsum;
    bf16_t* op = (MLA ? DB(D_YA) : DB(D_YD)) + qrow * 512 + hq * 64;
#pragma unroll
    for (int g = 0; g < 4; ++g) {
        bf16x4 a, c;
#pragma unroll
        for (int e = 0; e < 4; ++e) { a[e] = (short)f2bf(o0[g * 4 + e] * inv); c[e] = (short)f2bf(o1[g * 4 + e] * inv); }
        *(bf16x4*)(op + 8 * g + 4 * hh) = a;
        *(bf16x4*)(op + 32 + 8 * g + 4 * hh) = c;
    }
}

DEVI int proc_tok(int dir, int pidx) { return dir == 0 ? pidx : (pidx < CTXL ? CTXL - 1 - pidx : (CTXL + TPB - 1) - pidx); }

DEVI void retention_naive(const Params& p, int l, int task) {
    const int b = task >> 2, h = task & 3;
    const int dir = TIDX >> 7, dv = TIDX & 127;
    const float dec = p.in[I_RDEC][l * 8 + dir * 4 + h];
    const float lg = -log1pf(expf(-dec));
    const float g = expf(lg);
    float S[64];
#pragma unroll
    for (int d = 0; d < 64; ++d) S[d] = 0.f;
    const bf16_t* vT = CB(C_RVT) + (((size_t)b * 4 + h) * 128 + dv) * TPB;
    bf16_t* outp = (dir == 0 ? DB(D_OF) : DB(D_OB));
    for (int pi = 0; pi < TPB; ++pi) {
        const int u = proc_tok(dir, pi);
        const size_t row = (size_t)b * TPB + u;
        const bf16_t* qp = CB(C_RQ) + row * 256 + h * 64;
        const bf16_t* kp = CB(C_RK) + row * 256 + h * 64;
        const float v = bf2f(vT[u]);
        float o = 0.f;
#pragma unroll
        for (int c = 0; c < 8; ++c) {
            bf16x8 tq = *(const bf16x8*)(qp + c * 8);
            bf16x8 tk = *(const bf16x8*)(kp + c * 8);
#pragma unroll
            for (int e = 0; e < 8; ++e) {
                const int d = c * 8 + e;
                const float qd = bf2f((bf16_t)tq[e]), kd = bf2f((bf16_t)tk[e]);
                if (dir == 0) { S[d] = g * S[d] + kd * v; o += qd * S[d]; }
                else { S[d] = g * S[d]; o += qd * S[d]; S[d] += kd * v; }
            }
        }
        outp[row * 512 + h * 128 + dv] = f2bf(o);
    }
}

DEVI void lru_naive_wave(const Params& p, int l, int task) {
    const int lane = TIDX & 63;
    const int b = task >> 4, d = (task >> 3) & 1, blk = task & 7;
    const int ch = blk * 64 + lane;
    float cw[4];
#pragma unroll
    for (int j = 0; j < 4; ++j) cw[j] = p.in[I_LCW][(l * 4 + j) * 512 + ch];
    const float cb = p.in[I_LCB][l * 512 + ch];
    const float ba = p.in[I_LBA][(l * 2 + d) * 512 + ch], bx = p.in[I_LBX][(l * 2 + d) * 512 + ch];
    const float lam = p.in[I_LLAM][(l * 2 + d) * 512 + ch];
    const float sp = log1pf(expf(-lam));
    const float* Wa = p.in[I_LWA] + ((size_t)(l * 2 + d) * 8 + blk) * 4096;
    const float* Wx = p.in[I_LWX] + ((size_t)(l * 2 + d) * 8 + blk) * 4096;
    float h = 0.f;
    bf16_t* outp = (d == 0 ? DB(D_LH0) : DB(D_LH1));
    for (int pi = 0; pi < TPB; ++pi) {
        const int u = proc_tok(d, pi);
        const int lo = u < CTXL ? 0 : CTXL, hi = u < CTXL ? CTXL : TPB;
        const size_t row = (size_t)b * TPB + u;
        float uval = cb;
#pragma unroll
        for (int j = 0; j < 4; ++j) {
            const int tt = u - 2 + j;
            if (tt >= lo && tt < hi) uval += cw[j] * bf2f(CB(C_LX)[((size_t)b * TPB + tt) * 512 + ch]);
        }
        float rp = 0.f, ip = 0.f;
        for (int c = 0; c < 64; ++c) {
            const float uc = __shfl(uval, c);
            rp += uc * Wa[c * 64 + lane];
            ip += uc * Wx[c * 64 + lane];
        }
        const float r = sigmoidf_(rp + ba), ig = sigmoidf_(ip + bx);
        const float la = -8.f * r * sp;
        const float a = expf(la);
        const float bb = sqrtf(-expm1f(2.f * la)) * (ig * uval);
        h = a * h + bb;
        outp[row * 512 + ch] = f2bf(h);
    }
}


DEVI void retention_walk(const Params& p, int l, int task, unsigned char* smem) {
    constexpr int PLD = 136;
    const int b = task >> 3, h = (task >> 1) & 3, dir = task & 1;
    const int tid = TIDX, lane = tid & 63, w = tid >> 6, qc = lane & 31, hh = lane >> 5;
    const float dec = p.in[I_RDEC][l * 8 + dir * 4 + h];
    const float lg2 = -log1pf(expf(-dec)) * LOG2E;
    const float cdec = exp2f(lg2 * 128.f);
    bf16_t* P = (bf16_t*)smem;
    f32x16 S0, S1;
#pragma unroll
    for (int r = 0; r < 16; ++r) { S0[r] = 0.f; S1[r] = 0.f; }
    const bf16_t* Kg = CB(C_RK) + (size_t)b * TPB * 256 + h * 64;
    const bf16_t* Qg = CB(C_RQ) + (size_t)b * TPB * 256 + h * 64;
    const bf16_t* KTg = CB(C_RKT) + ((size_t)b * 4 + h) * 64 * TPB;
    const bf16_t* VTg = CB(C_RVT) + (((size_t)b * 4 + h) * 128 + w * 32 + qc) * TPB;
    bf16_t* outp = (dir == 0 ? DB(D_OF) : DB(D_OB)) + (size_t)b * TPB * 512 + h * 128 + w * 32;
    const int iq = 32 * w + qc;
    for (int cc = 0; cc < 18; ++cc) {
        const int mch = dir == 0 ? cc : (cc < 2 ? 1 - cc : 19 - cc);
        const int t0 = mch * 128;
        bf16x8 vf[8];
#pragma unroll
        for (int ks = 0; ks < 8; ++ks) vf[ks] = *(const bf16x8*)(VTg + t0 + ks * 16 + hh * 8);
        bf16x8 qf[4];
        {
            const bf16_t* qrow = Qg + (size_t)(t0 + iq) * 256;
#pragma unroll
            for (int ks = 0; ks < 4; ++ks) qf[ks] = *(const bf16x8*)(qrow + ks * 16 + hh * 8);
        }
        __syncthreads();
#pragma unroll 1
        for (int js = 0; js < 4; ++js) {
            f32x16 sc;
#pragma unroll
            for (int r = 0; r < 16; ++r) sc[r] = 0.f;
            const bf16_t* krow = Kg + (size_t)(t0 + 32 * js + qc) * 256;
#pragma unroll
            for (int ks = 0; ks < 4; ++ks) {
                bf16x8 a = *(const bf16x8*)(krow + ks * 16 + hh * 8);
                sc = __builtin_amdgcn_mfma_f32_32x32x16_bf16(a, qf[ks], sc, 0, 0, 0);
            }
#pragma unroll
            for (int g = 0; g < 4; ++g) {
                bf16x4 pk;
#pragma unroll
                for (int e = 0; e < 4; ++e) {
                    const int j = 32 * js + 8 * g + 4 * hh + e;
                    const int d = iq - j;
                    float wgt;
                    if (dir == 0) wgt = d >= 0 ? __builtin_amdgcn_exp2f(lg2 * (float)d) : 0.f;
                    else wgt = d < 0 ? __builtin_amdgcn_exp2f(lg2 * (float)(-d)) : 0.f;
                    pk[e] = (short)f2bf(sc[4 * g + e] * wgt);
                }
                *(bf16x4*)(P + iq * PLD + 32 * js + 8 * g + 4 * hh) = pk;
            }
        }
        __syncthreads();
        bf16x8 sf[2][2];
#pragma unroll
        for (int s = 0; s < 2; ++s)
#pragma unroll
            for (int j = 0; j < 8; ++j) { sf[0][s][j] = (short)f2bf(S0[8 * s + j]); sf[1][s][j] = (short)f2bf(S1[8 * s + j]); }
#pragma unroll 1
        for (int isub = 0; isub < 4; ++isub) {
            const int ii = 32 * isub + qc;
            const bf16_t* qr = Qg + (size_t)(t0 + ii) * 256;
            f32x16 o;
#pragma unroll
            for (int r = 0; r < 16; ++r) o[r] = 0.f;
#pragma unroll
            for (int sub = 0; sub < 2; ++sub)
#pragma unroll
                for (int s = 0; s < 2; ++s) {
                    const int dk0 = 32 * sub + 16 * s + 4 * hh;
                    bf16x4 lo = *(const bf16x4*)(qr + dk0), hi = *(const bf16x4*)(qr + dk0 + 8);
                    bf16x8 bq = bf16x8{lo[0], lo[1], lo[2], lo[3], hi[0], hi[1], hi[2], hi[3]};
                    o = __builtin_amdgcn_mfma_f32_32x32x16_bf16(sf[sub][s], bq, o, 0, 0, 0);
                }
            const float qd = dir == 0 ? __builtin_amdgcn_exp2f(lg2 * (float)(ii + 1)) : __builtin_amdgcn_exp2f(lg2 * (float)(128 - ii));
#pragma unroll
            for (int r = 0; r < 16; ++r) o[r] *= qd;
#pragma unroll
            for (int ks = 0; ks < 8; ++ks) {
                bf16x8 pf = *(const bf16x8*)(P + ii * PLD + 16 * ks + 8 * hh);
                o = __builtin_amdgcn_mfma_f32_32x32x16_bf16(vf[ks], pf, o, 0, 0, 0);
            }
            bf16_t* orow = outp + (size_t)(t0 + ii) * 512;
#pragma unroll
            for (int g = 0; g < 4; ++g) {
                bf16x4 pk;
#pragma unroll
                for (int e = 0; e < 4; ++e) pk[e] = (short)f2bf(o[4 * g + e]);
                *(bf16x4*)(orow + 8 * g + 4 * hh) = pk;
            }
        }
#pragma unroll
        for (int r = 0; r < 16; ++r) { S0[r] *= cdec; S1[r] *= cdec; }
#pragma unroll
        for (int ks = 0; ks < 8; ++ks) {
            bf16x8 vs;
#pragma unroll
            for (int e = 0; e < 8; ++e) {
                const int j = 16 * ks + 8 * hh + e;
                const float kd = dir == 0 ? __builtin_amdgcn_exp2f(lg2 * (float)(127 - j)) : __builtin_amdgcn_exp2f(lg2 * (float)j);
                vs[e] = (short)f2bf(bf2f((bf16_t)vf[ks][e]) * kd);
            }
            bf16x8 a0 = *(const bf16x8*)(KTg + (size_t)qc * TPB + t0 + 16 * ks + 8 * hh);
            bf16x8 a1 = *(const bf16x8*)(KTg + (size_t)(32 + qc) * TPB + t0 + 16 * ks + 8 * hh);
            S0 = __builtin_amdgcn_mfma_f32_32x32x16_bf16(a0, vs, S0, 0, 0, 0);
            S1 = __builtin_amdgcn_mfma_f32_32x32x16_bf16(a1, vs, S1, 0, 0, 0);
        }
    }
    __syncthreads();
}

DEVI void lru_walk(const Params& p, int l, int task, unsigned char* smem) {
    const int b = task >> 4, d = (task >> 3) & 1, blk = task & 7;
    const int tid = TIDX, lane = tid & 63, w = tid >> 6, ln = lane & 15, g = lane >> 4;
    bf16_t* Wt = (bf16_t*)smem;
    float* uw = (float*)(smem + 18432 + w * 4224);
    float* cpar = (float*)(smem + 35328);
    float* agg = (float*)(smem + 36608);
    __syncthreads();
    {
        const bf16_t* wsrc = WB(W_LRU + ((size_t)(l * 2 + d) * 8 + blk) * 8192);
        for (int c = tid; c < 128 * 8; c += 256) {
            const int n = c >> 3, kc = c & 7;
            *(bf16x8*)(Wt + n * 72 + kc * 8) = *(const bf16x8*)(wsrc + n * 64 + kc * 8);
        }
        if (tid < 64) {
            const int ch = blk * 64 + tid;
#pragma unroll
            for (int j = 0; j < 4; ++j) cpar[j * 64 + tid] = p.in[I_LCW][(l * 4 + j) * 512 + ch];
            cpar[256 + tid] = p.in[I_LCB][l * 512 + ch];
        }
    }
    __syncthreads();
    float ba[4], bx[4], sp[4], hc[4];
#pragma unroll
    for (int ct = 0; ct < 4; ++ct) {
        const int ch = blk * 64 + 16 * ct + ln;
        ba[ct] = p.in[I_LBA][(l * 2 + d) * 512 + ch];
        bx[ct] = p.in[I_LBX][(l * 2 + d) * 512 + ch];
        sp[ct] = log1pf(expf(-p.in[I_LLAM][(l * 2 + d) * 512 + ch]));
        hc[ct] = 0.f;
    }
    const bf16_t* X = CB(C_LX) + (size_t)b * TPB * 512 + blk * 64;
    bf16_t* outp = (d == 0 ? DB(D_LH0) : DB(D_LH1)) + (size_t)b * TPB * 512 + blk * 64;
    bf16x8 xr[2][4];
    float xm[4];
    {
        const int tok = proc_tok(d, 16 * w + ln);
        const int lo = tok < CTXL ? 0 : CTXL, hi = tok < CTXL ? CTXL : TPB;
#pragma unroll
        for (int ks = 0; ks < 2; ++ks)
#pragma unroll
            for (int j = 0; j < 4; ++j) {
                const int tt = tok - 2 + j;
                const int tc = tt < lo ? lo : (tt >= hi ? hi - 1 : tt);
                xr[ks][j] = *(const bf16x8*)(X + (size_t)tc * 512 + 32 * ks + 8 * g);
                xm[j] = (tt >= lo && tt < hi) ? 1.f : 0.f;
            }
    }
    for (int c = 0; c < 36; ++c) {
        bf16x8 af[2];
#pragma unroll
        for (int ks = 0; ks < 2; ++ks) {
            const int c0 = 32 * ks + 8 * g;
            float u8[8];
#pragma unroll
            for (int e = 0; e < 8; ++e) u8[e] = cpar[256 + c0 + e];
#pragma unroll
            for (int j = 0; j < 4; ++j)
#pragma unroll
                for (int e = 0; e < 8; ++e) u8[e] += (cpar[j * 64 + c0 + e] * xm[j]) * bf2f((bf16_t)xr[ks][j][e]);
#pragma unroll
            for (int e = 0; e < 8; ++e) { uw[ln * 65 + c0 + e] = u8[e]; af[ks][e] = (short)f2bf(u8[e]); }
        }
        if (c + 1 < 36) {
            const int tok = proc_tok(d, 64 * (c + 1) + 16 * w + ln);
            const int lo = tok < CTXL ? 0 : CTXL, hi = tok < CTXL ? CTXL : TPB;
#pragma unroll
            for (int ks = 0; ks < 2; ++ks)
#pragma unroll
                for (int j = 0; j < 4; ++j) {
                    const int tt = tok - 2 + j;
                    const int tc = tt < lo ? lo : (tt >= hi ? hi - 1 : tt);
                    xr[ks][j] = *(const bf16x8*)(X + (size_t)tc * 512 + 32 * ks + 8 * g);
                    xm[j] = (tt >= lo && tt < hi) ? 1.f : 0.f;
                }
        }
        __builtin_amdgcn_wave_barrier();
        f32x4 acc[8];
#pragma unroll
        for (int nt = 0; nt < 8; ++nt) acc[nt] = f32x4{0.f, 0.f, 0.f, 0.f};
#pragma unroll
        for (int ks = 0; ks < 2; ++ks)
#pragma unroll
            for (int nt = 0; nt < 8; ++nt) {
                bf16x8 bfr = *(const bf16x8*)(Wt + (16 * nt + ln) * 72 + 32 * ks + 8 * g);
                acc[nt] = __builtin_amdgcn_mfma_f32_16x16x32_bf16(af[ks], bfr, acc[nt], 0, 0, 0);
            }
        float A[4][4], B[4][4];
#pragma unroll
        for (int ct = 0; ct < 4; ++ct) {
            float pa = 1.f, pb = 0.f;
#pragma unroll
            for (int j = 0; j < 4; ++j) {
                const float r = fsig(acc[ct][j] + ba[ct]);
                const float ig = fsig(acc[4 + ct][j] + bx[ct]);
                const float la = -8.f * r * sp[ct];
                const float a = __expf(la);
                const float uu = uw[(4 * g + j) * 65 + 16 * ct + ln];
                const float bb = __builtin_amdgcn_sqrtf(fmaxf(1.f - a * a, 0.f)) * ig * uu;
                pb = a * pb + bb; pa = a * pa;
                A[ct][j] = pa; B[ct][j] = pb;
            }
            float ia = pa, ib = pb;
#pragma unroll
            for (int dd = 1; dd <= 2; dd <<= 1) {
                const float qa = __shfl_up(ia, 16 * dd), qb = __shfl_up(ib, 16 * dd);
                if (g >= dd) { ib = ia * qb + ib; ia = ia * qa; }
            }
            float ea = __shfl_up(ia, 16), eb = __shfl_up(ib, 16);
            if (g == 0) { ea = 1.f; eb = 0.f; }
#pragma unroll
            for (int j = 0; j < 4; ++j) { B[ct][j] = A[ct][j] * eb + B[ct][j]; A[ct][j] = A[ct][j] * ea; }
            if (g == 3) {
                float* ag = agg + (((c & 1) * 4 + w) * 64 + 16 * ct + ln) * 2;
                ag[0] = ia; ag[1] = ib;
            }
        }
        __syncthreads();
#pragma unroll
        for (int ct = 0; ct < 4; ++ct) {
            float hrun = hc[ct], hin = 0.f;
#pragma unroll
            for (int w2 = 0; w2 < 4; ++w2) {
                const float* ag = agg + (((c & 1) * 4 + w2) * 64 + 16 * ct + ln) * 2;
                if (w2 == w) hin = hrun;
                hrun = ag[0] * hrun + ag[1];
            }
            hc[ct] = hrun;
#pragma unroll
            for (int j = 0; j < 4; ++j) {
                const int tok2 = proc_tok(d, 64 * c + 16 * w + 4 * g + j);
                outp[(size_t)tok2 * 512 + 16 * ct + ln] = f2bf(A[ct][j] * hin + B[ct][j]);
            }
        }
    }
    __syncthreads();
}

DEVI void fin_tile(const Params& p, int l, int mq) {
    const int lane = TIDX & 63, w = TIDX >> 6;
    const int row0 = mt_of(mq, l != 0) * 128 + w * 32;
#pragma unroll 4
    for (int i = 0; i < 32; ++i) {
        const size_t o = (size_t)(row0 + i) * 512 + lane * 8;
        bf16x8 h0 = *(const bf16x8*)(DB(D_LH0) + o), h1 = *(const bf16x8*)(DB(D_LH1) + o), lg = *(const bf16x8*)(CB(C_LG) + o);
        bf16x8 oc;
#pragma unroll
        for (int e = 0; e < 8; ++e) oc[e] = (short)f2bf((bf2f((bf16_t)h0[e]) + bf2f((bf16_t)h1[e])) * gelu_tanh(bf2f((bf16_t)lg[e])));
        *(bf16x8*)(DB(D_LH0) + o) = oc;
    }
}

DEVI void phase_mix(const Params& p, int l, unsigned char* smem) {
    const int NLRU = 128, NRET = (l == 0 ? 576 : 512);
    const int NLAT = 1024, NCTX = (l == 0 ? 128 : 0);
    const int NFIN = (l == 0 ? 144 : 128);
    const int ntask = NLRU + NRET + 2 * NLAT + 2 * NCTX;
    int* depl = WSI(OFF_CNT) + 3072 + l * 16;
    const int ncvt = 3072;
    int cv = BIDX;
    int* ctr = WSI(OFF_CNT) + 128 + l;
    volatile int* nxt = (volatile int*)(smem + 65520);
    for (;;) {
        __syncthreads();
        if (TIDX == 0) *nxt = atomicAdd(ctr, 1);
        __syncthreads();
        const int task = *nxt;
        if (task >= ntask) break;
        if (cv < ncvt) { CvtJob j = get_moe_job(p, l, cv >> 10); if ((cv >> 10) < 2) cvt_tile256_fp8(j, cv & 1023, smem); else cvt_tile256(j, cv & 1023, smem); cv += gridDim.x; }
        if (task < NLRU) { lru_walk(p, l, task, smem); }
        else if (false) {
            const int mq = task - (ntask - NFIN);
            const int bq = mt_of(mq, l != 0) / 18;
            dep_wait(depl + bq, 16);
            fin_tile(p, l, mq);
        }
        else if (task >= NLRU + 2 * NLAT && task < NLRU + 2 * NLAT + NRET) {
            const int a = task - NLRU - 2 * NLAT;
            int b, h, m;
            if (l == 0) { b = a / 72; const int r = a % 72; h = r / 18; m = r % 18; }
            else { b = a >> 6; const int r = a & 63; h = r >> 4; m = 2 + (r & 15); }
            ret_out_task(p, l, b, h, m, smem);
        } else {
            int a = task < NLRU + 2 * NLAT ? task - NLRU : task - NLRU - NRET;
            int kind, b, hsel, tq0, nkeys;
            if (a < NLAT) { kind = 0; b = a >> 7; const int r = a & 127; hsel = r >> 4; tq0 = CTXL + (r & 15) * 128; nkeys = TPB; }
            else if (a < 2 * NLAT) { a -= NLAT; kind = 1; b = a >> 7; const int r = a & 127; hsel = r >> 6; tq0 = CTXL + (r & 63) * 32; nkeys = TPB; }
            else if (a < 2 * NLAT + NCTX) { a -= 2 * NLAT; kind = 0; b = a >> 4; const int r = a & 15; hsel = r >> 1; tq0 = (r & 1) * 128; nkeys = CTXL; }
            else { a -= 2 * NLAT + NCTX; kind = 1; b = a >> 4; const int r = a & 15; hsel = r >> 3; tq0 = (r & 7) * 32; nkeys = CTXL; }
            if (kind == 0) attn_task<96, true>(p, b, hsel, tq0, nkeys, smem);
            else attn_task<64, false>(p, b, hsel, tq0, nkeys, smem);
        }
    }
    for (; cv < ncvt; cv += gridDim.x) { CvtJob j = get_moe_job(p, l, cv >> 10); if ((cv >> 10) < 2) cvt_tile256_fp8(j, cv & 1023, smem); else cvt_tile256(j, cv & 1023, smem); }
}

DEVI void phase_fin(const Params& p, int l) {
    const int lane = TIDX & 63, w = TIDX >> 6;
    for (int row = BIDX * 4 + w; row < TT; row += gridDim.x * 4) {
        if (l == 1 && (row % TPB) < CTXL) continue;
        const size_t o = (size_t)row * 512 + lane * 8;
        bf16x8 h0 = *(const bf16x8*)(DB(D_LH0) + o), h1 = *(const bf16x8*)(DB(D_LH1) + o), lg = *(const bf16x8*)(CB(C_LG) + o);
        bf16x8 oc;
#pragma unroll
        for (int e = 0; e < 8; ++e) oc[e] = (short)f2bf((bf2f((bf16_t)h0[e]) + bf2f((bf16_t)h1[e])) * gelu_tanh(bf2f((bf16_t)lg[e])));
        *(bf16x8*)(DB(D_LH0) + o) = oc;
    }
}

template <int BN>
DEVI void merge_tile(const Params& p, int l, int mt, int nt, unsigned char* smem) {
    bf16_t* ct = (bf16_t*)smem;
    const int lane = TIDX & 63, wc = (TIDX >> 6) & 1;
    constexpr int NI = BN / 32;
    const int row0 = mt * 128;
    unsigned mp[4][NI][2];
#pragma unroll
    for (int mi = 0; mi < 4; ++mi)
#pragma unroll
        for (int ni = 0; ni < NI; ++ni) { mp[mi][ni][0] = 0u; mp[mi][ni][1] = 0u; }
#pragma unroll 1
    for (int n = 0; n < 4; ++n) {
        unsigned gp[4][NI][2];
        {
            f32x4 ag[4][NI];
            acc_zero<BN>(ag);
            gemm_core_fp8<false, BN>(ag, (const unsigned char*)HB, 2048, row0, (const unsigned char*)WB(W_MG + (size_t)l * 4096 * 1024) + (size_t)(n * 1024 + nt * BN) * 1024, 1024, 1024, smem);
            const float* bm = p.in[I_BMG] + l * 4096 + n * 1024 + nt * BN + wc * (BN / 2) + (lane & 15);
#pragma unroll
            for (int ni = 0; ni < NI; ++ni) {
                const float bias = bm[ni * 16];
#pragma unroll
                for (int mi = 0; mi < 4; ++mi) {
                    gp[mi][ni][0] = (unsigned)f2bf(fsig(ag[mi][ni][0] + bias)) | ((unsigned)f2bf(fsig(ag[mi][ni][1] + bias)) << 16);
                    gp[mi][ni][1] = (unsigned)f2bf(fsig(ag[mi][ni][2] + bias)) | ((unsigned)f2bf(fsig(ag[mi][ni][3] + bias)) << 16);
                }
            }
        }
        f32x4 ap[4][NI];
        acc_zero<BN>(ap);
        const bf16_t* yb = n == 0 ? DB(D_YA) : (n == 1 ? DB(D_OF) : (n == 2 ? DB(D_LH0) : DB(D_YD)));
        AOp A2{yb, 512, row0, nullptr};
        gemm_core<BN>(ap, A2, WB(W_BR + ((size_t)l * 4 + n) * 1024 * 512 + (size_t)(nt * BN) * 512), 512, 512, smem);
#pragma unroll
        for (int mi = 0; mi < 4; ++mi)
#pragma unroll
            for (int ni = 0; ni < NI; ++ni) {
                const float m0 = __uint_as_float(mp[mi][ni][0] << 16) + __uint_as_float(gp[mi][ni][0] << 16) * ap[mi][ni][0];
                const float m1 = __uint_as_float(mp[mi][ni][0] & 0xffff0000u) + __uint_as_float(gp[mi][ni][0] & 0xffff0000u) * ap[mi][ni][1];
                const float m2 = __uint_as_float(mp[mi][ni][1] << 16) + __uint_as_float(gp[mi][ni][1] << 16) * ap[mi][ni][2];
                const float m3 = __uint_as_float(mp[mi][ni][1] & 0xffff0000u) + __uint_as_float(gp[mi][ni][1] & 0xffff0000u) * ap[mi][ni][3];
                mp[mi][ni][0] = (unsigned)f2bf(m0) | ((unsigned)f2bf(m1) << 16);
                mp[mi][ni][1] = (unsigned)f2bf(m2) | ((unsigned)f2bf(m3) << 16);
            }
    }
    __syncthreads();
    {
        const int wid = TIDX >> 6, wr = wid >> 1;
#pragma unroll
        for (int mi = 0; mi < 4; ++mi)
#pragma unroll
            for (int ni = 0; ni < NI; ++ni) {
                bf16_t* cp = ct + (wr * 64 + mi * 16 + (lane >> 4) * 4) * CT_LD + wc * (BN / 2) + ni * 16 + (lane & 15);
                cp[0] = (bf16_t)(mp[mi][ni][0] & 0xffffu); cp[CT_LD] = (bf16_t)(mp[mi][ni][0] >> 16);
                cp[2 * CT_LD] = (bf16_t)(mp[mi][ni][1] & 0xffffu); cp[3 * CT_LD] = (bf16_t)(mp[mi][ni][1] >> 16);
            }
    }
    __syncthreads();
    ep_store_rows<BN>(ct, 0, CB(C_M) + nt * BN, 1024, row0);
}

DEVI void wout_tile(const Params& p, int l, int mt, int nt, unsigned char* smem) {
    bf16_t* ct = (bf16_t*)smem;
    const int row0 = mt * 128, b = mt / 18, t0 = (mt % 18) * 128;
    const bool isctx = (mt % 18) < 2;
    const int bi = isctx ? 8 : b;
    f32x4 acc[4][4];
    acc_zero<128>(acc);
    AOp A{CB(C_M), 1024, row0, nullptr};
    gemm_core<128>(acc, A, WB(W_OUT + (size_t)l * 1024 * 1024 + (size_t)nt * 128 * 1024), 1024, 1024, smem);
    __syncthreads();
    acc_to_ct<128>(acc, ct);
    __syncthreads();
    const float* gate = WSF(OFF_MOD) + (size_t)(l * 9 + bi) * 6144 + 2 * 1024 + nt * 128;
    for (int c = TIDX; c < 128 * 32; c += 256) {
        const int i = c >> 5, jc = c & 31;
        const int t = t0 + i;
        const float* xs;
        if (l == 0) xs = isctx ? p.in[I_CTX] + ((size_t)b * CTXL + t) * DM : p.in[I_X] + ((size_t)b * SEQL + (t - CTXL)) * DM;
        else xs = XCUR + (size_t)(row0 + i) * DM;
        float4 x4 = *(const float4*)(xs + nt * 128 + jc * 4);
        float4 g4 = *(const float4*)(gate + jc * 4);
        uint2 y = *(const uint2*)(ct + i * CT_LD + jc * 4);
        x4.x += g4.x * __uint_as_float(y.x << 16);
        x4.y += g4.y * __uint_as_float(y.x & 0xffff0000u);
        x4.z += g4.z * __uint_as_float(y.y << 16);
        x4.w += g4.w * __uint_as_float(y.y & 0xffff0000u);
        *(float4*)(XCUR + (size_t)(row0 + i) * DM + nt * 128 + jc * 4) = x4;
    }
}

DEVI void phase_merge_wout(const Params& p, int l, unsigned char* smem) {
    const int NL = 128 * 8, NC = (l == 0 ? 16 * 16 : 0), N5 = NL + NC, N6 = (l == 0 ? 144 : 128) * 8;
    int* ctr = WSI(OFF_CNT) + 132 + l;
    int* dep = WSI(OFF_CNT) + 256 + l * 160;
    for (;;) {
        const int task = fetch_task(ctr, smem);
        if (task >= N5 + N6) break;
        if (task < NL) {
            const int q = task >> 3, mt = (q >> 4) * 18 + 2 + (q & 15);
            merge_tile<128>(p, l, mt, task & 7, smem);
            dep_signal(dep + mt);
        } else if (task < N5) {
            const int t = task - NL, c = t >> 4, mt = (c >> 1) * 18 + (c & 1);
            merge_tile<64>(p, l, mt, t & 15, smem);
            dep_signal(dep + mt);
        } else {
            const int t6 = task - N5, q = t6 >> 3;
            const bool isl = q < 128;
            const int mt = isl ? (q >> 4) * 18 + 2 + (q & 15) : ((q - 128) >> 1) * 18 + ((q - 128) & 1);
            dep_wait(dep + mt, isl ? 8 : 16);
            wout_tile(p, l, mt, t6 & 7, smem);
        }
    }
}

DEVI void phase_route(const Params& p, int l, unsigned char* smem) {
    const int tid = TIDX, lane = tid & 63, w = tid >> 6, wr = w >> 1, wc = w & 1;
    float* lgt = (float*)smem;
    const float rbias = p.in[I_RB][lane];
    int* cnt = WSI(OFF_CNT) + l * 64;
    int* list = WSI(OFF_LIST);
    const int ntile = l == 0 ? 144 : 128;
    for (int q = BIDX; q < ntile; q += gridDim.x) {
        const int mt = mt_of(q, l != 0);
        const int row0 = mt * 128;
        f32x4 acc[4][2];
        acc_zero<64>(acc);
        AOp A{HB, 1024, row0, nullptr};
        gemm_core<64>(acc, A, WB(W_RT), 1024, 1024, smem);
        __syncthreads();
#pragma unroll
        for (int mi = 0; mi < 4; ++mi)
#pragma unroll
            for (int ni = 0; ni < 2; ++ni)
#pragma unroll
                for (int j = 0; j < 4; ++j)
                    lgt[(wr * 64 + mi * 16 + (lane >> 4) * 4 + j) * 68 + wc * 32 + ni * 16 + (lane & 15)] = acc[mi][ni][j];
        __syncthreads();
        int me0 = 0, me1 = 0; float ms0 = 0.f, ms1 = 0.f;
#pragma unroll 2
        for (int i = 0; i < 32; ++i) {
            const float lg = lgt[(w * 32 + i) * 68 + lane];
            const float score = sigmoidf_(lg);
            const float biased = score + rbias;
            float v1 = biased; int i1 = lane;
#pragma unroll
            for (int off = 1; off < 8; off <<= 1) {
                float ov = __shfl_xor(v1, off); int oi = __shfl_xor(i1, off);
                if (ov > v1 || (ov == v1 && oi < i1)) { v1 = ov; i1 = oi; }
            }
            float v2 = (lane == i1) ? -3.0e38f : biased; int i2 = lane;
#pragma unroll
            for (int off = 1; off < 8; off <<= 1) {
                float ov = __shfl_xor(v2, off); int oi = __shfl_xor(i2, off);
                if (ov > v2 || (ov == v2 && oi < i2)) { v2 = ov; i2 = oi; }
            }
            float gv = v1 + v2; int gi = lane >> 3;
#pragma unroll
            for (int off = 8; off < 64; off <<= 1) {
                float ov = __shfl_xor(gv, off); int oi = __shfl_xor(gi, off);
                if (ov > gv || (ov == gv && oi < gi)) { gv = ov; gi = oi; }
            }
            const int e0 = __shfl(i1, gi * 8), e1 = __shfl(i2, gi * 8);
            const float s0 = __shfl(score, e0), s1 = __shfl(score, e1);
            if (lane == i) { me0 = e0; me1 = e1; ms0 = s0; ms1 = s1; }
        }
        int* hist = (int*)(smem + 36864);
        int* base = hist + 64;
        if (tid < 64) hist[tid] = 0;
        __syncthreads();
        int r0 = 0, r1 = 0;
        if (lane < 32) { r0 = atomicAdd(&hist[me0], 1); r1 = atomicAdd(&hist[me1], 1); }
        __syncthreads();
        if (tid < 64) { const int hc = hist[tid]; base[tid] = hc ? atomicAdd(&cnt[tid], hc) : 0; }
        __syncthreads();
        if (lane < 32) {
            const int row = row0 + w * 32 + lane;
            Rec rc;
            rc.e0 = me0; rc.e1 = me1;
            rc.p0 = base[me0] + r0;
            rc.p1 = base[me1] + r1;
            const float inv = 1.f / (ms0 + ms1);
            rc.w0 = ms0 * inv; rc.w1 = ms1 * inv; rc.pad0 = 0; rc.pad1 = 0;
            list[(size_t)me0 * TT + rc.p0] = row;
            list[(size_t)me1 * TT + rc.p1] = row;
            ((Rec*)(p.ws + OFF_REC))[row] = rc;
        }
        __syncthreads();
    }
}

struct MoeGrp { int ne[8], sg[8], cn[8]; };
DEVI MoeGrp moe_grp(const MoeTab& mt, const GrpInfo& gi) {
    MoeGrp g;
#pragma unroll
    for (int q = 0; q < 8; ++q) {
        const int ee = gi.ngrp == 8 ? gi.xcd * 8 + q : 0;
        g.cn[q] = mt.cnt(ee); g.sg[q] = mt.seg(ee); g.ne[q] = (g.cn[q] + 127) >> 7;
    }
    return g;
}
DEVI bool moe_tile(const MoeTab& mt, const MoeGrp& mg, const GrpInfo& gi, int it, int NT, int& e, int& jt, int& nt, int& cn, int& sg) {
    int rem = gi.j + gi.per * it;
    if (gi.ngrp == 8) {
#pragma unroll
        for (int q = 0; q < 8; ++q) {
            const int ne = mg.ne[q] * NT;
            if (rem < ne) { e = gi.xcd * 8 + q; jt = rem / NT; nt = rem % NT; cn = mg.cn[q]; sg = mg.sg[q]; return true; }
            rem -= ne;
        }
        return false;
    }
    for (int ee = 0; ee < 64; ++ee) {
        const int c = mt.cnt(ee);
        const int ne = ((c + 127) >> 7) * NT;
        if (rem < ne) { e = ee; jt = rem / NT; nt = rem % NT; cn = c; sg = mt.seg(ee); return true; }
        rem -= ne;
    }
    return false;
}
struct MoeRegs { int tp, cnt, seg; };
DEVI void moe_find(const MoeRegs& mr, int rt, int& e, int& jt, int& cn, int& sg) {
    const unsigned long long m = __ballot(mr.tp <= rt);
    e = __popcll(m) - 1;
    jt = rt - __shfl(mr.tp, e); cn = __shfl(mr.cnt, e); sg = __shfl(mr.seg, e);
}
DEVI void phase_moe(const Params& p, int l, unsigned char* smem) {
    bf16_t* ct = (bf16_t*)smem;
    int* ridx = (int*)(smem + AUX_OFF);
    MoeTab mt = moe_tables(p, l, smem);
    const int* list = WSI(OFF_LIST);
    const int nrt = mt.tp(64);
    MoeRegs mr; mr.tp = mt.tp(TIDX & 63); mr.cnt = mt.cnt(TIDX & 63); mr.seg = mt.seg(TIDX & 63);
    int* ctr = WSI(OFF_CNT) + 136 + l;
    int* dep = WSI(OFF_CNT) + 1024 + l * 384;
    for (;;) {
        const int task = fetch_task(ctr, smem);
        if (task >= nrt * 12) break;
        if (task < nrt * 4) {
            const int rt = task >> 2, nt = task & 3;
            int e, jt, cn, sg;
            moe_find(mr, rt, e, jt, cn, sg);
            if (TIDX < 128) {
                const int idx = jt * 128 + TIDX;
                ridx[TIDX] = list[(size_t)e * TT + (idx < cn ? idx : 0)];
            }
            __syncthreads();
            f32x4 acc[4][4];
            acc_zero<128>(acc);
            gemm_core_fp8<true>(acc, (const unsigned char*)CB(0), 1024, 0, (const unsigned char*)MWB(MW_13) + ((size_t)e * 512 + nt * 128) * 1024, 1024, 1024, smem, ridx);
            __syncthreads();
            acc_to_ct<128>(acc, ct);
            __syncthreads();
            const int slot0 = sg + jt * 128;
            for (int c = TIDX; c < 128 * 8; c += 256) {
                const int i = c >> 3, jc = c & 7;
                bf16x8 a = *(const bf16x8*)(ct + i * CT_LD + jc * 8), g = *(const bf16x8*)(ct + i * CT_LD + 64 + jc * 8), o;
#pragma unroll
                for (int q = 0; q < 8; ++q) o[q] = (short)f2bf(siluf_(bf2f((bf16_t)a[q])) * bf2f((bf16_t)g[q]));
                *(bf16x8*)(DB(D_ACT) + (size_t)(slot0 + i) * 256 + nt * 64 + jc * 8) = o;
            }
            dep_signal(dep + rt);
        } else {
            const int t2 = task - nrt * 4;
            const int rt = t2 >> 3, nt = t2 & 7;
            int e, jt, cn, sg;
            moe_find(mr, rt, e, jt, cn, sg);
            const int slot0 = sg + jt * 128;
            dep_wait(dep + rt, 4);
            f32x4 acc[4][4];
            acc_zero<128>(acc);
            AOp A{DB(D_ACT), 256, slot0, nullptr};
            gemm_core<128>(acc, A, MWB(MW_2) + ((size_t)e * 1024 + nt * 128) * 256, 256, 256, smem);
            __syncthreads();
            acc_to_ct<128>(acc, ct);
            __syncthreads();
            ep_store_rows<128>(ct, 0, DB(D_YS) + nt * 128, 1024, slot0);
        }
    }
}

#define XB_TMO      128
#define XB_XCNT(j)  (256  + 64 * (j))
#define XB_XSUB(j)  (1280 + 64 * (j))
#define XB_XGEN(j)  (2304 + 64 * (j))
#define XB_TOP      3328
#define XB_TOPGEN   3392
#define XB_SPIN_CAP (1u << 22)
DEVI unsigned xb_ld(unsigned* p) { return __hip_atomic_load(p, __ATOMIC_RELAXED, __HIP_MEMORY_SCOPE_AGENT); }
DEVI unsigned xb_add(unsigned* p, unsigned v) { return __hip_atomic_fetch_add(p, v, __ATOMIC_RELAXED, __HIP_MEMORY_SCOPE_AGENT); }
DEVI unsigned xb_xcc_id() { return (unsigned)__builtin_amdgcn_s_getreg((3 << 11) | 20) & 0xFu; }
#define XB_SPIN(cond, bar) do { unsigned _sp = 0; while (cond) { __builtin_amdgcn_s_sleep(1); \
    if ((++_sp & 255u) == 0u) { if (xb_ld(&(bar)[XB_TMO])) break; if (_sp > XB_SPIN_CAP) { atomicAdd(&(bar)[XB_TMO], 1u); break; } } } } while (0)
struct XcdBarrier { unsigned* bar; unsigned x; unsigned* st; };
DEVI XcdBarrier xcd_barrier_post(unsigned* bar, unsigned* st) {
    XcdBarrier b; b.bar = bar; b.x = xb_xcc_id(); b.st = st;
    if (__builtin_amdgcn_workitem_id_x() == 0) (void)xb_add(&bar[XB_XCNT(b.x)], 1u);
    return b;
}
DEVI void xcd_barrier_complete(unsigned* bar, unsigned x, unsigned& nloc, unsigned& nx) {
    const unsigned G = gridDim.x * gridDim.y * gridDim.z;
    unsigned sum, cnt, mine, sp = 0u;
    for (;;) {
        sum = 0u; cnt = 0u; mine = 0u;
#pragma unroll
        for (unsigned j = 0; j < 16; ++j) { const unsigned c = xb_ld(&bar[XB_XCNT(j)]); sum += c; cnt += (c > 0u) ? 1u : 0u; mine = (j == x) ? c : mine; }
        if (sum == G) break;
        __builtin_amdgcn_s_sleep(1);
        if ((++sp & 255u) == 0u) { if (xb_ld(&bar[XB_TMO])) break; if (sp > XB_SPIN_CAP) { atomicAdd(&bar[XB_TMO], 1u); break; } }
    }
    nloc = mine > 0u ? mine : 1u; nx = cnt > 0u ? cnt : 1u;
}
DEVI void xcd_barrier(const XcdBarrier& b) {
    asm volatile("s_waitcnt vmcnt(0)" ::: "memory");
    __syncthreads();
    if (__builtin_amdgcn_workitem_id_x() == 0) {
        unsigned* bar = b.bar;
        __builtin_amdgcn_s_waitcnt(0);
        unsigned nloc = xb_ld(&b.st[0]), nx = xb_ld(&b.st[1]);
        if (nloc == 0u) { xcd_barrier_complete(bar, b.x, nloc, nx); __hip_atomic_store(&b.st[0], nloc, __ATOMIC_RELAXED, __HIP_MEMORY_SCOPE_AGENT); __hip_atomic_store(&b.st[1], nx, __ATOMIC_RELAXED, __HIP_MEMORY_SCOPE_AGENT); }
        const unsigned old = xb_add(&bar[XB_XSUB(b.x)], 1u);
        const unsigned gen = old / nloc;
        if (old + 1u == (gen + 1u) * nloc) {
            __builtin_amdgcn_fence(__ATOMIC_RELEASE, "agent");
            asm volatile("s_waitcnt vmcnt(0)" ::: "memory");
            const unsigned og = xb_add(&bar[XB_TOP], 1u);
            const unsigned tg = og / nx;
            if (og + 1u == (tg + 1u) * nx) xb_add(&bar[XB_TOPGEN], 1u);
            else XB_SPIN(xb_ld(&bar[XB_TOPGEN]) == tg, bar);
            __builtin_amdgcn_fence(__ATOMIC_ACQUIRE, "agent");
            xb_add(&bar[XB_XGEN(b.x)], 1u);
            asm volatile("s_waitcnt vmcnt(0)" ::: "memory");
        } else {
            XB_SPIN(xb_ld(&bar[XB_XGEN(b.x)]) == gen, bar);
            __builtin_amdgcn_fence(__ATOMIC_ACQUIRE, "agent");
            asm volatile("s_waitcnt vmcnt(0)" ::: "memory");
        }
    }
    __syncthreads();
}

constexpr int NPHASE = 24;
DEVI void run_phase(const Params& p, int ph, unsigned char* smem) {
#ifndef ONLYK
    if (ph == 0) { phase0(p, smem); return; }
    if (ph == 23) { phase_norm1(p, 1, 1, smem); return; }
#endif
    const int l = (ph - 1) / 11, k = (ph - 1) % 11;
#ifdef ONLYK
    if (k != ONLYK) return;
#endif
    switch (k) {
    case 0: phase_norm1(p, l, 0, smem); break;
    case 1: phase_win(p, l, smem); break;
    case 2: phase_mla_up(p, l, smem); break;
    case 3: phase_mix(p, l, smem); break;
    case 4: phase_fin(p, l); break;
    case 5: phase_merge_wout(p, l, smem); break;
    case 6: break;
    case 7: phase_norm1(p, l, 2, smem); break;
    case 8: phase_route(p, l, smem); break;
    case 9: phase_moe(p, l, smem); break;
    default: break;
    }
}

__global__ void __launch_bounds__(256, 2) k_main(Params p, int ph_lo, int ph_hi) {
    __shared__ __attribute__((aligned(16))) unsigned char smem[SMEM_BYTES];
    unsigned* xb_priv = (unsigned*)(p.ws + OFF_PRIV + (size_t)__builtin_amdgcn_workgroup_id_x() * 1024 + 896);
    if (__builtin_amdgcn_workitem_id_x() == 0) { __hip_atomic_store(xb_priv, 0u, __ATOMIC_RELAXED, __HIP_MEMORY_SCOPE_AGENT); __hip_atomic_store(xb_priv + 1, 0u, __ATOMIC_RELAXED, __HIP_MEMORY_SCOPE_AGENT); }
    XcdBarrier xb = xcd_barrier_post((unsigned*)(p.ws + OFF_BAR), xb_priv);
    if (__builtin_amdgcn_workitem_id_x() == 0) {
        const unsigned rk = xb_add((unsigned*)(p.ws + OFF_BAR) + 3456 + xb.x, 1u);
        __hip_atomic_store(xb_priv + 2, xb.x, __ATOMIC_RELAXED, __HIP_MEMORY_SCOPE_AGENT);
        __hip_atomic_store(xb_priv + 3, rk, __ATOMIC_RELAXED, __HIP_MEMORY_SCOPE_AGENT);
    }
    for (int ph = ph_lo; ph < ph_hi; ++ph) {
        if (ph >= 1 && ph <= 22 && (((ph - 1) % 11) == 6 || ((ph - 1) % 11) == 10)) continue;
        run_phase(p, ph, smem);
#ifdef DUPK
        if (ph >= 1 && ph <= 22 && ((ph - 1) % 11) == DUPK) run_phase(p, ph, smem);
        if (DUPK == 10 && ph == 0) run_phase(p, ph, smem);
#endif
        if (ph + 1 < ph_hi) {
            if (ph_hi < 0) cg::this_grid().sync();
            xcd_barrier(xb);
        }
    }
#ifdef TPROBE
    if (__builtin_amdgcn_workgroup_id_x() == 0 && __builtin_amdgcn_workitem_id_x() == 0) {
        const unsigned long long dt = __hip_atomic_load(T_SLOT(TPROBE), __ATOMIC_RELAXED, __HIP_MEMORY_SCOPE_AGENT) * TMULT;
        const unsigned long long t0 = __builtin_amdgcn_s_memrealtime();
        while (__builtin_amdgcn_s_memrealtime() - t0 < dt) __builtin_amdgcn_s_sleep(8);
    }
#endif
}

extern "C" void kernel_launch(void* const* d_in, const int* in_sizes, int n_in, void* d_out, int out_size, void* d_ws, size_t ws_size,
                              hipStream_t stream) {
    if (ws_size < WS_NEED || n_in < N_IN) { fprintf(stderr, "workspace too small: %zu < %zu\n", ws_size, (size_t)WS_NEED); return; }
    Params p{};
    for (int i = 0; i < N_IN; ++i) p.in[i] = (const float*)d_in[i];
    p.out = (float*)d_out;
    p.ws = (unsigned char*)d_ws;
    static int grid_blocks = 0;
    if (!grid_blocks) {
        int dev = 0, cus = 0, per_cu = 0;
        hipGetDevice(&dev);
        hipDeviceGetAttribute(&cus, hipDeviceAttributeMultiprocessorCount, dev);
        hipOccupancyMaxActiveBlocksPerMultiprocessor(&per_cu, k_main, 256, DYN_LDS);
        if (per_cu > 2) per_cu = 2;
        if (per_cu < 1) per_cu = 1;
        grid_blocks = cus * per_cu;
    }
    hipMemsetAsync(p.ws + OFF_BAR, 0, 16384, stream);
#if ONE_LAUNCH
    int lo = 0, hi = NPHASE;
    void* args[] = {&p, &lo, &hi};
    hipError_t e = hipLaunchCooperativeKernel((void*)k_main, dim3(grid_blocks), dim3(256), args, DYN_LDS, stream);
    if (e != hipSuccess) fprintf(stderr, "cooperative launch failed: %s (grid %d)\n", hipGetErrorString(e), grid_blocks);
#else
    for (int ph = 0; ph < NPHASE; ++ph) hipLaunchKernelGGL(k_main, dim3(grid_blocks), dim3(256), DYN_LDS, stream, p, ph, ph + 1);
#endif
}
```

```cpp
#include <hip/hip_runtime.h>
#include <hip/hip_cooperative_groups.h>
#include <stdint.h>
#include <stdio.h>
namespace cg = cooperative_groups;

#define DEVI __device__ __forceinline__
#define LAS __attribute__((address_space(3)))
typedef unsigned short bf16_t;
typedef __attribute__((ext_vector_type(8))) short bf16x8;
typedef __attribute__((ext_vector_type(4))) float f32x4;
typedef __attribute__((ext_vector_type(16))) float f32x16;
typedef __attribute__((ext_vector_type(4))) short bf16x4;

#ifndef NAIVE_GEMM
#define NAIVE_GEMM 0
#endif
#ifndef ONE_LAUNCH
#define ONE_LAUNCH 1
#endif

constexpr int DM = 1024, NBT = 8, SEQL = 2048, CTXL = 256, TPB = 2304, TT = 18432;
constexpr int DINP = 3840;
constexpr float LOG2E = 1.4426950408889634f;
constexpr float EPSV = 1e-6f;
constexpr int NSLOT = 2 * TT + 64 * 128;

enum { I_X = 0, I_C, I_CTX, I_CCTX, I_ADAW, I_ADAB, I_N1G, I_N2G, I_WIN, I_MQN, I_MKVN, I_WUQ, I_WUKV, I_RDEC, I_RNORM,
       I_LCW, I_LCB, I_LWA, I_LBA, I_LWX, I_LBX, I_LLAM, I_GQN, I_GKN, I_WBR, I_WMG, I_BMG, I_WOUT, I_RW, I_RB,
       I_W1, I_W3, I_W2, I_FN, N_IN };

constexpr size_t AL(size_t x) { return (x + 255) & ~(size_t)255; }
constexpr size_t OFF_BAR = 0;
__device__ unsigned g_bar[4096];
constexpr int XB_EXIT = 3900;
constexpr size_t OFF_CNT = 16384;
constexpr size_t OFF_MOD = OFF_CNT + 16384;
constexpr size_t OFF_R64 = AL(OFF_MOD + (size_t)2 * 9 * 6144 * 4);
constexpr size_t OFF_R32 = OFF_R64 + (size_t)2048 * 64 * 4;
constexpr size_t OFF_REC = OFF_R32 + (size_t)2048 * 32 * 4;
constexpr size_t OFF_LIST = OFF_REC + (size_t)TT * 32;
constexpr size_t OFF_PRIV = AL(OFF_LIST + (size_t)64 * TT * 4);
constexpr size_t OFF_W = OFF_PRIV + (size_t)2048 * 1024;
constexpr size_t W_IN = 0;
constexpr size_t W_UQ = W_IN + (size_t)2 * 3840 * 1024;
constexpr size_t W_UKV = W_UQ + (size_t)2 * 768 * 256;
constexpr size_t W_BR = W_UKV + (size_t)2 * 1024 * 128;
constexpr size_t W_MG = W_BR + (size_t)2 * 4 * 1024 * 512;
constexpr size_t W_OUT = W_MG + (size_t)2 * 4096 * 1024;
constexpr size_t W_LRU = W_OUT + (size_t)2 * 1024 * 1024;
constexpr size_t W_RT = W_LRU + (size_t)2 * 2 * 8 * 2 * 64 * 64;
constexpr size_t W_END = W_RT + (size_t)64 * 1024;
constexpr size_t OFF_XCUR = AL(OFF_W + W_END * 2);
constexpr size_t OFF_H = OFF_XCUR + (size_t)TT * 1024 * 4;
constexpr size_t OFF_C = OFF_H + (size_t)TT * 1024 * 2;
constexpr size_t C_CQ = 0;
constexpr size_t C_CKV = C_CQ + (size_t)TT * 256;
constexpr size_t C_KR = C_CKV + (size_t)TT * 128;
constexpr size_t C_MQ = C_KR + (size_t)TT * 32;
constexpr size_t C_KN = C_MQ + (size_t)TT * 768;
constexpr size_t C_VMT = C_KN + (size_t)TT * 512;
constexpr size_t C_RQ = C_VMT + (size_t)TT * 512;
constexpr size_t C_RK = C_RQ + (size_t)TT * 256;
constexpr size_t C_RKT = C_RK + (size_t)TT * 256;
constexpr size_t C_RVT = C_RKT + (size_t)TT * 256;
constexpr size_t C_RG = C_RVT + (size_t)TT * 512;
constexpr size_t C_LX = C_RG + (size_t)TT * 512;
constexpr size_t C_LG = C_LX + (size_t)TT * 512;
constexpr size_t C_GQ = C_LG + (size_t)TT * 512;
constexpr size_t C_GK = C_GQ + (size_t)TT * 512;
constexpr size_t C_GVT = C_GK + (size_t)TT * 128;
constexpr size_t C_END = C_GVT + (size_t)TT * 128;
constexpr size_t C_M = 0;
constexpr size_t C_W13 = (size_t)24 * 1024 * 1024;
constexpr size_t C_W2 = C_W13 + (size_t)64 * 512 * 1024;
static_assert(C_W2 + (size_t)64 * 1024 * 256 <= C_END, "moe alias");
static_assert((size_t)TT * 1024 <= C_W13, "m alias");
constexpr size_t OFF_D = OFF_C + C_END * 2;
constexpr size_t D_YA = 0;
constexpr size_t D_YD = (size_t)TT * 512;
constexpr size_t D_OF = (size_t)2 * TT * 512;
constexpr size_t D_OB = (size_t)3 * TT * 512;
constexpr size_t D_LH0 = (size_t)4 * TT * 512;
constexpr size_t D_LH1 = (size_t)5 * TT * 512;
constexpr size_t D_ACT = 0;
constexpr size_t D_YS = (size_t)12 * 1024 * 1024;
constexpr size_t D_END = D_YS + (size_t)NSLOT * 1024;
static_assert((size_t)NSLOT * 256 <= D_YS, "act alias");
static_assert((size_t)6 * TT * 512 <= D_END, "d size");
constexpr size_t OFF_MOEW = AL(OFF_D + D_END * 2);
constexpr size_t MW_13 = 0, MW_2 = (size_t)64 * 512 * 1024, MW_END = MW_2 + (size_t)64 * 1024 * 256;
constexpr size_t WS_NEED = OFF_MOEW + MW_END * 2;

struct Params {
    const float* in[N_IN];
    float* out;
    unsigned char* ws;
};

#define WSF(off) ((float*)(p.ws + (off)))
#define WSI(off) ((int*)(p.ws + (off)))
#define WB(el) ((bf16_t*)(p.ws + OFF_W) + (el))
#define CB(el) ((bf16_t*)(p.ws + OFF_C) + (el))
#define DB(el) ((bf16_t*)(p.ws + OFF_D) + (el))
#define MWB(el) ((bf16_t*)(p.ws + OFF_MOEW) + (el))
#define HB ((bf16_t*)(p.ws + OFF_H))
#define XCUR ((float*)(p.ws + OFF_XCUR))

constexpr int SMEM_BYTES = 81920;
constexpr int DYN_LDS = 0;
constexpr int CT_LD = 136;
constexpr int AUX_OFF = 36864;

#ifdef TPROBE
#define T_SLOT(id) ((unsigned long long*)((unsigned char*)g_bar + 14400) + (id))
#define T_BEGIN(id) const unsigned long long _tb##id = __builtin_amdgcn_s_memrealtime()
#define T_END(id, cond) do { if ((cond) && __builtin_amdgcn_workitem_id_x() == 0) atomicAdd(T_SLOT(id), __builtin_amdgcn_s_memrealtime() - _tb##id); } while (0)
#else
#define T_BEGIN(id)
#define T_END(id, cond)
#endif
DEVI int launder_tid() { int t = __builtin_amdgcn_workitem_id_x(); asm volatile("" : "+v"(t)); return t; }
DEVI int launder_bid() { int t = __builtin_amdgcn_workgroup_id_x(); asm volatile("" : "+s"(t)); return t; }
#define TIDX launder_tid()
#define BIDX launder_bid()
DEVI float bf2f(bf16_t v) { return __uint_as_float(((unsigned)v) << 16); }
DEVI bf16_t f2bf(float f) {
    __bf16 h = (__bf16)f;
    return __builtin_bit_cast(unsigned short, h);
}
typedef __attribute__((ext_vector_type(8))) int i32x8;
typedef __attribute__((ext_vector_type(4))) int i32x4;
DEVI float clamp8(float x) { return __builtin_amdgcn_fmed3f(x, -448.f, 448.f); }
DEVI int pk4_fp8(float a, float b, float c, float d) {
    int r = __builtin_amdgcn_cvt_pk_fp8_f32(clamp8(a), clamp8(b), 0, false);
    return __builtin_amdgcn_cvt_pk_fp8_f32(clamp8(c), clamp8(d), r, true);
}
DEVI float fsig(float x) { return __builtin_amdgcn_rcpf(1.f + __expf(-x)); }
DEVI float sigmoidf_(float x) { return 1.f / (1.f + __expf(-x)); }
DEVI float siluf_(float x) { return x / (1.f + __expf(-x)); }
DEVI float gelu_tanh(float x) {
    float u = 0.7978845608028654f * (x + 0.044715f * x * x * x);
    return 0.5f * x * (1.f + tanhf(u));
}
DEVI int dpp_xor1(int v) { return __builtin_amdgcn_update_dpp(0, v, 0xB1, 0xf, 0xf, false); }
DEVI float dpp_xor1(float v) { return __builtin_bit_cast(float, dpp_xor1(__builtin_bit_cast(int, v))); }
DEVI void wave_halves(float v, float& lo, float& hi) {
    const auto r = __builtin_amdgcn_permlane32_swap(__builtin_bit_cast(unsigned, v), __builtin_bit_cast(unsigned, v), false, false);
    lo = __builtin_bit_cast(float, (unsigned)r[0]); hi = __builtin_bit_cast(float, (unsigned)r[1]);
}
DEVI float wave_sum(float v) {
    int x = __builtin_bit_cast(int, v);
    v += __builtin_bit_cast(float, __builtin_amdgcn_update_dpp(0, x, 0xB1, 0xf, 0xf, false)); x = __builtin_bit_cast(int, v);
    v += __builtin_bit_cast(float, __builtin_amdgcn_update_dpp(0, x, 0x4E, 0xf, 0xf, false)); x = __builtin_bit_cast(int, v);
    v += __builtin_bit_cast(float, __builtin_amdgcn_update_dpp(0, x, 0x141, 0xf, 0xf, false)); x = __builtin_bit_cast(int, v);
    v += __builtin_bit_cast(float, __builtin_amdgcn_update_dpp(0, x, 0x140, 0xf, 0xf, false)); x = __builtin_bit_cast(int, v);
    const float r0 = __builtin_bit_cast(float, __builtin_amdgcn_readlane(x, 0)), r1 = __builtin_bit_cast(float, __builtin_amdgcn_readlane(x, 16));
    const float r2 = __builtin_bit_cast(float, __builtin_amdgcn_readlane(x, 32)), r3 = __builtin_bit_cast(float, __builtin_amdgcn_readlane(x, 48));
    return (r0 + r1) + (r2 + r3);
}
DEVI int mt_of(int q, bool latonly) { return latonly ? (q >> 4) * 18 + 2 + (q & 15) : q; }

struct CvtJob { const float* src; bf16_t* dst; const float* ks; int K, N, ldd, batch; size_t sbs, dbs; int mode; int lds, n0, wide; };
DEVI int cvt_rowmap(int mode, int n) {
    if (mode == 1) return n < 384 ? n : (n < 416 ? n - 384 + 3712 : n - 32);
    if (mode == 2) { int h = n / 96, j = n % 96; return j < 64 ? h * 64 + j : 512 + h * 32 + (j - 64); }
    if (mode == 3) return (n >> 6) * 128 + (n & 63);
    return n;
}
DEVI void cvt_tile(const CvtJob& j, int tile, float* lds) {
    const int tn = j.N / 32, tk = j.K / 64, per = tn * tk;
    const int bb = tile / per, r = tile % per, kt = r / tn, nt = r % tn;
    const float* s = j.src + (size_t)bb * j.sbs + (size_t)(kt * 64) * j.lds + j.n0 + nt * 32;
    const int tx = TIDX & 31, ty = TIDX >> 5;
#pragma unroll
    for (int i = 0; i < 8; ++i) {
        int k = ty + 8 * i;
        float v = s[(size_t)k * j.lds + tx];
        if (j.ks) v *= j.ks[kt * 64 + k];
        lds[k * 33 + tx] = v;
    }
    __syncthreads();
    bf16_t* d = j.dst + (size_t)bb * j.dbs;
#pragma unroll
    for (int i = 0; i < 4; ++i) {
        int n = ty + 8 * i, kk = tx * 2;
        unsigned lo = f2bf(lds[kk * 33 + n]), hi = f2bf(lds[(kk + 1) * 33 + n]);
        int row = cvt_rowmap(j.mode, j.n0 + nt * 32 + n);
        *(unsigned*)(d + (size_t)row * j.ldd + kt * 64 + kk) = lo | (hi << 16);
    }
    __syncthreads();
}

DEVI void cvt_tile256(const CvtJob& j, int tile, unsigned char* smem) {
    constexpr int NS = 68;
    bf16_t* T = (bf16_t*)smem;
    const int tn = j.N / 256, tk = j.K / 64, per = tn * tk;
    const int bb = tile / per, r = tile % per, kt = r / tn, nt = r % tn;
    const float* s = j.src + (size_t)bb * j.sbs + (size_t)(kt * 64) * j.lds + j.n0 + nt * 256;
    const int tid = TIDX, lane = tid & 63, w = tid >> 6;
    float4 v[16];
#pragma unroll
    for (int i = 0; i < 16; ++i) v[i] = *(const float4*)(s + (size_t)(w * 16 + i) * j.lds + lane * 4);
    if (j.ks) {
#pragma unroll
        for (int i = 0; i < 16; ++i) { const float sc = j.ks[kt * 64 + w * 16 + i]; v[i].x *= sc; v[i].y *= sc; v[i].z *= sc; v[i].w *= sc; }
    }
    __syncthreads();
#pragma unroll
    for (int h = 0; h < 2; ++h) {
        bf16x4 q0a, q0b, q1a, q1b, q2a, q2b, q3a, q3b;
#pragma unroll
        for (int e = 0; e < 4; ++e) {
            q0a[e] = (short)f2bf(v[h * 8 + e].x); q0b[e] = (short)f2bf(v[h * 8 + 4 + e].x);
            q1a[e] = (short)f2bf(v[h * 8 + e].y); q1b[e] = (short)f2bf(v[h * 8 + 4 + e].y);
            q2a[e] = (short)f2bf(v[h * 8 + e].z); q2b[e] = (short)f2bf(v[h * 8 + 4 + e].z);
            q3a[e] = (short)f2bf(v[h * 8 + e].w); q3b[e] = (short)f2bf(v[h * 8 + 4 + e].w);
        }
        bf16_t* tp = T + (lane * 4) * NS + w * 16 + h * 8;
        *(bf16x4*)(tp) = q0a; *(bf16x4*)(tp + 4) = q0b;
        *(bf16x4*)(tp + NS) = q1a; *(bf16x4*)(tp + NS + 4) = q1b;
        *(bf16x4*)(tp + 2 * NS) = q2a; *(bf16x4*)(tp + 2 * NS + 4) = q2b;
        *(bf16x4*)(tp + 3 * NS) = q3a; *(bf16x4*)(tp + 3 * NS + 4) = q3b;
    }
    __syncthreads();
    bf16_t* d = j.dst + (size_t)bb * j.dbs;
#pragma unroll
    for (int i = 0; i < 8; ++i) {
        const int c = tid + 256 * i, n = c >> 3, kc = c & 7;
        const bf16x4 lo = *(const bf16x4*)(T + n * NS + kc * 8), hi = *(const bf16x4*)(T + n * NS + kc * 8 + 4);
        const int row = cvt_rowmap(j.mode, j.n0 + nt * 256 + n);
        *(bf16x8*)(d + (size_t)row * j.ldd + kt * 64 + kc * 8) = bf16x8{lo[0], lo[1], lo[2], lo[3], hi[0], hi[1], hi[2], hi[3]};
    }
}
constexpr float Y8_SCALE = 1.f;
constexpr int Y8_E8M0 = 0x7f7f7f7f;
constexpr float W8_SCALE = 32.f;
DEVI void cvt_tile256_fp8(const CvtJob& j, int tile, unsigned char* smem) {
    constexpr int RS = 80;
    const int tn = j.N / 256, tk = j.K / 64, per = tn * tk;
    const int bb = tile / per, r = tile % per, kt = r / tn, nt = r % tn;
    const float* s = j.src + (size_t)bb * j.sbs + (size_t)(kt * 64) * j.lds + nt * 256;
    const int tid = TIDX, lane = tid & 63, w = tid >> 6;
    float4 v[16];
#pragma unroll
    for (int i = 0; i < 16; ++i) v[i] = *(const float4*)(s + (size_t)(w * 16 + i) * j.lds + lane * 4);
    __syncthreads();
    i32x4 q0, q1, q2, q3;
#pragma unroll
    for (int c = 0; c < 4; ++c) {
        q0[c] = pk4_fp8(v[4 * c].x * W8_SCALE, v[4 * c + 1].x * W8_SCALE, v[4 * c + 2].x * W8_SCALE, v[4 * c + 3].x * W8_SCALE);
        q1[c] = pk4_fp8(v[4 * c].y * W8_SCALE, v[4 * c + 1].y * W8_SCALE, v[4 * c + 2].y * W8_SCALE, v[4 * c + 3].y * W8_SCALE);
        q2[c] = pk4_fp8(v[4 * c].z * W8_SCALE, v[4 * c + 1].z * W8_SCALE, v[4 * c + 2].z * W8_SCALE, v[4 * c + 3].z * W8_SCALE);
        q3[c] = pk4_fp8(v[4 * c].w * W8_SCALE, v[4 * c + 1].w * W8_SCALE, v[4 * c + 2].w * W8_SCALE, v[4 * c + 3].w * W8_SCALE);
    }
    unsigned char* tp = smem + (lane * 4) * RS + w * 16;
    *(i32x4*)(tp) = q0; *(i32x4*)(tp + RS) = q1; *(i32x4*)(tp + 2 * RS) = q2; *(i32x4*)(tp + 3 * RS) = q3;
    __syncthreads();
    unsigned char* d = (unsigned char*)j.dst + (size_t)bb * j.dbs;
#pragma unroll
    for (int i = 0; i < 4; ++i) {
        const int c = tid + 256 * i, n = c >> 2, kc = c & 3;
        *(i32x4*)(d + (size_t)cvt_rowmap(j.mode, nt * 256 + n) * j.ldd + kt * 64 + kc * 16) = *(const i32x4*)(smem + n * RS + kc * 16);
    }
}
__constant__ const int CVT_TILES[10] = {224, 80, 12, 8, 128, 256, 64, 32, 32, 32};
constexpr int CVT_PER_LAYER = 224 + 80 + 12 + 8 + 128 + 256 + 64 + 32 + 32 + 32;
DEVI CvtJob get_job(const Params& p, int l, int k) {
    CvtJob j; j.ks = nullptr; j.batch = 1; j.sbs = 0; j.dbs = 0; j.mode = 0; j.n0 = 0; j.wide = 1;
    switch (k) {
    case 0: j.src = p.in[I_WIN] + (size_t)l * 1024 * 3744; j.dst = WB(W_IN + (size_t)l * 3840 * 1024); j.K = 1024; j.N = 3584; j.lds = 3744; j.ldd = 1024; j.mode = 1; break;
    case 1: j.src = p.in[I_WIN] + (size_t)l * 1024 * 3744; j.dst = WB(W_IN + (size_t)l * 3840 * 1024); j.K = 1024; j.N = 160; j.lds = 3744; j.n0 = 3584; j.ldd = 1024; j.mode = 1; j.wide = 0; break;
    case 2: j.src = p.in[I_WUQ] + (size_t)l * 256 * 768; j.dst = WB(W_UQ + (size_t)l * 768 * 256); j.K = 256; j.N = 768; j.lds = 768; j.ldd = 256; j.ks = p.in[I_MQN] + l * 256; j.mode = 2; break;
    case 3: j.src = p.in[I_WUKV] + (size_t)l * 128 * 1024; j.dst = WB(W_UKV + (size_t)l * 1024 * 128); j.K = 128; j.N = 1024; j.lds = 1024; j.ldd = 128; j.ks = p.in[I_MKVN] + l * 128; break;
    case 4: j.src = p.in[I_WBR] + (size_t)l * 4 * 512 * 1024; j.dst = WB(W_BR + (size_t)l * 4 * 1024 * 512); j.K = 512; j.N = 1024; j.lds = 1024; j.ldd = 512; j.batch = 4; j.sbs = 512 * 1024; j.dbs = 1024 * 512; break;
    case 5: j.src = p.in[I_WMG] + (size_t)l * 1024 * 4096; j.dst = WB(W_MG + (size_t)l * 4096 * 1024); j.K = 1024; j.N = 4096; j.lds = 4096; j.ldd = 1024; break;
    case 6: j.src = p.in[I_WOUT] + (size_t)l * 1024 * 1024; j.dst = WB(W_OUT + (size_t)l * 1024 * 1024); j.K = 1024; j.N = 1024; j.lds = 1024; j.ldd = 1024; break;
    case 7: j.src = p.in[I_LWA] + (size_t)l * 16 * 4096; j.dst = WB(W_LRU + (size_t)l * 16 * 8192); j.K = 64; j.N = 64; j.lds = 64; j.ldd = 64; j.batch = 16; j.sbs = 4096; j.dbs = 8192; j.wide = 0; break;
    case 8: j.src = p.in[I_LWX] + (size_t)l * 16 * 4096; j.dst = WB(W_LRU + (size_t)l * 16 * 8192 + 4096); j.K = 64; j.N = 64; j.lds = 64; j.ldd = 64; j.batch = 16; j.sbs = 4096; j.dbs = 8192; j.wide = 0; break;
    default: j.src = p.in[I_RW]; j.dst = WB(W_RT); j.K = 1024; j.N = 64; j.lds = 64; j.ldd = 1024; j.wide = 0; break;
    }
    return j;
}
DEVI CvtJob get_moe_job(const Params& p, int l, int k) {
    CvtJob j; j.ks = nullptr; j.batch = 64; j.sbs = 262144; j.n0 = 0; j.wide = 1;
    if (k == 0) { j.src = p.in[I_W1] + (size_t)l * 64 * 262144; j.dst = MWB(MW_13);     j.K = 1024; j.N = 256; j.lds = 256; j.ldd = 1024; j.dbs = 512 * 1024; j.mode = 3; }
    else if (k == 1) { j.src = p.in[I_W3] + (size_t)l * 64 * 262144; j.dst = (bf16_t*)((unsigned char*)MWB(MW_13) + 64 * 1024); j.K = 1024; j.N = 256; j.lds = 256; j.ldd = 1024; j.dbs = 512 * 1024; j.mode = 3; }
    else { j.src = p.in[I_W2] + (size_t)l * 64 * 262144; j.dst = MWB(MW_2); j.K = 256; j.N = 1024; j.lds = 1024; j.ldd = 256; j.dbs = 262144; j.mode = 0; }
    return j;
}

struct AOp { const bf16_t* base; int ld; int row0; const int* ridx; };
DEVI const bf16_t* arow(const AOp& a, int i) {
    int r = a.ridx ? a.ridx[i] : a.row0 + i;
    return a.base + (size_t)r * a.ld;
}

#if NAIVE_GEMM
template <int BN>
DEVI void gemm_core(f32x4 (&acc)[4][BN / 32], const AOp& A, const bf16_t* B, int ldb, int K, unsigned char* smem) {
    constexpr int NI = BN / 32;
    const int tid = TIDX, lane = tid & 63, wid = tid >> 6, wr = wid >> 1, wc = wid & 1;
    for (int k0 = 0; k0 < K; k0 += 8) {
        bf16x8 bv[NI];
#pragma unroll
        for (int ni = 0; ni < NI; ++ni) bv[ni] = *(const bf16x8*)(B + (size_t)(wc * (BN / 2) + ni * 16 + (lane & 15)) * ldb + k0);
#pragma unroll
        for (int mi = 0; mi < 4; ++mi)
#pragma unroll
            for (int j = 0; j < 4; ++j) {
                bf16x8 av = *(const bf16x8*)(arow(A, wr * 64 + mi * 16 + (lane >> 4) * 4 + j) + k0);
#pragma unroll
                for (int ni = 0; ni < NI; ++ni) {
                    float s = 0.f;
#pragma unroll
                    for (int e = 0; e < 8; ++e) s += bf2f((bf16_t)av[e]) * bf2f((bf16_t)bv[ni][e]);
                    acc[mi][ni][j] += s;
                }
            }
    }
}
#else
#define GAS __attribute__((address_space(1)))
template <int BN, bool GATHER = false>
DEVI void gemm_core(f32x4 (&acc)[4][BN / 32], const AOp& A, const bf16_t* B, int ldb, int K, unsigned char* smem) {
    constexpr int NI = BN / 32;
    constexpr int NBL = BN / 32;
    constexpr int STG = 32768;
    const int tid = TIDX, lane = tid & 63, wid = tid >> 6, wr = wid >> 1, wc = wid & 1;
    const int lr = tid >> 3;
    const int kc = (tid & 7) ^ (lr & 7);
    const bf16_t* ap[GATHER ? 4 : 1];
    if (GATHER) {
#pragma unroll
        for (int i = 0; i < (GATHER ? 4 : 1); ++i) ap[i] = arow(A, lr + 32 * i) + kc * 8;
    } else ap[0] = A.base + (size_t)(A.row0 + lr) * A.ld + kc * 8;
    const size_t astep = (size_t)32 * A.ld;
    const bf16_t* bp = B + (size_t)lr * ldb + kc * 8;
    const size_t bstep = (size_t)32 * ldb;
    LAS unsigned char* lA = (LAS unsigned char*)smem + tid * 16;
    LAS unsigned char* lB = lA + 16384;
    const int nk = K >> 6;
    const int arow_off = (wr * 64 + (lane & 15)) * 128;
    const int brow_off = 16384 + (wc * (BN / 2) + (lane & 15)) * 128;
    __syncthreads();
#pragma unroll
    for (int i = 0; i < 4; ++i) __builtin_amdgcn_global_load_lds((const GAS unsigned*)(GATHER ? ap[GATHER ? i : 0] : ap[0] + i * astep), (LAS unsigned*)(lA + i * 4096), 16, 0, 0);
#pragma unroll
    for (int i = 0; i < NBL; ++i) __builtin_amdgcn_global_load_lds((const GAS unsigned*)(bp + i * bstep), (LAS unsigned*)(lB + i * 4096), 16, 0, 0);
    for (int kt = 0; kt < nk; ++kt) {
        __syncthreads();
        if (kt + 1 < nk) {
            const int ko = (kt + 1) * 64;
            const int so = ((kt + 1) & 1) * STG;
#pragma unroll
            for (int i = 0; i < 4; ++i) __builtin_amdgcn_global_load_lds((const GAS unsigned*)((GATHER ? ap[GATHER ? i : 0] : ap[0] + i * astep) + ko), (LAS unsigned*)(lA + so + i * 4096), 16, 0, 0);
#pragma unroll
            for (int i = 0; i < NBL; ++i) __builtin_amdgcn_global_load_lds((const GAS unsigned*)(bp + i * bstep + ko), (LAS unsigned*)(lB + so + i * 4096), 16, 0, 0);
        }
        const unsigned char* cs = smem + (kt & 1) * STG;
#pragma unroll
        for (int ks = 0; ks < 2; ++ks) {
            const int pch = ((ks * 4 + (lane >> 4)) ^ (lane & 7)) << 4;
            bf16x8 bfr[NI];
#pragma unroll
            for (int ni = 0; ni < NI; ++ni) bfr[ni] = *(const bf16x8*)(cs + brow_off + ni * 2048 + pch);
#pragma unroll
            for (int mi = 0; mi < 4; mi += 2) {
                const bf16x8 a0 = *(const bf16x8*)(cs + arow_off + mi * 2048 + pch);
                const bf16x8 a1 = *(const bf16x8*)(cs + arow_off + (mi + 1) * 2048 + pch);
#pragma unroll
                for (int ni = 0; ni < NI; ++ni) acc[mi][ni] = __builtin_amdgcn_mfma_f32_16x16x32_bf16(a0, bfr[ni], acc[mi][ni], 0, 0, 0);
#pragma unroll
                for (int ni = 0; ni < NI; ++ni) acc[mi + 1][ni] = __builtin_amdgcn_mfma_f32_16x16x32_bf16(a1, bfr[ni], acc[mi + 1][ni], 0, 0, 0);
            }
        }
    }
}
#endif

DEVI void gemm_core256(f32x4 (&acc)[2][4][4], const bf16_t* Ab, int lda, int row0, const bf16_t* B, int ldb, int K, unsigned char* smem) {
    constexpr int STG = 24576;
    const int tid = TIDX, lane = tid & 63, wid = tid >> 6, wr = wid >> 1, wc = wid & 1;
    const int lr = tid >> 2;
    const int kc = (tid & 3) ^ ((tid >> 4) & 3);
    const bf16_t* ap = Ab + (size_t)(row0 + lr) * lda + kc * 8;
    const size_t astep = (size_t)64 * lda;
    const bf16_t* bp = B + (size_t)lr * ldb + kc * 8;
    const size_t bstep = (size_t)64 * ldb;
    LAS unsigned char* lA = (LAS unsigned char*)smem + tid * 16;
    LAS unsigned char* lB = lA + 16384;
    const int nk = K >> 5;
    const int pch = ((lane >> 4) ^ ((lane >> 2) & 3)) << 4;
    const int arow_off = (wr * 64 + (lane & 15)) * 64 + pch;
    const int brow_off = 16384 + (wc * 64 + (lane & 15)) * 64 + pch;
#pragma unroll
    for (int t = 0; t < 2; ++t) {
#pragma unroll
        for (int i = 0; i < 4; ++i) __builtin_amdgcn_global_load_lds((const GAS unsigned*)(ap + i * astep + t * 32), (LAS unsigned*)(lA + t * STG + i * 4096), 16, 0, 0);
#pragma unroll
        for (int i = 0; i < 2; ++i) __builtin_amdgcn_global_load_lds((const GAS unsigned*)(bp + i * bstep + t * 32), (LAS unsigned*)(lB + t * STG + i * 4096), 16, 0, 0);
    }
    int st = 0, st2 = 2 * STG;
#pragma unroll 1
    for (int kt = 0; kt < nk; ++kt) {
        if (kt + 1 < nk) asm volatile("s_waitcnt vmcnt(6)" ::: "memory"); else asm volatile("s_waitcnt vmcnt(0)" ::: "memory");
        __builtin_amdgcn_s_barrier();
        asm volatile("" ::: "memory");
        const unsigned char* cs = smem + st;
        bf16x8 bfr[4], afr[8];
#pragma unroll
        for (int ni = 0; ni < 4; ++ni) bfr[ni] = *(const bf16x8*)(cs + brow_off + ni * 1024);
#pragma unroll
        for (int m = 0; m < 8; ++m) afr[m] = *(const bf16x8*)(cs + arow_off + (m >> 2) * 8192 + (m & 3) * 1024);
        __builtin_amdgcn_sched_barrier(0);
        if (kt + 2 < nk) {
            const int ko = (kt + 2) * 32;
#pragma unroll
            for (int i = 0; i < 4; ++i) __builtin_amdgcn_global_load_lds((const GAS unsigned*)(ap + i * astep + ko), (LAS unsigned*)(lA + st2 + i * 4096), 16, 0, 0);
#pragma unroll
            for (int i = 0; i < 2; ++i) __builtin_amdgcn_global_load_lds((const GAS unsigned*)(bp + i * bstep + ko), (LAS unsigned*)(lB + st2 + i * 4096), 16, 0, 0);
        }
        __builtin_amdgcn_sched_barrier(0);
#pragma unroll
        for (int m = 0; m < 8; ++m)
#pragma unroll
            for (int ni = 0; ni < 4; ++ni) acc[m >> 2][m & 3][ni] = __builtin_amdgcn_mfma_f32_16x16x32_bf16(afr[m], bfr[ni], acc[m >> 2][m & 3][ni], 0, 0, 0);
        st = (st == 2 * STG) ? 0 : st + STG;
        st2 = (st2 == 2 * STG) ? 0 : st2 + STG;
    }
}

template <bool GATHER = false, int BN = 128>
DEVI void gemm_core_fp8(f32x4 (&acc)[4][BN / 32], const unsigned char* Ab, size_t lda, int row0, const unsigned char* Bb, size_t ldb, int K, unsigned char* smem, const int* ridx = nullptr, int sa = 0x7f7f7f7f, bool pre = false) {
    constexpr int STG = 32768;
    constexpr int NI = BN / 32;
    const int tid = TIDX, lane = tid & 63, wid = tid >> 6, wr = wid >> 1, wc = wid & 1;
    const int lr = tid >> 3;
    const int kc = (tid & 7) ^ (lr & 7);
    const unsigned char* ap[GATHER ? 4 : 1];
    if (GATHER) {
#pragma unroll
        for (int i = 0; i < (GATHER ? 4 : 1); ++i) ap[i] = Ab + (size_t)ridx[lr + 32 * i] * lda + kc * 16;
    } else ap[0] = Ab + (size_t)(row0 + lr) * lda + kc * 16;
    const size_t astep = GATHER ? 0 : 32 * lda;
    const unsigned char* bp = Bb + (size_t)lr * ldb + kc * 16;
    const size_t bstep = 32 * ldb;
    LAS unsigned char* lA = (LAS unsigned char*)smem + tid * 16;
    LAS unsigned char* lB = lA + 16384;
    const int nk = K >> 7;
    const int arow_off = (wr * 64 + (lane & 15)) * 128;
    const int brow_off = 16384 + (wc * (BN / 2) + (lane & 15)) * 128;
    const int c0 = ((2 * (lane >> 4)) ^ (lane & 7)) << 4, c1 = ((2 * (lane >> 4) + 1) ^ (lane & 7)) << 4;
    if (!pre) {
        __syncthreads();
#pragma unroll
        for (int i = 0; i < 4; ++i) __builtin_amdgcn_global_load_lds((const GAS unsigned*)(ap[GATHER ? i : 0] + i * astep), (LAS unsigned*)(lA + i * 4096), 16, 0, 0);
#pragma unroll
        for (int i = 0; i < NI; ++i) __builtin_amdgcn_global_load_lds((const GAS unsigned*)(bp + i * bstep), (LAS unsigned*)(lB + i * 4096), 16, 0, 0);
    }
#pragma unroll 1
    for (int kt = 0; kt < nk; ++kt) {
        __syncthreads();
        if (kt + 1 < nk) {
            const int ko = (kt + 1) * 128;
            const int so = ((kt + 1) & 1) * STG;
#pragma unroll
            for (int i = 0; i < 4; ++i) __builtin_amdgcn_global_load_lds((const GAS unsigned*)(ap[GATHER ? i : 0] + i * astep + ko), (LAS unsigned*)(lA + so + i * 4096), 16, 0, 0);
#pragma unroll
            for (int i = 0; i < NI; ++i) __builtin_amdgcn_global_load_lds((const GAS unsigned*)(bp + i * bstep + ko), (LAS unsigned*)(lB + so + i * 4096), 16, 0, 0);
        }
        const unsigned char* cs = smem + (kt & 1) * STG;
        i32x8 bfr[NI];
#pragma unroll
        for (int ni = 0; ni < NI; ++ni) {
            const i32x4 lo = *(const i32x4*)(cs + brow_off + ni * 2048 + c0), hi = *(const i32x4*)(cs + brow_off + ni * 2048 + c1);
            bfr[ni] = i32x8{lo[0], lo[1], lo[2], lo[3], hi[0], hi[1], hi[2], hi[3]};
        }
#pragma unroll
        for (int mi = 0; mi < 4; ++mi) {
            const i32x4 lo = *(const i32x4*)(cs + arow_off + mi * 2048 + c0), hi = *(const i32x4*)(cs + arow_off + mi * 2048 + c1);
            const i32x8 af = i32x8{lo[0], lo[1], lo[2], lo[3], hi[0], hi[1], hi[2], hi[3]};
#pragma unroll
            for (int ni = 0; ni < NI; ++ni)
                acc[mi][ni] = __builtin_amdgcn_mfma_scale_f32_16x16x128_f8f6f4(af, bfr[ni], acc[mi][ni], 0, 0, 0, sa, 0, 0x7a7a7a7a);
        }
    }
}

template <int BN>
DEVI void acc_zero(f32x4 (&acc)[4][BN / 32]) {
#pragma unroll
    for (int mi = 0; mi < 4; ++mi)
#pragma unroll
        for (int ni = 0; ni < BN / 32; ++ni) acc[mi][ni] = f32x4{0.f, 0.f, 0.f, 0.f};
}
template <int BN>
DEVI void acc_to_ct(const f32x4 (&acc)[4][BN / 32], bf16_t* ct) {
    const int tid = TIDX, lane = tid & 63, wid = tid >> 6, wr = wid >> 1, wc = wid & 1;
#pragma unroll
    for (int mi = 0; mi < 4; ++mi)
#pragma unroll
        for (int ni = 0; ni < BN / 32; ++ni)
#pragma unroll
            for (int j = 0; j < 4; ++j)
                ct[(wr * 64 + mi * 16 + (lane >> 4) * 4 + j) * CT_LD + wc * (BN / 2) + ni * 16 + (lane & 15)] = f2bf(acc[mi][ni][j]);
}

DEVI void acc_to_ctT(const f32x4 (&acc)[4][4], bf16_t* ct) {
    const int tid = TIDX, lane = tid & 63, wid = tid >> 6, wr = wid >> 1, wc = wid & 1;
#pragma unroll
    for (int mi = 0; mi < 4; ++mi)
#pragma unroll
        for (int ni = 0; ni < 4; ++ni) {
            bf16x4 v;
#pragma unroll
            for (int j = 0; j < 4; ++j) v[j] = (short)f2bf(acc[mi][ni][j]);
            *(bf16x4*)(ct + (wc * 64 + ni * 16 + (lane & 15)) * CT_LD + wr * 64 + mi * 16 + (lane >> 4) * 4) = v;
        }
}
template <int NC>
DEVI void ep_store_rows(const bf16_t* ct, int c0, bf16_t* dst, int ldd, int row0) {
    constexpr int CPR = NC / 8;
    for (int c = TIDX; c < 128 * CPR; c += 256) {
        int i = c / CPR, jc = c % CPR;
        *(bf16x8*)(dst + (size_t)(row0 + i) * ldd + jc * 8) = *(const bf16x8*)(ct + i * CT_LD + c0 + jc * 8);
    }
}
DEVI void ep_store_T(const bf16_t* ct, int c0, int nc, bf16_t* dstT, int ldT, int t0) {
    for (int c = TIDX; c < nc * 16; c += 256) {
        int j = c >> 4, ic = c & 15;
        bf16x8 v;
#pragma unroll
        for (int e = 0; e < 8; ++e) v[e] = (short)ct[(ic * 8 + e) * CT_LD + c0 + j];
        *(bf16x8*)(dstT + (size_t)j * ldT + t0 + ic * 8) = v;
    }
}
DEVI void ep_rope64(bf16_t* ct, const float* gain, float scale, bool lat, int pos0, const float* cs64) {
    const int row = TIDX >> 1, half = TIDX & 1;
    bf16_t* pr = ct + row * CT_LD + half * 64;
    float v[64];
#pragma unroll
    for (int c = 0; c < 8; ++c) {
        bf16x8 t = *(const bf16x8*)(pr + c * 8);
#pragma unroll
        for (int e = 0; e < 8; ++e) v[c * 8 + e] = bf2f((bf16_t)t[e]);
    }
    if (gain) {
        float ss = 0.f;
#pragma unroll
        for (int d = 0; d < 64; ++d) ss += v[d] * v[d];
        float rstd = rsqrtf(ss * (1.f / 64.f) + EPSV);
#pragma unroll
        for (int c = 0; c < 16; ++c) {
            const float4 g4 = *(const float4*)(gain + c * 4);
            v[c * 4] *= rstd * g4.x; v[c * 4 + 1] *= rstd * g4.y; v[c * 4 + 2] *= rstd * g4.z; v[c * 4 + 3] *= rstd * g4.w;
        }
    }
    if (lat) {
        const float* cs = cs64 + (size_t)(pos0 + row) * 64;
        float cw[64];
#pragma unroll
        for (int c = 0; c < 16; ++c) { const float4 t4 = *(const float4*)(cs + c * 4); cw[c * 4] = t4.x; cw[c * 4 + 1] = t4.y; cw[c * 4 + 2] = t4.z; cw[c * 4 + 3] = t4.w; }
#pragma unroll
        for (int i = 0; i < 16; ++i) {
            float a = v[i], b = v[i + 16], c = cw[i], sn = cw[32 + i];
            v[i] = a * c - b * sn; v[i + 16] = b * c + a * sn;
            a = v[32 + i]; b = v[48 + i]; c = cw[16 + i]; sn = cw[48 + i];
            v[32 + i] = a * c - b * sn; v[48 + i] = b * c + a * sn;
        }
    }
#pragma unroll
    for (int c = 0; c < 8; ++c) {
        bf16x8 t;
#pragma unroll
        for (int e = 0; e < 8; ++e) t[e] = (short)f2bf(v[c * 8 + e] * scale);
        *(bf16x8*)(pr + c * 8) = t;
    }
}
DEVI void ep_rope32(bf16_t* ct, int ngroups, const float* rstd, float scale, bool lat, int pos0, const float* cs32) {
    const int row = TIDX >> 1, half = TIDX & 1;
    const float rs = (rstd ? rstd[row] : 1.f) * scale;
#pragma unroll
    for (int gg = 0; gg < 2; ++gg) {
        const int g = half * 2 + gg;
        if (g < ngroups) {
            bf16_t* pr = ct + row * CT_LD + g * 32;
            float v[32];
#pragma unroll
            for (int c = 0; c < 4; ++c) {
                bf16x8 t = *(const bf16x8*)(pr + c * 8);
#pragma unroll
                for (int e = 0; e < 8; ++e) v[c * 8 + e] = bf2f((bf16_t)t[e]);
            }
            if (lat) {
                const float* cs = cs32 + (size_t)(pos0 + row) * 32;
#pragma unroll
                for (int i = 0; i < 8; ++i) {
                    float a = v[i], b = v[i + 8], c = cs[i], s = cs[16 + i];
                    v[i] = a * c - b * s; v[i + 8] = b * c + a * s;
                    a = v[16 + i]; b = v[24 + i]; c = cs[8 + i]; s = cs[24 + i];
                    v[16 + i] = a * c - b * s; v[24 + i] = b * c + a * s;
                }
            }
#pragma unroll
            for (int c = 0; c < 4; ++c) {
                bf16x8 t;
#pragma unroll
                for (int e = 0; e < 8; ++e) t[e] = (short)f2bf(v[c * 8 + e] * rs);
                *(bf16x8*)(pr + c * 8) = t;
            }
        }
    }
}
DEVI void ep_scale_rows(bf16_t* ct, int c0, int nc, const float* rstd, float scale) {
    const int cpr = nc / 8;
    for (int c = TIDX; c < 128 * cpr; c += 256) {
        int i = c / cpr, jc = c % cpr;
        bf16_t* pr = ct + i * CT_LD + c0 + jc * 8;
        bf16x8 t = *(const bf16x8*)pr;
        float rs = rstd[i] * scale;
#pragma unroll
        for (int e = 0; e < 8; ++e) t[e] = (short)f2bf(bf2f((bf16_t)t[e]) * rs);
        *(bf16x8*)pr = t;
    }
}
DEVI void ep_rstd(const bf16_t* A, int ld, int row0, int K, float* rstd) {
    const int row = TIDX >> 1, half = TIDX & 1;
    const bf16_t* pr = A + (size_t)(row0 + row) * ld + half * (K / 2);
    float ss = 0.f;
    for (int c = 0; c < K / 16; ++c) {
        bf16x8 t = *(const bf16x8*)(pr + c * 8);
#pragma unroll
        for (int e = 0; e < 8; ++e) { float f = bf2f((bf16_t)t[e]); ss += f * f; }
    }
    ss += dpp_xor1(ss);
    if (half == 0) rstd[row] = rsqrtf(ss / (float)K + EPSV);
}


struct GrpInfo { int xcd, j, per, ngrp; };
DEVI GrpInfo grp_info(const Params& p) {
    const unsigned* pv = (const unsigned*)(p.ws + OFF_PRIV + (size_t)BIDX * 1024 + 896);
    GrpInfo g;
    g.xcd = (int)__hip_atomic_load(pv + 2, __ATOMIC_RELAXED, __HIP_MEMORY_SCOPE_AGENT);
    g.j = (int)__hip_atomic_load(pv + 3, __ATOMIC_RELAXED, __HIP_MEMORY_SCOPE_AGENT);
    g.per = (int)__hip_atomic_load((const unsigned*)g_bar + 256 + 64 * g.xcd, __ATOMIC_RELAXED, __HIP_MEMORY_SCOPE_AGENT);
    g.ngrp = 8;
    if (g.xcd >= 8 || g.per <= 0) { g.xcd = 0; g.j = BIDX; g.per = gridDim.x; g.ngrp = 1; }
    return g;
}
DEVI bool super_tile(const GrpInfo& gi, int it, int NMT, int NNT, int SM, int SN, int& mt, int& nt) {
    const int ST = SM * SN, passes = (ST + gi.per - 1) / gi.per;
    const int nsn = (NNT + SN - 1) / SN, nsm = (NMT + SM - 1) / SM;
    const int s = (it / passes) * gi.ngrp + gi.xcd;
    if (s >= nsm * nsn) return false;
    const int idx = (it % passes) * gi.per + gi.j;
    mt = -1; nt = 0;
    if (idx < ST) {
        const int m = (s / nsn) * SM + idx / SN, n = (s % nsn) * SN + idx % SN;
        if (m < NMT && n < NNT) { mt = m; nt = n; }
    }
    return true;
}

DEVI void do_cvt_task(const Params& p, int l, int t, unsigned char* smem) {
    int k = 0;
    while (t >= CVT_TILES[k]) { t -= CVT_TILES[k]; ++k; }
    CvtJob j = get_job(p, l, k);
    if (k == 5 || k == 4) cvt_tile256_fp8(j, t, smem); else if (j.wide) cvt_tile256(j, t, smem); else cvt_tile(j, t, (float*)smem);
}
constexpr int CVT_L1_DEFER = CVT_PER_LAYER - 32;
DEVI void phase0(const Params& p, unsigned char* smem) {
    const int tid = TIDX, lane = tid & 63, w = tid >> 6;
    const int NG = 384, NCV = CVT_PER_LAYER, NR = 192;
    const int ntask = NG + NCV + NR + 1;
    const int bb = BIDX, G = gridDim.x, EX = 7;
    const int pre = G > NG ? ((G - NG) * EX < ntask - NG ? (G - NG) * EX : ntask - NG) : 0;
    int seq = 0, it = 0;
    for (;;) {
        int task;
        if (seq == 0) {
            task = bb + it * G; ++it;
            if (task >= NG) { seq = 1; it = 0; continue; }
        } else if (seq == 1) {
            if (bb < NG || it >= EX || (bb - NG) * EX + it >= pre) { seq = 2; it = 0; continue; }
            task = NG + (bb - NG) * EX + it; ++it;
        } else {
            task = NG + pre + bb + it * G; ++it;
            if (task >= ntask) break;
        }
        if (task < NG) {
            const int l = task / 192, n0 = (task % 192) * 32;
            float* sv = (float*)smem;
            float* red = (float*)smem;
            {
                float cvl[36];
#pragma unroll
                for (int it = 0; it < 36; ++it) {
                    const int bi = it >> 2, kk = (it & 3) * 64 + lane, k = 256 * w + kk;
                    cvl[it] = bi < 8 ? p.in[I_C][bi * 1024 + k] : p.in[I_CCTX][k];
                }
#pragma unroll
                for (int it = 0; it < 36; ++it) {
                    const int bi = it >> 2, kk = (it & 3) * 64 + lane;
                    sv[(w * 9 + bi) * 256 + kk] = siluf_(cvl[it]);
                }
            }
            __syncthreads();
            const int ksub = lane >> 3, c4 = (lane & 7) * 4;
            float acc[9][4];
#pragma unroll
            for (int bi = 0; bi < 9; ++bi) { acc[bi][0] = 0.f; acc[bi][1] = 0.f; acc[bi][2] = 0.f; acc[bi][3] = 0.f; }
            const float* wp = p.in[I_ADAW] + (size_t)l * 1024 * 6144 + (size_t)(256 * w + ksub) * 6144 + n0 + c4;
#pragma unroll 16
            for (int i = 0; i < 32; ++i) {
                const float4 wv = *(const float4*)(wp + (size_t)(8 * i) * 6144);
#pragma unroll
                for (int bi = 0; bi < 9; ++bi) {
                    const float sx = sv[(w * 9 + bi) * 256 + 8 * i + ksub];
                    acc[bi][0] += sx * wv.x; acc[bi][1] += sx * wv.y; acc[bi][2] += sx * wv.z; acc[bi][3] += sx * wv.w;
                }
            }
            __syncthreads();
#pragma unroll
            for (int bi = 0; bi < 9; ++bi)
                *(float4*)(red + (((w * 8 + ksub) * 9 + bi) * 32) + c4) = make_float4(acc[bi][0], acc[bi][1], acc[bi][2], acc[bi][3]);
            __syncthreads();
            for (int idx = tid; idx < 9 * 32; idx += 256) {
                int bi = idx >> 5, c = idx & 31;
                float sacc = p.in[I_ADAB][l * 6144 + n0 + c];
#pragma unroll
                for (int q = 0; q < 32; ++q) sacc += red[((q * 9 + bi) * 32) + c];
                WSF(OFF_MOD)[(size_t)(l * 9 + bi) * 6144 + n0 + c] = sacc;
            }
            __syncthreads();
        } else if (task < NG + NCV) {
            do_cvt_task(p, 0, task - NG, smem);
        } else if (task < NG + NCV + NR) {
            const int idx = (task - NG - NCV) * 256 + tid;
            const int pos = idx / 24, f = idx % 24;
            const float rp = (float)(pos >> 6), cp = (float)(pos & 63);
            if (f < 16) {
                const float inv = powf(10000.f, -(float)(2 * f) / 32.f);
                const float ar = rp * inv, ac = cp * inv;
                float* t64 = WSF(OFF_R64) + (size_t)pos * 64;
                t64[f] = cosf(ar); t64[16 + f] = cosf(ac); t64[32 + f] = sinf(ar); t64[48 + f] = sinf(ac);
            } else {
                const int i = f - 16;
                const float inv = powf(10000.f, -(float)(2 * i) / 16.f);
                const float ar = rp * inv, ac = cp * inv;
                float* t32 = WSF(OFF_R32) + (size_t)pos * 32;
                t32[i] = cosf(ar); t32[8 + i] = cosf(ac); t32[16 + i] = sinf(ar); t32[24 + i] = sinf(ac);
            }
        } else {
            for (int i = tid; i < 4096; i += 256) WSI(OFF_CNT)[i] = 0;
            for (int l = 0; l < 2; ++l) {
                unsigned* z = (unsigned*)WB(W_IN + (size_t)l * 3840 * 1024 + (size_t)3744 * 1024);
                for (int i = tid; i < 96 * 1024 / 2; i += 256) z[i] = 0u;
            }
        }
    }
}

struct MoeRegs { int tp, cnt, seg, nrt; };
DEVI MoeRegs moe_regs(const Params& p, int l) {
    const int lane = TIDX & 63;
    MoeRegs r;
    r.cnt = WSI(OFF_CNT)[l * 64 + lane];
    const int nt = (r.cnt + 127) >> 7;
    int inc = nt;
#pragma unroll
    for (int off = 1; off < 64; off <<= 1) { const int v = __builtin_amdgcn_ds_bpermute(((lane - off) & 63) << 2, inc); if (lane >= off) inc += v; }
    r.tp = inc - nt;
    r.seg = r.tp * 128;
    r.nrt = __builtin_amdgcn_readlane(inc, 63);
    return r;
}
struct Rec { int e0, p0, e1, p1; float w0, w1; int pad0, pad1; };

DEVI void phase_norm1(const Params& p, int l, int mode, unsigned char* smem) {
    const int lane = TIDX & 63, w = TIDX >> 6;
    const bool comb = (mode == 0 && l > 0) || mode == 1;
    const int lp = mode == 1 ? 1 : l - 1;
    int segv = 0;
    if (comb) segv = moe_regs(p, lp).seg;
    const float* g1 = mode == 1 ? p.in[I_FN] : (mode == 2 ? p.in[I_N2G] + l * 1024 : p.in[I_N1G] + l * 1024);
    const bool latonly = (mode == 1) || (mode == 2 && l == 1);
    const int nw = gridDim.x * 4, wv = BIDX * 4 + w;
    const int nunits = 2048 + (latonly ? 0 : 2048);
    float4 gv[4];
#pragma unroll
    for (int i = 0; i < 4; ++i) gv[i] = *(const float4*)(g1 + i * 256 + lane * 4);
    auto srcof = [&](int row) -> const float* {
        if (mode == 0 && l == 0) {
            const int b = row / TPB, t = row % TPB;
            return t < CTXL ? p.in[I_CTX] + ((size_t)b * CTXL + t) * DM : p.in[I_X] + ((size_t)b * SEQL + (t - CTXL)) * DM;
        }
        return XCUR + (size_t)row * DM;
    };
    for (int u = wv; u < nunits; u += nw) {
        int b, t0, nr, bi;
        if (u < 2048) { b = u >> 8; t0 = CTXL + (u & 255) * 8; nr = 8; bi = b; }
        else { const int c = u - 2048; b = c >> 8; t0 = c & 255; nr = 1; bi = 8; }
        const int rowbase = b * TPB + t0;
        float4 shv[4], scv[4], gtv[4];
#pragma unroll
        for (int i = 0; i < 4; ++i) { shv[i] = make_float4(0.f, 0.f, 0.f, 0.f); scv[i] = shv[i]; gtv[i] = shv[i]; }
        if (mode != 1) {
            const float* md = WSF(OFF_MOD) + (size_t)(l * 9 + bi) * 6144 + (mode == 2 ? 3 * 1024 : 0);
#pragma unroll
            for (int i = 0; i < 4; ++i) { shv[i] = *(const float4*)(md + i * 256 + lane * 4); scv[i] = *(const float4*)(md + 1024 + i * 256 + lane * 4); }
        }
        if (comb) {
            const float* gate = WSF(OFF_MOD) + (size_t)(lp * 9 + bi) * 6144 + 5 * 1024;
#pragma unroll
            for (int i = 0; i < 4; ++i) gtv[i] = *(const float4*)(gate + i * 256 + lane * 4);
        }
        float4 xn[4];
        Rec rcn; rcn.e0 = 0; rcn.e1 = 0; rcn.p0 = 0; rcn.p1 = 0; rcn.w0 = 0.f; rcn.w1 = 0.f;
        Rec rcn2 = rcn;
        uint2 yn0[4], yn1[4];
#pragma unroll
        for (int i = 0; i < 4; ++i) { yn0[i] = make_uint2(0u, 0u); yn1[i] = make_uint2(0u, 0u); }
        auto yload = [&](const Rec& r) {
            const bf16_t* y0 = DB(D_YS) + (size_t)(__builtin_amdgcn_ds_bpermute(r.e0 << 2, segv) + r.p0) * 1024;
            const bf16_t* y1 = DB(D_YS) + (size_t)(__builtin_amdgcn_ds_bpermute(r.e1 << 2, segv) + r.p1) * 1024;
#pragma unroll
            for (int i = 0; i < 4; ++i) { yn0[i] = *(const uint2*)(y0 + i * 256 + lane * 4); yn1[i] = *(const uint2*)(y1 + i * 256 + lane * 4); }
        };
        {
            const float* src = srcof(rowbase);
#pragma unroll
            for (int i = 0; i < 4; ++i) xn[i] = *(const float4*)(src + i * 256 + lane * 4);
            if (comb) {
                rcn = ((const Rec*)(p.ws + OFF_REC))[rowbase];
                if (nr > 1) rcn2 = ((const Rec*)(p.ws + OFF_REC))[rowbase + 1];
                yload(rcn);
            }
        }
        for (int k = 0; k < nr; ++k) {
            const int row = rowbase + k, t = t0 + k;
            float v[16];
#pragma unroll
            for (int i = 0; i < 4; ++i) { v[i * 4] = xn[i].x; v[i * 4 + 1] = xn[i].y; v[i * 4 + 2] = xn[i].z; v[i * 4 + 3] = xn[i].w; }
            const Rec rc = rcn;
            uint2 ya[4], yb[4];
#pragma unroll
            for (int i = 0; i < 4; ++i) { ya[i] = yn0[i]; yb[i] = yn1[i]; }
            if (k + 1 < nr) {
                if (comb) {
                    rcn = rcn2;
                    if (k + 2 < nr) rcn2 = ((const Rec*)(p.ws + OFF_REC))[row + 2];
                    yload(rcn);
                }
                const float* src = srcof(row + 1);
#pragma unroll
                for (int i = 0; i < 4; ++i) xn[i] = *(const float4*)(src + i * 256 + lane * 4);
            }
            if (comb) {
                float* xr = XCUR + (size_t)row * DM;
#pragma unroll
                for (int i = 0; i < 4; ++i) {
                    const int c = i * 256 + lane * 4;
                    const float4 g4 = gtv[i];
                    uint2 a = ya[i], bb = yb[i];
                    float f0 = rc.w0 * __uint_as_float(a.x << 16) + rc.w1 * __uint_as_float(bb.x << 16);
                    float f1 = rc.w0 * __uint_as_float(a.x & 0xffff0000u) + rc.w1 * __uint_as_float(bb.x & 0xffff0000u);
                    float f2 = rc.w0 * __uint_as_float(a.y << 16) + rc.w1 * __uint_as_float(bb.y << 16);
                    float f3 = rc.w0 * __uint_as_float(a.y & 0xffff0000u) + rc.w1 * __uint_as_float(bb.y & 0xffff0000u);
                    v[i * 4] += g4.x * f0; v[i * 4 + 1] += g4.y * f1; v[i * 4 + 2] += g4.z * f2; v[i * 4 + 3] += g4.w * f3;
                    if (mode == 0) *(float4*)(xr + c) = make_float4(v[i * 4], v[i * 4 + 1], v[i * 4 + 2], v[i * 4 + 3]);
                }
            }
            float ss = 0.f;
#pragma unroll
            for (int i = 0; i < 16; ++i) ss += v[i] * v[i];
            ss = wave_sum(ss);
            const float rstd = rsqrtf(ss * (1.f / 1024.f) + EPSV);
            if (mode == 1) {
                float* o = p.out + ((size_t)b * SEQL + (t - CTXL)) * DM;
#pragma unroll
                for (int i = 0; i < 4; ++i) {
                    const int c = i * 256 + lane * 4;
                    const float4 g4 = gv[i];
                    float4 r4;
                    r4.x = v[i * 4] * rstd * g4.x; r4.y = v[i * 4 + 1] * rstd * g4.y; r4.z = v[i * 4 + 2] * rstd * g4.z; r4.w = v[i * 4 + 3] * rstd * g4.w;
                    *(float4*)(o + c) = r4;
                }
            } else {
                bf16_t* ho = HB + (size_t)row * DM;
#pragma unroll
                for (int i = 0; i < 4; ++i) {
                    const int c = i * 256 + lane * 4;
                    const float4 g4 = gv[i], sh = shv[i], sc = scv[i];
                    float h0 = v[i * 4] * rstd * g4.x * (1.f + sc.x) + sh.x;
                    float h1 = v[i * 4 + 1] * rstd * g4.y * (1.f + sc.y) + sh.y;
                    float h2 = v[i * 4 + 2] * rstd * g4.z * (1.f + sc.z) + sh.z;
                    float h3 = v[i * 4 + 3] * rstd * g4.w * (1.f + sc.w) + sh.w;
                    uint2 o2;
                    o2.x = (unsigned)f2bf(h0) | ((unsigned)f2bf(h1) << 16);
                    o2.y = (unsigned)f2bf(h2) | ((unsigned)f2bf(h3) << 16);
                    *(uint2*)(ho + c) = o2;
                    if (mode == 2) *(int*)((unsigned char*)CB(0) + (size_t)row * 1024 + c) = pk4_fp8(h0, h1, h2, h3);
                }
            }
        }
    }
}

DEVI int fetch_task(int* ctr, unsigned char* smem) {
    __syncthreads();
    if (TIDX == 0) *(volatile int*)smem = atomicAdd(ctr, 1);
    __syncthreads();
    return *(volatile int*)smem;
}
DEVI void dep_signal(int* cnt) {
    asm volatile("s_waitcnt vmcnt(0)" ::: "memory");
    __syncthreads();
    if (TIDX == 0) {
        __builtin_amdgcn_fence(__ATOMIC_RELEASE, "agent");
        asm volatile("s_waitcnt vmcnt(0)" ::: "memory");
        __hip_atomic_fetch_add(cnt, 1, __ATOMIC_RELAXED, __HIP_MEMORY_SCOPE_AGENT);
    }
}
DEVI void dep_wait(int* cnt, int need) {
    if (TIDX == 0) {
        while (__hip_atomic_load(cnt, __ATOMIC_RELAXED, __HIP_MEMORY_SCOPE_AGENT) < need) __builtin_amdgcn_s_sleep(2);
        __builtin_amdgcn_fence(__ATOMIC_ACQUIRE, "agent");
        asm volatile("s_waitcnt vmcnt(0)" ::: "memory");
    }
    __syncthreads();
}

DEVI void win_epilogue(const Params& p, int l, int nt, bf16_t* ct, int row0, int b, int t0, bool lat, const float* cs64, const float* cs32) {
    const int pos0 = t0 - CTXL;
    if (nt < 2) ep_store_rows<128>(ct, 0, CB(C_CQ) + nt * 128, 256, row0);
    else if (nt == 2) ep_store_rows<128>(ct, 0, CB(C_CKV), 128, row0);
    else if (nt < 5) { ep_rope64(ct, nullptr, 1.f, lat, pos0, cs64); __syncthreads(); ep_store_rows<128>(ct, 0, CB(C_RQ) + (nt - 3) * 128, 256, row0); }
    else if (nt < 7) {
        ep_rope64(ct, nullptr, 0.125f, lat, pos0, cs64); __syncthreads();
        ep_store_rows<128>(ct, 0, CB(C_RK) + (nt - 5) * 128, 256, row0);
        ep_store_T(ct, 0, 128, CB(C_RKT) + ((size_t)b * 256 + (nt - 5) * 128) * TPB, TPB, t0);
    }
    else if (nt < 11) ep_store_rows<128>(ct, 0, CB(C_RVT) + ((size_t)b * 4 + (nt - 7)) * 128 * TPB + t0, TPB, 0);
    else if (nt < 15) ep_store_rows<128>(ct, 0, CB(C_RG) + (nt - 11) * 128, 512, row0);
    else if (nt < 19) ep_store_rows<128>(ct, 0, CB(C_LX) + (nt - 15) * 128, 512, row0);
    else if (nt < 23) ep_store_rows<128>(ct, 0, CB(C_LG) + (nt - 19) * 128, 512, row0);
    else if (nt < 27) { ep_rope64(ct, p.in[I_GQN] + l * 64, 0.125f * LOG2E, lat, pos0, cs64); __syncthreads(); ep_store_rows<128>(ct, 0, CB(C_GQ) + (nt - 23) * 128, 512, row0); }
    else if (nt == 27) { ep_rope64(ct, p.in[I_GKN] + l * 64, 1.f, lat, pos0, cs64); __syncthreads(); ep_store_rows<128>(ct, 0, CB(C_GK), 128, row0); }
    else if (nt == 28) ep_store_rows<128>(ct, 0, CB(C_GVT) + (size_t)b * 128 * TPB + t0, TPB, 0);
    else { ep_rope32(ct, 1, nullptr, 1.f, lat, pos0, cs32); __syncthreads(); ep_store_rows<32>(ct, 0, CB(C_KR), 32, row0); }
}
DEVI void phase_win(const Params& p, int l, unsigned char* smem) {
    bf16_t* ct = (bf16_t*)smem;
    const float* cs64 = WSF(OFF_R64);
    const float* cs32 = WSF(OFF_R32);
    int* ctr = WSI(OFF_CNT) + 134 + l;
    constexpr int NBIG = 68 * 30, NALL = NBIG + 8 * 30;
    for (;;) {
        const int task = fetch_task(ctr, smem);
        __syncthreads();
        if (task >= NALL) break;
        const bool big = task < NBIG;
        const int ts = big ? task : task - NBIG;
        const int nt = ts % 30;
        const int row0 = big ? (ts / 30) * 256 : (136 + ts / 30) * 128;
        const int b = row0 / TPB, t0 = row0 % TPB;
        const bool lat = t0 >= CTXL;
        const bool tonly = (nt >= 7 && nt < 11) || nt == 28;
        const bf16_t* Wt = WB(W_IN + (size_t)l * 3840 * 1024 + (size_t)nt * 128 * 1024);
        f32x4 acc[2][4][4];
        acc_zero<128>(acc[0]);
        if (big) {
            acc_zero<128>(acc[1]);
            T_BEGIN(3);
            gemm_core256(acc, HB, 1024, row0, Wt, 1024, 1024, smem);
            __syncthreads();
            T_END(3, l == 0 && BIDX == 8);
            if (tonly) { acc_to_ctT(acc[0], ct); acc_to_ctT(acc[1], ct + 128 * CT_LD); }
            else { acc_to_ct<128>(acc[0], ct); acc_to_ct<128>(acc[1], ct + 128 * CT_LD); }
        } else {
            AOp A{HB, 1024, row0, nullptr};
            gemm_core<128>(acc[0], A, Wt, 1024, 1024, smem);
            __syncthreads();
            if (tonly) acc_to_ctT(acc[0], ct); else acc_to_ct<128>(acc[0], ct);
        }
        __syncthreads();
        T_BEGIN(4);
        const int nh = big ? 2 : 1;
#pragma unroll 1
        for (int h = 0; h < nh; ++h)
            win_epilogue(p, l, nt, ct + h * 128 * CT_LD, row0 + 128 * h, b, t0 + 128 * h, lat, cs64, cs32);
        T_END(4, l == 0 && BIDX == 8);
    }
}

DEVI float ret_lg2(const Params& p, int l, int dir, int h) { return -log1pf(expf(-p.in[I_RDEC][l * 8 + dir * 4 + h])) * LOG2E; }
DEVI void ret_chunk_U(const Params& p, int l, int task) {
    const int b = task / 72, r = task % 72, h = r / 18, m = r % 18;
    const int tid = TIDX, lane = tid & 63, w = tid >> 6, qc = lane & 31, hh = lane >> 5;
    const int t0 = m * 128;
    const bf16_t* KTg = CB(C_RKT) + ((size_t)b * 4 + h) * 64 * TPB + t0 + 8 * hh;
    const bf16_t* VTg = CB(C_RVT) + (((size_t)b * 4 + h) * 128 + w * 32 + qc) * TPB + t0 + 8 * hh;
    bf16x8 vf[8];
#pragma unroll
    for (int ks = 0; ks < 8; ++ks) vf[ks] = *(const bf16x8*)(VTg + ks * 16);
#pragma unroll 1
    for (int sub = 0; sub < 2; ++sub) {
        bf16x8 ka[8];
#pragma unroll
        for (int ks = 0; ks < 8; ++ks) ka[ks] = *(const bf16x8*)(KTg + (size_t)(32 * sub + qc) * TPB + ks * 16);
#pragma unroll 1
        for (int dir = 0; dir < 2; ++dir) {
            const float lg2 = ret_lg2(p, l, dir, h);
            f32x16 U;
#pragma unroll
            for (int rr = 0; rr < 16; ++rr) U[rr] = 0.f;
#pragma unroll
            for (int ks = 0; ks < 8; ++ks) {
                bf16x8 vs;
#pragma unroll
                for (int e = 0; e < 8; ++e) {
                    const int j = 16 * ks + 8 * hh + e;
                    const float kd = __builtin_amdgcn_exp2f(lg2 * (float)(dir == 0 ? 127 - j : j));
                    vs[e] = (short)f2bf(bf2f((bf16_t)vf[ks][e]) * kd);
                }
                U = __builtin_amdgcn_mfma_f32_32x32x16_bf16(ka[ks], vs, U, 0, 0, 0);
            }
            bf16_t* up = DB(D_OB) + ((((size_t)(b * 4 + h) * 18 + m) * 2 + dir) * 128) * 64 + (size_t)(32 * w + qc) * 8 + 4 * hh;
#pragma unroll
            for (int g = 0; g < 4; ++g) {
                bf16x4 a;
#pragma unroll
                for (int e = 0; e < 4; ++e) a[e] = (short)f2bf(U[4 * g + e]);
                *(bf16x4*)(up + (((2 * sub + (g >> 1)) * 2 + (g & 1)) * 128) * 8) = a;
            }
        }
    }
}
DEVI void ret_out_task(const Params& p, int l, int b, int h, int m, unsigned char* smem) {
    constexpr int PLD = 136;
    bf16_t* P = (bf16_t*)smem;
    float* red = (float*)(smem + 34816);
    const int tid = TIDX, lane = tid & 63, w = tid >> 6, qc = lane & 31, hh = lane >> 5;
    const int t0 = m * 128, iq = 32 * w + qc;
    const float lgf = ret_lg2(p, l, 0, h), lgb = ret_lg2(p, l, 1, h);
    const float cdf = exp2f(lgf * 128.f), cdb = exp2f(lgb * 128.f);
    bf16x8 sff[4], sfb[4];
    {
        float Sf[4][8], Sb[4][8];
#pragma unroll
        for (int ks = 0; ks < 4; ++ks)
#pragma unroll
            for (int e = 0; e < 8; ++e) { Sf[ks][e] = 0.f; Sb[ks][e] = 0.f; }
        const bf16_t* Ub = DB(D_OB) + (size_t)(b * 4 + h) * 18 * 2 * 128 * 64 + (size_t)(hh * 128 + 32 * w + qc) * 8;
        const int pos = m < 2 ? 1 - m : 19 - m;
        const int nf4 = (m + 3) & ~3, nb4 = (pos + 3) & ~3;
        for (int c0 = 0; c0 < nf4; c0 += 4) {
            bf16x8 u[4][4]; float wg[4];
#pragma unroll
            for (int q = 0; q < 4; ++q) {
                const int c = c0 + q, cl = c < m ? c : 0;
                wg[q] = c < m ? __builtin_amdgcn_exp2f(lgf * 128.f * (float)(m - 1 - c)) : 0.f;
                const bf16_t* up = Ub + (size_t)(cl * 2 + 0) * 128 * 64;
#pragma unroll
                for (int ks = 0; ks < 4; ++ks) u[q][ks] = *(const bf16x8*)(up + ks * 2048);
            }
#pragma unroll
            for (int q = 0; q < 4; ++q)
#pragma unroll
                for (int ks = 0; ks < 4; ++ks)
#pragma unroll
                    for (int e = 0; e < 8; ++e) Sf[ks][e] += wg[q] * bf2f((bf16_t)u[q][ks][e]);
        }
        for (int c0 = 0; c0 < nb4; c0 += 4) {
            bf16x8 u[4][4]; float wg[4];
#pragma unroll
            for (int q = 0; q < 4; ++q) {
                const int cc = c0 + q, ccl = cc < pos ? cc : 0;
                const int c = ccl < 2 ? 1 - ccl : 19 - ccl;
                wg[q] = cc < pos ? __builtin_amdgcn_exp2f(lgb * 128.f * (float)(pos - 1 - cc)) : 0.f;
                const bf16_t* up = Ub + (size_t)(c * 2 + 1) * 128 * 64;
#pragma unroll
                for (int ks = 0; ks < 4; ++ks) u[q][ks] = *(const bf16x8*)(up + ks * 2048);
            }
#pragma unroll
            for (int q = 0; q < 4; ++q)
#pragma unroll
                for (int ks = 0; ks < 4; ++ks)
#pragma unroll
                    for (int e = 0; e < 8; ++e) Sb[ks][e] += wg[q] * bf2f((bf16_t)u[q][ks][e]);
        }
#pragma unroll
        for (int ks = 0; ks < 4; ++ks)
#pragma unroll
            for (int e = 0; e < 8; ++e) { sff[ks][e] = (short)f2bf(Sf[ks][e]); sfb[ks][e] = (short)f2bf(Sb[ks][e]); }
    }
    const bf16_t* Kg = CB(C_RK) + ((size_t)b * TPB + t0) * 256 + h * 64 + 8 * hh;
    const bf16_t* Qg = CB(C_RQ) + ((size_t)b * TPB + t0) * 256 + h * 64 + 8 * hh;
    const bf16_t* VTg = CB(C_RVT) + (((size_t)b * 4 + h) * 128 + w * 32 + qc) * TPB + t0 + 8 * hh;
    bf16x8 vf[8];
#pragma unroll
    for (int ks = 0; ks < 8; ++ks) vf[ks] = *(const bf16x8*)(VTg + ks * 16);
    {
        bf16x8 qf[4], ka[4][4];
#pragma unroll
        for (int ks = 0; ks < 4; ++ks) qf[ks] = *(const bf16x8*)(Qg + (size_t)iq * 256 + ks * 16);
#pragma unroll
        for (int js = 0; js < 4; ++js)
#pragma unroll
            for (int ks = 0; ks < 4; ++ks) ka[js][ks] = *(const bf16x8*)(Kg + (size_t)(32 * js + qc) * 256 + ks * 16);
        __syncthreads();
#pragma unroll
        for (int js = 0; js < 4; ++js) {
            f32x16 sc;
#pragma unroll
            for (int r = 0; r < 16; ++r) sc[r] = 0.f;
#pragma unroll
            for (int ks = 0; ks < 4; ++ks) sc = __builtin_amdgcn_mfma_f32_32x32x16_bf16(ka[js][ks], qf[ks], sc, 0, 0, 0);
#pragma unroll
            for (int g = 0; g < 4; ++g) {
                bf16x4 pk;
#pragma unroll
                for (int e = 0; e < 4; ++e) {
                    const int d = iq - (32 * js + 8 * g + 4 * hh + e);
                    const float wgt = d >= 0 ? __builtin_amdgcn_exp2f(lgf * (float)d) : __builtin_amdgcn_exp2f(lgb * (float)(-d));
                    pk[e] = (short)f2bf(sc[4 * g + e] * wgt);
                }
                *(bf16x4*)(P + iq * PLD + 32 * js + 8 * g + 4 * hh) = pk;
            }
        }
    }
    bf16x8 qa[4];
#pragma unroll
    for (int ks = 0; ks < 4; ++ks) qa[ks] = *(const bf16x8*)(Qg + (size_t)qc * 256 + ks * 16);
    __syncthreads();
    f32x16 o[4];
#pragma unroll
    for (int isub = 0; isub < 4; ++isub) {
        const int ii = 32 * isub + qc;
        bf16x8 qn[4];
        if (isub < 3) {
#pragma unroll
            for (int ks = 0; ks < 4; ++ks) qn[ks] = *(const bf16x8*)(Qg + (size_t)(ii + 32) * 256 + ks * 16);
        }
#pragma unroll
        for (int r = 0; r < 16; ++r) o[isub][r] = 0.f;
#pragma unroll
        for (int ks = 0; ks < 4; ++ks) o[isub] = __builtin_amdgcn_mfma_f32_32x32x16_bf16(sff[ks], qa[ks], o[isub], 0, 0, 0);
        const float qdf = __builtin_amdgcn_exp2f(lgf * (float)(ii + 1)), qdb = __builtin_amdgcn_exp2f(lgb * (float)(128 - ii));
        const float rat = qdf / qdb;
#pragma unroll
        for (int r = 0; r < 16; ++r) o[isub][r] *= rat;
#pragma unroll
        for (int ks = 0; ks < 4; ++ks) o[isub] = __builtin_amdgcn_mfma_f32_32x32x16_bf16(sfb[ks], qa[ks], o[isub], 0, 0, 0);
#pragma unroll
        for (int r = 0; r < 16; ++r) o[isub][r] *= qdb;
#pragma unroll
        for (int ks = 0; ks < 8; ++ks) {
            bf16x8 pf = *(const bf16x8*)(P + ii * PLD + 16 * ks + 8 * hh);
            o[isub] = __builtin_amdgcn_mfma_f32_32x32x16_bf16(vf[ks], pf, o[isub], 0, 0, 0);
        }
        float s1 = 0.f, s2 = 0.f;
#pragma unroll
        for (int r = 0; r < 16; ++r) { s1 += o[isub][r]; s2 += o[isub][r] * o[isub][r]; }
        { float lo, hi; wave_halves(s1, lo, hi); s1 = lo + hi; wave_halves(s2, lo, hi); s2 = lo + hi; }
        if (hh == 0) { red[(w * 128 + ii) * 2] = s1; red[(w * 128 + ii) * 2 + 1] = s2; }
        if (isub < 3) {
#pragma unroll
            for (int ks = 0; ks < 4; ++ks) qa[ks] = qn[ks];
        }
    }
    __syncthreads();
    const float* gn = p.in[I_RNORM] + l * 512 + h * 128 + 32 * w + 4 * hh;
    float gnv[16];
#pragma unroll
    for (int g = 0; g < 4; ++g)
#pragma unroll
        for (int e = 0; e < 4; ++e) gnv[4 * g + e] = gn[8 * g + e];
#pragma unroll
    for (int isub = 0; isub < 4; ++isub) {
        const int ii = 32 * isub + qc;
        float t1 = 0.f, t2 = 0.f;
#pragma unroll
        for (int ww = 0; ww < 4; ++ww) { t1 += red[(ww * 128 + ii) * 2]; t2 += red[(ww * 128 + ii) * 2 + 1]; }
        const float mu = t1 * (1.f / 128.f);
        const float rs = rsqrtf(fmaxf(t2 * (1.f / 128.f) - mu * mu, 0.f) + EPSV);
#pragma unroll
        for (int g = 0; g < 4; ++g) {
            bf16x4 ov;
#pragma unroll
            for (int e = 0; e < 4; ++e) ov[e] = (short)f2bf((o[isub][4 * g + e] - mu) * rs * gnv[4 * g + e]);
            *(bf16x4*)(P + ii * PLD + 32 * w + 8 * g + 4 * hh) = ov;
        }
    }
    __syncthreads();
#pragma unroll
    for (int k = 0; k < 8; ++k) {
        const int c = tid + 256 * k, row = c >> 4, ch = c & 15;
        const size_t ro = ((size_t)b * TPB + t0 + row) * 512 + h * 128 + ch * 8;
        const bf16x8 nv = *(const bf16x8*)(P + row * PLD + ch * 8);
        const bf16x8 gt = *(const bf16x8*)(CB(C_RG) + ro);
        float yv[8];
#pragma unroll
        for (int e = 0; e < 8; ++e) yv[e] = siluf_(bf2f((bf16_t)gt[e])) * bf2f((bf16_t)nv[e]) * Y8_SCALE;
        int2 o8; o8.x = pk4_fp8(yv[0], yv[1], yv[2], yv[3]); o8.y = pk4_fp8(yv[4], yv[5], yv[6], yv[7]);
        *(int2*)((unsigned char*)DB(D_OF) + ro) = o8;
    }
}

DEVI void h_to_fp8(const Params& p, int t32) {
    const int lane = TIDX & 63, w = TIDX >> 6;
    const size_t row0 = (size_t)t32 * 32 + w * 8;
    bf16x8 a[8], b[8];
#pragma unroll
    for (int i = 0; i < 8; ++i) {
        a[i] = *(const bf16x8*)(HB + (row0 + i) * 1024 + lane * 16);
        b[i] = *(const bf16x8*)(HB + (row0 + i) * 1024 + lane * 16 + 8);
    }
    asm volatile("s_waitcnt vmcnt(0)" ::: "memory");
#pragma unroll
    for (int i = 0; i < 8; ++i) {
        i32x4 o;
        o[0] = pk4_fp8(bf2f((bf16_t)a[i][0]), bf2f((bf16_t)a[i][1]), bf2f((bf16_t)a[i][2]), bf2f((bf16_t)a[i][3]));
        o[1] = pk4_fp8(bf2f((bf16_t)a[i][4]), bf2f((bf16_t)a[i][5]), bf2f((bf16_t)a[i][6]), bf2f((bf16_t)a[i][7]));
        o[2] = pk4_fp8(bf2f((bf16_t)b[i][0]), bf2f((bf16_t)b[i][1]), bf2f((bf16_t)b[i][2]), bf2f((bf16_t)b[i][3]));
        o[3] = pk4_fp8(bf2f((bf16_t)b[i][4]), bf2f((bf16_t)b[i][5]), bf2f((bf16_t)b[i][6]), bf2f((bf16_t)b[i][7]));
        *(i32x4*)((unsigned char*)HB + (row0 + i) * 2048 + lane * 16) = o;
    }
}
DEVI void phase_mla_up(const Params& p, int l, unsigned char* smem) {
    bf16_t* ct = (bf16_t*)smem;
    float* rstd = (float*)(smem + 71680);
    const float* cs32 = WSF(OFF_R32);
    const float qscale = 0.10206207261596575f * LOG2E;
    const int nq = (l == 0 ? 144 : 128) * 3;
    const int nkv = 144 * 4;
    for (int tile = BIDX; tile < nq + nkv + 576 + 576; tile += gridDim.x) {
        if (tile >= nq + nkv + 576) { h_to_fp8(p, tile - nq - nkv - 576); continue; }
        if (tile >= nq + nkv) { ret_chunk_U(p, l, tile - nq - nkv); continue; }
        f32x4 acc[2][4][4];
        acc_zero<128>(acc[0]); acc_zero<128>(acc[1]);
        __syncthreads();
        if (tile < nq) {
            const int mt = mt_of(tile / 3, l != 0), nt2 = tile % 3;
            const int row0 = mt * 128, t0 = (mt % 18) * 128;
            const bool lat = (mt % 18) >= 2;
            gemm_core256(acc, WB(W_UQ + (size_t)l * 768 * 256 + (size_t)nt2 * 256 * 256), 256, 0, CB(C_CQ) + (size_t)row0 * 256, 256, 256, smem);
            __syncthreads();
            acc_to_ctT(acc[0], ct); acc_to_ctT(acc[1], ct + 128 * CT_LD);
            ep_rstd(CB(C_CQ), 256, row0, 256, rstd);
            __syncthreads();
#pragma unroll 1
            for (int h = 0; h < 2; ++h) {
                bf16_t* cth = ct + h * 128 * CT_LD;
                const int nt = nt2 * 2 + h;
                if (nt < 4) {
                    ep_scale_rows(cth, 0, 128, rstd, qscale); __syncthreads();
                    ep_store_rows<64>(cth, 0, CB(C_MQ) + (nt * 2) * 96, 768, row0);
                    ep_store_rows<64>(cth, 64, CB(C_MQ) + (nt * 2 + 1) * 96, 768, row0);
                } else {
                    ep_rope32(cth, 4, rstd, qscale, lat, t0 - CTXL, cs32); __syncthreads();
#pragma unroll
                    for (int g = 0; g < 4; ++g) ep_store_rows<32>(cth, g * 32, CB(C_MQ) + ((nt - 4) * 4 + g) * 96 + 64, 768, row0);
                }
            }
        } else {
            const int tk = tile - nq;
            const int mt = tk / 4, nt2 = tk % 4;
            const int row0 = mt * 128, b = mt / 18, t0 = (mt % 18) * 128;
            gemm_core256(acc, WB(W_UKV + (size_t)l * 1024 * 128 + (size_t)nt2 * 256 * 128), 128, 0, CB(C_CKV) + (size_t)row0 * 128, 128, 128, smem);
            __syncthreads();
            acc_to_ctT(acc[0], ct); acc_to_ctT(acc[1], ct + 128 * CT_LD);
            ep_rstd(CB(C_CKV), 128, row0, 128, rstd);
            __syncthreads();
#pragma unroll 1
            for (int h = 0; h < 2; ++h) {
                bf16_t* cth = ct + h * 128 * CT_LD;
                const int nt = nt2 * 2 + h;
                ep_scale_rows(cth, 0, 128, rstd, 1.f); __syncthreads();
                ep_store_rows<64>(cth, 0, CB(C_KN) + nt * 64, 512, row0);
                ep_store_T(cth, 64, 64, CB(C_VMT) + ((size_t)b * 8 + nt) * 64 * TPB, TPB, t0);
            }
        }
    }
}

template <int DK, bool MLA>
DEVI void attn_naive_wave(const Params& p, int b, int t0, int hq) {
    const int lane = TIDX & 63;
    const int t = t0 + lane, row = b * TPB + t;
    const int nkeys = (t0 < CTXL) ? CTXL : TPB;
    float q[DK];
    const bf16_t* qp = MLA ? CB(C_MQ) + (size_t)row * 768 + hq * 96 : CB(C_GQ) + (size_t)row * 512 + hq * 64;
#pragma unroll
    for (int c = 0; c < DK / 8; ++c) {
        bf16x8 tq = *(const bf16x8*)(qp + c * 8);
#pragma unroll
        for (int e = 0; e < 8; ++e) q[c * 8 + e] = bf2f((bf16_t)tq[e]);
    }
    float acc[64];
#pragma unroll
    for (int d = 0; d < 64; ++d) acc[d] = 0.f;
    float m = -1e30f, lsum = 0.f;
    const int hk = MLA ? hq : (hq >> 2);
    const bf16_t* vT = MLA ? CB(C_VMT) + ((size_t)b * 8 + hk) * 64 * TPB : CB(C_GVT) + ((size_t)b * 2 + hk) * 64 * TPB;
    for (int kt = 0; kt < nkeys; ++kt) {
        const size_t krow = (size_t)b * TPB + kt;
        float s = 0.f;
        const bf16_t* kp = MLA ? CB(C_KN) + krow * 512 + hk * 64 : CB(C_GK) + krow * 128 + hk * 64;
#pragma unroll
        for (int c = 0; c < 8; ++c) {
            bf16x8 tk = *(const bf16x8*)(kp + c * 8);
#pragma unroll
            for (int e = 0; e < 8; ++e) s += q[c * 8 + e] * bf2f((bf16_t)tk[e]);
        }
        if (MLA) {
            const bf16_t* rp = CB(C_KR) + krow * 32;
#pragma unroll
            for (int c = 0; c < 4; ++c) {
                bf16x8 tk = *(const bf16x8*)(rp + c * 8);
#pragma unroll
                for (int e = 0; e < 8; ++e) s += q[(DK - 32) + c * 8 + e] * bf2f((bf16_t)tk[e]);
            }
        }
        const float mn = fmaxf(m, s);
        const float alpha = exp2f(m - mn), pp = exp2f(s - mn);
        lsum = lsum * alpha + pp;
#pragma unroll
        for (int d = 0; d < 64; ++d) acc[d] = acc[d] * alpha + pp * bf2f(vT[(size_t)d * TPB + kt]);
        m = mn;
    }
    const float inv = 1.f / lsum;
    bf16_t* op = (MLA ? DB(D_YA) : DB(D_YD)) + (size_t)row * 512 + hq * 64;
#pragma unroll
    for (int c = 0; c < 8; ++c) {
        bf16x8 o;
#pragma unroll
        for (int e = 0; e < 8; ++e) o[e] = (short)f2bf(acc[c * 8 + e] * inv);
        *(bf16x8*)(op + c * 8) = o;
    }
}


template <int DK, bool MLA>
DEVI void attn_task(const Params& p, int b, int hsel, int tq0, int nkeys, unsigned char* smem) {
    constexpr int KLD = DK + 8;
    constexpr int CK = DK / 8;
    constexpr int NKC = 64 * CK / 256;
    constexpr int VLD = 68;
    constexpr int KBYTES = 64 * KLD * 2, VBYTES = 64 * VLD * 2;
    constexpr int VOFF = 2 * KBYTES;
    static_assert(2 * (KBYTES + VBYTES) <= 60000, "attn lds");
    const int tid = TIDX, lane = tid & 63, w = tid >> 6, qc = lane & 31, hh = lane >> 5;
    const int tq = MLA ? tq0 + w * 32 + qc : tq0 + qc;
    const int hq = MLA ? hsel : hsel * 4 + w;
    const size_t qrow = (size_t)b * TPB + tq;
    const bf16_t* qp = MLA ? CB(C_MQ) + qrow * 768 + hq * 96 : CB(C_GQ) + qrow * 512 + hq * 64;
    bf16x8 qf[DK / 16];
#pragma unroll
    for (int ks = 0; ks < DK / 16; ++ks) qf[ks] = *(const bf16x8*)(qp + ks * 16 + hh * 8);
    const bf16_t* ksrc[NKC]; int kstep[NKC], kdst[NKC];
#pragma unroll
    for (int i = 0; i < NKC; ++i) {
        const int q = tid + 256 * i, key = q / CK, ch = q % CK;
        if (MLA) {
            if (ch < 8) { ksrc[i] = CB(C_KN) + ((size_t)b * TPB + key) * 512 + hsel * 64 + ch * 8; kstep[i] = 64 * 512; }
            else { ksrc[i] = CB(C_KR) + ((size_t)b * TPB + key) * 32 + (ch - 8) * 8; kstep[i] = 64 * 32; }
        } else { ksrc[i] = CB(C_GK) + ((size_t)b * TPB + key) * 128 + hsel * 64 + ch * 8; kstep[i] = 64 * 128; }
        kdst[i] = (key * KLD + ch * 8) * 2;
    }
    const bf16_t* vT = MLA ? CB(C_VMT) + ((size_t)b * 8 + hsel) * 64 * TPB : CB(C_GVT) + ((size_t)b * 2 + hsel) * 64 * TPB;
    const bf16_t* vsrc[2]; int vdst[2];
#pragma unroll
    for (int i = 0; i < 2; ++i) {
        const int q = tid + 256 * i, dv = q >> 3, ch = q & 7;
        vsrc[i] = vT + (size_t)dv * TPB + ch * 8;
        vdst[i] = VOFF + (dv * VLD + ch * 8) * 2;
    }
    const int nt = nkeys >> 6;
    bf16x8 kr[NKC], vr[2];
#pragma unroll
    for (int i = 0; i < NKC; ++i) kr[i] = *(const bf16x8*)(ksrc[i]);
#pragma unroll
    for (int i = 0; i < 2; ++i) vr[i] = *(const bf16x8*)(vsrc[i]);
    __syncthreads();
#pragma unroll
    for (int i = 0; i < NKC; ++i) *(bf16x8*)(smem + kdst[i]) = kr[i];
#pragma unroll
    for (int i = 0; i < 2; ++i) {
        *(bf16x4*)(smem + vdst[i]) = bf16x4{vr[i][0], vr[i][1], vr[i][2], vr[i][3]};
        *(bf16x4*)(smem + vdst[i] + 8) = bf16x4{vr[i][4], vr[i][5], vr[i][6], vr[i][7]};
    }
#pragma unroll
    for (int i = 0; i < NKC; ++i) kr[i] = *(const bf16x8*)(ksrc[i] + (size_t)kstep[i]);
    __syncthreads();
    f32x16 s0, s1;
#pragma unroll
    for (int r = 0; r < 16; ++r) { s0[r] = 0.f; s1[r] = 0.f; }
#pragma unroll
    for (int ks = 0; ks < DK / 16; ++ks) {
        bf16x8 a0 = *(const bf16x8*)(smem + (qc * KLD + ks * 16 + hh * 8) * 2);
        bf16x8 a1 = *(const bf16x8*)(smem + ((32 + qc) * KLD + ks * 16 + hh * 8) * 2);
        s0 = __builtin_amdgcn_mfma_f32_32x32x16_bf16(a0, qf[ks], s0, 0, 0, 0);
        s1 = __builtin_amdgcn_mfma_f32_32x32x16_bf16(a1, qf[ks], s1, 0, 0, 0);
    }
#pragma unroll
    for (int i = 0; i < NKC; ++i) *(bf16x8*)(smem + KBYTES + kdst[i]) = kr[i];
    bf16x8 kr2[NKC], vr2[2];
#pragma unroll
    for (int i = 0; i < NKC; ++i) { kr[i] = *(const bf16x8*)(ksrc[i] + (size_t)2 * kstep[i]); kr2[i] = kr[i]; }
#pragma unroll
    for (int i = 0; i < 2; ++i) { vr[i] = *(const bf16x8*)(vsrc[i] + 64); vr2[i] = vr[i]; }
    f32x16 o0, o1;
#pragma unroll
    for (int r = 0; r < 16; ++r) { o0[r] = 0.f; o1[r] = 0.f; }
    float m = -1e30f;
    const bf16x8 ones = bf16x8{0x3F80, 0x3F80, 0x3F80, 0x3F80, 0x3F80, 0x3F80, 0x3F80, 0x3F80};
    f32x16 osum;
#pragma unroll
    for (int r = 0; r < 16; ++r) osum[r] = 0.f;
    f32x16 n0, n1;
    auto step = [&](f32x16& s0, f32x16& s1, f32x16& n0, f32x16& n1, bf16x8 (&krW)[NKC], bf16x8 (&vrW)[2], bf16x8 (&krL)[NKC], bf16x8 (&vrL)[2], const int it, const int par) {
        __syncthreads();
        {
            const int kt3 = it + 3 < nt ? it + 3 : nt - 1, vt2 = it + 2 < nt ? it + 2 : nt - 1;
#pragma unroll
            for (int i = 0; i < NKC; ++i) krL[i] = *(const bf16x8*)(ksrc[i] + (size_t)kt3 * kstep[i]);
#pragma unroll
            for (int i = 0; i < 2; ++i) vrL[i] = *(const bf16x8*)(vsrc[i] + vt2 * 64);
        }
        __builtin_amdgcn_sched_barrier(0);
#pragma unroll
        for (int r = 0; r < 16; ++r) { n0[r] = 0.f; n1[r] = 0.f; }
        {
            const unsigned char* ck = smem + (par ^ 1) * KBYTES;
#pragma unroll
            for (int ks = 0; ks < DK / 16; ++ks) {
                bf16x8 a0 = *(const bf16x8*)(ck + (qc * KLD + ks * 16 + hh * 8) * 2);
                bf16x8 a1 = *(const bf16x8*)(ck + ((32 + qc) * KLD + ks * 16 + hh * 8) * 2);
                n0 = __builtin_amdgcn_mfma_f32_32x32x16_bf16(a0, qf[ks], n0, 0, 0, 0);
                n1 = __builtin_amdgcn_mfma_f32_32x32x16_bf16(a1, qf[ks], n1, 0, 0, 0);
            }
        }
        if (MLA) {
            float mx = s0[0];
#pragma unroll
            for (int r = 1; r < 16; ++r) mx = fmaxf(mx, s0[r]);
#pragma unroll
            for (int r = 0; r < 16; ++r) mx = fmaxf(mx, s1[r]);
            { float lo, hi; wave_halves(mx, lo, hi); mx = fmaxf(lo, hi); }
            if (!__all(mx <= m + 6.f)) {
                const float mn = fmaxf(m, mx);
                const float alpha = __builtin_amdgcn_exp2f(m - mn);
                m = mn;
                osum[0] *= alpha;
#pragma unroll
                for (int r = 0; r < 16; ++r) { o0[r] *= alpha; o1[r] *= alpha; }
            }
        } else {
            m = 0.f;
        }
#pragma unroll
        for (int r = 0; r < 16; ++r) s0[r] = __builtin_amdgcn_exp2f(s0[r] - m);
#pragma unroll
        for (int r = 0; r < 16; ++r) s1[r] = __builtin_amdgcn_exp2f(s1[r] - m);
        bf16x8 pf[2][2];
#pragma unroll
        for (int s = 0; s < 2; ++s)
#pragma unroll
            for (int j = 0; j < 8; ++j) { pf[0][s][j] = (short)f2bf(s0[8 * s + j]); pf[1][s][j] = (short)f2bf(s1[8 * s + j]); }
        const unsigned char* cv = smem + VOFF + par * VBYTES;
#pragma unroll
        for (int a = 0; a < 2; ++a)
#pragma unroll
            for (int s = 0; s < 2; ++s) {
                const int keyoff = a * 32 + 16 * s + 4 * hh;
                bf16x4 l0 = *(const bf16x4*)(cv + (qc * VLD + keyoff) * 2);
                bf16x4 h0 = *(const bf16x4*)(cv + (qc * VLD + keyoff + 8) * 2);
                bf16x4 l1 = *(const bf16x4*)(cv + ((32 + qc) * VLD + keyoff) * 2);
                bf16x4 h1 = *(const bf16x4*)(cv + ((32 + qc) * VLD + keyoff + 8) * 2);
                bf16x8 v0 = bf16x8{l0[0], l0[1], l0[2], l0[3], h0[0], h0[1], h0[2], h0[3]};
                bf16x8 v1 = bf16x8{l1[0], l1[1], l1[2], l1[3], h1[0], h1[1], h1[2], h1[3]};
                o0 = __builtin_amdgcn_mfma_f32_32x32x16_bf16(v0, pf[a][s], o0, 0, 0, 0);
                o1 = __builtin_amdgcn_mfma_f32_32x32x16_bf16(v1, pf[a][s], o1, 0, 0, 0);
                osum = __builtin_amdgcn_mfma_f32_32x32x16_bf16(ones, pf[a][s], osum, 0, 0, 0);
            }
        {
            unsigned char* nk = smem + par * KBYTES;
#pragma unroll
            for (int i = 0; i < NKC; ++i) *(bf16x8*)(nk + kdst[i]) = krW[i];
            unsigned char* nv = smem + (par ^ 1) * VBYTES;
#pragma unroll
            for (int i = 0; i < 2; ++i) {
                *(bf16x4*)(nv + vdst[i]) = bf16x4{vrW[i][0], vrW[i][1], vrW[i][2], vrW[i][3]};
                *(bf16x4*)(nv + vdst[i] + 8) = bf16x4{vrW[i][4], vrW[i][5], vrW[i][6], vrW[i][7]};
            }
        }
    };
    for (int it = 0; it < nt; it += 2) {
        step(s0, s1, n0, n1, kr, vr, kr2, vr2, it, 0);
        step(n0, n1, s0, s1, kr2, vr2, kr, vr, it + 1, 1);
    }
    const float inv = 1.f / osum[0];
    unsigned char* op = (unsigned char*)(MLA ? DB(D_YA) : DB(D_YD)) + qrow * 512 + hq * 64;
    const float sc = inv * Y8_SCALE;
#pragma unroll
    for (int g = 0; g < 4; ++g) {
        *(int*)(op + 8 * g + 4 * hh) = pk4_fp8(o0[g * 4] * sc, o0[g * 4 + 1] * sc, o0[g * 4 + 2] * sc, o0[g * 4 + 3] * sc);
        *(int*)(op + 32 + 8 * g + 4 * hh) = pk4_fp8(o1[g * 4] * sc, o1[g * 4 + 1] * sc, o1[g * 4 + 2] * sc, o1[g * 4 + 3] * sc);
    }
}

DEVI int proc_tok(int dir, int pidx) { return dir == 0 ? pidx : (pidx < CTXL ? CTXL - 1 - pidx : (CTXL + TPB - 1) - pidx); }

DEVI void retention_naive(const Params& p, int l, int task) {
    const int b = task >> 2, h = task & 3;
    const int dir = TIDX >> 7, dv = TIDX & 127;
    const float dec = p.in[I_RDEC][l * 8 + dir * 4 + h];
    const float lg = -log1pf(expf(-dec));
    const float g = expf(lg);
    float S[64];
#pragma unroll
    for (int d = 0; d < 64; ++d) S[d] = 0.f;
    const bf16_t* vT = CB(C_RVT) + (((size_t)b * 4 + h) * 128 + dv) * TPB;
    bf16_t* outp = (dir == 0 ? DB(D_OF) : DB(D_OB));
    for (int pi = 0; pi < TPB; ++pi) {
        const int u = proc_tok(dir, pi);
        const size_t row = (size_t)b * TPB + u;
        const bf16_t* qp = CB(C_RQ) + row * 256 + h * 64;
        const bf16_t* kp = CB(C_RK) + row * 256 + h * 64;
        const float v = bf2f(vT[u]);
        float o = 0.f;
#pragma unroll
        for (int c = 0; c < 8; ++c) {
            bf16x8 tq = *(const bf16x8*)(qp + c * 8);
            bf16x8 tk = *(const bf16x8*)(kp + c * 8);
#pragma unroll
            for (int e = 0; e < 8; ++e) {
                const int d = c * 8 + e;
                const float qd = bf2f((bf16_t)tq[e]), kd = bf2f((bf16_t)tk[e]);
                if (dir == 0) { S[d] = g * S[d] + kd * v; o += qd * S[d]; }
                else { S[d] = g * S[d]; o += qd * S[d]; S[d] += kd * v; }
            }
        }
        outp[row * 512 + h * 128 + dv] = f2bf(o);
    }
}

DEVI void lru_naive_wave(const Params& p, int l, int task) {
    const int lane = TIDX & 63;
    const int b = task >> 4, d = (task >> 3) & 1, blk = task & 7;
    const int ch = blk * 64 + lane;
    float cw[4];
#pragma unroll
    for (int j = 0; j < 4; ++j) cw[j] = p.in[I_LCW][(l * 4 + j) * 512 + ch];
    const float cb = p.in[I_LCB][l * 512 + ch];
    const float ba = p.in[I_LBA][(l * 2 + d) * 512 + ch], bx = p.in[I_LBX][(l * 2 + d) * 512 + ch];
    const float lam = p.in[I_LLAM][(l * 2 + d) * 512 + ch];
    const float sp = log1pf(expf(-lam));
    const float* Wa = p.in[I_LWA] + ((size_t)(l * 2 + d) * 8 + blk) * 4096;
    const float* Wx = p.in[I_LWX] + ((size_t)(l * 2 + d) * 8 + blk) * 4096;
    float h = 0.f;
    bf16_t* outp = (d == 0 ? DB(D_LH0) : DB(D_LH1));
    for (int pi = 0; pi < TPB; ++pi) {
        const int u = proc_tok(d, pi);
        const int lo = u < CTXL ? 0 : CTXL, hi = u < CTXL ? CTXL : TPB;
        const size_t row = (size_t)b * TPB + u;
        float uval = cb;
#pragma unroll
        for (int j = 0; j < 4; ++j) {
            const int tt = u - 2 + j;
            if (tt >= lo && tt < hi) uval += cw[j] * bf2f(CB(C_LX)[((size_t)b * TPB + tt) * 512 + ch]);
        }
        float rp = 0.f, ip = 0.f;
        for (int c = 0; c < 64; ++c) {
            const float uc = __shfl(uval, c);
            rp += uc * Wa[c * 64 + lane];
            ip += uc * Wx[c * 64 + lane];
        }
        const float r = sigmoidf_(rp + ba), ig = sigmoidf_(ip + bx);
        const float la = -8.f * r * sp;
        const float a = expf(la);
        const float bb = sqrtf(-expm1f(2.f * la)) * (ig * uval);
        h = a * h + bb;
        outp[row * 512 + ch] = f2bf(h);
    }
}


DEVI void retention_walk(const Params& p, int l, int task, unsigned char* smem) {
    constexpr int PLD = 136;
    const int b = task >> 3, h = (task >> 1) & 3, dir = task & 1;
    const int tid = TIDX, lane = tid & 63, w = tid >> 6, qc = lane & 31, hh = lane >> 5;
    const float dec = p.in[I_RDEC][l * 8 + dir * 4 + h];
    const float lg2 = -log1pf(expf(-dec)) * LOG2E;
    const float cdec = exp2f(lg2 * 128.f);
    bf16_t* P = (bf16_t*)smem;
    f32x16 S0, S1;
#pragma unroll
    for (int r = 0; r < 16; ++r) { S0[r] = 0.f; S1[r] = 0.f; }
    const bf16_t* Kg = CB(C_RK) + (size_t)b * TPB * 256 + h * 64;
    const bf16_t* Qg = CB(C_RQ) + (size_t)b * TPB * 256 + h * 64;
    const bf16_t* KTg = CB(C_RKT) + ((size_t)b * 4 + h) * 64 * TPB;
    const bf16_t* VTg = CB(C_RVT) + (((size_t)b * 4 + h) * 128 + w * 32 + qc) * TPB;
    bf16_t* outp = (dir == 0 ? DB(D_OF) : DB(D_OB)) + (size_t)b * TPB * 512 + h * 128 + w * 32;
    const int iq = 32 * w + qc;
    for (int cc = 0; cc < 18; ++cc) {
        const int mch = dir == 0 ? cc : (cc < 2 ? 1 - cc : 19 - cc);
        const int t0 = mch * 128;
        bf16x8 vf[8];
#pragma unroll
        for (int ks = 0; ks < 8; ++ks) vf[ks] = *(const bf16x8*)(VTg + t0 + ks * 16 + hh * 8);
        bf16x8 qf[4];
        {
            const bf16_t* qrow = Qg + (size_t)(t0 + iq) * 256;
#pragma unroll
            for (int ks = 0; ks < 4; ++ks) qf[ks] = *(const bf16x8*)(qrow + ks * 16 + hh * 8);
        }
        __syncthreads();
#pragma unroll 1
        for (int js = 0; js < 4; ++js) {
            f32x16 sc;
#pragma unroll
            for (int r = 0; r < 16; ++r) sc[r] = 0.f;
            const bf16_t* krow = Kg + (size_t)(t0 + 32 * js + qc) * 256;
#pragma unroll
            for (int ks = 0; ks < 4; ++ks) {
                bf16x8 a = *(const bf16x8*)(krow + ks * 16 + hh * 8);
                sc = __builtin_amdgcn_mfma_f32_32x32x16_bf16(a, qf[ks], sc, 0, 0, 0);
            }
#pragma unroll
            for (int g = 0; g < 4; ++g) {
                bf16x4 pk;
#pragma unroll
                for (int e = 0; e < 4; ++e) {
                    const int j = 32 * js + 8 * g + 4 * hh + e;
                    const int d = iq - j;
                    float wgt;
                    if (dir == 0) wgt = d >= 0 ? __builtin_amdgcn_exp2f(lg2 * (float)d) : 0.f;
                    else wgt = d < 0 ? __builtin_amdgcn_exp2f(lg2 * (float)(-d)) : 0.f;
                    pk[e] = (short)f2bf(sc[4 * g + e] * wgt);
                }
                *(bf16x4*)(P + iq * PLD + 32 * js + 8 * g + 4 * hh) = pk;
            }
        }
        __syncthreads();
        bf16x8 sf[2][2];
#pragma unroll
        for (int s = 0; s < 2; ++s)
#pragma unroll
            for (int j = 0; j < 8; ++j) { sf[0][s][j] = (short)f2bf(S0[8 * s + j]); sf[1][s][j] = (short)f2bf(S1[8 * s + j]); }
#pragma unroll 1
        for (int isub = 0; isub < 4; ++isub) {
            const int ii = 32 * isub + qc;
            const bf16_t* qr = Qg + (size_t)(t0 + ii) * 256;
            f32x16 o;
#pragma unroll
            for (int r = 0; r < 16; ++r) o[r] = 0.f;
#pragma unroll
            for (int sub = 0; sub < 2; ++sub)
#pragma unroll
                for (int s = 0; s < 2; ++s) {
                    const int dk0 = 32 * sub + 16 * s + 4 * hh;
                    bf16x4 lo = *(const bf16x4*)(qr + dk0), hi = *(const bf16x4*)(qr + dk0 + 8);
                    bf16x8 bq = bf16x8{lo[0], lo[1], lo[2], lo[3], hi[0], hi[1], hi[2], hi[3]};
                    o = __builtin_amdgcn_mfma_f32_32x32x16_bf16(sf[sub][s], bq, o, 0, 0, 0);
                }
            const float qd = dir == 0 ? __builtin_amdgcn_exp2f(lg2 * (float)(ii + 1)) : __builtin_amdgcn_exp2f(lg2 * (float)(128 - ii));
#pragma unroll
            for (int r = 0; r < 16; ++r) o[r] *= qd;
#pragma unroll
            for (int ks = 0; ks < 8; ++ks) {
                bf16x8 pf = *(const bf16x8*)(P + ii * PLD + 16 * ks + 8 * hh);
                o = __builtin_amdgcn_mfma_f32_32x32x16_bf16(vf[ks], pf, o, 0, 0, 0);
            }
            bf16_t* orow = outp + (size_t)(t0 + ii) * 512;
#pragma unroll
            for (int g = 0; g < 4; ++g) {
                bf16x4 pk;
#pragma unroll
                for (int e = 0; e < 4; ++e) pk[e] = (short)f2bf(o[4 * g + e]);
                *(bf16x4*)(orow + 8 * g + 4 * hh) = pk;
            }
        }
#pragma unroll
        for (int r = 0; r < 16; ++r) { S0[r] *= cdec; S1[r] *= cdec; }
#pragma unroll
        for (int ks = 0; ks < 8; ++ks) {
            bf16x8 vs;
#pragma unroll
            for (int e = 0; e < 8; ++e) {
                const int j = 16 * ks + 8 * hh + e;
                const float kd = dir == 0 ? __builtin_amdgcn_exp2f(lg2 * (float)(127 - j)) : __builtin_amdgcn_exp2f(lg2 * (float)j);
                vs[e] = (short)f2bf(bf2f((bf16_t)vf[ks][e]) * kd);
            }
            bf16x8 a0 = *(const bf16x8*)(KTg + (size_t)qc * TPB + t0 + 16 * ks + 8 * hh);
            bf16x8 a1 = *(const bf16x8*)(KTg + (size_t)(32 + qc) * TPB + t0 + 16 * ks + 8 * hh);
            S0 = __builtin_amdgcn_mfma_f32_32x32x16_bf16(a0, vs, S0, 0, 0, 0);
            S1 = __builtin_amdgcn_mfma_f32_32x32x16_bf16(a1, vs, S1, 0, 0, 0);
        }
    }
    __syncthreads();
}

DEVI void lru_walk(const Params& p, int l, int task, unsigned char* smem) {
    const int b = task >> 4, d = (task >> 3) & 1, blk = task & 7;
    const int tid = TIDX, lane = tid & 63, w = tid >> 6, ln = lane & 15, g = lane >> 4;
    bf16_t* Wt = (bf16_t*)smem;
    float* uw = (float*)(smem + 18432 + w * 4224);
    float* cpar = (float*)(smem + 35328);
    float* agg = (float*)(smem + 36608);
    __syncthreads();
    {
        const bf16_t* wsrc = WB(W_LRU + ((size_t)(l * 2 + d) * 8 + blk) * 8192);
        for (int c = tid; c < 128 * 8; c += 256) {
            const int n = c >> 3, kc = c & 7;
            *(bf16x8*)(Wt + n * 72 + kc * 8) = *(const bf16x8*)(wsrc + n * 64 + kc * 8);
        }
        if (tid < 64) {
            const int ch = blk * 64 + tid;
#pragma unroll
            for (int j = 0; j < 4; ++j) cpar[j * 64 + tid] = p.in[I_LCW][(l * 4 + j) * 512 + ch];
            cpar[256 + tid] = p.in[I_LCB][l * 512 + ch];
        }
    }
    __syncthreads();
    float ba[4], bx[4], sp[4], hc[4];
#pragma unroll
    for (int ct = 0; ct < 4; ++ct) {
        const int ch = blk * 64 + 16 * ct + ln;
        ba[ct] = p.in[I_LBA][(l * 2 + d) * 512 + ch];
        bx[ct] = p.in[I_LBX][(l * 2 + d) * 512 + ch];
        sp[ct] = log1pf(expf(-p.in[I_LLAM][(l * 2 + d) * 512 + ch]));
        hc[ct] = 0.f;
    }
    const bf16_t* X = CB(C_LX) + (size_t)b * TPB * 512 + blk * 64;
    bf16_t* outp = (d == 0 ? DB(D_LH0) : DB(D_LH1)) + (size_t)b * TPB * 512 + blk * 64;
    bf16x8 xr[2][4];
    float xm[4];
    {
        const int tok = proc_tok(d, 16 * w + ln);
        const int lo = tok < CTXL ? 0 : CTXL, hi = tok < CTXL ? CTXL : TPB;
#pragma unroll
        for (int ks = 0; ks < 2; ++ks)
#pragma unroll
            for (int j = 0; j < 4; ++j) {
                const int tt = tok - 2 + j;
                const int tc = tt < lo ? lo : (tt >= hi ? hi - 1 : tt);
                xr[ks][j] = *(const bf16x8*)(X + (size_t)tc * 512 + 32 * ks + 8 * g);
                xm[j] = (tt >= lo && tt < hi) ? 1.f : 0.f;
            }
    }
    for (int c = 0; c < 36; ++c) {
        bf16x8 af[2];
#pragma unroll
        for (int ks = 0; ks < 2; ++ks) {
            const int c0 = 32 * ks + 8 * g;
            float u8[8];
#pragma unroll
            for (int e = 0; e < 8; ++e) u8[e] = cpar[256 + c0 + e];
#pragma unroll
            for (int j = 0; j < 4; ++j)
#pragma unroll
                for (int e = 0; e < 8; ++e) u8[e] += (cpar[j * 64 + c0 + e] * xm[j]) * bf2f((bf16_t)xr[ks][j][e]);
#pragma unroll
            for (int e = 0; e < 8; ++e) { uw[ln * 65 + c0 + e] = u8[e]; af[ks][e] = (short)f2bf(u8[e]); }
        }
        if (c + 1 < 36) {
            const int tok = proc_tok(d, 64 * (c + 1) + 16 * w + ln);
            const int lo = tok < CTXL ? 0 : CTXL, hi = tok < CTXL ? CTXL : TPB;
#pragma unroll
            for (int ks = 0; ks < 2; ++ks)
#pragma unroll
                for (int j = 0; j < 4; ++j) {
                    const int tt = tok - 2 + j;
                    const int tc = tt < lo ? lo : (tt >= hi ? hi - 1 : tt);
                    xr[ks][j] = *(const bf16x8*)(X + (size_t)tc * 512 + 32 * ks + 8 * g);
                    xm[j] = (tt >= lo && tt < hi) ? 1.f : 0.f;
                }
        }
        __builtin_amdgcn_wave_barrier();
        f32x4 acc[8];
#pragma unroll
        for (int nt = 0; nt < 8; ++nt) acc[nt] = f32x4{0.f, 0.f, 0.f, 0.f};
#pragma unroll
        for (int ks = 0; ks < 2; ++ks)
#pragma unroll
            for (int nt = 0; nt < 8; ++nt) {
                bf16x8 bfr = *(const bf16x8*)(Wt + (16 * nt + ln) * 72 + 32 * ks + 8 * g);
                acc[nt] = __builtin_amdgcn_mfma_f32_16x16x32_bf16(af[ks], bfr, acc[nt], 0, 0, 0);
            }
        float A[4][4], B[4][4];
#pragma unroll
        for (int ct = 0; ct < 4; ++ct) {
            float pa = 1.f, pb = 0.f;
#pragma unroll
            for (int j = 0; j < 4; ++j) {
                const float r = fsig(acc[ct][j] + ba[ct]);
                const float ig = fsig(acc[4 + ct][j] + bx[ct]);
                const float la = -8.f * r * sp[ct];
                const float a = __expf(la);
                const float uu = uw[(4 * g + j) * 65 + 16 * ct + ln];
                const float bb = __builtin_amdgcn_sqrtf(fmaxf(1.f - a * a, 0.f)) * ig * uu;
                pb = a * pb + bb; pa = a * pa;
                A[ct][j] = pa; B[ct][j] = pb;
            }
            float ia = pa, ib = pb;
#pragma unroll
            for (int dd = 1; dd <= 2; dd <<= 1) {
                const int sl = ((TIDX & 63) - 16 * dd) << 2;
                const float qa = __builtin_bit_cast(float, __builtin_amdgcn_ds_bpermute(sl, __builtin_bit_cast(int, ia))), qb = __builtin_bit_cast(float, __builtin_amdgcn_ds_bpermute(sl, __builtin_bit_cast(int, ib)));
                if (g >= dd) { ib = ia * qb + ib; ia = ia * qa; }
            }
            const int sl1 = ((TIDX & 63) - 16) << 2;
            float ea = __builtin_bit_cast(float, __builtin_amdgcn_ds_bpermute(sl1, __builtin_bit_cast(int, ia))), eb = __builtin_bit_cast(float, __builtin_amdgcn_ds_bpermute(sl1, __builtin_bit_cast(int, ib)));
            if (g == 0) { ea = 1.f; eb = 0.f; }
#pragma unroll
            for (int j = 0; j < 4; ++j) { B[ct][j] = A[ct][j] * eb + B[ct][j]; A[ct][j] = A[ct][j] * ea; }
            if (g == 3) {
                float* ag = agg + (((c & 1) * 4 + w) * 64 + 16 * ct + ln) * 2;
                ag[0] = ia; ag[1] = ib;
            }
        }
        __syncthreads();
#pragma unroll
        for (int ct = 0; ct < 4; ++ct) {
            float hrun = hc[ct], hin = 0.f;
#pragma unroll
            for (int w2 = 0; w2 < 4; ++w2) {
                const float* ag = agg + (((c & 1) * 4 + w2) * 64 + 16 * ct + ln) * 2;
                if (w2 == w) hin = hrun;
                hrun = ag[0] * hrun + ag[1];
            }
            hc[ct] = hrun;
#pragma unroll
            for (int j = 0; j < 4; ++j) {
                const int tok2 = proc_tok(d, 64 * c + 16 * w + 4 * g + j);
                outp[(size_t)tok2 * 512 + 16 * ct + ln] = f2bf(A[ct][j] * hin + B[ct][j]);
            }
        }
    }
    __syncthreads();
}

DEVI void fin_tile(const Params& p, int l, int mq) {
    const int lane = TIDX & 63, w = TIDX >> 6;
    const int row0 = mt_of(mq, l != 0) * 128 + w * 32;
#pragma unroll 4
    for (int i = 0; i < 32; ++i) {
        const size_t o = (size_t)(row0 + i) * 512 + lane * 8;
        bf16x8 h0 = *(const bf16x8*)(DB(D_LH0) + o), h1 = *(const bf16x8*)(DB(D_LH1) + o), lg = *(const bf16x8*)(CB(C_LG) + o);
        bf16x8 oc;
#pragma unroll
        for (int e = 0; e < 8; ++e) oc[e] = (short)f2bf((bf2f((bf16_t)h0[e]) + bf2f((bf16_t)h1[e])) * gelu_tanh(bf2f((bf16_t)lg[e])));
        *(bf16x8*)(DB(D_LH0) + o) = oc;
    }
}

DEVI void phase_mix(const Params& p, int l, unsigned char* smem) {
    const int NLRU = 128, NRET = (l == 0 ? 576 : 512);
    const int NLAT = 1024, NCTX = (l == 0 ? 128 : 0);
    const int NFIN = (l == 0 ? 144 : 128);
    const int ntask = NLRU + NRET + 2 * NLAT + 2 * NCTX;
    int* depl = WSI(OFF_CNT) + 3072 + l * 16;
    const int ncvt = 3072;
    int cv = BIDX;
    int* ctr = WSI(OFF_CNT) + 128 + l;
    for (;;) {
        LAS volatile int* nxt = (LAS volatile int*)((LAS unsigned char*)smem + 65520);
        __syncthreads();
        if (TIDX == 0) *nxt = atomicAdd(ctr, 1);
        __syncthreads();
        const int task = *nxt;
        if (task >= ntask) break;
        if (cv < ncvt) { CvtJob j = get_moe_job(p, l, cv >> 10); if ((cv >> 10) < 2) cvt_tile256_fp8(j, cv & 1023, smem); else cvt_tile256(j, cv & 1023, smem); cv += gridDim.x; }
        if (task < NLRU) { lru_walk(p, l, task, smem); }
        else if (false) {
            const int mq = task - (ntask - NFIN);
            const int bq = mt_of(mq, l != 0) / 18;
            dep_wait(depl + bq, 16);
            fin_tile(p, l, mq);
        }
        else if (task >= NLRU + 2 * NLAT && task < NLRU + 2 * NLAT + NRET) {
            const int a = task - NLRU - 2 * NLAT;
            int b, h, m;
            if (l == 0) { b = a / 72; const int r = a % 72; h = r / 18; m = r % 18; }
            else { b = a >> 6; const int r = a & 63; h = r >> 4; m = 2 + (r & 15); }
            ret_out_task(p, l, b, h, m, smem);
        } else {
            int a = task < NLRU + 2 * NLAT ? task - NLRU : task - NLRU - NRET;
            int kind, b, hsel, tq0, nkeys;
            if (a < NLAT) { kind = 0; b = a >> 7; const int r = a & 127; hsel = r >> 4; tq0 = CTXL + (r & 15) * 128; nkeys = TPB; }
            else if (a < 2 * NLAT) { a -= NLAT; kind = 1; b = a >> 7; const int r = a & 127; hsel = r >> 6; tq0 = CTXL + (r & 63) * 32; nkeys = TPB; }
            else if (a < 2 * NLAT + NCTX) { a -= 2 * NLAT; kind = 0; b = a >> 4; const int r = a & 15; hsel = r >> 1; tq0 = (r & 1) * 128; nkeys = CTXL; }
            else { a -= 2 * NLAT + NCTX; kind = 1; b = a >> 4; const int r = a & 15; hsel = r >> 3; tq0 = (r & 7) * 32; nkeys = CTXL; }
            if (kind == 0) attn_task<96, true>(p, b, hsel, tq0, nkeys, smem);
            else attn_task<64, false>(p, b, hsel, tq0, nkeys, smem);
        }
    }
    for (; cv < ncvt; cv += gridDim.x) { CvtJob j = get_moe_job(p, l, cv >> 10); if ((cv >> 10) < 2) cvt_tile256_fp8(j, cv & 1023, smem); else cvt_tile256(j, cv & 1023, smem); }
}

DEVI void phase_fin(const Params& p, int l) {
    const int lane = TIDX & 63, w = TIDX >> 6;
    for (int row = BIDX * 4 + w; row < TT; row += gridDim.x * 4) {
        if (l == 1 && (row % TPB) < CTXL) continue;
        const size_t o = (size_t)row * 512 + lane * 8;
        bf16x8 h0 = *(const bf16x8*)(DB(D_LH0) + o), h1 = *(const bf16x8*)(DB(D_LH1) + o), lg = *(const bf16x8*)(CB(C_LG) + o);
        float yv[8];
#pragma unroll
        for (int e = 0; e < 8; ++e) yv[e] = (bf2f((bf16_t)h0[e]) + bf2f((bf16_t)h1[e])) * gelu_tanh(bf2f((bf16_t)lg[e])) * Y8_SCALE;
        int2 o8; o8.x = pk4_fp8(yv[0], yv[1], yv[2], yv[3]); o8.y = pk4_fp8(yv[4], yv[5], yv[6], yv[7]);
        *(int2*)((unsigned char*)DB(D_OB) + o) = o8;
    }
}

template <int BN>
DEVI void gemm_fp8_prologue(const unsigned char* Ab, size_t lda, int row0, const unsigned char* Bb, size_t ldb, unsigned char* smem) {
    constexpr int NI = BN / 32;
    const int tid = TIDX, lr = tid >> 3, kc = (tid & 7) ^ (lr & 7);
    const unsigned char* ap = Ab + (size_t)(row0 + lr) * lda + kc * 16;
    const unsigned char* bp = Bb + (size_t)lr * ldb + kc * 16;
    LAS unsigned char* lA = (LAS unsigned char*)smem + tid * 16;
    LAS unsigned char* lB = lA + 16384;
#pragma unroll
    for (int i = 0; i < 4; ++i) __builtin_amdgcn_global_load_lds((const GAS unsigned*)(ap + i * 32 * lda), (LAS unsigned*)(lA + i * 4096), 16, 0, 0);
#pragma unroll
    for (int i = 0; i < NI; ++i) __builtin_amdgcn_global_load_lds((const GAS unsigned*)(bp + i * 32 * ldb), (LAS unsigned*)(lB + i * 4096), 16, 0, 0);
}
template <int BN>
DEVI void merge_tile(const Params& p, int l, int mt, int nt, unsigned char* smem) {
    bf16_t* ct = (bf16_t*)smem;
    const int lane = TIDX & 63, wc = (TIDX >> 6) & 1;
    constexpr int NI = BN / 32;
    const int row0 = mt * 128;
    unsigned mp[4][NI][2];
#pragma unroll
    for (int mi = 0; mi < 4; ++mi)
#pragma unroll
        for (int ni = 0; ni < NI; ++ni) { mp[mi][ni][0] = 0u; mp[mi][ni][1] = 0u; }
#pragma unroll 1
    for (int n = 0; n < 4; ++n) {
        unsigned gp[4][NI][2];
        const unsigned char* yb = (const unsigned char*)(n == 0 ? DB(D_YA) : (n == 1 ? DB(D_OF) : (n == 2 ? DB(D_OB) : DB(D_YD))));
        const unsigned char* wbr = (const unsigned char*)WB(W_BR + (size_t)l * 4 * 1024 * 512) + (size_t)n * 1024 * 512 + (size_t)(nt * BN) * 512;
        {
            float bsv[NI];
            const float* bm = p.in[I_BMG] + l * 4096 + n * 1024 + nt * BN + wc * (BN / 2) + (lane & 15);
#pragma unroll
            for (int ni = 0; ni < NI; ++ni) bsv[ni] = bm[ni * 16];
            f32x4 ag[4][NI];
            acc_zero<BN>(ag);
            gemm_core_fp8<false, BN>(ag, (const unsigned char*)HB, 2048, row0, (const unsigned char*)WB(W_MG + (size_t)l * 4096 * 1024) + (size_t)(n * 1024 + nt * BN) * 1024, 1024, 1024, smem, nullptr, 0x7f7f7f7f, n > 0);
            gemm_fp8_prologue<BN>(yb, 512, row0, wbr, 512, smem);
#pragma unroll
            for (int ni = 0; ni < NI; ++ni) {
                const float bias = bsv[ni];
#pragma unroll
                for (int mi = 0; mi < 4; ++mi) {
                    gp[mi][ni][0] = (unsigned)f2bf(fsig(ag[mi][ni][0] + bias)) | ((unsigned)f2bf(fsig(ag[mi][ni][1] + bias)) << 16);
                    gp[mi][ni][1] = (unsigned)f2bf(fsig(ag[mi][ni][2] + bias)) | ((unsigned)f2bf(fsig(ag[mi][ni][3] + bias)) << 16);
                }
            }
        }
        f32x4 ap[4][NI];
        acc_zero<BN>(ap);
        gemm_core_fp8<false, BN>(ap, yb, 512, row0, wbr, 512, 512, smem, nullptr, Y8_E8M0, true);
        if (n < 3)
            gemm_fp8_prologue<BN>((const unsigned char*)HB, 2048, row0, (const unsigned char*)WB(W_MG + (size_t)l * 4096 * 1024) + (size_t)((n + 1) * 1024 + nt * BN) * 1024, 1024, smem);
#pragma unroll
        for (int mi = 0; mi < 4; ++mi)
#pragma unroll
            for (int ni = 0; ni < NI; ++ni) {
                const float m0 = __uint_as_float(mp[mi][ni][0] << 16) + __uint_as_float(gp[mi][ni][0] << 16) * ap[mi][ni][0];
                const float m1 = __uint_as_float(mp[mi][ni][0] & 0xffff0000u) + __uint_as_float(gp[mi][ni][0] & 0xffff0000u) * ap[mi][ni][1];
                const float m2 = __uint_as_float(mp[mi][ni][1] << 16) + __uint_as_float(gp[mi][ni][1] << 16) * ap[mi][ni][2];
                const float m3 = __uint_as_float(mp[mi][ni][1] & 0xffff0000u) + __uint_as_float(gp[mi][ni][1] & 0xffff0000u) * ap[mi][ni][3];
                mp[mi][ni][0] = (unsigned)f2bf(m0) | ((unsigned)f2bf(m1) << 16);
                mp[mi][ni][1] = (unsigned)f2bf(m2) | ((unsigned)f2bf(m3) << 16);
            }
    }
    __syncthreads();
    {
        const int wid = TIDX >> 6, wr = wid >> 1;
#pragma unroll
        for (int mi = 0; mi < 4; ++mi)
#pragma unroll
            for (int ni = 0; ni < NI; ++ni) {
                bf16_t* cp = ct + (wr * 64 + mi * 16 + (lane >> 4) * 4) * CT_LD + wc * (BN / 2) + ni * 16 + (lane & 15);
                cp[0] = (bf16_t)(mp[mi][ni][0] & 0xffffu); cp[CT_LD] = (bf16_t)(mp[mi][ni][0] >> 16);
                cp[2 * CT_LD] = (bf16_t)(mp[mi][ni][1] & 0xffffu); cp[3 * CT_LD] = (bf16_t)(mp[mi][ni][1] >> 16);
            }
    }
    __syncthreads();
    ep_store_rows<BN>(ct, 0, CB(C_M) + nt * BN, 1024, row0);
}

DEVI void wout_tile(const Params& p, int l, int mt, int nt, unsigned char* smem) {
    bf16_t* ct = (bf16_t*)smem;
    const int row0 = mt * 128, b = mt / 18, t0 = (mt % 18) * 128;
    const bool isctx = (mt % 18) < 2;
    const int bi = isctx ? 8 : b;
    f32x4 acc[4][4];
    acc_zero<128>(acc);
    AOp A{CB(C_M), 1024, row0, nullptr};
    gemm_core<128>(acc, A, WB(W_OUT + (size_t)l * 1024 * 1024 + (size_t)nt * 128 * 1024), 1024, 1024, smem);
    __syncthreads();
    acc_to_ct<128>(acc, ct);
    __syncthreads();
    const float* gate = WSF(OFF_MOD) + (size_t)(l * 9 + bi) * 6144 + 2 * 1024 + nt * 128;
#pragma unroll 8
    for (int c = TIDX; c < 128 * 32; c += 256) {
        const int i = c >> 5, jc = c & 31;
        const int t = t0 + i;
        const float* xs;
        if (l == 0) xs = isctx ? p.in[I_CTX] + ((size_t)b * CTXL + t) * DM : p.in[I_X] + ((size_t)b * SEQL + (t - CTXL)) * DM;
        else xs = XCUR + (size_t)(row0 + i) * DM;
        float4 x4 = *(const float4*)(xs + nt * 128 + jc * 4);
        float4 g4 = *(const float4*)(gate + jc * 4);
        uint2 y = *(const uint2*)(ct + i * CT_LD + jc * 4);
        x4.x += g4.x * __uint_as_float(y.x << 16);
        x4.y += g4.y * __uint_as_float(y.x & 0xffff0000u);
        x4.z += g4.z * __uint_as_float(y.y << 16);
        x4.w += g4.w * __uint_as_float(y.y & 0xffff0000u);
        *(float4*)(XCUR + (size_t)(row0 + i) * DM + nt * 128 + jc * 4) = x4;
    }
}

DEVI void phase_merge_wout(const Params& p, int l, unsigned char* smem) {
    const int NL = 128 * 8, NC = (l == 0 ? 16 * 16 : 0), N5 = NL + NC, N6 = (l == 0 ? 144 : 128) * 8;
    int* ctr = WSI(OFF_CNT) + 132 + l;
    int* dep = WSI(OFF_CNT) + 256 + l * 160;
    for (;;) {
        const int task = fetch_task(ctr, smem);
        if (task >= N5 + N6) break;
        if (task < NL) {
            const int q = task >> 3, mt = (q >> 4) * 18 + 2 + (q & 15);
            merge_tile<128>(p, l, mt, task & 7, smem);
            dep_signal(dep + mt);
        } else if (task < N5) {
            const int t = task - NL, c = t >> 4, mt = (c >> 1) * 18 + (c & 1);
            merge_tile<64>(p, l, mt, t & 15, smem);
            dep_signal(dep + mt);
        } else {
            const int t6 = task - N5, q = t6 >> 3;
            const bool isl = q < 128;
            const int mt = isl ? (q >> 4) * 18 + 2 + (q & 15) : ((q - 128) >> 1) * 18 + ((q - 128) & 1);
            dep_wait(dep + mt, isl ? 8 : 16);
            wout_tile(p, l, mt, t6 & 7, smem);
        }
    }
}

DEVI void phase_route(const Params& p, int l, unsigned char* smem) {
    const int tid = TIDX, lane = tid & 63, w = tid >> 6, wr = w >> 1, wc = w & 1;
    float* lgt = (float*)smem;
    float* rbs = (float*)(smem + 36864 + 512);
    int* cnt = WSI(OFF_CNT) + l * 64;
    int* list = WSI(OFF_LIST);
    const int ntile = l == 0 ? 144 : 128;
    if (l == 0) {
        const int G = gridDim.x, nidle = G - ntile;
        if (nidle > 0) { if ((int)BIDX >= ntile) for (int t = BIDX - ntile; t < CVT_L1_DEFER; t += nidle) do_cvt_task(p, 1, t, smem); }
        else for (int t = BIDX; t < CVT_L1_DEFER; t += G) do_cvt_task(p, 1, t, smem);
        __syncthreads();
    }
    for (int q = BIDX; q < ntile; q += gridDim.x) {
        const int mt = mt_of(q, l != 0);
        const int row0 = mt * 128;
        f32x4 acc[4][2];
        acc_zero<64>(acc);
        AOp A{HB, 1024, row0, nullptr};
        gemm_core<64>(acc, A, WB(W_RT), 1024, 1024, smem);
        __syncthreads();
#pragma unroll
        for (int mi = 0; mi < 4; ++mi)
#pragma unroll
            for (int ni = 0; ni < 2; ++ni)
#pragma unroll
                for (int j = 0; j < 4; ++j)
                    lgt[(wr * 64 + mi * 16 + (lane >> 4) * 4 + j) * 68 + wc * 32 + ni * 16 + (lane & 15)] = acc[mi][ni][j];
        if (tid < 64) rbs[tid] = p.in[I_RB][tid];
        __syncthreads();
        int me0 = 0, me1 = 0; float ms0 = 0.f, ms1 = 0.f;
        {
            const int hf = tid & 1;
            const float* lrow = lgt + (tid >> 1) * 68 + hf * 32;
            float bgv = -3.0e38f; int bg = 0;
#pragma unroll
            for (int g = 0; g < 4; ++g) {
                const float4 q0 = *(const float4*)(lrow + g * 8), q1 = *(const float4*)(lrow + g * 8 + 4);
                const float lg[8] = {q0.x, q0.y, q0.z, q0.w, q1.x, q1.y, q1.z, q1.w};
                float v1 = -3.0e38f, v2 = -3.0e38f, s1 = 0.f, s2 = 0.f; int i1 = 0, i2 = 0;
#pragma unroll
                for (int j = 0; j < 8; ++j) {
                    const int ex = hf * 32 + g * 8 + j;
                    const float sc = sigmoidf_(lg[j]);
                    const float bv = sc + rbs[ex];
                    if (bv > v1) { v2 = v1; i2 = i1; s2 = s1; v1 = bv; i1 = ex; s1 = sc; }
                    else if (bv > v2) { v2 = bv; i2 = ex; s2 = sc; }
                }
                const float gv = v1 + v2;
                if (gv > bgv) { bgv = gv; bg = hf * 4 + g; me0 = i1; me1 = i2; ms0 = s1; ms1 = s2; }
            }
            const float ogv = dpp_xor1(bgv);
            const int oe0 = dpp_xor1(me0), oe1 = dpp_xor1(me1);
            const float os0 = dpp_xor1(ms0), os1 = dpp_xor1(ms1);
            if (hf == 0 && ogv > bgv) { me0 = oe0; me1 = oe1; ms0 = os0; ms1 = os1; }
            (void)bg;
        }
        int* hist = (int*)(smem + 36864);
        int* base = hist + 64;
        if (tid < 64) hist[tid] = 0;
        __syncthreads();
        int r0 = 0, r1 = 0;
        if ((tid & 1) == 0) { r0 = atomicAdd(&hist[me0], 1); r1 = atomicAdd(&hist[me1], 1); }
        __syncthreads();
        if (tid < 64) { const int hc = hist[tid]; base[tid] = hc ? atomicAdd(&cnt[tid], hc) : 0; }
        __syncthreads();
        if ((tid & 1) == 0) {
            const int row = row0 + (tid >> 1);
            Rec rc;
            rc.e0 = me0; rc.e1 = me1;
            rc.p0 = base[me0] + r0;
            rc.p1 = base[me1] + r1;
            const float inv = 1.f / (ms0 + ms1);
            rc.w0 = ms0 * inv; rc.w1 = ms1 * inv; rc.pad0 = 0; rc.pad1 = 0;
            list[(size_t)me0 * TT + rc.p0] = row;
            list[(size_t)me1 * TT + rc.p1] = row;
            ((Rec*)(p.ws + OFF_REC))[row] = rc;
        }
        __syncthreads();
    }
}

DEVI void moe_find(const MoeRegs& mr, int rt, int& e, int& jt, int& cn, int& sg) {
    const unsigned long long m = __ballot(mr.tp <= rt);
    e = __popcll(m) - 1;
    jt = rt - __builtin_amdgcn_ds_bpermute(e << 2, mr.tp); cn = __builtin_amdgcn_ds_bpermute(e << 2, mr.cnt); sg = __builtin_amdgcn_ds_bpermute(e << 2, mr.seg);
}
DEVI void phase_moe(const Params& p, int l, unsigned char* smem) {
    bf16_t* ct = (bf16_t*)smem;
    int* ridx = (int*)(smem + AUX_OFF);
    const MoeRegs mr = moe_regs(p, l);
    const int* list = WSI(OFF_LIST);
    const int nrt = mr.nrt;
    int* ctr = WSI(OFF_CNT) + 136 + l;
    int* dep = WSI(OFF_CNT) + 1024 + l * 384;
    for (;;) {
        const int task = fetch_task(ctr, smem);
        if (task >= nrt * 8) break;
        if (task < nrt * 4) {
            const int rt = task >> 2, nt = task & 3;
            int e, jt, cn, sg;
            moe_find(mr, rt, e, jt, cn, sg);
            if (TIDX < 128) {
                const int idx = jt * 128 + TIDX;
                ridx[TIDX] = list[(size_t)e * TT + (idx < cn ? idx : 0)];
            }
            __syncthreads();
            f32x4 acc[4][4];
            acc_zero<128>(acc);
            gemm_core_fp8<true>(acc, (const unsigned char*)CB(0), 1024, 0, (const unsigned char*)MWB(MW_13) + ((size_t)e * 512 + nt * 128) * 1024, 1024, 1024, smem, ridx);
            __syncthreads();
            acc_to_ct<128>(acc, ct);
            __syncthreads();
            const int slot0 = sg + jt * 128;
            for (int c = TIDX; c < 128 * 8; c += 256) {
                const int i = c >> 3, jc = c & 7;
                bf16x8 a = *(const bf16x8*)(ct + i * CT_LD + jc * 8), g = *(const bf16x8*)(ct + i * CT_LD + 64 + jc * 8), o;
#pragma unroll
                for (int q = 0; q < 8; ++q) o[q] = (short)f2bf(siluf_(bf2f((bf16_t)a[q])) * bf2f((bf16_t)g[q]));
                *(bf16x8*)(DB(D_ACT) + (size_t)(slot0 + i) * 256 + nt * 64 + jc * 8) = o;
            }
            dep_signal(dep + rt);
        } else {
            const int t2 = task - nrt * 4;
            const int rt = t2 >> 2, nt = t2 & 3;
            int e, jt, cn, sg;
            moe_find(mr, rt, e, jt, cn, sg);
            const int slot0 = sg + jt * 128;
            dep_wait(dep + rt, 4);
            f32x4 acc[2][4][4];
            acc_zero<128>(acc[0]); acc_zero<128>(acc[1]);
            gemm_core256(acc, MWB(MW_2) + ((size_t)e * 1024 + nt * 256) * 256, 256, 0, DB(D_ACT) + (size_t)slot0 * 256, 256, 256, smem);
            __syncthreads();
            acc_to_ctT(acc[0], ct); acc_to_ctT(acc[1], ct + 128 * CT_LD);
            __syncthreads();
            ep_store_rows<128>(ct, 0, DB(D_YS) + nt * 256, 1024, slot0);
            ep_store_rows<128>(ct + 128 * CT_LD, 0, DB(D_YS) + nt * 256 + 128, 1024, slot0);
        }
    }
}

#define XB_TMO      128
#define XB_XCNT(j)  (256  + 64 * (j))
#define XB_XSUB(j)  (1280 + 64 * (j))
#define XB_XGEN(j)  (2304 + 64 * (j))
#define XB_TOP      3328
#define XB_TOPGEN   3392
#define XB_SPIN_CAP (1u << 22)
DEVI unsigned xb_ld(unsigned* p) { return __hip_atomic_load(p, __ATOMIC_RELAXED, __HIP_MEMORY_SCOPE_AGENT); }
DEVI unsigned xb_add(unsigned* p, unsigned v) { return __hip_atomic_fetch_add(p, v, __ATOMIC_RELAXED, __HIP_MEMORY_SCOPE_AGENT); }
DEVI unsigned xb_xcc_id() { return (unsigned)__builtin_amdgcn_s_getreg((3 << 11) | 20) & 0xFu; }
#define XB_SPIN(cond, bar) do { unsigned _sp = 0; while (cond) { __builtin_amdgcn_s_sleep(1); \
    if ((++_sp & 255u) == 0u) { if (xb_ld(&(bar)[XB_TMO])) break; if (_sp > XB_SPIN_CAP) { atomicAdd(&(bar)[XB_TMO], 1u); break; } } } } while (0)
struct XcdBarrier { unsigned* bar; unsigned x; unsigned* st; };
DEVI XcdBarrier xcd_barrier_post(unsigned* bar, unsigned* st) {
    XcdBarrier b; b.bar = bar; b.x = xb_xcc_id(); b.st = st;
    if (__builtin_amdgcn_workitem_id_x() == 0) (void)xb_add(&bar[XB_XCNT(b.x)], 1u);
    return b;
}
DEVI void xcd_barrier_complete(unsigned* bar, unsigned x, unsigned& nloc, unsigned& nx) {
    const unsigned G = gridDim.x * gridDim.y * gridDim.z;
    unsigned sum, cnt, mine, sp = 0u;
    for (;;) {
        sum = 0u; cnt = 0u; mine = 0u;
#pragma unroll
        for (unsigned j = 0; j < 16; ++j) { const unsigned c = xb_ld(&bar[XB_XCNT(j)]); sum += c; cnt += (c > 0u) ? 1u : 0u; mine = (j == x) ? c : mine; }
        if (sum == G) break;
        __builtin_amdgcn_s_sleep(1);
        if ((++sp & 255u) == 0u) { if (xb_ld(&bar[XB_TMO])) break; if (sp > XB_SPIN_CAP) { atomicAdd(&bar[XB_TMO], 1u); break; } }
    }
    nloc = mine > 0u ? mine : 1u; nx = cnt > 0u ? cnt : 1u;
}
DEVI void xcd_barrier(const XcdBarrier& b) {
    asm volatile("s_waitcnt vmcnt(0)" ::: "memory");
    __syncthreads();
    if (__builtin_amdgcn_workitem_id_x() == 0) {
        unsigned* bar = b.bar;
        __builtin_amdgcn_s_waitcnt(0);
        unsigned nloc = xb_ld(&b.st[0]), nx = xb_ld(&b.st[1]);
        if (nloc == 0u) { xcd_barrier_complete(bar, b.x, nloc, nx); __hip_atomic_store(&b.st[0], nloc, __ATOMIC_RELAXED, __HIP_MEMORY_SCOPE_AGENT); __hip_atomic_store(&b.st[1], nx, __ATOMIC_RELAXED, __HIP_MEMORY_SCOPE_AGENT); }
        const unsigned old = xb_add(&bar[XB_XSUB(b.x)], 1u);
        const unsigned gen = old / nloc;
        if (old + 1u == (gen + 1u) * nloc) {
            __builtin_amdgcn_fence(__ATOMIC_RELEASE, "agent");
            asm volatile("s_waitcnt vmcnt(0)" ::: "memory");
            const unsigned og = xb_add(&bar[XB_TOP], 1u);
            const unsigned tg = og / nx;
            if (og + 1u == (tg + 1u) * nx) xb_add(&bar[XB_TOPGEN], 1u);
            else XB_SPIN(xb_ld(&bar[XB_TOPGEN]) == tg, bar);
            __builtin_amdgcn_fence(__ATOMIC_ACQUIRE, "agent");
            xb_add(&bar[XB_XGEN(b.x)], 1u);
            asm volatile("s_waitcnt vmcnt(0)" ::: "memory");
        } else {
            XB_SPIN(xb_ld(&bar[XB_XGEN(b.x)]) == gen, bar);
            __builtin_amdgcn_fence(__ATOMIC_ACQUIRE, "agent");
            asm volatile("s_waitcnt vmcnt(0)" ::: "memory");
        }
    }
    __syncthreads();
}

constexpr int NPHASE = 24;
DEVI void run_phase(const Params& p, int ph, unsigned char* smem) {
#ifndef ONLYK
    if (ph == 0) { phase0(p, smem); return; }
    if (ph == 23) { phase_norm1(p, 1, 1, smem); return; }
#endif
    const int l = (ph - 1) / 11, k = (ph - 1) % 11;
#ifdef ONLYK
    if (k != ONLYK) return;
#endif
    switch (k) {
    case 0: phase_norm1(p, l, 0, smem); break;
    case 1: phase_win(p, l, smem); break;
    case 2: phase_mla_up(p, l, smem); break;
    case 3: phase_mix(p, l, smem); break;
    case 4: phase_fin(p, l); break;
    case 5: phase_merge_wout(p, l, smem); break;
    case 6: break;
    case 7: phase_norm1(p, l, 2, smem); break;
    case 8: phase_route(p, l, smem); break;
    case 9: phase_moe(p, l, smem); break;
    default: break;
    }
}

__global__ void __launch_bounds__(256, 2) k_main(Params p, int ph_lo, int ph_hi) {
    __shared__ __attribute__((aligned(16))) unsigned char smem[SMEM_BYTES];
    unsigned* xb_priv = (unsigned*)(p.ws + OFF_PRIV + (size_t)__builtin_amdgcn_workgroup_id_x() * 1024 + 896);
    if (__builtin_amdgcn_workitem_id_x() == 0) { __hip_atomic_store(xb_priv, 0u, __ATOMIC_RELAXED, __HIP_MEMORY_SCOPE_AGENT); __hip_atomic_store(xb_priv + 1, 0u, __ATOMIC_RELAXED, __HIP_MEMORY_SCOPE_AGENT); }
    XcdBarrier xb = xcd_barrier_post(g_bar, xb_priv);
    if (__builtin_amdgcn_workitem_id_x() == 0) {
        const unsigned rk = xb_add(g_bar + 3456 + xb.x, 1u);
        __hip_atomic_store(xb_priv + 2, xb.x, __ATOMIC_RELAXED, __HIP_MEMORY_SCOPE_AGENT);
        __hip_atomic_store(xb_priv + 3, rk, __ATOMIC_RELAXED, __HIP_MEMORY_SCOPE_AGENT);
    }
    for (int ph = ph_lo; ph < ph_hi; ++ph) {
        if (ph >= 1 && ph <= 22 && (((ph - 1) % 11) == 6 || ((ph - 1) % 11) == 10)) continue;
        run_phase(p, ph, smem);
#ifdef DUPK
        if (ph >= 1 && ph <= 22 && ((ph - 1) % 11) == DUPK) run_phase(p, ph, smem);
        if (DUPK == 10 && ph == 0) run_phase(p, ph, smem);
#endif
        if (ph + 1 < ph_hi) {
            if (ph_hi < 0) cg::this_grid().sync();
            xcd_barrier(xb);
        }
    }
#ifdef TPROBE
    if (__builtin_amdgcn_workgroup_id_x() == 0 && __builtin_amdgcn_workitem_id_x() == 0) {
        const unsigned long long dt = __hip_atomic_load(T_SLOT(TPROBE), __ATOMIC_RELAXED, __HIP_MEMORY_SCOPE_AGENT) * TMULT;
        const unsigned long long t0 = __builtin_amdgcn_s_memrealtime();
        while (__builtin_amdgcn_s_memrealtime() - t0 < dt) __builtin_amdgcn_s_sleep(8);
    }
#endif
    __syncthreads();
    if (__builtin_amdgcn_workitem_id_x() == 0) {
        __builtin_amdgcn_fence(__ATOMIC_RELEASE, "agent");
        const unsigned old = xb_add(&g_bar[XB_EXIT], 1u);
        __builtin_amdgcn_fence(__ATOMIC_ACQUIRE, "agent");
        *(volatile unsigned*)smem = old;
    }
    __syncthreads();
    if (*(volatile unsigned*)smem == gridDim.x - 1u) {
        for (int i = __builtin_amdgcn_workitem_id_x(); i < 4096; i += 256) __hip_atomic_store(&g_bar[i], 0u, __ATOMIC_RELAXED, __HIP_MEMORY_SCOPE_AGENT);
    }
}

extern "C" void kernel_launch(void* const* d_in, const int* in_sizes, int n_in, void* d_out, int out_size, void* d_ws, size_t ws_size,
                              hipStream_t stream) {
    if (ws_size < WS_NEED || n_in < N_IN) { fprintf(stderr, "workspace too small: %zu < %zu\n", ws_size, (size_t)WS_NEED); return; }
    Params p{};
    for (int i = 0; i < N_IN; ++i) p.in[i] = (const float*)d_in[i];
    p.out = (float*)d_out;
    p.ws = (unsigned char*)d_ws;
    static int grid_blocks = 0;
    if (!grid_blocks) {
        int dev = 0, cus = 0, per_cu = 0;
        hipGetDevice(&dev);
        hipDeviceGetAttribute(&cus, hipDeviceAttributeMultiprocessorCount, dev);
        hipOccupancyMaxActiveBlocksPerMultiprocessor(&per_cu, k_main, 256, DYN_LDS);
        if (per_cu > 2) per_cu = 2;
        if (per_cu < 1) per_cu = 1;
        grid_blocks = cus * per_cu;
    }
#if ONE_LAUNCH
    int lo = 0, hi = NPHASE;
    void* args[] = {&p, &lo, &hi};
    hipError_t e = hipLaunchCooperativeKernel((void*)k_main, dim3(grid_blocks), dim3(256), args, DYN_LDS, stream);
    if (e != hipSuccess) fprintf(stderr, "cooperative launch failed: %s (grid %d)\n", hipGetErrorString(e), grid_blocks);
#else
    for (int ph = 0; ph < NPHASE; ++ph) hipLaunchKernelGGL(k_main, dim3(grid_blocks), dim3(256), DYN_LDS, stream, p, ph, ph + 1);
#endif
}
```
